# Optimizing an MI355X kernel written in HIP

```python
import jax, jax.numpy as jnp
from jax import lax
import numpy as np

D_MODEL = 1024
BATCH = 1
SEQ = 16384
DEPTH = 1

CHUNK = 64
C_CONV = 512
CONV_WIDTH = 31
N_HEADS = 8
HEAD_DIM = 64
D_ATTN = N_HEADS * HEAD_DIM
IDX_HEADS = 8
IDX_DIM = 64
TOPK_KEYS_MAX = 256
Q_BLOCK = 128
ROPE_THETA = 10000.0
D_MIX = C_CONV + D_ATTN
N_IN = 2 * C_CONV + 3 * D_ATTN + IDX_HEADS * IDX_DIM + IDX_DIM + IDX_HEADS
N_EXPERTS = 32
TOP_K_EXPERTS = 4
D_EXPERT = 1024
SWIGLU_LIMIT = 7.0
SWIGLU_ALPHA = 1.702
EXPERT_BLOCK = 128
NORM_EPS = 1e-5

kernel_name = 'hymba_conformer_dsa_moe_block'


def rmsnorm(x, g):
    xf = x.astype(jnp.float32)
    y = xf * lax.rsqrt(jnp.mean(xf * xf, axis=-1, keepdims=True) + NORM_EPS)
    return (y * g.astype(jnp.float32)).astype(x.dtype)


def layernorm(x, g, b):
    xf = x.astype(jnp.float32)
    mu = jnp.mean(xf, axis=-1, keepdims=True)
    var = jnp.mean(jnp.square(xf - mu), axis=-1, keepdims=True)
    y = (xf - mu) * lax.rsqrt(var + NORM_EPS)
    return (y * g.astype(jnp.float32) + b.astype(jnp.float32)).astype(x.dtype)


def rope(x, pos):
    d = x.shape[-1]
    half = d // 2
    inv = ROPE_THETA ** (-jnp.arange(half, dtype=jnp.float32) / half)
    ang = pos.astype(jnp.float32)[..., None] * inv
    ang = ang.reshape(ang.shape[:2] + (1,) * (x.ndim - 3) + (half,))
    cos, sin = jnp.cos(ang), jnp.sin(ang)
    xf = x.astype(jnp.float32)
    x1, x2 = xf[..., :half], xf[..., half:]
    return jnp.concatenate([x1 * cos - x2 * sin, x2 * cos + x1 * sin], axis=-1).astype(x.dtype)


def causal_depthwise_conv(u, w, b):
    out = lax.conv_general_dilated(
        u, w[:, None, :].astype(u.dtype), window_strides=(1,),
        padding=[(CONV_WIDTH - 1, 0)], dimension_numbers=('NWC', 'WIO', 'NWC'),
        feature_group_count=u.shape[-1])
    return out + b.astype(u.dtype)


def dsa_attention(q, k, v, qi, ki, wi, pos):
    B, S = pos.shape
    nb = S // Q_BLOCK
    k_sel = min(TOPK_KEYS_MAX, S // 4)
    chunk = pos // CHUNK
    gather = jax.vmap(lambda a, i: a[i])

    def to_blocks(a):
        return jnp.moveaxis(a.reshape((B, nb, Q_BLOCK) + a.shape[2:]), 1, 0)

    def one_block(args):
        qb, qib, wib, cqb = args
        s_h = jax.nn.relu(jnp.einsum('bqhd,bsd->bqhs', qib, ki).astype(jnp.float32))
        s_idx = jnp.einsum('bqhs,bqh->bqs', s_h, wib.astype(jnp.float32))
        adm = chunk[:, None, :] <= cqb[:, :, None]
        s_idx = jnp.where(adm, s_idx, -jnp.inf)
        _, sel = lax.top_k(s_idx, k_sel)
        kg = gather(k, sel)
        vg = gather(v, sel)
        valid = gather(chunk, sel) <= cqb[:, :, None]
        logits = jnp.einsum('bqhd,bqkhd->bqhk', qb, kg).astype(jnp.float32) * (HEAD_DIM ** -0.5)
        logits = jnp.where(valid[:, :, None, :], logits, -jnp.inf)
        p = jax.nn.softmax(logits, axis=-1).astype(vg.dtype)
        return jnp.einsum('bqhk,bqkhd->bqhd', p, vg)

    out = lax.map(one_block, (to_blocks(q), to_blocks(qi), to_blocks(wi), to_blocks(chunk)))
    return jnp.moveaxis(out, 0, 1).reshape(B, S, -1)


def moe_ffn(xn, w_router, b_router, w_gate_up, b_gate_up, w_down, b_down):
    B, S, D = xn.shape
    T = B * S
    xf = xn.reshape(T, D)
    logits = (xf @ w_router + b_router).astype(jnp.float32)
    top_vals, top_idx = lax.top_k(logits, TOP_K_EXPERTS)
    gates = jax.nn.softmax(top_vals, axis=-1)
    n_pairs = T * TOP_K_EXPERTS
    expert_flat = top_idx.reshape(-1).astype(jnp.int32)
    token_flat = jnp.arange(n_pairs, dtype=jnp.int32) // TOP_K_EXPERTS
    gate_flat = gates.reshape(-1)
    order = jnp.argsort(expert_flat, stable=True)
    sorted_expert = expert_flat[order]
    counts = jax.ops.segment_sum(jnp.ones_like(expert_flat), expert_flat, num_segments=N_EXPERTS)
    padded = (counts + EXPERT_BLOCK - 1) // EXPERT_BLOCK * EXPERT_BLOCK
    start = jnp.cumsum(counts) - counts
    padded_end = jnp.cumsum(padded)
    padded_start = padded_end - padded
    dest = padded_start[sorted_expert] + jnp.arange(n_pairs, dtype=jnp.int32) - start[sorted_expert]
    n_blocks = -(-n_pairs // EXPERT_BLOCK) + N_EXPERTS
    n_rows = n_blocks * EXPERT_BLOCK
    row_token = jnp.zeros((n_rows,), jnp.int32).at[dest].set(token_flat[order])
    row_gate = jnp.zeros((n_rows,), jnp.float32).at[dest].set(gate_flat[order])
    block_start = jnp.arange(n_blocks, dtype=jnp.int32) * EXPERT_BLOCK
    block_expert = jnp.minimum(jnp.searchsorted(padded_end, block_start, side='right'), N_EXPERTS - 1)

    def expert_block(args):
        xb, e = args
        gu = xb @ w_gate_up[e] + b_gate_up[e]
        g, u = jnp.split(gu, 2, axis=-1)
        g = jnp.minimum(g, SWIGLU_LIMIT)
        u = jnp.clip(u, -SWIGLU_LIMIT, SWIGLU_LIMIT)
        hdn = g * jax.nn.sigmoid(SWIGLU_ALPHA * g) * (u + 1)
        return hdn @ w_down[e] + b_down[e]

    xs = xf[row_token].reshape(n_blocks, EXPERT_BLOCK, D)
    ys = lax.map(expert_block, (xs, block_expert)).reshape(n_rows, D)
    ys = ys * row_gate[:, None].astype(ys.dtype)
    out = jnp.zeros_like(xf).at[row_token].add(ys)
    return out.reshape(B, S, D)


def setup_inputs(seed: int = 0) -> dict:
    key = jax.random.key(seed)
    ks = jax.random.split(key, 20)
    f32 = jnp.float32

    def nrm(k, shape, scale):
        return jax.random.normal(k, shape, f32) * scale

    return {
        'x': nrm(ks[0], (BATCH, SEQ, D_MODEL), 1.0),
        'positions': jnp.broadcast_to(jnp.arange(SEQ, dtype=jnp.int32), (BATCH, SEQ)),
        'norm_mix_g': 1.0 + nrm(ks[1], (DEPTH, D_MODEL), 0.02),
        'w_in': nrm(ks[2], (DEPTH, D_MODEL, N_IN), D_MODEL ** -0.5),
        'idx_k_norm_g': 1.0 + nrm(ks[3], (DEPTH, IDX_DIM), 0.02),
        'idx_k_norm_b': nrm(ks[4], (DEPTH, IDX_DIM), 0.02),
        'conv_w': nrm(ks[5], (DEPTH, CONV_WIDTH, C_CONV), CONV_WIDTH ** -0.5),
        'conv_b': nrm(ks[6], (DEPTH, C_CONV), 0.02),
        'conv_norm_g': 1.0 + nrm(ks[7], (DEPTH, C_CONV), 0.02),
        'conv_norm_b': nrm(ks[8], (DEPTH, C_CONV), 0.02),
        'w_out': nrm(ks[9], (DEPTH, D_MIX, D_MODEL), D_MIX ** -0.5),
        'norm_ffn_g': 1.0 + nrm(ks[10], (DEPTH, D_MODEL), 0.02),
        'w_router': nrm(ks[11], (DEPTH, D_MODEL, N_EXPERTS), D_MODEL ** -0.5),
        'b_router': nrm(ks[12], (DEPTH, N_EXPERTS), 0.01),
        'w_gate_up': nrm(ks[13], (DEPTH, N_EXPERTS, D_MODEL, 2 * D_EXPERT), D_MODEL ** -0.5),
        'b_gate_up': nrm(ks[14], (DEPTH, N_EXPERTS, 2 * D_EXPERT), 0.01),
        'w_down': nrm(ks[15], (DEPTH, N_EXPERTS, D_EXPERT, D_MODEL), D_EXPERT ** -0.5),
        'b_down': nrm(ks[16], (DEPTH, N_EXPERTS, D_MODEL), 0.01),
        'norm_final_g': 1.0 + nrm(ks[17], (D_MODEL,), 0.02),
    }


def reference(x, positions, norm_mix_g, w_in, idx_k_norm_g, idx_k_norm_b, conv_w, conv_b,
              conv_norm_g, conv_norm_b, w_out, norm_ffn_g, w_router, b_router, w_gate_up,
              b_gate_up, w_down, b_down, norm_final_g):
    B, S, _ = x.shape
    sizes = (C_CONV, C_CONV, D_ATTN, D_ATTN, D_ATTN, IDX_HEADS * IDX_DIM, IDX_DIM, IDX_HEADS)
    cuts = [sum(sizes[:i + 1]) for i in range(len(sizes) - 1)]
    h = x
    for l in range(DEPTH):
        hn = rmsnorm(h, norm_mix_g[l])
        proj = hn @ w_in[l]
        glu_val, glu_gate, q, k, v, qi, ki, wi = jnp.split(proj, cuts, axis=-1)
        u = glu_val * jax.nn.sigmoid(glu_gate)
        u = causal_depthwise_conv(u, conv_w[l], conv_b[l])
        u = jax.nn.silu(layernorm(u, conv_norm_g[l], conv_norm_b[l]))
        q = rope(q.reshape(B, S, N_HEADS, HEAD_DIM), positions)
        k = rope(k.reshape(B, S, N_HEADS, HEAD_DIM), positions)
        v = v.reshape(B, S, N_HEADS, HEAD_DIM)
        qi = rope(qi.reshape(B, S, IDX_HEADS, IDX_DIM), positions)
        ki = rope(layernorm(ki, idx_k_norm_g[l], idx_k_norm_b[l]), positions)
        wi = wi * (IDX_HEADS ** -0.5 * IDX_DIM ** -0.5)
        a = dsa_attention(q, k, v, qi, ki, wi, positions)
        h = h + jnp.concatenate([u, a], axis=-1) @ w_out[l]
        h = h + moe_ffn(rmsnorm(h, norm_ffn_g[l]), w_router[l], b_router[l], w_gate_up[l],
                        b_gate_up[l], w_down[l], b_down[l])
    return rmsnorm(h, norm_final_g)
```

```cpp
#include <hip/hip_runtime.h>
#include <hip/hip_cooperative_groups.h>
#include <cstdio>
#include <cstdint>
namespace cg = cooperative_groups;

constexpr int S = 16384, D = 1024, NIN = 3144, NP = 3328;
constexpr int CC = 512, CW = 31, NH = 8, HD = 64, NE = 32, DE = 1024;
constexpr int C_VAL = 0, C_GATE = 512, C_Q = 1024, C_K = 1536, C_V = 2048, C_QI = 2560, C_KI = 3072, C_WI = 3136;
constexpr int KSEL = 256;
constexpr float EPS = 1e-5f;
constexpr float C2 = 0.125f * 1.4426950408889634f;
constexpr int NTHREADS = 512, NWAVES = 8;
constexpr int MAXROWS = 65536 + NE * 256;
constexpr int MAXTILES = MAXROWS / 256;

constexpr size_t MiB = 1u << 20;
constexpr size_t WS_CTL = 0, CTL_BYTES = 1 * MiB;
constexpr size_t WS_WINT = 2 * MiB;
constexpr size_t WS_WOUTT = 9 * MiB;
constexpr size_t WS_WGRT = 11 * MiB;
constexpr size_t WS_COS = 12 * MiB;
constexpr size_t WS_SIN = 14 * MiB;
constexpr size_t WS_WGUT = 16 * MiB;
constexpr size_t WS_WDT = 144 * MiB;
constexpr size_t WS_XN = 208 * MiB;
constexpr size_t WS_PROJ = 240 * MiB;
constexpr size_t WS_MIX = 344 * MiB;
constexpr size_t WS_KI = 376 * MiB;
constexpr size_t WS_QL = 378 * MiB;
constexpr size_t WS_WI = 380 * MiB;
constexpr size_t WS_RSTD = 381 * MiB;
constexpr size_t WS_TOKOF = 382 * MiB;
constexpr size_t WS_GATEOF = 384 * MiB;
constexpr size_t WS_PAIR = 386 * MiB;
constexpr size_t WS_ROWRSTD = 387 * MiB;
constexpr size_t WS_ROWGATE = 388 * MiB;
constexpr size_t WS_MASK = 392 * MiB;
constexpr size_t WS_H2 = 424 * MiB;
constexpr size_t WS_XS = 488 * MiB;
constexpr size_t WS_HDN = 632 * MiB;
constexpr size_t WS_YS = 776 * MiB;
constexpr size_t WS_END = 920 * MiB;
constexpr int CW_CNT = 1024;

constexpr int LDS_BYTES = 147456;
constexpr int LDS_MISC = 131072;

typedef unsigned short bf16;
typedef unsigned long long u64;
typedef float f32x4 __attribute__((ext_vector_type(4)));
typedef unsigned u32x4 __attribute__((ext_vector_type(4)));

__device__ __forceinline__ float bf2f(unsigned v) { return __uint_as_float(v << 16); }
__device__ __forceinline__ unsigned f2bf(float f) { unsigned u = __float_as_uint(f); return (u + 0x7fffu + ((u >> 16) & 1u)) >> 16; }
__device__ __forceinline__ unsigned pk2(float lo, float hi) { return f2bf(lo) | (f2bf(hi) << 16); }
__device__ __forceinline__ float blo(unsigned w) { return __uint_as_float(w << 16); }
__device__ __forceinline__ float bhi(unsigned w) { return __uint_as_float(w & 0xffff0000u); }
__device__ __forceinline__ float wave_sum(float v) {
#pragma unroll
    for (int o = 1; o < 64; o <<= 1) v += __shfl_xor(v, o);
    return v;
}
__device__ __forceinline__ float wave_max(float v) {
#pragma unroll
    for (int o = 1; o < 64; o <<= 1) v = fmaxf(v, __shfl_xor(v, o));
    return v;
}
__device__ __forceinline__ float sigmoidf_(float x) { return 1.f / (1.f + __expf(-x)); }

struct Params {
    const float* x; const int* pos; const float* norm_mix_g; const float* w_in; const float* idx_g; const float* idx_b;
    const float* conv_w; const float* conv_b; const float* conv_ng; const float* conv_nb; const float* w_out; const float* norm_ffn_g;
    const float* w_router; const float* b_router; const float* w_gu; const float* b_gu; const float* w_down; const float* b_down;
    const float* norm_final_g; float* out; unsigned char* ws;
};

__device__ __forceinline__ void transpose_item(const float* W, int K, int N, bf16* WT, int dst_row0, int k0, int n0, float* scr, int lane) {
#pragma unroll 8
    for (int i = 0; i < 32; ++i) { const int kk = 2 * i + (lane >> 5); const int n = n0 + (lane & 31);
        scr[kk * 33 + (lane & 31)] = (n < N) ? W[(size_t)(k0 + kk) * N + n] : 0.f; }
    __builtin_amdgcn_s_waitcnt(0); asm volatile("" ::: "memory");
    const int c = lane & 7;
#pragma unroll
    for (int j = 0; j < 4; ++j) { const int n = (lane >> 3) + 8 * j; const float* s = scr + (8 * c) * 33 + n;
        u32x4 o; o.x = pk2(s[0 * 33], s[1 * 33]); o.y = pk2(s[2 * 33], s[3 * 33]); o.z = pk2(s[4 * 33], s[5 * 33]); o.w = pk2(s[6 * 33], s[7 * 33]);
        *(u32x4*)(WT + (size_t)(dst_row0 + n) * K + k0 + 8 * c) = o; }
    __builtin_amdgcn_s_waitcnt(0); asm volatile("" ::: "memory");
}

__device__ __forceinline__ void phase_prologue(const Params& p, unsigned char* lds) {
    const int tid = threadIdx.x, lane = tid & 63, wave = tid >> 6;
    const int gw = blockIdx.x * NWAVES + wave, NGW = gridDim.x * NWAVES;
    float* scr = (float*)(lds + wave * 16384);
    bf16* WinT = (bf16*)(p.ws + WS_WINT); bf16* WoutT = (bf16*)(p.ws + WS_WOUTT); bf16* WguT = (bf16*)(p.ws + WS_WGUT); bf16* WdT = (bf16*)(p.ws + WS_WDT);
    constexpr int I_IN = 16 * (NP / 32), I_OUT = 16 * 32, I_GU = 16 * 64, I_DN = 16 * 32;
    constexpr int NITEMS = I_IN + I_OUT + NE * I_GU + NE * I_DN;
    for (int it = gw; it < NITEMS; it += NGW) {
        int r = it;
        if (r < I_IN) { const int nb = r % (NP / 32), kb = r / (NP / 32); transpose_item(p.w_in, D, NIN, WinT, nb * 32, kb * 64, nb * 32, scr, lane); continue; }
        r -= I_IN;
        if (r < I_OUT) { const int nb = r % 32, kb = r / 32; transpose_item(p.w_out, D, D, WoutT, nb * 32, kb * 64, nb * 32, scr, lane); continue; }
        r -= I_OUT;
        if (r < NE * I_GU) { const int e = r / I_GU, q = r % I_GU, nb = q % 64, kb = q / 64; const int n0 = nb * 32;
            const int c = n0 & 1023, isu = n0 >> 10; const int drow = e * 2048 + (c >> 7) * 256 + isu * 128 + (c & 127);
            transpose_item(p.w_gu + (size_t)e * D * 2048, D, 2048, WguT, drow - 0, kb * 64, n0, scr, lane);
            continue; }
        r -= NE * I_GU;
        { const int e = r / I_DN, q = r % I_DN, nb = q % 32, kb = q / 32;
            transpose_item(p.w_down + (size_t)e * DE * D, DE, D, WdT, e * D + nb * 32, kb * 64, nb * 32, scr, lane); }
    }
    for (int i = blockIdx.x * NTHREADS + tid; i < NE * D; i += gridDim.x * NTHREADS) { const int e = i / D, k = i % D; ((float*)(p.ws + WS_WGRT))[i] = p.norm_ffn_g[k] * p.w_router[k * NE + e]; }
    for (int i = blockIdx.x * NTHREADS + tid; i < S * 32; i += gridDim.x * NTHREADS) { const int t = i >> 5, j = i & 31;
        const float inv = powf(10000.f, -(float)j / 32.f); const float ang = (float)p.pos[t] * inv;
        double xr = (double)ang * 0.15915494309189535; xr -= floor(xr); const float xf = (float)xr;
        ((float*)(p.ws + WS_COS))[i] = __builtin_amdgcn_cosf(xf); ((float*)(p.ws + WS_SIN))[i] = __builtin_amdgcn_sinf(xf); }
    bf16* XN = (bf16*)(p.ws + WS_XN);
    for (int m = gw; m < S; m += NGW) {
        const f32x4* xr = (const f32x4*)(p.x + (size_t)m * D) + lane; f32x4 v[4]; float ss = 0.f;
#pragma unroll
        for (int j = 0; j < 4; ++j) { v[j] = xr[64 * j]; ss += v[j].x * v[j].x + v[j].y * v[j].y + v[j].z * v[j].z + v[j].w * v[j].w; }
        const float rstd = rsqrtf(wave_sum(ss) * (1.f / D) + EPS);
        u64* o8 = (u64*)(XN + (size_t)m * D) + lane;
#pragma unroll
        for (int j = 0; j < 4; ++j) { const f32x4 g = ((const f32x4*)p.norm_mix_g)[lane + 64 * j];
            o8[64 * j] = (u64)pk2(v[j].x * rstd * g.x, v[j].y * rstd * g.y) | ((u64)pk2(v[j].z * rstd * g.z, v[j].w * rstd * g.w) << 32); }
    }
}

template <class Epi>
__device__ __forceinline__ void ngemm_unit(unsigned char* lds, const bf16* A, int lda, const bf16* Bt, int ldb, int K, const Epi& epi) {
    float* As = (float*)lds; float* Bs = As + 32 * 256;
    const int tid = threadIdx.x, tr = tid >> 4, tc = tid & 15;
    float acc0[8][8], acc1[8][8];
#pragma unroll
    for (int i = 0; i < 8; ++i)
#pragma unroll
        for (int j = 0; j < 8; ++j) { acc0[i][j] = 0.f; acc1[i][j] = 0.f; }
    for (int k0 = 0; k0 < K; k0 += 32) {
        __syncthreads();
#pragma unroll
        for (int j = 0; j < 2; ++j) { const int pidx = tid + 512 * j, r = pidx & 255, kq = pidx >> 8;
            const u32x4 va = *(const u32x4*)(A + (size_t)r * lda + k0 + kq * 8);
            const u32x4 vb = *(const u32x4*)(Bt + (size_t)r * ldb + k0 + kq * 8);
            float* ap = As + (kq * 8) * 256 + r; float* bp = Bs + (kq * 8) * 256 + r;
            ap[0 * 256] = blo(va.x); ap[1 * 256] = bhi(va.x); ap[2 * 256] = blo(va.y); ap[3 * 256] = bhi(va.y); ap[4 * 256] = blo(va.z); ap[5 * 256] = bhi(va.z); ap[6 * 256] = blo(va.w); ap[7 * 256] = bhi(va.w);
            bp[0 * 256] = blo(vb.x); bp[1 * 256] = bhi(vb.x); bp[2 * 256] = blo(vb.y); bp[3 * 256] = bhi(vb.y); bp[4 * 256] = blo(vb.z); bp[5 * 256] = bhi(vb.z); bp[6 * 256] = blo(vb.w); bp[7 * 256] = bhi(vb.w); }
        __syncthreads();
#pragma unroll 2
        for (int kk = 0; kk < 32; ++kk) {
            const f32x4 a0 = *(const f32x4*)(As + kk * 256 + tr * 8), a1 = *(const f32x4*)(As + kk * 256 + tr * 8 + 4);
            const f32x4 b00 = *(const f32x4*)(Bs + kk * 256 + tc * 8), b01 = *(const f32x4*)(Bs + kk * 256 + tc * 8 + 4);
            const f32x4 b10 = *(const f32x4*)(Bs + kk * 256 + 128 + tc * 8), b11 = *(const f32x4*)(Bs + kk * 256 + 128 + tc * 8 + 4);
            const float a[8] = {a0.x, a0.y, a0.z, a0.w, a1.x, a1.y, a1.z, a1.w};
            const float b0[8] = {b00.x, b00.y, b00.z, b00.w, b01.x, b01.y, b01.z, b01.w};
            const float b1[8] = {b10.x, b10.y, b10.z, b10.w, b11.x, b11.y, b11.z, b11.w};
#pragma unroll
            for (int i = 0; i < 8; ++i)
#pragma unroll
                for (int j = 0; j < 8; ++j) { acc0[i][j] = fmaf(a[i], b0[j], acc0[i][j]); acc1[i][j] = fmaf(a[i], b1[j], acc1[i][j]); }
        }
    }
#pragma unroll
    for (int i = 0; i < 8; ++i) epi(tr * 8 + i, tc * 8, acc0[i], acc1[i]);
}

__device__ __forceinline__ void store8_bf16(bf16* dst, const float (&v)[8]) {
    u32x4 o; o.x = pk2(v[0], v[1]); o.y = pk2(v[2], v[3]); o.z = pk2(v[4], v[5]); o.w = pk2(v[6], v[7]); *(u32x4*)dst = o;
}

struct EpiProj { bf16* O; int pm, pn;
    __device__ __forceinline__ void operator()(int r, int c8, const float (&v0)[8], const float (&v1)[8]) const {
        bf16* row = O + (size_t)(pm * 256 + r) * NP + pn * 256 + c8; store8_bf16(row, v0); store8_bf16(row + 128, v1); } };
struct EpiOut { const float* x; const float* gffn; float* H2; bf16* XN2; int pm, pn;
    __device__ __forceinline__ void operator()(int r, int c8, const float (&v0)[8], const float (&v1)[8]) const {
        const size_t off = (size_t)(pm * 256 + r) * D + pn * 256 + c8; float h0[8], h1[8], n0[8], n1[8];
#pragma unroll
        for (int i = 0; i < 8; ++i) { h0[i] = x[off + i] + v0[i]; h1[i] = x[off + 128 + i] + v1[i]; n0[i] = h0[i] * gffn[pn * 256 + c8 + i]; n1[i] = h1[i] * gffn[pn * 256 + 128 + c8 + i]; }
        *(f32x4*)(H2 + off) = (f32x4){h0[0], h0[1], h0[2], h0[3]}; *(f32x4*)(H2 + off + 4) = (f32x4){h0[4], h0[5], h0[6], h0[7]};
        *(f32x4*)(H2 + off + 128) = (f32x4){h1[0], h1[1], h1[2], h1[3]}; *(f32x4*)(H2 + off + 132) = (f32x4){h1[4], h1[5], h1[6], h1[7]};
        store8_bf16(XN2 + off, n0); store8_bf16(XN2 + off + 128, n1); } };
struct EpiGU { const float* bgu; const float* rowrstd; bf16* HDN; int pt, e, pnl;
    __device__ __forceinline__ void operator()(int r, int c8, const float (&v0)[8], const float (&v1)[8]) const {
        const int row = pt * 256 + r; const float rs = rowrstd[row]; const int cb = pnl * 128 + c8; float h[8];
#pragma unroll
        for (int i = 0; i < 8; ++i) { float g = v0[i] * rs + bgu[e * 2048 + cb + i]; float u = v1[i] * rs + bgu[e * 2048 + 1024 + cb + i];
            g = fminf(g, 7.f); u = fminf(fmaxf(u, -7.f), 7.f); h[i] = g * sigmoidf_(1.702f * g) * (u + 1.f); }
        store8_bf16(HDN + (size_t)row * DE + cb, h); } };
struct EpiDown { const float* bd; const float* rowgate; bf16* YS; int pt, e, pnl;
    __device__ __forceinline__ void operator()(int r, int c8, const float (&v0)[8], const float (&v1)[8]) const {
        const int row = pt * 256 + r; const float gt = rowgate[row]; const int cb = pnl * 256 + c8; float y0[8], y1[8];
#pragma unroll
        for (int i = 0; i < 8; ++i) { y0[i] = (v0[i] + bd[e * D + cb + i]) * gt; y1[i] = (v1[i] + bd[e * D + cb + 128 + i]) * gt; }
        store8_bf16(YS + (size_t)row * D + cb, y0); store8_bf16(YS + (size_t)row * D + cb + 128, y1); } };

__device__ __forceinline__ void phase_ew_naive(const Params& p, unsigned char* lds) {
    const int tid = threadIdx.x, lane = tid & 63, wave = tid >> 6;
    bf16* PROJ = (bf16*)(p.ws + WS_PROJ); bf16* MIX = (bf16*)(p.ws + WS_MIX); bf16* KI = (bf16*)(p.ws + WS_KI); bf16* QL = (bf16*)(p.ws + WS_QL); float* WI = (float*)(p.ws + WS_WI);
    const float* COS = (const float*)(p.ws + WS_COS); const float* SIN = (const float*)(p.ws + WS_SIN);
    float* red = (float*)(lds);
    for (int t = blockIdx.x; t < S; t += gridDim.x) {
        const int c = tid; float acc = p.conv_b[c];
        for (int j = 0; j < CW; ++j) { const int tt = t - (CW - 1) + j; if (tt >= 0) { const float val = bf2f(PROJ[(size_t)tt * NP + C_VAL + c]), gate = bf2f(PROJ[(size_t)tt * NP + C_GATE + c]);
                acc = fmaf(p.conv_w[j * CC + c], val * sigmoidf_(gate), acc); } }
        const int hh = (tid & 255) >> 5, ii = tid & 31; const int qkbase = (tid < 256) ? C_Q : C_K;
        const float cs = COS[t * 32 + ii], sn = SIN[t * 32 + ii];
        const float x1 = bf2f(PROJ[(size_t)t * NP + qkbase + hh * 64 + ii]), x2 = bf2f(PROJ[(size_t)t * NP + qkbase + hh * 64 + 32 + ii]);
        float qi1 = 0.f, qi2 = 0.f; if (tid < 256) { qi1 = bf2f(PROJ[(size_t)t * NP + C_QI + hh * 64 + ii]); qi2 = bf2f(PROJ[(size_t)t * NP + C_QI + hh * 64 + 32 + ii]); }
        float kiv = 0.f, qlv = 0.f;
        if (wave == 4) kiv = bf2f(PROJ[(size_t)t * NP + C_KI + lane]);
        if (wave == 5) { for (int h = 0; h < 8; ++h) qlv = fmaf(bf2f(PROJ[(size_t)t * NP + C_WI + h]), bf2f(PROJ[(size_t)t * NP + C_QI + h * 64 + lane]), qlv); }
        float wiv = 0.f; if (wave == 6 && lane < 8) wiv = bf2f(PROJ[(size_t)t * NP + C_WI + lane]);
        float s1 = wave_sum(acc); if (lane == 0) red[wave] = s1; __syncthreads();
        float mean = 0.f;
#pragma unroll
        for (int w = 0; w < 8; ++w) mean += red[w];
        mean *= (1.f / CC); const float dv = acc - mean; float s2 = wave_sum(dv * dv); if (lane == 0) red[8 + wave] = s2; __syncthreads();
        float var = 0.f;
#pragma unroll
        for (int w = 0; w < 8; ++w) var += red[8 + w];
        var *= (1.f / CC);
        const float y = dv * rsqrtf(var + EPS) * p.conv_ng[c] + p.conv_nb[c];
        MIX[(size_t)t * D + c] = (bf16)f2bf(y * sigmoidf_(y));
        { const float sc = (tid < 256) ? C2 : 1.f; PROJ[(size_t)t * NP + qkbase + hh * 64 + ii] = (bf16)f2bf((x1 * cs - x2 * sn) * sc); PROJ[(size_t)t * NP + qkbase + hh * 64 + 32 + ii] = (bf16)f2bf((x2 * cs + x1 * sn) * sc); }
        if (tid < 256) { PROJ[(size_t)t * NP + C_QI + hh * 64 + ii] = (bf16)f2bf(qi1 * cs - qi2 * sn); PROJ[(size_t)t * NP + C_QI + hh * 64 + 32 + ii] = (bf16)f2bf(qi2 * cs + qi1 * sn); }
        if (wave == 4) { const float m = wave_sum(kiv) * (1.f / 64.f); const float d = kiv - m; const float vr = wave_sum(d * d) * (1.f / 64.f);
            const float yk = d * rsqrtf(vr + EPS) * p.idx_g[lane] + p.idx_b[lane]; const float other = __shfl_xor(yk, 32);
            const float c_ = COS[t * 32 + (lane & 31)], s_ = SIN[t * 32 + (lane & 31)];
            KI[(size_t)t * 64 + lane] = (bf16)f2bf(lane < 32 ? (yk * c_ - other * s_) : (yk * c_ + other * s_)); }
        if (wave == 5) { const float other = __shfl_xor(qlv, 32); const float c_ = COS[t * 32 + (lane & 31)], s_ = SIN[t * 32 + (lane & 31)];
            QL[(size_t)t * 64 + lane] = (bf16)f2bf(lane < 32 ? (qlv * c_ - other * s_) : (qlv * c_ + other * s_)); }
        if (wave == 6 && lane < 8) WI[t * 8 + lane] = wiv;
        __syncthreads();
    }
}

__device__ __forceinline__ unsigned fkey(float f) { unsigned u = __float_as_uint(f); if (u == 0x80000000u) u = 0u; return (u & 0x80000000u) ? ~u : (u | 0x80000000u); }
__device__ __forceinline__ void phase_idx_naive(const Params& p, unsigned char* lds) {
    const int tid = threadIdx.x, lane = tid & 63, wave = tid >> 6;
    const bf16* PROJ = (const bf16*)(p.ws + WS_PROJ); const bf16* KI = (const bf16*)(p.ws + WS_KI); const float* WI = (const float*)(p.ws + WS_WI);
    u64* MASK = (u64*)(p.ws + WS_MASK);
    float* scores = (float*)lds;
    float* qif = (float*)(lds + 65536);
    float* wf = (float*)(lds + 65536 + 2048);
    unsigned* hist = (unsigned*)(lds + 65536 + 4096);
    u64* tiebits = (u64*)(lds + 65536 + 8192);
    int* sh = (int*)(lds + 65536 + 12288);
    for (int t = blockIdx.x; t < S; t += gridDim.x) {
        const int tq = t >> 6, nadm = 64 * (tq + 1), ntw = 4 * (t >> 8) + 4;
        __syncthreads();
        if (nadm <= KSEL) {
            if (tid < ntw) MASK[(size_t)tid * S + t] = (tid <= tq) ? ~0ull : 0ull;
            continue;
        }
        qif[tid] = bf2f(PROJ[(size_t)t * NP + C_QI + tid]); if (tid < 8) wf[tid] = WI[t * 8 + tid];
        __syncthreads();
        for (int s = tid; s < nadm; s += NTHREADS) {
            float kf[64];
#pragma unroll
            for (int j = 0; j < 8; ++j) { const u32x4 v = *(const u32x4*)(KI + (size_t)s * 64 + j * 8);
                kf[j * 8 + 0] = blo(v.x); kf[j * 8 + 1] = bhi(v.x); kf[j * 8 + 2] = blo(v.y); kf[j * 8 + 3] = bhi(v.y); kf[j * 8 + 4] = blo(v.z); kf[j * 8 + 5] = bhi(v.z); kf[j * 8 + 6] = blo(v.w); kf[j * 8 + 7] = bhi(v.w); }
            float I = 0.f;
            for (int h = 0; h < 8; ++h) { float d = 0.f;
#pragma unroll
                for (int k = 0; k < 64; k += 4) { const f32x4 q4 = *(const f32x4*)(qif + h * 64 + k); d = fmaf(q4.x, kf[k], d); d = fmaf(q4.y, kf[k + 1], d); d = fmaf(q4.z, kf[k + 2], d); d = fmaf(q4.w, kf[k + 3], d); }
                I = fmaf(wf[h], fmaxf(d, 0.f), I); }
            scores[s] = I;
        }
        __syncthreads();
        unsigned prefix = 0; int kk = KSEL;
        for (int ps = 0; ps < 4; ++ps) {
            const int shift = 24 - 8 * ps;
            if (tid < 256) hist[tid] = 0u;
            __syncthreads();
            for (int s = tid; s < nadm; s += NTHREADS) { const unsigned key = fkey(scores[s]); if (ps == 0 || (key >> (shift + 8)) == prefix) atomicAdd(&hist[(key >> shift) & 255u], 1u); }
            __syncthreads();
            if (wave == 0) {
                unsigned c4[4]; unsigned tot = 0;
#pragma unroll
                for (int j = 0; j < 4; ++j) { c4[j] = hist[255 - (4 * lane + j)]; tot += c4[j]; }
                unsigned incl = tot;
#pragma unroll
                for (int o = 1; o < 64; o <<= 1) { const unsigned v = __shfl_up(incl, o); if (lane >= o) incl += v; }
                const unsigned excl = incl - tot;
                if (excl < (unsigned)kk && (unsigned)kk <= incl) { const unsigned s0 = excl + c4[0], s1 = s0 + c4[1], s2 = s1 + c4[2]; const unsigned ukk = (unsigned)kk;
                    const int j = ukk <= s0 ? 0 : ukk <= s1 ? 1 : ukk <= s2 ? 2 : 3; const unsigned cum = ukk <= s0 ? excl : ukk <= s1 ? s0 : ukk <= s2 ? s1 : s2;
                    sh[0] = 255 - (4 * lane + j); sh[1] = kk - (int)cum; }
            }
            __syncthreads();
            prefix = (prefix << 8) | (unsigned)sh[0]; kk = sh[1];
            __syncthreads();
        }
        const unsigned T = prefix;
        if (wave == 0) { int run = 0;
            for (int tile = 0; tile <= tq; ++tile) { const bool tie = fkey(scores[tile * 64 + lane]) == T; const u64 bal = __ballot(tie);
                const int rank = run + __popcll(bal & ((1ull << lane) - 1ull)); const u64 tb = __ballot(tie && rank < kk); if (lane == 0) tiebits[tile] = tb; run += __popcll(bal); } }
        __syncthreads();
        for (int tile = wave; tile < ntw; tile += NWAVES) { u64 w = 0ull;
            if (tile <= tq) { w = __ballot(fkey(scores[tile * 64 + lane]) > T) | tiebits[tile]; }
            if (lane == 0) MASK[(size_t)tile * S + t] = w; }
    }
}

__device__ __forceinline__ void phase_att_naive(const Params& p, unsigned char* lds) {
    const int tid = threadIdx.x, lane = tid & 63, wave = tid >> 6;
    const bf16* PROJ = (const bf16*)(p.ws + WS_PROJ); bf16* MIX = (bf16*)(p.ws + WS_MIX); const u64* MASK = (const u64*)(p.ws + WS_MASK);
    int* sidx = (int*)(lds + wave * 2048); float* slog = (float*)(lds + wave * 2048 + 1024);
    const int h = wave;
    for (int t = blockIdx.x; t < S; t += gridDim.x) {
        const int tq = t >> 6;
        float qf[64];
#pragma unroll
        for (int j = 0; j < 8; ++j) { const u32x4 v = *(const u32x4*)(PROJ + (size_t)t * NP + C_Q + h * 64 + j * 8);
            qf[j * 8 + 0] = blo(v.x); qf[j * 8 + 1] = bhi(v.x); qf[j * 8 + 2] = blo(v.y); qf[j * 8 + 3] = bhi(v.y); qf[j * 8 + 4] = blo(v.z); qf[j * 8 + 5] = bhi(v.z); qf[j * 8 + 6] = blo(v.w); qf[j * 8 + 7] = bhi(v.w); }
        int n = 0;
        for (int tile = 0; tile <= tq; ++tile) {
            const u64 w = MASK[(size_t)tile * S + t]; const bool sel = (w >> lane) & 1ull;
            if (w == 0ull) continue;
            float lg = 0.f; const int s = tile * 64 + lane;
            if (sel) {
#pragma unroll
                for (int j = 0; j < 8; ++j) { const u32x4 v = *(const u32x4*)(PROJ + (size_t)s * NP + C_K + h * 64 + j * 8);
                    lg = fmaf(qf[j * 8 + 0], blo(v.x), lg); lg = fmaf(qf[j * 8 + 1], bhi(v.x), lg); lg = fmaf(qf[j * 8 + 2], blo(v.y), lg); lg = fmaf(qf[j * 8 + 3], bhi(v.y), lg);
                    lg = fmaf(qf[j * 8 + 4], blo(v.z), lg); lg = fmaf(qf[j * 8 + 5], bhi(v.z), lg); lg = fmaf(qf[j * 8 + 6], blo(v.w), lg); lg = fmaf(qf[j * 8 + 7], bhi(v.w), lg); }
                const int pos = n + __popcll(w & ((1ull << lane) - 1ull));
                if (pos < 256) { sidx[pos] = s; slog[pos] = lg; }
            }
            n += __popcll(w);
        }
        if (n > 256) n = 256;
        __builtin_amdgcn_s_waitcnt(0); asm volatile("" ::: "memory");
        float m = -INFINITY; for (int j = lane; j < n; j += 64) m = fmaxf(m, slog[j]);
        m = wave_max(m);
        float l = 0.f; for (int j = lane; j < n; j += 64) { const float pj = exp2f(slog[j] - m); slog[j] = pj; l += pj; }
        l = wave_sum(l);
        __builtin_amdgcn_s_waitcnt(0); asm volatile("" ::: "memory");
        float o = 0.f;
        for (int j = 0; j < n; ++j) o = fmaf(slog[j], bf2f(PROJ[(size_t)sidx[j] * NP + C_V + h * 64 + lane]), o);
        MIX[(size_t)t * D + 512 + h * 64 + lane] = (bf16)f2bf(o / l);
        __builtin_amdgcn_s_waitcnt(0); asm volatile("" ::: "memory");
    }
}

__device__ __forceinline__ void phase_route_naive(const Params& p, unsigned char* lds) {
    const int tid = threadIdx.x, lane = tid & 63, wave = tid >> 6;
    const int gw = blockIdx.x * NWAVES + wave, NGW = gridDim.x * NWAVES;
    const float* H2 = (const float*)(p.ws + WS_H2); const float* WGRT = (const float*)(p.ws + WS_WGRT);
    float* RSTD = (float*)(p.ws + WS_RSTD); int* TOKOF = (int*)(p.ws + WS_TOKOF); float* GATEOF = (float*)(p.ws + WS_GATEOF); int* PAIR = (int*)(p.ws + WS_PAIR);
    unsigned* CNT = (unsigned*)(p.ws + WS_CTL) + CW_CNT;
    for (int t = gw; t < S; t += NGW) {
        const f32x4* hr = (const f32x4*)(H2 + (size_t)t * D) + lane; f32x4 v[4]; float ss = 0.f;
#pragma unroll
        for (int j = 0; j < 4; ++j) { v[j] = hr[64 * j]; ss += v[j].x * v[j].x + v[j].y * v[j].y + v[j].z * v[j].z + v[j].w * v[j].w; }
        const float rstd = rsqrtf(wave_sum(ss) * (1.f / D) + EPS);
        float mine = -INFINITY;
        for (int e = 0; e < NE; ++e) { const f32x4* wr = (const f32x4*)(WGRT + (size_t)e * D) + lane; float a = 0.f;
#pragma unroll
            for (int j = 0; j < 4; ++j) { const f32x4 w = wr[64 * j]; a = fmaf(v[j].x, w.x, a); a = fmaf(v[j].y, w.y, a); a = fmaf(v[j].z, w.z, a); a = fmaf(v[j].w, w.w, a); }
            a = wave_sum(a); if (lane == e) mine = a * rstd + p.b_router[e]; }
        float tv[4]; int te[4];
#pragma unroll
        for (int k = 0; k < 4; ++k) { float bv = mine; int bi = lane;
#pragma unroll
            for (int o = 32; o >= 1; o >>= 1) { const float ov = __shfl_xor(bv, o); const int oi = __shfl_xor(bi, o); if (ov > bv || (ov == bv && oi < bi)) { bv = ov; bi = oi; } }
            tv[k] = bv; te[k] = bi; if (lane == bi) mine = -INFINITY; }
        float g[4], gs = 0.f;
#pragma unroll
        for (int k = 0; k < 4; ++k) { g[k] = __expf(tv[k] - tv[0]); gs += g[k]; }
        if (lane == 0) RSTD[t] = rstd;
        if (lane < 4) { const int e = lane == 0 ? te[0] : lane == 1 ? te[1] : lane == 2 ? te[2] : te[3]; const float gg = (lane == 0 ? g[0] : lane == 1 ? g[1] : lane == 2 ? g[2] : g[3]) / gs;
            const unsigned slot = atomicAdd(&CNT[e], 1u); TOKOF[e * S + slot] = t; GATEOF[e * S + slot] = gg; PAIR[t * 4 + lane] = (e << 16) | (int)slot; }
    }
}

__device__ __forceinline__ int build_tiles(const Params& p, unsigned char* lds) {
    int* pst = (int*)(lds + LDS_MISC); int* tile_e = pst + 40;
    const unsigned* CNT = (const unsigned*)(p.ws + WS_CTL) + CW_CNT;
    __syncthreads();
    if (threadIdx.x == 0) { int acc = 0; for (int e = 0; e < NE; ++e) { pst[e] = acc; const int nt = ((int)__hip_atomic_load(&CNT[e], __ATOMIC_RELAXED, __HIP_MEMORY_SCOPE_AGENT) + 255) >> 8; for (int i = 0; i < nt; ++i) tile_e[acc + i] = e; acc += nt; } pst[NE] = acc; }
    __syncthreads();
    return pst[NE];
}

__device__ __forceinline__ void phase_gather(const Params& p, unsigned char* lds) {
    const int tid = threadIdx.x, lane = tid & 63, wave = tid >> 6;
    const int gw = blockIdx.x * NWAVES + wave, NGW = gridDim.x * NWAVES;
    build_tiles(p, lds); const int* pst = (const int*)(lds + LDS_MISC);
    const bf16* XN2 = (const bf16*)(p.ws + WS_XN); bf16* XS = (bf16*)(p.ws + WS_XS); const int* PAIR = (const int*)(p.ws + WS_PAIR);
    const float* RSTD = (const float*)(p.ws + WS_RSTD); const float* GATEOF = (const float*)(p.ws + WS_GATEOF);
    float* ROWRSTD = (float*)(p.ws + WS_ROWRSTD); float* ROWGATE = (float*)(p.ws + WS_ROWGATE);
    for (int pr = gw; pr < S * 4; pr += NGW) { const int t = pr >> 2; const int pe = PAIR[pr]; const int e = pe >> 16, slot = pe & 0xffff; const int row = pst[e] * 256 + slot;
        const u32x4* src = (const u32x4*)(XN2 + (size_t)t * D); u32x4* dst = (u32x4*)(XS + (size_t)row * D);
        dst[lane] = src[lane]; dst[lane + 64] = src[lane + 64];
        if (lane == 0) { ROWRSTD[row] = RSTD[t]; ROWGATE[row] = GATEOF[e * S + slot]; } }
}

__device__ __forceinline__ void phase_final(const Params& p, unsigned char* lds) {
    const int tid = threadIdx.x, lane = tid & 63, wave = tid >> 6;
    const int gw = blockIdx.x * NWAVES + wave, NGW = gridDim.x * NWAVES;
    build_tiles(p, lds); const int* pst = (const int*)(lds + LDS_MISC);
    const float* H2 = (const float*)(p.ws + WS_H2); const bf16* YS = (const bf16*)(p.ws + WS_YS); const int* PAIR = (const int*)(p.ws + WS_PAIR);
    for (int t = gw; t < S; t += NGW) {
        const f32x4* hr = (const f32x4*)(H2 + (size_t)t * D) + lane; f32x4 v[4];
#pragma unroll
        for (int j = 0; j < 4; ++j) v[j] = hr[64 * j];
#pragma unroll
        for (int k = 0; k < 4; ++k) { const int pe = PAIR[t * 4 + k]; const int row = pst[pe >> 16] * 256 + (pe & 0xffff); const uint2* yr = (const uint2*)(YS + (size_t)row * D) + lane;
#pragma unroll
            for (int j = 0; j < 4; ++j) { const uint2 y = yr[64 * j]; v[j].x += blo(y.x); v[j].y += bhi(y.x); v[j].z += blo(y.y); v[j].w += bhi(y.y); } }
        float ss = 0.f;
#pragma unroll
        for (int j = 0; j < 4; ++j) ss += v[j].x * v[j].x + v[j].y * v[j].y + v[j].z * v[j].z + v[j].w * v[j].w;
        const float rstd = rsqrtf(wave_sum(ss) * (1.f / D) + EPS);
        f32x4* o = (f32x4*)(p.out + (size_t)t * D) + lane;
#pragma unroll
        for (int j = 0; j < 4; ++j) { const f32x4 g = ((const f32x4*)p.norm_final_g)[lane + 64 * j]; o[64 * j] = (f32x4){v[j].x * rstd * g.x, v[j].y * rstd * g.y, v[j].z * rstd * g.z, v[j].w * rstd * g.w}; }
    }
}

__global__ void __launch_bounds__(NTHREADS, 2) fwd_kernel(Params p) {
    extern __shared__ __attribute__((aligned(16))) unsigned char lds[];
    cg::grid_group grid = cg::this_grid();
    const int G = gridDim.x, bx = blockIdx.x;
    phase_prologue(p, lds);
    grid.sync();
    { const bf16* XN = (const bf16*)(p.ws + WS_XN); const bf16* WinT = (const bf16*)(p.ws + WS_WINT);
        for (int u = bx; u < 64 * 13; u += G) { const int pm = u / 13, pn = u % 13; EpiProj E{(bf16*)(p.ws + WS_PROJ), pm, pn};
            ngemm_unit(lds, XN + (size_t)pm * 256 * D, D, WinT + (size_t)pn * 256 * D, D, D, E); } }
    grid.sync();
    phase_ew_naive(p, lds);
    grid.sync();
    phase_idx_naive(p, lds);
    grid.sync();
    phase_att_naive(p, lds);
    grid.sync();
    { const bf16* MIX = (const bf16*)(p.ws + WS_MIX); const bf16* WoutT = (const bf16*)(p.ws + WS_WOUTT);
        for (int u = bx; u < 64 * 4; u += G) { const int pm = u / 4, pn = u % 4; EpiOut E{p.x, p.norm_ffn_g, (float*)(p.ws + WS_H2), (bf16*)(p.ws + WS_XN), pm, pn};
            ngemm_unit(lds, MIX + (size_t)pm * 256 * D, D, WoutT + (size_t)pn * 256 * D, D, D, E); } }
    grid.sync();
    phase_route_naive(p, lds);
    grid.sync();
    phase_gather(p, lds);
    grid.sync();
    { const int ntile = build_tiles(p, lds); const int* tile_e = (const int*)(lds + LDS_MISC) + 40;
        const bf16* XS = (const bf16*)(p.ws + WS_XS); const bf16* WguT = (const bf16*)(p.ws + WS_WGUT);
        for (int u = bx; u < ntile * 8; u += G) { const int pt = u >> 3, pnl = u & 7, e = tile_e[pt];
            EpiGU E{p.b_gu, (const float*)(p.ws + WS_ROWRSTD), (bf16*)(p.ws + WS_HDN), pt, e, pnl};
            ngemm_unit(lds, XS + (size_t)pt * 256 * D, D, WguT + ((size_t)e * 2048 + pnl * 256) * D, D, D, E); } }
    grid.sync();
    { const int ntile = build_tiles(p, lds); const int* tile_e = (const int*)(lds + LDS_MISC) + 40;
        const bf16* HDN = (const bf16*)(p.ws + WS_HDN); const bf16* WdT = (const bf16*)(p.ws + WS_WDT);
        for (int u = bx; u < ntile * 4; u += G) { const int pt = u >> 2, pnl = u & 3, e = tile_e[pt];
            EpiDown E{p.b_down, (const float*)(p.ws + WS_ROWGATE), (bf16*)(p.ws + WS_YS), pt, e, pnl};
            ngemm_unit(lds, HDN + (size_t)pt * 256 * DE, DE, WdT + ((size_t)e * D + pnl * 256) * DE, DE, DE, E); } }
    grid.sync();
    phase_final(p, lds);
}

extern "C" void kernel_launch(void* const* d_in, const int* in_sizes, int n_in, void* d_out, int out_size, void* d_ws, size_t ws_size, hipStream_t stream) {
    static int grid = 0;
    if (grid == 0) {
        if (n_in != 19 || out_size != S * D || ws_size < WS_END) { fprintf(stderr, "kernel_launch: unexpected shapes (n_in %d out %d ws %zu)\n", n_in, out_size, ws_size); grid = -1; return; }
        int dev = 0, cus = 0, per_cu = 0;
        (void)hipGetDevice(&dev); (void)hipDeviceGetAttribute(&cus, hipDeviceAttributeMultiprocessorCount, dev);
        if (hipFuncSetAttribute((const void*)fwd_kernel, hipFuncAttributeMaxDynamicSharedMemorySize, LDS_BYTES) != hipSuccess) { fprintf(stderr, "kernel_launch: hipFuncSetAttribute failed\n"); grid = -1; return; }
        if (hipOccupancyMaxActiveBlocksPerMultiprocessor(&per_cu, (const void*)fwd_kernel, NTHREADS, LDS_BYTES) != hipSuccess || per_cu < 1) { fprintf(stderr, "kernel_launch: occupancy query says %d\n", per_cu); per_cu = 1; }
        (void)hipGetLastError();
        grid = cus * 1;
    }
    if (grid < 0) return;
    (void)hipMemsetAsync((char*)d_ws + WS_CTL, 0, CTL_BYTES, stream);
    Params p{};
    p.x = (const float*)d_in[0]; p.pos = (const int*)d_in[1]; p.norm_mix_g = (const float*)d_in[2]; p.w_in = (const float*)d_in[3]; p.idx_g = (const float*)d_in[4]; p.idx_b = (const float*)d_in[5];
    p.conv_w = (const float*)d_in[6]; p.conv_b = (const float*)d_in[7]; p.conv_ng = (const float*)d_in[8]; p.conv_nb = (const float*)d_in[9]; p.w_out = (const float*)d_in[10]; p.norm_ffn_g = (const float*)d_in[11];
    p.w_router = (const float*)d_in[12]; p.b_router = (const float*)d_in[13]; p.w_gu = (const float*)d_in[14]; p.b_gu = (const float*)d_in[15]; p.w_down = (const float*)d_in[16]; p.b_down = (const float*)d_in[17];
    p.norm_final_g = (const float*)d_in[18]; p.out = (float*)d_out; p.ws = (unsigned char*)d_ws;
    void* args[] = {&p};
    hipError_t e = hipLaunchCooperativeKernel((const void*)fwd_kernel, dim3(grid), dim3(NTHREADS), args, LDS_BYTES, stream);
    if (e != hipSuccess) fprintf(stderr, "cooperative launch failed: %s (grid %d)\n", hipGetErrorString(e), grid);
}
```

```cpp
#include <hip/hip_runtime.h>
#include <hip/hip_cooperative_groups.h>
#include <cstdio>
#include <cstdint>
namespace cg = cooperative_groups;

constexpr int S = 16384, D = 1024, NIN = 3144, NP = 3328;
constexpr int CC = 512, CW = 31, NH = 8, HD = 64, NE = 32, DE = 1024;
constexpr int C_VAL = 0, C_GATE = 512, C_Q = 1024, C_K = 1536, C_V = 2048, C_QI = 2560, C_KI = 3072, C_WI = 3136;
constexpr int KSEL = 256;
constexpr float EPS = 1e-5f;
constexpr float C2 = 0.125f * 1.4426950408889634f;
constexpr int NTHREADS = 512, NWAVES = 8;
constexpr int MAXROWS = 65536 + NE * 256;
constexpr int MAXTILES = MAXROWS / 256;

constexpr size_t MiB = 1u << 20;
constexpr size_t WS_CTL = 0, CTL_BYTES = 1 * MiB;
constexpr size_t WS_WINT = 2 * MiB;
constexpr size_t WS_WOUTT = 9 * MiB;
constexpr size_t WS_WGRT = 11 * MiB;
constexpr size_t WS_COS = 12 * MiB;
constexpr size_t WS_SIN = 14 * MiB;
constexpr size_t WS_WGUT = 16 * MiB;
constexpr size_t WS_WDT = 144 * MiB;
constexpr size_t WS_XN = 208 * MiB;
constexpr size_t WS_PROJ = 240 * MiB;
constexpr size_t WS_MIX = 344 * MiB;
constexpr size_t WS_KI = 376 * MiB;
constexpr size_t WS_QL = 378 * MiB;
constexpr size_t WS_WI = 380 * MiB;
constexpr size_t WS_RSTD = 381 * MiB;
constexpr size_t WS_TOKOF = 382 * MiB;
constexpr size_t WS_GATEOF = 384 * MiB;
constexpr size_t WS_PAIR = 386 * MiB;
constexpr size_t WS_ROWRSTD = 387 * MiB;
constexpr size_t WS_ROWGATE = 388 * MiB;
constexpr size_t WS_MASK = 392 * MiB;
constexpr size_t WS_H2 = 424 * MiB;
constexpr size_t WS_XS = 488 * MiB;
constexpr size_t WS_HDN = 632 * MiB;
constexpr size_t WS_YS = 776 * MiB;
constexpr size_t WS_END = 920 * MiB;
constexpr int CW_CNT = 1024;

constexpr int LDS_BYTES = 147456;
constexpr int LDS_MISC = 131072;

#define LAS __attribute__((address_space(3)))
typedef unsigned short bf16;
typedef unsigned long long u64;
typedef float f32x4 __attribute__((ext_vector_type(4)));
typedef unsigned u32x4 __attribute__((ext_vector_type(4)));

__device__ __forceinline__ float bf2f(unsigned v) { return __uint_as_float(v << 16); }
__device__ __forceinline__ unsigned f2bf(float f) { unsigned u = __float_as_uint(f); return (u + 0x7fffu + ((u >> 16) & 1u)) >> 16; }
__device__ __forceinline__ unsigned pk2(float lo, float hi) { return f2bf(lo) | (f2bf(hi) << 16); }
__device__ __forceinline__ float blo(unsigned w) { return __uint_as_float(w << 16); }
__device__ __forceinline__ float bhi(unsigned w) { return __uint_as_float(w & 0xffff0000u); }
__device__ __forceinline__ float wave_sum(float v) {
#pragma unroll
    for (int o = 1; o < 64; o <<= 1) v += __shfl_xor(v, o);
    return v;
}
__device__ __forceinline__ float wave_max(float v) {
#pragma unroll
    for (int o = 1; o < 64; o <<= 1) v = fmaxf(v, __shfl_xor(v, o));
    return v;
}
__device__ __forceinline__ float sigmoidf_(float x) { return 1.f / (1.f + __expf(-x)); }

struct Params {
    const float* x; const int* pos; const float* norm_mix_g; const float* w_in; const float* idx_g; const float* idx_b;
    const float* conv_w; const float* conv_b; const float* conv_ng; const float* conv_nb; const float* w_out; const float* norm_ffn_g;
    const float* w_router; const float* b_router; const float* w_gu; const float* b_gu; const float* w_down; const float* b_down;
    const float* norm_final_g; float* out; unsigned char* ws;
};

__device__ __forceinline__ void transpose_item(const float* W, int K, int N, bf16* WT, int dst_row0, int k0, int n0, float* scr, int lane) {
#pragma unroll 8
    for (int i = 0; i < 32; ++i) { const int kk = 2 * i + (lane >> 5); const int n = n0 + (lane & 31);
        scr[kk * 33 + (lane & 31)] = (n < N) ? W[(size_t)(k0 + kk) * N + n] : 0.f; }
    __builtin_amdgcn_s_waitcnt(0); asm volatile("" ::: "memory");
    const int c = lane & 7;
#pragma unroll
    for (int j = 0; j < 4; ++j) { const int n = (lane >> 3) + 8 * j; const float* s = scr + (8 * c) * 33 + n;
        u32x4 o; o.x = pk2(s[0 * 33], s[1 * 33]); o.y = pk2(s[2 * 33], s[3 * 33]); o.z = pk2(s[4 * 33], s[5 * 33]); o.w = pk2(s[6 * 33], s[7 * 33]);
        *(u32x4*)(WT + (size_t)(dst_row0 + n) * K + k0 + 8 * c) = o; }
    __builtin_amdgcn_s_waitcnt(0); asm volatile("" ::: "memory");
}

__device__ __forceinline__ void phase_prologue(const Params& p, unsigned char* lds) {
    const int tid = threadIdx.x, lane = tid & 63, wave = tid >> 6;
    const int gw = blockIdx.x * NWAVES + wave, NGW = gridDim.x * NWAVES;
    float* scr = (float*)(lds + wave * 16384);
    bf16* WinT = (bf16*)(p.ws + WS_WINT); bf16* WoutT = (bf16*)(p.ws + WS_WOUTT); bf16* WguT = (bf16*)(p.ws + WS_WGUT); bf16* WdT = (bf16*)(p.ws + WS_WDT);
    constexpr int I_IN = 16 * (NP / 32), I_OUT = 16 * 32, I_GU = 16 * 64, I_DN = 16 * 32;
    constexpr int NITEMS = I_IN + I_OUT + NE * I_GU + NE * I_DN;
    for (int it = gw; it < NITEMS; it += NGW) {
        int r = it;
        if (r < I_IN) { const int nb = r % (NP / 32), kb = r / (NP / 32); transpose_item(p.w_in, D, NIN, WinT, nb * 32, kb * 64, nb * 32, scr, lane); continue; }
        r -= I_IN;
        if (r < I_OUT) { const int nb = r % 32, kb = r / 32; transpose_item(p.w_out, D, D, WoutT, nb * 32, kb * 64, nb * 32, scr, lane); continue; }
        r -= I_OUT;
        if (r < NE * I_GU) { const int e = r / I_GU, q = r % I_GU, nb = q % 64, kb = q / 64; const int n0 = nb * 32;
            const int c = n0 & 1023, isu = n0 >> 10; const int drow = e * 2048 + (c >> 7) * 256 + isu * 128 + (c & 127);
            transpose_item(p.w_gu + (size_t)e * D * 2048, D, 2048, WguT, drow - 0, kb * 64, n0, scr, lane);
            continue; }
        r -= NE * I_GU;
        { const int e = r / I_DN, q = r % I_DN, nb = q % 32, kb = q / 32;
            transpose_item(p.w_down + (size_t)e * DE * D, DE, D, WdT, e * D + nb * 32, kb * 64, nb * 32, scr, lane); }
    }
    for (int i = blockIdx.x * NTHREADS + tid; i < NE * D; i += gridDim.x * NTHREADS) { const int e = i / D, k = i % D; ((float*)(p.ws + WS_WGRT))[i] = p.norm_ffn_g[k] * p.w_router[k * NE + e]; }
    for (int i = blockIdx.x * NTHREADS + tid; i < S * 32; i += gridDim.x * NTHREADS) { const int t = i >> 5, j = i & 31;
        const float inv = powf(10000.f, -(float)j / 32.f); const float ang = (float)p.pos[t] * inv;
        double xr = (double)ang * 0.15915494309189535; xr -= floor(xr); const float xf = (float)xr;
        ((float*)(p.ws + WS_COS))[i] = __builtin_amdgcn_cosf(xf); ((float*)(p.ws + WS_SIN))[i] = __builtin_amdgcn_sinf(xf); }
    bf16* XN = (bf16*)(p.ws + WS_XN);
    for (int m = gw; m < S; m += NGW) {
        const f32x4* xr = (const f32x4*)(p.x + (size_t)m * D) + lane; f32x4 v[4]; float ss = 0.f;
#pragma unroll
        for (int j = 0; j < 4; ++j) { v[j] = xr[64 * j]; ss += v[j].x * v[j].x + v[j].y * v[j].y + v[j].z * v[j].z + v[j].w * v[j].w; }
        const float rstd = rsqrtf(wave_sum(ss) * (1.f / D) + EPS);
        u64* o8 = (u64*)(XN + (size_t)m * D) + lane;
#pragma unroll
        for (int j = 0; j < 4; ++j) { const f32x4 g = ((const f32x4*)p.norm_mix_g)[lane + 64 * j];
            o8[64 * j] = (u64)pk2(v[j].x * rstd * g.x, v[j].y * rstd * g.y) | ((u64)pk2(v[j].z * rstd * g.z, v[j].w * rstd * g.w) << 32); }
    }
}

namespace pg8 {
#define PG8_LAS __attribute__((address_space(3)))
typedef unsigned short bf16_t;
typedef short bf16x8 __attribute__((ext_vector_type(8)));
typedef float f32x4 __attribute__((ext_vector_type(4)));
typedef unsigned u32x4 __attribute__((ext_vector_type(4)));
constexpr int BM = 256, BK = 64, HALF = 128, HTB = HALF * BK * 2  , STAGE_BYTES = 8 * HTB, NXCD = 8, WGM = 8;

__host__ __device__ __forceinline__ int lds_byte(int r, int c) { const int st = (r >> 4) * 2 + (c >> 5), rr = r & 15, cc = c & 31, ob = rr * 64 + cc * 2; return st * 1024 + (ob ^ (((ob >> 9) & 1) << 5)); }
__host__ __device__ __forceinline__ void stage_rc(int b, int& R, int& C) { const int st = b / 1024, sb = b % 1024, swz = sb ^ (((sb >> 9) & 1) << 5); R = (st >> 1) * 16 + swz / 64; C = (st & 1) * 32 + (swz % 64) / 2; }
__host__ __device__ __forceinline__ int perm32(int rho) { const int n = rho >> 4, i = rho & 15; return 8 * (i >> 2) + 4 * n + (i & 3); }

struct Unit { int pm, pn; };
struct Gemm { const bf16_t* A; const bf16_t* Bt; int M, N, K; };

struct StaticOrder {
    int nM, nN, nwg, G, c;
    __host__ __device__ void init(int M, int N, int G_, int c_) { nM = M / BM; nN = N / BM; nwg = nM * nN; G = G_; c = c_; }
    __host__ __device__ bool next(int i, Unit& u) const {
        const long L = (long)i * G + c; if (L >= nwg) return false;
        int wgid = (int)L; { const int q = nwg / NXCD, r = nwg % NXCD, xcd = wgid % NXCD, off = wgid / NXCD; wgid = (xcd < r ? xcd * (q + 1) : r * (q + 1) + (xcd - r) * q) + off; }
        const int nig = WGM * nN, gid = wgid / nig, fm = gid * WGM, gsz = (nM - fm) < WGM ? (nM - fm) : WGM;
        u.pm = fm + ((wgid % nig) % gsz); u.pn = (wgid % nig) / gsz; return true;
    }
    __device__ __forceinline__ int bidx(const Unit& u) const { return u.pn; }
    __device__ __forceinline__ void a_ready(const Unit&) const {}
    __device__ __forceinline__ void done(const Unit&) const {}
};
template <class Epi, class Sched, bool ALIGN_EPI = false, bool SP2 = false>
__device__ __forceinline__ void gemm_phase(PG8_LAS unsigned char* lds, const Gemm g, const Sched& S, const Epi& E) {
    const int tid = threadIdx.x, wid = __builtin_amdgcn_readfirstlane(tid >> 6), lane = tid & 63, wr = wid >> 2, wc = wid & 3, fr = lane & 15, fq = lane >> 4;
    const int K = g.K, nt = K / BK;
    unsigned voffA[2], voffB[2];
#pragma unroll
    for (int i = 0; i < 2; ++i) { int R, C; stage_rc(tid * 16 + i * 8192, R, C); const int Rb = Epi::PERM ? ((R & ~31) + perm32(R & 31)) : R;
        voffA[i] = (unsigned)(R * K + C) * 2u; voffB[i] = (unsigned)(Rb * K + C) * 2u; }
    const size_t kstep = (size_t)(BK * 2);
    const size_t hstep = (size_t)HALF * K * 2;
    const size_t tstep = 2 * hstep;
    const unsigned ldsw = (unsigned)wid * 1024u;
    const int aoff = lds_byte(wr * 64 + fr, fq * 8), boff = lds_byte(wc * 32 + fr, fq * 8);
#define PG8_SA(b, h) (((b) * 2 + (h)) * HTB)
#define PG8_SB(b, h) ((4 + (b) * 2 + (h)) * HTB)
#define PG8_STAGE(bufoff, gbase, voff) do { _Pragma("unroll") for (int _i = 0; _i < 2; ++_i) \
        __builtin_amdgcn_global_load_lds((const unsigned*)((const char*)(gbase) + (voff)[_i]), (PG8_LAS unsigned*)(lds + (bufoff) + ldsw + _i * 8192), 16, 0, 0); } while (0)
#define PG8_LDA(dst, b, h) do { _Pragma("unroll") for (int m = 0; m < 4; ++m) _Pragma("unroll") for (int k = 0; k < 2; ++k) dst[m][k] = *(const PG8_LAS bf16x8*)(lds + PG8_SA(b, h) + aoff + m * 2048 + k * 1024); } while (0)
#define PG8_LDB(dst, b, h) do { _Pragma("unroll") for (int n = 0; n < 2; ++n) _Pragma("unroll") for (int k = 0; k < 2; ++k) dst[n][k] = *(const PG8_LAS bf16x8*)(lds + PG8_SB(b, h) + boff + n * 2048 + k * 1024); } while (0)
#define PG8_MMA(ai, bj, At, Bt) do { __builtin_amdgcn_s_setprio(1); _Pragma("unroll") for (int m = 0; m < 4; ++m) _Pragma("unroll") for (int n = 0; n < 2; ++n) _Pragma("unroll") for (int k = 0; k < 2; ++k) \
        acc[ai][bj][m][n] = __builtin_amdgcn_mfma_f32_16x16x32_bf16(Bt[n][k], At[m][k], acc[ai][bj][m][n], 0, 0, 0); __builtin_amdgcn_s_setprio(0); } while (0)
#define PG8_WAIT_V(n) asm volatile("s_waitcnt vmcnt(" #n ")" ::: "memory")
#define PG8_WAIT_L(n) asm volatile("s_waitcnt lgkmcnt(" #n ")" ::: "memory")
#define PG8_BAR __builtin_amdgcn_s_barrier()
#define PG8_SCHED __builtin_amdgcn_sched_barrier(0)
    Unit cur, nxt; int ui = 0;
    if (!S.next(0, cur)) return;
    f32x4 acc[2][2][4][2];
#pragma unroll
    for (int a = 0; a < 2; ++a)
#pragma unroll
        for (int b = 0; b < 2; ++b)
#pragma unroll
            for (int m = 0; m < 4; ++m)
#pragma unroll
                for (int n = 0; n < 2; ++n) acc[a][b][m][n] = (f32x4){0.f, 0.f, 0.f, 0.f};
    bf16x8 At[4][2], B0[2][2], B1[2][2];
    const char* cA = (const char*)g.A + (size_t)cur.pm * tstep; const char* cB = (const char*)g.Bt + (size_t)S.bidx(cur) * tstep;
    S.a_ready(cur);
    if constexpr (SP2) {
        PG8_STAGE(PG8_SB(0, 0), cB, voffB); PG8_STAGE(PG8_SB(0, 1), cB + hstep, voffB); PG8_STAGE(PG8_SA(0, 0), cA, voffA); PG8_STAGE(PG8_SA(0, 1), cA + hstep, voffA);
        if (wr == 1) PG8_BAR;
        PG8_WAIT_V(2); PG8_BAR;
        PG8_STAGE(PG8_SB(1, 0), cB + kstep, voffB); PG8_STAGE(PG8_SA(1, 0), cA + kstep, voffA); PG8_STAGE(PG8_SB(1, 1), cB + hstep + kstep, voffB);
        PG8_WAIT_V(6); PG8_BAR;
    } else {
        PG8_STAGE(PG8_SB(0, 0), cB, voffB); PG8_STAGE(PG8_SA(0, 0), cA, voffA); PG8_STAGE(PG8_SB(0, 1), cB + hstep, voffB); PG8_STAGE(PG8_SA(0, 1), cA + hstep, voffA);
        if (wr == 1) PG8_BAR;
        PG8_WAIT_V(4); PG8_BAR;
        PG8_STAGE(PG8_SB(1, 0), cB + kstep, voffB); PG8_STAGE(PG8_SA(1, 0), cA + kstep, voffA); PG8_STAGE(PG8_SB(1, 1), cB + hstep + kstep, voffB);
        PG8_WAIT_V(6); PG8_BAR;
    }
    for (;;) {
        const bool has_next = S.next(ui + 1, nxt);
        const char* nA = has_next ? (const char*)g.A + (size_t)nxt.pm * tstep : cA; const char* nB = has_next ? (const char*)g.Bt + (size_t)S.bidx(nxt) * tstep : cB;
        for (int t = 0; t < nt; t += 2) {
            const bool last = (t == nt - 2);
            const char* a1 = cA + (size_t)(t + 1) * kstep;
            const char* a2 = last ? nA : cA + (size_t)(t + 2) * kstep; const char* b2 = last ? nB : cB + (size_t)(t + 2) * kstep;
            const char* a3 = a2 + kstep; const char* b3 = b2 + kstep;
            if (last && has_next) S.a_ready(nxt);
            if constexpr (SP2) {
            PG8_LDB(B0, 0, 0); PG8_LDB(B1, 0, 1); PG8_SCHED; PG8_LDA(At, 0, 0); PG8_STAGE(PG8_SA(1, 1), a1 + hstep, voffA);
            PG8_WAIT_V(8); PG8_WAIT_L(0); PG8_BAR; PG8_MMA(0, 0, At, B0); PG8_MMA(0, 1, At, B1); PG8_BAR; PG8_SCHED;
            PG8_LDA(At, 0, 1); PG8_STAGE(PG8_SB(0, 0), b2, voffB); PG8_STAGE(PG8_SB(0, 1), b2 + hstep, voffB); PG8_STAGE(PG8_SA(0, 0), a2, voffA);
            PG8_WAIT_V(8); PG8_WAIT_L(0); PG8_BAR; PG8_MMA(1, 0, At, B0); PG8_MMA(1, 1, At, B1); PG8_BAR; PG8_SCHED;
            PG8_LDB(B0, 1, 0); PG8_LDB(B1, 1, 1); PG8_SCHED; PG8_LDA(At, 1, 0); PG8_STAGE(PG8_SA(0, 1), a2 + hstep, voffA);
            PG8_WAIT_V(8); PG8_WAIT_L(0); PG8_BAR; PG8_MMA(0, 0, At, B0); PG8_MMA(0, 1, At, B1); PG8_BAR; PG8_SCHED;
            PG8_LDA(At, 1, 1); PG8_STAGE(PG8_SB(1, 0), b3, voffB); PG8_STAGE(PG8_SB(1, 1), b3 + hstep, voffB); PG8_STAGE(PG8_SA(1, 0), a3, voffA);
            PG8_WAIT_V(8); PG8_WAIT_L(0); PG8_BAR; PG8_MMA(1, 0, At, B0); PG8_MMA(1, 1, At, B1); PG8_BAR; PG8_SCHED;
            } else {
            PG8_LDB(B0, 0, 0); PG8_SCHED; PG8_LDA(At, 0, 0); PG8_STAGE(PG8_SA(1, 1), a1 + hstep, voffA);
            PG8_WAIT_L(8); PG8_BAR; PG8_WAIT_L(0); PG8_MMA(0, 0, At, B0); PG8_BAR; PG8_SCHED;
            PG8_LDB(B1, 0, 1); PG8_STAGE(PG8_SB(0, 0), b2, voffB);
            PG8_BAR; PG8_WAIT_L(0); PG8_MMA(0, 1, At, B1); PG8_BAR;
            PG8_LDA(At, 0, 1); PG8_STAGE(PG8_SA(0, 0), a2, voffA);
            PG8_BAR; PG8_WAIT_L(0); PG8_MMA(1, 0, At, B0); PG8_BAR; PG8_SCHED;
            PG8_STAGE(PG8_SB(0, 1), b2 + hstep, voffB);
            PG8_WAIT_V(6); PG8_BAR; PG8_MMA(1, 1, At, B1); PG8_BAR;
            PG8_LDB(B0, 1, 0); PG8_SCHED; PG8_LDA(At, 1, 0); PG8_STAGE(PG8_SA(0, 1), a2 + hstep, voffA);
            PG8_WAIT_L(8); PG8_BAR; PG8_WAIT_L(0); PG8_MMA(0, 0, At, B0); PG8_BAR; PG8_SCHED;
            PG8_LDB(B1, 1, 1); PG8_STAGE(PG8_SB(1, 0), b3, voffB);
            PG8_BAR; PG8_WAIT_L(0); PG8_MMA(0, 1, At, B1); PG8_BAR;
            PG8_LDA(At, 1, 1); PG8_STAGE(PG8_SA(1, 0), a3, voffA);
            PG8_BAR; PG8_WAIT_L(0); PG8_MMA(1, 0, At, B0); PG8_BAR; PG8_SCHED;
            PG8_STAGE(PG8_SB(1, 1), b3 + hstep, voffB);
            PG8_WAIT_V(6); PG8_BAR; PG8_MMA(1, 1, At, B1); PG8_BAR;
            }
        }
        if constexpr (ALIGN_EPI) { if (wr == 0) PG8_BAR; }
        if constexpr (!Epi::AFTER_DRAIN) { E(acc, cur, wr, wc, fr, fq); S.done(cur); }
        if (!has_next) break;
#pragma unroll
        for (int a = 0; a < 2; ++a)
#pragma unroll
            for (int b = 0; b < 2; ++b)
#pragma unroll
                for (int m = 0; m < 4; ++m)
#pragma unroll
                    for (int n = 0; n < 2; ++n) acc[a][b][m][n] = (f32x4){0.f, 0.f, 0.f, 0.f};
        cur = nxt; cA = nA; cB = nB; ++ui;
        if constexpr (ALIGN_EPI) { if (wr == 1) PG8_BAR; }
    }
    PG8_WAIT_V(0);
    if constexpr (!ALIGN_EPI) { if (wr == 0) PG8_BAR; }
    PG8_BAR;
    if constexpr (Epi::AFTER_DRAIN) { E.fused(acc, cur, wr, wc, fr, fq, lds, wid, lane); S.done(cur); }
#undef PG8_SA
#undef PG8_SB
#undef PG8_STAGE
#undef PG8_LDA
#undef PG8_LDB
#undef PG8_MMA
#undef PG8_WAIT_V
#undef PG8_WAIT_L
#undef PG8_BAR
#undef PG8_SCHED
}
}

template <class Epi>
__device__ __forceinline__ void ngemm_unit(unsigned char* lds, const bf16* A, int lda, const bf16* Bt, int ldb, int K, const Epi& epi, const pg8::Unit& u) {
    float* As = (float*)lds; float* Bs = As + 32 * 256;
    const int tid = threadIdx.x, tr = tid >> 4, tc = tid & 15;
    float acc0[8][8], acc1[8][8];
#pragma unroll
    for (int i = 0; i < 8; ++i)
#pragma unroll
        for (int j = 0; j < 8; ++j) { acc0[i][j] = 0.f; acc1[i][j] = 0.f; }
    for (int k0 = 0; k0 < K; k0 += 32) {
        __syncthreads();
#pragma unroll
        for (int j = 0; j < 2; ++j) { const int pidx = tid + 512 * j, r = pidx & 255, kq = pidx >> 8;
            const u32x4 va = *(const u32x4*)(A + (size_t)r * lda + k0 + kq * 8);
            const u32x4 vb = *(const u32x4*)(Bt + (size_t)r * ldb + k0 + kq * 8);
            float* ap = As + (kq * 8) * 256 + r; float* bp = Bs + (kq * 8) * 256 + r;
            ap[0 * 256] = blo(va.x); ap[1 * 256] = bhi(va.x); ap[2 * 256] = blo(va.y); ap[3 * 256] = bhi(va.y); ap[4 * 256] = blo(va.z); ap[5 * 256] = bhi(va.z); ap[6 * 256] = blo(va.w); ap[7 * 256] = bhi(va.w);
            bp[0 * 256] = blo(vb.x); bp[1 * 256] = bhi(vb.x); bp[2 * 256] = blo(vb.y); bp[3 * 256] = bhi(vb.y); bp[4 * 256] = blo(vb.z); bp[5 * 256] = bhi(vb.z); bp[6 * 256] = blo(vb.w); bp[7 * 256] = bhi(vb.w); }
        __syncthreads();
#pragma unroll 2
        for (int kk = 0; kk < 32; ++kk) {
            const f32x4 a0 = *(const f32x4*)(As + kk * 256 + tr * 8), a1 = *(const f32x4*)(As + kk * 256 + tr * 8 + 4);
            const f32x4 b00 = *(const f32x4*)(Bs + kk * 256 + tc * 8), b01 = *(const f32x4*)(Bs + kk * 256 + tc * 8 + 4);
            const f32x4 b10 = *(const f32x4*)(Bs + kk * 256 + 128 + tc * 8), b11 = *(const f32x4*)(Bs + kk * 256 + 128 + tc * 8 + 4);
            const float a[8] = {a0.x, a0.y, a0.z, a0.w, a1.x, a1.y, a1.z, a1.w};
            const float b0[8] = {b00.x, b00.y, b00.z, b00.w, b01.x, b01.y, b01.z, b01.w};
            const float b1[8] = {b10.x, b10.y, b10.z, b10.w, b11.x, b11.y, b11.z, b11.w};
#pragma unroll
            for (int i = 0; i < 8; ++i)
#pragma unroll
                for (int j = 0; j < 8; ++j) { acc0[i][j] = fmaf(a[i], b0[j], acc0[i][j]); acc1[i][j] = fmaf(a[i], b1[j], acc1[i][j]); }
        }
    }
#pragma unroll
    for (int i = 0; i < 8; ++i) epi(u, tr * 8 + i, tc * 8, acc0[i], acc1[i]);
}

__device__ __forceinline__ void store8_bf16(bf16* dst, const float (&v)[8]) {
    u32x4 o; o.x = pk2(v[0], v[1]); o.y = pk2(v[2], v[3]); o.z = pk2(v[4], v[5]); o.w = pk2(v[6], v[7]); *(u32x4*)dst = o;
}

typedef pg8::Unit Unit;
struct EpiProj { bf16* O;
    __device__ __forceinline__ void operator()(const Unit& u, int r, int c8, const float (&v0)[8], const float (&v1)[8]) const {
        bf16* row = O + (size_t)(u.pm * 256 + r) * NP + u.pn * 256 + c8; store8_bf16(row, v0); store8_bf16(row + 128, v1); } };
struct EpiOut { const float* x; const float* gffn; float* H2; bf16* XN2;
    __device__ __forceinline__ void operator()(const Unit& u, int r, int c8, const float (&v0)[8], const float (&v1)[8]) const {
        const int col = u.pn * 256 + c8; const size_t off = (size_t)(u.pm * 256 + r) * D + col; float h0[8], h1[8], n0[8], n1[8];
        const f32x4 xa = *(const f32x4*)(x + off), xb = *(const f32x4*)(x + off + 4), xc = *(const f32x4*)(x + off + 128), xd = *(const f32x4*)(x + off + 132);
        const f32x4 ga = *(const f32x4*)(gffn + col), gb = *(const f32x4*)(gffn + col + 4), gc = *(const f32x4*)(gffn + col + 128), gd = *(const f32x4*)(gffn + col + 132);
        const float xs0[8] = {xa.x, xa.y, xa.z, xa.w, xb.x, xb.y, xb.z, xb.w}, xs1[8] = {xc.x, xc.y, xc.z, xc.w, xd.x, xd.y, xd.z, xd.w};
        const float gs0[8] = {ga.x, ga.y, ga.z, ga.w, gb.x, gb.y, gb.z, gb.w}, gs1[8] = {gc.x, gc.y, gc.z, gc.w, gd.x, gd.y, gd.z, gd.w};
#pragma unroll
        for (int i = 0; i < 8; ++i) { h0[i] = xs0[i] + v0[i]; h1[i] = xs1[i] + v1[i]; n0[i] = h0[i] * gs0[i]; n1[i] = h1[i] * gs1[i]; }
        *(f32x4*)(H2 + off) = (f32x4){h0[0], h0[1], h0[2], h0[3]}; *(f32x4*)(H2 + off + 4) = (f32x4){h0[4], h0[5], h0[6], h0[7]};
        *(f32x4*)(H2 + off + 128) = (f32x4){h1[0], h1[1], h1[2], h1[3]}; *(f32x4*)(H2 + off + 132) = (f32x4){h1[4], h1[5], h1[6], h1[7]};
        store8_bf16(XN2 + off, n0); store8_bf16(XN2 + off + 128, n1); } };
struct EpiGU { const float* bgu; const float* rowrstd; bf16* HDN; const LAS int* tile_e;
    __device__ __forceinline__ void operator()(const Unit& u, int r, int c8, const float (&v0)[8], const float (&v1)[8]) const {
        const int e = tile_e[u.pm]; const int row = u.pm * 256 + r; const float rs = rowrstd[row]; const int cb = u.pn * 128 + c8; float h[8];
        const float* bg = bgu + e * 2048 + cb; const f32x4 ba = *(const f32x4*)bg, bb = *(const f32x4*)(bg + 4), bc = *(const f32x4*)(bg + 1024), bd_ = *(const f32x4*)(bg + 1028);
        const float b0[8] = {ba.x, ba.y, ba.z, ba.w, bb.x, bb.y, bb.z, bb.w}, b1[8] = {bc.x, bc.y, bc.z, bc.w, bd_.x, bd_.y, bd_.z, bd_.w};
#pragma unroll
        for (int i = 0; i < 8; ++i) { float g = v0[i] * rs + b0[i]; float uu = v1[i] * rs + b1[i];
            g = fminf(g, 7.f); uu = fminf(fmaxf(uu, -7.f), 7.f); h[i] = g * sigmoidf_(1.702f * g) * (uu + 1.f); }
        store8_bf16(HDN + (size_t)row * DE + cb, h); } };
struct EpiDown { const float* bd; const float* rowgate; bf16* YS; const LAS int* tile_e;
    __device__ __forceinline__ void operator()(const Unit& u, int r, int c8, const float (&v0)[8], const float (&v1)[8]) const {
        const int e = tile_e[u.pm]; const int row = u.pm * 256 + r; const float gt = rowgate[row]; const int cb = u.pn * 256 + c8; float y0[8], y1[8];
        const float* bp = bd + e * D + cb; const f32x4 ba = *(const f32x4*)bp, bb = *(const f32x4*)(bp + 4), bc = *(const f32x4*)(bp + 128), bd_ = *(const f32x4*)(bp + 132);
        const float b0[8] = {ba.x, ba.y, ba.z, ba.w, bb.x, bb.y, bb.z, bb.w}, b1[8] = {bc.x, bc.y, bc.z, bc.w, bd_.x, bd_.y, bd_.z, bd_.w};
#pragma unroll
        for (int i = 0; i < 8; ++i) { y0[i] = (v0[i] + b0[i]) * gt; y1[i] = (v1[i] + b1[i]) * gt; }
        store8_bf16(YS + (size_t)row * D + cb, y0); store8_bf16(YS + (size_t)row * D + cb + 128, y1); } };

template <class F> struct EpiAdapt {
    static constexpr bool PERM = true, AFTER_DRAIN = false; F f;
    __device__ __forceinline__ void operator()(const f32x4 (&acc)[2][2][4][2], const Unit& u, int wr, int wc, int fr, int fq) const {
#pragma unroll
        for (int ai = 0; ai < 2; ++ai)
#pragma unroll
            for (int m = 0; m < 4; ++m) { const int r = ai * 128 + wr * 64 + m * 16 + fr, c8 = wc * 32 + fq * 8;
                const f32x4 a = acc[ai][0][m][0], b = acc[ai][0][m][1], c = acc[ai][1][m][0], d = acc[ai][1][m][1];
                const float v0[8] = {a.x, a.y, a.z, a.w, b.x, b.y, b.z, b.w}, v1[8] = {c.x, c.y, c.z, c.w, d.x, d.y, d.z, d.w};
                f(u, r, c8, v0, v1); }
    }
};
struct MoeOrder { pg8::StaticOrder so; const LAS int* tile_e; int ncol;
    __device__ __forceinline__ bool next(int i, Unit& u) const { return so.next(i, u); }
    __device__ __forceinline__ int bidx(const Unit& u) const { return tile_e[u.pm] * ncol + u.pn; }
    __device__ __forceinline__ void a_ready(const Unit&) const {}
    __device__ __forceinline__ void done(const Unit&) const {} };

__device__ __forceinline__ void phase_ew_naive(const Params& p, unsigned char* lds) {
    const int tid = threadIdx.x, lane = tid & 63, wave = tid >> 6;
    bf16* PROJ = (bf16*)(p.ws + WS_PROJ); bf16* MIX = (bf16*)(p.ws + WS_MIX); bf16* KI = (bf16*)(p.ws + WS_KI); bf16* QL = (bf16*)(p.ws + WS_QL); float* WI = (float*)(p.ws + WS_WI);
    const float* COS = (const float*)(p.ws + WS_COS); const float* SIN = (const float*)(p.ws + WS_SIN);
    float* red = (float*)(lds);
    for (int t = blockIdx.x; t < S; t += gridDim.x) {
        const int c = tid; float acc = p.conv_b[c];
        for (int j = 0; j < CW; ++j) { const int tt = t - (CW - 1) + j; if (tt >= 0) { const float val = bf2f(PROJ[(size_t)tt * NP + C_VAL + c]), gate = bf2f(PROJ[(size_t)tt * NP + C_GATE + c]);
                acc = fmaf(p.conv_w[j * CC + c], val * sigmoidf_(gate), acc); } }
        const int hh = (tid & 255) >> 5, ii = tid & 31; const int qkbase = (tid < 256) ? C_Q : C_K;
        const float cs = COS[t * 32 + ii], sn = SIN[t * 32 + ii];
        const float x1 = bf2f(PROJ[(size_t)t * NP + qkbase + hh * 64 + ii]), x2 = bf2f(PROJ[(size_t)t * NP + qkbase + hh * 64 + 32 + ii]);
        float qi1 = 0.f, qi2 = 0.f; if (tid < 256) { qi1 = bf2f(PROJ[(size_t)t * NP + C_QI + hh * 64 + ii]); qi2 = bf2f(PROJ[(size_t)t * NP + C_QI + hh * 64 + 32 + ii]); }
        float kiv = 0.f, qlv = 0.f;
        if (wave == 4) kiv = bf2f(PROJ[(size_t)t * NP + C_KI + lane]);
        if (wave == 5) { for (int h = 0; h < 8; ++h) qlv = fmaf(bf2f(PROJ[(size_t)t * NP + C_WI + h]), bf2f(PROJ[(size_t)t * NP + C_QI + h * 64 + lane]), qlv); }
        float wiv = 0.f; if (wave == 6 && lane < 8) wiv = bf2f(PROJ[(size_t)t * NP + C_WI + lane]);
        float s1 = wave_sum(acc); if (lane == 0) red[wave] = s1; __syncthreads();
        float mean = 0.f;
#pragma unroll
        for (int w = 0; w < 8; ++w) mean += red[w];
        mean *= (1.f / CC); const float dv = acc - mean; float s2 = wave_sum(dv * dv); if (lane == 0) red[8 + wave] = s2; __syncthreads();
        float var = 0.f;
#pragma unroll
        for (int w = 0; w < 8; ++w) var += red[8 + w];
        var *= (1.f / CC);
        const float y = dv * rsqrtf(var + EPS) * p.conv_ng[c] + p.conv_nb[c];
        MIX[(size_t)t * D + c] = (bf16)f2bf(y * sigmoidf_(y));
        { const float sc = (tid < 256) ? C2 : 1.f; PROJ[(size_t)t * NP + qkbase + hh * 64 + ii] = (bf16)f2bf((x1 * cs - x2 * sn) * sc); PROJ[(size_t)t * NP + qkbase + hh * 64 + 32 + ii] = (bf16)f2bf((x2 * cs + x1 * sn) * sc); }
        if (tid < 256) { PROJ[(size_t)t * NP + C_QI + hh * 64 + ii] = (bf16)f2bf(qi1 * cs - qi2 * sn); PROJ[(size_t)t * NP + C_QI + hh * 64 + 32 + ii] = (bf16)f2bf(qi2 * cs + qi1 * sn); }
        if (wave == 4) { const float m = wave_sum(kiv) * (1.f / 64.f); const float d = kiv - m; const float vr = wave_sum(d * d) * (1.f / 64.f);
            const float yk = d * rsqrtf(vr + EPS) * p.idx_g[lane] + p.idx_b[lane]; const float other = __shfl_xor(yk, 32);
            const float c_ = COS[t * 32 + (lane & 31)], s_ = SIN[t * 32 + (lane & 31)];
            KI[(size_t)t * 64 + lane] = (bf16)f2bf(lane < 32 ? (yk * c_ - other * s_) : (yk * c_ + other * s_)); }
        if (wave == 5) { const float other = __shfl_xor(qlv, 32); const float c_ = COS[t * 32 + (lane & 31)], s_ = SIN[t * 32 + (lane & 31)];
            QL[(size_t)t * 64 + lane] = (bf16)f2bf(lane < 32 ? (qlv * c_ - other * s_) : (qlv * c_ + other * s_)); }
        if (wave == 6 && lane < 8) WI[t * 8 + lane] = wiv;
        __syncthreads();
    }
}

__device__ __forceinline__ unsigned fkey(float f) { unsigned u = __float_as_uint(f); if (u == 0x80000000u) u = 0u; return (u & 0x80000000u) ? ~u : (u | 0x80000000u); }
__device__ __forceinline__ void phase_idx_naive(const Params& p, unsigned char* lds) {
    const int tid = threadIdx.x, lane = tid & 63, wave = tid >> 6;
    const bf16* PROJ = (const bf16*)(p.ws + WS_PROJ); const bf16* KI = (const bf16*)(p.ws + WS_KI); const float* WI = (const float*)(p.ws + WS_WI);
    u64* MASK = (u64*)(p.ws + WS_MASK);
    float* scores = (float*)lds;
    float* qif = (float*)(lds + 65536);
    float* wf = (float*)(lds + 65536 + 2048);
    unsigned* hist = (unsigned*)(lds + 65536 + 4096);
    u64* tiebits = (u64*)(lds + 65536 + 8192);
    int* sh = (int*)(lds + 65536 + 12288);
    for (int t = blockIdx.x; t < S; t += gridDim.x) {
        const int tq = t >> 6, nadm = 64 * (tq + 1), ntw = 4 * (t >> 8) + 4;
        __syncthreads();
        if (nadm <= KSEL) {
            if (tid < ntw) MASK[(size_t)tid * S + t] = (tid <= tq) ? ~0ull : 0ull;
            continue;
        }
        qif[tid] = bf2f(PROJ[(size_t)t * NP + C_QI + tid]); if (tid < 8) wf[tid] = WI[t * 8 + tid];
        __syncthreads();
        for (int s = tid; s < nadm; s += NTHREADS) {
            float kf[64];
#pragma unroll
            for (int j = 0; j < 8; ++j) { const u32x4 v = *(const u32x4*)(KI + (size_t)s * 64 + j * 8);
                kf[j * 8 + 0] = blo(v.x); kf[j * 8 + 1] = bhi(v.x); kf[j * 8 + 2] = blo(v.y); kf[j * 8 + 3] = bhi(v.y); kf[j * 8 + 4] = blo(v.z); kf[j * 8 + 5] = bhi(v.z); kf[j * 8 + 6] = blo(v.w); kf[j * 8 + 7] = bhi(v.w); }
            float I = 0.f;
            for (int h = 0; h < 8; ++h) { float d = 0.f;
#pragma unroll
                for (int k = 0; k < 64; k += 4) { const f32x4 q4 = *(const f32x4*)(qif + h * 64 + k); d = fmaf(q4.x, kf[k], d); d = fmaf(q4.y, kf[k + 1], d); d = fmaf(q4.z, kf[k + 2], d); d = fmaf(q4.w, kf[k + 3], d); }
                I = fmaf(wf[h], fmaxf(d, 0.f), I); }
            scores[s] = I;
        }
        __syncthreads();
        unsigned prefix = 0; int kk = KSEL;
        for (int ps = 0; ps < 4; ++ps) {
            const int shift = 24 - 8 * ps;
            if (tid < 256) hist[tid] = 0u;
            __syncthreads();
            for (int s = tid; s < nadm; s += NTHREADS) { const unsigned key = fkey(scores[s]); if (ps == 0 || (key >> (shift + 8)) == prefix) atomicAdd(&hist[(key >> shift) & 255u], 1u); }
            __syncthreads();
            if (wave == 0) {
                unsigned c4[4]; unsigned tot = 0;
#pragma unroll
                for (int j = 0; j < 4; ++j) { c4[j] = hist[255 - (4 * lane + j)]; tot += c4[j]; }
                unsigned incl = tot;
#pragma unroll
                for (int o = 1; o < 64; o <<= 1) { const unsigned v = __shfl_up(incl, o); if (lane >= o) incl += v; }
                const unsigned excl = incl - tot;
                if (excl < (unsigned)kk && (unsigned)kk <= incl) { const unsigned s0 = excl + c4[0], s1 = s0 + c4[1], s2 = s1 + c4[2]; const unsigned ukk = (unsigned)kk;
                    const int j = ukk <= s0 ? 0 : ukk <= s1 ? 1 : ukk <= s2 ? 2 : 3; const unsigned cum = ukk <= s0 ? excl : ukk <= s1 ? s0 : ukk <= s2 ? s1 : s2;
                    sh[0] = 255 - (4 * lane + j); sh[1] = kk - (int)cum; }
            }
            __syncthreads();
            prefix = (prefix << 8) | (unsigned)sh[0]; kk = sh[1];
            __syncthreads();
        }
        const unsigned T = prefix;
        if (wave == 0) { int run = 0;
            for (int tile = 0; tile <= tq; ++tile) { const bool tie = fkey(scores[tile * 64 + lane]) == T; const u64 bal = __ballot(tie);
                const int rank = run + __popcll(bal & ((1ull << lane) - 1ull)); const u64 tb = __ballot(tie && rank < kk); if (lane == 0) tiebits[tile] = tb; run += __popcll(bal); } }
        __syncthreads();
        for (int tile = wave; tile < ntw; tile += NWAVES) { u64 w = 0ull;
            if (tile <= tq) { w = __ballot(fkey(scores[tile * 64 + lane]) > T) | tiebits[tile]; }
            if (lane == 0) MASK[(size_t)tile * S + t] = w; }
    }
}

__device__ __forceinline__ void phase_att_naive(const Params& p, unsigned char* lds) {
    const int tid = threadIdx.x, lane = tid & 63, wave = tid >> 6;
    const bf16* PROJ = (const bf16*)(p.ws + WS_PROJ); bf16* MIX = (bf16*)(p.ws + WS_MIX); const u64* MASK = (const u64*)(p.ws + WS_MASK);
    int* sidx = (int*)(lds + wave * 2048); float* slog = (float*)(lds + wave * 2048 + 1024);
    const int h = wave;
    for (int t = blockIdx.x; t < S; t += gridDim.x) {
        const int tq = t >> 6;
        float qf[64];
#pragma unroll
        for (int j = 0; j < 8; ++j) { const u32x4 v = *(const u32x4*)(PROJ + (size_t)t * NP + C_Q + h * 64 + j * 8);
            qf[j * 8 + 0] = blo(v.x); qf[j * 8 + 1] = bhi(v.x); qf[j * 8 + 2] = blo(v.y); qf[j * 8 + 3] = bhi(v.y); qf[j * 8 + 4] = blo(v.z); qf[j * 8 + 5] = bhi(v.z); qf[j * 8 + 6] = blo(v.w); qf[j * 8 + 7] = bhi(v.w); }
        int n = 0;
        for (int tile = 0; tile <= tq; ++tile) {
            const u64 w = MASK[(size_t)tile * S + t]; const bool sel = (w >> lane) & 1ull;
            if (w == 0ull) continue;
            float lg = 0.f; const int s = tile * 64 + lane;
            if (sel) {
#pragma unroll
                for (int j = 0; j < 8; ++j) { const u32x4 v = *(const u32x4*)(PROJ + (size_t)s * NP + C_K + h * 64 + j * 8);
                    lg = fmaf(qf[j * 8 + 0], blo(v.x), lg); lg = fmaf(qf[j * 8 + 1], bhi(v.x), lg); lg = fmaf(qf[j * 8 + 2], blo(v.y), lg); lg = fmaf(qf[j * 8 + 3], bhi(v.y), lg);
                    lg = fmaf(qf[j * 8 + 4], blo(v.z), lg); lg = fmaf(qf[j * 8 + 5], bhi(v.z), lg); lg = fmaf(qf[j * 8 + 6], blo(v.w), lg); lg = fmaf(qf[j * 8 + 7], bhi(v.w), lg); }
                const int pos = n + __popcll(w & ((1ull << lane) - 1ull));
                if (pos < 256) { sidx[pos] = s; slog[pos] = lg; }
            }
            n += __popcll(w);
        }
        if (n > 256) n = 256;
        __builtin_amdgcn_s_waitcnt(0); asm volatile("" ::: "memory");
        float m = -INFINITY; for (int j = lane; j < n; j += 64) m = fmaxf(m, slog[j]);
        m = wave_max(m);
        float l = 0.f; for (int j = lane; j < n; j += 64) { const float pj = exp2f(slog[j] - m); slog[j] = pj; l += pj; }
        l = wave_sum(l);
        __builtin_amdgcn_s_waitcnt(0); asm volatile("" ::: "memory");
        float o = 0.f;
        for (int j = 0; j < n; ++j) o = fmaf(slog[j], bf2f(PROJ[(size_t)sidx[j] * NP + C_V + h * 64 + lane]), o);
        MIX[(size_t)t * D + 512 + h * 64 + lane] = (bf16)f2bf(o / l);
        __builtin_amdgcn_s_waitcnt(0); asm volatile("" ::: "memory");
    }
}

__device__ __forceinline__ void phase_route_naive(const Params& p, unsigned char* lds) {
    const int tid = threadIdx.x, lane = tid & 63, wave = tid >> 6;
    const int gw = blockIdx.x * NWAVES + wave, NGW = gridDim.x * NWAVES;
    const float* H2 = (const float*)(p.ws + WS_H2); const float* WGRT = (const float*)(p.ws + WS_WGRT);
    float* RSTD = (float*)(p.ws + WS_RSTD); int* TOKOF = (int*)(p.ws + WS_TOKOF); float* GATEOF = (float*)(p.ws + WS_GATEOF); int* PAIR = (int*)(p.ws + WS_PAIR);
    unsigned* CNT = (unsigned*)(p.ws + WS_CTL) + CW_CNT;
    for (int t = gw; t < S; t += NGW) {
        const f32x4* hr = (const f32x4*)(H2 + (size_t)t * D) + lane; f32x4 v[4]; float ss = 0.f;
#pragma unroll
        for (int j = 0; j < 4; ++j) { v[j] = hr[64 * j]; ss += v[j].x * v[j].x + v[j].y * v[j].y + v[j].z * v[j].z + v[j].w * v[j].w; }
        const float rstd = rsqrtf(wave_sum(ss) * (1.f / D) + EPS);
        float mine = -INFINITY;
        for (int e = 0; e < NE; ++e) { const f32x4* wr = (const f32x4*)(WGRT + (size_t)e * D) + lane; float a = 0.f;
#pragma unroll
            for (int j = 0; j < 4; ++j) { const f32x4 w = wr[64 * j]; a = fmaf(v[j].x, w.x, a); a = fmaf(v[j].y, w.y, a); a = fmaf(v[j].z, w.z, a); a = fmaf(v[j].w, w.w, a); }
            a = wave_sum(a); if (lane == e) mine = a * rstd + p.b_router[e]; }
        float tv[4]; int te[4];
#pragma unroll
        for (int k = 0; k < 4; ++k) { float bv = mine; int bi = lane;
#pragma unroll
            for (int o = 32; o >= 1; o >>= 1) { const float ov = __shfl_xor(bv, o); const int oi = __shfl_xor(bi, o); if (ov > bv || (ov == bv && oi < bi)) { bv = ov; bi = oi; } }
            tv[k] = bv; te[k] = bi; if (lane == bi) mine = -INFINITY; }
        float g[4], gs = 0.f;
#pragma unroll
        for (int k = 0; k < 4; ++k) { g[k] = __expf(tv[k] - tv[0]); gs += g[k]; }
        if (lane == 0) RSTD[t] = rstd;
        if (lane < 4) { const int e = lane == 0 ? te[0] : lane == 1 ? te[1] : lane == 2 ? te[2] : te[3]; const float gg = (lane == 0 ? g[0] : lane == 1 ? g[1] : lane == 2 ? g[2] : g[3]) / gs;
            const unsigned slot = atomicAdd(&CNT[e], 1u); TOKOF[e * S + slot] = t; GATEOF[e * S + slot] = gg; PAIR[t * 4 + lane] = (e << 16) | (int)slot; }
    }
}

__device__ __forceinline__ int build_tiles(const Params& p, unsigned char* lds) {
    int* pst = (int*)(lds + LDS_MISC); int* tile_e = pst + 40;
    const unsigned* CNT = (const unsigned*)(p.ws + WS_CTL) + CW_CNT;
    __syncthreads();
    if (threadIdx.x == 0) { int acc = 0; for (int e = 0; e < NE; ++e) { pst[e] = acc; const int nt = ((int)__hip_atomic_load(&CNT[e], __ATOMIC_RELAXED, __HIP_MEMORY_SCOPE_AGENT) + 255) >> 8; for (int i = 0; i < nt; ++i) tile_e[acc + i] = e; acc += nt; } pst[NE] = acc; }
    __syncthreads();
    return pst[NE];
}

__device__ __forceinline__ void phase_gather(const Params& p, unsigned char* lds) {
    const int tid = threadIdx.x, lane = tid & 63, wave = tid >> 6;
    const int gw = blockIdx.x * NWAVES + wave, NGW = gridDim.x * NWAVES;
    build_tiles(p, lds); const int* pst = (const int*)(lds + LDS_MISC);
    const bf16* XN2 = (const bf16*)(p.ws + WS_XN); bf16* XS = (bf16*)(p.ws + WS_XS); const int* PAIR = (const int*)(p.ws + WS_PAIR);
    const float* RSTD = (const float*)(p.ws + WS_RSTD); const float* GATEOF = (const float*)(p.ws + WS_GATEOF);
    float* ROWRSTD = (float*)(p.ws + WS_ROWRSTD); float* ROWGATE = (float*)(p.ws + WS_ROWGATE);
    for (int pr = gw; pr < S * 4; pr += NGW) { const int t = pr >> 2; const int pe = PAIR[pr]; const int e = pe >> 16, slot = pe & 0xffff; const int row = pst[e] * 256 + slot;
        const u32x4* src = (const u32x4*)(XN2 + (size_t)t * D); u32x4* dst = (u32x4*)(XS + (size_t)row * D);
        dst[lane] = src[lane]; dst[lane + 64] = src[lane + 64];
        if (lane == 0) { ROWRSTD[row] = RSTD[t]; ROWGATE[row] = GATEOF[e * S + slot]; } }
}

__device__ __forceinline__ void phase_final(const Params& p, unsigned char* lds) {
    const int tid = threadIdx.x, lane = tid & 63, wave = tid >> 6;
    const int gw = blockIdx.x * NWAVES + wave, NGW = gridDim.x * NWAVES;
    build_tiles(p, lds); const int* pst = (const int*)(lds + LDS_MISC);
    const float* H2 = (const float*)(p.ws + WS_H2); const bf16* YS = (const bf16*)(p.ws + WS_YS); const int* PAIR = (const int*)(p.ws + WS_PAIR);
    for (int t = gw; t < S; t += NGW) {
        const f32x4* hr = (const f32x4*)(H2 + (size_t)t * D) + lane; f32x4 v[4];
#pragma unroll
        for (int j = 0; j < 4; ++j) v[j] = hr[64 * j];
#pragma unroll
        for (int k = 0; k < 4; ++k) { const int pe = PAIR[t * 4 + k]; const int row = pst[pe >> 16] * 256 + (pe & 0xffff); const uint2* yr = (const uint2*)(YS + (size_t)row * D) + lane;
#pragma unroll
            for (int j = 0; j < 4; ++j) { const uint2 y = yr[64 * j]; v[j].x += blo(y.x); v[j].y += bhi(y.x); v[j].z += blo(y.y); v[j].w += bhi(y.y); } }
        float ss = 0.f;
#pragma unroll
        for (int j = 0; j < 4; ++j) ss += v[j].x * v[j].x + v[j].y * v[j].y + v[j].z * v[j].z + v[j].w * v[j].w;
        const float rstd = rsqrtf(wave_sum(ss) * (1.f / D) + EPS);
        f32x4* o = (f32x4*)(p.out + (size_t)t * D) + lane;
#pragma unroll
        for (int j = 0; j < 4; ++j) { const f32x4 g = ((const f32x4*)p.norm_final_g)[lane + 64 * j]; o[64 * j] = (f32x4){v[j].x * rstd * g.x, v[j].y * rstd * g.y, v[j].z * rstd * g.z, v[j].w * rstd * g.w}; }
    }
}

#ifndef FAST_GEMM
#define FAST_GEMM 1
#endif
template <class F, class Sched>
__device__ __forceinline__ void run_gemm(unsigned char* lds, const bf16* A, const bf16* Bt, int K, const Sched& S, const F& f) {
#if FAST_GEMM
    pg8::Gemm g{A, Bt, 0, 0, K}; EpiAdapt<F> E{f};
    pg8::gemm_phase<EpiAdapt<F>, Sched, true, true>((LAS unsigned char*)lds, g, S, E);
#else
    Unit u;
    for (int i = 0; S.next(i, u); ++i) ngemm_unit(lds, A + (size_t)u.pm * 256 * K, K, Bt + (size_t)S.bidx(u) * 256 * K, K, K, f, u);
#endif
    __syncthreads();
}

__global__ void __launch_bounds__(NTHREADS, 2) fwd_kernel(Params p) {
    extern __shared__ __attribute__((aligned(16))) unsigned char lds[];
    cg::grid_group grid = cg::this_grid();
    const int G = gridDim.x, bx = blockIdx.x;
    const LAS int* tile_e = (const LAS int*)((LAS unsigned char*)lds + LDS_MISC) + 40;
    phase_prologue(p, lds);
    grid.sync();
    { pg8::StaticOrder so; so.init(S, NP, G, bx); EpiProj E{(bf16*)(p.ws + WS_PROJ)};
        run_gemm(lds, (const bf16*)(p.ws + WS_XN), (const bf16*)(p.ws + WS_WINT), D, so, E); }
    grid.sync();
    phase_ew_naive(p, lds);
    grid.sync();
    phase_idx_naive(p, lds);
    grid.sync();
    phase_att_naive(p, lds);
    grid.sync();
    { pg8::StaticOrder so; so.init(S, D, G, bx); EpiOut E{p.x, p.norm_ffn_g, (float*)(p.ws + WS_H2), (bf16*)(p.ws + WS_XN)};
        run_gemm(lds, (const bf16*)(p.ws + WS_MIX), (const bf16*)(p.ws + WS_WOUTT), D, so, E); }
    grid.sync();
    phase_route_naive(p, lds);
    grid.sync();
    phase_gather(p, lds);
    grid.sync();
    { const int ntile = build_tiles(p, lds);
        MoeOrder mo; mo.so.init(ntile * 256, 2048, G, bx); mo.tile_e = tile_e; mo.ncol = 8;
        EpiGU E{p.b_gu, (const float*)(p.ws + WS_ROWRSTD), (bf16*)(p.ws + WS_HDN), tile_e};
        run_gemm(lds, (const bf16*)(p.ws + WS_XS), (const bf16*)(p.ws + WS_WGUT), D, mo, E); }
    grid.sync();
    { const int ntile = build_tiles(p, lds);
        MoeOrder mo; mo.so.init(ntile * 256, D, G, bx); mo.tile_e = tile_e; mo.ncol = 4;
        EpiDown E{p.b_down, (const float*)(p.ws + WS_ROWGATE), (bf16*)(p.ws + WS_YS), tile_e};
        run_gemm(lds, (const bf16*)(p.ws + WS_HDN), (const bf16*)(p.ws + WS_WDT), DE, mo, E); }
    grid.sync();
    phase_final(p, lds);
}

extern "C" void kernel_launch(void* const* d_in, const int* in_sizes, int n_in, void* d_out, int out_size, void* d_ws, size_t ws_size, hipStream_t stream) {
    static int grid = 0;
    if (grid == 0) {
        if (n_in != 19 || out_size != S * D || ws_size < WS_END) { fprintf(stderr, "kernel_launch: unexpected shapes (n_in %d out %d ws %zu)\n", n_in, out_size, ws_size); grid = -1; return; }
        int dev = 0, cus = 0, per_cu = 0;
        (void)hipGetDevice(&dev); (void)hipDeviceGetAttribute(&cus, hipDeviceAttributeMultiprocessorCount, dev);
        if (hipFuncSetAttribute((const void*)fwd_kernel, hipFuncAttributeMaxDynamicSharedMemorySize, LDS_BYTES) != hipSuccess) { fprintf(stderr, "kernel_launch: hipFuncSetAttribute failed\n"); grid = -1; return; }
        if (hipOccupancyMaxActiveBlocksPerMultiprocessor(&per_cu, (const void*)fwd_kernel, NTHREADS, LDS_BYTES) != hipSuccess || per_cu < 1) { fprintf(stderr, "kernel_launch: occupancy query says %d\n", per_cu); per_cu = 1; }
        (void)hipGetLastError();
        grid = cus * 1;
    }
    if (grid < 0) return;
    (void)hipMemsetAsync((char*)d_ws + WS_CTL, 0, CTL_BYTES, stream);
    Params p{};
    p.x = (const float*)d_in[0]; p.pos = (const int*)d_in[1]; p.norm_mix_g = (const float*)d_in[2]; p.w_in = (const float*)d_in[3]; p.idx_g = (const float*)d_in[4]; p.idx_b = (const float*)d_in[5];
    p.conv_w = (const float*)d_in[6]; p.conv_b = (const float*)d_in[7]; p.conv_ng = (const float*)d_in[8]; p.conv_nb = (const float*)d_in[9]; p.w_out = (const float*)d_in[10]; p.norm_ffn_g = (const float*)d_in[11];
    p.w_router = (const float*)d_in[12]; p.b_router = (const float*)d_in[13]; p.w_gu = (const float*)d_in[14]; p.b_gu = (const float*)d_in[15]; p.w_down = (const float*)d_in[16]; p.b_down = (const float*)d_in[17];
    p.norm_final_g = (const float*)d_in[18]; p.out = (float*)d_out; p.ws = (unsigned char*)d_ws;
    void* args[] = {&p};
    hipError_t e = hipLaunchCooperativeKernel((const void*)fwd_kernel, dim3(grid), dim3(NTHREADS), args, LDS_BYTES, stream);
    if (e != hipSuccess) fprintf(stderr, "cooperative launch failed: %s (grid %d)\n", hipGetErrorString(e), grid);
}
```

```cpp
#include <hip/hip_runtime.h>
#include <hip/hip_cooperative_groups.h>
#include <cstdio>
#include <cstdint>
#include <hip/hip_bf16.h>
#include <cmath>
namespace cg = cooperative_groups;

constexpr int S = 16384, D = 1024, NIN = 3144, NP = 3328;
constexpr int CC = 512, CW = 31, NH = 8, HD = 64, NE = 32, DE = 1024;
constexpr int C_VAL = 0, C_GATE = 512, C_Q = 1024, C_K = 1536, C_V = 2048, C_QI = 2560, C_KI = 3072, C_WI = 3136;
constexpr int KSEL = 256;
constexpr float EPS = 1e-5f;
constexpr float C2 = 0.125f * 1.4426950408889634f;
constexpr int NTHREADS = 512, NWAVES = 8;
constexpr int MAXROWS = 65536 + NE * 256;
constexpr int MAXTILES = MAXROWS / 256;

constexpr size_t MiB = 1u << 20;
constexpr size_t WS_CTL = 0, CTL_BYTES = 1 * MiB;
constexpr size_t WS_WINT = 2 * MiB;
constexpr size_t WS_WOUTT = 9 * MiB;
constexpr size_t WS_WGRT = 11 * MiB;
constexpr size_t WS_COS = 12 * MiB;
constexpr size_t WS_SIN = 14 * MiB;
constexpr size_t WS_WGUT = 16 * MiB;
constexpr size_t WS_WDT = 144 * MiB;
constexpr size_t WS_XN = 208 * MiB;
constexpr size_t WS_PROJ = 240 * MiB;
constexpr size_t WS_MIX = 344 * MiB;
constexpr size_t WS_KI = 376 * MiB;
constexpr size_t WS_QL = 378 * MiB;
constexpr size_t WS_WI = 380 * MiB;
constexpr size_t WS_RSTD = 381 * MiB;
constexpr size_t WS_TOKOF = 382 * MiB;
constexpr size_t WS_GATEOF = 384 * MiB;
constexpr size_t WS_PAIR = 386 * MiB;
constexpr size_t WS_ROWRSTD = 387 * MiB;
constexpr size_t WS_ROWGATE = 388 * MiB;
constexpr size_t WS_MASK = 392 * MiB;
constexpr size_t WS_H2 = 424 * MiB;
constexpr size_t WS_XS = 488 * MiB;
constexpr size_t WS_HDN = 632 * MiB;
constexpr size_t WS_YS = 776 * MiB;
constexpr size_t WS_END = 920 * MiB;
constexpr int CW_CNT = 1024;

constexpr int LDS_BYTES = 147456;
constexpr int LDS_MISC = 131072;

#define LAS __attribute__((address_space(3)))
typedef unsigned short bf16;
typedef unsigned long long u64;
typedef float f32x4 __attribute__((ext_vector_type(4)));
typedef unsigned u32x4 __attribute__((ext_vector_type(4)));

__device__ __forceinline__ float bf2f(unsigned v) { return __uint_as_float(v << 16); }
__device__ __forceinline__ unsigned f2bf(float f) { unsigned u = __float_as_uint(f); return (u + 0x7fffu + ((u >> 16) & 1u)) >> 16; }
__device__ __forceinline__ unsigned pk2(float lo, float hi) { return f2bf(lo) | (f2bf(hi) << 16); }
__device__ __forceinline__ float blo(unsigned w) { return __uint_as_float(w << 16); }
__device__ __forceinline__ float bhi(unsigned w) { return __uint_as_float(w & 0xffff0000u); }
__device__ __forceinline__ float wave_sum(float v) {
#pragma unroll
    for (int o = 1; o < 64; o <<= 1) v += __shfl_xor(v, o);
    return v;
}
__device__ __forceinline__ float wave_max(float v) {
#pragma unroll
    for (int o = 1; o < 64; o <<= 1) v = fmaxf(v, __shfl_xor(v, o));
    return v;
}
__device__ __forceinline__ float sigmoidf_(float x) { return 1.f / (1.f + __expf(-x)); }

struct Params {
    const float* x; const int* pos; const float* norm_mix_g; const float* w_in; const float* idx_g; const float* idx_b;
    const float* conv_w; const float* conv_b; const float* conv_ng; const float* conv_nb; const float* w_out; const float* norm_ffn_g;
    const float* w_router; const float* b_router; const float* w_gu; const float* b_gu; const float* w_down; const float* b_down;
    const float* norm_final_g; float* out; unsigned char* ws;
};

__device__ __forceinline__ void transpose_item(const float* W, int K, int N, bf16* WT, int dst_row0, int k0, int n0, float* scr, int lane) {
#pragma unroll 8
    for (int i = 0; i < 32; ++i) { const int kk = 2 * i + (lane >> 5); const int n = n0 + (lane & 31);
        scr[kk * 33 + (lane & 31)] = (n < N) ? W[(size_t)(k0 + kk) * N + n] : 0.f; }
    __builtin_amdgcn_s_waitcnt(0); asm volatile("" ::: "memory");
    const int c = lane & 7;
#pragma unroll
    for (int j = 0; j < 4; ++j) { const int n = (lane >> 3) + 8 * j; const float* s = scr + (8 * c) * 33 + n;
        u32x4 o; o.x = pk2(s[0 * 33], s[1 * 33]); o.y = pk2(s[2 * 33], s[3 * 33]); o.z = pk2(s[4 * 33], s[5 * 33]); o.w = pk2(s[6 * 33], s[7 * 33]);
        *(u32x4*)(WT + (size_t)(dst_row0 + n) * K + k0 + 8 * c) = o; }
    __builtin_amdgcn_s_waitcnt(0); asm volatile("" ::: "memory");
}

__device__ __forceinline__ void phase_prologue(const Params& p, unsigned char* lds) {
    const int tid = threadIdx.x, lane = tid & 63, wave = tid >> 6;
    const int gw = blockIdx.x * NWAVES + wave, NGW = gridDim.x * NWAVES;
    float* scr = (float*)(lds + wave * 16384);
    bf16* WinT = (bf16*)(p.ws + WS_WINT); bf16* WoutT = (bf16*)(p.ws + WS_WOUTT); bf16* WguT = (bf16*)(p.ws + WS_WGUT); bf16* WdT = (bf16*)(p.ws + WS_WDT);
    constexpr int I_IN = 16 * (NP / 32), I_OUT = 16 * 32, I_GU = 16 * 64, I_DN = 16 * 32;
    constexpr int NITEMS = I_IN + I_OUT + NE * I_GU + NE * I_DN;
    for (int it = gw; it < NITEMS; it += NGW) {
        int r = it;
        if (r < I_IN) { const int nb = r % (NP / 32), kb = r / (NP / 32); transpose_item(p.w_in, D, NIN, WinT, nb * 32, kb * 64, nb * 32, scr, lane); continue; }
        r -= I_IN;
        if (r < I_OUT) { const int nb = r % 32, kb = r / 32; transpose_item(p.w_out, D, D, WoutT, nb * 32, kb * 64, nb * 32, scr, lane); continue; }
        r -= I_OUT;
        if (r < NE * I_GU) { const int e = r / I_GU, q = r % I_GU, nb = q % 64, kb = q / 64; const int n0 = nb * 32;
            const int c = n0 & 1023, isu = n0 >> 10; const int drow = e * 2048 + (c >> 7) * 256 + isu * 128 + (c & 127);
            transpose_item(p.w_gu + (size_t)e * D * 2048, D, 2048, WguT, drow - 0, kb * 64, n0, scr, lane);
            continue; }
        r -= NE * I_GU;
        { const int e = r / I_DN, q = r % I_DN, nb = q % 32, kb = q / 32;
            transpose_item(p.w_down + (size_t)e * DE * D, DE, D, WdT, e * D + nb * 32, kb * 64, nb * 32, scr, lane); }
    }
    for (int i = blockIdx.x * NTHREADS + tid; i < NE * D; i += gridDim.x * NTHREADS) { const int e = i / D, k = i % D; ((float*)(p.ws + WS_WGRT))[i] = p.norm_ffn_g[k] * p.w_router[k * NE + e]; }
    for (int i = blockIdx.x * NTHREADS + tid; i < S * 32; i += gridDim.x * NTHREADS) { const int t = i >> 5, j = i & 31;
        const float inv = powf(10000.f, -(float)j / 32.f); const float ang = (float)p.pos[t] * inv;
        double xr = (double)ang * 0.15915494309189535; xr -= floor(xr); const float xf = (float)xr;
        ((float*)(p.ws + WS_COS))[i] = __builtin_amdgcn_cosf(xf); ((float*)(p.ws + WS_SIN))[i] = __builtin_amdgcn_sinf(xf); }
    bf16* XN = (bf16*)(p.ws + WS_XN);
    for (int m = gw; m < S; m += NGW) {
        const f32x4* xr = (const f32x4*)(p.x + (size_t)m * D) + lane; f32x4 v[4]; float ss = 0.f;
#pragma unroll
        for (int j = 0; j < 4; ++j) { v[j] = xr[64 * j]; ss += v[j].x * v[j].x + v[j].y * v[j].y + v[j].z * v[j].z + v[j].w * v[j].w; }
        const float rstd = rsqrtf(wave_sum(ss) * (1.f / D) + EPS);
        u64* o8 = (u64*)(XN + (size_t)m * D) + lane;
#pragma unroll
        for (int j = 0; j < 4; ++j) { const f32x4 g = ((const f32x4*)p.norm_mix_g)[lane + 64 * j];
            o8[64 * j] = (u64)pk2(v[j].x * rstd * g.x, v[j].y * rstd * g.y) | ((u64)pk2(v[j].z * rstd * g.z, v[j].w * rstd * g.w) << 32); }
    }
}

namespace pg8 {
#define PG8_LAS __attribute__((address_space(3)))
typedef unsigned short bf16_t;
typedef short bf16x8 __attribute__((ext_vector_type(8)));
typedef float f32x4 __attribute__((ext_vector_type(4)));
typedef unsigned u32x4 __attribute__((ext_vector_type(4)));
constexpr int BM = 256, BK = 64, HALF = 128, HTB = HALF * BK * 2  , STAGE_BYTES = 8 * HTB, NXCD = 8, WGM = 8;

__host__ __device__ __forceinline__ int lds_byte(int r, int c) { const int st = (r >> 4) * 2 + (c >> 5), rr = r & 15, cc = c & 31, ob = rr * 64 + cc * 2; return st * 1024 + (ob ^ (((ob >> 9) & 1) << 5)); }
__host__ __device__ __forceinline__ void stage_rc(int b, int& R, int& C) { const int st = b / 1024, sb = b % 1024, swz = sb ^ (((sb >> 9) & 1) << 5); R = (st >> 1) * 16 + swz / 64; C = (st & 1) * 32 + (swz % 64) / 2; }
__host__ __device__ __forceinline__ int perm32(int rho) { const int n = rho >> 4, i = rho & 15; return 8 * (i >> 2) + 4 * n + (i & 3); }

struct Unit { int pm, pn; };
struct Gemm { const bf16_t* A; const bf16_t* Bt; int M, N, K; };

struct StaticOrder {
    int nM, nN, nwg, G, c;
    __host__ __device__ void init(int M, int N, int G_, int c_) { nM = M / BM; nN = N / BM; nwg = nM * nN; G = G_; c = c_; }
    __host__ __device__ bool next(int i, Unit& u) const {
        const long L = (long)i * G + c; if (L >= nwg) return false;
        int wgid = (int)L; { const int q = nwg / NXCD, r = nwg % NXCD, xcd = wgid % NXCD, off = wgid / NXCD; wgid = (xcd < r ? xcd * (q + 1) : r * (q + 1) + (xcd - r) * q) + off; }
        const int nig = WGM * nN, gid = wgid / nig, fm = gid * WGM, gsz = (nM - fm) < WGM ? (nM - fm) : WGM;
        u.pm = fm + ((wgid % nig) % gsz); u.pn = (wgid % nig) / gsz; return true;
    }
    __device__ __forceinline__ int bidx(const Unit& u) const { return u.pn; }
    __device__ __forceinline__ void a_ready(const Unit&) const {}
    __device__ __forceinline__ void done(const Unit&) const {}
};
template <class Epi, class Sched, bool ALIGN_EPI = false, bool SP2 = false>
__device__ __forceinline__ void gemm_phase(PG8_LAS unsigned char* lds, const Gemm g, const Sched& S, const Epi& E) {
    int tid_ = threadIdx.x; asm volatile("" : "+v"(tid_));
    const int tid = tid_, wid = __builtin_amdgcn_readfirstlane(tid >> 6), lane = tid & 63, wr = wid >> 2, wc = wid & 3, fr = lane & 15, fq = lane >> 4;
    const int K = g.K, nt = K / BK;
    unsigned voffA[2], voffB[2];
#pragma unroll
    for (int i = 0; i < 2; ++i) { int R, C; stage_rc(tid * 16 + i * 8192, R, C); const int Rb = Epi::PERM ? ((R & ~31) + perm32(R & 31)) : R;
        voffA[i] = (unsigned)(R * K + C) * 2u; voffB[i] = (unsigned)(Rb * K + C) * 2u; }
    const size_t kstep = (size_t)(BK * 2);
    const size_t hstep = (size_t)HALF * K * 2;
    const size_t tstep = 2 * hstep;
    const unsigned ldsw = (unsigned)wid * 1024u;
    const int aoff = lds_byte(wr * 64 + fr, fq * 8), boff = lds_byte(wc * 32 + fr, fq * 8);
#define PG8_SA(b, h) (((b) * 2 + (h)) * HTB)
#define PG8_SB(b, h) ((4 + (b) * 2 + (h)) * HTB)
#define PG8_STAGE(bufoff, gbase, voff) do { _Pragma("unroll") for (int _i = 0; _i < 2; ++_i) \
        __builtin_amdgcn_global_load_lds((const unsigned*)((const char*)(gbase) + (voff)[_i]), (PG8_LAS unsigned*)(lds + (bufoff) + ldsw + _i * 8192), 16, 0, 0); } while (0)
#define PG8_LDA(dst, b, h) do { _Pragma("unroll") for (int m = 0; m < 4; ++m) _Pragma("unroll") for (int k = 0; k < 2; ++k) dst[m][k] = *(const PG8_LAS bf16x8*)(lds + PG8_SA(b, h) + aoff + m * 2048 + k * 1024); } while (0)
#define PG8_LDB(dst, b, h) do { _Pragma("unroll") for (int n = 0; n < 2; ++n) _Pragma("unroll") for (int k = 0; k < 2; ++k) dst[n][k] = *(const PG8_LAS bf16x8*)(lds + PG8_SB(b, h) + boff + n * 2048 + k * 1024); } while (0)
#define PG8_MMA(ai, bj, At, Bt) do { __builtin_amdgcn_s_setprio(1); _Pragma("unroll") for (int m = 0; m < 4; ++m) _Pragma("unroll") for (int n = 0; n < 2; ++n) _Pragma("unroll") for (int k = 0; k < 2; ++k) \
        acc[ai][bj][m][n] = __builtin_amdgcn_mfma_f32_16x16x32_bf16(Bt[n][k], At[m][k], acc[ai][bj][m][n], 0, 0, 0); __builtin_amdgcn_s_setprio(0); } while (0)
#define PG8_WAIT_V(n) asm volatile("s_waitcnt vmcnt(" #n ")" ::: "memory")
#define PG8_WAIT_L(n) asm volatile("s_waitcnt lgkmcnt(" #n ")" ::: "memory")
#define PG8_BAR __builtin_amdgcn_s_barrier()
#define PG8_SCHED __builtin_amdgcn_sched_barrier(0)
    Unit cur, nxt; int ui = 0;
    if (!S.next(0, cur)) return;
    f32x4 acc[2][2][4][2];
#pragma unroll
    for (int a = 0; a < 2; ++a)
#pragma unroll
        for (int b = 0; b < 2; ++b)
#pragma unroll
            for (int m = 0; m < 4; ++m)
#pragma unroll
                for (int n = 0; n < 2; ++n) acc[a][b][m][n] = (f32x4){0.f, 0.f, 0.f, 0.f};
    bf16x8 At[4][2], B0[2][2], B1[2][2];
    const char* cA = (const char*)g.A + (size_t)cur.pm * tstep; const char* cB = (const char*)g.Bt + (size_t)S.bidx(cur) * tstep;
    S.a_ready(cur);
    if constexpr (SP2) {
        PG8_STAGE(PG8_SB(0, 0), cB, voffB); PG8_STAGE(PG8_SB(0, 1), cB + hstep, voffB); PG8_STAGE(PG8_SA(0, 0), cA, voffA); PG8_STAGE(PG8_SA(0, 1), cA + hstep, voffA);
        if (wr == 1) PG8_BAR;
        PG8_WAIT_V(2); PG8_BAR;
        PG8_STAGE(PG8_SB(1, 0), cB + kstep, voffB); PG8_STAGE(PG8_SA(1, 0), cA + kstep, voffA); PG8_STAGE(PG8_SB(1, 1), cB + hstep + kstep, voffB);
        PG8_WAIT_V(6); PG8_BAR;
    } else {
        PG8_STAGE(PG8_SB(0, 0), cB, voffB); PG8_STAGE(PG8_SA(0, 0), cA, voffA); PG8_STAGE(PG8_SB(0, 1), cB + hstep, voffB); PG8_STAGE(PG8_SA(0, 1), cA + hstep, voffA);
        if (wr == 1) PG8_BAR;
        PG8_WAIT_V(4); PG8_BAR;
        PG8_STAGE(PG8_SB(1, 0), cB + kstep, voffB); PG8_STAGE(PG8_SA(1, 0), cA + kstep, voffA); PG8_STAGE(PG8_SB(1, 1), cB + hstep + kstep, voffB);
        PG8_WAIT_V(6); PG8_BAR;
    }
    for (;;) {
        const bool has_next = S.next(ui + 1, nxt);
        const char* nA = has_next ? (const char*)g.A + (size_t)nxt.pm * tstep : cA; const char* nB = has_next ? (const char*)g.Bt + (size_t)S.bidx(nxt) * tstep : cB;
        for (int t = 0; t < nt; t += 2) {
            const bool last = (t == nt - 2);
            const char* a1 = cA + (size_t)(t + 1) * kstep;
            const char* a2 = last ? nA : cA + (size_t)(t + 2) * kstep; const char* b2 = last ? nB : cB + (size_t)(t + 2) * kstep;
            const char* a3 = a2 + kstep; const char* b3 = b2 + kstep;
            if (last && has_next) S.a_ready(nxt);
            if constexpr (SP2) {
            PG8_LDB(B0, 0, 0); PG8_LDB(B1, 0, 1); PG8_SCHED; PG8_LDA(At, 0, 0); PG8_STAGE(PG8_SA(1, 1), a1 + hstep, voffA);
            PG8_WAIT_V(8); PG8_WAIT_L(0); PG8_BAR; PG8_MMA(0, 0, At, B0); PG8_MMA(0, 1, At, B1); PG8_BAR; PG8_SCHED;
            PG8_LDA(At, 0, 1); PG8_STAGE(PG8_SB(0, 0), b2, voffB); PG8_STAGE(PG8_SB(0, 1), b2 + hstep, voffB); PG8_STAGE(PG8_SA(0, 0), a2, voffA);
            PG8_WAIT_V(8); PG8_WAIT_L(0); PG8_BAR; PG8_MMA(1, 0, At, B0); PG8_MMA(1, 1, At, B1); PG8_BAR; PG8_SCHED;
            PG8_LDB(B0, 1, 0); PG8_LDB(B1, 1, 1); PG8_SCHED; PG8_LDA(At, 1, 0); PG8_STAGE(PG8_SA(0, 1), a2 + hstep, voffA);
            PG8_WAIT_V(8); PG8_WAIT_L(0); PG8_BAR; PG8_MMA(0, 0, At, B0); PG8_MMA(0, 1, At, B1); PG8_BAR; PG8_SCHED;
            PG8_LDA(At, 1, 1); PG8_STAGE(PG8_SB(1, 0), b3, voffB); PG8_STAGE(PG8_SB(1, 1), b3 + hstep, voffB); PG8_STAGE(PG8_SA(1, 0), a3, voffA);
            PG8_WAIT_V(8); PG8_WAIT_L(0); PG8_BAR; PG8_MMA(1, 0, At, B0); PG8_MMA(1, 1, At, B1); PG8_BAR; PG8_SCHED;
            } else {
            PG8_LDB(B0, 0, 0); PG8_SCHED; PG8_LDA(At, 0, 0); PG8_STAGE(PG8_SA(1, 1), a1 + hstep, voffA);
            PG8_WAIT_L(8); PG8_BAR; PG8_WAIT_L(0); PG8_MMA(0, 0, At, B0); PG8_BAR; PG8_SCHED;
            PG8_LDB(B1, 0, 1); PG8_STAGE(PG8_SB(0, 0), b2, voffB);
            PG8_BAR; PG8_WAIT_L(0); PG8_MMA(0, 1, At, B1); PG8_BAR;
            PG8_LDA(At, 0, 1); PG8_STAGE(PG8_SA(0, 0), a2, voffA);
            PG8_BAR; PG8_WAIT_L(0); PG8_MMA(1, 0, At, B0); PG8_BAR; PG8_SCHED;
            PG8_STAGE(PG8_SB(0, 1), b2 + hstep, voffB);
            PG8_WAIT_V(6); PG8_BAR; PG8_MMA(1, 1, At, B1); PG8_BAR;
            PG8_LDB(B0, 1, 0); PG8_SCHED; PG8_LDA(At, 1, 0); PG8_STAGE(PG8_SA(0, 1), a2 + hstep, voffA);
            PG8_WAIT_L(8); PG8_BAR; PG8_WAIT_L(0); PG8_MMA(0, 0, At, B0); PG8_BAR; PG8_SCHED;
            PG8_LDB(B1, 1, 1); PG8_STAGE(PG8_SB(1, 0), b3, voffB);
            PG8_BAR; PG8_WAIT_L(0); PG8_MMA(0, 1, At, B1); PG8_BAR;
            PG8_LDA(At, 1, 1); PG8_STAGE(PG8_SA(1, 0), a3, voffA);
            PG8_BAR; PG8_WAIT_L(0); PG8_MMA(1, 0, At, B0); PG8_BAR; PG8_SCHED;
            PG8_STAGE(PG8_SB(1, 1), b3 + hstep, voffB);
            PG8_WAIT_V(6); PG8_BAR; PG8_MMA(1, 1, At, B1); PG8_BAR;
            }
        }
        if constexpr (ALIGN_EPI) { if (wr == 0) PG8_BAR; }
        if constexpr (!Epi::AFTER_DRAIN) { E(acc, cur, wr, wc, fr, fq); S.done(cur); }
        if (!has_next) break;
#pragma unroll
        for (int a = 0; a < 2; ++a)
#pragma unroll
            for (int b = 0; b < 2; ++b)
#pragma unroll
                for (int m = 0; m < 4; ++m)
#pragma unroll
                    for (int n = 0; n < 2; ++n) acc[a][b][m][n] = (f32x4){0.f, 0.f, 0.f, 0.f};
        cur = nxt; cA = nA; cB = nB; ++ui;
        if constexpr (ALIGN_EPI) { if (wr == 1) PG8_BAR; }
    }
    PG8_WAIT_V(0);
    if constexpr (!ALIGN_EPI) { if (wr == 0) PG8_BAR; }
    PG8_BAR;
    if constexpr (Epi::AFTER_DRAIN) { E.fused(acc, cur, wr, wc, fr, fq, lds, wid, lane); S.done(cur); }
#undef PG8_SA
#undef PG8_SB
#undef PG8_STAGE
#undef PG8_LDA
#undef PG8_LDB
#undef PG8_MMA
#undef PG8_WAIT_V
#undef PG8_WAIT_L
#undef PG8_BAR
#undef PG8_SCHED
}
}

template <class Epi>
__device__ __forceinline__ void ngemm_unit(unsigned char* lds, const bf16* A, int lda, const bf16* Bt, int ldb, int K, const Epi& epi, const pg8::Unit& u) {
    float* As = (float*)lds; float* Bs = As + 32 * 256;
    const int tid = threadIdx.x, tr = tid >> 4, tc = tid & 15;
    float acc0[8][8], acc1[8][8];
#pragma unroll
    for (int i = 0; i < 8; ++i)
#pragma unroll
        for (int j = 0; j < 8; ++j) { acc0[i][j] = 0.f; acc1[i][j] = 0.f; }
    for (int k0 = 0; k0 < K; k0 += 32) {
        __syncthreads();
#pragma unroll
        for (int j = 0; j < 2; ++j) { const int pidx = tid + 512 * j, r = pidx & 255, kq = pidx >> 8;
            const u32x4 va = *(const u32x4*)(A + (size_t)r * lda + k0 + kq * 8);
            const u32x4 vb = *(const u32x4*)(Bt + (size_t)r * ldb + k0 + kq * 8);
            float* ap = As + (kq * 8) * 256 + r; float* bp = Bs + (kq * 8) * 256 + r;
            ap[0 * 256] = blo(va.x); ap[1 * 256] = bhi(va.x); ap[2 * 256] = blo(va.y); ap[3 * 256] = bhi(va.y); ap[4 * 256] = blo(va.z); ap[5 * 256] = bhi(va.z); ap[6 * 256] = blo(va.w); ap[7 * 256] = bhi(va.w);
            bp[0 * 256] = blo(vb.x); bp[1 * 256] = bhi(vb.x); bp[2 * 256] = blo(vb.y); bp[3 * 256] = bhi(vb.y); bp[4 * 256] = blo(vb.z); bp[5 * 256] = bhi(vb.z); bp[6 * 256] = blo(vb.w); bp[7 * 256] = bhi(vb.w); }
        __syncthreads();
#pragma unroll 2
        for (int kk = 0; kk < 32; ++kk) {
            const f32x4 a0 = *(const f32x4*)(As + kk * 256 + tr * 8), a1 = *(const f32x4*)(As + kk * 256 + tr * 8 + 4);
            const f32x4 b00 = *(const f32x4*)(Bs + kk * 256 + tc * 8), b01 = *(const f32x4*)(Bs + kk * 256 + tc * 8 + 4);
            const f32x4 b10 = *(const f32x4*)(Bs + kk * 256 + 128 + tc * 8), b11 = *(const f32x4*)(Bs + kk * 256 + 128 + tc * 8 + 4);
            const float a[8] = {a0.x, a0.y, a0.z, a0.w, a1.x, a1.y, a1.z, a1.w};
            const float b0[8] = {b00.x, b00.y, b00.z, b00.w, b01.x, b01.y, b01.z, b01.w};
            const float b1[8] = {b10.x, b10.y, b10.z, b10.w, b11.x, b11.y, b11.z, b11.w};
#pragma unroll
            for (int i = 0; i < 8; ++i)
#pragma unroll
                for (int j = 0; j < 8; ++j) { acc0[i][j] = fmaf(a[i], b0[j], acc0[i][j]); acc1[i][j] = fmaf(a[i], b1[j], acc1[i][j]); }
        }
    }
#pragma unroll
    for (int i = 0; i < 8; ++i) epi(u, tr * 8 + i, tc * 8, acc0[i], acc1[i]);
}

__device__ __forceinline__ void store8_bf16(bf16* dst, const float (&v)[8]) {
    u32x4 o; o.x = pk2(v[0], v[1]); o.y = pk2(v[2], v[3]); o.z = pk2(v[4], v[5]); o.w = pk2(v[6], v[7]); *(u32x4*)dst = o;
}

typedef pg8::Unit Unit;
struct EpiProj { bf16* O;
    __device__ __forceinline__ void operator()(const Unit& u, int r, int c8, const float (&v0)[8], const float (&v1)[8]) const {
        bf16* row = O + (size_t)(u.pm * 256 + r) * NP + u.pn * 256 + c8; store8_bf16(row, v0); store8_bf16(row + 128, v1); } };
struct EpiOut { const float* x; const float* gffn; float* H2; bf16* XN2;
    __device__ __forceinline__ void operator()(const Unit& u, int r, int c8, const float (&v0)[8], const float (&v1)[8]) const {
        const int col = u.pn * 256 + c8; const size_t off = (size_t)(u.pm * 256 + r) * D + col; float h0[8], h1[8], n0[8], n1[8];
        const f32x4 xa = *(const f32x4*)(x + off), xb = *(const f32x4*)(x + off + 4), xc = *(const f32x4*)(x + off + 128), xd = *(const f32x4*)(x + off + 132);
        const f32x4 ga = *(const f32x4*)(gffn + col), gb = *(const f32x4*)(gffn + col + 4), gc = *(const f32x4*)(gffn + col + 128), gd = *(const f32x4*)(gffn + col + 132);
        const float xs0[8] = {xa.x, xa.y, xa.z, xa.w, xb.x, xb.y, xb.z, xb.w}, xs1[8] = {xc.x, xc.y, xc.z, xc.w, xd.x, xd.y, xd.z, xd.w};
        const float gs0[8] = {ga.x, ga.y, ga.z, ga.w, gb.x, gb.y, gb.z, gb.w}, gs1[8] = {gc.x, gc.y, gc.z, gc.w, gd.x, gd.y, gd.z, gd.w};
#pragma unroll
        for (int i = 0; i < 8; ++i) { h0[i] = xs0[i] + v0[i]; h1[i] = xs1[i] + v1[i]; n0[i] = h0[i] * gs0[i]; n1[i] = h1[i] * gs1[i]; }
        *(f32x4*)(H2 + off) = (f32x4){h0[0], h0[1], h0[2], h0[3]}; *(f32x4*)(H2 + off + 4) = (f32x4){h0[4], h0[5], h0[6], h0[7]};
        *(f32x4*)(H2 + off + 128) = (f32x4){h1[0], h1[1], h1[2], h1[3]}; *(f32x4*)(H2 + off + 132) = (f32x4){h1[4], h1[5], h1[6], h1[7]};
        store8_bf16(XN2 + off, n0); store8_bf16(XN2 + off + 128, n1); } };
struct EpiGU { const float* bgu; const float* rowrstd; bf16* HDN; const LAS int* tile_e;
    __device__ __forceinline__ void operator()(const Unit& u, int r, int c8, const float (&v0)[8], const float (&v1)[8]) const {
        const int e = tile_e[u.pm]; const int row = u.pm * 256 + r; const float rs = rowrstd[row]; const int cb = u.pn * 128 + c8; float h[8];
        const float* bg = bgu + e * 2048 + cb; const f32x4 ba = *(const f32x4*)bg, bb = *(const f32x4*)(bg + 4), bc = *(const f32x4*)(bg + 1024), bd_ = *(const f32x4*)(bg + 1028);
        const float b0[8] = {ba.x, ba.y, ba.z, ba.w, bb.x, bb.y, bb.z, bb.w}, b1[8] = {bc.x, bc.y, bc.z, bc.w, bd_.x, bd_.y, bd_.z, bd_.w};
#pragma unroll
        for (int i = 0; i < 8; ++i) { float g = v0[i] * rs + b0[i]; float uu = v1[i] * rs + b1[i];
            g = fminf(g, 7.f); uu = fminf(fmaxf(uu, -7.f), 7.f); h[i] = g * sigmoidf_(1.702f * g) * (uu + 1.f); }
        store8_bf16(HDN + (size_t)row * DE + cb, h); } };
struct EpiDown { const float* bd; const float* rowgate; bf16* YS; const LAS int* tile_e;
    __device__ __forceinline__ void operator()(const Unit& u, int r, int c8, const float (&v0)[8], const float (&v1)[8]) const {
        const int e = tile_e[u.pm]; const int row = u.pm * 256 + r; const float gt = rowgate[row]; const int cb = u.pn * 256 + c8; float y0[8], y1[8];
        const float* bp = bd + e * D + cb; const f32x4 ba = *(const f32x4*)bp, bb = *(const f32x4*)(bp + 4), bc = *(const f32x4*)(bp + 128), bd_ = *(const f32x4*)(bp + 132);
        const float b0[8] = {ba.x, ba.y, ba.z, ba.w, bb.x, bb.y, bb.z, bb.w}, b1[8] = {bc.x, bc.y, bc.z, bc.w, bd_.x, bd_.y, bd_.z, bd_.w};
#pragma unroll
        for (int i = 0; i < 8; ++i) { y0[i] = (v0[i] + b0[i]) * gt; y1[i] = (v1[i] + b1[i]) * gt; }
        store8_bf16(YS + (size_t)row * D + cb, y0); store8_bf16(YS + (size_t)row * D + cb + 128, y1); } };

template <class F> struct EpiAdapt {
    static constexpr bool PERM = true, AFTER_DRAIN = false; F f;
    __device__ __forceinline__ void operator()(const f32x4 (&acc)[2][2][4][2], const Unit& u, int wr, int wc, int fr, int fq) const {
#pragma unroll
        for (int ai = 0; ai < 2; ++ai)
#pragma unroll
            for (int m = 0; m < 4; ++m) { const int r = ai * 128 + wr * 64 + m * 16 + fr, c8 = wc * 32 + fq * 8;
                const f32x4 a = acc[ai][0][m][0], b = acc[ai][0][m][1], c = acc[ai][1][m][0], d = acc[ai][1][m][1];
                const float v0[8] = {a.x, a.y, a.z, a.w, b.x, b.y, b.z, b.w}, v1[8] = {c.x, c.y, c.z, c.w, d.x, d.y, d.z, d.w};
                f(u, r, c8, v0, v1); }
    }
};
struct MoeOrder { pg8::StaticOrder so; const LAS int* tile_e; int ncol;
    __device__ __forceinline__ bool next(int i, Unit& u) const { return so.next(i, u); }
    __device__ __forceinline__ int bidx(const Unit& u) const { return tile_e[u.pm] * ncol + u.pn; }
    __device__ __forceinline__ void a_ready(const Unit&) const {}
    __device__ __forceinline__ void done(const Unit&) const {} };

__device__ __forceinline__ void phase_ew_naive(const Params& p, unsigned char* lds) {
    const int tid = threadIdx.x, lane = tid & 63, wave = tid >> 6;
    bf16* PROJ = (bf16*)(p.ws + WS_PROJ); bf16* MIX = (bf16*)(p.ws + WS_MIX); bf16* KI = (bf16*)(p.ws + WS_KI); bf16* QL = (bf16*)(p.ws + WS_QL); float* WI = (float*)(p.ws + WS_WI);
    const float* COS = (const float*)(p.ws + WS_COS); const float* SIN = (const float*)(p.ws + WS_SIN);
    float* red = (float*)(lds);
    for (int t = blockIdx.x; t < S; t += gridDim.x) {
        const int c = tid; float acc = p.conv_b[c];
        for (int j = 0; j < CW; ++j) { const int tt = t - (CW - 1) + j; if (tt >= 0) { const float val = bf2f(PROJ[(size_t)tt * NP + C_VAL + c]), gate = bf2f(PROJ[(size_t)tt * NP + C_GATE + c]);
                acc = fmaf(p.conv_w[j * CC + c], val * sigmoidf_(gate), acc); } }
        const int hh = (tid & 255) >> 5, ii = tid & 31; const int qkbase = (tid < 256) ? C_Q : C_K;
        const float cs = COS[t * 32 + ii], sn = SIN[t * 32 + ii];
        const float x1 = bf2f(PROJ[(size_t)t * NP + qkbase + hh * 64 + ii]), x2 = bf2f(PROJ[(size_t)t * NP + qkbase + hh * 64 + 32 + ii]);
        float qi1 = 0.f, qi2 = 0.f; if (tid < 256) { qi1 = bf2f(PROJ[(size_t)t * NP + C_QI + hh * 64 + ii]); qi2 = bf2f(PROJ[(size_t)t * NP + C_QI + hh * 64 + 32 + ii]); }
        float kiv = 0.f, qlv = 0.f;
        if (wave == 4) kiv = bf2f(PROJ[(size_t)t * NP + C_KI + lane]);
        if (wave == 5) { for (int h = 0; h < 8; ++h) qlv = fmaf(bf2f(PROJ[(size_t)t * NP + C_WI + h]), bf2f(PROJ[(size_t)t * NP + C_QI + h * 64 + lane]), qlv); }
        float wiv = 0.f; if (wave == 6 && lane < 8) wiv = bf2f(PROJ[(size_t)t * NP + C_WI + lane]);
        float s1 = wave_sum(acc); if (lane == 0) red[wave] = s1; __syncthreads();
        float mean = 0.f;
#pragma unroll
        for (int w = 0; w < 8; ++w) mean += red[w];
        mean *= (1.f / CC); const float dv = acc - mean; float s2 = wave_sum(dv * dv); if (lane == 0) red[8 + wave] = s2; __syncthreads();
        float var = 0.f;
#pragma unroll
        for (int w = 0; w < 8; ++w) var += red[8 + w];
        var *= (1.f / CC);
        const float y = dv * rsqrtf(var + EPS) * p.conv_ng[c] + p.conv_nb[c];
        MIX[(size_t)t * D + c] = (bf16)f2bf(y * sigmoidf_(y));
        { const float sc = (tid < 256) ? C2 : 1.f; PROJ[(size_t)t * NP + qkbase + hh * 64 + ii] = (bf16)f2bf((x1 * cs - x2 * sn) * sc); PROJ[(size_t)t * NP + qkbase + hh * 64 + 32 + ii] = (bf16)f2bf((x2 * cs + x1 * sn) * sc); }
        if (tid < 256) { PROJ[(size_t)t * NP + C_QI + hh * 64 + ii] = (bf16)f2bf(qi1 * cs - qi2 * sn); PROJ[(size_t)t * NP + C_QI + hh * 64 + 32 + ii] = (bf16)f2bf(qi2 * cs + qi1 * sn); }
        if (wave == 4) { const float m = wave_sum(kiv) * (1.f / 64.f); const float d = kiv - m; const float vr = wave_sum(d * d) * (1.f / 64.f);
            const float yk = d * rsqrtf(vr + EPS) * p.idx_g[lane] + p.idx_b[lane]; const float other = __shfl_xor(yk, 32);
            const float c_ = COS[t * 32 + (lane & 31)], s_ = SIN[t * 32 + (lane & 31)];
            KI[(size_t)t * 64 + lane] = (bf16)f2bf(lane < 32 ? (yk * c_ - other * s_) : (yk * c_ + other * s_)); }
        if (wave == 5) { const float other = __shfl_xor(qlv, 32); const float c_ = COS[t * 32 + (lane & 31)], s_ = SIN[t * 32 + (lane & 31)];
            QL[(size_t)t * 64 + lane] = (bf16)f2bf(lane < 32 ? (qlv * c_ - other * s_) : (qlv * c_ + other * s_)); }
        if (wave == 6 && lane < 8) WI[t * 8 + lane] = wiv;
        __syncthreads();
    }
}

__device__ __forceinline__ unsigned fkey(float f) { unsigned u = __float_as_uint(f); if (u == 0x80000000u) u = 0u; return (u & 0x80000000u) ? ~u : (u | 0x80000000u); }
__device__ __forceinline__ void phase_idx_naive(const Params& p, unsigned char* lds) {
    const int tid = threadIdx.x, lane = tid & 63, wave = tid >> 6;
    const bf16* PROJ = (const bf16*)(p.ws + WS_PROJ); const bf16* KI = (const bf16*)(p.ws + WS_KI); const float* WI = (const float*)(p.ws + WS_WI);
    u64* MASK = (u64*)(p.ws + WS_MASK);
    float* scores = (float*)lds;
    float* qif = (float*)(lds + 65536);
    float* wf = (float*)(lds + 65536 + 2048);
    unsigned* hist = (unsigned*)(lds + 65536 + 4096);
    u64* tiebits = (u64*)(lds + 65536 + 8192);
    int* sh = (int*)(lds + 65536 + 12288);
    for (int t = blockIdx.x; t < S; t += gridDim.x) {
        const int tq = t >> 6, nadm = 64 * (tq + 1), ntw = 4 * (t >> 8) + 4;
        __syncthreads();
        if (nadm <= KSEL) {
            if (tid < ntw) MASK[(size_t)tid * S + t] = (tid <= tq) ? ~0ull : 0ull;
            continue;
        }
        qif[tid] = bf2f(PROJ[(size_t)t * NP + C_QI + tid]); if (tid < 8) wf[tid] = WI[t * 8 + tid];
        __syncthreads();
        for (int s = tid; s < nadm; s += NTHREADS) {
            float kf[64];
#pragma unroll
            for (int j = 0; j < 8; ++j) { const u32x4 v = *(const u32x4*)(KI + (size_t)s * 64 + j * 8);
                kf[j * 8 + 0] = blo(v.x); kf[j * 8 + 1] = bhi(v.x); kf[j * 8 + 2] = blo(v.y); kf[j * 8 + 3] = bhi(v.y); kf[j * 8 + 4] = blo(v.z); kf[j * 8 + 5] = bhi(v.z); kf[j * 8 + 6] = blo(v.w); kf[j * 8 + 7] = bhi(v.w); }
            float I = 0.f;
            for (int h = 0; h < 8; ++h) { float d = 0.f;
#pragma unroll
                for (int k = 0; k < 64; k += 4) { const f32x4 q4 = *(const f32x4*)(qif + h * 64 + k); d = fmaf(q4.x, kf[k], d); d = fmaf(q4.y, kf[k + 1], d); d = fmaf(q4.z, kf[k + 2], d); d = fmaf(q4.w, kf[k + 3], d); }
                I = fmaf(wf[h], fmaxf(d, 0.f), I); }
            scores[s] = I;
        }
        __syncthreads();
        unsigned prefix = 0; int kk = KSEL;
        for (int ps = 0; ps < 4; ++ps) {
            const int shift = 24 - 8 * ps;
            if (tid < 256) hist[tid] = 0u;
            __syncthreads();
            for (int s = tid; s < nadm; s += NTHREADS) { const unsigned key = fkey(scores[s]); if (ps == 0 || (key >> (shift + 8)) == prefix) atomicAdd(&hist[(key >> shift) & 255u], 1u); }
            __syncthreads();
            if (wave == 0) {
                unsigned c4[4]; unsigned tot = 0;
#pragma unroll
                for (int j = 0; j < 4; ++j) { c4[j] = hist[255 - (4 * lane + j)]; tot += c4[j]; }
                unsigned incl = tot;
#pragma unroll
                for (int o = 1; o < 64; o <<= 1) { const unsigned v = __shfl_up(incl, o); if (lane >= o) incl += v; }
                const unsigned excl = incl - tot;
                if (excl < (unsigned)kk && (unsigned)kk <= incl) { const unsigned s0 = excl + c4[0], s1 = s0 + c4[1], s2 = s1 + c4[2]; const unsigned ukk = (unsigned)kk;
                    const int j = ukk <= s0 ? 0 : ukk <= s1 ? 1 : ukk <= s2 ? 2 : 3; const unsigned cum = ukk <= s0 ? excl : ukk <= s1 ? s0 : ukk <= s2 ? s1 : s2;
                    sh[0] = 255 - (4 * lane + j); sh[1] = kk - (int)cum; }
            }
            __syncthreads();
            prefix = (prefix << 8) | (unsigned)sh[0]; kk = sh[1];
            __syncthreads();
        }
        const unsigned T = prefix;
        if (wave == 0) { int run = 0;
            for (int tile = 0; tile <= tq; ++tile) { const bool tie = fkey(scores[tile * 64 + lane]) == T; const u64 bal = __ballot(tie);
                const int rank = run + __popcll(bal & ((1ull << lane) - 1ull)); const u64 tb = __ballot(tie && rank < kk); if (lane == 0) tiebits[tile] = tb; run += __popcll(bal); } }
        __syncthreads();
        for (int tile = wave; tile < ntw; tile += NWAVES) { u64 w = 0ull;
            if (tile <= tq) { w = __ballot(fkey(scores[tile * 64 + lane]) > T) | tiebits[tile]; }
            if (lane == 0) MASK[(size_t)tile * S + t] = w; }
    }
}

__device__ __forceinline__ void phase_att_naive(const Params& p, unsigned char* lds) {
    const int tid = threadIdx.x, lane = tid & 63, wave = tid >> 6;
    const bf16* PROJ = (const bf16*)(p.ws + WS_PROJ); bf16* MIX = (bf16*)(p.ws + WS_MIX); const u64* MASK = (const u64*)(p.ws + WS_MASK);
    int* sidx = (int*)(lds + wave * 2048); float* slog = (float*)(lds + wave * 2048 + 1024);
    const int h = wave;
    for (int t = blockIdx.x; t < S; t += gridDim.x) {
        const int tq = t >> 6;
        float qf[64];
#pragma unroll
        for (int j = 0; j < 8; ++j) { const u32x4 v = *(const u32x4*)(PROJ + (size_t)t * NP + C_Q + h * 64 + j * 8);
            qf[j * 8 + 0] = blo(v.x); qf[j * 8 + 1] = bhi(v.x); qf[j * 8 + 2] = blo(v.y); qf[j * 8 + 3] = bhi(v.y); qf[j * 8 + 4] = blo(v.z); qf[j * 8 + 5] = bhi(v.z); qf[j * 8 + 6] = blo(v.w); qf[j * 8 + 7] = bhi(v.w); }
        int n = 0;
        for (int tile = 0; tile <= tq; ++tile) {
            const u64 w = MASK[(size_t)tile * S + t]; const bool sel = (w >> lane) & 1ull;
            if (w == 0ull) continue;
            float lg = 0.f; const int s = tile * 64 + lane;
            if (sel) {
#pragma unroll
                for (int j = 0; j < 8; ++j) { const u32x4 v = *(const u32x4*)(PROJ + (size_t)s * NP + C_K + h * 64 + j * 8);
                    lg = fmaf(qf[j * 8 + 0], blo(v.x), lg); lg = fmaf(qf[j * 8 + 1], bhi(v.x), lg); lg = fmaf(qf[j * 8 + 2], blo(v.y), lg); lg = fmaf(qf[j * 8 + 3], bhi(v.y), lg);
                    lg = fmaf(qf[j * 8 + 4], blo(v.z), lg); lg = fmaf(qf[j * 8 + 5], bhi(v.z), lg); lg = fmaf(qf[j * 8 + 6], blo(v.w), lg); lg = fmaf(qf[j * 8 + 7], bhi(v.w), lg); }
                const int pos = n + __popcll(w & ((1ull << lane) - 1ull));
                if (pos < 256) { sidx[pos] = s; slog[pos] = lg; }
            }
            n += __popcll(w);
        }
        if (n > 256) n = 256;
        __builtin_amdgcn_s_waitcnt(0); asm volatile("" ::: "memory");
        float m = -INFINITY; for (int j = lane; j < n; j += 64) m = fmaxf(m, slog[j]);
        m = wave_max(m);
        float l = 0.f; for (int j = lane; j < n; j += 64) { const float pj = exp2f(slog[j] - m); slog[j] = pj; l += pj; }
        l = wave_sum(l);
        __builtin_amdgcn_s_waitcnt(0); asm volatile("" ::: "memory");
        float o = 0.f;
        for (int j = 0; j < n; ++j) o = fmaf(slog[j], bf2f(PROJ[(size_t)sidx[j] * NP + C_V + h * 64 + lane]), o);
        MIX[(size_t)t * D + 512 + h * 64 + lane] = (bf16)f2bf(o / l);
        __builtin_amdgcn_s_waitcnt(0); asm volatile("" ::: "memory");
    }
}

namespace attn_body {
using bf16=__hip_bfloat16;
using bf16x8=__attribute__((ext_vector_type(8)))short;
using s16x4=__attribute__((ext_vector_type(4)))short;
using f32x16=__attribute__((ext_vector_type(16)))float;
using u32x4=__attribute__((ext_vector_type(4)))unsigned;
constexpr int NHEAD=8,SEQ=16384,D=64,DMI=3328,DMO=1024;
typedef unsigned long long u64;
constexpr int NW=8,QBLK=32,QB=QBLK*NW,KVBLK=64,NQB=SEQ/QB;
__device__ __forceinline__ int crow(int r,int hi){return (r&3)+8*(r>>2)+4*hi;}
#define SBAR() __builtin_amdgcn_sched_barrier(0)
__device__ __forceinline__ void cmask(f32x16&p0,f32x16&p1,int jb,int qrel,int hi){
  const float NEG=-INFINITY; int kb=64*jb+4*hi;
  #pragma unroll
  for(int r=0;r<16;++r){int kv=kb+(r&3)+8*(r>>2); if(kv>qrel)p0[r]=NEG; if(kv+32>qrel)p1[r]=NEG;}
}

constexpr int NSLOT=3, SLOTB=8192;
constexpr int LDS_K=0, LDS_V=NSLOT*SLOTB, LDS_WS=2*NSLOT*SLOTB, LDS_OST=LDS_WS+NW*64*4, LDS_M=LDS_OST+NW*4096, LDS_BYTES=LDS_M+NW*2048;
constexpr float C2=0.125f*1.4426950408889634f;
__device__ __forceinline__ void glds16s(const void*sbase,unsigned voff,unsigned lds_dst){unsigned keep;
  asm volatile("s_mov_b32 %0, m0\n\ts_mov_b32 m0, %3\n\ts_nop 0\n\tglobal_load_lds_dwordx4 %1, %2\n\ts_mov_b32 m0, %0":"=&s"(keep):"v"(voff),"s"(sbase),"s"(lds_dst):"memory");}
__device__ __forceinline__ void glds16(const void*gsrc,unsigned lds_dst){unsigned keep;
  asm volatile("s_mov_b32 %0, m0\n\ts_mov_b32 m0, %2\n\ts_nop 0\n\tglobal_load_lds_dwordx4 %1, off\n\ts_mov_b32 m0, %0":"=&s"(keep):"v"(gsrc),"s"(lds_dst):"memory");}
__device__ __forceinline__ float max3f(float a,float b,float c){float r;asm("v_max3_f32 %0, %1, %2, %3":"=v"(r):"v"(a),"v"(b),"v"(c));return r;}
__device__ __forceinline__ float max2f(float a,float b){float r;asm("v_max_f32_e32 %0, %1, %2":"=v"(r):"v"(a),"v"(b));return r;}
__device__ __forceinline__ float fadd_s(float a,float b){float r;asm("v_add_f32_e32 %0, %1, %2":"=v"(r):"v"(a),"v"(b));return r;}
__device__ __forceinline__ float fsub_s(float a,float b){float r;asm("v_sub_f32_e32 %0, %1, %2":"=v"(r):"v"(a),"v"(b));return r;}
typedef float f32x2_t __attribute__((ext_vector_type(2))); typedef __bf16 bf16x2_t __attribute__((ext_vector_type(2)));
__device__ __forceinline__ unsigned cvtpk_s(float lo,float hi){f32x2_t v={lo,hi};bf16x2_t b=__builtin_convertvector(v,bf16x2_t);return __builtin_bit_cast(unsigned,b);}
#define WAIT_BAR(N) asm volatile("s_waitcnt vmcnt(" #N ") lgkmcnt(0)\n\ts_barrier":::"memory")

__device__ __forceinline__ void qkt(f32x16&p0,f32x16&p1,const char*Kslot,const bf16x8*qr,int r32,int hi){ const f32x16 negm=f32x16{};
  const char*kb=Kslot+hi*1024+r32*16;
  #pragma unroll
  for(int d0=0;d0<4;++d0){
    const bf16x8 b0=*reinterpret_cast<const bf16x8*>(kb+d0*2048);
    const bf16x8 b1=*reinterpret_cast<const bf16x8*>(kb+d0*2048+512);
    if(d0==0){p0=__builtin_amdgcn_mfma_f32_32x32x16_bf16(b0,qr[0],negm,0,0,0);p1=__builtin_amdgcn_mfma_f32_32x32x16_bf16(b1,qr[0],negm,0,0,0);}
    else{p0=__builtin_amdgcn_mfma_f32_32x32x16_bf16(b0,qr[d0],p0,0,0,0);p1=__builtin_amdgcn_mfma_f32_32x32x16_bf16(b1,qr[d0],p1,0,0,0);}}
}
typedef __attribute__((address_space(3))) const char* lds_cptr;
typedef short v4i16_t __attribute__((ext_vector_type(4)));
__device__ __forceinline__ void kload8(bf16x8*kf,lds_cptr kp){
  kf[0]=*(const __attribute__((address_space(3))) bf16x8*)(kp);      kf[1]=*(const __attribute__((address_space(3))) bf16x8*)(kp+512);
  kf[2]=*(const __attribute__((address_space(3))) bf16x8*)(kp+2048); kf[3]=*(const __attribute__((address_space(3))) bf16x8*)(kp+2560);
  kf[4]=*(const __attribute__((address_space(3))) bf16x8*)(kp+4096); kf[5]=*(const __attribute__((address_space(3))) bf16x8*)(kp+4608);
  kf[6]=*(const __attribute__((address_space(3))) bf16x8*)(kp+6144); kf[7]=*(const __attribute__((address_space(3))) bf16x8*)(kp+6656);
}
__device__ __forceinline__ void kload2(bf16x8*kf,lds_cptr kp,int j){ kf[2*j]=*(const __attribute__((address_space(3))) bf16x8*)(kp+j*2048); kf[2*j+1]=*(const __attribute__((address_space(3))) bf16x8*)(kp+j*2048+512); }
__device__ __forceinline__ s16x4 vtr(lds_cptr p){ return __builtin_bit_cast(s16x4,__builtin_amdgcn_ds_read_tr16_b64_v4i16((__attribute__((address_space(3))) v4i16_t*)p)); }
__device__ __forceinline__ float rowmax(const f32x16&p0,const f32x16&p1){
  float a=max3f(p0[0],p0[1],p1[0]),b=max3f(p0[2],p0[3],p1[1]);a=max3f(a,p1[2],p1[3]);
  #pragma unroll
  for(int r=4;r<16;r+=4){a=max3f(a,p0[r],p0[r+1]);b=max3f(b,p0[r+2],p0[r+3]);a=max3f(a,p1[r],p1[r+1]);b=max3f(b,p1[r+2],p1[r+3]);}
  const float m=max2f(a,b);
  auto rr=__builtin_amdgcn_permlane32_swap(__float_as_uint(m),__float_as_uint(m),false,false);
  return max2f(__uint_as_float(rr[0]),__uint_as_float(rr[1]));
}
__device__ __forceinline__ void pv(f32x16*o,int vb,bf16x8 pa0,bf16x8 pa1,bf16x8 pa2,bf16x8 pa3){
  #pragma unroll
  for(int d0=0;d0<2;++d0){s16x4 lo[4],hi[4];
    #pragma unroll
    for(int ks=0;ks<4;++ks){
      asm volatile("ds_read_b64_tr_b16 %0,%1 offset:%c2":"=&v"(lo[ks]):"v"(vb),"i"(d0*4096+ks*1024):"memory");
      asm volatile("ds_read_b64_tr_b16 %0,%1 offset:%c2":"=&v"(hi[ks]):"v"(vb),"i"(d0*4096+ks*1024+512):"memory");}
    asm volatile("s_waitcnt lgkmcnt(0)":::"memory");SBAR();
    #define PK(k) (bf16x8){lo[k][0],lo[k][1],lo[k][2],lo[k][3],hi[k][0],hi[k][1],hi[k][2],hi[k][3]}
    o[d0]=__builtin_amdgcn_mfma_f32_32x32x16_bf16(pa0,PK(0),o[d0],0,0,0);
    o[d0]=__builtin_amdgcn_mfma_f32_32x32x16_bf16(pa1,PK(1),o[d0],0,0,0);
    o[d0]=__builtin_amdgcn_mfma_f32_32x32x16_bf16(pa2,PK(2),o[d0],0,0,0);
    o[d0]=__builtin_amdgcn_mfma_f32_32x32x16_bf16(pa3,PK(3),o[d0],0,0,0);
    #undef PK
  }
}

#ifndef ATTN_STORE16
#define ATTN_STORE16(p,v) (*(u32x4*)(p)=(v))
#endif
template<int THRL> __device__ __forceinline__ void attn_unit(int h,int qb,const bf16*Q,const bf16*__restrict__ K,const bf16*__restrict__ V,const u64*__restrict__ MASK,bf16*O,char*shm){
  int tid_=threadIdx.x; asm volatile("":"+v"(tid_)); const int tid=tid_,lane=tid&63,r32=lane&31,hi=lane>>5; const int wid=__builtin_amdgcn_readfirstlane(tid>>6);
  const long rowbase=0; const int q0=qb*QB;
  const bf16*Qw=Q+(rowbase+q0+wid*QBLK)*DMI+h*D;
  const bf16*Kh=K+rowbase*DMI+h*D,*Vh=V+rowbase*DMI+h*D;
  const unsigned lds0=(unsigned)(uintptr_t)shm;
  float*wsf=(float*)(shm+LDS_WS)+wid*64;
  const unsigned koff=(unsigned)(lane*DMI+wid*8)*2u;
  const unsigned voffv=(unsigned)((16*(wid&3)+(lane>>2))*DMI+(wid>>2)*32+(lane&3)*8)*2u;
  const unsigned kdst=lds0+LDS_K+wid*1024, vdst=lds0+LDS_V+wid*1024;
  const u64*mbase=MASK+q0+wid*QBLK; const int jm=lane>>4; const unsigned mdst=lds0+LDS_M+wid*2048; const unsigned moff0=(unsigned)(lane&15)*16u, moff1=moff0+((jm==1)?(unsigned)SEQ*8u:0u);
  #define DMA_M2(tA,tB,slot) glds16s(mbase+(size_t)(tA)*SEQ,((tB)!=(tA))?moff1:moff0,(unsigned)__builtin_amdgcn_readfirstlane(mdst+(slot)))
  const unsigned sh4=4u*(unsigned)hi; const float NEGINF=-INFINITY;
  #define MAPPLY(C0,C1,MW) do{ const unsigned lo_=(unsigned)(MW)>>sh4, hi_=(unsigned)((MW)>>32)>>sh4; \
    _Pragma("unroll") for(int r=0;r<16;++r){ const unsigned bit_=1u<<((r&3)+8*(r>>2)); C0[r]=(lo_&bit_)?C0[r]:NEGINF; C1[r]=(hi_&bit_)?C1[r]:NEGINF; } }while(0)
  #define DMA_K(t,slot) glds16s(Kh+(long)(t)*KVBLK*DMI,koff,(unsigned)__builtin_amdgcn_readfirstlane(kdst+(slot)))
  #define DMA_V(t,slot) glds16s(Vh+(long)(t)*KVBLK*DMI,voffv,(unsigned)__builtin_amdgcn_readfirstlane(vdst+(slot)))
  const int vb0=(int)(lds0+LDS_V)+((lane>>4)&1)*32+(lane&3)*8+(4*hi+((lane&15)>>2))*64;
  const char*Kbase=shm+LDS_K; bf16x8 kf[8];
  const lds_cptr shm3=(lds_cptr)shm; const lds_cptr mp0=shm3+LDS_M+wid*2048+r32*8;
  #define MLD(off) (*(const __attribute__((address_space(3))) u64*)(mp0+(off)))
  const lds_cptr kp0=shm3+LDS_K+hi*1024+r32*16; const lds_cptr vp0=shm3+LDS_V+((lane>>4)&1)*32+(lane&3)*8+(4*hi+((lane&15)>>2))*64;
  const int NT=(q0+QB)/KVBLK;
  glds16s(mbase,moff0+((jm==0)?(unsigned)SEQ*8u:(jm==1)?(unsigned)SEQ*16u:0u),(unsigned)__builtin_amdgcn_readfirstlane(mdst));
  DMA_K(0,0);DMA_V(0,0);DMA_K(1,SLOTB);
  bf16x8 qr[4];
  #pragma unroll
  for(int d0=0;d0<4;++d0)qr[d0]=*reinterpret_cast<const bf16x8*>(&Qw[(long)r32*DMI+d0*16+hi*8]);
  float mhat=0.f,l_reg=0.f;f32x16 o[2];o[0]=f32x16{};o[1]=f32x16{};const f32x16 Z16=f32x16{};
  bool resc=false;
  #define START(P0,P1,MW) do{ const float rm=rowmax(P0,P1); resc=false; \
    if(__builtin_expect(__any(rm>(float)THRL),0)){ const float dl=__builtin_fmaxf(rm,0.f); mhat+=dl; \
      _Pragma("unroll") for(int r=0;r<16;++r){P0[r]-=dl;P1[r]-=dl;} } \
    MAPPLY(P0,P1,MW); \
    _Pragma("unroll") for(int r=0;r<16;++r)P0[r]=__builtin_amdgcn_exp2f(P0[r]); }while(0)
  #define RESC() do{ if(resc){ asm volatile("s_waitcnt lgkmcnt(0)":::"memory"); \
      _Pragma("unroll") for(int d_=0;d_<2;++d_) _Pragma("unroll") for(int r=0;r<16;++r)o[d_][r]*=wsf[crow(r,hi)]; } }while(0)
  f32x16 pA0,pA1,pB0,pB1;
  int sl_prev=0,sl_cur=0,sl_next=SLOTB;
  #define ROT() do{sl_prev=sl_cur;sl_cur=sl_next;sl_next=(sl_next==(NSLOT-1)*SLOTB)?0:sl_next+SLOTB;}while(0)
  DMA_K(2,2*SLOTB);
  WAIT_BAR(3);
  const u64 mw0=MLD(512);
  qkt(pA0,pA1,Kbase,qr,r32,hi);asm volatile("s_nop 15\n\ts_nop 7":"+v"(pA0),"+v"(pA1));
  START(pA0,pA1,mw0);
  _Pragma("unroll") for(int r=0;r<16;++r)pA1[r]=__builtin_amdgcn_exp2f(pA1[r]);
  WAIT_BAR(0);
  DMA_K(3,0);DMA_V(1,SLOTB);
  ROT();
  kload8(kf,kp0+sl_cur);
  WAIT_BAR(2);
  s16x4 vlo[8],vhi[8]; u32x4 pw0,pw1,pw2,pw3;
  #define PKW(P,B) cvtpk_s(P[B],P[B+1])
  #define PAF(k) __builtin_bit_cast(bf16x8,pw##k)
  #define VFR(i) (bf16x8){vlo[i][0],vlo[i][1],vlo[i][2],vlo[i][3],vhi[i][0],vhi[i][1],vhi[i][2],vhi[i][3]}
  #define PIN(x) asm volatile("":"+v"(x))
  #define MX3(a,b,c) __builtin_fmaxf(__builtin_fmaxf((a),(b)),(c))
  #define GAPA(MF,A0,A1,A2,A3,W0,W1,PW) do{ MF; sacc+=A0; sacc+=A1; sacc+=A2; sacc+=A3; PIN(sacc); W0; W1; PIN(PW); SBAR(); }while(0)
  #define EX(v) __builtin_amdgcn_exp2f(v)
  #define GAPB(MF,X,B) do{ MF; X[B]=EX(X[B]); X[B+1]=EX(X[B+1]); X[B+2]=EX(X[B+2]); X[B+3]=EX(X[B+3]); PIN(X); SBAR(); }while(0)
  #define VRD(i) do{ vlo[i]=vtr(vp_+(((i)>>2)*4096+((i)&3)*1024)); vhi[i]=vtr(vp_+(((i)>>2)*4096+((i)&3)*1024+512)); }while(0)
  #define KRD(G,j) do{ if(G){ kload2(kf,kp0+sl_next,j); SBAR(); } }while(0)
  #define STEP(C0,C1,P0,P1,t,GK,GV,GL,GM,MOFF) do{ SBAR(); \
    const lds_cptr vp_=vp0+sl_prev; \
    VRD(0); SBAR(); float sacc=(P0[0]+P0[1]); \
    GAPA(C0=__builtin_amdgcn_mfma_f32_32x32x16_bf16(kf[0],qr[0],Z16,0,0,0), P0[2],P0[3],P0[4],P0[5],     pw0[0]=PKW(P0,0), pw0[1]=PKW(P0,2), pw0); \
    VRD(4); SBAR(); GAPA(C1=__builtin_amdgcn_mfma_f32_32x32x16_bf16(kf[1],qr[0],Z16,0,0,0), P0[6],P0[7],P0[8],P0[9],     pw0[2]=PKW(P0,4), pw0[3]=PKW(P0,6), pw0); \
    VRD(1); SBAR(); GAPA(C0=__builtin_amdgcn_mfma_f32_32x32x16_bf16(kf[2],qr[1],C0,0,0,0),   P0[10],P0[11],P0[12],P0[13], pw1[0]=PKW(P0,8), pw1[1]=PKW(P0,10), pw1); \
    VRD(5); SBAR(); GAPA(C1=__builtin_amdgcn_mfma_f32_32x32x16_bf16(kf[3],qr[1],C1,0,0,0),   P0[14],P0[15],P1[0],P1[1],   pw1[2]=PKW(P0,12),pw1[3]=PKW(P0,14), pw1); \
    VRD(2); SBAR(); GAPA(C0=__builtin_amdgcn_mfma_f32_32x32x16_bf16(kf[4],qr[2],C0,0,0,0),   P1[2],P1[3],P1[4],P1[5],     pw2[0]=PKW(P1,0), pw2[1]=PKW(P1,2), pw2); \
    VRD(6); SBAR(); GAPA(C1=__builtin_amdgcn_mfma_f32_32x32x16_bf16(kf[5],qr[2],C1,0,0,0),   P1[6],P1[7],P1[8],P1[9],     pw2[2]=PKW(P1,4), pw2[3]=PKW(P1,6), pw2); \
    VRD(3); SBAR(); GAPA(C0=__builtin_amdgcn_mfma_f32_32x32x16_bf16(kf[6],qr[3],C0,0,0,0),   P1[10],P1[11],P1[12],P1[13], pw3[0]=PKW(P1,8), pw3[1]=PKW(P1,10), pw3); \
    VRD(7); SBAR(); GAPA(C1=__builtin_amdgcn_mfma_f32_32x32x16_bf16(kf[7],qr[3],C1,0,0,0),   P1[14],P1[15],0.f,0.f,       pw3[2]=PKW(P1,12),pw3[3]=PKW(P1,14), pw3); \
    l_reg+=sacc; \
    if(GK){DMA_K((t)+3,sl_cur);} if(GV){DMA_V((t)+1,sl_next);} if(GM){ const int tb_=((t)+3<NT)?(t)+3:NT-1; DMA_M2((t)+2,tb_,mslot^1024); } \
    const u64 mw_=MLD(MOFF); \
    if(__builtin_expect(__any(mhat!=0.f),0)){ _Pragma("unroll") for(int r=0;r<16;++r){C0[r]-=mhat;C1[r]-=mhat;} } \
    { float a=MX3(C0[0],C0[1],C1[0]),b=MX3(C0[2],C0[3],C1[1]); a=MX3(a,C1[2],C1[3]); \
      _Pragma("unroll") for(int r=4;r<16;r+=4){a=MX3(a,C0[r],C0[r+1]);b=MX3(b,C0[r+2],C0[r+3]);a=MX3(a,C1[r],C1[r+1]);b=MX3(b,C1[r+2],C1[r+3]);} \
      float rm=__builtin_fmaxf(a,b); { auto rr=__builtin_amdgcn_permlane32_swap(__float_as_uint(rm),__float_as_uint(rm),false,false); rm=__builtin_fmaxf(__uint_as_float(rr[0]),__uint_as_float(rr[1])); } \
      resc=false; \
      if(__builtin_expect(__any(rm>(float)THRL),0)){ const float dl=__builtin_fmaxf(rm,0.f); mhat+=dl; \
        _Pragma("unroll") for(int r=0;r<16;++r){C0[r]-=dl;C1[r]-=dl;} \
        const float f=__builtin_amdgcn_exp2f(-dl); l_reg*=f; if(hi==0)wsf[r32]=f; resc=true; } } \
    MAPPLY(C0,C1,mw_); \
    SBAR(); \
    GAPB(o[0]=__builtin_amdgcn_mfma_f32_32x32x16_bf16(PAF(0),VFR(0),o[0],0,0,0), C0,0); \
    GAPB(o[1]=__builtin_amdgcn_mfma_f32_32x32x16_bf16(PAF(0),VFR(4),o[1],0,0,0), C0,4); \
    KRD(GL,0); GAPB(o[0]=__builtin_amdgcn_mfma_f32_32x32x16_bf16(PAF(1),VFR(1),o[0],0,0,0), C0,8); \
    KRD(GL,1); GAPB(o[1]=__builtin_amdgcn_mfma_f32_32x32x16_bf16(PAF(1),VFR(5),o[1],0,0,0), C0,12); \
    KRD(GL,2); GAPB(o[0]=__builtin_amdgcn_mfma_f32_32x32x16_bf16(PAF(2),VFR(2),o[0],0,0,0), C1,0); \
    KRD(GL,3); GAPB(o[1]=__builtin_amdgcn_mfma_f32_32x32x16_bf16(PAF(2),VFR(6),o[1],0,0,0), C1,4); \
    GAPB(o[0]=__builtin_amdgcn_mfma_f32_32x32x16_bf16(PAF(3),VFR(3),o[0],0,0,0), C1,8); \
    GAPB(o[1]=__builtin_amdgcn_mfma_f32_32x32x16_bf16(PAF(3),VFR(7),o[1],0,0,0), C1,12); \
    }while(0)
  int t=1; int mslot=0;
  for(;t+5<NT;t+=2){
    STEP(pB0,pB1,pA0,pA1,t,true,true,true,true,mslot);          WAIT_BAR(3); RESC(); ROT();
    STEP(pA0,pA1,pB0,pB1,t+1,true,true,true,false,mslot+256);   WAIT_BAR(2); RESC(); ROT(); mslot^=1024;
  }
  #define ENDW(nf) do{ if((nf)==3){WAIT_BAR(3);} else if((nf)==2){WAIT_BAR(2);} else if((nf)==1){WAIT_BAR(1);} else {WAIT_BAR(0);} }while(0)
  for(;t+1<NT;t+=2){
    { const bool gk=(t+3<NT),gv=(t+1<NT),gm=(t+2<NT); STEP(pB0,pB1,pA0,pA1,t,gk,gv,gv,gm,mslot);   ENDW((int)gk+(int)gv+(int)gm); RESC(); ROT(); }
    { const bool gk=(t+4<NT),gv=(t+2<NT);             STEP(pA0,pA1,pB0,pB1,t+1,gk,gv,gv,false,mslot+256); ENDW((t+3<NT)?((int)gk+(int)gv):0); RESC(); ROT(); mslot^=1024; }
  }
  STEP(pB0,pB1,pA0,pA1,NT-1,false,false,false,false,mslot); RESC();
  { float sacc=pB0[0]+pB0[1]; _Pragma("unroll") for(int r=2;r<16;++r)sacc+=pB0[r]; _Pragma("unroll") for(int r=0;r<16;++r)sacc+=pB1[r]; l_reg+=sacc;
    pw0=(u32x4){PKW(pB0,0),PKW(pB0,2),PKW(pB0,4),PKW(pB0,6)};pw1=(u32x4){PKW(pB0,8),PKW(pB0,10),PKW(pB0,12),PKW(pB0,14)};pw2=(u32x4){PKW(pB1,0),PKW(pB1,2),PKW(pB1,4),PKW(pB1,6)};pw3=(u32x4){PKW(pB1,8),PKW(pB1,10),PKW(pB1,12),PKW(pB1,14)};
    SBAR(); pv(o,vb0+sl_cur,PAF(0),PAF(1),PAF(2),PAF(3)); }
  #undef PKW
  #undef PAF
  #undef VFR
  #undef PIN
  #undef MX3
  #undef GAPA
  #undef GAPB
  #undef EX
  #undef VRD
  #undef KRD
  #undef STEP
  #undef ENDW
  {auto rr=__builtin_amdgcn_permlane32_swap(__float_as_uint(l_reg),__float_as_uint(l_reg),false,false);l_reg=__uint_as_float(rr[0])+__uint_as_float(rr[1]);}
  if(hi==0)wsf[32+r32]=l_reg;asm volatile("s_waitcnt lgkmcnt(0)":::"memory");
  float rli[16];
  #pragma unroll
  for(int r=0;r<16;++r)rli[r]=__builtin_amdgcn_rcpf(wsf[32+crow(r,hi)]);
  bf16*Ow=O+(rowbase+q0+wid*QBLK)*DMO+h*D;
  { bf16*stg=(bf16*)(shm+LDS_OST)+wid*2048;
    #pragma unroll
    for(int r=0;r<16;++r){const int orow=crow(r,hi);
      #pragma unroll
      for(int d0=0;d0<2;++d0)stg[orow*64+d0*32+r32]=__float2bfloat16(o[d0][r]*rli[r]);}
    asm volatile("s_waitcnt lgkmcnt(0)":::"memory");
    #pragma unroll
    for(int i=0;i<4;++i){const int row=i*8+(lane>>3),ch=lane&7; const u32x4 v=*(const u32x4*)(stg+row*64+ch*8); ATTN_STORE16(Ow+(long)row*DMO+ch*8,v);} }
  asm volatile("s_waitcnt lgkmcnt(0)\n\ts_barrier":::"memory");
  #undef DMA_K
  #undef DMA_V
  #undef DMA_M2
  #undef MAPPLY
  #undef MLD
  #undef START
  #undef RESC
  #undef ROT
}
constexpr int ATTN_LDS_BYTES=LDS_BYTES;
template<int THRL=8> __device__ __forceinline__ void attn_phase(char*lds,const bf16*Q,const bf16*K,const bf16*V,const u64*MASK,bf16*O){
  const int G=gridDim.x;
  for(int w=blockIdx.x;w<256;w+=G){ const int h=w&7,s=w>>3; attn_unit<THRL>(h,s,Q,K,V,MASK,O,lds); attn_unit<THRL>(h,63-s,Q,K,V,MASK,O,lds); }
}
#undef SBAR
#undef WAIT_BAR
}

__device__ __forceinline__ void phase_route_naive(const Params& p, unsigned char* lds) {
    const int tid = threadIdx.x, lane = tid & 63, wave = tid >> 6;
    const int gw = blockIdx.x * NWAVES + wave, NGW = gridDim.x * NWAVES;
    const float* H2 = (const float*)(p.ws + WS_H2); const float* WGRT = (const float*)(p.ws + WS_WGRT);
    float* RSTD = (float*)(p.ws + WS_RSTD); int* TOKOF = (int*)(p.ws + WS_TOKOF); float* GATEOF = (float*)(p.ws + WS_GATEOF); int* PAIR = (int*)(p.ws + WS_PAIR);
    unsigned* CNT = (unsigned*)(p.ws + WS_CTL) + CW_CNT;
    for (int t = gw; t < S; t += NGW) {
        const f32x4* hr = (const f32x4*)(H2 + (size_t)t * D) + lane; f32x4 v[4]; float ss = 0.f;
#pragma unroll
        for (int j = 0; j < 4; ++j) { v[j] = hr[64 * j]; ss += v[j].x * v[j].x + v[j].y * v[j].y + v[j].z * v[j].z + v[j].w * v[j].w; }
        const float rstd = rsqrtf(wave_sum(ss) * (1.f / D) + EPS);
        float mine = -INFINITY;
        for (int e = 0; e < NE; ++e) { const f32x4* wr = (const f32x4*)(WGRT + (size_t)e * D) + lane; float a = 0.f;
#pragma unroll
            for (int j = 0; j < 4; ++j) { const f32x4 w = wr[64 * j]; a = fmaf(v[j].x, w.x, a); a = fmaf(v[j].y, w.y, a); a = fmaf(v[j].z, w.z, a); a = fmaf(v[j].w, w.w, a); }
            a = wave_sum(a); if (lane == e) mine = a * rstd + p.b_router[e]; }
        float tv[4]; int te[4];
#pragma unroll
        for (int k = 0; k < 4; ++k) { float bv = mine; int bi = lane;
#pragma unroll
            for (int o = 32; o >= 1; o >>= 1) { const float ov = __shfl_xor(bv, o); const int oi = __shfl_xor(bi, o); if (ov > bv || (ov == bv && oi < bi)) { bv = ov; bi = oi; } }
            tv[k] = bv; te[k] = bi; if (lane == bi) mine = -INFINITY; }
        float g[4], gs = 0.f;
#pragma unroll
        for (int k = 0; k < 4; ++k) { g[k] = __expf(tv[k] - tv[0]); gs += g[k]; }
        if (lane == 0) RSTD[t] = rstd;
        if (lane < 4) { const int e = lane == 0 ? te[0] : lane == 1 ? te[1] : lane == 2 ? te[2] : te[3]; const float gg = (lane == 0 ? g[0] : lane == 1 ? g[1] : lane == 2 ? g[2] : g[3]) / gs;
            const unsigned slot = atomicAdd(&CNT[e], 1u); TOKOF[e * S + slot] = t; GATEOF[e * S + slot] = gg; PAIR[t * 4 + lane] = (e << 16) | (int)slot; }
    }
}

__device__ __forceinline__ int build_tiles(const Params& p, unsigned char* lds) {
    int* pst = (int*)(lds + LDS_MISC); int* tile_e = pst + 40;
    const unsigned* CNT = (const unsigned*)(p.ws + WS_CTL) + CW_CNT;
    __syncthreads();
    if (threadIdx.x == 0) { int acc = 0; for (int e = 0; e < NE; ++e) { pst[e] = acc; const int nt = ((int)__hip_atomic_load(&CNT[e], __ATOMIC_RELAXED, __HIP_MEMORY_SCOPE_AGENT) + 255) >> 8; for (int i = 0; i < nt; ++i) tile_e[acc + i] = e; acc += nt; } pst[NE] = acc; }
    __syncthreads();
    return pst[NE];
}

__device__ __forceinline__ void phase_gather(const Params& p, unsigned char* lds) {
    const int tid = threadIdx.x, lane = tid & 63, wave = tid >> 6;
    const int gw = blockIdx.x * NWAVES + wave, NGW = gridDim.x * NWAVES;
    build_tiles(p, lds); const int* pst = (const int*)(lds + LDS_MISC);
    const bf16* XN2 = (const bf16*)(p.ws + WS_XN); bf16* XS = (bf16*)(p.ws + WS_XS); const int* PAIR = (const int*)(p.ws + WS_PAIR);
    const float* RSTD = (const float*)(p.ws + WS_RSTD); const float* GATEOF = (const float*)(p.ws + WS_GATEOF);
    float* ROWRSTD = (float*)(p.ws + WS_ROWRSTD); float* ROWGATE = (float*)(p.ws + WS_ROWGATE);
    for (int pr = gw; pr < S * 4; pr += NGW) { const int t = pr >> 2; const int pe = PAIR[pr]; const int e = pe >> 16, slot = pe & 0xffff; const int row = pst[e] * 256 + slot;
        const u32x4* src = (const u32x4*)(XN2 + (size_t)t * D); u32x4* dst = (u32x4*)(XS + (size_t)row * D);
        dst[lane] = src[lane]; dst[lane + 64] = src[lane + 64];
        if (lane == 0) { ROWRSTD[row] = RSTD[t]; ROWGATE[row] = GATEOF[e * S + slot]; } }
}

__device__ __forceinline__ void phase_final(const Params& p, unsigned char* lds) {
    const int tid = threadIdx.x, lane = tid & 63, wave = tid >> 6;
    const int gw = blockIdx.x * NWAVES + wave, NGW = gridDim.x * NWAVES;
    build_tiles(p, lds); const int* pst = (const int*)(lds + LDS_MISC);
    const float* H2 = (const float*)(p.ws + WS_H2); const bf16* YS = (const bf16*)(p.ws + WS_YS); const int* PAIR = (const int*)(p.ws + WS_PAIR);
    for (int t = gw; t < S; t += NGW) {
        const f32x4* hr = (const f32x4*)(H2 + (size_t)t * D) + lane; f32x4 v[4];
#pragma unroll
        for (int j = 0; j < 4; ++j) v[j] = hr[64 * j];
#pragma unroll
        for (int k = 0; k < 4; ++k) { const int pe = PAIR[t * 4 + k]; const int row = pst[pe >> 16] * 256 + (pe & 0xffff); const uint2* yr = (const uint2*)(YS + (size_t)row * D) + lane;
#pragma unroll
            for (int j = 0; j < 4; ++j) { const uint2 y = yr[64 * j]; v[j].x += blo(y.x); v[j].y += bhi(y.x); v[j].z += blo(y.y); v[j].w += bhi(y.y); } }
        float ss = 0.f;
#pragma unroll
        for (int j = 0; j < 4; ++j) ss += v[j].x * v[j].x + v[j].y * v[j].y + v[j].z * v[j].z + v[j].w * v[j].w;
        const float rstd = rsqrtf(wave_sum(ss) * (1.f / D) + EPS);
        f32x4* o = (f32x4*)(p.out + (size_t)t * D) + lane;
#pragma unroll
        for (int j = 0; j < 4; ++j) { const f32x4 g = ((const f32x4*)p.norm_final_g)[lane + 64 * j]; o[64 * j] = (f32x4){v[j].x * rstd * g.x, v[j].y * rstd * g.y, v[j].z * rstd * g.z, v[j].w * rstd * g.w}; }
    }
}

#ifndef FAST_GEMM
#define FAST_GEMM 1
#endif
#ifndef FAST_ATT
#define FAST_ATT 1
#endif
template <class F, class Sched>
__device__ __forceinline__ void run_gemm(unsigned char* lds, const bf16* A, const bf16* Bt, int K, const Sched& S, const F& f) {
#if FAST_GEMM
    pg8::Gemm g{A, Bt, 0, 0, K}; EpiAdapt<F> E{f};
    pg8::gemm_phase<EpiAdapt<F>, Sched, true, true>((LAS unsigned char*)lds, g, S, E);
#else
    Unit u;
    for (int i = 0; S.next(i, u); ++i) ngemm_unit(lds, A + (size_t)u.pm * 256 * K, K, Bt + (size_t)S.bidx(u) * 256 * K, K, K, f, u);
#endif
    __syncthreads();
}

__global__ void __launch_bounds__(NTHREADS, 2) fwd_kernel(Params p) {
    extern __shared__ __attribute__((aligned(16))) unsigned char lds[];
    cg::grid_group grid = cg::this_grid();
    const int G = gridDim.x, bx = blockIdx.x;
    const LAS int* tile_e = (const LAS int*)((LAS unsigned char*)lds + LDS_MISC) + 40;
    phase_prologue(p, lds);
    grid.sync();
    { pg8::StaticOrder so; so.init(S, NP, G, bx); EpiProj E{(bf16*)(p.ws + WS_PROJ)};
        run_gemm(lds, (const bf16*)(p.ws + WS_XN), (const bf16*)(p.ws + WS_WINT), D, so, E); }
    grid.sync();
    phase_ew_naive(p, lds);
    grid.sync();
    phase_idx_naive(p, lds);
    grid.sync();
#if FAST_ATT
    attn_body::attn_phase<16>((char*)lds, (const attn_body::bf16*)(p.ws + WS_PROJ) + C_Q, (const attn_body::bf16*)(p.ws + WS_PROJ) + C_K, (const attn_body::bf16*)(p.ws + WS_PROJ) + C_V,
        (const u64*)(p.ws + WS_MASK), (attn_body::bf16*)(p.ws + WS_MIX) + 512);
    __syncthreads();
#else
    phase_att_naive(p, lds);
#endif
    grid.sync();
    { pg8::StaticOrder so; so.init(S, D, G, bx); EpiOut E{p.x, p.norm_ffn_g, (float*)(p.ws + WS_H2), (bf16*)(p.ws + WS_XN)};
        run_gemm(lds, (const bf16*)(p.ws + WS_MIX), (const bf16*)(p.ws + WS_WOUTT), D, so, E); }
    grid.sync();
    phase_route_naive(p, lds);
    grid.sync();
    phase_gather(p, lds);
    grid.sync();
    { const int ntile = build_tiles(p, lds);
        MoeOrder mo; mo.so.init(ntile * 256, 2048, G, bx); mo.tile_e = tile_e; mo.ncol = 8;
        EpiGU E{p.b_gu, (const float*)(p.ws + WS_ROWRSTD), (bf16*)(p.ws + WS_HDN), tile_e};
        run_gemm(lds, (const bf16*)(p.ws + WS_XS), (const bf16*)(p.ws + WS_WGUT), D, mo, E); }
    grid.sync();
    { const int ntile = build_tiles(p, lds);
        MoeOrder mo; mo.so.init(ntile * 256, D, G, bx); mo.tile_e = tile_e; mo.ncol = 4;
        EpiDown E{p.b_down, (const float*)(p.ws + WS_ROWGATE), (bf16*)(p.ws + WS_YS), tile_e};
        run_gemm(lds, (const bf16*)(p.ws + WS_HDN), (const bf16*)(p.ws + WS_WDT), DE, mo, E); }
    grid.sync();
    phase_final(p, lds);
}

extern "C" void kernel_launch(void* const* d_in, const int* in_sizes, int n_in, void* d_out, int out_size, void* d_ws, size_t ws_size, hipStream_t stream) {
    static int grid = 0;
    if (grid == 0) {
        if (n_in != 19 || out_size != S * D || ws_size < WS_END) { fprintf(stderr, "kernel_launch: unexpected shapes (n_in %d out %d ws %zu)\n", n_in, out_size, ws_size); grid = -1; return; }
        int dev = 0, cus = 0, per_cu = 0;
        (void)hipGetDevice(&dev); (void)hipDeviceGetAttribute(&cus, hipDeviceAttributeMultiprocessorCount, dev);
        if (hipFuncSetAttribute((const void*)fwd_kernel, hipFuncAttributeMaxDynamicSharedMemorySize, LDS_BYTES) != hipSuccess) { fprintf(stderr, "kernel_launch: hipFuncSetAttribute failed\n"); grid = -1; return; }
        if (hipOccupancyMaxActiveBlocksPerMultiprocessor(&per_cu, (const void*)fwd_kernel, NTHREADS, LDS_BYTES) != hipSuccess || per_cu < 1) { fprintf(stderr, "kernel_launch: occupancy query says %d\n", per_cu); per_cu = 1; }
        (void)hipGetLastError();
        grid = cus * 1;
    }
    if (grid < 0) return;
    (void)hipMemsetAsync((char*)d_ws + WS_CTL, 0, CTL_BYTES, stream);
    Params p{};
    p.x = (const float*)d_in[0]; p.pos = (const int*)d_in[1]; p.norm_mix_g = (const float*)d_in[2]; p.w_in = (const float*)d_in[3]; p.idx_g = (const float*)d_in[4]; p.idx_b = (const float*)d_in[5];
    p.conv_w = (const float*)d_in[6]; p.conv_b = (const float*)d_in[7]; p.conv_ng = (const float*)d_in[8]; p.conv_nb = (const float*)d_in[9]; p.w_out = (const float*)d_in[10]; p.norm_ffn_g = (const float*)d_in[11];
    p.w_router = (const float*)d_in[12]; p.b_router = (const float*)d_in[13]; p.w_gu = (const float*)d_in[14]; p.b_gu = (const float*)d_in[15]; p.w_down = (const float*)d_in[16]; p.b_down = (const float*)d_in[17];
    p.norm_final_g = (const float*)d_in[18]; p.out = (float*)d_out; p.ws = (unsigned char*)d_ws;
    void* args[] = {&p};
    hipError_t e = hipLaunchCooperativeKernel((const void*)fwd_kernel, dim3(grid), dim3(NTHREADS), args, LDS_BYTES, stream);
    if (e != hipSuccess) fprintf(stderr, "cooperative launch failed: %s (grid %d)\n", hipGetErrorString(e), grid);
}
```

```cpp
#include <hip/hip_runtime.h>
#include <hip/hip_cooperative_groups.h>
#include <cstdio>
#include <cstdint>
#include <hip/hip_bf16.h>
#include <cmath>
namespace cg = cooperative_groups;

constexpr int S = 16384, D = 1024, NIN = 3144, NP = 3328;
constexpr int CC = 512, CW = 31, NH = 8, HD = 64, NE = 32, DE = 1024;
constexpr int C_VAL = 0, C_GATE = 512, C_Q = 1024, C_K = 1536, C_V = 2048, C_QI = 2560, C_KI = 3072, C_WI = 3136;
constexpr int KSEL = 256;
constexpr float EPS = 1e-5f;
constexpr float C2 = 0.125f * 1.4426950408889634f;
constexpr int NTHREADS = 512, NWAVES = 8;
constexpr int MAXROWS = 65536 + NE * 256;
constexpr int MAXTILES = MAXROWS / 256;

constexpr size_t MiB = 1u << 20;
constexpr size_t WS_CTL = 0, CTL_BYTES = 1 * MiB;
constexpr size_t WS_WINT = 2 * MiB;
constexpr size_t WS_WOUTT = 9 * MiB;
constexpr size_t WS_WGRT = 11 * MiB;
constexpr size_t WS_COS = 12 * MiB;
constexpr size_t WS_SIN = 14 * MiB;
constexpr size_t WS_WGUT = 16 * MiB;
constexpr size_t WS_WDT = 144 * MiB;
constexpr size_t WS_XN = 208 * MiB;
constexpr size_t WS_PROJ = 240 * MiB;
constexpr size_t WS_MIX = 344 * MiB;
constexpr size_t WS_KI = 376 * MiB;
constexpr size_t WS_QL = 378 * MiB;
constexpr size_t WS_WI = 380 * MiB;
constexpr size_t WS_RSTD = 381 * MiB;
constexpr size_t WS_TOKOF = 382 * MiB;
constexpr size_t WS_GATEOF = 384 * MiB;
constexpr size_t WS_PAIR = 386 * MiB;
constexpr size_t WS_ROWRSTD = 387 * MiB;
constexpr size_t WS_ROWGATE = 388 * MiB;
constexpr size_t WS_MASK = 392 * MiB;
constexpr size_t WS_H2 = 424 * MiB;
constexpr size_t WS_XS = 488 * MiB;
constexpr size_t WS_HDN = 632 * MiB;
constexpr size_t WS_YS = 776 * MiB;
constexpr size_t WS_END = 920 * MiB;
constexpr int CW_CNT = 1024;

constexpr int LDS_BYTES = 147456;
constexpr int LDS_MISC = 131072;

#define LAS __attribute__((address_space(3)))
typedef unsigned short bf16;
typedef unsigned long long u64;
typedef float f32x4 __attribute__((ext_vector_type(4)));
typedef unsigned u32x4 __attribute__((ext_vector_type(4)));

__device__ __forceinline__ float bf2f(unsigned v) { return __uint_as_float(v << 16); }
__device__ __forceinline__ unsigned f2bf(float f) { unsigned u = __float_as_uint(f); return (u + 0x7fffu + ((u >> 16) & 1u)) >> 16; }
__device__ __forceinline__ unsigned pk2(float lo, float hi) { return f2bf(lo) | (f2bf(hi) << 16); }
__device__ __forceinline__ float blo(unsigned w) { return __uint_as_float(w << 16); }
__device__ __forceinline__ float bhi(unsigned w) { return __uint_as_float(w & 0xffff0000u); }
__device__ __forceinline__ float wave_sum(float v) {
#pragma unroll
    for (int o = 1; o < 64; o <<= 1) v += __shfl_xor(v, o);
    return v;
}
__device__ __forceinline__ float wave_max(float v) {
#pragma unroll
    for (int o = 1; o < 64; o <<= 1) v = fmaxf(v, __shfl_xor(v, o));
    return v;
}
__device__ __forceinline__ int opaque_tid() { int t = threadIdx.x; asm volatile("" : "+v"(t)); return t; }
__device__ __forceinline__ float sigmoidf_(float x) { return 1.f / (1.f + __expf(-x)); }

struct Params {
    const float* x; const int* pos; const float* norm_mix_g; const float* w_in; const float* idx_g; const float* idx_b;
    const float* conv_w; const float* conv_b; const float* conv_ng; const float* conv_nb; const float* w_out; const float* norm_ffn_g;
    const float* w_router; const float* b_router; const float* w_gu; const float* b_gu; const float* w_down; const float* b_down;
    const float* norm_final_g; float* out; unsigned char* ws;
};

__device__ __forceinline__ void transpose_item(const float* W, int K, int N, bf16* WT, int dst_row0, int k0, int n0, float* scr, int lane) {
#pragma unroll 8
    for (int i = 0; i < 32; ++i) { const int kk = 2 * i + (lane >> 5); const int n = n0 + (lane & 31);
        scr[kk * 33 + (lane & 31)] = (n < N) ? W[(size_t)(k0 + kk) * N + n] : 0.f; }
    __builtin_amdgcn_s_waitcnt(0); asm volatile("" ::: "memory");
    const int c = lane & 7;
#pragma unroll
    for (int j = 0; j < 4; ++j) { const int n = (lane >> 3) + 8 * j; const float* s = scr + (8 * c) * 33 + n;
        u32x4 o; o.x = pk2(s[0 * 33], s[1 * 33]); o.y = pk2(s[2 * 33], s[3 * 33]); o.z = pk2(s[4 * 33], s[5 * 33]); o.w = pk2(s[6 * 33], s[7 * 33]);
        *(u32x4*)(WT + (size_t)(dst_row0 + n) * K + k0 + 8 * c) = o; }
    __builtin_amdgcn_s_waitcnt(0); asm volatile("" ::: "memory");
}

__device__ __forceinline__ void phase_prologue(const Params& p, unsigned char* lds) {
    const int tid = opaque_tid(), lane = tid & 63, wave = tid >> 6;
    const int gw = blockIdx.x * NWAVES + wave, NGW = gridDim.x * NWAVES;
    float* scr = (float*)(lds + wave * 16384);
    bf16* WinT = (bf16*)(p.ws + WS_WINT); bf16* WoutT = (bf16*)(p.ws + WS_WOUTT); bf16* WguT = (bf16*)(p.ws + WS_WGUT); bf16* WdT = (bf16*)(p.ws + WS_WDT);
    constexpr int I_IN = 16 * (NP / 32), I_OUT = 16 * 32, I_GU = 16 * 64, I_DN = 16 * 32;
    constexpr int NITEMS = I_IN + I_OUT + NE * I_GU + NE * I_DN;
    for (int it = gw; it < NITEMS; it += NGW) {
        int r = it;
        if (r < I_IN) { const int nb = r % (NP / 32), kb = r / (NP / 32); transpose_item(p.w_in, D, NIN, WinT, nb * 32, kb * 64, nb * 32, scr, lane); continue; }
        r -= I_IN;
        if (r < I_OUT) { const int nb = r % 32, kb = r / 32; transpose_item(p.w_out, D, D, WoutT, nb * 32, kb * 64, nb * 32, scr, lane); continue; }
        r -= I_OUT;
        if (r < NE * I_GU) { const int e = r / I_GU, q = r % I_GU, nb = q % 64, kb = q / 64; const int n0 = nb * 32;
            const int c = n0 & 1023, isu = n0 >> 10; const int drow = e * 2048 + (c >> 7) * 256 + isu * 128 + (c & 127);
            transpose_item(p.w_gu + (size_t)e * D * 2048, D, 2048, WguT, drow - 0, kb * 64, n0, scr, lane);
            continue; }
        r -= NE * I_GU;
        { const int e = r / I_DN, q = r % I_DN, nb = q % 32, kb = q / 32;
            transpose_item(p.w_down + (size_t)e * DE * D, DE, D, WdT, e * D + nb * 32, kb * 64, nb * 32, scr, lane); }
    }
    for (int i = blockIdx.x * NTHREADS + tid; i < NE * D; i += gridDim.x * NTHREADS) { const int e = i / D, k = i % D; ((float*)(p.ws + WS_WGRT))[i] = p.norm_ffn_g[k] * p.w_router[k * NE + e]; }
    for (int i = blockIdx.x * NTHREADS + tid; i < S * 32; i += gridDim.x * NTHREADS) { const int t = i >> 5, j = i & 31;
        const float inv = powf(10000.f, -(float)j / 32.f); const float ang = (float)p.pos[t] * inv;
        double xr = (double)ang * 0.15915494309189535; xr -= floor(xr); const float xf = (float)xr;
        ((float*)(p.ws + WS_COS))[i] = __builtin_amdgcn_cosf(xf); ((float*)(p.ws + WS_SIN))[i] = __builtin_amdgcn_sinf(xf); }
    bf16* XN = (bf16*)(p.ws + WS_XN);
    for (int m = gw; m < S; m += NGW) {
        const f32x4* xr = (const f32x4*)(p.x + (size_t)m * D) + lane; f32x4 v[4]; float ss = 0.f;
#pragma unroll
        for (int j = 0; j < 4; ++j) { v[j] = xr[64 * j]; ss += v[j].x * v[j].x + v[j].y * v[j].y + v[j].z * v[j].z + v[j].w * v[j].w; }
        const float rstd = rsqrtf(wave_sum(ss) * (1.f / D) + EPS);
        u64* o8 = (u64*)(XN + (size_t)m * D) + lane;
#pragma unroll
        for (int j = 0; j < 4; ++j) { const f32x4 g = ((const f32x4*)p.norm_mix_g)[lane + 64 * j];
            o8[64 * j] = (u64)pk2(v[j].x * rstd * g.x, v[j].y * rstd * g.y) | ((u64)pk2(v[j].z * rstd * g.z, v[j].w * rstd * g.w) << 32); }
    }
}

namespace pg8 {
#define PG8_LAS __attribute__((address_space(3)))
typedef unsigned short bf16_t;
typedef short bf16x8 __attribute__((ext_vector_type(8)));
typedef float f32x4 __attribute__((ext_vector_type(4)));
typedef unsigned u32x4 __attribute__((ext_vector_type(4)));
constexpr int BM = 256, BK = 64, HALF = 128, HTB = HALF * BK * 2  , STAGE_BYTES = 8 * HTB, NXCD = 8, WGM = 8;

__host__ __device__ __forceinline__ int lds_byte(int r, int c) { const int st = (r >> 4) * 2 + (c >> 5), rr = r & 15, cc = c & 31, ob = rr * 64 + cc * 2; return st * 1024 + (ob ^ (((ob >> 9) & 1) << 5)); }
__host__ __device__ __forceinline__ void stage_rc(int b, int& R, int& C) { const int st = b / 1024, sb = b % 1024, swz = sb ^ (((sb >> 9) & 1) << 5); R = (st >> 1) * 16 + swz / 64; C = (st & 1) * 32 + (swz % 64) / 2; }
__host__ __device__ __forceinline__ int perm32(int rho) { const int n = rho >> 4, i = rho & 15; return 8 * (i >> 2) + 4 * n + (i & 3); }

struct Unit { int pm, pn; };
struct Gemm { const bf16_t* A; const bf16_t* Bt; int M, N, K; };

struct StaticOrder {
    int nM, nN, nwg, G, c;
    __host__ __device__ void init(int M, int N, int G_, int c_) { nM = M / BM; nN = N / BM; nwg = nM * nN; G = G_; c = c_; }
    __host__ __device__ bool next(int i, Unit& u) const {
        const long L = (long)i * G + c; if (L >= nwg) return false;
        int wgid = (int)L; { const int q = nwg / NXCD, r = nwg % NXCD, xcd = wgid % NXCD, off = wgid / NXCD; wgid = (xcd < r ? xcd * (q + 1) : r * (q + 1) + (xcd - r) * q) + off; }
        const int nig = WGM * nN, gid = wgid / nig, fm = gid * WGM, gsz = (nM - fm) < WGM ? (nM - fm) : WGM;
        u.pm = fm + ((wgid % nig) % gsz); u.pn = (wgid % nig) / gsz; return true;
    }
    __device__ __forceinline__ int bidx(const Unit& u) const { return u.pn; }
    __device__ __forceinline__ void a_ready(const Unit&) const {}
    __device__ __forceinline__ void done(const Unit&) const {}
};
template <class Epi, class Sched, bool ALIGN_EPI = false, bool SP2 = false>
__device__ __forceinline__ void gemm_phase(PG8_LAS unsigned char* lds, const Gemm g, const Sched& S, const Epi& E) {
    int tid_ = threadIdx.x; asm volatile("" : "+v"(tid_));
    const int tid = tid_, wid = __builtin_amdgcn_readfirstlane(tid >> 6), lane = tid & 63, wr = wid >> 2, wc = wid & 3, fr = lane & 15, fq = lane >> 4;
    const int K = g.K, nt = K / BK;
    unsigned voffA[2], voffB[2];
#pragma unroll
    for (int i = 0; i < 2; ++i) { int R, C; stage_rc(tid * 16 + i * 8192, R, C); const int Rb = Epi::PERM ? ((R & ~31) + perm32(R & 31)) : R;
        voffA[i] = (unsigned)(R * K + C) * 2u; voffB[i] = (unsigned)(Rb * K + C) * 2u; }
    const size_t kstep = (size_t)(BK * 2);
    const size_t hstep = (size_t)HALF * K * 2;
    const size_t tstep = 2 * hstep;
    const unsigned ldsw = (unsigned)wid * 1024u;
    const int aoff = lds_byte(wr * 64 + fr, fq * 8), boff = lds_byte(wc * 32 + fr, fq * 8);
#define PG8_SA(b, h) (((b) * 2 + (h)) * HTB)
#define PG8_SB(b, h) ((4 + (b) * 2 + (h)) * HTB)
#define PG8_STAGE(bufoff, gbase, voff) do { _Pragma("unroll") for (int _i = 0; _i < 2; ++_i) \
        __builtin_amdgcn_global_load_lds((const unsigned*)((const char*)(gbase) + (voff)[_i]), (PG8_LAS unsigned*)(lds + (bufoff) + ldsw + _i * 8192), 16, 0, 0); } while (0)
#define PG8_LDA(dst, b, h) do { _Pragma("unroll") for (int m = 0; m < 4; ++m) _Pragma("unroll") for (int k = 0; k < 2; ++k) dst[m][k] = *(const PG8_LAS bf16x8*)(lds + PG8_SA(b, h) + aoff + m * 2048 + k * 1024); } while (0)
#define PG8_LDB(dst, b, h) do { _Pragma("unroll") for (int n = 0; n < 2; ++n) _Pragma("unroll") for (int k = 0; k < 2; ++k) dst[n][k] = *(const PG8_LAS bf16x8*)(lds + PG8_SB(b, h) + boff + n * 2048 + k * 1024); } while (0)
#define PG8_MMA(ai, bj, At, Bt) do { __builtin_amdgcn_s_setprio(1); _Pragma("unroll") for (int m = 0; m < 4; ++m) _Pragma("unroll") for (int n = 0; n < 2; ++n) _Pragma("unroll") for (int k = 0; k < 2; ++k) \
        acc[ai][bj][m][n] = __builtin_amdgcn_mfma_f32_16x16x32_bf16(Bt[n][k], At[m][k], acc[ai][bj][m][n], 0, 0, 0); __builtin_amdgcn_s_setprio(0); } while (0)
#define PG8_WAIT_V(n) asm volatile("s_waitcnt vmcnt(" #n ")" ::: "memory")
#define PG8_WAIT_L(n) asm volatile("s_waitcnt lgkmcnt(" #n ")" ::: "memory")
#define PG8_BAR __builtin_amdgcn_s_barrier()
#define PG8_SCHED __builtin_amdgcn_sched_barrier(0)
    Unit cur, nxt; int ui = 0;
    if (!S.next(0, cur)) return;
    f32x4 acc[2][2][4][2];
#pragma unroll
    for (int a = 0; a < 2; ++a)
#pragma unroll
        for (int b = 0; b < 2; ++b)
#pragma unroll
            for (int m = 0; m < 4; ++m)
#pragma unroll
                for (int n = 0; n < 2; ++n) acc[a][b][m][n] = (f32x4){0.f, 0.f, 0.f, 0.f};
    bf16x8 At[4][2], B0[2][2], B1[2][2];
    const char* cA = (const char*)g.A + (size_t)cur.pm * tstep; const char* cB = (const char*)g.Bt + (size_t)S.bidx(cur) * tstep;
    S.a_ready(cur);
    if constexpr (SP2) {
        PG8_STAGE(PG8_SB(0, 0), cB, voffB); PG8_STAGE(PG8_SB(0, 1), cB + hstep, voffB); PG8_STAGE(PG8_SA(0, 0), cA, voffA); PG8_STAGE(PG8_SA(0, 1), cA + hstep, voffA);
        if (wr == 1) PG8_BAR;
        PG8_WAIT_V(2); PG8_BAR;
        PG8_STAGE(PG8_SB(1, 0), cB + kstep, voffB); PG8_STAGE(PG8_SA(1, 0), cA + kstep, voffA); PG8_STAGE(PG8_SB(1, 1), cB + hstep + kstep, voffB);
        PG8_WAIT_V(6); PG8_BAR;
    } else {
        PG8_STAGE(PG8_SB(0, 0), cB, voffB); PG8_STAGE(PG8_SA(0, 0), cA, voffA); PG8_STAGE(PG8_SB(0, 1), cB + hstep, voffB); PG8_STAGE(PG8_SA(0, 1), cA + hstep, voffA);
        if (wr == 1) PG8_BAR;
        PG8_WAIT_V(4); PG8_BAR;
        PG8_STAGE(PG8_SB(1, 0), cB + kstep, voffB); PG8_STAGE(PG8_SA(1, 0), cA + kstep, voffA); PG8_STAGE(PG8_SB(1, 1), cB + hstep + kstep, voffB);
        PG8_WAIT_V(6); PG8_BAR;
    }
    for (;;) {
        const bool has_next = S.next(ui + 1, nxt);
        const char* nA = has_next ? (const char*)g.A + (size_t)nxt.pm * tstep : cA; const char* nB = has_next ? (const char*)g.Bt + (size_t)S.bidx(nxt) * tstep : cB;
        for (int t = 0; t < nt; t += 2) {
            const bool last = (t == nt - 2);
            const char* a1 = cA + (size_t)(t + 1) * kstep;
            const char* a2 = last ? nA : cA + (size_t)(t + 2) * kstep; const char* b2 = last ? nB : cB + (size_t)(t + 2) * kstep;
            const char* a3 = a2 + kstep; const char* b3 = b2 + kstep;
            if (last && has_next) S.a_ready(nxt);
            if constexpr (SP2) {
            PG8_LDB(B0, 0, 0); PG8_LDB(B1, 0, 1); PG8_SCHED; PG8_LDA(At, 0, 0); PG8_STAGE(PG8_SA(1, 1), a1 + hstep, voffA);
            PG8_WAIT_V(8); PG8_WAIT_L(0); PG8_BAR; PG8_MMA(0, 0, At, B0); PG8_MMA(0, 1, At, B1); PG8_BAR; PG8_SCHED;
            PG8_LDA(At, 0, 1); PG8_STAGE(PG8_SB(0, 0), b2, voffB); PG8_STAGE(PG8_SB(0, 1), b2 + hstep, voffB); PG8_STAGE(PG8_SA(0, 0), a2, voffA);
            PG8_WAIT_V(8); PG8_WAIT_L(0); PG8_BAR; PG8_MMA(1, 0, At, B0); PG8_MMA(1, 1, At, B1); PG8_BAR; PG8_SCHED;
            PG8_LDB(B0, 1, 0); PG8_LDB(B1, 1, 1); PG8_SCHED; PG8_LDA(At, 1, 0); PG8_STAGE(PG8_SA(0, 1), a2 + hstep, voffA);
            PG8_WAIT_V(8); PG8_WAIT_L(0); PG8_BAR; PG8_MMA(0, 0, At, B0); PG8_MMA(0, 1, At, B1); PG8_BAR; PG8_SCHED;
            PG8_LDA(At, 1, 1); PG8_STAGE(PG8_SB(1, 0), b3, voffB); PG8_STAGE(PG8_SB(1, 1), b3 + hstep, voffB); PG8_STAGE(PG8_SA(1, 0), a3, voffA);
            PG8_WAIT_V(8); PG8_WAIT_L(0); PG8_BAR; PG8_MMA(1, 0, At, B0); PG8_MMA(1, 1, At, B1); PG8_BAR; PG8_SCHED;
            } else {
            PG8_LDB(B0, 0, 0); PG8_SCHED; PG8_LDA(At, 0, 0); PG8_STAGE(PG8_SA(1, 1), a1 + hstep, voffA);
            PG8_WAIT_L(8); PG8_BAR; PG8_WAIT_L(0); PG8_MMA(0, 0, At, B0); PG8_BAR; PG8_SCHED;
            PG8_LDB(B1, 0, 1); PG8_STAGE(PG8_SB(0, 0), b2, voffB);
            PG8_BAR; PG8_WAIT_L(0); PG8_MMA(0, 1, At, B1); PG8_BAR;
            PG8_LDA(At, 0, 1); PG8_STAGE(PG8_SA(0, 0), a2, voffA);
            PG8_BAR; PG8_WAIT_L(0); PG8_MMA(1, 0, At, B0); PG8_BAR; PG8_SCHED;
            PG8_STAGE(PG8_SB(0, 1), b2 + hstep, voffB);
            PG8_WAIT_V(6); PG8_BAR; PG8_MMA(1, 1, At, B1); PG8_BAR;
            PG8_LDB(B0, 1, 0); PG8_SCHED; PG8_LDA(At, 1, 0); PG8_STAGE(PG8_SA(0, 1), a2 + hstep, voffA);
            PG8_WAIT_L(8); PG8_BAR; PG8_WAIT_L(0); PG8_MMA(0, 0, At, B0); PG8_BAR; PG8_SCHED;
            PG8_LDB(B1, 1, 1); PG8_STAGE(PG8_SB(1, 0), b3, voffB);
            PG8_BAR; PG8_WAIT_L(0); PG8_MMA(0, 1, At, B1); PG8_BAR;
            PG8_LDA(At, 1, 1); PG8_STAGE(PG8_SA(1, 0), a3, voffA);
            PG8_BAR; PG8_WAIT_L(0); PG8_MMA(1, 0, At, B0); PG8_BAR; PG8_SCHED;
            PG8_STAGE(PG8_SB(1, 1), b3 + hstep, voffB);
            PG8_WAIT_V(6); PG8_BAR; PG8_MMA(1, 1, At, B1); PG8_BAR;
            }
        }
        if constexpr (ALIGN_EPI) { if (wr == 0) PG8_BAR; }
        if constexpr (!Epi::AFTER_DRAIN) { E(acc, cur, wr, wc, fr, fq); S.done(cur); }
        if (!has_next) break;
#pragma unroll
        for (int a = 0; a < 2; ++a)
#pragma unroll
            for (int b = 0; b < 2; ++b)
#pragma unroll
                for (int m = 0; m < 4; ++m)
#pragma unroll
                    for (int n = 0; n < 2; ++n) acc[a][b][m][n] = (f32x4){0.f, 0.f, 0.f, 0.f};
        cur = nxt; cA = nA; cB = nB; ++ui;
        if constexpr (ALIGN_EPI) { if (wr == 1) PG8_BAR; }
    }
    PG8_WAIT_V(0);
    if constexpr (!ALIGN_EPI) { if (wr == 0) PG8_BAR; }
    PG8_BAR;
    if constexpr (Epi::AFTER_DRAIN) { E.fused(acc, cur, wr, wc, fr, fq, lds, wid, lane); S.done(cur); }
#undef PG8_SA
#undef PG8_SB
#undef PG8_STAGE
#undef PG8_LDA
#undef PG8_LDB
#undef PG8_MMA
#undef PG8_WAIT_V
#undef PG8_WAIT_L
#undef PG8_BAR
#undef PG8_SCHED
}
}

template <class Epi>
__device__ __forceinline__ void ngemm_unit(unsigned char* lds, const bf16* A, int lda, const bf16* Bt, int ldb, int K, const Epi& epi, const pg8::Unit& u) {
    float* As = (float*)lds; float* Bs = As + 32 * 256;
    const int tid = opaque_tid(), tr = tid >> 4, tc = tid & 15;
    float acc0[8][8], acc1[8][8];
#pragma unroll
    for (int i = 0; i < 8; ++i)
#pragma unroll
        for (int j = 0; j < 8; ++j) { acc0[i][j] = 0.f; acc1[i][j] = 0.f; }
    for (int k0 = 0; k0 < K; k0 += 32) {
        __syncthreads();
#pragma unroll
        for (int j = 0; j < 2; ++j) { const int pidx = tid + 512 * j, r = pidx & 255, kq = pidx >> 8;
            const u32x4 va = *(const u32x4*)(A + (size_t)r * lda + k0 + kq * 8);
            const u32x4 vb = *(const u32x4*)(Bt + (size_t)r * ldb + k0 + kq * 8);
            float* ap = As + (kq * 8) * 256 + r; float* bp = Bs + (kq * 8) * 256 + r;
            ap[0 * 256] = blo(va.x); ap[1 * 256] = bhi(va.x); ap[2 * 256] = blo(va.y); ap[3 * 256] = bhi(va.y); ap[4 * 256] = blo(va.z); ap[5 * 256] = bhi(va.z); ap[6 * 256] = blo(va.w); ap[7 * 256] = bhi(va.w);
            bp[0 * 256] = blo(vb.x); bp[1 * 256] = bhi(vb.x); bp[2 * 256] = blo(vb.y); bp[3 * 256] = bhi(vb.y); bp[4 * 256] = blo(vb.z); bp[5 * 256] = bhi(vb.z); bp[6 * 256] = blo(vb.w); bp[7 * 256] = bhi(vb.w); }
        __syncthreads();
#pragma unroll 2
        for (int kk = 0; kk < 32; ++kk) {
            const f32x4 a0 = *(const f32x4*)(As + kk * 256 + tr * 8), a1 = *(const f32x4*)(As + kk * 256 + tr * 8 + 4);
            const f32x4 b00 = *(const f32x4*)(Bs + kk * 256 + tc * 8), b01 = *(const f32x4*)(Bs + kk * 256 + tc * 8 + 4);
            const f32x4 b10 = *(const f32x4*)(Bs + kk * 256 + 128 + tc * 8), b11 = *(const f32x4*)(Bs + kk * 256 + 128 + tc * 8 + 4);
            const float a[8] = {a0.x, a0.y, a0.z, a0.w, a1.x, a1.y, a1.z, a1.w};
            const float b0[8] = {b00.x, b00.y, b00.z, b00.w, b01.x, b01.y, b01.z, b01.w};
            const float b1[8] = {b10.x, b10.y, b10.z, b10.w, b11.x, b11.y, b11.z, b11.w};
#pragma unroll
            for (int i = 0; i < 8; ++i)
#pragma unroll
                for (int j = 0; j < 8; ++j) { acc0[i][j] = fmaf(a[i], b0[j], acc0[i][j]); acc1[i][j] = fmaf(a[i], b1[j], acc1[i][j]); }
        }
    }
#pragma unroll
    for (int i = 0; i < 8; ++i) epi(u, tr * 8 + i, tc * 8, acc0[i], acc1[i]);
}

__device__ __forceinline__ void store8_bf16(bf16* dst, const float (&v)[8]) {
    u32x4 o; o.x = pk2(v[0], v[1]); o.y = pk2(v[2], v[3]); o.z = pk2(v[4], v[5]); o.w = pk2(v[6], v[7]); *(u32x4*)dst = o;
}

typedef pg8::Unit Unit;
struct EpiProj { bf16* O;
    __device__ __forceinline__ void operator()(const Unit& u, int r, int c8, const float (&v0)[8], const float (&v1)[8]) const {
        bf16* row = O + (size_t)(u.pm * 256 + r) * NP + u.pn * 256 + c8; store8_bf16(row, v0); store8_bf16(row + 128, v1); } };
struct EpiOut { const float* x; const float* gffn; float* H2; bf16* XN2;
    __device__ __forceinline__ void operator()(const Unit& u, int r, int c8, const float (&v0)[8], const float (&v1)[8]) const {
        const int col = u.pn * 256 + c8; const size_t off = (size_t)(u.pm * 256 + r) * D + col; float h0[8], h1[8], n0[8], n1[8];
        const f32x4 xa = *(const f32x4*)(x + off), xb = *(const f32x4*)(x + off + 4), xc = *(const f32x4*)(x + off + 128), xd = *(const f32x4*)(x + off + 132);
        const f32x4 ga = *(const f32x4*)(gffn + col), gb = *(const f32x4*)(gffn + col + 4), gc = *(const f32x4*)(gffn + col + 128), gd = *(const f32x4*)(gffn + col + 132);
        const float xs0[8] = {xa.x, xa.y, xa.z, xa.w, xb.x, xb.y, xb.z, xb.w}, xs1[8] = {xc.x, xc.y, xc.z, xc.w, xd.x, xd.y, xd.z, xd.w};
        const float gs0[8] = {ga.x, ga.y, ga.z, ga.w, gb.x, gb.y, gb.z, gb.w}, gs1[8] = {gc.x, gc.y, gc.z, gc.w, gd.x, gd.y, gd.z, gd.w};
#pragma unroll
        for (int i = 0; i < 8; ++i) { h0[i] = xs0[i] + v0[i]; h1[i] = xs1[i] + v1[i]; n0[i] = h0[i] * gs0[i]; n1[i] = h1[i] * gs1[i]; }
        *(f32x4*)(H2 + off) = (f32x4){h0[0], h0[1], h0[2], h0[3]}; *(f32x4*)(H2 + off + 4) = (f32x4){h0[4], h0[5], h0[6], h0[7]};
        *(f32x4*)(H2 + off + 128) = (f32x4){h1[0], h1[1], h1[2], h1[3]}; *(f32x4*)(H2 + off + 132) = (f32x4){h1[4], h1[5], h1[6], h1[7]};
        store8_bf16(XN2 + off, n0); store8_bf16(XN2 + off + 128, n1); } };
struct EpiGU { const float* bgu; const float* rowrstd; bf16* HDN; const LAS int* tile_e;
    __device__ __forceinline__ void operator()(const Unit& u, int r, int c8, const float (&v0)[8], const float (&v1)[8]) const {
        const int e = tile_e[u.pm]; const int row = u.pm * 256 + r; const float rs = rowrstd[row]; const int cb = u.pn * 128 + c8; float h[8];
        const float* bg = bgu + e * 2048 + cb; const f32x4 ba = *(const f32x4*)bg, bb = *(const f32x4*)(bg + 4), bc = *(const f32x4*)(bg + 1024), bd_ = *(const f32x4*)(bg + 1028);
        const float b0[8] = {ba.x, ba.y, ba.z, ba.w, bb.x, bb.y, bb.z, bb.w}, b1[8] = {bc.x, bc.y, bc.z, bc.w, bd_.x, bd_.y, bd_.z, bd_.w};
#pragma unroll
        for (int i = 0; i < 8; ++i) { float g = v0[i] * rs + b0[i]; float uu = v1[i] * rs + b1[i];
            g = fminf(g, 7.f); uu = fminf(fmaxf(uu, -7.f), 7.f); h[i] = g * sigmoidf_(1.702f * g) * (uu + 1.f); }
        store8_bf16(HDN + (size_t)row * DE + cb, h); } };
struct EpiDown { const float* bd; const float* rowgate; bf16* YS; const LAS int* tile_e;
    __device__ __forceinline__ void operator()(const Unit& u, int r, int c8, const float (&v0)[8], const float (&v1)[8]) const {
        const int e = tile_e[u.pm]; const int row = u.pm * 256 + r; const float gt = rowgate[row]; const int cb = u.pn * 256 + c8; float y0[8], y1[8];
        const float* bp = bd + e * D + cb; const f32x4 ba = *(const f32x4*)bp, bb = *(const f32x4*)(bp + 4), bc = *(const f32x4*)(bp + 128), bd_ = *(const f32x4*)(bp + 132);
        const float b0[8] = {ba.x, ba.y, ba.z, ba.w, bb.x, bb.y, bb.z, bb.w}, b1[8] = {bc.x, bc.y, bc.z, bc.w, bd_.x, bd_.y, bd_.z, bd_.w};
#pragma unroll
        for (int i = 0; i < 8; ++i) { y0[i] = (v0[i] + b0[i]) * gt; y1[i] = (v1[i] + b1[i]) * gt; }
        store8_bf16(YS + (size_t)row * D + cb, y0); store8_bf16(YS + (size_t)row * D + cb + 128, y1); } };

template <class F> struct EpiAdapt {
    static constexpr bool PERM = true, AFTER_DRAIN = false; F f;
    __device__ __forceinline__ void operator()(const f32x4 (&acc)[2][2][4][2], const Unit& u, int wr, int wc, int fr, int fq) const {
#pragma unroll
        for (int ai = 0; ai < 2; ++ai)
#pragma unroll
            for (int m = 0; m < 4; ++m) { const int r = ai * 128 + wr * 64 + m * 16 + fr, c8 = wc * 32 + fq * 8;
                const f32x4 a = acc[ai][0][m][0], b = acc[ai][0][m][1], c = acc[ai][1][m][0], d = acc[ai][1][m][1];
                const float v0[8] = {a.x, a.y, a.z, a.w, b.x, b.y, b.z, b.w}, v1[8] = {c.x, c.y, c.z, c.w, d.x, d.y, d.z, d.w};
                f(u, r, c8, v0, v1); }
    }
};
struct MoeOrder { pg8::StaticOrder so; const LAS int* tile_e; int ncol;
    __device__ __forceinline__ bool next(int i, Unit& u) const { return so.next(i, u); }
    __device__ __forceinline__ int bidx(const Unit& u) const { return tile_e[u.pm] * ncol + u.pn; }
    __device__ __forceinline__ void a_ready(const Unit&) const {}
    __device__ __forceinline__ void done(const Unit&) const {} };

__device__ __forceinline__ void phase_ew_naive(const Params& p, unsigned char* lds) {
    const int tid = opaque_tid(), lane = tid & 63, wave = tid >> 6;
    bf16* PROJ = (bf16*)(p.ws + WS_PROJ); bf16* MIX = (bf16*)(p.ws + WS_MIX); bf16* KI = (bf16*)(p.ws + WS_KI); bf16* QL = (bf16*)(p.ws + WS_QL); float* WI = (float*)(p.ws + WS_WI);
    const float* COS = (const float*)(p.ws + WS_COS); const float* SIN = (const float*)(p.ws + WS_SIN);
    float* red = (float*)(lds);
    for (int t = blockIdx.x; t < S; t += gridDim.x) {
        const int c = tid; float acc = p.conv_b[c];
        for (int j = 0; j < CW; ++j) { const int tt = t - (CW - 1) + j; if (tt >= 0) { const float val = bf2f(PROJ[(size_t)tt * NP + C_VAL + c]), gate = bf2f(PROJ[(size_t)tt * NP + C_GATE + c]);
                acc = fmaf(p.conv_w[j * CC + c], val * sigmoidf_(gate), acc); } }
        const int hh = (tid & 255) >> 5, ii = tid & 31; const int qkbase = (tid < 256) ? C_Q : C_K;
        const float cs = COS[t * 32 + ii], sn = SIN[t * 32 + ii];
        const float x1 = bf2f(PROJ[(size_t)t * NP + qkbase + hh * 64 + ii]), x2 = bf2f(PROJ[(size_t)t * NP + qkbase + hh * 64 + 32 + ii]);
        float qi1 = 0.f, qi2 = 0.f; if (tid < 256) { qi1 = bf2f(PROJ[(size_t)t * NP + C_QI + hh * 64 + ii]); qi2 = bf2f(PROJ[(size_t)t * NP + C_QI + hh * 64 + 32 + ii]); }
        float kiv = 0.f, qlv = 0.f;
        if (wave == 4) kiv = bf2f(PROJ[(size_t)t * NP + C_KI + lane]);
        if (wave == 5) { for (int h = 0; h < 8; ++h) qlv = fmaf(bf2f(PROJ[(size_t)t * NP + C_WI + h]), bf2f(PROJ[(size_t)t * NP + C_QI + h * 64 + lane]), qlv); }
        float wiv = 0.f; if (wave == 6 && lane < 8) wiv = bf2f(PROJ[(size_t)t * NP + C_WI + lane]);
        float s1 = wave_sum(acc); if (lane == 0) red[wave] = s1; __syncthreads();
        float mean = 0.f;
#pragma unroll
        for (int w = 0; w < 8; ++w) mean += red[w];
        mean *= (1.f / CC); const float dv = acc - mean; float s2 = wave_sum(dv * dv); if (lane == 0) red[8 + wave] = s2; __syncthreads();
        float var = 0.f;
#pragma unroll
        for (int w = 0; w < 8; ++w) var += red[8 + w];
        var *= (1.f / CC);
        const float y = dv * rsqrtf(var + EPS) * p.conv_ng[c] + p.conv_nb[c];
        MIX[(size_t)t * D + c] = (bf16)f2bf(y * sigmoidf_(y));
        { const float sc = (tid < 256) ? C2 : 1.f; PROJ[(size_t)t * NP + qkbase + hh * 64 + ii] = (bf16)f2bf((x1 * cs - x2 * sn) * sc); PROJ[(size_t)t * NP + qkbase + hh * 64 + 32 + ii] = (bf16)f2bf((x2 * cs + x1 * sn) * sc); }
        if (tid < 256) { PROJ[(size_t)t * NP + C_QI + hh * 64 + ii] = (bf16)f2bf(qi1 * cs - qi2 * sn); PROJ[(size_t)t * NP + C_QI + hh * 64 + 32 + ii] = (bf16)f2bf(qi2 * cs + qi1 * sn); }
        if (wave == 4) { const float m = wave_sum(kiv) * (1.f / 64.f); const float d = kiv - m; const float vr = wave_sum(d * d) * (1.f / 64.f);
            const float yk = d * rsqrtf(vr + EPS) * p.idx_g[lane] + p.idx_b[lane]; const float other = __shfl_xor(yk, 32);
            const float c_ = COS[t * 32 + (lane & 31)], s_ = SIN[t * 32 + (lane & 31)];
            KI[(size_t)t * 64 + lane] = (bf16)f2bf(lane < 32 ? (yk * c_ - other * s_) : (yk * c_ + other * s_)); }
        if (wave == 5) { const float other = __shfl_xor(qlv, 32); const float c_ = COS[t * 32 + (lane & 31)], s_ = SIN[t * 32 + (lane & 31)];
            QL[(size_t)t * 64 + lane] = (bf16)f2bf(lane < 32 ? (qlv * c_ - other * s_) : (qlv * c_ + other * s_)); }
        if (wave == 6 && lane < 8) WI[t * 8 + lane] = wiv;
        __syncthreads();
    }
}

__device__ __forceinline__ unsigned fkey(float f) { unsigned u = __float_as_uint(f); if (u == 0x80000000u) u = 0u; return (u & 0x80000000u) ? ~u : (u | 0x80000000u); }
__device__ __forceinline__ void phase_idx_naive(const Params& p, unsigned char* lds) {
    const int tid = opaque_tid(), lane = tid & 63, wave = tid >> 6;
    const bf16* PROJ = (const bf16*)(p.ws + WS_PROJ); const bf16* KI = (const bf16*)(p.ws + WS_KI); const float* WI = (const float*)(p.ws + WS_WI);
    u64* MASK = (u64*)(p.ws + WS_MASK);
    float* scores = (float*)lds;
    float* qif = (float*)(lds + 65536);
    float* wf = (float*)(lds + 65536 + 2048);
    unsigned* hist = (unsigned*)(lds + 65536 + 4096);
    u64* tiebits = (u64*)(lds + 65536 + 8192);
    int* sh = (int*)(lds + 65536 + 12288);
    for (int t = blockIdx.x; t < S; t += gridDim.x) {
        const int tq = t >> 6, nadm = 64 * (tq + 1), ntw = 4 * (t >> 8) + 4;
        __syncthreads();
        if (nadm <= KSEL) {
            if (tid < ntw) MASK[(size_t)tid * S + t] = (tid <= tq) ? ~0ull : 0ull;
            continue;
        }
        qif[tid] = bf2f(PROJ[(size_t)t * NP + C_QI + tid]); if (tid < 8) wf[tid] = WI[t * 8 + tid];
        __syncthreads();
        for (int s = tid; s < nadm; s += NTHREADS) {
            float kf[64];
#pragma unroll
            for (int j = 0; j < 8; ++j) { const u32x4 v = *(const u32x4*)(KI + (size_t)s * 64 + j * 8);
                kf[j * 8 + 0] = blo(v.x); kf[j * 8 + 1] = bhi(v.x); kf[j * 8 + 2] = blo(v.y); kf[j * 8 + 3] = bhi(v.y); kf[j * 8 + 4] = blo(v.z); kf[j * 8 + 5] = bhi(v.z); kf[j * 8 + 6] = blo(v.w); kf[j * 8 + 7] = bhi(v.w); }
            float I = 0.f;
            for (int h = 0; h < 8; ++h) { float d = 0.f;
#pragma unroll
                for (int k = 0; k < 64; k += 4) { const f32x4 q4 = *(const f32x4*)(qif + h * 64 + k); d = fmaf(q4.x, kf[k], d); d = fmaf(q4.y, kf[k + 1], d); d = fmaf(q4.z, kf[k + 2], d); d = fmaf(q4.w, kf[k + 3], d); }
                I = fmaf(wf[h], fmaxf(d, 0.f), I); }
            scores[s] = I;
        }
        __syncthreads();
        unsigned prefix = 0; int kk = KSEL;
        for (int ps = 0; ps < 4; ++ps) {
            const int shift = 24 - 8 * ps;
            if (tid < 256) hist[tid] = 0u;
            __syncthreads();
            for (int s = tid; s < nadm; s += NTHREADS) { const unsigned key = fkey(scores[s]); if (ps == 0 || (key >> (shift + 8)) == prefix) atomicAdd(&hist[(key >> shift) & 255u], 1u); }
            __syncthreads();
            if (wave == 0) {
                unsigned c4[4]; unsigned tot = 0;
#pragma unroll
                for (int j = 0; j < 4; ++j) { c4[j] = hist[255 - (4 * lane + j)]; tot += c4[j]; }
                unsigned incl = tot;
#pragma unroll
                for (int o = 1; o < 64; o <<= 1) { const unsigned v = __shfl_up(incl, o); if (lane >= o) incl += v; }
                const unsigned excl = incl - tot;
                if (excl < (unsigned)kk && (unsigned)kk <= incl) { const unsigned s0 = excl + c4[0], s1 = s0 + c4[1], s2 = s1 + c4[2]; const unsigned ukk = (unsigned)kk;
                    const int j = ukk <= s0 ? 0 : ukk <= s1 ? 1 : ukk <= s2 ? 2 : 3; const unsigned cum = ukk <= s0 ? excl : ukk <= s1 ? s0 : ukk <= s2 ? s1 : s2;
                    sh[0] = 255 - (4 * lane + j); sh[1] = kk - (int)cum; }
            }
            __syncthreads();
            prefix = (prefix << 8) | (unsigned)sh[0]; kk = sh[1];
            __syncthreads();
        }
        const unsigned T = prefix;
        if (wave == 0) { int run = 0;
            for (int tile = 0; tile <= tq; ++tile) { const bool tie = fkey(scores[tile * 64 + lane]) == T; const u64 bal = __ballot(tie);
                const int rank = run + __popcll(bal & ((1ull << lane) - 1ull)); const u64 tb = __ballot(tie && rank < kk); if (lane == 0) tiebits[tile] = tb; run += __popcll(bal); } }
        __syncthreads();
        for (int tile = wave; tile < ntw; tile += NWAVES) { u64 w = 0ull;
            if (tile <= tq) { w = __ballot(fkey(scores[tile * 64 + lane]) > T) | tiebits[tile]; }
            if (lane == 0) MASK[(size_t)tile * S + t] = w; }
    }
}

namespace idxf {
typedef short bf16x8 __attribute__((ext_vector_type(8)));
typedef float f32x16 __attribute__((ext_vector_type(16)));
constexpr int L_B = 0, L_HIST = 36864, L_PK = L_HIST + 32 * 257 * 4, L_TAIL = L_PK + 512, L_END = L_TAIL + 32 * 64 * 4;
static_assert(L_END <= 131072, "idx LDS");
__device__ __forceinline__ unsigned fkey32(float f) { const unsigned u = __float_as_uint(f); return u ^ ((unsigned)((int)u >> 31) | 0x80000000u); }

template <int MODE>
__device__ __forceinline__ void sweep(const Params& p, LAS unsigned char* L, int q0, int ntk, int wave, int lane) {
    const int j = lane & 31, hi = lane >> 5;
    const bf16* KI = (const bf16*)(p.ws + WS_KI); u64* MASK = (u64*)(p.ws + WS_MASK);
    LAS unsigned* hist = (LAS unsigned*)(L + L_HIST) + j * 257; LAS unsigned* PK = (LAS unsigned*)(L + L_PK); LAS unsigned* tail = (LAS unsigned*)(L + L_TAIL);
    float w[8]; { const f32x4 wa = *(const f32x4*)((const float*)(p.ws + WS_WI) + (size_t)(q0 + j) * 8), wb = *(const f32x4*)((const float*)(p.ws + WS_WI) + (size_t)(q0 + j) * 8 + 4);
        w[0] = wa.x; w[1] = wa.y; w[2] = wa.z; w[3] = wa.w; w[4] = wb.x; w[5] = wb.y; w[6] = wb.z; w[7] = wb.w; }
    const unsigned P = (MODE == 1) ? 0u : PK[j];
    const LAS unsigned char* bfr = L + L_B + lane * 16;
    const bf16* abase = KI + (size_t)(lane & 31) * 64 + hi * 8;
    for (int kt = wave; kt < ntk; kt += NWAVES) {
        bf16x8 a[2][4];
#pragma unroll
        for (int hf = 0; hf < 2; ++hf)
#pragma unroll
            for (int ks = 0; ks < 4; ++ks) a[hf][ks] = *(const bf16x8*)(abase + (size_t)(kt * 64 + hf * 32) * 64 + ks * 16);
        f32x16 L0 = f32x16{}, L1 = f32x16{}; float I0[16], I1[16];
        f32x16 cA0 = f32x16{}, cA1 = f32x16{}, cB0, cB1;
#define IDX_CHAIN(D0, D1, H) do { D0 = f32x16{}; D1 = f32x16{}; _Pragma("unroll") for (int ks = 0; ks < 4; ++ks) { const bf16x8 b = *(const LAS bf16x8*)(bfr + ((H) * 4 + ks) * 1024); \
            D0 = __builtin_amdgcn_mfma_f32_32x32x16_bf16(a[0][ks], b, D0, 0, 0, 0); D1 = __builtin_amdgcn_mfma_f32_32x32x16_bf16(a[1][ks], b, D1, 0, 0, 0); } } while (0)
#define IDX_ACC(C0_, C1_, H) do { _Pragma("unroll") for (int r = 0; r < 16; ++r) { I0[r] = fmaf(w[H], __builtin_fabsf(C0_[r]), I0[r]); I1[r] = fmaf(w[H], __builtin_fabsf(C1_[r]), I1[r]); asm volatile("" : "+v"(I0[r]), "+v"(I1[r])); } } while (0)
        IDX_CHAIN(L0, L1, 8);
        IDX_CHAIN(cA0, cA1, 0);
        __builtin_amdgcn_sched_barrier(0);
#pragma unroll
        for (int r = 0; r < 16; ++r) { I0[r] = L0[r]; I1[r] = L1[r]; }
        IDX_CHAIN(cB0, cB1, 1); IDX_ACC(cA0, cA1, 0); __builtin_amdgcn_sched_barrier(0);
        IDX_CHAIN(cA0, cA1, 2); IDX_ACC(cB0, cB1, 1); __builtin_amdgcn_sched_barrier(0);
        IDX_CHAIN(cB0, cB1, 3); IDX_ACC(cA0, cA1, 2); __builtin_amdgcn_sched_barrier(0);
        IDX_CHAIN(cA0, cA1, 4); IDX_ACC(cB0, cB1, 3); __builtin_amdgcn_sched_barrier(0);
        IDX_CHAIN(cB0, cB1, 5); IDX_ACC(cA0, cA1, 4); __builtin_amdgcn_sched_barrier(0);
        IDX_CHAIN(cA0, cA1, 6); IDX_ACC(cB0, cB1, 5); __builtin_amdgcn_sched_barrier(0);
        IDX_CHAIN(cB0, cB1, 7); IDX_ACC(cA0, cA1, 6); __builtin_amdgcn_sched_barrier(0);
        IDX_ACC(cB0, cB1, 7);
        __builtin_amdgcn_sched_barrier(0);
#undef IDX_CHAIN
#undef IDX_ACC
        if (MODE == 1) {
#pragma unroll
            for (int r = 0; r < 16; ++r) { const unsigned k0 = fkey32(I0[r]), k1 = fkey32(I1[r]);
                __hip_atomic_fetch_add(hist + (k0 >> 24), 1u, __ATOMIC_RELAXED, __HIP_MEMORY_SCOPE_WORKGROUP); __hip_atomic_fetch_add(hist + (k1 >> 24), 1u, __ATOMIC_RELAXED, __HIP_MEMORY_SCOPE_WORKGROUP); }
        } else if (MODE == 2) {
#pragma unroll
            for (int r = 0; r < 16; ++r) { const unsigned k0 = fkey32(I0[r]), k1 = fkey32(I1[r]);
                if ((k0 >> 24) == P) __hip_atomic_fetch_add(hist + ((k0 >> 16) & 255u), 1u, __ATOMIC_RELAXED, __HIP_MEMORY_SCOPE_WORKGROUP);
                if ((k1 >> 24) == P) __hip_atomic_fetch_add(hist + ((k1 >> 16) & 255u), 1u, __ATOMIC_RELAXED, __HIP_MEMORY_SCOPE_WORKGROUP); }
        } else {
            unsigned wlo = 0u, whi = 0u;
#pragma unroll
            for (int r = 0; r < 16; ++r) { const int kb = (r & 3) + 8 * (r >> 2); const unsigned k0 = fkey32(I0[r]), k1 = fkey32(I1[r]);
                wlo |= ((k0 >> 16) > P) ? (1u << kb) : 0u; whi |= ((k1 >> 16) > P) ? (1u << kb) : 0u;
                if ((k0 >> 16) == P) { const unsigned pos = __hip_atomic_fetch_add(PK + 64 + j, 1u, __ATOMIC_RELAXED, __HIP_MEMORY_SCOPE_WORKGROUP); if (pos < 64u) tail[j * 64 + pos] = ((k0 & 0xffffu) << 14) | (unsigned)(16383 - (kt * 64 + kb + 4 * hi)); }
                if ((k1 >> 16) == P) { const unsigned pos = __hip_atomic_fetch_add(PK + 64 + j, 1u, __ATOMIC_RELAXED, __HIP_MEMORY_SCOPE_WORKGROUP); if (pos < 64u) tail[j * 64 + pos] = ((k1 & 0xffffu) << 14) | (unsigned)(16383 - (kt * 64 + 32 + kb + 4 * hi)); } }
            wlo <<= 4 * hi; whi <<= 4 * hi;
            wlo |= (unsigned)__shfl_xor((int)wlo, 32); whi |= (unsigned)__shfl_xor((int)whi, 32);
            if (hi == 0) MASK[(size_t)kt * S + q0 + j] = ((u64)whi << 32) | (u64)wlo;
        }
    }
}

__device__ __forceinline__ void scan4(LAS unsigned char* L, int wave, int lane) {
    LAS unsigned* PK = (LAS unsigned*)(L + L_PK);
    for (int qq = 0; qq < 4; ++qq) { const int jq = wave * 4 + qq; const LAS unsigned* hb = (const LAS unsigned*)(L + L_HIST) + jq * 257;
        const unsigned kk = PK[32 + jq];
        const unsigned c0 = hb[255 - 4 * lane], c1 = hb[254 - 4 * lane], c2 = hb[253 - 4 * lane], c3 = hb[252 - 4 * lane]; const unsigned tot = c0 + c1 + c2 + c3;
        unsigned incl = tot;
#pragma unroll
        for (int o = 1; o < 64; o <<= 1) { const unsigned v = __shfl_up(incl, o); if (lane >= o) incl += v; }
        const unsigned excl = incl - tot;
        if (excl < kk && kk <= incl) { const unsigned s0 = excl + c0, s1 = s0 + c1, s2 = s1 + c2;
            const int jb = kk <= s0 ? 0 : kk <= s1 ? 1 : kk <= s2 ? 2 : 3; const unsigned cum = kk <= s0 ? excl : kk <= s1 ? s0 : kk <= s2 ? s1 : s2;
            PK[jq] = (PK[jq] << 8) | (unsigned)(255 - (4 * lane + jb)); PK[32 + jq] = kk - cum; }
    }
}

__device__ __forceinline__ void idx_unit(const Params& p, unsigned char* lds, int u) {
    int tid_ = threadIdx.x; asm volatile("" : "+v"(tid_)); const int tid = tid_, lane = tid & 63; const int wave = __builtin_amdgcn_readfirstlane(tid >> 6);
    LAS unsigned char* L = (LAS unsigned char*)lds;
    const int q0 = u * 32, tq = q0 >> 6, ntk = tq + 1, ntw = 4 * (q0 >> 8) + 4;
    u64* MASK = (u64*)(p.ws + WS_MASK);
    if (ntk * 64 <= KSEL) { for (int i = tid; i < ntw * 32; i += NTHREADS) { const int tile = i >> 5; MASK[(size_t)tile * S + q0 + (i & 31)] = (tile <= tq) ? ~0ull : 0ull; } return; }
    for (int i = tid; i < (ntw - ntk) * 32; i += NTHREADS) MASK[(size_t)(ntk + (i >> 5)) * S + q0 + (i & 31)] = 0ull;
    __syncthreads();
    { const bf16* PROJ = (const bf16*)(p.ws + WS_PROJ); const bf16* QL = (const bf16*)(p.ws + WS_QL); const int j = lane & 31, hi = lane >> 5;
        for (int f = wave; f < 36; f += NWAVES) { const int h = f >> 2, ks = f & 3;
            const bf16* src = (h < 8) ? PROJ + (size_t)(q0 + j) * NP + C_QI + h * 64 + ks * 16 + hi * 8 : QL + (size_t)(q0 + j) * 64 + ks * 16 + hi * 8;
            *(LAS u32x4*)(L + L_B + f * 1024 + lane * 16) = *(const u32x4*)src; } }
    LAS unsigned* PK = (LAS unsigned*)(L + L_PK);
    if (tid < 32) { PK[tid] = 0u; PK[32 + tid] = (unsigned)KSEL; PK[64 + tid] = 0u; }
    for (int i = tid; i < 32 * 257; i += NTHREADS) ((LAS unsigned*)(L + L_HIST))[i] = 0u;
    __syncthreads();
    sweep<1>(p, L, q0, ntk, wave, lane);
    __syncthreads();
    scan4(L, wave, lane);
    __syncthreads();
    for (int i = tid; i < 32 * 257; i += NTHREADS) ((LAS unsigned*)(L + L_HIST))[i] = 0u;
    __syncthreads();
    sweep<2>(p, L, q0, ntk, wave, lane);
    __syncthreads();
    scan4(L, wave, lane);
    __syncthreads();
    sweep<3>(p, L, q0, ntk, wave, lane);
    __syncthreads();
    { const int jq = tid >> 4, e0 = tid & 15; const unsigned n = min(PK[64 + jq], 64u), kk = PK[32 + jq]; const LAS unsigned* tl = (const LAS unsigned*)(L + L_TAIL) + jq * 64;
        for (unsigned e = e0; e < n; e += 16) { const unsigned v = tl[e]; unsigned rank = 0; for (unsigned e2 = 0; e2 < n; ++e2) rank += (tl[e2] > v) ? 1u : 0u;
            if (rank < kk) { const int s = 16383 - (int)(v & 16383u); atomicOr((unsigned long long*)&MASK[(size_t)(s >> 6) * S + q0 + jq], 1ull << (s & 63)); } } }
}
__device__ __forceinline__ void idx_phase(const Params& p, unsigned char* lds) {
    for (int w = blockIdx.x; w < 256; w += gridDim.x) { idx_unit(p, lds, w); idx_unit(p, lds, 511 - w); }
}
}

__device__ __forceinline__ void phase_att_naive(const Params& p, unsigned char* lds) {
    const int tid = opaque_tid(), lane = tid & 63, wave = tid >> 6;
    const bf16* PROJ = (const bf16*)(p.ws + WS_PROJ); bf16* MIX = (bf16*)(p.ws + WS_MIX); const u64* MASK = (const u64*)(p.ws + WS_MASK);
    int* sidx = (int*)(lds + wave * 2048); float* slog = (float*)(lds + wave * 2048 + 1024);
    const int h = wave;
    for (int t = blockIdx.x; t < S; t += gridDim.x) {
        const int tq = t >> 6;
        float qf[64];
#pragma unroll
        for (int j = 0; j < 8; ++j) { const u32x4 v = *(const u32x4*)(PROJ + (size_t)t * NP + C_Q + h * 64 + j * 8);
            qf[j * 8 + 0] = blo(v.x); qf[j * 8 + 1] = bhi(v.x); qf[j * 8 + 2] = blo(v.y); qf[j * 8 + 3] = bhi(v.y); qf[j * 8 + 4] = blo(v.z); qf[j * 8 + 5] = bhi(v.z); qf[j * 8 + 6] = blo(v.w); qf[j * 8 + 7] = bhi(v.w); }
        int n = 0;
        for (int tile = 0; tile <= tq; ++tile) {
            const u64 w = MASK[(size_t)tile * S + t]; const bool sel = (w >> lane) & 1ull;
            if (w == 0ull) continue;
            float lg = 0.f; const int s = tile * 64 + lane;
            if (sel) {
#pragma unroll
                for (int j = 0; j < 8; ++j) { const u32x4 v = *(const u32x4*)(PROJ + (size_t)s * NP + C_K + h * 64 + j * 8);
                    lg = fmaf(qf[j * 8 + 0], blo(v.x), lg); lg = fmaf(qf[j * 8 + 1], bhi(v.x), lg); lg = fmaf(qf[j * 8 + 2], blo(v.y), lg); lg = fmaf(qf[j * 8 + 3], bhi(v.y), lg);
                    lg = fmaf(qf[j * 8 + 4], blo(v.z), lg); lg = fmaf(qf[j * 8 + 5], bhi(v.z), lg); lg = fmaf(qf[j * 8 + 6], blo(v.w), lg); lg = fmaf(qf[j * 8 + 7], bhi(v.w), lg); }
                const int pos = n + __popcll(w & ((1ull << lane) - 1ull));
                if (pos < 256) { sidx[pos] = s; slog[pos] = lg; }
            }
            n += __popcll(w);
        }
        if (n > 256) n = 256;
        __builtin_amdgcn_s_waitcnt(0); asm volatile("" ::: "memory");
        float m = -INFINITY; for (int j = lane; j < n; j += 64) m = fmaxf(m, slog[j]);
        m = wave_max(m);
        float l = 0.f; for (int j = lane; j < n; j += 64) { const float pj = exp2f(slog[j] - m); slog[j] = pj; l += pj; }
        l = wave_sum(l);
        __builtin_amdgcn_s_waitcnt(0); asm volatile("" ::: "memory");
        float o = 0.f;
        for (int j = 0; j < n; ++j) o = fmaf(slog[j], bf2f(PROJ[(size_t)sidx[j] * NP + C_V + h * 64 + lane]), o);
        MIX[(size_t)t * D + 512 + h * 64 + lane] = (bf16)f2bf(o / l);
        __builtin_amdgcn_s_waitcnt(0); asm volatile("" ::: "memory");
    }
}

namespace attn_body {
using bf16=__hip_bfloat16;
using bf16x8=__attribute__((ext_vector_type(8)))short;
using s16x4=__attribute__((ext_vector_type(4)))short;
using f32x16=__attribute__((ext_vector_type(16)))float;
using u32x4=__attribute__((ext_vector_type(4)))unsigned;
constexpr int NHEAD=8,SEQ=16384,D=64,DMI=3328,DMO=1024;
typedef unsigned long long u64;
constexpr int NW=8,QBLK=32,QB=QBLK*NW,KVBLK=64,NQB=SEQ/QB;
__device__ __forceinline__ int crow(int r,int hi){return (r&3)+8*(r>>2)+4*hi;}
#define SBAR() __builtin_amdgcn_sched_barrier(0)
__device__ __forceinline__ void cmask(f32x16&p0,f32x16&p1,int jb,int qrel,int hi){
  const float NEG=-INFINITY; int kb=64*jb+4*hi;
  #pragma unroll
  for(int r=0;r<16;++r){int kv=kb+(r&3)+8*(r>>2); if(kv>qrel)p0[r]=NEG; if(kv+32>qrel)p1[r]=NEG;}
}

constexpr int NSLOT=3, SLOTB=8192;
constexpr int LDS_K=0, LDS_V=NSLOT*SLOTB, LDS_WS=2*NSLOT*SLOTB, LDS_OST=LDS_WS+NW*64*4, LDS_M=LDS_OST+NW*4096, LDS_BYTES=LDS_M+NW*2048;
constexpr float C2=0.125f*1.4426950408889634f;
__device__ __forceinline__ void glds16s(const void*sbase,unsigned voff,unsigned lds_dst){unsigned keep;
  asm volatile("s_mov_b32 %0, m0\n\ts_mov_b32 m0, %3\n\ts_nop 0\n\tglobal_load_lds_dwordx4 %1, %2\n\ts_mov_b32 m0, %0":"=&s"(keep):"v"(voff),"s"(sbase),"s"(lds_dst):"memory");}
__device__ __forceinline__ void glds16(const void*gsrc,unsigned lds_dst){unsigned keep;
  asm volatile("s_mov_b32 %0, m0\n\ts_mov_b32 m0, %2\n\ts_nop 0\n\tglobal_load_lds_dwordx4 %1, off\n\ts_mov_b32 m0, %0":"=&s"(keep):"v"(gsrc),"s"(lds_dst):"memory");}
__device__ __forceinline__ float max3f(float a,float b,float c){float r;asm("v_max3_f32 %0, %1, %2, %3":"=v"(r):"v"(a),"v"(b),"v"(c));return r;}
__device__ __forceinline__ float max2f(float a,float b){float r;asm("v_max_f32_e32 %0, %1, %2":"=v"(r):"v"(a),"v"(b));return r;}
__device__ __forceinline__ float fadd_s(float a,float b){float r;asm("v_add_f32_e32 %0, %1, %2":"=v"(r):"v"(a),"v"(b));return r;}
__device__ __forceinline__ float fsub_s(float a,float b){float r;asm("v_sub_f32_e32 %0, %1, %2":"=v"(r):"v"(a),"v"(b));return r;}
typedef float f32x2_t __attribute__((ext_vector_type(2))); typedef __bf16 bf16x2_t __attribute__((ext_vector_type(2)));
__device__ __forceinline__ unsigned cvtpk_s(float lo,float hi){f32x2_t v={lo,hi};bf16x2_t b=__builtin_convertvector(v,bf16x2_t);return __builtin_bit_cast(unsigned,b);}
#define WAIT_BAR(N) asm volatile("s_waitcnt vmcnt(" #N ") lgkmcnt(0)\n\ts_barrier":::"memory")

__device__ __forceinline__ void qkt(f32x16&p0,f32x16&p1,const char*Kslot,const bf16x8*qr,int r32,int hi){ const f32x16 negm=f32x16{};
  const char*kb=Kslot+hi*1024+r32*16;
  #pragma unroll
  for(int d0=0;d0<4;++d0){
    const bf16x8 b0=*reinterpret_cast<const bf16x8*>(kb+d0*2048);
    const bf16x8 b1=*reinterpret_cast<const bf16x8*>(kb+d0*2048+512);
    if(d0==0){p0=__builtin_amdgcn_mfma_f32_32x32x16_bf16(b0,qr[0],negm,0,0,0);p1=__builtin_amdgcn_mfma_f32_32x32x16_bf16(b1,qr[0],negm,0,0,0);}
    else{p0=__builtin_amdgcn_mfma_f32_32x32x16_bf16(b0,qr[d0],p0,0,0,0);p1=__builtin_amdgcn_mfma_f32_32x32x16_bf16(b1,qr[d0],p1,0,0,0);}}
}
typedef __attribute__((address_space(3))) const char* lds_cptr;
typedef short v4i16_t __attribute__((ext_vector_type(4)));
__device__ __forceinline__ void kload8(bf16x8*kf,lds_cptr kp){
  kf[0]=*(const __attribute__((address_space(3))) bf16x8*)(kp);      kf[1]=*(const __attribute__((address_space(3))) bf16x8*)(kp+512);
  kf[2]=*(const __attribute__((address_space(3))) bf16x8*)(kp+2048); kf[3]=*(const __attribute__((address_space(3))) bf16x8*)(kp+2560);
  kf[4]=*(const __attribute__((address_space(3))) bf16x8*)(kp+4096); kf[5]=*(const __attribute__((address_space(3))) bf16x8*)(kp+4608);
  kf[6]=*(const __attribute__((address_space(3))) bf16x8*)(kp+6144); kf[7]=*(const __attribute__((address_space(3))) bf16x8*)(kp+6656);
}
__device__ __forceinline__ void kload2(bf16x8*kf,lds_cptr kp,int j){ kf[2*j]=*(const __attribute__((address_space(3))) bf16x8*)(kp+j*2048); kf[2*j+1]=*(const __attribute__((address_space(3))) bf16x8*)(kp+j*2048+512); }
__device__ __forceinline__ s16x4 vtr(lds_cptr p){ return __builtin_bit_cast(s16x4,__builtin_amdgcn_ds_read_tr16_b64_v4i16((__attribute__((address_space(3))) v4i16_t*)p)); }
__device__ __forceinline__ float rowmax(const f32x16&p0,const f32x16&p1){
  float a=max3f(p0[0],p0[1],p1[0]),b=max3f(p0[2],p0[3],p1[1]);a=max3f(a,p1[2],p1[3]);
  #pragma unroll
  for(int r=4;r<16;r+=4){a=max3f(a,p0[r],p0[r+1]);b=max3f(b,p0[r+2],p0[r+3]);a=max3f(a,p1[r],p1[r+1]);b=max3f(b,p1[r+2],p1[r+3]);}
  const float m=max2f(a,b);
  auto rr=__builtin_amdgcn_permlane32_swap(__float_as_uint(m),__float_as_uint(m),false,false);
  return max2f(__uint_as_float(rr[0]),__uint_as_float(rr[1]));
}
__device__ __forceinline__ void pv(f32x16*o,int vb,bf16x8 pa0,bf16x8 pa1,bf16x8 pa2,bf16x8 pa3){
  #pragma unroll
  for(int d0=0;d0<2;++d0){s16x4 lo[4],hi[4];
    #pragma unroll
    for(int ks=0;ks<4;++ks){
      asm volatile("ds_read_b64_tr_b16 %0,%1 offset:%c2":"=&v"(lo[ks]):"v"(vb),"i"(d0*4096+ks*1024):"memory");
      asm volatile("ds_read_b64_tr_b16 %0,%1 offset:%c2":"=&v"(hi[ks]):"v"(vb),"i"(d0*4096+ks*1024+512):"memory");}
    asm volatile("s_waitcnt lgkmcnt(0)":::"memory");SBAR();
    #define PK(k) (bf16x8){lo[k][0],lo[k][1],lo[k][2],lo[k][3],hi[k][0],hi[k][1],hi[k][2],hi[k][3]}
    o[d0]=__builtin_amdgcn_mfma_f32_32x32x16_bf16(pa0,PK(0),o[d0],0,0,0);
    o[d0]=__builtin_amdgcn_mfma_f32_32x32x16_bf16(pa1,PK(1),o[d0],0,0,0);
    o[d0]=__builtin_amdgcn_mfma_f32_32x32x16_bf16(pa2,PK(2),o[d0],0,0,0);
    o[d0]=__builtin_amdgcn_mfma_f32_32x32x16_bf16(pa3,PK(3),o[d0],0,0,0);
    #undef PK
  }
}

#ifndef ATTN_STORE16
#define ATTN_STORE16(p,v) (*(u32x4*)(p)=(v))
#endif
template<int THRL> __device__ __forceinline__ void attn_unit(int h,int qb,const bf16*Q,const bf16*__restrict__ K,const bf16*__restrict__ V,const u64*__restrict__ MASK,bf16*O,char*shm){
  int tid_=threadIdx.x; asm volatile("":"+v"(tid_)); const int tid=tid_,lane=tid&63,r32=lane&31,hi=lane>>5; const int wid=__builtin_amdgcn_readfirstlane(tid>>6);
  const long rowbase=0; const int q0=qb*QB;
  const bf16*Qw=Q+(rowbase+q0+wid*QBLK)*DMI+h*D;
  const bf16*Kh=K+rowbase*DMI+h*D,*Vh=V+rowbase*DMI+h*D;
  const unsigned lds0=(unsigned)(uintptr_t)shm;
  float*wsf=(float*)(shm+LDS_WS)+wid*64;
  const unsigned koff=(unsigned)(lane*DMI+wid*8)*2u;
  const unsigned voffv=(unsigned)((16*(wid&3)+(lane>>2))*DMI+(wid>>2)*32+(lane&3)*8)*2u;
  const unsigned kdst=lds0+LDS_K+wid*1024, vdst=lds0+LDS_V+wid*1024;
  const u64*mbase=MASK+q0+wid*QBLK; const int jm=lane>>4; const unsigned mdst=lds0+LDS_M+wid*2048; const unsigned moff0=(unsigned)(lane&15)*16u, moff1=moff0+((jm==1)?(unsigned)SEQ*8u:0u);
  #define DMA_M2(tA,tB,slot) glds16s(mbase+(size_t)(tA)*SEQ,((tB)!=(tA))?moff1:moff0,(unsigned)__builtin_amdgcn_readfirstlane(mdst+(slot)))
  const unsigned sh4=4u*(unsigned)hi; const float NEGINF=-INFINITY;
  #define MAPPLY(C0,C1,MW) do{ const unsigned lo_=(unsigned)(MW)>>sh4, hi_=(unsigned)((MW)>>32)>>sh4; \
    _Pragma("unroll") for(int r=0;r<16;++r){ const unsigned bit_=1u<<((r&3)+8*(r>>2)); C0[r]=(lo_&bit_)?C0[r]:NEGINF; C1[r]=(hi_&bit_)?C1[r]:NEGINF; } }while(0)
  #define DMA_K(t,slot) glds16s(Kh+(long)(t)*KVBLK*DMI,koff,(unsigned)__builtin_amdgcn_readfirstlane(kdst+(slot)))
  #define DMA_V(t,slot) glds16s(Vh+(long)(t)*KVBLK*DMI,voffv,(unsigned)__builtin_amdgcn_readfirstlane(vdst+(slot)))
  const int vb0=(int)(lds0+LDS_V)+((lane>>4)&1)*32+(lane&3)*8+(4*hi+((lane&15)>>2))*64;
  const char*Kbase=shm+LDS_K; bf16x8 kf[8];
  const lds_cptr shm3=(lds_cptr)shm; const lds_cptr mp0=shm3+LDS_M+wid*2048+r32*8;
  #define MLD(off) (*(const __attribute__((address_space(3))) u64*)(mp0+(off)))
  const lds_cptr kp0=shm3+LDS_K+hi*1024+r32*16; const lds_cptr vp0=shm3+LDS_V+((lane>>4)&1)*32+(lane&3)*8+(4*hi+((lane&15)>>2))*64;
  const int NT=(q0+QB)/KVBLK;
  glds16s(mbase,moff0+((jm==0)?(unsigned)SEQ*8u:(jm==1)?(unsigned)SEQ*16u:0u),(unsigned)__builtin_amdgcn_readfirstlane(mdst));
  DMA_K(0,0);DMA_V(0,0);DMA_K(1,SLOTB);
  bf16x8 qr[4];
  #pragma unroll
  for(int d0=0;d0<4;++d0)qr[d0]=*reinterpret_cast<const bf16x8*>(&Qw[(long)r32*DMI+d0*16+hi*8]);
  float mhat=0.f,l_reg=0.f;f32x16 o[2];o[0]=f32x16{};o[1]=f32x16{};const f32x16 Z16=f32x16{};
  bool resc=false;
  #define START(P0,P1,MW) do{ const float rm=rowmax(P0,P1); resc=false; \
    if(__builtin_expect(__any(rm>(float)THRL),0)){ const float dl=__builtin_fmaxf(rm,0.f); mhat+=dl; \
      _Pragma("unroll") for(int r=0;r<16;++r){P0[r]-=dl;P1[r]-=dl;} } \
    MAPPLY(P0,P1,MW); \
    _Pragma("unroll") for(int r=0;r<16;++r)P0[r]=__builtin_amdgcn_exp2f(P0[r]); }while(0)
  #define RESC() do{ if(resc){ asm volatile("s_waitcnt lgkmcnt(0)":::"memory"); \
      _Pragma("unroll") for(int d_=0;d_<2;++d_) _Pragma("unroll") for(int r=0;r<16;++r)o[d_][r]*=wsf[crow(r,hi)]; } }while(0)
  f32x16 pA0,pA1,pB0,pB1;
  int sl_prev=0,sl_cur=0,sl_next=SLOTB;
  #define ROT() do{sl_prev=sl_cur;sl_cur=sl_next;sl_next=(sl_next==(NSLOT-1)*SLOTB)?0:sl_next+SLOTB;}while(0)
  DMA_K(2,2*SLOTB);
  WAIT_BAR(3);
  const u64 mw0=MLD(512);
  qkt(pA0,pA1,Kbase,qr,r32,hi);asm volatile("s_nop 15\n\ts_nop 7":"+v"(pA0),"+v"(pA1));
  START(pA0,pA1,mw0);
  _Pragma("unroll") for(int r=0;r<16;++r)pA1[r]=__builtin_amdgcn_exp2f(pA1[r]);
  WAIT_BAR(0);
  DMA_K(3,0);DMA_V(1,SLOTB);
  ROT();
  kload8(kf,kp0+sl_cur);
  WAIT_BAR(2);
  s16x4 vlo[8],vhi[8]; u32x4 pw0,pw1,pw2,pw3;
  #define PKW(P,B) cvtpk_s(P[B],P[B+1])
  #define PAF(k) __builtin_bit_cast(bf16x8,pw##k)
  #define VFR(i) (bf16x8){vlo[i][0],vlo[i][1],vlo[i][2],vlo[i][3],vhi[i][0],vhi[i][1],vhi[i][2],vhi[i][3]}
  #define PIN(x) asm volatile("":"+v"(x))
  #define MX3(a,b,c) __builtin_fmaxf(__builtin_fmaxf((a),(b)),(c))
  #define GAPA(MF,A0,A1,A2,A3,W0,W1,PW) do{ MF; sacc+=A0; sacc+=A1; sacc+=A2; sacc+=A3; PIN(sacc); W0; W1; PIN(PW); SBAR(); }while(0)
  #define EX(v) __builtin_amdgcn_exp2f(v)
  #define GAPB(MF,X,B) do{ MF; X[B]=EX(X[B]); X[B+1]=EX(X[B+1]); X[B+2]=EX(X[B+2]); X[B+3]=EX(X[B+3]); PIN(X); SBAR(); }while(0)
  #define VRD(i) do{ vlo[i]=vtr(vp_+(((i)>>2)*4096+((i)&3)*1024)); vhi[i]=vtr(vp_+(((i)>>2)*4096+((i)&3)*1024+512)); }while(0)
  #define KRD(G,j) do{ if(G){ kload2(kf,kp0+sl_next,j); SBAR(); } }while(0)
  #define STEP(C0,C1,P0,P1,t,GK,GV,GL,GM,MOFF) do{ SBAR(); \
    const lds_cptr vp_=vp0+sl_prev; \
    VRD(0); SBAR(); float sacc=(P0[0]+P0[1]); \
    GAPA(C0=__builtin_amdgcn_mfma_f32_32x32x16_bf16(kf[0],qr[0],Z16,0,0,0), P0[2],P0[3],P0[4],P0[5],     pw0[0]=PKW(P0,0), pw0[1]=PKW(P0,2), pw0); \
    VRD(4); SBAR(); GAPA(C1=__builtin_amdgcn_mfma_f32_32x32x16_bf16(kf[1],qr[0],Z16,0,0,0), P0[6],P0[7],P0[8],P0[9],     pw0[2]=PKW(P0,4), pw0[3]=PKW(P0,6), pw0); \
    VRD(1); SBAR(); GAPA(C0=__builtin_amdgcn_mfma_f32_32x32x16_bf16(kf[2],qr[1],C0,0,0,0),   P0[10],P0[11],P0[12],P0[13], pw1[0]=PKW(P0,8), pw1[1]=PKW(P0,10), pw1); \
    VRD(5); SBAR(); GAPA(C1=__builtin_amdgcn_mfma_f32_32x32x16_bf16(kf[3],qr[1],C1,0,0,0),   P0[14],P0[15],P1[0],P1[1],   pw1[2]=PKW(P0,12),pw1[3]=PKW(P0,14), pw1); \
    VRD(2); SBAR(); GAPA(C0=__builtin_amdgcn_mfma_f32_32x32x16_bf16(kf[4],qr[2],C0,0,0,0),   P1[2],P1[3],P1[4],P1[5],     pw2[0]=PKW(P1,0), pw2[1]=PKW(P1,2), pw2); \
    VRD(6); SBAR(); GAPA(C1=__builtin_amdgcn_mfma_f32_32x32x16_bf16(kf[5],qr[2],C1,0,0,0),   P1[6],P1[7],P1[8],P1[9],     pw2[2]=PKW(P1,4), pw2[3]=PKW(P1,6), pw2); \
    VRD(3); SBAR(); GAPA(C0=__builtin_amdgcn_mfma_f32_32x32x16_bf16(kf[6],qr[3],C0,0,0,0),   P1[10],P1[11],P1[12],P1[13], pw3[0]=PKW(P1,8), pw3[1]=PKW(P1,10), pw3); \
    VRD(7); SBAR(); GAPA(C1=__builtin_amdgcn_mfma_f32_32x32x16_bf16(kf[7],qr[3],C1,0,0,0),   P1[14],P1[15],0.f,0.f,       pw3[2]=PKW(P1,12),pw3[3]=PKW(P1,14), pw3); \
    l_reg+=sacc; \
    if(GK){DMA_K((t)+3,sl_cur);} if(GV){DMA_V((t)+1,sl_next);} if(GM){ const int tb_=((t)+3<NT)?(t)+3:NT-1; DMA_M2((t)+2,tb_,mslot^1024); } \
    const u64 mw_=MLD(MOFF); \
    if(__builtin_expect(__any(mhat!=0.f),0)){ _Pragma("unroll") for(int r=0;r<16;++r){C0[r]-=mhat;C1[r]-=mhat;} } \
    { float a=MX3(C0[0],C0[1],C1[0]),b=MX3(C0[2],C0[3],C1[1]); a=MX3(a,C1[2],C1[3]); \
      _Pragma("unroll") for(int r=4;r<16;r+=4){a=MX3(a,C0[r],C0[r+1]);b=MX3(b,C0[r+2],C0[r+3]);a=MX3(a,C1[r],C1[r+1]);b=MX3(b,C1[r+2],C1[r+3]);} \
      float rm=__builtin_fmaxf(a,b); { auto rr=__builtin_amdgcn_permlane32_swap(__float_as_uint(rm),__float_as_uint(rm),false,false); rm=__builtin_fmaxf(__uint_as_float(rr[0]),__uint_as_float(rr[1])); } \
      resc=false; \
      if(__builtin_expect(__any(rm>(float)THRL),0)){ const float dl=__builtin_fmaxf(rm,0.f); mhat+=dl; \
        _Pragma("unroll") for(int r=0;r<16;++r){C0[r]-=dl;C1[r]-=dl;} \
        const float f=__builtin_amdgcn_exp2f(-dl); l_reg*=f; if(hi==0)wsf[r32]=f; resc=true; } } \
    MAPPLY(C0,C1,mw_); \
    SBAR(); \
    GAPB(o[0]=__builtin_amdgcn_mfma_f32_32x32x16_bf16(PAF(0),VFR(0),o[0],0,0,0), C0,0); \
    GAPB(o[1]=__builtin_amdgcn_mfma_f32_32x32x16_bf16(PAF(0),VFR(4),o[1],0,0,0), C0,4); \
    KRD(GL,0); GAPB(o[0]=__builtin_amdgcn_mfma_f32_32x32x16_bf16(PAF(1),VFR(1),o[0],0,0,0), C0,8); \
    KRD(GL,1); GAPB(o[1]=__builtin_amdgcn_mfma_f32_32x32x16_bf16(PAF(1),VFR(5),o[1],0,0,0), C0,12); \
    KRD(GL,2); GAPB(o[0]=__builtin_amdgcn_mfma_f32_32x32x16_bf16(PAF(2),VFR(2),o[0],0,0,0), C1,0); \
    KRD(GL,3); GAPB(o[1]=__builtin_amdgcn_mfma_f32_32x32x16_bf16(PAF(2),VFR(6),o[1],0,0,0), C1,4); \
    GAPB(o[0]=__builtin_amdgcn_mfma_f32_32x32x16_bf16(PAF(3),VFR(3),o[0],0,0,0), C1,8); \
    GAPB(o[1]=__builtin_amdgcn_mfma_f32_32x32x16_bf16(PAF(3),VFR(7),o[1],0,0,0), C1,12); \
    }while(0)
  int t=1; int mslot=0;
  for(;t+5<NT;t+=2){
    STEP(pB0,pB1,pA0,pA1,t,true,true,true,true,mslot);          WAIT_BAR(3); RESC(); ROT();
    STEP(pA0,pA1,pB0,pB1,t+1,true,true,true,false,mslot+256);   WAIT_BAR(2); RESC(); ROT(); mslot^=1024;
  }
  #define ENDW(nf) do{ if((nf)==3){WAIT_BAR(3);} else if((nf)==2){WAIT_BAR(2);} else if((nf)==1){WAIT_BAR(1);} else {WAIT_BAR(0);} }while(0)
  for(;t+1<NT;t+=2){
    { const bool gk=(t+3<NT),gv=(t+1<NT),gm=(t+2<NT); STEP(pB0,pB1,pA0,pA1,t,gk,gv,gv,gm,mslot);   ENDW((int)gk+(int)gv+(int)gm); RESC(); ROT(); }
    { const bool gk=(t+4<NT),gv=(t+2<NT);             STEP(pA0,pA1,pB0,pB1,t+1,gk,gv,gv,false,mslot+256); ENDW((t+3<NT)?((int)gk+(int)gv):0); RESC(); ROT(); mslot^=1024; }
  }
  STEP(pB0,pB1,pA0,pA1,NT-1,false,false,false,false,mslot); RESC();
  { float sacc=pB0[0]+pB0[1]; _Pragma("unroll") for(int r=2;r<16;++r)sacc+=pB0[r]; _Pragma("unroll") for(int r=0;r<16;++r)sacc+=pB1[r]; l_reg+=sacc;
    pw0=(u32x4){PKW(pB0,0),PKW(pB0,2),PKW(pB0,4),PKW(pB0,6)};pw1=(u32x4){PKW(pB0,8),PKW(pB0,10),PKW(pB0,12),PKW(pB0,14)};pw2=(u32x4){PKW(pB1,0),PKW(pB1,2),PKW(pB1,4),PKW(pB1,6)};pw3=(u32x4){PKW(pB1,8),PKW(pB1,10),PKW(pB1,12),PKW(pB1,14)};
    SBAR(); pv(o,vb0+sl_cur,PAF(0),PAF(1),PAF(2),PAF(3)); }
  #undef PKW
  #undef PAF
  #undef VFR
  #undef PIN
  #undef MX3
  #undef GAPA
  #undef GAPB
  #undef EX
  #undef VRD
  #undef KRD
  #undef STEP
  #undef ENDW
  {auto rr=__builtin_amdgcn_permlane32_swap(__float_as_uint(l_reg),__float_as_uint(l_reg),false,false);l_reg=__uint_as_float(rr[0])+__uint_as_float(rr[1]);}
  if(hi==0)wsf[32+r32]=l_reg;asm volatile("s_waitcnt lgkmcnt(0)":::"memory");
  float rli[16];
  #pragma unroll
  for(int r=0;r<16;++r)rli[r]=__builtin_amdgcn_rcpf(wsf[32+crow(r,hi)]);
  bf16*Ow=O+(rowbase+q0+wid*QBLK)*DMO+h*D;
  { bf16*stg=(bf16*)(shm+LDS_OST)+wid*2048;
    #pragma unroll
    for(int r=0;r<16;++r){const int orow=crow(r,hi);
      #pragma unroll
      for(int d0=0;d0<2;++d0)stg[orow*64+d0*32+r32]=__float2bfloat16(o[d0][r]*rli[r]);}
    asm volatile("s_waitcnt lgkmcnt(0)":::"memory");
    #pragma unroll
    for(int i=0;i<4;++i){const int row=i*8+(lane>>3),ch=lane&7; const u32x4 v=*(const u32x4*)(stg+row*64+ch*8); ATTN_STORE16(Ow+(long)row*DMO+ch*8,v);} }
  asm volatile("s_waitcnt lgkmcnt(0)\n\ts_barrier":::"memory");
  #undef DMA_K
  #undef DMA_V
  #undef DMA_M2
  #undef MAPPLY
  #undef MLD
  #undef START
  #undef RESC
  #undef ROT
}
constexpr int ATTN_LDS_BYTES=LDS_BYTES;
template<int THRL=8> __device__ __forceinline__ void attn_phase(char*lds,const bf16*Q,const bf16*K,const bf16*V,const u64*MASK,bf16*O){
  const int G=gridDim.x;
  for(int w=blockIdx.x;w<256;w+=G){ const int h=w&7,s=w>>3; attn_unit<THRL>(h,s,Q,K,V,MASK,O,lds); attn_unit<THRL>(h,63-s,Q,K,V,MASK,O,lds); }
}
#undef SBAR
#undef WAIT_BAR
}

__device__ __forceinline__ void phase_route_naive(const Params& p, unsigned char* lds) {
    const int tid = opaque_tid(), lane = tid & 63, wave = tid >> 6;
    const int gw = blockIdx.x * NWAVES + wave, NGW = gridDim.x * NWAVES;
    const float* H2 = (const float*)(p.ws + WS_H2); const float* WGRT = (const float*)(p.ws + WS_WGRT);
    float* RSTD = (float*)(p.ws + WS_RSTD); int* TOKOF = (int*)(p.ws + WS_TOKOF); float* GATEOF = (float*)(p.ws + WS_GATEOF); int* PAIR = (int*)(p.ws + WS_PAIR);
    unsigned* CNT = (unsigned*)(p.ws + WS_CTL) + CW_CNT;
    for (int t = gw; t < S; t += NGW) {
        const f32x4* hr = (const f32x4*)(H2 + (size_t)t * D) + lane; f32x4 v[4]; float ss = 0.f;
#pragma unroll
        for (int j = 0; j < 4; ++j) { v[j] = hr[64 * j]; ss += v[j].x * v[j].x + v[j].y * v[j].y + v[j].z * v[j].z + v[j].w * v[j].w; }
        const float rstd = rsqrtf(wave_sum(ss) * (1.f / D) + EPS);
        float mine = -INFINITY;
        for (int e = 0; e < NE; ++e) { const f32x4* wr = (const f32x4*)(WGRT + (size_t)e * D) + lane; float a = 0.f;
#pragma unroll
            for (int j = 0; j < 4; ++j) { const f32x4 w = wr[64 * j]; a = fmaf(v[j].x, w.x, a); a = fmaf(v[j].y, w.y, a); a = fmaf(v[j].z, w.z, a); a = fmaf(v[j].w, w.w, a); }
            a = wave_sum(a); if (lane == e) mine = a * rstd + p.b_router[e]; }
        float tv[4]; int te[4];
#pragma unroll
        for (int k = 0; k < 4; ++k) { float bv = mine; int bi = lane;
#pragma unroll
            for (int o = 32; o >= 1; o >>= 1) { const float ov = __shfl_xor(bv, o); const int oi = __shfl_xor(bi, o); if (ov > bv || (ov == bv && oi < bi)) { bv = ov; bi = oi; } }
            tv[k] = bv; te[k] = bi; if (lane == bi) mine = -INFINITY; }
        float g[4], gs = 0.f;
#pragma unroll
        for (int k = 0; k < 4; ++k) { g[k] = __expf(tv[k] - tv[0]); gs += g[k]; }
        if (lane == 0) RSTD[t] = rstd;
        if (lane < 4) { const int e = lane == 0 ? te[0] : lane == 1 ? te[1] : lane == 2 ? te[2] : te[3]; const float gg = (lane == 0 ? g[0] : lane == 1 ? g[1] : lane == 2 ? g[2] : g[3]) / gs;
            const unsigned slot = atomicAdd(&CNT[e], 1u); TOKOF[e * S + slot] = t; GATEOF[e * S + slot] = gg; PAIR[t * 4 + lane] = (e << 16) | (int)slot; }
    }
}

__device__ __forceinline__ int build_tiles(const Params& p, unsigned char* lds) {
    int* pst = (int*)(lds + LDS_MISC); int* tile_e = pst + 40;
    const unsigned* CNT = (const unsigned*)(p.ws + WS_CTL) + CW_CNT;
    __syncthreads();
    if (opaque_tid() == 0) { int acc = 0; for (int e = 0; e < NE; ++e) { pst[e] = acc; const int nt = ((int)__hip_atomic_load(&CNT[e], __ATOMIC_RELAXED, __HIP_MEMORY_SCOPE_AGENT) + 255) >> 8; for (int i = 0; i < nt; ++i) tile_e[acc + i] = e; acc += nt; } pst[NE] = acc; }
    __syncthreads();
    return pst[NE];
}

__device__ __forceinline__ void phase_gather(const Params& p, unsigned char* lds) {
    const int tid = opaque_tid(), lane = tid & 63, wave = tid >> 6;
    const int gw = blockIdx.x * NWAVES + wave, NGW = gridDim.x * NWAVES;
    build_tiles(p, lds); const int* pst = (const int*)(lds + LDS_MISC);
    const bf16* XN2 = (const bf16*)(p.ws + WS_XN); bf16* XS = (bf16*)(p.ws + WS_XS); const int* PAIR = (const int*)(p.ws + WS_PAIR);
    const float* RSTD = (const float*)(p.ws + WS_RSTD); const float* GATEOF = (const float*)(p.ws + WS_GATEOF);
    float* ROWRSTD = (float*)(p.ws + WS_ROWRSTD); float* ROWGATE = (float*)(p.ws + WS_ROWGATE);
    for (int pr = gw; pr < S * 4; pr += NGW) { const int t = pr >> 2; const int pe = PAIR[pr]; const int e = pe >> 16, slot = pe & 0xffff; const int row = pst[e] * 256 + slot;
        const u32x4* src = (const u32x4*)(XN2 + (size_t)t * D); u32x4* dst = (u32x4*)(XS + (size_t)row * D);
        dst[lane] = src[lane]; dst[lane + 64] = src[lane + 64];
        if (lane == 0) { ROWRSTD[row] = RSTD[t]; ROWGATE[row] = GATEOF[e * S + slot]; } }
}

__device__ __forceinline__ void phase_final(const Params& p, unsigned char* lds) {
    const int tid = opaque_tid(), lane = tid & 63, wave = tid >> 6;
    const int gw = blockIdx.x * NWAVES + wave, NGW = gridDim.x * NWAVES;
    build_tiles(p, lds); const int* pst = (const int*)(lds + LDS_MISC);
    const float* H2 = (const float*)(p.ws + WS_H2); const bf16* YS = (const bf16*)(p.ws + WS_YS); const int* PAIR = (const int*)(p.ws + WS_PAIR);
    for (int t = gw; t < S; t += NGW) {
        const f32x4* hr = (const f32x4*)(H2 + (size_t)t * D) + lane; f32x4 v[4];
#pragma unroll
        for (int j = 0; j < 4; ++j) v[j] = hr[64 * j];
#pragma unroll
        for (int k = 0; k < 4; ++k) { const int pe = PAIR[t * 4 + k]; const int row = pst[pe >> 16] * 256 + (pe & 0xffff); const uint2* yr = (const uint2*)(YS + (size_t)row * D) + lane;
#pragma unroll
            for (int j = 0; j < 4; ++j) { const uint2 y = yr[64 * j]; v[j].x += blo(y.x); v[j].y += bhi(y.x); v[j].z += blo(y.y); v[j].w += bhi(y.y); } }
        float ss = 0.f;
#pragma unroll
        for (int j = 0; j < 4; ++j) ss += v[j].x * v[j].x + v[j].y * v[j].y + v[j].z * v[j].z + v[j].w * v[j].w;
        const float rstd = rsqrtf(wave_sum(ss) * (1.f / D) + EPS);
        f32x4* o = (f32x4*)(p.out + (size_t)t * D) + lane;
#pragma unroll
        for (int j = 0; j < 4; ++j) { const f32x4 g = ((const f32x4*)p.norm_final_g)[lane + 64 * j]; o[64 * j] = (f32x4){v[j].x * rstd * g.x, v[j].y * rstd * g.y, v[j].z * rstd * g.z, v[j].w * rstd * g.w}; }
    }
}

#ifndef FAST_GEMM
#define FAST_GEMM 1
#endif
#ifndef FAST_ATT
#define FAST_ATT 1
#endif
#ifndef FAST_IDX
#define FAST_IDX 1
#endif
template <class F, class Sched>
__device__ __forceinline__ void run_gemm(unsigned char* lds, const bf16* A, const bf16* Bt, int K, const Sched& S, const F& f) {
#if FAST_GEMM
    pg8::Gemm g{A, Bt, 0, 0, K}; EpiAdapt<F> E{f};
    pg8::gemm_phase<EpiAdapt<F>, Sched, true, true>((LAS unsigned char*)lds, g, S, E);
#else
    Unit u;
    for (int i = 0; S.next(i, u); ++i) ngemm_unit(lds, A + (size_t)u.pm * 256 * K, K, Bt + (size_t)S.bidx(u) * 256 * K, K, K, f, u);
#endif
    __syncthreads();
}

__global__ void __launch_bounds__(NTHREADS, 2) fwd_kernel(Params p) {
    extern __shared__ __attribute__((aligned(16))) unsigned char lds[];
    cg::grid_group grid = cg::this_grid();
    const int G = gridDim.x, bx = blockIdx.x;
    const LAS int* tile_e = (const LAS int*)((LAS unsigned char*)lds + LDS_MISC) + 40;
    phase_prologue(p, lds);
    grid.sync();
    { pg8::StaticOrder so; so.init(S, NP, G, bx); EpiProj E{(bf16*)(p.ws + WS_PROJ)};
        run_gemm(lds, (const bf16*)(p.ws + WS_XN), (const bf16*)(p.ws + WS_WINT), D, so, E); }
    grid.sync();
    phase_ew_naive(p, lds);
    grid.sync();
#if FAST_IDX
    idxf::idx_phase(p, lds);
    __syncthreads();
#else
    phase_idx_naive(p, lds);
#endif
    grid.sync();
#if FAST_ATT
    attn_body::attn_phase<16>((char*)lds, (const attn_body::bf16*)(p.ws + WS_PROJ) + C_Q, (const attn_body::bf16*)(p.ws + WS_PROJ) + C_K, (const attn_body::bf16*)(p.ws + WS_PROJ) + C_V,
        (const u64*)(p.ws + WS_MASK), (attn_body::bf16*)(p.ws + WS_MIX) + 512);
    __syncthreads();
#else
    phase_att_naive(p, lds);
#endif
    grid.sync();
    { pg8::StaticOrder so; so.init(S, D, G, bx); EpiOut E{p.x, p.norm_ffn_g, (float*)(p.ws + WS_H2), (bf16*)(p.ws + WS_XN)};
        run_gemm(lds, (const bf16*)(p.ws + WS_MIX), (const bf16*)(p.ws + WS_WOUTT), D, so, E); }
    grid.sync();
    phase_route_naive(p, lds);
    grid.sync();
    phase_gather(p, lds);
    grid.sync();
    { const int ntile = build_tiles(p, lds);
        MoeOrder mo; mo.so.init(ntile * 256, 2048, G, bx); mo.tile_e = tile_e; mo.ncol = 8;
        EpiGU E{p.b_gu, (const float*)(p.ws + WS_ROWRSTD), (bf16*)(p.ws + WS_HDN), tile_e};
        run_gemm(lds, (const bf16*)(p.ws + WS_XS), (const bf16*)(p.ws + WS_WGUT), D, mo, E); }
    grid.sync();
    { const int ntile = build_tiles(p, lds);
        MoeOrder mo; mo.so.init(ntile * 256, D, G, bx); mo.tile_e = tile_e; mo.ncol = 4;
        EpiDown E{p.b_down, (const float*)(p.ws + WS_ROWGATE), (bf16*)(p.ws + WS_YS), tile_e};
        run_gemm(lds, (const bf16*)(p.ws + WS_HDN), (const bf16*)(p.ws + WS_WDT), DE, mo, E); }
    grid.sync();
    phase_final(p, lds);
}

extern "C" void kernel_launch(void* const* d_in, const int* in_sizes, int n_in, void* d_out, int out_size, void* d_ws, size_t ws_size, hipStream_t stream) {
    static int grid = 0;
    if (grid == 0) {
        if (n_in != 19 || out_size != S * D || ws_size < WS_END) { fprintf(stderr, "kernel_launch: unexpected shapes (n_in %d out %d ws %zu)\n", n_in, out_size, ws_size); grid = -1; return; }
        int dev = 0, cus = 0, per_cu = 0;
        (void)hipGetDevice(&dev); (void)hipDeviceGetAttribute(&cus, hipDeviceAttributeMultiprocessorCount, dev);
        if (hipFuncSetAttribute((const void*)fwd_kernel, hipFuncAttributeMaxDynamicSharedMemorySize, LDS_BYTES) != hipSuccess) { fprintf(stderr, "kernel_launch: hipFuncSetAttribute failed\n"); grid = -1; return; }
        if (hipOccupancyMaxActiveBlocksPerMultiprocessor(&per_cu, (const void*)fwd_kernel, NTHREADS, LDS_BYTES) != hipSuccess || per_cu < 1) { fprintf(stderr, "kernel_launch: occupancy query says %d\n", per_cu); per_cu = 1; }
        (void)hipGetLastError();
        grid = cus * 1;
    }
    if (grid < 0) return;
    (void)hipMemsetAsync((char*)d_ws + WS_CTL, 0, CTL_BYTES, stream);
    Params p{};
    p.x = (const float*)d_in[0]; p.pos = (const int*)d_in[1]; p.norm_mix_g = (const float*)d_in[2]; p.w_in = (const float*)d_in[3]; p.idx_g = (const float*)d_in[4]; p.idx_b = (const float*)d_in[5];
    p.conv_w = (const float*)d_in[6]; p.conv_b = (const float*)d_in[7]; p.conv_ng = (const float*)d_in[8]; p.conv_nb = (const float*)d_in[9]; p.w_out = (const float*)d_in[10]; p.norm_ffn_g = (const float*)d_in[11];
    p.w_router = (const float*)d_in[12]; p.b_router = (const float*)d_in[13]; p.w_gu = (const float*)d_in[14]; p.b_gu = (const float*)d_in[15]; p.w_down = (const float*)d_in[16]; p.b_down = (const float*)d_in[17];
    p.norm_final_g = (const float*)d_in[18]; p.out = (float*)d_out; p.ws = (unsigned char*)d_ws;
    void* args[] = {&p};
    hipError_t e = hipLaunchCooperativeKernel((const void*)fwd_kernel, dim3(grid), dim3(NTHREADS), args, LDS_BYTES, stream);
    if (e != hipSuccess) fprintf(stderr, "cooperative launch failed: %s (grid %d)\n", hipGetErrorString(e), grid);
}
```

```cpp
#include <hip/hip_runtime.h>
#include <hip/hip_cooperative_groups.h>
#include <cstdio>
#include <cstdint>
#include <hip/hip_bf16.h>
#include <cmath>
namespace cg = cooperative_groups;
#ifndef FUSED_GATHER
#define FUSED_GATHER 1
#endif
#ifndef PROBE_PHASE
#define PROBE_PHASE (-1)
#endif

constexpr int S = 16384, D = 1024, NIN = 3144, NP = 3328;
constexpr int CC = 512, CW = 31, NH = 8, HD = 64, NE = 32, DE = 1024;
constexpr int C_VAL = 0, C_GATE = 512, C_Q = 1024, C_K = 1536, C_V = 2048, C_QI = 2560, C_KI = 3072, C_WI = 3136;
constexpr int KSEL = 256;
constexpr float EPS = 1e-5f;
constexpr float C2 = 0.125f * 1.4426950408889634f;
constexpr int NTHREADS = 512, NWAVES = 8;
constexpr int MAXROWS = 65536 + NE * 256;
constexpr int MAXTILES = MAXROWS / 256;

constexpr size_t MiB = 1u << 20;
constexpr size_t WS_CTL = 0, CTL_BYTES = 1 * MiB;
constexpr size_t WS_WINT = 2 * MiB;
constexpr size_t WS_WOUTT = 9 * MiB;
constexpr size_t WS_WGRT = 11 * MiB;
constexpr size_t WS_COS = 12 * MiB;
constexpr size_t WS_SIN = 14 * MiB;
constexpr size_t WS_WGUT = 16 * MiB;
constexpr size_t WS_WDT = 144 * MiB;
constexpr size_t WS_XN = 208 * MiB;
constexpr size_t WS_PROJ = 240 * MiB;
constexpr size_t WS_MIX = 344 * MiB;
constexpr size_t WS_KI = 376 * MiB;
constexpr size_t WS_QL = 378 * MiB;
constexpr size_t WS_WI = 380 * MiB;
constexpr size_t WS_RSTD = 381 * MiB;
constexpr size_t WS_TOKOF = 382 * MiB;
constexpr size_t WS_GATEOF = 384 * MiB;
constexpr size_t WS_PAIR = 386 * MiB;
constexpr size_t WS_ROWRSTD = 387 * MiB;
constexpr size_t WS_ROWGATE = 388 * MiB;
constexpr size_t WS_ROWTOK = 389 * MiB;
constexpr size_t WS_MASK = 392 * MiB;
constexpr size_t WS_H2 = 424 * MiB;
constexpr size_t WS_XS = 488 * MiB;
constexpr size_t WS_HDN = 632 * MiB;
constexpr size_t WS_YS = 776 * MiB;
constexpr size_t WS_END = 920 * MiB;
constexpr int CW_CNT = 1024;
constexpr int CW_BAR = 4096;
constexpr int CW_KMAX = 2052;
constexpr int CW_DEP = 8192;

constexpr int LDS_BYTES = 163840;
constexpr int LDS_LTOK = 147456;
constexpr int LDS_MISC = 131072;
constexpr int LDS_LRS = LDS_MISC + 4608;
constexpr int LDS_PROBE = LDS_MISC + 14336;

#define LAS __attribute__((address_space(3)))
typedef unsigned short bf16;
typedef unsigned long long u64;
typedef float f32x4 __attribute__((ext_vector_type(4)));
typedef unsigned u32x4 __attribute__((ext_vector_type(4)));

__device__ __forceinline__ float bf2f(unsigned v) { return __uint_as_float(v << 16); }
__device__ __forceinline__ unsigned f2bf(float f) { unsigned u = __float_as_uint(f); return (u + 0x7fffu + ((u >> 16) & 1u)) >> 16; }
typedef float f32x2_pk __attribute__((ext_vector_type(2))); typedef __bf16 bf16x2_pk __attribute__((ext_vector_type(2)));
__device__ __forceinline__ unsigned pk2(float lo, float hi) { const f32x2_pk v = {lo, hi}; return __builtin_bit_cast(unsigned, __builtin_convertvector(v, bf16x2_pk)); }
__device__ __forceinline__ float blo(unsigned w) { return __uint_as_float(w << 16); }
__device__ __forceinline__ float bhi(unsigned w) { return __uint_as_float(w & 0xffff0000u); }
__device__ __forceinline__ float wave_sum(float v) {
#pragma unroll
    for (int o = 1; o < 64; o <<= 1) v += __shfl_xor(v, o);
    return v;
}
__device__ __forceinline__ float wave_max(float v) {
#pragma unroll
    for (int o = 1; o < 64; o <<= 1) v = fmaxf(v, __shfl_xor(v, o));
    return v;
}
__device__ __forceinline__ int opaque_tid() { int t = threadIdx.x; asm volatile("" : "+v"(t)); return t; }
#if PROBE_PHASE >= 200
#define ISEC(k) do { __syncthreads(); if (blockIdx.x == 0 && tid == 0) { volatile LAS unsigned long long* st_ = (volatile LAS unsigned long long*)((LAS unsigned char*)lds + LDS_PROBE + 256); const unsigned long long now_ = __builtin_amdgcn_s_memrealtime(); st_[k] += now_ - st_[15]; st_[15] = now_; } } while (0)
#else
#define ISEC(k) do { } while (0)
#endif
__device__ __forceinline__ float sigmoidf_(float x) { return __builtin_amdgcn_rcpf(1.f + __expf(-x)); }

struct Params {
    const float* x; const int* pos; const float* norm_mix_g; const float* w_in; const float* idx_g; const float* idx_b;
    const float* conv_w; const float* conv_b; const float* conv_ng; const float* conv_nb; const float* w_out; const float* norm_ffn_g;
    const float* w_router; const float* b_router; const float* w_gu; const float* b_gu; const float* w_down; const float* b_down;
    const float* norm_final_g; float* out; unsigned char* ws;
};

__device__ __forceinline__ void transpose_item(const float* W, int K, int N, bf16* WT, int dst_row0, int k0, int n0, float* scr, int lane) {
    float v[32]; const int n = n0 + (lane & 31); const float* src = W + (size_t)(k0 + (lane >> 5)) * N + n;
#pragma unroll
    for (int i = 0; i < 32; ++i) v[i] = (n < N) ? src[(size_t)(2 * i) * N] : 0.f;
#pragma unroll
    for (int i = 0; i < 32; ++i) scr[(2 * i + (lane >> 5)) * 33 + (lane & 31)] = v[i];
    asm volatile("s_waitcnt lgkmcnt(0)" ::: "memory");
    const int c = lane & 7;
#pragma unroll
    for (int j = 0; j < 4; ++j) { const int nn = (lane >> 3) + 8 * j; const float* s = scr + (8 * c) * 33 + nn;
        u32x4 o; o.x = pk2(s[0 * 33], s[1 * 33]); o.y = pk2(s[2 * 33], s[3 * 33]); o.z = pk2(s[4 * 33], s[5 * 33]); o.w = pk2(s[6 * 33], s[7 * 33]);
        *(u32x4*)(WT + (size_t)(dst_row0 + nn) * K + k0 + 8 * c) = o; }
    asm volatile("s_waitcnt lgkmcnt(0)" ::: "memory");
}

__device__ __forceinline__ void phase_prologue(const Params& p, unsigned char* lds) {
    const int tid = opaque_tid(), lane = tid & 63, wave = tid >> 6;
    const int gw = blockIdx.x * NWAVES + wave, NGW = gridDim.x * NWAVES;
    float* scr = (float*)(lds + wave * 16384);
    bf16* WinT = (bf16*)(p.ws + WS_WINT); bf16* WoutT = (bf16*)(p.ws + WS_WOUTT); bf16* WguT = (bf16*)(p.ws + WS_WGUT); bf16* WdT = (bf16*)(p.ws + WS_WDT);
    constexpr int I_IN = 16 * (NP / 32), I_OUT = 16 * 32, I_GU = 16 * 64, I_DN = 16 * 32;
    constexpr int NITEMS = I_IN + I_OUT + NE * I_GU + NE * I_DN;
    for (int it = gw; it < NITEMS; it += NGW) {
        int r = it;
        if (r < I_IN) { const int nb = r % (NP / 32), kb = r / (NP / 32); transpose_item(p.w_in, D, NIN, WinT, nb * 32, kb * 64, nb * 32, scr, lane); continue; }
        r -= I_IN;
        if (r < I_OUT) { const int nb = r % 32, kb = r / 32; transpose_item(p.w_out, D, D, WoutT, nb * 32, kb * 64, nb * 32, scr, lane); continue; }
        r -= I_OUT;
        if (r < NE * I_GU) { const int e = r / I_GU, q = r % I_GU, nb = q % 64, kb = q / 64; const int n0 = nb * 32;
            const int c = n0 & 1023, isu = n0 >> 10; const int drow = e * 2048 + (c >> 7) * 256 + isu * 128 + (c & 127);
            transpose_item(p.w_gu + (size_t)e * D * 2048, D, 2048, WguT, drow - 0, kb * 64, n0, scr, lane);
            continue; }
        r -= NE * I_GU;
        { const int e = r / I_DN, q = r % I_DN, nb = q % 32, kb = q / 32;
            transpose_item(p.w_down + (size_t)e * DE * D, DE, D, WdT, e * D + nb * 32, kb * 64, nb * 32, scr, lane); }
    }
    for (int i = blockIdx.x * NTHREADS + tid; i < NE * D; i += gridDim.x * NTHREADS) { const int e = i / D, k = i % D; ((float*)(p.ws + WS_WGRT))[i] = p.norm_ffn_g[k] * p.w_router[k * NE + e]; }
    for (int i = blockIdx.x * NTHREADS + tid; i < NE * D; i += gridDim.x * NTHREADS) { const int k = i / NE; ((float*)(p.ws + WS_WGRT))[65536 + i] = p.norm_ffn_g[k] * p.w_router[i]; }
    for (int i = blockIdx.x * NTHREADS + tid; i < S * 32; i += gridDim.x * NTHREADS) { const int t = i >> 5, j = i & 31;
        const float inv = powf(10000.f, -(float)j / 32.f); const float ang = (float)p.pos[t] * inv;
        double xr = (double)ang * 0.15915494309189535; xr -= floor(xr); const float xf = (float)xr;
        ((float*)(p.ws + WS_COS))[i] = __builtin_amdgcn_cosf(xf); ((float*)(p.ws + WS_SIN))[i] = __builtin_amdgcn_sinf(xf); }
    bf16* XN = (bf16*)(p.ws + WS_XN);
    for (int m = gw; m < S; m += NGW) {
        const f32x4* xr = (const f32x4*)(p.x + (size_t)m * D) + lane; f32x4 v[4]; float ss = 0.f;
#pragma unroll
        for (int j = 0; j < 4; ++j) { v[j] = xr[64 * j]; ss += v[j].x * v[j].x + v[j].y * v[j].y + v[j].z * v[j].z + v[j].w * v[j].w; }
        const float rstd = rsqrtf(wave_sum(ss) * (1.f / D) + EPS);
        u64* o8 = (u64*)(XN + (size_t)m * D) + lane;
#pragma unroll
        for (int j = 0; j < 4; ++j) { const f32x4 g = ((const f32x4*)p.norm_mix_g)[lane + 64 * j];
            o8[64 * j] = (u64)pk2(v[j].x * rstd * g.x, v[j].y * rstd * g.y) | ((u64)pk2(v[j].z * rstd * g.z, v[j].w * rstd * g.w) << 32); }
    }
}

namespace pg8 {
#define PG8_LAS __attribute__((address_space(3)))
typedef unsigned short bf16_t;
typedef short bf16x8 __attribute__((ext_vector_type(8)));
typedef float f32x4 __attribute__((ext_vector_type(4)));
typedef unsigned u32x4 __attribute__((ext_vector_type(4)));
constexpr int BM = 256, BK = 64, HALF = 128, HTB = HALF * BK * 2  , STAGE_BYTES = 8 * HTB, NXCD = 8, WGM = 8;

__host__ __device__ __forceinline__ int lds_byte(int r, int c) { const int st = (r >> 4) * 2 + (c >> 5), rr = r & 15, cc = c & 31, ob = rr * 64 + cc * 2; return st * 1024 + (ob ^ (((ob >> 9) & 1) << 5)); }
__host__ __device__ __forceinline__ void stage_rc(int b, int& R, int& C) { const int st = b / 1024, sb = b % 1024, swz = sb ^ (((sb >> 9) & 1) << 5); R = (st >> 1) * 16 + swz / 64; C = (st & 1) * 32 + (swz % 64) / 2; }
__host__ __device__ __forceinline__ int perm32(int rho) { const int n = rho >> 4, i = rho & 15; return 8 * (i >> 2) + 4 * n + (i & 3); }

struct Unit { int pm, pn, ui; };
struct Gemm { const bf16_t* A; const bf16_t* Bt; int M, N, K; };

struct StaticOrder {
    int nM, nN, nwg, G, c;
    __host__ __device__ void init(int M, int N, int G_, int c_) { nM = M / BM; nN = N / BM; nwg = nM * nN; G = G_; c = c_; }
    __host__ __device__ bool next(int i, Unit& u) const { const long L = (long)i * G + c; if (!map(L, u)) return false; u.ui = i; return true; }
    __host__ __device__ bool map(long L, Unit& u) const {
        if (L >= nwg) return false;
        int wgid = (int)L; { const int q = nwg / NXCD, r = nwg % NXCD, xcd = wgid % NXCD, off = wgid / NXCD; wgid = (xcd < r ? xcd * (q + 1) : r * (q + 1) + (xcd - r) * q) + off; }
        const int nig = WGM * nN, gid = wgid / nig, fm = gid * WGM, gsz = (nM - fm) < WGM ? (nM - fm) : WGM;
        u.pm = fm + ((wgid % nig) % gsz); u.pn = (wgid % nig) / gsz; u.ui = 0; return true;
    }
    __device__ __forceinline__ int bidx(const Unit& u) const { return u.pn; }
    __device__ __forceinline__ void a_ready(const Unit&) const {}
    __device__ __forceinline__ void done(const Unit&) const {}
};
template <class Epi, class Sched, bool ALIGN_EPI = false, bool SP2 = false, bool GATHER = false>
__device__ __forceinline__ void gemm_phase(PG8_LAS unsigned char* lds, const Gemm g, const Sched& S, const Epi& E) {
    static_assert(!GATHER || SP2, "GATHER is written for the SP2 loop");
    int tid_ = threadIdx.x; asm volatile("" : "+v"(tid_));
    const int tid = tid_, wid = __builtin_amdgcn_readfirstlane(tid >> 6), lane = tid & 63, wr = wid >> 2, wc = wid & 3, fr = lane & 15, fq = lane >> 4;
    const int K = g.K, nt = K / BK;
    unsigned voffA[2], voffB[2], gC[2]; int gR[2];
#pragma unroll
    for (int i = 0; i < 2; ++i) { int R, C; stage_rc(tid * 16 + i * 8192, R, C); const int Rb = Epi::PERM ? ((R & ~31) + perm32(R & 31)) : R;
        voffA[i] = (unsigned)(R * K + C) * 2u; voffB[i] = (unsigned)(Rb * K + C) * 2u; gR[i] = R; gC[i] = (unsigned)C * 2u; }
    unsigned vc[2][2] = {{0u, 0u}, {0u, 0u}}, vn[2][2] = {{0u, 0u}, {0u, 0u}};
#define PG8_GOFF(dst, uidx) do { _Pragma("unroll") for (int h_ = 0; h_ < 2; ++h_) _Pragma("unroll") for (int i_ = 0; i_ < 2; ++i_) dst[h_][i_] = (unsigned)S.rowtok((uidx), h_ * 128 + gR[i_]) * (unsigned)(K * 2) + gC[i_]; } while (0)
    const size_t kstep = (size_t)(BK * 2);
    const size_t hstep = (size_t)HALF * K * 2;
    const size_t tstep = 2 * hstep;
    const unsigned ldsw = (unsigned)wid * 1024u;
    const int aoff = lds_byte(wr * 64 + fr, fq * 8), boff = lds_byte(wc * 32 + fr, fq * 8);
#define PG8_SA(b, h) (((b) * 2 + (h)) * HTB)
#define PG8_SB(b, h) ((4 + (b) * 2 + (h)) * HTB)
#define PG8_STAGE(bufoff, gbase, voff) do { _Pragma("unroll") for (int _i = 0; _i < 2; ++_i) \
        __builtin_amdgcn_global_load_lds((const unsigned*)((const char*)(gbase) + (voff)[_i]), (PG8_LAS unsigned*)(lds + (bufoff) + ldsw + _i * 8192), 16, 0, 0); } while (0)
#define PG8_STAGE_AG(bufoff, kb, v0, v1) do { \
        __builtin_amdgcn_global_load_lds((const unsigned*)((const char*)g.A + (kb) + (v0)), (PG8_LAS unsigned*)(lds + (bufoff) + ldsw), 16, 0, 0); \
        __builtin_amdgcn_global_load_lds((const unsigned*)((const char*)g.A + (kb) + (v1)), (PG8_LAS unsigned*)(lds + (bufoff) + ldsw + 8192), 16, 0, 0); } while (0)
#define PG8_LDA(dst, b, h) do { _Pragma("unroll") for (int m = 0; m < 4; ++m) _Pragma("unroll") for (int k = 0; k < 2; ++k) dst[m][k] = *(const PG8_LAS bf16x8*)(lds + PG8_SA(b, h) + aoff + m * 2048 + k * 1024); } while (0)
#define PG8_LDB(dst, b, h) do { _Pragma("unroll") for (int n = 0; n < 2; ++n) _Pragma("unroll") for (int k = 0; k < 2; ++k) dst[n][k] = *(const PG8_LAS bf16x8*)(lds + PG8_SB(b, h) + boff + n * 2048 + k * 1024); } while (0)
#define PG8_MMA(ai, bj, At, Bt) do { __builtin_amdgcn_s_setprio(1); _Pragma("unroll") for (int m = 0; m < 4; ++m) _Pragma("unroll") for (int n = 0; n < 2; ++n) _Pragma("unroll") for (int k = 0; k < 2; ++k) \
        acc[ai][bj][m][n] = __builtin_amdgcn_mfma_f32_16x16x32_bf16(Bt[n][k], At[m][k], acc[ai][bj][m][n], 0, 0, 0); __builtin_amdgcn_s_setprio(0); } while (0)
#define PG8_WAIT_V(n) asm volatile("s_waitcnt vmcnt(" #n ")" ::: "memory")
#define PG8_WAIT_L(n) asm volatile("s_waitcnt lgkmcnt(" #n ")" ::: "memory")
#define PG8_BAR __builtin_amdgcn_s_barrier()
#define PG8_SCHED __builtin_amdgcn_sched_barrier(0)
    Unit cur, nxt; int ui = 0;
    if (!S.next(0, cur)) return;
    f32x4 acc[2][2][4][2];
#pragma unroll
    for (int a = 0; a < 2; ++a)
#pragma unroll
        for (int b = 0; b < 2; ++b)
#pragma unroll
            for (int m = 0; m < 4; ++m)
#pragma unroll
                for (int n = 0; n < 2; ++n) acc[a][b][m][n] = (f32x4){0.f, 0.f, 0.f, 0.f};
    bf16x8 At[4][2], B0[2][2], B1[2][2];
    const char* cA = (const char*)g.A + (size_t)cur.pm * tstep; const char* cB = (const char*)g.Bt + (size_t)S.bidx(cur) * tstep;
    S.a_ready(cur);
    if constexpr (SP2) {
        if constexpr (GATHER) { PG8_GOFF(vc, 0); }
        PG8_STAGE(PG8_SB(0, 0), cB, voffB); PG8_STAGE(PG8_SB(0, 1), cB + hstep, voffB);
        if constexpr (GATHER) { PG8_STAGE_AG(PG8_SA(0, 0), (size_t)0, vc[0][0], vc[0][1]); PG8_STAGE_AG(PG8_SA(0, 1), (size_t)0, vc[1][0], vc[1][1]); } else { PG8_STAGE(PG8_SA(0, 0), cA, voffA); PG8_STAGE(PG8_SA(0, 1), cA + hstep, voffA); }
        if (wr == 1) PG8_BAR;
        PG8_WAIT_V(2); PG8_BAR;
        PG8_STAGE(PG8_SB(1, 0), cB + kstep, voffB); if constexpr (GATHER) { PG8_STAGE_AG(PG8_SA(1, 0), kstep, vc[0][0], vc[0][1]); } else { PG8_STAGE(PG8_SA(1, 0), cA + kstep, voffA); } PG8_STAGE(PG8_SB(1, 1), cB + hstep + kstep, voffB);
        PG8_WAIT_V(6); PG8_BAR;
    } else {
        PG8_STAGE(PG8_SB(0, 0), cB, voffB); PG8_STAGE(PG8_SA(0, 0), cA, voffA); PG8_STAGE(PG8_SB(0, 1), cB + hstep, voffB); PG8_STAGE(PG8_SA(0, 1), cA + hstep, voffA);
        if (wr == 1) PG8_BAR;
        PG8_WAIT_V(4); PG8_BAR;
        PG8_STAGE(PG8_SB(1, 0), cB + kstep, voffB); PG8_STAGE(PG8_SA(1, 0), cA + kstep, voffA); PG8_STAGE(PG8_SB(1, 1), cB + hstep + kstep, voffB);
        PG8_WAIT_V(6); PG8_BAR;
    }
    for (;;) {
        const bool has_next = S.next(ui + 1, nxt);
        if constexpr (GATHER) { if (has_next) { PG8_GOFF(vn, ui + 1); } }
        const char* nA = has_next ? (const char*)g.A + (size_t)nxt.pm * tstep : cA; const char* nB = has_next ? (const char*)g.Bt + (size_t)S.bidx(nxt) * tstep : cB;
        for (int t = 0; t < nt; t += 2) {
            const bool last = (t == nt - 2);
            const char* a1 = cA + (size_t)(t + 1) * kstep;
            const char* a2 = last ? nA : cA + (size_t)(t + 2) * kstep; const char* b2 = last ? nB : cB + (size_t)(t + 2) * kstep;
            const char* a3 = a2 + kstep; const char* b3 = b2 + kstep;
            if (last && has_next) S.a_ready(nxt);
            const bool un_ = last && has_next; const size_t k1_ = (size_t)(t + 1) * kstep, k2_ = last ? (size_t)0 : (size_t)(t + 2) * kstep, k3_ = k2_ + kstep;
            const unsigned w00 = un_ ? vn[0][0] : vc[0][0], w01 = un_ ? vn[0][1] : vc[0][1], w10 = un_ ? vn[1][0] : vc[1][0], w11 = un_ ? vn[1][1] : vc[1][1];
            if constexpr (SP2) {
            PG8_LDB(B0, 0, 0); PG8_LDB(B1, 0, 1); PG8_SCHED; PG8_LDA(At, 0, 0); if constexpr (GATHER) { PG8_STAGE_AG(PG8_SA(1, 1), k1_, vc[1][0], vc[1][1]); } else { PG8_STAGE(PG8_SA(1, 1), a1 + hstep, voffA); }
            PG8_WAIT_V(8); PG8_WAIT_L(0); PG8_BAR; PG8_MMA(0, 0, At, B0); PG8_MMA(0, 1, At, B1); PG8_BAR; PG8_SCHED;
            PG8_LDA(At, 0, 1); PG8_STAGE(PG8_SB(0, 0), b2, voffB); PG8_STAGE(PG8_SB(0, 1), b2 + hstep, voffB); if constexpr (GATHER) { PG8_STAGE_AG(PG8_SA(0, 0), k2_, w00, w01); } else { PG8_STAGE(PG8_SA(0, 0), a2, voffA); }
            PG8_WAIT_V(8); PG8_WAIT_L(0); PG8_BAR; PG8_MMA(1, 0, At, B0); PG8_MMA(1, 1, At, B1); PG8_BAR; PG8_SCHED;
            PG8_LDB(B0, 1, 0); PG8_LDB(B1, 1, 1); PG8_SCHED; PG8_LDA(At, 1, 0); if constexpr (GATHER) { PG8_STAGE_AG(PG8_SA(0, 1), k2_, w10, w11); } else { PG8_STAGE(PG8_SA(0, 1), a2 + hstep, voffA); }
            PG8_WAIT_V(8); PG8_WAIT_L(0); PG8_BAR; PG8_MMA(0, 0, At, B0); PG8_MMA(0, 1, At, B1); PG8_BAR; PG8_SCHED;
            PG8_LDA(At, 1, 1); PG8_STAGE(PG8_SB(1, 0), b3, voffB); PG8_STAGE(PG8_SB(1, 1), b3 + hstep, voffB); if constexpr (GATHER) { PG8_STAGE_AG(PG8_SA(1, 0), k3_, w00, w01); } else { PG8_STAGE(PG8_SA(1, 0), a3, voffA); }
            PG8_WAIT_V(8); PG8_WAIT_L(0); PG8_BAR; PG8_MMA(1, 0, At, B0); PG8_MMA(1, 1, At, B1); PG8_BAR; PG8_SCHED;
            } else {
            PG8_LDB(B0, 0, 0); PG8_SCHED; PG8_LDA(At, 0, 0); PG8_STAGE(PG8_SA(1, 1), a1 + hstep, voffA);
            PG8_WAIT_L(8); PG8_BAR; PG8_WAIT_L(0); PG8_MMA(0, 0, At, B0); PG8_BAR; PG8_SCHED;
            PG8_LDB(B1, 0, 1); PG8_STAGE(PG8_SB(0, 0), b2, voffB);
            PG8_BAR; PG8_WAIT_L(0); PG8_MMA(0, 1, At, B1); PG8_BAR;
            PG8_LDA(At, 0, 1); PG8_STAGE(PG8_SA(0, 0), a2, voffA);
            PG8_BAR; PG8_WAIT_L(0); PG8_MMA(1, 0, At, B0); PG8_BAR; PG8_SCHED;
            PG8_STAGE(PG8_SB(0, 1), b2 + hstep, voffB);
            PG8_WAIT_V(6); PG8_BAR; PG8_MMA(1, 1, At, B1); PG8_BAR;
            PG8_LDB(B0, 1, 0); PG8_SCHED; PG8_LDA(At, 1, 0); PG8_STAGE(PG8_SA(0, 1), a2 + hstep, voffA);
            PG8_WAIT_L(8); PG8_BAR; PG8_WAIT_L(0); PG8_MMA(0, 0, At, B0); PG8_BAR; PG8_SCHED;
            PG8_LDB(B1, 1, 1); PG8_STAGE(PG8_SB(1, 0), b3, voffB);
            PG8_BAR; PG8_WAIT_L(0); PG8_MMA(0, 1, At, B1); PG8_BAR;
            PG8_LDA(At, 1, 1); PG8_STAGE(PG8_SA(1, 0), a3, voffA);
            PG8_BAR; PG8_WAIT_L(0); PG8_MMA(1, 0, At, B0); PG8_BAR; PG8_SCHED;
            PG8_STAGE(PG8_SB(1, 1), b3 + hstep, voffB);
            PG8_WAIT_V(6); PG8_BAR; PG8_MMA(1, 1, At, B1); PG8_BAR;
            }
        }
        if constexpr (ALIGN_EPI) { if (wr == 0) PG8_BAR; }
        if constexpr (!Epi::AFTER_DRAIN) { E(acc, cur, wr, wc, fr, fq); S.done(cur); }
        if (!has_next) break;
#pragma unroll
        for (int a = 0; a < 2; ++a)
#pragma unroll
            for (int b = 0; b < 2; ++b)
#pragma unroll
                for (int m = 0; m < 4; ++m)
#pragma unroll
                    for (int n = 0; n < 2; ++n) acc[a][b][m][n] = (f32x4){0.f, 0.f, 0.f, 0.f};
        cur = nxt; cA = nA; cB = nB; ++ui;
        if constexpr (GATHER) { vc[0][0] = vn[0][0]; vc[0][1] = vn[0][1]; vc[1][0] = vn[1][0]; vc[1][1] = vn[1][1]; }
        if constexpr (ALIGN_EPI) { if (wr == 1) PG8_BAR; }
    }
    PG8_WAIT_V(0);
    if constexpr (!ALIGN_EPI) { if (wr == 0) PG8_BAR; }
    PG8_BAR;
    if constexpr (Epi::AFTER_DRAIN) { E.fused(acc, cur, wr, wc, fr, fq, lds, wid, lane); S.done(cur); }
#undef PG8_SA
#undef PG8_SB
#undef PG8_STAGE
#undef PG8_LDA
#undef PG8_STAGE_AG
#undef PG8_GOFF
#undef PG8_LDB
#undef PG8_MMA
#undef PG8_WAIT_V
#undef PG8_WAIT_L
#undef PG8_BAR
#undef PG8_SCHED
}
}

template <class Epi>
__device__ __forceinline__ void ngemm_unit(unsigned char* lds, const bf16* A, int lda, const bf16* Bt, int ldb, int K, const Epi& epi, const pg8::Unit& u) {
    float* As = (float*)lds; float* Bs = As + 32 * 256;
    const int tid = opaque_tid(), tr = tid >> 4, tc = tid & 15;
    float acc0[8][8], acc1[8][8];
#pragma unroll
    for (int i = 0; i < 8; ++i)
#pragma unroll
        for (int j = 0; j < 8; ++j) { acc0[i][j] = 0.f; acc1[i][j] = 0.f; }
    for (int k0 = 0; k0 < K; k0 += 32) {
        __syncthreads();
#pragma unroll
        for (int j = 0; j < 2; ++j) { const int pidx = tid + 512 * j, r = pidx & 255, kq = pidx >> 8;
            const u32x4 va = *(const u32x4*)(A + (size_t)r * lda + k0 + kq * 8);
            const u32x4 vb = *(const u32x4*)(Bt + (size_t)r * ldb + k0 + kq * 8);
            float* ap = As + (kq * 8) * 256 + r; float* bp = Bs + (kq * 8) * 256 + r;
            ap[0 * 256] = blo(va.x); ap[1 * 256] = bhi(va.x); ap[2 * 256] = blo(va.y); ap[3 * 256] = bhi(va.y); ap[4 * 256] = blo(va.z); ap[5 * 256] = bhi(va.z); ap[6 * 256] = blo(va.w); ap[7 * 256] = bhi(va.w);
            bp[0 * 256] = blo(vb.x); bp[1 * 256] = bhi(vb.x); bp[2 * 256] = blo(vb.y); bp[3 * 256] = bhi(vb.y); bp[4 * 256] = blo(vb.z); bp[5 * 256] = bhi(vb.z); bp[6 * 256] = blo(vb.w); bp[7 * 256] = bhi(vb.w); }
        __syncthreads();
#pragma unroll 2
        for (int kk = 0; kk < 32; ++kk) {
            const f32x4 a0 = *(const f32x4*)(As + kk * 256 + tr * 8), a1 = *(const f32x4*)(As + kk * 256 + tr * 8 + 4);
            const f32x4 b00 = *(const f32x4*)(Bs + kk * 256 + tc * 8), b01 = *(const f32x4*)(Bs + kk * 256 + tc * 8 + 4);
            const f32x4 b10 = *(const f32x4*)(Bs + kk * 256 + 128 + tc * 8), b11 = *(const f32x4*)(Bs + kk * 256 + 128 + tc * 8 + 4);
            const float a[8] = {a0.x, a0.y, a0.z, a0.w, a1.x, a1.y, a1.z, a1.w};
            const float b0[8] = {b00.x, b00.y, b00.z, b00.w, b01.x, b01.y, b01.z, b01.w};
            const float b1[8] = {b10.x, b10.y, b10.z, b10.w, b11.x, b11.y, b11.z, b11.w};
#pragma unroll
            for (int i = 0; i < 8; ++i)
#pragma unroll
                for (int j = 0; j < 8; ++j) { acc0[i][j] = fmaf(a[i], b0[j], acc0[i][j]); acc1[i][j] = fmaf(a[i], b1[j], acc1[i][j]); }
        }
    }
#pragma unroll
    for (int i = 0; i < 8; ++i) epi(u, tr * 8 + i, tc * 8, acc0[i], acc1[i]);
}

__device__ __forceinline__ void store8_bf16(bf16* dst, const float (&v)[8]) {
    u32x4 o; o.x = pk2(v[0], v[1]); o.y = pk2(v[2], v[3]); o.z = pk2(v[4], v[5]); o.w = pk2(v[6], v[7]); *(u32x4*)dst = o;
}

typedef pg8::Unit Unit;
struct EpiProj { bf16* O;
    __device__ __forceinline__ void operator()(const Unit& u, int r, int c8, const float (&v0)[8], const float (&v1)[8]) const {
        bf16* row = O + (size_t)(u.pm * 256 + r) * NP + u.pn * 256 + c8; store8_bf16(row, v0); store8_bf16(row + 128, v1); } };
struct EpiOut { const float* x; const float* gffn; float* H2; bf16* XN2;
    __device__ __forceinline__ void operator()(const Unit& u, int r, int c8, const float (&v0)[8], const float (&v1)[8]) const {
        const int col = u.pn * 256 + c8; const size_t off = (size_t)(u.pm * 256 + r) * D + col; float h0[8], h1[8], n0[8], n1[8];
        const f32x4 xa = *(const f32x4*)(x + off), xb = *(const f32x4*)(x + off + 4), xc = *(const f32x4*)(x + off + 128), xd = *(const f32x4*)(x + off + 132);
        const f32x4 ga = *(const f32x4*)(gffn + col), gb = *(const f32x4*)(gffn + col + 4), gc = *(const f32x4*)(gffn + col + 128), gd = *(const f32x4*)(gffn + col + 132);
        const float xs0[8] = {xa.x, xa.y, xa.z, xa.w, xb.x, xb.y, xb.z, xb.w}, xs1[8] = {xc.x, xc.y, xc.z, xc.w, xd.x, xd.y, xd.z, xd.w};
        const float gs0[8] = {ga.x, ga.y, ga.z, ga.w, gb.x, gb.y, gb.z, gb.w}, gs1[8] = {gc.x, gc.y, gc.z, gc.w, gd.x, gd.y, gd.z, gd.w};
#pragma unroll
        for (int i = 0; i < 8; ++i) { h0[i] = xs0[i] + v0[i]; h1[i] = xs1[i] + v1[i]; n0[i] = h0[i] * gs0[i]; n1[i] = h1[i] * gs1[i]; }
        *(f32x4*)(H2 + off) = (f32x4){h0[0], h0[1], h0[2], h0[3]}; *(f32x4*)(H2 + off + 4) = (f32x4){h0[4], h0[5], h0[6], h0[7]};
        *(f32x4*)(H2 + off + 128) = (f32x4){h1[0], h1[1], h1[2], h1[3]}; *(f32x4*)(H2 + off + 132) = (f32x4){h1[4], h1[5], h1[6], h1[7]};
        store8_bf16(XN2 + off, n0); store8_bf16(XN2 + off + 128, n1); } };
struct EpiGU { const float* bgu; const LAS float* rowrstd; bf16* HDN; const LAS int* tile_e;
    __device__ __forceinline__ void operator()(const Unit& u, int r, int c8, const float (&v0)[8], const float (&v1)[8]) const {
        const int e = tile_e[u.pm]; const int row = u.pm * 256 + r; const float rs = rowrstd[u.ui * 256 + r]; const int cb = u.pn * 128 + c8; float h[8];
        const float* bg = bgu + e * 2048 + cb; const f32x4 ba = *(const f32x4*)bg, bb = *(const f32x4*)(bg + 4), bc = *(const f32x4*)(bg + 1024), bd_ = *(const f32x4*)(bg + 1028);
        const float b0[8] = {ba.x, ba.y, ba.z, ba.w, bb.x, bb.y, bb.z, bb.w}, b1[8] = {bc.x, bc.y, bc.z, bc.w, bd_.x, bd_.y, bd_.z, bd_.w};
#pragma unroll
        for (int i = 0; i < 8; ++i) { float g = v0[i] * rs + b0[i]; float uu = v1[i] * rs + b1[i];
            g = fminf(g, 7.f); uu = fminf(fmaxf(uu, -7.f), 7.f); h[i] = g * sigmoidf_(1.702f * g) * (uu + 1.f); }
        store8_bf16(HDN + (size_t)row * DE + cb, h); } };
struct EpiDown { const float* bd; const LAS float* rowgate; bf16* YS; const LAS int* tile_e;
    __device__ __forceinline__ void operator()(const Unit& u, int r, int c8, const float (&v0)[8], const float (&v1)[8]) const {
        const int e = tile_e[u.pm]; const int row = u.pm * 256 + r; const float gt = rowgate[u.ui * 256 + r]; const int cb = u.pn * 256 + c8; float y0[8], y1[8];
        const float* bp = bd + e * D + cb; const f32x4 ba = *(const f32x4*)bp, bb = *(const f32x4*)(bp + 4), bc = *(const f32x4*)(bp + 128), bd_ = *(const f32x4*)(bp + 132);
        const float b0[8] = {ba.x, ba.y, ba.z, ba.w, bb.x, bb.y, bb.z, bb.w}, b1[8] = {bc.x, bc.y, bc.z, bc.w, bd_.x, bd_.y, bd_.z, bd_.w};
#pragma unroll
        for (int i = 0; i < 8; ++i) { y0[i] = (v0[i] + b0[i]) * gt; y1[i] = (v1[i] + b1[i]) * gt; }
        store8_bf16(YS + (size_t)row * D + cb, y0); store8_bf16(YS + (size_t)row * D + cb + 128, y1); } };

__device__ __forceinline__ void store8_bf16_wt(bf16* dst, const float (&v)[8]) {
    u32x4 o; o.x = pk2(v[0], v[1]); o.y = pk2(v[2], v[3]); o.z = pk2(v[4], v[5]); o.w = pk2(v[6], v[7]);
    asm volatile("global_store_dwordx4 %0, %1, off sc1\n\ts_nop 1" :: "v"(dst), "v"(o) : "memory");
}
struct EpiMoe { const float* bgu; const float* bd; const LAS float* rowtab0; const LAS float* rowtab1; bf16* HDN; bf16* YS; const LAS int* tile_e;
    __device__ __forceinline__ void operator()(const Unit& u, int r, int c8, const float (&v0)[8], const float (&v1)[8]) const {
        const int e = tile_e[u.pm]; const int row = u.pm * 256 + r; const float rt = (u.ui < 9) ? rowtab0[u.ui * 256 + r] : rowtab1[(u.ui - 9) * 256 + r];
        if (u.pn < 8) { const int cb = u.pn * 128 + c8; float h[8];
            const float* bg = bgu + e * 2048 + cb; const f32x4 ba = *(const f32x4*)bg, bb = *(const f32x4*)(bg + 4), bc = *(const f32x4*)(bg + 1024), bd_ = *(const f32x4*)(bg + 1028);
            const float b0[8] = {ba.x, ba.y, ba.z, ba.w, bb.x, bb.y, bb.z, bb.w}, b1[8] = {bc.x, bc.y, bc.z, bc.w, bd_.x, bd_.y, bd_.z, bd_.w};
#pragma unroll
            for (int i = 0; i < 8; ++i) { float g = v0[i] * rt + b0[i]; float uu = v1[i] * rt + b1[i];
                g = fminf(g, 7.f); uu = fminf(fmaxf(uu, -7.f), 7.f); h[i] = g * sigmoidf_(1.702f * g) * (uu + 1.f); }
            store8_bf16_wt(HDN + (size_t)row * DE + cb, h);
        } else { const int cb = (u.pn - 8) * 256 + c8; float y0[8], y1[8];
            const float* bp = bd + e * D + cb; const f32x4 ba = *(const f32x4*)bp, bb = *(const f32x4*)(bp + 4), bc = *(const f32x4*)(bp + 128), bd_ = *(const f32x4*)(bp + 132);
            const float b0[8] = {ba.x, ba.y, ba.z, ba.w, bb.x, bb.y, bb.z, bb.w}, b1[8] = {bc.x, bc.y, bc.z, bc.w, bd_.x, bd_.y, bd_.z, bd_.w};
#pragma unroll
            for (int i = 0; i < 8; ++i) { y0[i] = (v0[i] + b0[i]) * rt; y1[i] = (v1[i] + b1[i]) * rt; }
            store8_bf16(YS + (size_t)row * D + cb, y0); store8_bf16(YS + (size_t)row * D + cb + 128, y1); } } };

template <class F> struct EpiAdapt {
    static constexpr bool PERM = true, AFTER_DRAIN = false; F f;
    __device__ __forceinline__ void operator()(const f32x4 (&acc)[2][2][4][2], const Unit& u, int wr, int wc, int fr, int fq) const {
#pragma unroll
        for (int ai = 0; ai < 2; ++ai)
#pragma unroll
            for (int m = 0; m < 4; ++m) { const int r = ai * 128 + wr * 64 + m * 16 + fr, c8 = wc * 32 + fq * 8;
                const f32x4 a = acc[ai][0][m][0], b = acc[ai][0][m][1], c = acc[ai][1][m][0], d = acc[ai][1][m][1];
                const float v0[8] = {a.x, a.y, a.z, a.w, b.x, b.y, b.z, b.w}, v1[8] = {c.x, c.y, c.z, c.w, d.x, d.y, d.z, d.w};
                f(u, r, c8, v0, v1); }
    }
};
struct MoeOrder { pg8::StaticOrder so; const LAS int* tile_e; int ncol; const LAS int* ltok;
    __device__ __forceinline__ bool next(int i, Unit& u) const { return so.next(i, u); }
    __device__ __forceinline__ int bidx(const Unit& u) const { return tile_e[u.pm] * ncol + u.pn; }
    __device__ __forceinline__ int rowtok(int ui, int r) const { return ltok[ui * 256 + r]; }
    __device__ __forceinline__ void a_ready(const Unit&) const {}
    __device__ __forceinline__ void done(const Unit&) const {} };
constexpr int HDN_PSEUDO_TOK = (int)((WS_HDN - WS_XN) / 2048);
constexpr int WD_TILE0 = (int)((WS_WDT - WS_WGUT) / (256 * 1024 * 2));
static_assert((WS_HDN - WS_XN) % 2048 == 0 && (WS_WDT - WS_WGUT) % (256 * 1024 * 2) == 0, "merged expert GEMM addressing");
struct MoeMerged { pg8::StaticOrder so1, so2; const LAS int* tile_e; const LAS int* ltok; unsigned* dep; int G, c, n1;
    __device__ __forceinline__ bool next(int i, Unit& u) const { const long L = (long)i * G + c; bool ok;
        if (L < so1.nwg) ok = so1.map(L, u); else { ok = so2.map(L - so1.nwg, u); u.pn += 8; }
        u.ui = i; return ok; }
    __device__ __forceinline__ int bidx(const Unit& u) const { return u.pn < 8 ? tile_e[u.pm] * 8 + u.pn : WD_TILE0 + tile_e[u.pm] * 4 + (u.pn - 8); }
    __device__ __forceinline__ int rowtok(int ui, int r) const { return ui < n1 ? ltok[ui * 256 + r] : ltok[9 * 256 + ui] + r; }
    __device__ __forceinline__ void a_ready(const Unit& u) const {
        if (u.pn < 8) return;
        if (__builtin_amdgcn_readfirstlane(threadIdx.x >> 6) == 0) { unsigned sp = 0u;
            while (__hip_atomic_load(dep + u.pm, __ATOMIC_RELAXED, __HIP_MEMORY_SCOPE_AGENT) < 64u) { __builtin_amdgcn_s_sleep(4); if (++sp > (1u << 22)) break; }
            __builtin_amdgcn_fence(__ATOMIC_ACQUIRE, "agent"); asm volatile("s_waitcnt vmcnt(0)" ::: "memory"); }
        __builtin_amdgcn_s_barrier(); }
    __device__ __forceinline__ void done(const Unit& u) const {
        if (u.pn >= 8) return;
        asm volatile("s_waitcnt vmcnt(0)" ::: "memory");
        if ((threadIdx.x & 63) == 0) __hip_atomic_fetch_add(dep + u.pm, 1u, __ATOMIC_RELAXED, __HIP_MEMORY_SCOPE_AGENT); } };

__device__ __forceinline__ void phase_ew_naive(const Params& p, unsigned char* lds) {
    const int tid = opaque_tid(), lane = tid & 63, wave = tid >> 6;
    bf16* PROJ = (bf16*)(p.ws + WS_PROJ); bf16* MIX = (bf16*)(p.ws + WS_MIX); bf16* KI = (bf16*)(p.ws + WS_KI); bf16* QL = (bf16*)(p.ws + WS_QL); float* WI = (float*)(p.ws + WS_WI);
    const float* COS = (const float*)(p.ws + WS_COS); const float* SIN = (const float*)(p.ws + WS_SIN);
    float* red = (float*)(lds);
    for (int t = blockIdx.x; t < S; t += gridDim.x) {
        const int c = tid; float acc = p.conv_b[c];
        for (int j = 0; j < CW; ++j) { const int tt = t - (CW - 1) + j; if (tt >= 0) { const float val = bf2f(PROJ[(size_t)tt * NP + C_VAL + c]), gate = bf2f(PROJ[(size_t)tt * NP + C_GATE + c]);
                acc = fmaf(p.conv_w[j * CC + c], val * sigmoidf_(gate), acc); } }
        const int hh = (tid & 255) >> 5, ii = tid & 31; const int qkbase = (tid < 256) ? C_Q : C_K;
        const float cs = COS[t * 32 + ii], sn = SIN[t * 32 + ii];
        const float x1 = bf2f(PROJ[(size_t)t * NP + qkbase + hh * 64 + ii]), x2 = bf2f(PROJ[(size_t)t * NP + qkbase + hh * 64 + 32 + ii]);
        float qi1 = 0.f, qi2 = 0.f; if (tid < 256) { qi1 = bf2f(PROJ[(size_t)t * NP + C_QI + hh * 64 + ii]); qi2 = bf2f(PROJ[(size_t)t * NP + C_QI + hh * 64 + 32 + ii]); }
        float kiv = 0.f, qlv = 0.f;
        if (wave == 4) kiv = bf2f(PROJ[(size_t)t * NP + C_KI + lane]);
        if (wave == 5) { for (int h = 0; h < 8; ++h) qlv = fmaf(bf2f(PROJ[(size_t)t * NP + C_WI + h]), bf2f(PROJ[(size_t)t * NP + C_QI + h * 64 + lane]), qlv); }
        float wiv = 0.f; if (wave == 6 && lane < 8) wiv = bf2f(PROJ[(size_t)t * NP + C_WI + lane]);
        float s1 = wave_sum(acc); if (lane == 0) red[wave] = s1; __syncthreads();
        float mean = 0.f;
#pragma unroll
        for (int w = 0; w < 8; ++w) mean += red[w];
        mean *= (1.f / CC); const float dv = acc - mean; float s2 = wave_sum(dv * dv); if (lane == 0) red[8 + wave] = s2; __syncthreads();
        float var = 0.f;
#pragma unroll
        for (int w = 0; w < 8; ++w) var += red[8 + w];
        var *= (1.f / CC);
        const float y = dv * rsqrtf(var + EPS) * p.conv_ng[c] + p.conv_nb[c];
        MIX[(size_t)t * D + c] = (bf16)f2bf(y * sigmoidf_(y));
        { const float sc = (tid < 256) ? C2 : 1.f; PROJ[(size_t)t * NP + qkbase + hh * 64 + ii] = (bf16)f2bf((x1 * cs - x2 * sn) * sc); PROJ[(size_t)t * NP + qkbase + hh * 64 + 32 + ii] = (bf16)f2bf((x2 * cs + x1 * sn) * sc); }
        if (tid < 256) { PROJ[(size_t)t * NP + C_QI + hh * 64 + ii] = (bf16)f2bf(qi1 * cs - qi2 * sn); PROJ[(size_t)t * NP + C_QI + hh * 64 + 32 + ii] = (bf16)f2bf(qi2 * cs + qi1 * sn); }
        if (wave == 4) { const float m = wave_sum(kiv) * (1.f / 64.f); const float d = kiv - m; const float vr = wave_sum(d * d) * (1.f / 64.f);
            const float yk = d * rsqrtf(vr + EPS) * p.idx_g[lane] + p.idx_b[lane]; const float other = __shfl_xor(yk, 32);
            const float c_ = COS[t * 32 + (lane & 31)], s_ = SIN[t * 32 + (lane & 31)];
            KI[(size_t)t * 64 + lane] = (bf16)f2bf(lane < 32 ? (yk * c_ - other * s_) : (yk * c_ + other * s_)); }
        if (wave == 5) { const float other = __shfl_xor(qlv, 32); const float c_ = COS[t * 32 + (lane & 31)], s_ = SIN[t * 32 + (lane & 31)];
            QL[(size_t)t * 64 + lane] = (bf16)f2bf(lane < 32 ? (qlv * c_ - other * s_) : (qlv * c_ + other * s_)); }
        if (wave == 6 && lane < 8) WI[t * 8 + lane] = wiv;
        __syncthreads();
    }
}

__device__ __forceinline__ void phase_ew_fast(const Params& p, unsigned char* lds) {
    const int tid = opaque_tid(), lane = tid & 63, wave = tid >> 6;
    bf16* PROJ = (bf16*)(p.ws + WS_PROJ); bf16* MIX = (bf16*)(p.ws + WS_MIX); bf16* KI = (bf16*)(p.ws + WS_KI); bf16* QL = (bf16*)(p.ws + WS_QL); float* WI = (float*)(p.ws + WS_WI);
    const float* COS = (const float*)(p.ws + WS_COS); const float* SIN = (const float*)(p.ws + WS_SIN);
    LAS unsigned char* L = (LAS unsigned char*)lds;
    LAS unsigned* U = (LAS unsigned*)L;
    LAS float* RED = (LAS float*)(L + 65536);
    const int cp = tid & 255, g = tid >> 8, wv_ = wave & 3;
    typedef float f32x2 __attribute__((ext_vector_type(2))); f32x2 wv[CW];
#pragma unroll
    for (int j = 0; j < CW; ++j) { const float2 ww = *(const float2*)(p.conv_w + j * CC + 2 * cp); wv[j] = (f32x2){ww.x, ww.y}; }
    const float2 cb = *(const float2*)(p.conv_b + 2 * cp), ng = *(const float2*)(p.conv_ng + 2 * cp), nb = *(const float2*)(p.conv_nb + 2 * cp);
    float kmx = 0.f;
    for (int unit = blockIdx.x; unit < S / 32; unit += gridDim.x) {
        const int t0 = unit * 32;
        __syncthreads();
        ISEC(6);
#pragma unroll 2
        for (int it = tid; it < 62 * 64; it += NTHREADS) { const int row = it >> 6, c8 = (it & 63) * 8, tt = t0 - 30 + row; u32x4 o = (u32x4){0u, 0u, 0u, 0u};
            if (tt >= 0) { const u32x4 va = *(const u32x4*)(PROJ + (size_t)tt * NP + C_VAL + c8), ga = *(const u32x4*)(PROJ + (size_t)tt * NP + C_GATE + c8);
                o.x = pk2(blo(va.x) * sigmoidf_(blo(ga.x)), bhi(va.x) * sigmoidf_(bhi(ga.x))); o.y = pk2(blo(va.y) * sigmoidf_(blo(ga.y)), bhi(va.y) * sigmoidf_(bhi(ga.y)));
                o.z = pk2(blo(va.z) * sigmoidf_(blo(ga.z)), bhi(va.z) * sigmoidf_(bhi(ga.z))); o.w = pk2(blo(va.w) * sigmoidf_(blo(ga.w)), bhi(va.w) * sigmoidf_(bhi(ga.w))); }
            *(LAS u32x4*)(L + (size_t)row * 1024 + c8 * 2) = o; }
        __syncthreads();
        ISEC(12);
        f32x2 acc[16];
#pragma unroll
        for (int tt = 0; tt < 16; ++tt) acc[tt] = (f32x2){cb.x, cb.y};
#pragma unroll
        for (int r = 0; r < 46; ++r) { const unsigned x = U[(g * 16 + r) * 256 + cp]; const f32x2 xv = (f32x2){blo(x), bhi(x)};
#pragma unroll
            for (int tt = 0; tt < 16; ++tt) { const int j = r - tt; if (j >= 0 && j < CW) acc[tt] = __builtin_elementwise_fma(wv[j], xv, acc[tt]); } }
#pragma unroll
        for (int tt = 0; tt < 16; ++tt) { const f32x2 a = acc[tt]; const float s1 = wave_sum(a.x + a.y), s2 = wave_sum(a.x * a.x + a.y * a.y);
            if (lane == 0) { RED[((g * 16 + tt) * 4 + wv_) * 2] = s1; RED[((g * 16 + tt) * 4 + wv_) * 2 + 1] = s2; } }
        __syncthreads();
#pragma unroll
        for (int tt = 0; tt < 16; ++tt) { const LAS f32x4* rp = (const LAS f32x4*)(RED + (g * 16 + tt) * 8); const f32x4 ra = rp[0], rb = rp[1];
            const float mean = (ra.x + ra.z + rb.x + rb.z) * (1.f / CC), var = (ra.y + ra.w + rb.y + rb.w) * (1.f / CC) - mean * mean, rstd = rsqrtf(fmaxf(var, 0.f) + EPS);
            const float y0 = (acc[tt].x - mean) * rstd * ng.x + nb.x, y1 = (acc[tt].y - mean) * rstd * ng.y + nb.y;
            *(unsigned*)(MIX + (size_t)(t0 + g * 16 + tt) * D + 2 * cp) = pk2(y0 * sigmoidf_(y0), y1 * sigmoidf_(y1)); }
        ISEC(13);
        { const int tl = (lane >> 3) & 3, dc = lane & 7, t = t0 + wave * 4 + tl; const bf16* prow = PROJ + (size_t)t * NP;
            const u32x4 kraw = *(const u32x4*)(prow + C_KI + dc * 8); const u32x4 wraw = *(const u32x4*)(prow + C_WI);
            const float wf[8] = {blo(wraw.x), bhi(wraw.x), blo(wraw.y), bhi(wraw.y), blo(wraw.z), bhi(wraw.z), blo(wraw.w), bhi(wraw.w)};
            float kv[8] = {blo(kraw.x), bhi(kraw.x), blo(kraw.y), bhi(kraw.y), blo(kraw.z), bhi(kraw.z), blo(kraw.w), bhi(kraw.w)}, qv[8] = {0.f, 0.f, 0.f, 0.f, 0.f, 0.f, 0.f, 0.f};
#pragma unroll
            for (int h = 0; h < 8; ++h) { const u32x4 q = *(const u32x4*)(prow + C_QI + h * 64 + dc * 8);
                qv[0] = fmaf(wf[h], blo(q.x), qv[0]); qv[1] = fmaf(wf[h], bhi(q.x), qv[1]); qv[2] = fmaf(wf[h], blo(q.y), qv[2]); qv[3] = fmaf(wf[h], bhi(q.y), qv[3]);
                qv[4] = fmaf(wf[h], blo(q.z), qv[4]); qv[5] = fmaf(wf[h], bhi(q.z), qv[5]); qv[6] = fmaf(wf[h], blo(q.w), qv[6]); qv[7] = fmaf(wf[h], bhi(q.w), qv[7]); }
            float s = 0.f;
#pragma unroll
            for (int i = 0; i < 8; ++i) s += kv[i];
            s += __shfl_xor(s, 1); s += __shfl_xor(s, 2); s += __shfl_xor(s, 4); const float m = s * (1.f / 64.f);
            float s2 = 0.f;
#pragma unroll
            for (int i = 0; i < 8; ++i) { kv[i] -= m; s2 += kv[i] * kv[i]; }
            s2 += __shfl_xor(s2, 1); s2 += __shfl_xor(s2, 2); s2 += __shfl_xor(s2, 4); const float rstd = rsqrtf(s2 * (1.f / 64.f) + EPS);
            const f32x4 ga = *(const f32x4*)(p.idx_g + dc * 8), gb = *(const f32x4*)(p.idx_g + dc * 8 + 4), ba = *(const f32x4*)(p.idx_b + dc * 8), bb = *(const f32x4*)(p.idx_b + dc * 8 + 4);
            const float gg[8] = {ga.x, ga.y, ga.z, ga.w, gb.x, gb.y, gb.z, gb.w}, bbv[8] = {ba.x, ba.y, ba.z, ba.w, bb.x, bb.y, bb.z, bb.w};
            const int cd = (dc & 3) * 8;
            const f32x4 c0 = *(const f32x4*)(COS + t * 32 + cd), c1 = *(const f32x4*)(COS + t * 32 + cd + 4), s0 = *(const f32x4*)(SIN + t * 32 + cd), s1 = *(const f32x4*)(SIN + t * 32 + cd + 4);
            const float cc[8] = {c0.x, c0.y, c0.z, c0.w, c1.x, c1.y, c1.z, c1.w}, ss[8] = {s0.x, s0.y, s0.z, s0.w, s1.x, s1.y, s1.z, s1.w};
            float ko[8], qo[8];
#pragma unroll
            for (int i = 0; i < 8; ++i) { const float yk = kv[i] * rstd * gg[i] + bbv[i]; const float ok = __shfl_xor(yk, 4), oq = __shfl_xor(qv[i], 4);
                ko[i] = (dc < 4) ? (yk * cc[i] - ok * ss[i]) : (yk * cc[i] + ok * ss[i]); qo[i] = (dc < 4) ? (qv[i] * cc[i] - oq * ss[i]) : (qv[i] * cc[i] + oq * ss[i]); }
            if (lane < 32) { store8_bf16(KI + (size_t)t * 64 + dc * 8, ko); store8_bf16(QL + (size_t)t * 64 + dc * 8, qo);
                if (dc == 0) { *(f32x4*)(WI + t * 8) = (f32x4){wf[0], wf[1], wf[2], wf[3]}; *(f32x4*)(WI + t * 8 + 4) = (f32x4){wf[4], wf[5], wf[6], wf[7]}; } } }
        __syncthreads();
        ISEC(14);
#pragma unroll 3
        for (int it = tid; it < 32 * 96; it += NTHREADS) { const int tl = it / 96, rem = it % 96, ten = rem >> 5, hh = (rem >> 2) & 7, ch = rem & 3; const int t = t0 + tl;
            bf16* base = PROJ + (size_t)t * NP + (ten == 0 ? C_Q : ten == 1 ? C_K : C_QI) + hh * 64 + ch * 8; const float sc = (ten == 0) ? C2 : 1.f;
            const u32x4 xa = *(const u32x4*)base, xb = *(const u32x4*)(base + 32);
            const f32x4 c0 = *(const f32x4*)(COS + t * 32 + ch * 8), c1 = *(const f32x4*)(COS + t * 32 + ch * 8 + 4), s0 = *(const f32x4*)(SIN + t * 32 + ch * 8), s1 = *(const f32x4*)(SIN + t * 32 + ch * 8 + 4);
            const float x1[8] = {blo(xa.x), bhi(xa.x), blo(xa.y), bhi(xa.y), blo(xa.z), bhi(xa.z), blo(xa.w), bhi(xa.w)}, x2[8] = {blo(xb.x), bhi(xb.x), blo(xb.y), bhi(xb.y), blo(xb.z), bhi(xb.z), blo(xb.w), bhi(xb.w)};
            const float cc[8] = {c0.x, c0.y, c0.z, c0.w, c1.x, c1.y, c1.z, c1.w}, ss[8] = {s0.x, s0.y, s0.z, s0.w, s1.x, s1.y, s1.z, s1.w};
            float o1[8], o2[8];
#pragma unroll
            for (int i = 0; i < 8; ++i) { o1[i] = (x1[i] * cc[i] - x2[i] * ss[i]) * sc; o2[i] = (x2[i] * cc[i] + x1[i] * ss[i]) * sc; }
            if (ten == 1) {
#pragma unroll
                for (int i = 0; i < 8; ++i) kmx = fmaxf(kmx, fmaxf(fabsf(o1[i]), fabsf(o2[i]))); }
            store8_bf16(base, o1); store8_bf16(base + 32, o2); }
        ISEC(5);
    }
    kmx = wave_max(kmx);
    if (lane == 0) atomicMax((unsigned*)(p.ws + WS_CTL) + CW_KMAX, __float_as_uint(kmx * 1.01f));
}

__device__ __forceinline__ unsigned fkey(float f) { unsigned u = __float_as_uint(f); if (u == 0x80000000u) u = 0u; return (u & 0x80000000u) ? ~u : (u | 0x80000000u); }
__device__ __forceinline__ void phase_idx_naive(const Params& p, unsigned char* lds) {
    const int tid = opaque_tid(), lane = tid & 63, wave = tid >> 6;
    const bf16* PROJ = (const bf16*)(p.ws + WS_PROJ); const bf16* KI = (const bf16*)(p.ws + WS_KI); const float* WI = (const float*)(p.ws + WS_WI);
    u64* MASK = (u64*)(p.ws + WS_MASK);
    float* scores = (float*)lds;
    float* qif = (float*)(lds + 65536);
    float* wf = (float*)(lds + 65536 + 2048);
    unsigned* hist = (unsigned*)(lds + 65536 + 4096);
    u64* tiebits = (u64*)(lds + 65536 + 8192);
    int* sh = (int*)(lds + 65536 + 12288);
    for (int t = blockIdx.x; t < S; t += gridDim.x) {
        const int tq = t >> 6, nadm = 64 * (tq + 1), ntw = 4 * (t >> 8) + 4;
        __syncthreads();
        if (nadm <= KSEL) {
            if (tid < ntw) MASK[(size_t)tid * S + t] = (tid <= tq) ? ~0ull : 0ull;
            continue;
        }
        qif[tid] = bf2f(PROJ[(size_t)t * NP + C_QI + tid]); if (tid < 8) wf[tid] = WI[t * 8 + tid];
        __syncthreads();
        for (int s = tid; s < nadm; s += NTHREADS) {
            float kf[64];
#pragma unroll
            for (int j = 0; j < 8; ++j) { const u32x4 v = *(const u32x4*)(KI + (size_t)s * 64 + j * 8);
                kf[j * 8 + 0] = blo(v.x); kf[j * 8 + 1] = bhi(v.x); kf[j * 8 + 2] = blo(v.y); kf[j * 8 + 3] = bhi(v.y); kf[j * 8 + 4] = blo(v.z); kf[j * 8 + 5] = bhi(v.z); kf[j * 8 + 6] = blo(v.w); kf[j * 8 + 7] = bhi(v.w); }
            float I = 0.f;
            for (int h = 0; h < 8; ++h) { float d = 0.f;
#pragma unroll
                for (int k = 0; k < 64; k += 4) { const f32x4 q4 = *(const f32x4*)(qif + h * 64 + k); d = fmaf(q4.x, kf[k], d); d = fmaf(q4.y, kf[k + 1], d); d = fmaf(q4.z, kf[k + 2], d); d = fmaf(q4.w, kf[k + 3], d); }
                I = fmaf(wf[h], fmaxf(d, 0.f), I); }
            scores[s] = I;
        }
        __syncthreads();
        unsigned prefix = 0; int kk = KSEL;
        for (int ps = 0; ps < 4; ++ps) {
            const int shift = 24 - 8 * ps;
            if (tid < 256) hist[tid] = 0u;
            __syncthreads();
            for (int s = tid; s < nadm; s += NTHREADS) { const unsigned key = fkey(scores[s]); if (ps == 0 || (key >> (shift + 8)) == prefix) atomicAdd(&hist[(key >> shift) & 255u], 1u); }
            __syncthreads();
            if (wave == 0) {
                unsigned c4[4]; unsigned tot = 0;
#pragma unroll
                for (int j = 0; j < 4; ++j) { c4[j] = hist[255 - (4 * lane + j)]; tot += c4[j]; }
                unsigned incl = tot;
#pragma unroll
                for (int o = 1; o < 64; o <<= 1) { const unsigned v = __shfl_up(incl, o); if (lane >= o) incl += v; }
                const unsigned excl = incl - tot;
                if (excl < (unsigned)kk && (unsigned)kk <= incl) { const unsigned s0 = excl + c4[0], s1 = s0 + c4[1], s2 = s1 + c4[2]; const unsigned ukk = (unsigned)kk;
                    const int j = ukk <= s0 ? 0 : ukk <= s1 ? 1 : ukk <= s2 ? 2 : 3; const unsigned cum = ukk <= s0 ? excl : ukk <= s1 ? s0 : ukk <= s2 ? s1 : s2;
                    sh[0] = 255 - (4 * lane + j); sh[1] = kk - (int)cum; }
            }
            __syncthreads();
            prefix = (prefix << 8) | (unsigned)sh[0]; kk = sh[1];
            __syncthreads();
        }
        const unsigned T = prefix;
        if (wave == 0) { int run = 0;
            for (int tile = 0; tile <= tq; ++tile) { const bool tie = fkey(scores[tile * 64 + lane]) == T; const u64 bal = __ballot(tie);
                const int rank = run + __popcll(bal & ((1ull << lane) - 1ull)); const u64 tb = __ballot(tie && rank < kk); if (lane == 0) tiebits[tile] = tb; run += __popcll(bal); } }
        __syncthreads();
        for (int tile = wave; tile < ntw; tile += NWAVES) { u64 w = 0ull;
            if (tile <= tq) { w = __ballot(fkey(scores[tile * 64 + lane]) > T) | tiebits[tile]; }
            if (lane == 0) MASK[(size_t)tile * S + t] = w; }
    }
}

namespace idxf {
typedef short bf16x8 __attribute__((ext_vector_type(8)));
typedef float f32x16 __attribute__((ext_vector_type(16)));
constexpr int L_B = 0, L_HIST = 36864, L_PK = L_HIST + 32 * 513 * 4, L_TAIL = L_PK + 2048, L_CC = L_TAIL + 2 * 32 * 64 * 4, L_CT = L_CC + 16 * 32 * 4, L_END = L_CT + 16 * 32 * 4;
constexpr int PK_P = 0, PK_KK = 32, PK_TC = 64, PK_A = 96, PK_SC = 128, PK_MN = 160, PK_MX = 192, PK_FLAG = 224, PK_LO = 256, PK_ND = 288, PK_NC = 320;
constexpr int CAND_CAP = 1024;
constexpr int R_HI = 12, R_LO = 56;
static_assert(L_END <= 131072, "idx LDS");
__device__ __forceinline__ unsigned fkey32(float f) { const unsigned u = __float_as_uint(f); return u ^ ((unsigned)((int)u >> 31) | 0x80000000u); }
__device__ __forceinline__ float fkey_inv(unsigned k) { return __uint_as_float((k & 0x80000000u) ? (k ^ 0x80000000u) : ~k); }
__device__ __forceinline__ int lbin(float I, float A, float sc) { const int b = (int)((I - A) * sc); return b < 0 ? 0 : (b > 1023 ? 1023 : b); }

template <int MODE>
__device__ __forceinline__ void sweep(const Params& p, LAS unsigned char* L, int q0, int ntk, int wave, int lane) {
    const int j = lane & 31, hi = lane >> 5;
    const bf16* KI = (const bf16*)(p.ws + WS_KI); u64* MASK = (u64*)(p.ws + WS_MASK);
    LAS unsigned* PK = (LAS unsigned*)(L + L_PK); LAS unsigned* tailk = (LAS unsigned*)(L + L_TAIL); LAS unsigned* taili = tailk + 32 * 64;
    LAS unsigned* hist = (LAS unsigned*)(L + L_HIST) + ((MODE == 5 || MODE >= 7) ? j : j * 257);
    float w[8]; { const f32x4 wa = *(const f32x4*)((const float*)(p.ws + WS_WI) + (size_t)(q0 + j) * 8), wb = *(const f32x4*)((const float*)(p.ws + WS_WI) + (size_t)(q0 + j) * 8 + 4);
        w[0] = wa.x; w[1] = wa.y; w[2] = wa.z; w[3] = wa.w; w[4] = wb.x; w[5] = wb.y; w[6] = wb.z; w[7] = wb.w; }
    const unsigned P = (MODE == 2 || MODE == 3 || MODE == 6 || MODE == 8) ? PK[PK_P + j] : 0u; const unsigned PLO = (MODE == 8) ? PK[PK_LO + j] : 0u; unsigned ndef = 0u, ccnt = 0u;
    u64* CAND = (u64*)(p.ws + WS_XS) + (size_t)(q0 + j) * CAND_CAP + (wave * 2 + hi) * 64;
    const int nloop = (MODE == 4) ? NWAVES : (MODE == 7) ? ((ntk + 7) >> 3) : ntk;
    const float lA = (MODE >= 5) ? __uint_as_float(PK[PK_A + j]) : 0.f, lS = (MODE >= 5) ? __uint_as_float(PK[PK_SC + j]) : 0.f;
    const LAS unsigned char* bfr = L + L_B + lane * 16;
    const bf16* abase = KI + hi * 8;
    unsigned kmn = 0xffffffffu, tk8[8] = {0u, 0u, 0u, 0u, 0u, 0u, 0u, 0u};
    bf16x8 a[2][4];
#define IDX_LOADA(dst, kt_) do { _Pragma("unroll") for (int hf = 0; hf < 2; ++hf) { const int row = (MODE == 4) ? ((((kt_) * 64 + hf * 32 + (lane & 31)) * (ntk * 64)) >> 9) : (MODE == 7) ? min((((kt_) * 64 + hf * 32 + (lane & 31)) << 3) + 5, ntk * 64 - 1) : ((kt_) * 64 + hf * 32 + (lane & 31)); \
            _Pragma("unroll") for (int ks = 0; ks < 4; ++ks) dst[hf][ks] = *(const bf16x8*)(abase + (size_t)row * 64 + ks * 16); } } while (0)
    for (int kt = wave; kt < nloop; kt += NWAVES) {
        IDX_LOADA(a, kt);
        f32x16 L0, L1; float I0[16], I1[16];
        f32x16 cA0, cA1, cB0, cB1; bf16x8 bA[4], bB[4];
#define IDX_LOADB(BD, H) do { _Pragma("unroll") for (int ks = 0; ks < 4; ++ks) BD[ks] = *(const LAS bf16x8*)(bfr + ((H) * 4 + ks) * 1024); } while (0)
#define IDX_CHAIN(D0, D1, BS) do { D0 = f32x16{}; D1 = f32x16{}; _Pragma("unroll") for (int ks = 0; ks < 4; ++ks) { \
            D0 = __builtin_amdgcn_mfma_f32_32x32x16_bf16(a[0][ks], BS[ks], D0, 0, 0, 0); D1 = __builtin_amdgcn_mfma_f32_32x32x16_bf16(a[1][ks], BS[ks], D1, 0, 0, 0); } \
            asm volatile("" : "+v"(D0)); asm volatile("" : "+v"(D1)); } while (0)
#define IDX_ACC(C0_, C1_, H) do { _Pragma("unroll") for (int r = 0; r < 16; ++r) { I0[r] = fmaf(w[H], __builtin_fabsf(C0_[r]), I0[r]); I1[r] = fmaf(w[H], __builtin_fabsf(C1_[r]), I1[r]); asm volatile("" : "+v"(I0[r]), "+v"(I1[r])); } } while (0)
#define IDX_SB __builtin_amdgcn_sched_barrier(0)
        IDX_LOADB(bA, 8); IDX_LOADB(bB, 0); IDX_SB;
        IDX_LOADB(bA, 8); IDX_CHAIN(L0, L1, bA); IDX_SB;
        IDX_LOADB(bA, 1); IDX_CHAIN(cA0, cA1, bB); IDX_SB;
#pragma unroll
        for (int r = 0; r < 16; ++r) { I0[r] = L0[r]; I1[r] = L1[r]; }
        IDX_LOADB(bB, 2); IDX_CHAIN(cB0, cB1, bA); IDX_ACC(cA0, cA1, 0); IDX_SB;
        IDX_LOADB(bA, 3); IDX_CHAIN(cA0, cA1, bB); IDX_ACC(cB0, cB1, 1); IDX_SB;
        IDX_LOADB(bB, 4); IDX_CHAIN(cB0, cB1, bA); IDX_ACC(cA0, cA1, 2); IDX_SB;
        IDX_LOADB(bA, 5); IDX_CHAIN(cA0, cA1, bB); IDX_ACC(cB0, cB1, 3); IDX_SB;
        IDX_LOADB(bB, 6); IDX_CHAIN(cB0, cB1, bA); IDX_ACC(cA0, cA1, 4); IDX_SB;
        IDX_LOADB(bA, 7); IDX_CHAIN(cA0, cA1, bB); IDX_ACC(cB0, cB1, 5); IDX_SB;
        IDX_CHAIN(cB0, cB1, bA); IDX_ACC(cA0, cA1, 6); IDX_SB;
        IDX_ACC(cB0, cB1, 7);
        IDX_SB;
#undef IDX_LOADB
#undef IDX_SB
#undef IDX_CHAIN
#undef IDX_ACC
        if (MODE == 1) {
#pragma unroll
            for (int r = 0; r < 16; ++r) { const unsigned k0 = fkey32(I0[r]), k1 = fkey32(I1[r]);
                __hip_atomic_fetch_add(hist + (k0 >> 24), 1u, __ATOMIC_RELAXED, __HIP_MEMORY_SCOPE_WORKGROUP); __hip_atomic_fetch_add(hist + (k1 >> 24), 1u, __ATOMIC_RELAXED, __HIP_MEMORY_SCOPE_WORKGROUP); }
        } else if (MODE == 2) {
#pragma unroll
            for (int r = 0; r < 16; ++r) { const unsigned k0 = fkey32(I0[r]), k1 = fkey32(I1[r]);
                if ((k0 >> 24) == P) __hip_atomic_fetch_add(hist + ((k0 >> 16) & 255u), 1u, __ATOMIC_RELAXED, __HIP_MEMORY_SCOPE_WORKGROUP);
                if ((k1 >> 24) == P) __hip_atomic_fetch_add(hist + ((k1 >> 16) & 255u), 1u, __ATOMIC_RELAXED, __HIP_MEMORY_SCOPE_WORKGROUP); }
        } else if (MODE == 4) {
#pragma unroll
            for (int r = 0; r < 16; ++r) { unsigned k0 = fkey32(I0[r]), k1 = fkey32(I1[r]); kmn = min(kmn, min(k0, k1));
#pragma unroll
                for (int i = 0; i < 8; ++i) { const unsigned hi0 = max(tk8[i], k0); k0 = min(tk8[i], k0); tk8[i] = hi0; }
#pragma unroll
                for (int i = 0; i < 8; ++i) { const unsigned hi1 = max(tk8[i], k1); k1 = min(tk8[i], k1); tk8[i] = hi1; } }
        } else if (MODE == 5 || MODE == 7) {
#pragma unroll
            for (int r = 0; r < 16; ++r) { const int b0 = lbin(I0[r], lA, lS), b1 = lbin(I1[r], lA, lS); const int kb = (r & 3) + 8 * (r >> 2) + 4 * hi;
                const bool v0 = (MODE == 5) || (((kt * 64 + kb) << 3) + 5 < ntk * 64), v1 = (MODE == 5) || (((kt * 64 + 32 + kb) << 3) + 5 < ntk * 64);
                if (v0) __hip_atomic_fetch_add(hist + (b0 >> 1) * 32, 1u << ((b0 & 1) * 16), __ATOMIC_RELAXED, __HIP_MEMORY_SCOPE_WORKGROUP);
                if (v1) __hip_atomic_fetch_add(hist + (b1 >> 1) * 32, 1u << ((b1 & 1) * 16), __ATOMIC_RELAXED, __HIP_MEMORY_SCOPE_WORKGROUP); }
        } else if (MODE == 8) {
            unsigned wlo = 0u, whi = 0u; const float thi = (P >= 1023u) ? INFINITY : (float)(P + 1u), tlo = (float)PLO;     const unsigned wbits = __float_as_uint(thi - tlo);
#pragma unroll
            for (int r = 0; r < 16; ++r) { const int kb = (r & 3) + 8 * (r >> 2); const float x0 = (I0[r] - lA) * lS, x1 = (I1[r] - lA) * lS;
                wlo |= (x0 >= thi) ? (1u << kb) : 0u; whi |= (x1 >= thi) ? (1u << kb) : 0u;
                if (__float_as_uint(x0 - tlo) < wbits) { const unsigned c0 = (unsigned)lbin(I0[r], lA, lS); __hip_atomic_fetch_add(hist + (c0 >> 1) * 32, 1u << ((c0 & 1) * 16), __ATOMIC_RELAXED, __HIP_MEMORY_SCOPE_WORKGROUP);
                    if (ccnt < 64u) CAND[ccnt] = ((u64)fkey32(I0[r]) << 32) | (u64)(unsigned)(kt * 64 + kb + 4 * hi); ++ccnt; }
                if (__float_as_uint(x1 - tlo) < wbits) { const unsigned c1 = (unsigned)lbin(I1[r], lA, lS); __hip_atomic_fetch_add(hist + (c1 >> 1) * 32, 1u << ((c1 & 1) * 16), __ATOMIC_RELAXED, __HIP_MEMORY_SCOPE_WORKGROUP);
                    if (ccnt < 64u) CAND[ccnt] = ((u64)fkey32(I1[r]) << 32) | (u64)(unsigned)(kt * 64 + 32 + kb + 4 * hi); ++ccnt; } }
            wlo <<= 4 * hi; whi <<= 4 * hi;
            wlo |= (unsigned)__shfl_xor((int)wlo, 32); whi |= (unsigned)__shfl_xor((int)whi, 32);
            if (hi == 0) { MASK[(size_t)kt * S + q0 + j] = ((u64)whi << 32) | (u64)wlo; ndef += (unsigned)(__popc(wlo) + __popc(whi)); }
        } else {
            unsigned wlo = 0u, whi = 0u;
#pragma unroll
            for (int r = 0; r < 16; ++r) { const int kb = (r & 3) + 8 * (r >> 2); const unsigned k0 = fkey32(I0[r]), k1 = fkey32(I1[r]);
                const unsigned c0 = (MODE == 3) ? (k0 >> 16) : (unsigned)lbin(I0[r], lA, lS), c1 = (MODE == 3) ? (k1 >> 16) : (unsigned)lbin(I1[r], lA, lS);
                wlo |= (c0 > P) ? (1u << kb) : 0u; whi |= (c1 > P) ? (1u << kb) : 0u;
                if (c0 == P) { const unsigned pos = __hip_atomic_fetch_add(PK + PK_TC + j, 1u, __ATOMIC_RELAXED, __HIP_MEMORY_SCOPE_WORKGROUP); if (pos < 64u) { tailk[j * 64 + pos] = k0; taili[j * 64 + pos] = (unsigned)(kt * 64 + kb + 4 * hi); } }
                if (c1 == P) { const unsigned pos = __hip_atomic_fetch_add(PK + PK_TC + j, 1u, __ATOMIC_RELAXED, __HIP_MEMORY_SCOPE_WORKGROUP); if (pos < 64u) { tailk[j * 64 + pos] = k1; taili[j * 64 + pos] = (unsigned)(kt * 64 + 32 + kb + 4 * hi); } } }
            wlo <<= 4 * hi; whi <<= 4 * hi;
            wlo |= (unsigned)__shfl_xor((int)wlo, 32); whi |= (unsigned)__shfl_xor((int)whi, 32);
            if (hi == 0) MASK[(size_t)kt * S + q0 + j] = ((u64)whi << 32) | (u64)wlo;
        }
    }
#undef IDX_LOADA
    if (MODE == 8) { if (hi == 0 && ndef) __hip_atomic_fetch_add(PK + PK_ND + j, ndef, __ATOMIC_RELAXED, __HIP_MEMORY_SCOPE_WORKGROUP); ((LAS unsigned*)(L + L_CC))[(wave * 2 + hi) * 32 + j] = ccnt; }
    if (MODE == 4) {
        const int nadm = ntk * 64; const unsigned cand = nadm >= 8192 ? tk8[3] : nadm >= 4096 ? tk8[7] : nadm >= 2048 ? kmn : nadm >= 1024 ? tk8[7] : kmn;
        __hip_atomic_fetch_min(PK + PK_MN + j, cand, __ATOMIC_RELAXED, __HIP_MEMORY_SCOPE_WORKGROUP); __hip_atomic_fetch_max(PK + PK_MX + j, tk8[0], __ATOMIC_RELAXED, __HIP_MEMORY_SCOPE_WORKGROUP); }
}

__device__ __forceinline__ void scan4(LAS unsigned char* L, int wave, int lane) {
    LAS unsigned* PK = (LAS unsigned*)(L + L_PK);
    for (int qq = 0; qq < 4; ++qq) { const int jq = wave * 4 + qq; const LAS unsigned* hb = (const LAS unsigned*)(L + L_HIST) + jq * 257;
        const unsigned kk = PK[PK_KK + jq];
        const unsigned c0 = hb[255 - 4 * lane], c1 = hb[254 - 4 * lane], c2 = hb[253 - 4 * lane], c3 = hb[252 - 4 * lane]; const unsigned tot = c0 + c1 + c2 + c3;
        unsigned incl = tot;
#pragma unroll
        for (int o = 1; o < 64; o <<= 1) { const unsigned v = __shfl_up(incl, o); if (lane >= o) incl += v; }
        const unsigned excl = incl - tot;
        if (excl < kk && kk <= incl) { const unsigned s0 = excl + c0, s1 = s0 + c1, s2 = s1 + c2;
            const int jb = kk <= s0 ? 0 : kk <= s1 ? 1 : kk <= s2 ? 2 : 3; const unsigned cum = kk <= s0 ? excl : kk <= s1 ? s0 : kk <= s2 ? s1 : s2;
            PK[PK_P + jq] = (PK[PK_P + jq] << 8) | (unsigned)(255 - (4 * lane + jb)); PK[PK_KK + jq] = kk - cum; }
    }
}
__device__ __forceinline__ void scan_lin(LAS unsigned char* L, int tid, int kk_off = PK_KK, int out_off = PK_P, bool write_kk = true) {
    LAS unsigned* PK = (LAS unsigned*)(L + L_PK); LAS unsigned* CT = (LAS unsigned*)(L + L_CT);
    const int jq = tid & 31, ch = tid >> 5; const LAS unsigned* hb = (const LAS unsigned*)(L + L_HIST) + (32 * ch) * 32 + jq;
    unsigned tot = 0u;
#pragma unroll 8
    for (int i = 0; i < 32; ++i) { const unsigned wd = hb[i * 32]; tot += (wd & 0xffffu) + (wd >> 16); }
    CT[ch * 32 + jq] = tot;
    __syncthreads();
    unsigned excl = 0u;
#pragma unroll
    for (int c = 1; c < 16; ++c) excl += (c > ch) ? CT[c * 32 + jq] : 0u;
    const unsigned kk = PK[kk_off + jq];
    if (excl < kk && kk <= excl + tot) { unsigned cum = excl, bsel = 0u, nk = 0u; bool done = false;
        for (int i = 31; i >= 0; --i) { const unsigned wd = hb[i * 32]; const unsigned chi = wd >> 16, clo = wd & 0xffffu;
            bool hit = !done && (cum + chi >= kk); bsel = hit ? (unsigned)(2 * (32 * ch + i) + 1) : bsel; nk = hit ? (kk - cum) : nk; done = done || hit; cum += chi;
            hit = !done && (cum + clo >= kk); bsel = hit ? (unsigned)(2 * (32 * ch + i)) : bsel; nk = hit ? (kk - cum) : nk; done = done || hit; cum += clo; }
        PK[out_off + jq] = bsel; if (write_kk) PK[PK_KK + jq] = nk; }
}
template <bool TOLDS>
__device__ __forceinline__ void tail_resolve(const Params& p, LAS unsigned char* L, int q0, int tid) {
    u64* MASK = (u64*)(p.ws + WS_MASK); LAS unsigned* PK = (LAS unsigned*)(L + L_PK); LAS u64* MW = (LAS u64*)(L + L_HIST);
    const int jq = tid >> 4, e0 = tid & 15; const unsigned n = min(PK[PK_TC + jq], 64u), kk = PK[PK_KK + jq];
    const LAS unsigned* tk = (const LAS unsigned*)(L + L_TAIL) + jq * 64; const LAS unsigned* ti = tk + 32 * 64;
    for (unsigned e = e0; e < n; e += 16) { const unsigned k = tk[e], s = ti[e]; unsigned rank = 0;
        for (unsigned e2 = 0; e2 < n; ++e2) { const unsigned k2 = tk[e2], s2 = ti[e2]; rank += (k2 > k || (k2 == k && s2 < s)) ? 1u : 0u; }
        if (rank < kk) { if (TOLDS) __hip_atomic_fetch_or(MW + (s >> 6) * 32 + jq, 1ull << (s & 63), __ATOMIC_RELAXED, __HIP_MEMORY_SCOPE_WORKGROUP);
            else atomicOr((unsigned long long*)&MASK[(size_t)(s >> 6) * S + q0 + jq], 1ull << (s & 63)); } }
}
__device__ __forceinline__ void idx_unit(const Params& p, unsigned char* lds, int u) {
    int tid_ = threadIdx.x; asm volatile("" : "+v"(tid_)); const int tid = tid_, lane = tid & 63; const int wave = __builtin_amdgcn_readfirstlane(tid >> 6);
    LAS unsigned char* L = (LAS unsigned char*)lds;
    const int q0 = u * 32, tq = q0 >> 6, ntk = tq + 1, ntw = 4 * (q0 >> 8) + 4;
    u64* MASK = (u64*)(p.ws + WS_MASK);
    if (ntk * 64 <= KSEL) { for (int i = tid; i < ntw * 32; i += NTHREADS) { const int tile = i >> 5; MASK[(size_t)tile * S + q0 + (i & 31)] = (tile <= tq) ? ~0ull : 0ull; } return; }
    for (int i = tid; i < (ntw - ntk) * 32; i += NTHREADS) MASK[(size_t)(ntk + (i >> 5)) * S + q0 + (i & 31)] = 0ull;
    __syncthreads();
    ISEC(7);
    { const bf16* PROJ = (const bf16*)(p.ws + WS_PROJ); const bf16* QL = (const bf16*)(p.ws + WS_QL); const int j = lane & 31, hi = lane >> 5;
        for (int f = wave; f < 36; f += NWAVES) { const int h = f >> 2, ks = f & 3;
            const bf16* src = (h < 8) ? PROJ + (size_t)(q0 + j) * NP + C_QI + h * 64 + ks * 16 + hi * 8 : QL + (size_t)(q0 + j) * 64 + ks * 16 + hi * 8;
            *(LAS u32x4*)(L + L_B + f * 1024 + lane * 16) = *(const u32x4*)src; } }
    LAS unsigned* PK = (LAS unsigned*)(L + L_PK);
    if (tid < 32) { PK[PK_P + tid] = 0u; PK[PK_KK + tid] = (unsigned)KSEL; PK[PK_TC + tid] = 0u; PK[PK_MN + tid] = 0xffffffffu; PK[PK_MX + tid] = 0u; }
    if (tid == 0) PK[PK_FLAG] = 0u;
    for (int i = tid; i < 32 * 513; i += NTHREADS) ((LAS unsigned*)(L + L_HIST))[i] = 0u;
    __syncthreads();
    ISEC(0);
    sweep<4>(p, L, q0, ntk, wave, lane);
    __syncthreads();
    ISEC(1);
    if (tid < 32) { const float mn = fkey_inv(PK[PK_MN + tid]), mx = fkey_inv(PK[PK_MX + tid]); const float rg = mx - mn; const float A = mn; const float sc = 1024.f / (1.5f * rg);
        PK[PK_A + tid] = __float_as_uint(A); PK[PK_SC + tid] = __float_as_uint(sc); if (!(rg > 0.f) || !(sc < 3.0e38f)) PK[PK_FLAG] = 1u; }
    __syncthreads();
    bool fallback = PK[PK_FLAG] != 0u;
    bool done = false;
    if (!fallback && ntk >= 32) {
        sweep<7>(p, L, q0, ntk, wave, lane);
        __syncthreads();
        ISEC(8);
        if (tid < 32) { PK[PK_ND + tid] = (unsigned)R_HI; PK[PK_NC + tid] = (unsigned)R_LO; }
        __syncthreads();
        scan_lin(L, tid, PK_ND, PK_P, false);
        __syncthreads();
        scan_lin(L, tid, PK_NC, PK_LO, false);
        __syncthreads();
        if (tid < 32) { PK[PK_ND + tid] = 0u; PK[PK_NC + tid] = 0u; }
        for (int i = tid; i < 32 * 513; i += NTHREADS) ((LAS unsigned*)(L + L_HIST))[i] = 0u;
        __syncthreads();
        ISEC(9);
        sweep<8>(p, L, q0, ntk, wave, lane);
        __syncthreads();
        ISEC(10);
        if (tid < 32) { const LAS unsigned* cc = (const LAS unsigned*)(L + L_CC) + tid; unsigned nc = 0u, mxc = 0u;
#pragma unroll
            for (int i = 0; i < 16; ++i) { const unsigned c = cc[i * 32]; nc += c; mxc = max(mxc, c); }
            const unsigned nd = PK[PK_ND + tid]; const bool ok = nd < (unsigned)KSEL && nd + nc >= (unsigned)KSEL && mxc <= 64u;
            if (!ok) PK[PK_FLAG] = 1u; PK[PK_KK + tid] = (unsigned)KSEL - (ok ? nd : 0u); PK[PK_TC + tid] = 0u; }
        __syncthreads();
        if (PK[PK_FLAG] == 0u) {
            scan_lin(L, tid);
            __syncthreads();
            LAS u64* MW = (LAS u64*)(L + L_HIST);
            for (int i = tid; i < ntk * 32; i += NTHREADS) MW[i] = 0ull;
            __syncthreads();
            { const int jq = tid >> 4, e0 = tid & 15; const unsigned nc = ((const LAS unsigned*)(L + L_CC))[e0 * 32 + jq], bt = PK[PK_P + jq]; const float cA = __uint_as_float(PK[PK_A + jq]), cS = __uint_as_float(PK[PK_SC + jq]);
                const u64* cl = (const u64*)(p.ws + WS_XS) + (size_t)(q0 + jq) * CAND_CAP + e0 * 64; LAS unsigned* tk = (LAS unsigned*)(L + L_TAIL) + jq * 64; LAS unsigned* ti = tk + 32 * 64;
                for (unsigned eb = 0; eb < nc; eb += 8) { u64 rec[8];
#pragma unroll
                    for (int i = 0; i < 8; ++i) { const unsigned e = eb + i; rec[i] = (e < nc) ? cl[e] : 0ull; }
#pragma unroll
                    for (int i = 0; i < 8; ++i) { const unsigned e = eb + i; if (e < nc) { const unsigned key = (unsigned)(rec[i] >> 32), s = (unsigned)rec[i]; const unsigned b = (unsigned)lbin(fkey_inv(key), cA, cS);
                            if (b > bt) __hip_atomic_fetch_or(MW + (s >> 6) * 32 + jq, 1ull << (s & 63), __ATOMIC_RELAXED, __HIP_MEMORY_SCOPE_WORKGROUP);
                            else if (b == bt) { const unsigned pos = __hip_atomic_fetch_add(PK + PK_TC + jq, 1u, __ATOMIC_RELAXED, __HIP_MEMORY_SCOPE_WORKGROUP); if (pos < 64u) { tk[pos] = key; ti[pos] = s; } } } } } }
            __syncthreads();
            if (tid < 32 && PK[PK_TC + tid] > 64u) PK[PK_FLAG] = 1u;
            __syncthreads();
            if (PK[PK_FLAG] == 0u) { tail_resolve<true>(p, L, q0, tid); __syncthreads();
                for (int i = tid; i < ntk * 32; i += NTHREADS) { const u64 wv = MW[i]; if (wv) { u64* gp = &MASK[(size_t)(i >> 5) * S + q0 + (i & 31)]; *gp = *gp | wv; } }
                done = true; }
        }
        ISEC(11);
        if (!done) {
            __syncthreads();
#if PROBE_PHASE == 101
            if (tid == 0) atomicAdd((unsigned*)(p.ws + WS_CTL) + 2048, 1u);
#endif
            if (tid < 32) { PK[PK_P + tid] = 0u; PK[PK_KK + tid] = (unsigned)KSEL; PK[PK_TC + tid] = 0u; }
            if (tid == 0) PK[PK_FLAG] = 0u;
            for (int i = tid; i < 32 * 513; i += NTHREADS) ((LAS unsigned*)(L + L_HIST))[i] = 0u;
            __syncthreads();
        }
    }
    if (!fallback && !done) {
        sweep<5>(p, L, q0, ntk, wave, lane);
        __syncthreads();
        ISEC(2);
        scan_lin(L, tid);
        __syncthreads();
        ISEC(3);
        sweep<6>(p, L, q0, ntk, wave, lane);
        ISEC(4);
        __syncthreads();
        if (tid < 32 && PK[PK_TC + tid] > 64u) PK[PK_FLAG] = 1u;
        __syncthreads();
        fallback = PK[PK_FLAG] != 0u;
        if (!fallback) tail_resolve<false>(p, L, q0, tid);
        ISEC(5);
    }
    if (fallback && !done) {
        __syncthreads();
#if PROBE_PHASE == 100
        if (tid == 0) atomicAdd((unsigned*)(p.ws + WS_CTL) + 2048, 1u);
#endif
        if (tid < 32) { PK[PK_P + tid] = 0u; PK[PK_KK + tid] = (unsigned)KSEL; PK[PK_TC + tid] = 0u; }
        for (int i = tid; i < 32 * 257; i += NTHREADS) ((LAS unsigned*)(L + L_HIST))[i] = 0u;
        __syncthreads();
        sweep<1>(p, L, q0, ntk, wave, lane);
        __syncthreads();
        scan4(L, wave, lane);
        __syncthreads();
        for (int i = tid; i < 32 * 257; i += NTHREADS) ((LAS unsigned*)(L + L_HIST))[i] = 0u;
        __syncthreads();
        sweep<2>(p, L, q0, ntk, wave, lane);
        __syncthreads();
        scan4(L, wave, lane);
        __syncthreads();
        sweep<3>(p, L, q0, ntk, wave, lane);
        __syncthreads();
        tail_resolve<false>(p, L, q0, tid);
    }
}
__device__ __forceinline__ void idx_phase(const Params& p, unsigned char* lds) {
    for (int w = blockIdx.x; w < 256; w += gridDim.x)
#pragma unroll 1
        for (int k = 0; k < 2; ++k) idx_unit(p, lds, k ? 511 - w : w);
}
}

__device__ __forceinline__ void phase_att_naive(const Params& p, unsigned char* lds) {
    const int tid = opaque_tid(), lane = tid & 63, wave = tid >> 6;
    const bf16* PROJ = (const bf16*)(p.ws + WS_PROJ); bf16* MIX = (bf16*)(p.ws + WS_MIX); const u64* MASK = (const u64*)(p.ws + WS_MASK);
    int* sidx = (int*)(lds + wave * 2048); float* slog = (float*)(lds + wave * 2048 + 1024);
    const int h = wave;
    for (int t = blockIdx.x; t < S; t += gridDim.x) {
        const int tq = t >> 6;
        float qf[64];
#pragma unroll
        for (int j = 0; j < 8; ++j) { const u32x4 v = *(const u32x4*)(PROJ + (size_t)t * NP + C_Q + h * 64 + j * 8);
            qf[j * 8 + 0] = blo(v.x); qf[j * 8 + 1] = bhi(v.x); qf[j * 8 + 2] = blo(v.y); qf[j * 8 + 3] = bhi(v.y); qf[j * 8 + 4] = blo(v.z); qf[j * 8 + 5] = bhi(v.z); qf[j * 8 + 6] = blo(v.w); qf[j * 8 + 7] = bhi(v.w); }
        int n = 0;
        for (int tile = 0; tile <= tq; ++tile) {
            const u64 w = MASK[(size_t)tile * S + t]; const bool sel = (w >> lane) & 1ull;
            if (w == 0ull) continue;
            float lg = 0.f; const int s = tile * 64 + lane;
            if (sel) {
#pragma unroll
                for (int j = 0; j < 8; ++j) { const u32x4 v = *(const u32x4*)(PROJ + (size_t)s * NP + C_K + h * 64 + j * 8);
                    lg = fmaf(qf[j * 8 + 0], blo(v.x), lg); lg = fmaf(qf[j * 8 + 1], bhi(v.x), lg); lg = fmaf(qf[j * 8 + 2], blo(v.y), lg); lg = fmaf(qf[j * 8 + 3], bhi(v.y), lg);
                    lg = fmaf(qf[j * 8 + 4], blo(v.z), lg); lg = fmaf(qf[j * 8 + 5], bhi(v.z), lg); lg = fmaf(qf[j * 8 + 6], blo(v.w), lg); lg = fmaf(qf[j * 8 + 7], bhi(v.w), lg); }
                const int pos = n + __popcll(w & ((1ull << lane) - 1ull));
                if (pos < 256) { sidx[pos] = s; slog[pos] = lg; }
            }
            n += __popcll(w);
        }
        if (n > 256) n = 256;
        __builtin_amdgcn_s_waitcnt(0); asm volatile("" ::: "memory");
        float m = -INFINITY; for (int j = lane; j < n; j += 64) m = fmaxf(m, slog[j]);
        m = wave_max(m);
        float l = 0.f; for (int j = lane; j < n; j += 64) { const float pj = exp2f(slog[j] - m); slog[j] = pj; l += pj; }
        l = wave_sum(l);
        __builtin_amdgcn_s_waitcnt(0); asm volatile("" ::: "memory");
        float o = 0.f;
        for (int j = 0; j < n; ++j) o = fmaf(slog[j], bf2f(PROJ[(size_t)sidx[j] * NP + C_V + h * 64 + lane]), o);
        MIX[(size_t)t * D + 512 + h * 64 + lane] = (bf16)f2bf(o / l);
        __builtin_amdgcn_s_waitcnt(0); asm volatile("" ::: "memory");
    }
}

namespace attn_body {
using bf16=__hip_bfloat16;
using bf16x8=__attribute__((ext_vector_type(8)))short;
using s16x4=__attribute__((ext_vector_type(4)))short;
using f32x16=__attribute__((ext_vector_type(16)))float;
using u32x4=__attribute__((ext_vector_type(4)))unsigned;
constexpr int NHEAD=8,SEQ=16384,D=64,DMI=3328,DMO=1024;
typedef unsigned long long u64;
constexpr int NW=8,QBLK=32,QB=QBLK*NW,KVBLK=64,NQB=SEQ/QB;
__device__ __forceinline__ int crow(int r,int hi){return (r&3)+8*(r>>2)+4*hi;}
#define SBAR() __builtin_amdgcn_sched_barrier(0)
__device__ __forceinline__ void cmask(f32x16&p0,f32x16&p1,int jb,int qrel,int hi){
  const float NEG=-INFINITY; int kb=64*jb+4*hi;
  #pragma unroll
  for(int r=0;r<16;++r){int kv=kb+(r&3)+8*(r>>2); if(kv>qrel)p0[r]=NEG; if(kv+32>qrel)p1[r]=NEG;}
}

constexpr int NSLOT=3, SLOTB=8192;
constexpr int LDS_K=0, LDS_V=NSLOT*SLOTB, LDS_WS=2*NSLOT*SLOTB, LDS_OST=LDS_WS+NW*64*4, LDS_M=LDS_OST+NW*4096, LDS_BYTES=LDS_M+NW*2048;
constexpr float C2=0.125f*1.4426950408889634f;
__device__ __forceinline__ void glds16s(const void*sbase,unsigned voff,unsigned lds_dst){unsigned keep;
  asm volatile("s_mov_b32 %0, m0\n\ts_mov_b32 m0, %3\n\ts_nop 0\n\tglobal_load_lds_dwordx4 %1, %2\n\ts_mov_b32 m0, %0":"=&s"(keep):"v"(voff),"s"(sbase),"s"(lds_dst):"memory");}
__device__ __forceinline__ void glds16(const void*gsrc,unsigned lds_dst){unsigned keep;
  asm volatile("s_mov_b32 %0, m0\n\ts_mov_b32 m0, %2\n\ts_nop 0\n\tglobal_load_lds_dwordx4 %1, off\n\ts_mov_b32 m0, %0":"=&s"(keep):"v"(gsrc),"s"(lds_dst):"memory");}
__device__ __forceinline__ float max3f(float a,float b,float c){float r;asm("v_max3_f32 %0, %1, %2, %3":"=v"(r):"v"(a),"v"(b),"v"(c));return r;}
__device__ __forceinline__ float max2f(float a,float b){float r;asm("v_max_f32_e32 %0, %1, %2":"=v"(r):"v"(a),"v"(b));return r;}
__device__ __forceinline__ float fadd_s(float a,float b){float r;asm("v_add_f32_e32 %0, %1, %2":"=v"(r):"v"(a),"v"(b));return r;}
__device__ __forceinline__ float fsub_s(float a,float b){float r;asm("v_sub_f32_e32 %0, %1, %2":"=v"(r):"v"(a),"v"(b));return r;}
typedef float f32x2_t __attribute__((ext_vector_type(2))); typedef __bf16 bf16x2_t __attribute__((ext_vector_type(2)));
__device__ __forceinline__ unsigned cvtpk_s(float lo,float hi){f32x2_t v={lo,hi};bf16x2_t b=__builtin_convertvector(v,bf16x2_t);return __builtin_bit_cast(unsigned,b);}
#define WAIT_BAR(N) asm volatile("s_waitcnt vmcnt(" #N ") lgkmcnt(0)\n\ts_barrier":::"memory")

__device__ __forceinline__ void qkt(f32x16&p0,f32x16&p1,const char*Kslot,const bf16x8*qr,int r32,int hi){ const f32x16 negm=f32x16{};
  const char*kb=Kslot+hi*1024+r32*16;
  #pragma unroll
  for(int d0=0;d0<4;++d0){
    const bf16x8 b0=*reinterpret_cast<const bf16x8*>(kb+d0*2048);
    const bf16x8 b1=*reinterpret_cast<const bf16x8*>(kb+d0*2048+512);
    if(d0==0){p0=__builtin_amdgcn_mfma_f32_32x32x16_bf16(b0,qr[0],negm,0,0,0);p1=__builtin_amdgcn_mfma_f32_32x32x16_bf16(b1,qr[0],negm,0,0,0);}
    else{p0=__builtin_amdgcn_mfma_f32_32x32x16_bf16(b0,qr[d0],p0,0,0,0);p1=__builtin_amdgcn_mfma_f32_32x32x16_bf16(b1,qr[d0],p1,0,0,0);}}
}
typedef __attribute__((address_space(3))) const char* lds_cptr;
typedef short v4i16_t __attribute__((ext_vector_type(4)));
__device__ __forceinline__ void kload8(bf16x8*kf,lds_cptr kp){
  kf[0]=*(const __attribute__((address_space(3))) bf16x8*)(kp);      kf[1]=*(const __attribute__((address_space(3))) bf16x8*)(kp+512);
  kf[2]=*(const __attribute__((address_space(3))) bf16x8*)(kp+2048); kf[3]=*(const __attribute__((address_space(3))) bf16x8*)(kp+2560);
  kf[4]=*(const __attribute__((address_space(3))) bf16x8*)(kp+4096); kf[5]=*(const __attribute__((address_space(3))) bf16x8*)(kp+4608);
  kf[6]=*(const __attribute__((address_space(3))) bf16x8*)(kp+6144); kf[7]=*(const __attribute__((address_space(3))) bf16x8*)(kp+6656);
}
__device__ __forceinline__ void kload2(bf16x8*kf,lds_cptr kp,int j){ kf[2*j]=*(const __attribute__((address_space(3))) bf16x8*)(kp+j*2048); kf[2*j+1]=*(const __attribute__((address_space(3))) bf16x8*)(kp+j*2048+512); }
__device__ __forceinline__ s16x4 vtr(lds_cptr p){ return __builtin_bit_cast(s16x4,__builtin_amdgcn_ds_read_tr16_b64_v4i16((__attribute__((address_space(3))) v4i16_t*)p)); }
__device__ __forceinline__ float rowmax(const f32x16&p0,const f32x16&p1){
  float a=max3f(p0[0],p0[1],p1[0]),b=max3f(p0[2],p0[3],p1[1]);a=max3f(a,p1[2],p1[3]);
  #pragma unroll
  for(int r=4;r<16;r+=4){a=max3f(a,p0[r],p0[r+1]);b=max3f(b,p0[r+2],p0[r+3]);a=max3f(a,p1[r],p1[r+1]);b=max3f(b,p1[r+2],p1[r+3]);}
  const float m=max2f(a,b);
  auto rr=__builtin_amdgcn_permlane32_swap(__float_as_uint(m),__float_as_uint(m),false,false);
  return max2f(__uint_as_float(rr[0]),__uint_as_float(rr[1]));
}
__device__ __forceinline__ void pv(f32x16*o,int vb,bf16x8 pa0,bf16x8 pa1,bf16x8 pa2,bf16x8 pa3){
  #pragma unroll
  for(int d0=0;d0<2;++d0){s16x4 lo[4],hi[4];
    #pragma unroll
    for(int ks=0;ks<4;++ks){
      asm volatile("ds_read_b64_tr_b16 %0,%1 offset:%c2":"=&v"(lo[ks]):"v"(vb),"i"(d0*4096+ks*1024):"memory");
      asm volatile("ds_read_b64_tr_b16 %0,%1 offset:%c2":"=&v"(hi[ks]):"v"(vb),"i"(d0*4096+ks*1024+512):"memory");}
    asm volatile("s_waitcnt lgkmcnt(0)":::"memory");SBAR();
    #define PK(k) (bf16x8){lo[k][0],lo[k][1],lo[k][2],lo[k][3],hi[k][0],hi[k][1],hi[k][2],hi[k][3]}
    o[d0]=__builtin_amdgcn_mfma_f32_32x32x16_bf16(pa0,PK(0),o[d0],0,0,0);
    o[d0]=__builtin_amdgcn_mfma_f32_32x32x16_bf16(pa1,PK(1),o[d0],0,0,0);
    o[d0]=__builtin_amdgcn_mfma_f32_32x32x16_bf16(pa2,PK(2),o[d0],0,0,0);
    o[d0]=__builtin_amdgcn_mfma_f32_32x32x16_bf16(pa3,PK(3),o[d0],0,0,0);
    #undef PK
  }
}

#ifndef ATTN_STORE16
#define ATTN_STORE16(p,v) (*(u32x4*)(p)=(v))
#endif
template<int THRL,bool NM> __device__ __forceinline__ void attn_unit(int h,int qb,const bf16*Q,const bf16*__restrict__ K,const bf16*__restrict__ V,const u64*__restrict__ MASK,bf16*O,char*shm){
  int tid_=threadIdx.x; asm volatile("":"+v"(tid_)); const int tid=tid_,lane=tid&63,r32=lane&31,hi=lane>>5; const int wid=__builtin_amdgcn_readfirstlane(tid>>6);
  const long rowbase=0; const int q0=qb*QB;
  const bf16*Qw=Q+(rowbase+q0+wid*QBLK)*DMI+h*D;
  const bf16*Kh=K+rowbase*DMI+h*D,*Vh=V+rowbase*DMI+h*D;
  const unsigned lds0=(unsigned)(uintptr_t)shm;
  float*wsf=(float*)(shm+LDS_WS)+wid*64;
  const unsigned koff=(unsigned)(lane*DMI+wid*8)*2u;
  const unsigned voffv=(unsigned)((16*(wid&3)+(lane>>2))*DMI+(wid>>2)*32+(lane&3)*8)*2u;
  const unsigned kdst=lds0+LDS_K+wid*1024, vdst=lds0+LDS_V+wid*1024;
  const u64*mbase=MASK+q0+wid*QBLK; const int jm=lane>>4; const unsigned mdst=lds0+LDS_M+wid*2048; const unsigned moff0=(unsigned)(lane&15)*16u, moff1=moff0+((jm==1)?(unsigned)SEQ*8u:0u);
  #define DMA_M2(tA,tB,slot) glds16s(mbase+(size_t)(tA)*SEQ,((tB)!=(tA))?moff1:moff0,(unsigned)__builtin_amdgcn_readfirstlane(mdst+(slot)))
  const unsigned sh4=4u*(unsigned)hi; const float NEGINF=-INFINITY;
  #define MAPPLY(C0,C1,MW) do{ const unsigned lo_=(unsigned)(MW)>>sh4, hi_=(unsigned)((MW)>>32)>>sh4; \
    _Pragma("unroll") for(int r=0;r<16;++r){ const int sh_=31-((r&3)+8*(r>>2)); const int m0_=((int)(lo_<<sh_))>>31, m1_=((int)(hi_<<sh_))>>31;   \
      C0[r]=__int_as_float((__float_as_int(C0[r])&m0_)|(~m0_&(int)0xff800000)); C1[r]=__int_as_float((__float_as_int(C1[r])&m1_)|(~m1_&(int)0xff800000)); } }while(0)
  #define DMA_K(t,slot) glds16s(Kh+(long)(t)*KVBLK*DMI,koff,(unsigned)__builtin_amdgcn_readfirstlane(kdst+(slot)))
  #define DMA_V(t,slot) glds16s(Vh+(long)(t)*KVBLK*DMI,voffv,(unsigned)__builtin_amdgcn_readfirstlane(vdst+(slot)))
  const int vb0=(int)(lds0+LDS_V)+((lane>>4)&1)*32+(lane&3)*8+(4*hi+((lane&15)>>2))*64;
  const char*Kbase=shm+LDS_K; bf16x8 kf[8];
  const lds_cptr shm3=(lds_cptr)shm; const lds_cptr mp0=shm3+LDS_M+wid*2048+r32*8;
  #define MLD(off) (*(const __attribute__((address_space(3))) u64*)(mp0+(off)))
  const lds_cptr kp0=shm3+LDS_K+hi*1024+r32*16; const lds_cptr vp0=shm3+LDS_V+((lane>>4)&1)*32+(lane&3)*8+(4*hi+((lane&15)>>2))*64;
  const int NT=(q0+QB)/KVBLK;
  glds16s(mbase,moff0+((jm==0)?(unsigned)SEQ*8u:(jm==1)?(unsigned)SEQ*16u:0u),(unsigned)__builtin_amdgcn_readfirstlane(mdst));
  DMA_K(0,0);DMA_V(0,0);DMA_K(1,SLOTB);
  bf16x8 qr[4];
  #pragma unroll
  for(int d0=0;d0<4;++d0)qr[d0]=*reinterpret_cast<const bf16x8*>(&Qw[(long)r32*DMI+d0*16+hi*8]);
  float mhat=0.f,l_reg=0.f;f32x16 o[2];o[0]=f32x16{};o[1]=f32x16{};const f32x16 Z16=f32x16{};
  bool resc=false;
  #define START(P0,P1,MW) do{ const float rm=NM?0.f:rowmax(P0,P1); resc=false; \
    if(!NM&&__builtin_expect(__any(rm>(float)THRL),0)){ const float dl=__builtin_fmaxf(rm,0.f); mhat+=dl; \
      _Pragma("unroll") for(int r=0;r<16;++r){P0[r]-=dl;P1[r]-=dl;} } \
    MAPPLY(P0,P1,MW); \
    _Pragma("unroll") for(int r=0;r<16;++r)P0[r]=__builtin_amdgcn_exp2f(P0[r]); }while(0)
  #define RESC() do{ if(resc){ asm volatile("s_waitcnt lgkmcnt(0)":::"memory"); \
      _Pragma("unroll") for(int d_=0;d_<2;++d_) _Pragma("unroll") for(int r=0;r<16;++r)o[d_][r]*=wsf[crow(r,hi)]; } }while(0)
  f32x16 pA0,pA1,pB0,pB1;
  int sl_prev=0,sl_cur=0,sl_next=SLOTB;
  #define ROT() do{sl_prev=sl_cur;sl_cur=sl_next;sl_next=(sl_next==(NSLOT-1)*SLOTB)?0:sl_next+SLOTB;}while(0)
  DMA_K(2,2*SLOTB);
  WAIT_BAR(3);
  const u64 mw0=MLD(512);
  qkt(pA0,pA1,Kbase,qr,r32,hi);asm volatile("s_nop 15\n\ts_nop 7":"+v"(pA0),"+v"(pA1));
  START(pA0,pA1,mw0);
  _Pragma("unroll") for(int r=0;r<16;++r)pA1[r]=__builtin_amdgcn_exp2f(pA1[r]);
  WAIT_BAR(0);
  DMA_K(3,0);DMA_V(1,SLOTB);
  ROT();
  kload8(kf,kp0+sl_cur);
  WAIT_BAR(2);
  s16x4 vlo[8],vhi[8]; u32x4 pw0,pw1,pw2,pw3;
  #define PKW(P,B) cvtpk_s(P[B],P[B+1])
  #define PAF(k) __builtin_bit_cast(bf16x8,pw##k)
  #define VFR(i) (bf16x8){vlo[i][0],vlo[i][1],vlo[i][2],vlo[i][3],vhi[i][0],vhi[i][1],vhi[i][2],vhi[i][3]}
  #define PIN(x) asm volatile("":"+v"(x))
  #define MX3(a,b,c) __builtin_fmaxf(__builtin_fmaxf((a),(b)),(c))
  #define GAPA(MF,A0,A1,A2,A3,W0,W1,PW) do{ MF; sacc+=A0; sacc+=A1; sacc+=A2; sacc+=A3; PIN(sacc); W0; W1; PIN(PW); SBAR(); }while(0)
  #define EX(v) __builtin_amdgcn_exp2f(v)
  #define GAPB(MF,X,B) do{ MF; X[B]=EX(X[B]); X[B+1]=EX(X[B+1]); X[B+2]=EX(X[B+2]); X[B+3]=EX(X[B+3]); PIN(X); SBAR(); }while(0)
  #define VRD(i) do{ vlo[i]=vtr(vp_+(((i)>>2)*4096+((i)&3)*1024)); vhi[i]=vtr(vp_+(((i)>>2)*4096+((i)&3)*1024+512)); }while(0)
  #define KRD(G,j) do{ if(G){ kload2(kf,kp0+sl_next,j); SBAR(); } }while(0)
  #define STEP(C0,C1,P0,P1,t,GK,GV,GL,GM,MOFF) do{ SBAR(); \
    const lds_cptr vp_=vp0+sl_prev; \
    VRD(0); SBAR(); float sacc=(P0[0]+P0[1]); \
    GAPA(C0=__builtin_amdgcn_mfma_f32_32x32x16_bf16(kf[0],qr[0],Z16,0,0,0), P0[2],P0[3],P0[4],P0[5],     pw0[0]=PKW(P0,0), pw0[1]=PKW(P0,2), pw0); \
    VRD(4); SBAR(); GAPA(C1=__builtin_amdgcn_mfma_f32_32x32x16_bf16(kf[1],qr[0],Z16,0,0,0), P0[6],P0[7],P0[8],P0[9],     pw0[2]=PKW(P0,4), pw0[3]=PKW(P0,6), pw0); \
    VRD(1); SBAR(); GAPA(C0=__builtin_amdgcn_mfma_f32_32x32x16_bf16(kf[2],qr[1],C0,0,0,0),   P0[10],P0[11],P0[12],P0[13], pw1[0]=PKW(P0,8), pw1[1]=PKW(P0,10), pw1); \
    VRD(5); SBAR(); GAPA(C1=__builtin_amdgcn_mfma_f32_32x32x16_bf16(kf[3],qr[1],C1,0,0,0),   P0[14],P0[15],P1[0],P1[1],   pw1[2]=PKW(P0,12),pw1[3]=PKW(P0,14), pw1); \
    VRD(2); SBAR(); GAPA(C0=__builtin_amdgcn_mfma_f32_32x32x16_bf16(kf[4],qr[2],C0,0,0,0),   P1[2],P1[3],P1[4],P1[5],     pw2[0]=PKW(P1,0), pw2[1]=PKW(P1,2), pw2); \
    VRD(6); SBAR(); GAPA(C1=__builtin_amdgcn_mfma_f32_32x32x16_bf16(kf[5],qr[2],C1,0,0,0),   P1[6],P1[7],P1[8],P1[9],     pw2[2]=PKW(P1,4), pw2[3]=PKW(P1,6), pw2); \
    VRD(3); SBAR(); GAPA(C0=__builtin_amdgcn_mfma_f32_32x32x16_bf16(kf[6],qr[3],C0,0,0,0),   P1[10],P1[11],P1[12],P1[13], pw3[0]=PKW(P1,8), pw3[1]=PKW(P1,10), pw3); \
    VRD(7); SBAR(); GAPA(C1=__builtin_amdgcn_mfma_f32_32x32x16_bf16(kf[7],qr[3],C1,0,0,0),   P1[14],P1[15],0.f,0.f,       pw3[2]=PKW(P1,12),pw3[3]=PKW(P1,14), pw3); \
    l_reg+=sacc; \
    if(GK){DMA_K((t)+3,sl_cur);} if(GV){DMA_V((t)+1,sl_next);} if(GM){ const int tb_=((t)+3<NT)?(t)+3:NT-1; DMA_M2((t)+2,tb_,mslot^1024); } \
    const u64 mw_=MLD(MOFF); \
    resc=false; \
    if(!NM){ if(__builtin_expect(__any(mhat!=0.f),0)){ _Pragma("unroll") for(int r=0;r<16;++r){C0[r]-=mhat;C1[r]-=mhat;} } \
      float a=MX3(C0[0],C0[1],C1[0]),b=MX3(C0[2],C0[3],C1[1]); a=MX3(a,C1[2],C1[3]); \
      _Pragma("unroll") for(int r=4;r<16;r+=4){a=MX3(a,C0[r],C0[r+1]);b=MX3(b,C0[r+2],C0[r+3]);a=MX3(a,C1[r],C1[r+1]);b=MX3(b,C1[r+2],C1[r+3]);} \
      float rm=__builtin_fmaxf(a,b); { auto rr=__builtin_amdgcn_permlane32_swap(__float_as_uint(rm),__float_as_uint(rm),false,false); rm=__builtin_fmaxf(__uint_as_float(rr[0]),__uint_as_float(rr[1])); } \
      resc=false; \
      if(__builtin_expect(__any(rm>(float)THRL),0)){ const float dl=__builtin_fmaxf(rm,0.f); mhat+=dl; \
        _Pragma("unroll") for(int r=0;r<16;++r){C0[r]-=dl;C1[r]-=dl;} \
        const float f=__builtin_amdgcn_exp2f(-dl); l_reg*=f; if(hi==0)wsf[r32]=f; resc=true; } } \
    MAPPLY(C0,C1,mw_); \
    SBAR(); \
    GAPB(o[0]=__builtin_amdgcn_mfma_f32_32x32x16_bf16(PAF(0),VFR(0),o[0],0,0,0), C0,0); \
    GAPB(o[1]=__builtin_amdgcn_mfma_f32_32x32x16_bf16(PAF(0),VFR(4),o[1],0,0,0), C0,4); \
    KRD(GL,0); GAPB(o[0]=__builtin_amdgcn_mfma_f32_32x32x16_bf16(PAF(1),VFR(1),o[0],0,0,0), C0,8); \
    KRD(GL,1); GAPB(o[1]=__builtin_amdgcn_mfma_f32_32x32x16_bf16(PAF(1),VFR(5),o[1],0,0,0), C0,12); \
    KRD(GL,2); GAPB(o[0]=__builtin_amdgcn_mfma_f32_32x32x16_bf16(PAF(2),VFR(2),o[0],0,0,0), C1,0); \
    KRD(GL,3); GAPB(o[1]=__builtin_amdgcn_mfma_f32_32x32x16_bf16(PAF(2),VFR(6),o[1],0,0,0), C1,4); \
    GAPB(o[0]=__builtin_amdgcn_mfma_f32_32x32x16_bf16(PAF(3),VFR(3),o[0],0,0,0), C1,8); \
    GAPB(o[1]=__builtin_amdgcn_mfma_f32_32x32x16_bf16(PAF(3),VFR(7),o[1],0,0,0), C1,12); \
    }while(0)
  int t=1; int mslot=0;
  for(;t+5<NT;t+=2){
    STEP(pB0,pB1,pA0,pA1,t,true,true,true,true,mslot);          WAIT_BAR(3); RESC(); ROT();
    STEP(pA0,pA1,pB0,pB1,t+1,true,true,true,false,mslot+256);   WAIT_BAR(2); RESC(); ROT(); mslot^=1024;
  }
  #define ENDW(nf) do{ if((nf)==3){WAIT_BAR(3);} else if((nf)==2){WAIT_BAR(2);} else if((nf)==1){WAIT_BAR(1);} else {WAIT_BAR(0);} }while(0)
  for(;t+1<NT;t+=2){
    { const bool gk=(t+3<NT),gv=(t+1<NT),gm=(t+2<NT); STEP(pB0,pB1,pA0,pA1,t,gk,gv,gv,gm,mslot);   ENDW((int)gk+(int)gv+(int)gm); RESC(); ROT(); }
    { const bool gk=(t+4<NT),gv=(t+2<NT);             STEP(pA0,pA1,pB0,pB1,t+1,gk,gv,gv,false,mslot+256); ENDW((t+3<NT)?((int)gk+(int)gv):0); RESC(); ROT(); mslot^=1024; }
  }
  STEP(pB0,pB1,pA0,pA1,NT-1,false,false,false,false,mslot); RESC();
  { float sacc=pB0[0]+pB0[1]; _Pragma("unroll") for(int r=2;r<16;++r)sacc+=pB0[r]; _Pragma("unroll") for(int r=0;r<16;++r)sacc+=pB1[r]; l_reg+=sacc;
    pw0=(u32x4){PKW(pB0,0),PKW(pB0,2),PKW(pB0,4),PKW(pB0,6)};pw1=(u32x4){PKW(pB0,8),PKW(pB0,10),PKW(pB0,12),PKW(pB0,14)};pw2=(u32x4){PKW(pB1,0),PKW(pB1,2),PKW(pB1,4),PKW(pB1,6)};pw3=(u32x4){PKW(pB1,8),PKW(pB1,10),PKW(pB1,12),PKW(pB1,14)};
    SBAR(); pv(o,vb0+sl_cur,PAF(0),PAF(1),PAF(2),PAF(3)); }
  #undef PKW
  #undef PAF
  #undef VFR
  #undef PIN
  #undef MX3
  #undef GAPA
  #undef GAPB
  #undef EX
  #undef VRD
  #undef KRD
  #undef STEP
  #undef ENDW
  {auto rr=__builtin_amdgcn_permlane32_swap(__float_as_uint(l_reg),__float_as_uint(l_reg),false,false);l_reg=__uint_as_float(rr[0])+__uint_as_float(rr[1]);}
  if(hi==0)wsf[32+r32]=l_reg;asm volatile("s_waitcnt lgkmcnt(0)":::"memory");
  float rli[16];
  #pragma unroll
  for(int r=0;r<16;++r)rli[r]=__builtin_amdgcn_rcpf(wsf[32+crow(r,hi)]);
  bf16*Ow=O+(rowbase+q0+wid*QBLK)*DMO+h*D;
  { bf16*stg=(bf16*)(shm+LDS_OST)+wid*2048;
    #pragma unroll
    for(int r=0;r<16;++r){const int orow=crow(r,hi);
      #pragma unroll
      for(int d0=0;d0<2;++d0)stg[orow*64+d0*32+r32]=__float2bfloat16(o[d0][r]*rli[r]);}
    asm volatile("s_waitcnt lgkmcnt(0)":::"memory");
    #pragma unroll
    for(int i=0;i<4;++i){const int row=i*8+(lane>>3),ch=lane&7; const u32x4 v=*(const u32x4*)(stg+row*64+ch*8); ATTN_STORE16(Ow+(long)row*DMO+ch*8,v);} }
  asm volatile("s_waitcnt lgkmcnt(0)\n\ts_barrier":::"memory");
  #undef DMA_K
  #undef DMA_V
  #undef DMA_M2
  #undef MAPPLY
  #undef MLD
  #undef START
  #undef RESC
  #undef ROT
}
constexpr int ATTN_LDS_BYTES=LDS_BYTES;
template<int THRL,bool NM> __device__ __forceinline__ void attn_phase(char*lds,const bf16*Q,const bf16*K,const bf16*V,const u64*MASK,bf16*O){
  const int G=gridDim.x;
  for(int w=blockIdx.x;w<256;w+=G){ const int h=w&7,s=w>>3; attn_unit<THRL,NM>(h,s,Q,K,V,MASK,O,lds); attn_unit<THRL,NM>(h,63-s,Q,K,V,MASK,O,lds); }
}
#undef SBAR
#undef WAIT_BAR
}

__device__ __forceinline__ void phase_route_naive(const Params& p, unsigned char* lds) {
    const int tid = opaque_tid(), lane = tid & 63, wave = tid >> 6;
    const int gw = blockIdx.x * NWAVES + wave, NGW = gridDim.x * NWAVES;
    const float* H2 = (const float*)(p.ws + WS_H2); const float* WGRT = (const float*)(p.ws + WS_WGRT);
    float* RSTD = (float*)(p.ws + WS_RSTD); int* TOKOF = (int*)(p.ws + WS_TOKOF); float* GATEOF = (float*)(p.ws + WS_GATEOF); int* PAIR = (int*)(p.ws + WS_PAIR);
    unsigned* CNT = (unsigned*)(p.ws + WS_CTL) + CW_CNT;
    for (int t = gw; t < S; t += NGW) {
        const f32x4* hr = (const f32x4*)(H2 + (size_t)t * D) + lane; f32x4 v[4]; float ss = 0.f;
#pragma unroll
        for (int j = 0; j < 4; ++j) { v[j] = hr[64 * j]; ss += v[j].x * v[j].x + v[j].y * v[j].y + v[j].z * v[j].z + v[j].w * v[j].w; }
        const float rstd = rsqrtf(wave_sum(ss) * (1.f / D) + EPS);
        float mine = -INFINITY;
        for (int e = 0; e < NE; ++e) { const f32x4* wr = (const f32x4*)(WGRT + (size_t)e * D) + lane; float a = 0.f;
#pragma unroll
            for (int j = 0; j < 4; ++j) { const f32x4 w = wr[64 * j]; a = fmaf(v[j].x, w.x, a); a = fmaf(v[j].y, w.y, a); a = fmaf(v[j].z, w.z, a); a = fmaf(v[j].w, w.w, a); }
            a = wave_sum(a); if (lane == e) mine = a * rstd + p.b_router[e]; }
        float tv[4]; int te[4];
#pragma unroll
        for (int k = 0; k < 4; ++k) { float bv = mine; int bi = lane;
#pragma unroll
            for (int o = 32; o >= 1; o >>= 1) { const float ov = __shfl_xor(bv, o); const int oi = __shfl_xor(bi, o); if (ov > bv || (ov == bv && oi < bi)) { bv = ov; bi = oi; } }
            tv[k] = bv; te[k] = bi; if (lane == bi) mine = -INFINITY; }
        float g[4], gs = 0.f;
#pragma unroll
        for (int k = 0; k < 4; ++k) { g[k] = __expf(tv[k] - tv[0]); gs += g[k]; }
        if (lane == 0) RSTD[t] = rstd;
        if (lane < 4) { const int e = lane == 0 ? te[0] : lane == 1 ? te[1] : lane == 2 ? te[2] : te[3]; const float gg = (lane == 0 ? g[0] : lane == 1 ? g[1] : lane == 2 ? g[2] : g[3]) / gs;
            const unsigned slot = atomicAdd(&CNT[e], 1u); TOKOF[e * S + slot] = t; GATEOF[e * S + slot] = gg; PAIR[t * 4 + lane] = (e << 16) | (int)slot; }
    }
}

__device__ __forceinline__ void phase_route_fast(const Params& p, unsigned char* lds) {
    typedef float f32x16 __attribute__((ext_vector_type(16)));
    const int tid = opaque_tid(), lane = tid & 63, wave = tid >> 6, j = lane & 31, kk = lane >> 5, tsel = wave >> 2, kq = wave & 3;
    const float* H2 = (const float*)(p.ws + WS_H2); const float* WGR = (const float*)(p.ws + WS_WGRT) + 65536;
    float* RSTD = (float*)(p.ws + WS_RSTD); int* TOKOF = (int*)(p.ws + WS_TOKOF); float* GATEOF = (float*)(p.ws + WS_GATEOF); int* PAIR = (int*)(p.ws + WS_PAIR);
    unsigned* CNT = (unsigned*)(p.ws + WS_CTL) + CW_CNT;
    LAS float* sc = (LAS float*)((LAS unsigned char*)lds + wave * 8192);
    for (int tp = blockIdx.x; tp < S / 64; tp += gridDim.x) {
        const int t0 = (tp * 2 + tsel) * 32;
        const float* arow = H2 + (size_t)(t0 + j) * D + kq * 256 + 4 * kk; const float* bcol = WGR + (kq * 256 + 4 * kk) * NE + j;
        f32x16 acc = f32x16{}; float ss = 0.f;
#pragma unroll 8
        for (int m = 0; m < 32; ++m) { const f32x4 a = *(const f32x4*)(arow + 8 * m);
            const float b0 = bcol[(8 * m + 0) * NE], b1 = bcol[(8 * m + 1) * NE], b2 = bcol[(8 * m + 2) * NE], b3 = bcol[(8 * m + 3) * NE];
            acc = __builtin_amdgcn_mfma_f32_32x32x2f32(a.x, b0, acc, 0, 0, 0); acc = __builtin_amdgcn_mfma_f32_32x32x2f32(a.y, b1, acc, 0, 0, 0);
            acc = __builtin_amdgcn_mfma_f32_32x32x2f32(a.z, b2, acc, 0, 0, 0); acc = __builtin_amdgcn_mfma_f32_32x32x2f32(a.w, b3, acc, 0, 0, 0);
            ss += a.x * a.x + a.y * a.y + a.z * a.z + a.w * a.w; }
        ss += __shfl_xor(ss, 32);
        __syncthreads();
#pragma unroll
        for (int r = 0; r < 16; ++r) sc[((r & 3) + 8 * (r >> 2) + 4 * kk) * 33 + j] = acc[r];
        if (kk == 0) sc[32 * 33 + j] = ss;
        __syncthreads();
        if (kq == 0) {
            const LAS float* s0 = sc, *s1 = sc + 2048, *s2 = sc + 4096, *s3 = sc + 6144;
            const float sst = s0[32 * 33 + j] + s1[32 * 33 + j] + s2[32 * 33 + j] + s3[32 * 33 + j];
            const float rstd = rsqrtf(sst * (1.f / D) + EPS);
            float v[32];
#pragma unroll
            for (int e = 0; e < 32; ++e) v[e] = ((s0[j * 33 + e] + s1[j * 33 + e]) + (s2[j * 33 + e] + s3[j * 33 + e])) * rstd + p.b_router[e];
            float tv[4]; int te[4]; unsigned taken = 0u;
#pragma unroll
            for (int k = 0; k < 4; ++k) { float best = -INFINITY; int bi = 0;
#pragma unroll
                for (int e = 0; e < 32; ++e) { const bool ok = !((taken >> e) & 1u) && (v[e] > best); best = ok ? v[e] : best; bi = ok ? e : bi; }
                tv[k] = best; te[k] = bi; taken |= 1u << bi; }
            float g[4], gs = 0.f;
#pragma unroll
            for (int k = 0; k < 4; ++k) { g[k] = __expf(tv[k] - tv[0]); gs += g[k]; }
            const float gi = 1.f / gs;
            const bool act = lane < 32; int rk[4] = {0, 0, 0, 0}; unsigned mycnt = 0u;
#pragma unroll 4
            for (int e = 0; e < 32; ++e) { const bool pick = act && ((taken >> e) & 1u); const u64 m = __ballot(pick); const int below = __popcll(m & ((1ull << lane) - 1ull));
                if (lane == e) mycnt = (unsigned)__popcll(m);
#pragma unroll
                for (int k = 0; k < 4; ++k) rk[k] = (te[k] == e) ? below : rk[k]; }
            unsigned base = 0u; if (act && mycnt) base = atomicAdd(&CNT[lane], mycnt);
#pragma unroll
            for (int k = 0; k < 4; ++k) { const unsigned be = (unsigned)__shfl((int)base, te[k]); if (act) { const int slot = (int)be + rk[k]; const int t = t0 + lane;
                    TOKOF[te[k] * S + slot] = t; GATEOF[te[k] * S + slot] = g[k] * gi; PAIR[t * 4 + k] = (te[k] << 16) | slot; } }
            if (act) RSTD[t0 + lane] = rstd;
        }
    }
}

__device__ __forceinline__ int build_tiles(const Params& p, unsigned char* lds) {
    int* pst = (int*)(lds + LDS_MISC); int* tile_e = pst + 40;
    const unsigned* CNT = (const unsigned*)(p.ws + WS_CTL) + CW_CNT;
    __syncthreads();
    if (opaque_tid() == 0) { int acc = 0; for (int e = 0; e < NE; ++e) { pst[e] = acc; const int c = (int)__hip_atomic_load(&CNT[e], __ATOMIC_RELAXED, __HIP_MEMORY_SCOPE_AGENT); pst[328 + e] = c; const int nt = (c + 255) >> 8; for (int i = 0; i < nt; ++i) tile_e[acc + i] = e; acc += nt; } pst[NE] = acc; }
    __syncthreads();
    return pst[NE];
}

__device__ __forceinline__ void phase_gather(const Params& p, unsigned char* lds) {
    const int tid = opaque_tid(), lane = tid & 63, wave = tid >> 6;
    const int gw = blockIdx.x * NWAVES + wave, NGW = gridDim.x * NWAVES;
    build_tiles(p, lds); const int* pst = (const int*)(lds + LDS_MISC);
    const bf16* XN2 = (const bf16*)(p.ws + WS_XN); bf16* XS = (bf16*)(p.ws + WS_XS); const int* PAIR = (const int*)(p.ws + WS_PAIR);
    const float* RSTD = (const float*)(p.ws + WS_RSTD); const float* GATEOF = (const float*)(p.ws + WS_GATEOF);
    float* ROWRSTD = (float*)(p.ws + WS_ROWRSTD); float* ROWGATE = (float*)(p.ws + WS_ROWGATE);
#if FUSED_GATHER
    int* ROWTOK = (int*)(p.ws + WS_ROWTOK); const int* tile_e = pst + 40; const unsigned* CNT = (const unsigned*)(p.ws + WS_CTL) + CW_CNT; (void)XN2; (void)XS; (void)lane; (void)gw; (void)NGW;
    for (int row = blockIdx.x * NTHREADS + tid; row < pst[NE] * 256; row += gridDim.x * NTHREADS) { const int e = tile_e[row >> 8]; if (row - pst[e] * 256 >= (int)CNT[e]) ROWTOK[row] = 0; }
    for (int pr = blockIdx.x * NTHREADS + tid; pr < S * 4; pr += gridDim.x * NTHREADS) { const int t = pr >> 2; const int pe = PAIR[pr]; const int e = pe >> 16, slot = pe & 0xffff; const int row = pst[e] * 256 + slot;
        ROWTOK[row] = t; ROWRSTD[row] = RSTD[t]; ROWGATE[row] = GATEOF[e * S + slot]; }
#else
    for (int pr0 = gw * 4; pr0 < S * 4; pr0 += NGW * 4) {
        int row[4]; u32x4 va[4], vb[4];
#pragma unroll
        for (int i = 0; i < 4; ++i) { const int pr = pr0 + i, t = pr >> 2; const int pe = PAIR[pr]; const int e = pe >> 16, slot = pe & 0xffff; row[i] = pst[e] * 256 + slot;
            const u32x4* src = (const u32x4*)(XN2 + (size_t)t * D); va[i] = src[lane]; vb[i] = src[lane + 64];
            if (lane == 0) { ROWRSTD[row[i]] = RSTD[t]; ROWGATE[row[i]] = GATEOF[e * S + slot]; } }
#pragma unroll
        for (int i = 0; i < 4; ++i) { u32x4* dst = (u32x4*)(XS + (size_t)row[i] * D); dst[lane] = va[i]; dst[lane + 64] = vb[i]; }
    }
#endif
}

__device__ __forceinline__ void phase_final(const Params& p, unsigned char* lds) {
    const int tid = opaque_tid(), lane = tid & 63, wave = tid >> 6;
    const int gw = blockIdx.x * NWAVES + wave, NGW = gridDim.x * NWAVES;
    build_tiles(p, lds); const int* pst = (const int*)(lds + LDS_MISC);
    const float* H2 = (const float*)(p.ws + WS_H2); const bf16* YS = (const bf16*)(p.ws + WS_YS); const int* PAIR = (const int*)(p.ws + WS_PAIR);
    for (int t = gw; t < S; t += NGW) {
        const f32x4* hr = (const f32x4*)(H2 + (size_t)t * D) + lane; f32x4 v[4];
#pragma unroll
        for (int j = 0; j < 4; ++j) v[j] = hr[64 * j];
#pragma unroll
        for (int k = 0; k < 4; ++k) { const int pe = PAIR[t * 4 + k]; const int row = pst[pe >> 16] * 256 + (pe & 0xffff); const uint2* yr = (const uint2*)(YS + (size_t)row * D) + lane;
#pragma unroll
            for (int j = 0; j < 4; ++j) { const uint2 y = yr[64 * j]; v[j].x += blo(y.x); v[j].y += bhi(y.x); v[j].z += blo(y.y); v[j].w += bhi(y.y); } }
        float ss = 0.f;
#pragma unroll
        for (int j = 0; j < 4; ++j) ss += v[j].x * v[j].x + v[j].y * v[j].y + v[j].z * v[j].z + v[j].w * v[j].w;
        const float rstd = rsqrtf(wave_sum(ss) * (1.f / D) + EPS);
        f32x4* o = (f32x4*)(p.out + (size_t)t * D) + lane;
#pragma unroll
        for (int j = 0; j < 4; ++j) { const f32x4 g = ((const f32x4*)p.norm_final_g)[lane + 64 * j]; o[64 * j] = (f32x4){v[j].x * rstd * g.x, v[j].y * rstd * g.y, v[j].z * rstd * g.z, v[j].w * rstd * g.w}; }
    }
}

#define GAS __attribute__((address_space(1)))
typedef GAS unsigned gu32;
#define XB_TMO      128
#define XB_XCNT(j)  (256  + 64 * (j))
#define XB_XSUB(j)  (1280 + 64 * (j))
#define XB_XGEN(j)  (2304 + 64 * (j))
#define XB_TOP      3328
#define XB_TOPGEN   3392
#define XCD_BAR_WORDS 3456
#define XB_SPIN_CAP (1u << 18)

__device__ __forceinline__ unsigned xb_ld(unsigned* p)              { return __hip_atomic_load(p, __ATOMIC_RELAXED, __HIP_MEMORY_SCOPE_AGENT); }
__device__ __forceinline__ unsigned xb_add(unsigned* p, unsigned v) { return __hip_atomic_fetch_add(p, v, __ATOMIC_RELAXED, __HIP_MEMORY_SCOPE_AGENT); }
__device__ __forceinline__ unsigned xb_xcc_id() { return (unsigned)__builtin_amdgcn_s_getreg((3 << 11) | 20) & 0xFu; }
#define XB_SPIN(cond, bar) do { unsigned _sp = 0; while (cond) { __builtin_amdgcn_s_sleep(1); \
    if ((++_sp & 255u) == 0u) { if (xb_ld(&(bar)[XB_TMO])) break; if (_sp > XB_SPIN_CAP) { atomicAdd(&(bar)[XB_TMO], 1u); break; } } } } while (0)

struct XcdBarrier {
    unsigned* bar; unsigned x;
    volatile LAS unsigned* st;
};

__device__ __forceinline__ XcdBarrier xcd_barrier_post(unsigned* bar, volatile LAS unsigned* st) {
    XcdBarrier b; b.bar = bar; b.x = xb_xcc_id(); b.st = st;
    if (threadIdx.x == 0) (void)xb_add(&bar[XB_XCNT(b.x)], 1u);
    return b;
}
__device__ __forceinline__ void xcd_barrier_complete(unsigned* bar, unsigned x, unsigned& nloc, unsigned& nx) {
    const unsigned G = gridDim.x * gridDim.y * gridDim.z;
    unsigned sum, cnt, mine, sp = 0u;
    for (;;) {
        sum = 0u; cnt = 0u; mine = 0u;
#pragma unroll
        for (unsigned j = 0; j < 16; ++j) { const unsigned c = xb_ld(&bar[XB_XCNT(j)]); sum += c; cnt += (c > 0u) ? 1u : 0u; mine = (j == x) ? c : mine; }
        if (sum == G) break;
        __builtin_amdgcn_s_sleep(1);
        if ((++sp & 255u) == 0u) { if (xb_ld(&bar[XB_TMO])) break; if (sp > XB_SPIN_CAP) { atomicAdd(&bar[XB_TMO], 1u); break; } }
    }
    nloc = mine > 0u ? mine : 1u; nx = cnt > 0u ? cnt : 1u;
}

__device__ __forceinline__ void xcd_barrier(const XcdBarrier& b) {
    asm volatile("s_waitcnt vmcnt(0)" ::: "memory");
    __syncthreads();
    if (threadIdx.x == 0) {
        unsigned* bar = b.bar;
        __builtin_amdgcn_s_waitcnt(0);
        unsigned nloc = b.st[0], nx = b.st[1];
        if (nloc == 0u) { xcd_barrier_complete(bar, b.x, nloc, nx); b.st[0] = nloc; b.st[1] = nx; }
        const unsigned old = xb_add(&bar[XB_XSUB(b.x)], 1u);
        const unsigned gen = old / nloc;
        if (old + 1u == (gen + 1u) * nloc) {
            __builtin_amdgcn_fence(__ATOMIC_RELEASE, "agent");
            asm volatile("s_waitcnt vmcnt(0)" ::: "memory");
            const unsigned og = xb_add(&bar[XB_TOP], 1u);
            const unsigned tg = og / nx;
            if (og + 1u == (tg + 1u) * nx) xb_add(&bar[XB_TOPGEN], 1u);
            else XB_SPIN(xb_ld(&bar[XB_TOPGEN]) == tg, bar);
            __builtin_amdgcn_fence(__ATOMIC_ACQUIRE, "agent");
            xb_add(&bar[XB_XGEN(b.x)], 1u);
            asm volatile("s_waitcnt vmcnt(0)" ::: "memory");
        } else {
            XB_SPIN(xb_ld(&bar[XB_XGEN(b.x)]) == gen, bar);
            __builtin_amdgcn_fence(__ATOMIC_ACQUIRE, "agent");
            asm volatile("s_waitcnt vmcnt(0)" ::: "memory");
        }
    }
    __syncthreads();
}

#ifndef FAST_GEMM
#define FAST_GEMM 1
#endif
#ifndef FAST_ATT
#define FAST_ATT 1
#endif
#ifndef FAST_IDX
#define FAST_IDX 1
#endif
#ifndef FAST_EW
#define FAST_EW 1
#endif
#ifndef FAST_ROUTE
#define FAST_ROUTE 1
#endif
#ifndef MERGED_MOE
#define MERGED_MOE 0
#endif
template <class F, class Sched>
__device__ __forceinline__ void run_gemm_gather(unsigned char* lds, const bf16* A, const bf16* Bt, int K, const Sched& S, const F& f) {
    pg8::Gemm g{A, Bt, 0, 0, K}; EpiAdapt<F> E{f};
    pg8::gemm_phase<EpiAdapt<F>, Sched, true, true, true>((LAS unsigned char*)lds, g, S, E);
    __syncthreads();
}
template <class F, class Sched>
__device__ __forceinline__ void run_gemm(unsigned char* lds, const bf16* A, const bf16* Bt, int K, const Sched& S, const F& f) {
#if FAST_GEMM
    pg8::Gemm g{A, Bt, 0, 0, K}; EpiAdapt<F> E{f};
    pg8::gemm_phase<EpiAdapt<F>, Sched, true, true>((LAS unsigned char*)lds, g, S, E);
#else
    Unit u;
    for (int i = 0; S.next(i, u); ++i) ngemm_unit(lds, A + (size_t)u.pm * 256 * K, K, Bt + (size_t)S.bidx(u) * 256 * K, K, K, f, u);
#endif
    __syncthreads();
}

#ifndef PROBE_MULT
#define PROBE_MULT 8
#endif
#if PROBE_PHASE >= 0
#define STAMP(i) do { if (blockIdx.x == 0 && opaque_tid() == 0) ((volatile LAS unsigned long long*)((LAS unsigned char*)lds + LDS_PROBE))[i] = __builtin_amdgcn_s_memrealtime(); } while (0)
#else
#define STAMP(i) do { } while (0)
#endif
__global__ void __launch_bounds__(NTHREADS, 2) fwd_kernel(Params p) {
    extern __shared__ __attribute__((aligned(16))) unsigned char lds[];
    cg::grid_group grid = cg::this_grid();
    const int G = gridDim.x, bx = blockIdx.x;
    const LAS int* tile_e = (const LAS int*)((LAS unsigned char*)lds + LDS_MISC) + 40;
    volatile LAS unsigned* bst = (volatile LAS unsigned*)((LAS unsigned char*)lds + LDS_MISC + 4096);
    if (opaque_tid() < 2) bst[opaque_tid()] = 0u;
    __syncthreads();
    const XcdBarrier xbar = xcd_barrier_post((unsigned*)(p.ws + WS_CTL) + CW_BAR, bst);
#if PROBE_PHASE >= 200
    if (opaque_tid() < 16) ((volatile LAS unsigned long long*)((LAS unsigned char*)lds + LDS_PROBE + 256))[opaque_tid()] = 0ull;
#endif
    STAMP(0);
    phase_prologue(p, lds);
    if (gridDim.y == 0xffffu) grid.sync();
    xcd_barrier(xbar);
    STAMP(1);
    { pg8::StaticOrder so; so.init(S, NP, G, bx); EpiProj E{(bf16*)(p.ws + WS_PROJ)};
        run_gemm(lds, (const bf16*)(p.ws + WS_XN), (const bf16*)(p.ws + WS_WINT), D, so, E); }
    xcd_barrier(xbar);
    STAMP(2);
#if FAST_EW
    phase_ew_fast(p, lds);
#else
    phase_ew_naive(p, lds);
#endif
    xcd_barrier(xbar);
    STAMP(3);
#if FAST_IDX
    idxf::idx_phase(p, lds);
    __syncthreads();
#else
    phase_idx_naive(p, lds);
#endif
    xcd_barrier(xbar);
    STAMP(4);
#if FAST_ATT
    {
        const int tid = opaque_tid(); const int hq = bx & 7, sq = (bx >> 3) & 31; const int row = ((tid < 256) ? sq : 63 - sq) * 256 + (tid & 255);
        const bf16* qp = (const bf16*)(p.ws + WS_PROJ) + (size_t)row * NP + C_Q + hq * 64; float q1 = 0.f;
#pragma unroll
        for (int j = 0; j < 8; ++j) { const u32x4 v = *(const u32x4*)(qp + j * 8); q1 += fabsf(blo(v.x)) + fabsf(bhi(v.x)) + fabsf(blo(v.y)) + fabsf(bhi(v.y)) + fabsf(blo(v.z)) + fabsf(bhi(v.z)) + fabsf(blo(v.w)) + fabsf(bhi(v.w)); }
        q1 = wave_max(q1); LAS float* qb = (LAS float*)((LAS unsigned char*)lds + LDS_MISC + 4224); if ((tid & 63) == 0) qb[tid >> 6] = q1;
        __syncthreads();
        float qm = qb[0];
#pragma unroll
        for (int w = 1; w < 8; ++w) qm = fmaxf(qm, qb[w]);
        const float kmaxel = *(const float*)((const unsigned*)(p.ws + WS_CTL) + CW_KMAX); const bool nomax = (G == 256) && (qm * kmaxel <= 96.f);
        const attn_body::bf16* PJ = (const attn_body::bf16*)(p.ws + WS_PROJ); const u64* MK = (const u64*)(p.ws + WS_MASK); attn_body::bf16* MO = (attn_body::bf16*)(p.ws + WS_MIX) + 512;
        if (nomax) attn_body::attn_phase<96, true>((char*)lds, PJ + C_Q, PJ + C_K, PJ + C_V, MK, MO);
        else attn_body::attn_phase<96, false>((char*)lds, PJ + C_Q, PJ + C_K, PJ + C_V, MK, MO); }
    __syncthreads();
#else
    phase_att_naive(p, lds);
#endif
    xcd_barrier(xbar);
    STAMP(5);
    { pg8::StaticOrder so; so.init(S, D, G, bx); EpiOut E{p.x, p.norm_ffn_g, (float*)(p.ws + WS_H2), (bf16*)(p.ws + WS_XN)};
        run_gemm(lds, (const bf16*)(p.ws + WS_MIX), (const bf16*)(p.ws + WS_WOUTT), D, so, E); }
    xcd_barrier(xbar);
    STAMP(6);
#if FAST_ROUTE
    phase_route_fast(p, lds);
#else
    phase_route_naive(p, lds);
#endif
    xcd_barrier(xbar);
    STAMP(7);
#if MERGED_MOE
    { const int ntile = build_tiles(p, lds); const LAS int* pst = (const LAS int*)((LAS unsigned char*)lds + LDS_MISC);
        MoeMerged mm; mm.so1.init(ntile * 256, 2048, G, bx); mm.so2.init(ntile * 256, D, G, bx); mm.tile_e = tile_e; mm.ltok = (const LAS int*)((LAS unsigned char*)lds + LDS_LTOK);
        mm.dep = (unsigned*)(p.ws + WS_CTL) + CW_DEP; mm.G = G; mm.c = bx; mm.n1 = 0;
        LAS int* lt = (LAS int*)((LAS unsigned char*)lds + LDS_LTOK); LAS float* lr0 = (LAS float*)((LAS unsigned char*)lds + LDS_LRS); LAS float* lr1 = (LAS float*)(lt + 10 * 256);
        { const int* TOKOF = (const int*)(p.ws + WS_TOKOF); const float* RSTD = (const float*)(p.ws + WS_RSTD); const float* GATEOF = (const float*)(p.ws + WS_GATEOF); Unit u; const int tid = opaque_tid();
            for (int i = 0; i < 15 && mm.next(i, u); ++i) { if (u.pn < 8) mm.n1 = i + 1;
                if (tid < 256) { const int e = tile_e[u.pm], slot = (u.pm - pst[e]) * 256 + tid; const bool valid = slot < pst[328 + e]; LAS float* lr = (i < 9) ? lr0 + i * 256 : lr1 + (i - 9) * 256;
                    if (u.pn < 8) { const int tok = valid ? TOKOF[e * S + slot] : 0; lt[i * 256 + tid] = tok; lr[tid] = valid ? RSTD[tok] : 0.f; }
                    else { lr[tid] = valid ? GATEOF[e * S + slot] : 0.f; if (tid == 0) lt[9 * 256 + i] = HDN_PSEUDO_TOK + u.pm * 256; } } }
            __syncthreads(); }
        EpiMoe E{p.b_gu, p.b_down, lr0, lr1, (bf16*)(p.ws + WS_HDN), (bf16*)(p.ws + WS_YS), tile_e};
        run_gemm_gather(lds, (const bf16*)(p.ws + WS_XN), (const bf16*)(p.ws + WS_WGUT), D, mm, E);
    }
    xcd_barrier(xbar);
    STAMP(8);
    STAMP(9);
#else
    { const int ntile = build_tiles(p, lds); const LAS int* pst = (const LAS int*)((LAS unsigned char*)lds + LDS_MISC);
        MoeOrder mo; mo.so.init(ntile * 256, 2048, G, bx); mo.tile_e = tile_e; mo.ncol = 8; mo.ltok = (const LAS int*)((LAS unsigned char*)lds + LDS_LTOK);
        EpiGU E{p.b_gu, (const LAS float*)((LAS unsigned char*)lds + LDS_LRS), (bf16*)(p.ws + WS_HDN), tile_e};
        { const int* TOKOF = (const int*)(p.ws + WS_TOKOF); const float* RSTD = (const float*)(p.ws + WS_RSTD); LAS int* lt = (LAS int*)((LAS unsigned char*)lds + LDS_LTOK); LAS float* lr = (LAS float*)((LAS unsigned char*)lds + LDS_LRS);
            Unit u; const int tid = opaque_tid();
            for (int i = 0; i < 9 && mo.next(i, u); ++i) if (tid < 256) { const int e = tile_e[u.pm], slot = (u.pm - pst[e]) * 256 + tid; const bool valid = slot < pst[328 + e];
                    const int tok = valid ? TOKOF[e * S + slot] : 0; lt[i * 256 + tid] = tok; lr[i * 256 + tid] = valid ? RSTD[tok] : 0.f; }
            __syncthreads(); }
        run_gemm_gather(lds, (const bf16*)(p.ws + WS_XN), (const bf16*)(p.ws + WS_WGUT), D, mo, E);
    }
    xcd_barrier(xbar);
    STAMP(8);
    { const int ntile = build_tiles(p, lds);
        MoeOrder mo; mo.so.init(ntile * 256, D, G, bx); mo.tile_e = tile_e; mo.ncol = 4; mo.ltok = nullptr; const LAS int* pst = (const LAS int*)((LAS unsigned char*)lds + LDS_MISC);
        EpiDown E{p.b_down, (const LAS float*)((LAS unsigned char*)lds + LDS_LRS), (bf16*)(p.ws + WS_YS), tile_e};
        { const float* GATEOF = (const float*)(p.ws + WS_GATEOF); LAS float* lg = (LAS float*)((LAS unsigned char*)lds + LDS_LRS); Unit u; const int tid = opaque_tid();
            for (int i = 0; i < 9 && mo.next(i, u); ++i) if (tid < 256) { const int e = tile_e[u.pm], slot = (u.pm - pst[e]) * 256 + tid; lg[i * 256 + tid] = (slot < pst[328 + e]) ? GATEOF[e * S + slot] : 0.f; }
            __syncthreads(); }
        run_gemm(lds, (const bf16*)(p.ws + WS_HDN), (const bf16*)(p.ws + WS_WDT), DE, mo, E); }
    xcd_barrier(xbar);
    STAMP(9);
#endif
    phase_final(p, lds);
#if PROBE_PHASE >= 0
    STAMP(10);
    if (blockIdx.x == 0 && opaque_tid() == 0) { volatile LAS unsigned long long* st = (volatile LAS unsigned long long*)((LAS unsigned char*)lds + LDS_PROBE);
#if PROBE_PHASE >= 200
        const unsigned long long dt = ((volatile LAS unsigned long long*)((LAS unsigned char*)lds + LDS_PROBE + 256))[PROBE_PHASE - 200], t0 = __builtin_amdgcn_s_memrealtime();
#elif PROBE_PHASE == 100 || PROBE_PHASE == 101
        const unsigned long long dt = 125ull * (unsigned long long)__hip_atomic_load((unsigned*)(p.ws + WS_CTL) + 2048, __ATOMIC_RELAXED, __HIP_MEMORY_SCOPE_AGENT), t0 = __builtin_amdgcn_s_memrealtime();
#else
        const unsigned long long dt = st[PROBE_PHASE + 1] - st[PROBE_PHASE], t0 = __builtin_amdgcn_s_memrealtime();
#endif
        while (__builtin_amdgcn_s_memrealtime() - t0 < (unsigned long long)PROBE_MULT * dt) __builtin_amdgcn_s_sleep(8); }
#endif
}

extern "C" void kernel_launch(void* const* d_in, const int* in_sizes, int n_in, void* d_out, int out_size, void* d_ws, size_t ws_size, hipStream_t stream) {
    static int grid = 0;
    if (grid == 0) {
        if (n_in != 19 || out_size != S * D || ws_size < WS_END) { fprintf(stderr, "kernel_launch: unexpected shapes (n_in %d out %d ws %zu)\n", n_in, out_size, ws_size); grid = -1; return; }
        int dev = 0, cus = 0, per_cu = 0;
        (void)hipGetDevice(&dev); (void)hipDeviceGetAttribute(&cus, hipDeviceAttributeMultiprocessorCount, dev);
        if (hipFuncSetAttribute((const void*)fwd_kernel, hipFuncAttributeMaxDynamicSharedMemorySize, LDS_BYTES) != hipSuccess) { fprintf(stderr, "kernel_launch: hipFuncSetAttribute failed\n"); grid = -1; return; }
        if (hipOccupancyMaxActiveBlocksPerMultiprocessor(&per_cu, (const void*)fwd_kernel, NTHREADS, LDS_BYTES) != hipSuccess || per_cu < 1) { fprintf(stderr, "kernel_launch: occupancy query says %d\n", per_cu); per_cu = 1; }
        (void)hipGetLastError();
        grid = cus * 1;
    }
    if (grid < 0) return;
    (void)hipMemsetAsync((char*)d_ws + WS_CTL, 0, CTL_BYTES, stream);
    Params p{};
    p.x = (const float*)d_in[0]; p.pos = (const int*)d_in[1]; p.norm_mix_g = (const float*)d_in[2]; p.w_in = (const float*)d_in[3]; p.idx_g = (const float*)d_in[4]; p.idx_b = (const float*)d_in[5];
    p.conv_w = (const float*)d_in[6]; p.conv_b = (const float*)d_in[7]; p.conv_ng = (const float*)d_in[8]; p.conv_nb = (const float*)d_in[9]; p.w_out = (const float*)d_in[10]; p.norm_ffn_g = (const float*)d_in[11];
    p.w_router = (const float*)d_in[12]; p.b_router = (const float*)d_in[13]; p.w_gu = (const float*)d_in[14]; p.b_gu = (const float*)d_in[15]; p.w_down = (const float*)d_in[16]; p.b_down = (const float*)d_in[17];
    p.norm_final_g = (const float*)d_in[18]; p.out = (float*)d_out; p.ws = (unsigned char*)d_ws;
    void* args[] = {&p};
    hipError_t e = hipLaunchCooperativeKernel((const void*)fwd_kernel, dim3(grid), dim3(NTHREADS), args, LDS_BYTES, stream);
    if (e != hipSuccess) fprintf(stderr, "cooperative launch failed: %s (grid %d)\n", hipGetErrorString(e), grid);
}
```

```cpp
#include <hip/hip_runtime.h>
#include <hip/hip_cooperative_groups.h>
#include <cstdio>
#include <cstdint>
#include <hip/hip_bf16.h>
#include <cmath>
namespace cg = cooperative_groups;
#ifndef FUSED_GATHER
#define FUSED_GATHER 1
#endif
#ifndef PROBE_PHASE
#define PROBE_PHASE (-1)
#endif

constexpr int S = 16384, D = 1024, NIN = 3144, NP = 3328;
constexpr int CC = 512, CW = 31, NH = 8, HD = 64, NE = 32, DE = 1024;
constexpr int C_VAL = 0, C_GATE = 512, C_Q = 1024, C_K = 1536, C_V = 2048, C_QI = 2560, C_KI = 3072, C_WI = 3136;
constexpr int KSEL = 256;
constexpr float EPS = 1e-5f;
constexpr float C2 = 0.125f * 1.4426950408889634f;
constexpr int NTHREADS = 512, NWAVES = 8;
constexpr int MAXROWS = 65536 + NE * 256;
constexpr int MAXTILES = MAXROWS / 256;

constexpr size_t MiB = 1u << 20;
constexpr size_t WS_CTL = 0, CTL_BYTES = 1 * MiB;
constexpr size_t WS_WINT = 2 * MiB;
constexpr size_t WS_WOUTT = 9 * MiB;
constexpr size_t WS_WGRT = 11 * MiB;
constexpr size_t WS_COS = 12 * MiB;
constexpr size_t WS_SIN = 14 * MiB;
constexpr size_t WS_WGUT = 16 * MiB;
constexpr size_t WS_WDT = 144 * MiB;
constexpr size_t WS_XN = 208 * MiB;
constexpr size_t WS_PROJ = 240 * MiB;
constexpr size_t WS_MIX = 344 * MiB;
constexpr size_t WS_KI = 376 * MiB;
constexpr size_t WS_QL = 378 * MiB;
constexpr size_t WS_WI = 380 * MiB;
constexpr size_t WS_RSTD = 381 * MiB;
constexpr size_t WS_TOKOF = 382 * MiB;
constexpr size_t WS_GATEOF = 384 * MiB;
constexpr size_t WS_PAIR = 386 * MiB;
constexpr size_t WS_ROWRSTD = 387 * MiB;
constexpr size_t WS_ROWGATE = 388 * MiB;
constexpr size_t WS_ROWTOK = 389 * MiB;
constexpr size_t WS_MASK = 392 * MiB;
constexpr size_t WS_H2 = 424 * MiB;
constexpr size_t WS_XS = 488 * MiB;
constexpr size_t WS_HDN = 632 * MiB;
constexpr size_t WS_YS = 776 * MiB;
constexpr size_t WS_END = 920 * MiB;
constexpr int CW_CNT = 1024;
constexpr int CW_BAR = 4096;
constexpr int CW_KMAX = 2052;
constexpr int CW_DEP = 8192;

constexpr int LDS_BYTES = 163840;
constexpr int LDS_LTOK = 147456;
constexpr int LDS_MISC = 131072;
constexpr int LDS_LRS = LDS_MISC + 4608;
constexpr int LDS_PROBE = LDS_MISC + 14336;

#define LAS __attribute__((address_space(3)))
typedef unsigned short bf16;
typedef unsigned long long u64;
typedef float f32x4 __attribute__((ext_vector_type(4)));
typedef unsigned u32x4 __attribute__((ext_vector_type(4)));

__device__ __forceinline__ float bf2f(unsigned v) { return __uint_as_float(v << 16); }
__device__ __forceinline__ unsigned f2bf(float f) { unsigned u = __float_as_uint(f); return (u + 0x7fffu + ((u >> 16) & 1u)) >> 16; }
typedef float f32x2_pk __attribute__((ext_vector_type(2))); typedef __bf16 bf16x2_pk __attribute__((ext_vector_type(2)));
__device__ __forceinline__ unsigned pk2(float lo, float hi) { const f32x2_pk v = {lo, hi}; return __builtin_bit_cast(unsigned, __builtin_convertvector(v, bf16x2_pk)); }
__device__ __forceinline__ float blo(unsigned w) { return __uint_as_float(w << 16); }
__device__ __forceinline__ float bhi(unsigned w) { return __uint_as_float(w & 0xffff0000u); }
__device__ __forceinline__ float wave_sum(float v) {
#pragma unroll
    for (int o = 1; o < 64; o <<= 1) v += __shfl_xor(v, o);
    return v;
}
__device__ __forceinline__ float wave_max(float v) {
#pragma unroll
    for (int o = 1; o < 64; o <<= 1) v = fmaxf(v, __shfl_xor(v, o));
    return v;
}
__device__ __forceinline__ int opaque_tid() { int t = threadIdx.x; asm volatile("" : "+v"(t)); return t; }
#if PROBE_PHASE >= 200
#define ISEC(k) do { __syncthreads(); if (blockIdx.x == 0 && tid == 0) { volatile LAS unsigned long long* st_ = (volatile LAS unsigned long long*)((LAS unsigned char*)lds + LDS_PROBE + 256); const unsigned long long now_ = __builtin_amdgcn_s_memrealtime(); st_[k] += now_ - st_[15]; st_[15] = now_; } } while (0)
#else
#define ISEC(k) do { } while (0)
#endif
__device__ __forceinline__ float sigmoidf_(float x) { return __builtin_amdgcn_rcpf(1.f + __expf(-x)); }

struct Params {
    const float* x; const int* pos; const float* norm_mix_g; const float* w_in; const float* idx_g; const float* idx_b;
    const float* conv_w; const float* conv_b; const float* conv_ng; const float* conv_nb; const float* w_out; const float* norm_ffn_g;
    const float* w_router; const float* b_router; const float* w_gu; const float* b_gu; const float* w_down; const float* b_down;
    const float* norm_final_g; float* out; unsigned char* ws;
};

__device__ __forceinline__ void transpose_item(const float* W, int K, int N, bf16* WT, int dst_row0, int k0, int n0, float* scr, int lane) {
    float v[32]; const int n = n0 + (lane & 31); const float* src = W + (size_t)(k0 + (lane >> 5)) * N + n;
#pragma unroll
    for (int i = 0; i < 32; ++i) v[i] = (n < N) ? src[(size_t)(2 * i) * N] : 0.f;
#pragma unroll
    for (int i = 0; i < 32; ++i) scr[(2 * i + (lane >> 5)) * 33 + (lane & 31)] = v[i];
    asm volatile("s_waitcnt lgkmcnt(0)" ::: "memory");
    const int c = lane & 7;
#pragma unroll
    for (int j = 0; j < 4; ++j) { const int nn = (lane >> 3) + 8 * j; const float* s = scr + (8 * c) * 33 + nn;
        u32x4 o; o.x = pk2(s[0 * 33], s[1 * 33]); o.y = pk2(s[2 * 33], s[3 * 33]); o.z = pk2(s[4 * 33], s[5 * 33]); o.w = pk2(s[6 * 33], s[7 * 33]);
        *(u32x4*)(WT + (size_t)(dst_row0 + nn) * K + k0 + 8 * c) = o; }
    asm volatile("s_waitcnt lgkmcnt(0)" ::: "memory");
}

__device__ __forceinline__ void phase_prologue(const Params& p, unsigned char* lds) {
    const int tid = opaque_tid(), lane = tid & 63, wave = tid >> 6;
    const int gw = blockIdx.x * NWAVES + wave, NGW = gridDim.x * NWAVES;
    float* scr = (float*)(lds + wave * 16384);
    bf16* WinT = (bf16*)(p.ws + WS_WINT); bf16* WoutT = (bf16*)(p.ws + WS_WOUTT); bf16* WguT = (bf16*)(p.ws + WS_WGUT); bf16* WdT = (bf16*)(p.ws + WS_WDT);
    constexpr int I_IN = 16 * (NP / 32), I_OUT = 16 * 32, I_GU = 16 * 64, I_DN = 16 * 32;
    constexpr int NITEMS = I_IN + I_OUT + NE * I_GU + NE * I_DN;
    for (int it = gw; it < NITEMS; it += NGW) {
        int r = it;
        if (r < I_IN) { const int nb = r % (NP / 32), kb = r / (NP / 32); transpose_item(p.w_in, D, NIN, WinT, nb * 32, kb * 64, nb * 32, scr, lane); continue; }
        r -= I_IN;
        if (r < I_OUT) { const int nb = r % 32, kb = r / 32; transpose_item(p.w_out, D, D, WoutT, nb * 32, kb * 64, nb * 32, scr, lane); continue; }
        r -= I_OUT;
        if (r < NE * I_GU) { const int e = r / I_GU, q = r % I_GU, nb = q % 64, kb = q / 64; const int n0 = nb * 32;
            const int c = n0 & 1023, isu = n0 >> 10; const int drow = e * 2048 + (c >> 7) * 256 + isu * 128 + (c & 127);
            transpose_item(p.w_gu + (size_t)e * D * 2048, D, 2048, WguT, drow - 0, kb * 64, n0, scr, lane);
            continue; }
        r -= NE * I_GU;
        { const int e = r / I_DN, q = r % I_DN, nb = q % 32, kb = q / 32;
            transpose_item(p.w_down + (size_t)e * DE * D, DE, D, WdT, e * D + nb * 32, kb * 64, nb * 32, scr, lane); }
    }
    for (int i = blockIdx.x * NTHREADS + tid; i < NE * D; i += gridDim.x * NTHREADS) { const int e = i / D, k = i % D; ((float*)(p.ws + WS_WGRT))[i] = p.norm_ffn_g[k] * p.w_router[k * NE + e]; }
    for (int i = blockIdx.x * NTHREADS + tid; i < NE * D; i += gridDim.x * NTHREADS) { const int k = i / NE; ((float*)(p.ws + WS_WGRT))[65536 + i] = p.norm_ffn_g[k] * p.w_router[i]; }
    for (int i = blockIdx.x * NTHREADS + tid; i < S * 32; i += gridDim.x * NTHREADS) { const int t = i >> 5, j = i & 31;
        const float inv = powf(10000.f, -(float)j / 32.f); const float ang = (float)p.pos[t] * inv;
        double xr = (double)ang * 0.15915494309189535; xr -= floor(xr); const float xf = (float)xr;
        ((float*)(p.ws + WS_COS))[i] = __builtin_amdgcn_cosf(xf); ((float*)(p.ws + WS_SIN))[i] = __builtin_amdgcn_sinf(xf); }
    bf16* XN = (bf16*)(p.ws + WS_XN);
    for (int m = gw; m < S; m += NGW) {
        const f32x4* xr = (const f32x4*)(p.x + (size_t)m * D) + lane; f32x4 v[4]; float ss = 0.f;
#pragma unroll
        for (int j = 0; j < 4; ++j) { v[j] = xr[64 * j]; ss += v[j].x * v[j].x + v[j].y * v[j].y + v[j].z * v[j].z + v[j].w * v[j].w; }
        const float rstd = rsqrtf(wave_sum(ss) * (1.f / D) + EPS);
        u64* o8 = (u64*)(XN + (size_t)m * D) + lane;
#pragma unroll
        for (int j = 0; j < 4; ++j) { const f32x4 g = ((const f32x4*)p.norm_mix_g)[lane + 64 * j];
            o8[64 * j] = (u64)pk2(v[j].x * rstd * g.x, v[j].y * rstd * g.y) | ((u64)pk2(v[j].z * rstd * g.z, v[j].w * rstd * g.w) << 32); }
    }
}

namespace pg8 {
#define PG8_LAS __attribute__((address_space(3)))
typedef unsigned short bf16_t;
typedef short bf16x8 __attribute__((ext_vector_type(8)));
typedef float f32x4 __attribute__((ext_vector_type(4)));
typedef unsigned u32x4 __attribute__((ext_vector_type(4)));
constexpr int BM = 256, BK = 64, HALF = 128, HTB = HALF * BK * 2  , STAGE_BYTES = 8 * HTB, NXCD = 8, WGM = 8;

__host__ __device__ __forceinline__ int lds_byte(int r, int c) { const int st = (r >> 4) * 2 + (c >> 5), rr = r & 15, cc = c & 31, ob = rr * 64 + cc * 2; return st * 1024 + (ob ^ (((ob >> 9) & 1) << 5)); }
__host__ __device__ __forceinline__ void stage_rc(int b, int& R, int& C) { const int st = b / 1024, sb = b % 1024, swz = sb ^ (((sb >> 9) & 1) << 5); R = (st >> 1) * 16 + swz / 64; C = (st & 1) * 32 + (swz % 64) / 2; }
__host__ __device__ __forceinline__ int perm32(int rho) { const int n = rho >> 4, i = rho & 15; return 8 * (i >> 2) + 4 * n + (i & 3); }

struct Unit { int pm, pn, ui; };
struct Gemm { const bf16_t* A; const bf16_t* Bt; int M, N, K; };

struct StaticOrder {
    int nM, nN, nwg, G, c;
    __host__ __device__ void init(int M, int N, int G_, int c_) { nM = M / BM; nN = N / BM; nwg = nM * nN; G = G_; c = c_; }
    __host__ __device__ bool next(int i, Unit& u) const { const long L = (long)i * G + c; if (!map(L, u)) return false; u.ui = i; return true; }
    __host__ __device__ bool map(long L, Unit& u) const {
        if (L >= nwg) return false;
        int wgid = (int)L; { const int q = nwg / NXCD, r = nwg % NXCD, xcd = wgid % NXCD, off = wgid / NXCD; wgid = (xcd < r ? xcd * (q + 1) : r * (q + 1) + (xcd - r) * q) + off; }
        const int nig = WGM * nN, gid = wgid / nig, fm = gid * WGM, gsz = (nM - fm) < WGM ? (nM - fm) : WGM;
        u.pm = fm + ((wgid % nig) % gsz); u.pn = (wgid % nig) / gsz; u.ui = 0; return true;
    }
    __device__ __forceinline__ int bidx(const Unit& u) const { return u.pn; }
    __device__ __forceinline__ void a_ready(const Unit&) const {}
    __device__ __forceinline__ void done(const Unit&) const {}
};
template <class Epi, class Sched, bool ALIGN_EPI = false, bool SP2 = false, bool GATHER = false>
__device__ __forceinline__ void gemm_phase(PG8_LAS unsigned char* lds, const Gemm g, const Sched& S, const Epi& E) {
    static_assert(!GATHER || SP2, "GATHER is written for the SP2 loop");
    int tid_ = threadIdx.x; asm volatile("" : "+v"(tid_));
    const int tid = tid_, wid = __builtin_amdgcn_readfirstlane(tid >> 6), lane = tid & 63, wr = wid >> 2, wc = wid & 3, fr = lane & 15, fq = lane >> 4;
    const int K = g.K, nt = K / BK;
    unsigned voffA[2], voffB[2], gC[2]; int gR[2];
#pragma unroll
    for (int i = 0; i < 2; ++i) { int R, C; stage_rc(tid * 16 + i * 8192, R, C); const int Rb = Epi::PERM ? ((R & ~31) + perm32(R & 31)) : R;
        voffA[i] = (unsigned)(R * K + C) * 2u; voffB[i] = (unsigned)(Rb * K + C) * 2u; gR[i] = R; gC[i] = (unsigned)C * 2u; }
    unsigned vc[2][2] = {{0u, 0u}, {0u, 0u}}, vn[2][2] = {{0u, 0u}, {0u, 0u}};
#define PG8_GOFF(dst, uidx) do { _Pragma("unroll") for (int h_ = 0; h_ < 2; ++h_) _Pragma("unroll") for (int i_ = 0; i_ < 2; ++i_) dst[h_][i_] = (unsigned)S.rowtok((uidx), h_ * 128 + gR[i_]) * (unsigned)(K * 2) + gC[i_]; } while (0)
    const size_t kstep = (size_t)(BK * 2);
    const size_t hstep = (size_t)HALF * K * 2;
    const size_t tstep = 2 * hstep;
    const unsigned ldsw = (unsigned)wid * 1024u;
    const int aoff = lds_byte(wr * 64 + fr, fq * 8), boff = lds_byte(wc * 32 + fr, fq * 8);
#define PG8_SA(b, h) (((b) * 2 + (h)) * HTB)
#define PG8_SB(b, h) ((4 + (b) * 2 + (h)) * HTB)
#define PG8_STAGE(bufoff, gbase, voff) do { _Pragma("unroll") for (int _i = 0; _i < 2; ++_i) \
        __builtin_amdgcn_global_load_lds((const unsigned*)((const char*)(gbase) + (voff)[_i]), (PG8_LAS unsigned*)(lds + (bufoff) + ldsw + _i * 8192), 16, 0, 0); } while (0)
#define PG8_STAGE_AG(bufoff, kb, v0, v1) do { \
        __builtin_amdgcn_global_load_lds((const unsigned*)((const char*)g.A + (kb) + (v0)), (PG8_LAS unsigned*)(lds + (bufoff) + ldsw), 16, 0, 0); \
        __builtin_amdgcn_global_load_lds((const unsigned*)((const char*)g.A + (kb) + (v1)), (PG8_LAS unsigned*)(lds + (bufoff) + ldsw + 8192), 16, 0, 0); } while (0)
#define PG8_LDA(dst, b, h) do { _Pragma("unroll") for (int m = 0; m < 4; ++m) _Pragma("unroll") for (int k = 0; k < 2; ++k) dst[m][k] = *(const PG8_LAS bf16x8*)(lds + PG8_SA(b, h) + aoff + m * 2048 + k * 1024); } while (0)
#define PG8_LDB(dst, b, h) do { _Pragma("unroll") for (int n = 0; n < 2; ++n) _Pragma("unroll") for (int k = 0; k < 2; ++k) dst[n][k] = *(const PG8_LAS bf16x8*)(lds + PG8_SB(b, h) + boff + n * 2048 + k * 1024); } while (0)
#define PG8_MMA(ai, bj, At, Bt) do { __builtin_amdgcn_s_setprio(1); _Pragma("unroll") for (int m = 0; m < 4; ++m) _Pragma("unroll") for (int n = 0; n < 2; ++n) _Pragma("unroll") for (int k = 0; k < 2; ++k) \
        acc[ai][bj][m][n] = __builtin_amdgcn_mfma_f32_16x16x32_bf16(Bt[n][k], At[m][k], acc[ai][bj][m][n], 0, 0, 0); __builtin_amdgcn_s_setprio(0); } while (0)
#define PG8_WAIT_V(n) asm volatile("s_waitcnt vmcnt(" #n ")" ::: "memory")
#define PG8_WAIT_L(n) asm volatile("s_waitcnt lgkmcnt(" #n ")" ::: "memory")
#define PG8_BAR __builtin_amdgcn_s_barrier()
#define PG8_SCHED __builtin_amdgcn_sched_barrier(0)
    Unit cur, nxt; int ui = 0;
    if (!S.next(0, cur)) return;
    f32x4 acc[2][2][4][2];
#pragma unroll
    for (int a = 0; a < 2; ++a)
#pragma unroll
        for (int b = 0; b < 2; ++b)
#pragma unroll
            for (int m = 0; m < 4; ++m)
#pragma unroll
                for (int n = 0; n < 2; ++n) acc[a][b][m][n] = (f32x4){0.f, 0.f, 0.f, 0.f};
    bf16x8 At[4][2], B0[2][2], B1[2][2];
    const char* cA = (const char*)g.A + (size_t)cur.pm * tstep; const char* cB = (const char*)g.Bt + (size_t)S.bidx(cur) * tstep;
    S.a_ready(cur);
    if constexpr (SP2) {
        if constexpr (GATHER) { PG8_GOFF(vc, 0); }
        PG8_STAGE(PG8_SB(0, 0), cB, voffB); PG8_STAGE(PG8_SB(0, 1), cB + hstep, voffB);
        if constexpr (GATHER) { PG8_STAGE_AG(PG8_SA(0, 0), (size_t)0, vc[0][0], vc[0][1]); PG8_STAGE_AG(PG8_SA(0, 1), (size_t)0, vc[1][0], vc[1][1]); } else { PG8_STAGE(PG8_SA(0, 0), cA, voffA); PG8_STAGE(PG8_SA(0, 1), cA + hstep, voffA); }
        if (wr == 1) PG8_BAR;
        PG8_WAIT_V(2); PG8_BAR;
        PG8_STAGE(PG8_SB(1, 0), cB + kstep, voffB); if constexpr (GATHER) { PG8_STAGE_AG(PG8_SA(1, 0), kstep, vc[0][0], vc[0][1]); } else { PG8_STAGE(PG8_SA(1, 0), cA + kstep, voffA); } PG8_STAGE(PG8_SB(1, 1), cB + hstep + kstep, voffB);
        PG8_WAIT_V(6); PG8_BAR;
    } else {
        PG8_STAGE(PG8_SB(0, 0), cB, voffB); PG8_STAGE(PG8_SA(0, 0), cA, voffA); PG8_STAGE(PG8_SB(0, 1), cB + hstep, voffB); PG8_STAGE(PG8_SA(0, 1), cA + hstep, voffA);
        if (wr == 1) PG8_BAR;
        PG8_WAIT_V(4); PG8_BAR;
        PG8_STAGE(PG8_SB(1, 0), cB + kstep, voffB); PG8_STAGE(PG8_SA(1, 0), cA + kstep, voffA); PG8_STAGE(PG8_SB(1, 1), cB + hstep + kstep, voffB);
        PG8_WAIT_V(6); PG8_BAR;
    }
    for (;;) {
        const bool has_next = S.next(ui + 1, nxt);
        if constexpr (GATHER) { if (has_next) { PG8_GOFF(vn, ui + 1); } }
        const char* nA = has_next ? (const char*)g.A + (size_t)nxt.pm * tstep : cA; const char* nB = has_next ? (const char*)g.Bt + (size_t)S.bidx(nxt) * tstep : cB;
        for (int t = 0; t < nt; t += 2) {
            const bool last = (t == nt - 2);
            const char* a1 = cA + (size_t)(t + 1) * kstep;
            const char* a2 = last ? nA : cA + (size_t)(t + 2) * kstep; const char* b2 = last ? nB : cB + (size_t)(t + 2) * kstep;
            const char* a3 = a2 + kstep; const char* b3 = b2 + kstep;
            if (last && has_next) S.a_ready(nxt);
            const bool un_ = last && has_next; const size_t k1_ = (size_t)(t + 1) * kstep, k2_ = last ? (size_t)0 : (size_t)(t + 2) * kstep, k3_ = k2_ + kstep;
            const unsigned w00 = un_ ? vn[0][0] : vc[0][0], w01 = un_ ? vn[0][1] : vc[0][1], w10 = un_ ? vn[1][0] : vc[1][0], w11 = un_ ? vn[1][1] : vc[1][1];
            if constexpr (SP2) {
            PG8_LDB(B0, 0, 0); PG8_LDB(B1, 0, 1); PG8_SCHED; PG8_LDA(At, 0, 0); if constexpr (GATHER) { PG8_STAGE_AG(PG8_SA(1, 1), k1_, vc[1][0], vc[1][1]); } else { PG8_STAGE(PG8_SA(1, 1), a1 + hstep, voffA); }
            PG8_WAIT_V(8); PG8_WAIT_L(0); PG8_BAR; PG8_MMA(0, 0, At, B0); PG8_MMA(0, 1, At, B1); PG8_BAR; PG8_SCHED;
            PG8_LDA(At, 0, 1); PG8_STAGE(PG8_SB(0, 0), b2, voffB); PG8_STAGE(PG8_SB(0, 1), b2 + hstep, voffB); if constexpr (GATHER) { PG8_STAGE_AG(PG8_SA(0, 0), k2_, w00, w01); } else { PG8_STAGE(PG8_SA(0, 0), a2, voffA); }
            PG8_WAIT_V(8); PG8_WAIT_L(0); PG8_BAR; PG8_MMA(1, 0, At, B0); PG8_MMA(1, 1, At, B1); PG8_BAR; PG8_SCHED;
            PG8_LDB(B0, 1, 0); PG8_LDB(B1, 1, 1); PG8_SCHED; PG8_LDA(At, 1, 0); if constexpr (GATHER) { PG8_STAGE_AG(PG8_SA(0, 1), k2_, w10, w11); } else { PG8_STAGE(PG8_SA(0, 1), a2 + hstep, voffA); }
            PG8_WAIT_V(8); PG8_WAIT_L(0); PG8_BAR; PG8_MMA(0, 0, At, B0); PG8_MMA(0, 1, At, B1); PG8_BAR; PG8_SCHED;
            PG8_LDA(At, 1, 1); PG8_STAGE(PG8_SB(1, 0), b3, voffB); PG8_STAGE(PG8_SB(1, 1), b3 + hstep, voffB); if constexpr (GATHER) { PG8_STAGE_AG(PG8_SA(1, 0), k3_, w00, w01); } else { PG8_STAGE(PG8_SA(1, 0), a3, voffA); }
            PG8_WAIT_V(8); PG8_WAIT_L(0); PG8_BAR; PG8_MMA(1, 0, At, B0); PG8_MMA(1, 1, At, B1); PG8_BAR; PG8_SCHED;
            } else {
            PG8_LDB(B0, 0, 0); PG8_SCHED; PG8_LDA(At, 0, 0); PG8_STAGE(PG8_SA(1, 1), a1 + hstep, voffA);
            PG8_WAIT_L(8); PG8_BAR; PG8_WAIT_L(0); PG8_MMA(0, 0, At, B0); PG8_BAR; PG8_SCHED;
            PG8_LDB(B1, 0, 1); PG8_STAGE(PG8_SB(0, 0), b2, voffB);
            PG8_BAR; PG8_WAIT_L(0); PG8_MMA(0, 1, At, B1); PG8_BAR;
            PG8_LDA(At, 0, 1); PG8_STAGE(PG8_SA(0, 0), a2, voffA);
            PG8_BAR; PG8_WAIT_L(0); PG8_MMA(1, 0, At, B0); PG8_BAR; PG8_SCHED;
            PG8_STAGE(PG8_SB(0, 1), b2 + hstep, voffB);
            PG8_WAIT_V(6); PG8_BAR; PG8_MMA(1, 1, At, B1); PG8_BAR;
            PG8_LDB(B0, 1, 0); PG8_SCHED; PG8_LDA(At, 1, 0); PG8_STAGE(PG8_SA(0, 1), a2 + hstep, voffA);
            PG8_WAIT_L(8); PG8_BAR; PG8_WAIT_L(0); PG8_MMA(0, 0, At, B0); PG8_BAR; PG8_SCHED;
            PG8_LDB(B1, 1, 1); PG8_STAGE(PG8_SB(1, 0), b3, voffB);
            PG8_BAR; PG8_WAIT_L(0); PG8_MMA(0, 1, At, B1); PG8_BAR;
            PG8_LDA(At, 1, 1); PG8_STAGE(PG8_SA(1, 0), a3, voffA);
            PG8_BAR; PG8_WAIT_L(0); PG8_MMA(1, 0, At, B0); PG8_BAR; PG8_SCHED;
            PG8_STAGE(PG8_SB(1, 1), b3 + hstep, voffB);
            PG8_WAIT_V(6); PG8_BAR; PG8_MMA(1, 1, At, B1); PG8_BAR;
            }
        }
        if constexpr (ALIGN_EPI) { if (wr == 0) PG8_BAR; }
        if constexpr (!Epi::AFTER_DRAIN) { E(acc, cur, wr, wc, fr, fq); S.done(cur); }
        if (!has_next) break;
#pragma unroll
        for (int a = 0; a < 2; ++a)
#pragma unroll
            for (int b = 0; b < 2; ++b)
#pragma unroll
                for (int m = 0; m < 4; ++m)
#pragma unroll
                    for (int n = 0; n < 2; ++n) acc[a][b][m][n] = (f32x4){0.f, 0.f, 0.f, 0.f};
        cur = nxt; cA = nA; cB = nB; ++ui;
        if constexpr (GATHER) { vc[0][0] = vn[0][0]; vc[0][1] = vn[0][1]; vc[1][0] = vn[1][0]; vc[1][1] = vn[1][1]; }
        if constexpr (ALIGN_EPI) { if (wr == 1) PG8_BAR; }
    }
    PG8_WAIT_V(0);
    if constexpr (!ALIGN_EPI) { if (wr == 0) PG8_BAR; }
    PG8_BAR;
    if constexpr (Epi::AFTER_DRAIN) { E.fused(acc, cur, wr, wc, fr, fq, lds, wid, lane); S.done(cur); }
#undef PG8_SA
#undef PG8_SB
#undef PG8_STAGE
#undef PG8_LDA
#undef PG8_STAGE_AG
#undef PG8_GOFF
#undef PG8_LDB
#undef PG8_MMA
#undef PG8_WAIT_V
#undef PG8_WAIT_L
#undef PG8_BAR
#undef PG8_SCHED
}
}

template <class Epi>
__device__ __forceinline__ void ngemm_unit(unsigned char* lds, const bf16* A, int lda, const bf16* Bt, int ldb, int K, const Epi& epi, const pg8::Unit& u) {
    float* As = (float*)lds; float* Bs = As + 32 * 256;
    const int tid = opaque_tid(), tr = tid >> 4, tc = tid & 15;
    float acc0[8][8], acc1[8][8];
#pragma unroll
    for (int i = 0; i < 8; ++i)
#pragma unroll
        for (int j = 0; j < 8; ++j) { acc0[i][j] = 0.f; acc1[i][j] = 0.f; }
    for (int k0 = 0; k0 < K; k0 += 32) {
        __syncthreads();
#pragma unroll
        for (int j = 0; j < 2; ++j) { const int pidx = tid + 512 * j, r = pidx & 255, kq = pidx >> 8;
            const u32x4 va = *(const u32x4*)(A + (size_t)r * lda + k0 + kq * 8);
            const u32x4 vb = *(const u32x4*)(Bt + (size_t)r * ldb + k0 + kq * 8);
            float* ap = As + (kq * 8) * 256 + r; float* bp = Bs + (kq * 8) * 256 + r;
            ap[0 * 256] = blo(va.x); ap[1 * 256] = bhi(va.x); ap[2 * 256] = blo(va.y); ap[3 * 256] = bhi(va.y); ap[4 * 256] = blo(va.z); ap[5 * 256] = bhi(va.z); ap[6 * 256] = blo(va.w); ap[7 * 256] = bhi(va.w);
            bp[0 * 256] = blo(vb.x); bp[1 * 256] = bhi(vb.x); bp[2 * 256] = blo(vb.y); bp[3 * 256] = bhi(vb.y); bp[4 * 256] = blo(vb.z); bp[5 * 256] = bhi(vb.z); bp[6 * 256] = blo(vb.w); bp[7 * 256] = bhi(vb.w); }
        __syncthreads();
#pragma unroll 2
        for (int kk = 0; kk < 32; ++kk) {
            const f32x4 a0 = *(const f32x4*)(As + kk * 256 + tr * 8), a1 = *(const f32x4*)(As + kk * 256 + tr * 8 + 4);
            const f32x4 b00 = *(const f32x4*)(Bs + kk * 256 + tc * 8), b01 = *(const f32x4*)(Bs + kk * 256 + tc * 8 + 4);
            const f32x4 b10 = *(const f32x4*)(Bs + kk * 256 + 128 + tc * 8), b11 = *(const f32x4*)(Bs + kk * 256 + 128 + tc * 8 + 4);
            const float a[8] = {a0.x, a0.y, a0.z, a0.w, a1.x, a1.y, a1.z, a1.w};
            const float b0[8] = {b00.x, b00.y, b00.z, b00.w, b01.x, b01.y, b01.z, b01.w};
            const float b1[8] = {b10.x, b10.y, b10.z, b10.w, b11.x, b11.y, b11.z, b11.w};
#pragma unroll
            for (int i = 0; i < 8; ++i)
#pragma unroll
                for (int j = 0; j < 8; ++j) { acc0[i][j] = fmaf(a[i], b0[j], acc0[i][j]); acc1[i][j] = fmaf(a[i], b1[j], acc1[i][j]); }
        }
    }
#pragma unroll
    for (int i = 0; i < 8; ++i) epi(u, tr * 8 + i, tc * 8, acc0[i], acc1[i]);
}

__device__ __forceinline__ void store8_bf16(bf16* dst, const float (&v)[8]) {
    u32x4 o; o.x = pk2(v[0], v[1]); o.y = pk2(v[2], v[3]); o.z = pk2(v[4], v[5]); o.w = pk2(v[6], v[7]); *(u32x4*)dst = o;
}

typedef pg8::Unit Unit;
struct EpiProj { bf16* O;
    __device__ __forceinline__ void operator()(const Unit& u, int r, int c8, const float (&v0)[8], const float (&v1)[8]) const {
        bf16* row = O + (size_t)(u.pm * 256 + r) * NP + u.pn * 256 + c8; store8_bf16(row, v0); store8_bf16(row + 128, v1); } };
struct EpiOut { const float* x; const float* gffn; float* H2; bf16* XN2;
    __device__ __forceinline__ void operator()(const Unit& u, int r, int c8, const float (&v0)[8], const float (&v1)[8]) const {
        const int col = u.pn * 256 + c8; const size_t off = (size_t)(u.pm * 256 + r) * D + col; float h0[8], h1[8], n0[8], n1[8];
        const f32x4 xa = *(const f32x4*)(x + off), xb = *(const f32x4*)(x + off + 4), xc = *(const f32x4*)(x + off + 128), xd = *(const f32x4*)(x + off + 132);
        const f32x4 ga = *(const f32x4*)(gffn + col), gb = *(const f32x4*)(gffn + col + 4), gc = *(const f32x4*)(gffn + col + 128), gd = *(const f32x4*)(gffn + col + 132);
        const float xs0[8] = {xa.x, xa.y, xa.z, xa.w, xb.x, xb.y, xb.z, xb.w}, xs1[8] = {xc.x, xc.y, xc.z, xc.w, xd.x, xd.y, xd.z, xd.w};
        const float gs0[8] = {ga.x, ga.y, ga.z, ga.w, gb.x, gb.y, gb.z, gb.w}, gs1[8] = {gc.x, gc.y, gc.z, gc.w, gd.x, gd.y, gd.z, gd.w};
#pragma unroll
        for (int i = 0; i < 8; ++i) { h0[i] = xs0[i] + v0[i]; h1[i] = xs1[i] + v1[i]; n0[i] = h0[i] * gs0[i]; n1[i] = h1[i] * gs1[i]; }
        *(f32x4*)(H2 + off) = (f32x4){h0[0], h0[1], h0[2], h0[3]}; *(f32x4*)(H2 + off + 4) = (f32x4){h0[4], h0[5], h0[6], h0[7]};
        *(f32x4*)(H2 + off + 128) = (f32x4){h1[0], h1[1], h1[2], h1[3]}; *(f32x4*)(H2 + off + 132) = (f32x4){h1[4], h1[5], h1[6], h1[7]};
        store8_bf16(XN2 + off, n0); store8_bf16(XN2 + off + 128, n1); } };
struct EpiGU { const float* bgu; const LAS float* rowrstd; bf16* HDN; const LAS int* tile_e;
    __device__ __forceinline__ void operator()(const Unit& u, int r, int c8, const float (&v0)[8], const float (&v1)[8]) const {
        const int e = tile_e[u.pm]; const int row = u.pm * 256 + r; const float rs = rowrstd[u.ui * 256 + r]; const int cb = u.pn * 128 + c8; float h[8];
        const float* bg = bgu + e * 2048 + cb; const f32x4 ba = *(const f32x4*)bg, bb = *(const f32x4*)(bg + 4), bc = *(const f32x4*)(bg + 1024), bd_ = *(const f32x4*)(bg + 1028);
        const float b0[8] = {ba.x, ba.y, ba.z, ba.w, bb.x, bb.y, bb.z, bb.w}, b1[8] = {bc.x, bc.y, bc.z, bc.w, bd_.x, bd_.y, bd_.z, bd_.w};
#pragma unroll
        for (int i = 0; i < 8; ++i) { float g = v0[i] * rs + b0[i]; float uu = v1[i] * rs + b1[i];
            g = fminf(g, 7.f); uu = fminf(fmaxf(uu, -7.f), 7.f); h[i] = g * sigmoidf_(1.702f * g) * (uu + 1.f); }
        store8_bf16(HDN + (size_t)row * DE + cb, h); } };
struct EpiDown { const float* bd; const LAS float* rowgate; bf16* YS; const LAS int* tile_e;
    __device__ __forceinline__ void operator()(const Unit& u, int r, int c8, const float (&v0)[8], const float (&v1)[8]) const {
        const int e = tile_e[u.pm]; const int row = u.pm * 256 + r; const float gt = rowgate[u.ui * 256 + r]; const int cb = u.pn * 256 + c8; float y0[8], y1[8];
        const float* bp = bd + e * D + cb; const f32x4 ba = *(const f32x4*)bp, bb = *(const f32x4*)(bp + 4), bc = *(const f32x4*)(bp + 128), bd_ = *(const f32x4*)(bp + 132);
        const float b0[8] = {ba.x, ba.y, ba.z, ba.w, bb.x, bb.y, bb.z, bb.w}, b1[8] = {bc.x, bc.y, bc.z, bc.w, bd_.x, bd_.y, bd_.z, bd_.w};
#pragma unroll
        for (int i = 0; i < 8; ++i) { y0[i] = (v0[i] + b0[i]) * gt; y1[i] = (v1[i] + b1[i]) * gt; }
        store8_bf16(YS + (size_t)row * D + cb, y0); store8_bf16(YS + (size_t)row * D + cb + 128, y1); } };

__device__ __forceinline__ void store8_bf16_wt(bf16* dst, const float (&v)[8]) {
    u32x4 o; o.x = pk2(v[0], v[1]); o.y = pk2(v[2], v[3]); o.z = pk2(v[4], v[5]); o.w = pk2(v[6], v[7]);
    asm volatile("global_store_dwordx4 %0, %1, off sc1\n\ts_nop 1" :: "v"(dst), "v"(o) : "memory");
}
struct EpiMoe { const float* bgu; const float* bd; const LAS float* rowtab0; const LAS float* rowtab1; bf16* HDN; bf16* YS; const LAS int* tile_e;
    __device__ __forceinline__ void operator()(const Unit& u, int r, int c8, const float (&v0)[8], const float (&v1)[8]) const {
        const int e = tile_e[u.pm]; const int row = u.pm * 256 + r; const float rt = (u.ui < 9) ? rowtab0[u.ui * 256 + r] : rowtab1[(u.ui - 9) * 256 + r];
        if (u.pn < 8) { const int cb = u.pn * 128 + c8; float h[8];
            const float* bg = bgu + e * 2048 + cb; const f32x4 ba = *(const f32x4*)bg, bb = *(const f32x4*)(bg + 4), bc = *(const f32x4*)(bg + 1024), bd_ = *(const f32x4*)(bg + 1028);
            const float b0[8] = {ba.x, ba.y, ba.z, ba.w, bb.x, bb.y, bb.z, bb.w}, b1[8] = {bc.x, bc.y, bc.z, bc.w, bd_.x, bd_.y, bd_.z, bd_.w};
#pragma unroll
            for (int i = 0; i < 8; ++i) { float g = v0[i] * rt + b0[i]; float uu = v1[i] * rt + b1[i];
                g = fminf(g, 7.f); uu = fminf(fmaxf(uu, -7.f), 7.f); h[i] = g * sigmoidf_(1.702f * g) * (uu + 1.f); }
            store8_bf16_wt(HDN + (size_t)row * DE + cb, h);
        } else { const int cb = (u.pn - 8) * 256 + c8; float y0[8], y1[8];
            const float* bp = bd + e * D + cb; const f32x4 ba = *(const f32x4*)bp, bb = *(const f32x4*)(bp + 4), bc = *(const f32x4*)(bp + 128), bd_ = *(const f32x4*)(bp + 132);
            const float b0[8] = {ba.x, ba.y, ba.z, ba.w, bb.x, bb.y, bb.z, bb.w}, b1[8] = {bc.x, bc.y, bc.z, bc.w, bd_.x, bd_.y, bd_.z, bd_.w};
#pragma unroll
            for (int i = 0; i < 8; ++i) { y0[i] = (v0[i] + b0[i]) * rt; y1[i] = (v1[i] + b1[i]) * rt; }
            store8_bf16(YS + (size_t)row * D + cb, y0); store8_bf16(YS + (size_t)row * D + cb + 128, y1); } } };

template <class F> struct EpiAdapt {
    static constexpr bool PERM = true, AFTER_DRAIN = false; F f;
    __device__ __forceinline__ void operator()(const f32x4 (&acc)[2][2][4][2], const Unit& u, int wr, int wc, int fr, int fq) const {
#pragma unroll
        for (int ai = 0; ai < 2; ++ai)
#pragma unroll
            for (int m = 0; m < 4; ++m) { const int r = ai * 128 + wr * 64 + m * 16 + fr, c8 = wc * 32 + fq * 8;
                const f32x4 a = acc[ai][0][m][0], b = acc[ai][0][m][1], c = acc[ai][1][m][0], d = acc[ai][1][m][1];
                const float v0[8] = {a.x, a.y, a.z, a.w, b.x, b.y, b.z, b.w}, v1[8] = {c.x, c.y, c.z, c.w, d.x, d.y, d.z, d.w};
                f(u, r, c8, v0, v1); }
    }
};
struct MoeOrder { pg8::StaticOrder so; const LAS int* tile_e; int ncol; const LAS int* ltok;
    __device__ __forceinline__ bool next(int i, Unit& u) const { return so.next(i, u); }
    __device__ __forceinline__ int bidx(const Unit& u) const { return tile_e[u.pm] * ncol + u.pn; }
    __device__ __forceinline__ int rowtok(int ui, int r) const { return ltok[ui * 256 + r]; }
    __device__ __forceinline__ void a_ready(const Unit&) const {}
    __device__ __forceinline__ void done(const Unit&) const {} };
constexpr int HDN_PSEUDO_TOK = (int)((WS_HDN - WS_XN) / 2048);
constexpr int WD_TILE0 = (int)((WS_WDT - WS_WGUT) / (256 * 1024 * 2));
static_assert((WS_HDN - WS_XN) % 2048 == 0 && (WS_WDT - WS_WGUT) % (256 * 1024 * 2) == 0, "merged expert GEMM addressing");
struct MoeMerged { pg8::StaticOrder so1, so2; const LAS int* tile_e; const LAS int* ltok; unsigned* dep; int G, c, n1;
    __device__ __forceinline__ bool next(int i, Unit& u) const { const long L = (long)i * G + c; bool ok;
        if (L < so1.nwg) ok = so1.map(L, u); else { ok = so2.map(L - so1.nwg, u); u.pn += 8; }
        u.ui = i; return ok; }
    __device__ __forceinline__ int bidx(const Unit& u) const { return u.pn < 8 ? tile_e[u.pm] * 8 + u.pn : WD_TILE0 + tile_e[u.pm] * 4 + (u.pn - 8); }
    __device__ __forceinline__ int rowtok(int ui, int r) const { return ui < n1 ? ltok[ui * 256 + r] : ltok[9 * 256 + ui] + r; }
    __device__ __forceinline__ void a_ready(const Unit& u) const {
        if (u.pn < 8) return;
        if (__builtin_amdgcn_readfirstlane(threadIdx.x >> 6) == 0) { unsigned sp = 0u;
            while (__hip_atomic_load(dep + u.pm, __ATOMIC_RELAXED, __HIP_MEMORY_SCOPE_AGENT) < 64u) { __builtin_amdgcn_s_sleep(4); if (++sp > (1u << 22)) break; }
            __builtin_amdgcn_fence(__ATOMIC_ACQUIRE, "agent"); asm volatile("s_waitcnt vmcnt(0)" ::: "memory"); }
        __builtin_amdgcn_s_barrier(); }
    __device__ __forceinline__ void done(const Unit& u) const {
        if (u.pn >= 8) return;
        asm volatile("s_waitcnt vmcnt(0)" ::: "memory");
        if ((threadIdx.x & 63) == 0) __hip_atomic_fetch_add(dep + u.pm, 1u, __ATOMIC_RELAXED, __HIP_MEMORY_SCOPE_AGENT); } };

__device__ __forceinline__ void phase_ew_naive(const Params& p, unsigned char* lds) {
    const int tid = opaque_tid(), lane = tid & 63, wave = tid >> 6;
    bf16* PROJ = (bf16*)(p.ws + WS_PROJ); bf16* MIX = (bf16*)(p.ws + WS_MIX); bf16* KI = (bf16*)(p.ws + WS_KI); bf16* QL = (bf16*)(p.ws + WS_QL); float* WI = (float*)(p.ws + WS_WI);
    const float* COS = (const float*)(p.ws + WS_COS); const float* SIN = (const float*)(p.ws + WS_SIN);
    float* red = (float*)(lds);
    for (int t = blockIdx.x; t < S; t += gridDim.x) {
        const int c = tid; float acc = p.conv_b[c];
        for (int j = 0; j < CW; ++j) { const int tt = t - (CW - 1) + j; if (tt >= 0) { const float val = bf2f(PROJ[(size_t)tt * NP + C_VAL + c]), gate = bf2f(PROJ[(size_t)tt * NP + C_GATE + c]);
                acc = fmaf(p.conv_w[j * CC + c], val * sigmoidf_(gate), acc); } }
        const int hh = (tid & 255) >> 5, ii = tid & 31; const int qkbase = (tid < 256) ? C_Q : C_K;
        const float cs = COS[t * 32 + ii], sn = SIN[t * 32 + ii];
        const float x1 = bf2f(PROJ[(size_t)t * NP + qkbase + hh * 64 + ii]), x2 = bf2f(PROJ[(size_t)t * NP + qkbase + hh * 64 + 32 + ii]);
        float qi1 = 0.f, qi2 = 0.f; if (tid < 256) { qi1 = bf2f(PROJ[(size_t)t * NP + C_QI + hh * 64 + ii]); qi2 = bf2f(PROJ[(size_t)t * NP + C_QI + hh * 64 + 32 + ii]); }
        float kiv = 0.f, qlv = 0.f;
        if (wave == 4) kiv = bf2f(PROJ[(size_t)t * NP + C_KI + lane]);
        if (wave == 5) { for (int h = 0; h < 8; ++h) qlv = fmaf(bf2f(PROJ[(size_t)t * NP + C_WI + h]), bf2f(PROJ[(size_t)t * NP + C_QI + h * 64 + lane]), qlv); }
        float wiv = 0.f; if (wave == 6 && lane < 8) wiv = bf2f(PROJ[(size_t)t * NP + C_WI + lane]);
        float s1 = wave_sum(acc); if (lane == 0) red[wave] = s1; __syncthreads();
        float mean = 0.f;
#pragma unroll
        for (int w = 0; w < 8; ++w) mean += red[w];
        mean *= (1.f / CC); const float dv = acc - mean; float s2 = wave_sum(dv * dv); if (lane == 0) red[8 + wave] = s2; __syncthreads();
        float var = 0.f;
#pragma unroll
        for (int w = 0; w < 8; ++w) var += red[8 + w];
        var *= (1.f / CC);
        const float y = dv * rsqrtf(var + EPS) * p.conv_ng[c] + p.conv_nb[c];
        MIX[(size_t)t * D + c] = (bf16)f2bf(y * sigmoidf_(y));
        { const float sc = (tid < 256) ? C2 : 1.f; PROJ[(size_t)t * NP + qkbase + hh * 64 + ii] = (bf16)f2bf((x1 * cs - x2 * sn) * sc); PROJ[(size_t)t * NP + qkbase + hh * 64 + 32 + ii] = (bf16)f2bf((x2 * cs + x1 * sn) * sc); }
        if (tid < 256) { PROJ[(size_t)t * NP + C_QI + hh * 64 + ii] = (bf16)f2bf(qi1 * cs - qi2 * sn); PROJ[(size_t)t * NP + C_QI + hh * 64 + 32 + ii] = (bf16)f2bf(qi2 * cs + qi1 * sn); }
        if (wave == 4) { const float m = wave_sum(kiv) * (1.f / 64.f); const float d = kiv - m; const float vr = wave_sum(d * d) * (1.f / 64.f);
            const float yk = d * rsqrtf(vr + EPS) * p.idx_g[lane] + p.idx_b[lane]; const float other = __shfl_xor(yk, 32);
            const float c_ = COS[t * 32 + (lane & 31)], s_ = SIN[t * 32 + (lane & 31)];
            KI[(size_t)t * 64 + lane] = (bf16)f2bf(lane < 32 ? (yk * c_ - other * s_) : (yk * c_ + other * s_)); }
        if (wave == 5) { const float other = __shfl_xor(qlv, 32); const float c_ = COS[t * 32 + (lane & 31)], s_ = SIN[t * 32 + (lane & 31)];
            QL[(size_t)t * 64 + lane] = (bf16)f2bf(lane < 32 ? (qlv * c_ - other * s_) : (qlv * c_ + other * s_)); }
        if (wave == 6 && lane < 8) WI[t * 8 + lane] = wiv;
        __syncthreads();
    }
}

__device__ __forceinline__ void phase_ew_fast(const Params& p, unsigned char* lds) {
    const int tid = opaque_tid(), lane = tid & 63, wave = tid >> 6;
    bf16* PROJ = (bf16*)(p.ws + WS_PROJ); bf16* MIX = (bf16*)(p.ws + WS_MIX); bf16* KI = (bf16*)(p.ws + WS_KI); bf16* QL = (bf16*)(p.ws + WS_QL); float* WI = (float*)(p.ws + WS_WI);
    const float* COS = (const float*)(p.ws + WS_COS); const float* SIN = (const float*)(p.ws + WS_SIN);
    LAS unsigned char* L = (LAS unsigned char*)lds;
    LAS unsigned* U = (LAS unsigned*)L;
    LAS float* RED = (LAS float*)(L + 65536);
    const int cp = tid & 255, g = tid >> 8, wv_ = wave & 3;
    typedef float f32x2 __attribute__((ext_vector_type(2))); f32x2 wv[CW];
#pragma unroll
    for (int j = 0; j < CW; ++j) { const float2 ww = *(const float2*)(p.conv_w + j * CC + 2 * cp); wv[j] = (f32x2){ww.x, ww.y}; }
    const float2 cb = *(const float2*)(p.conv_b + 2 * cp), ng = *(const float2*)(p.conv_ng + 2 * cp), nb = *(const float2*)(p.conv_nb + 2 * cp);
    float kmx = 0.f;
    for (int unit = blockIdx.x; unit < S / 32; unit += gridDim.x) {
        const int t0 = unit * 32;
        __syncthreads();
        ISEC(6);
#pragma unroll 2
        for (int it = tid; it < 62 * 64; it += NTHREADS) { const int row = it >> 6, c8 = (it & 63) * 8, tt = t0 - 30 + row; u32x4 o = (u32x4){0u, 0u, 0u, 0u};
            if (tt >= 0) { const u32x4 va = *(const u32x4*)(PROJ + (size_t)tt * NP + C_VAL + c8), ga = *(const u32x4*)(PROJ + (size_t)tt * NP + C_GATE + c8);
                o.x = pk2(blo(va.x) * sigmoidf_(blo(ga.x)), bhi(va.x) * sigmoidf_(bhi(ga.x))); o.y = pk2(blo(va.y) * sigmoidf_(blo(ga.y)), bhi(va.y) * sigmoidf_(bhi(ga.y)));
                o.z = pk2(blo(va.z) * sigmoidf_(blo(ga.z)), bhi(va.z) * sigmoidf_(bhi(ga.z))); o.w = pk2(blo(va.w) * sigmoidf_(blo(ga.w)), bhi(va.w) * sigmoidf_(bhi(ga.w))); }
            *(LAS u32x4*)(L + (size_t)row * 1024 + c8 * 2) = o; }
        __syncthreads();
        ISEC(12);
        f32x2 acc[16];
#pragma unroll
        for (int tt = 0; tt < 16; ++tt) acc[tt] = (f32x2){cb.x, cb.y};
#pragma unroll
        for (int r = 0; r < 46; ++r) { const unsigned x = U[(g * 16 + r) * 256 + cp]; const f32x2 xv = (f32x2){blo(x), bhi(x)};
#pragma unroll
            for (int tt = 0; tt < 16; ++tt) { const int j = r - tt; if (j >= 0 && j < CW) acc[tt] = __builtin_elementwise_fma(wv[j], xv, acc[tt]); } }
#pragma unroll
        for (int tt = 0; tt < 16; ++tt) { const f32x2 a = acc[tt]; const float s1 = wave_sum(a.x + a.y), s2 = wave_sum(a.x * a.x + a.y * a.y);
            if (lane == 0) { RED[((g * 16 + tt) * 4 + wv_) * 2] = s1; RED[((g * 16 + tt) * 4 + wv_) * 2 + 1] = s2; } }
        __syncthreads();
#pragma unroll
        for (int tt = 0; tt < 16; ++tt) { const LAS f32x4* rp = (const LAS f32x4*)(RED + (g * 16 + tt) * 8); const f32x4 ra = rp[0], rb = rp[1];
            const float mean = (ra.x + ra.z + rb.x + rb.z) * (1.f / CC), var = (ra.y + ra.w + rb.y + rb.w) * (1.f / CC) - mean * mean, rstd = rsqrtf(fmaxf(var, 0.f) + EPS);
            const float y0 = (acc[tt].x - mean) * rstd * ng.x + nb.x, y1 = (acc[tt].y - mean) * rstd * ng.y + nb.y;
            *(unsigned*)(MIX + (size_t)(t0 + g * 16 + tt) * D + 2 * cp) = pk2(y0 * sigmoidf_(y0), y1 * sigmoidf_(y1)); }
        ISEC(13);
        { const int tl = (lane >> 3) & 3, dc = lane & 7, t = t0 + wave * 4 + tl; const bf16* prow = PROJ + (size_t)t * NP;
            const u32x4 kraw = *(const u32x4*)(prow + C_KI + dc * 8); const u32x4 wraw = *(const u32x4*)(prow + C_WI);
            const float wf[8] = {blo(wraw.x), bhi(wraw.x), blo(wraw.y), bhi(wraw.y), blo(wraw.z), bhi(wraw.z), blo(wraw.w), bhi(wraw.w)};
            float kv[8] = {blo(kraw.x), bhi(kraw.x), blo(kraw.y), bhi(kraw.y), blo(kraw.z), bhi(kraw.z), blo(kraw.w), bhi(kraw.w)}, qv[8] = {0.f, 0.f, 0.f, 0.f, 0.f, 0.f, 0.f, 0.f};
#pragma unroll
            for (int h = 0; h < 8; ++h) { const u32x4 q = *(const u32x4*)(prow + C_QI + h * 64 + dc * 8);
                qv[0] = fmaf(wf[h], blo(q.x), qv[0]); qv[1] = fmaf(wf[h], bhi(q.x), qv[1]); qv[2] = fmaf(wf[h], blo(q.y), qv[2]); qv[3] = fmaf(wf[h], bhi(q.y), qv[3]);
                qv[4] = fmaf(wf[h], blo(q.z), qv[4]); qv[5] = fmaf(wf[h], bhi(q.z), qv[5]); qv[6] = fmaf(wf[h], blo(q.w), qv[6]); qv[7] = fmaf(wf[h], bhi(q.w), qv[7]); }
            float s = 0.f;
#pragma unroll
            for (int i = 0; i < 8; ++i) s += kv[i];
            s += __shfl_xor(s, 1); s += __shfl_xor(s, 2); s += __shfl_xor(s, 4); const float m = s * (1.f / 64.f);
            float s2 = 0.f;
#pragma unroll
            for (int i = 0; i < 8; ++i) { kv[i] -= m; s2 += kv[i] * kv[i]; }
            s2 += __shfl_xor(s2, 1); s2 += __shfl_xor(s2, 2); s2 += __shfl_xor(s2, 4); const float rstd = rsqrtf(s2 * (1.f / 64.f) + EPS);
            const f32x4 ga = *(const f32x4*)(p.idx_g + dc * 8), gb = *(const f32x4*)(p.idx_g + dc * 8 + 4), ba = *(const f32x4*)(p.idx_b + dc * 8), bb = *(const f32x4*)(p.idx_b + dc * 8 + 4);
            const float gg[8] = {ga.x, ga.y, ga.z, ga.w, gb.x, gb.y, gb.z, gb.w}, bbv[8] = {ba.x, ba.y, ba.z, ba.w, bb.x, bb.y, bb.z, bb.w};
            const int cd = (dc & 3) * 8;
            const f32x4 c0 = *(const f32x4*)(COS + t * 32 + cd), c1 = *(const f32x4*)(COS + t * 32 + cd + 4), s0 = *(const f32x4*)(SIN + t * 32 + cd), s1 = *(const f32x4*)(SIN + t * 32 + cd + 4);
            const float cc[8] = {c0.x, c0.y, c0.z, c0.w, c1.x, c1.y, c1.z, c1.w}, ss[8] = {s0.x, s0.y, s0.z, s0.w, s1.x, s1.y, s1.z, s1.w};
            float ko[8], qo[8];
#pragma unroll
            for (int i = 0; i < 8; ++i) { const float yk = kv[i] * rstd * gg[i] + bbv[i]; const float ok = __shfl_xor(yk, 4), oq = __shfl_xor(qv[i], 4);
                ko[i] = (dc < 4) ? (yk * cc[i] - ok * ss[i]) : (yk * cc[i] + ok * ss[i]); qo[i] = (dc < 4) ? (qv[i] * cc[i] - oq * ss[i]) : (qv[i] * cc[i] + oq * ss[i]); }
            if (lane < 32) { store8_bf16(KI + (size_t)t * 64 + dc * 8, ko); store8_bf16(QL + (size_t)t * 64 + dc * 8, qo);
                if (dc == 0) { *(f32x4*)(WI + t * 8) = (f32x4){wf[0], wf[1], wf[2], wf[3]}; *(f32x4*)(WI + t * 8 + 4) = (f32x4){wf[4], wf[5], wf[6], wf[7]}; } } }
        __syncthreads();
        ISEC(14);
#pragma unroll 3
        for (int it = tid; it < 32 * 96; it += NTHREADS) { const int tl = it / 96, rem = it % 96, ten = rem >> 5, hh = (rem >> 2) & 7, ch = rem & 3; const int t = t0 + tl;
            bf16* base = PROJ + (size_t)t * NP + (ten == 0 ? C_Q : ten == 1 ? C_K : C_QI) + hh * 64 + ch * 8; const float sc = (ten == 0) ? C2 : 1.f;
            const u32x4 xa = *(const u32x4*)base, xb = *(const u32x4*)(base + 32);
            const f32x4 c0 = *(const f32x4*)(COS + t * 32 + ch * 8), c1 = *(const f32x4*)(COS + t * 32 + ch * 8 + 4), s0 = *(const f32x4*)(SIN + t * 32 + ch * 8), s1 = *(const f32x4*)(SIN + t * 32 + ch * 8 + 4);
            const float x1[8] = {blo(xa.x), bhi(xa.x), blo(xa.y), bhi(xa.y), blo(xa.z), bhi(xa.z), blo(xa.w), bhi(xa.w)}, x2[8] = {blo(xb.x), bhi(xb.x), blo(xb.y), bhi(xb.y), blo(xb.z), bhi(xb.z), blo(xb.w), bhi(xb.w)};
            const float cc[8] = {c0.x, c0.y, c0.z, c0.w, c1.x, c1.y, c1.z, c1.w}, ss[8] = {s0.x, s0.y, s0.z, s0.w, s1.x, s1.y, s1.z, s1.w};
            float o1[8], o2[8];
#pragma unroll
            for (int i = 0; i < 8; ++i) { o1[i] = (x1[i] * cc[i] - x2[i] * ss[i]) * sc; o2[i] = (x2[i] * cc[i] + x1[i] * ss[i]) * sc; }
            { float am = fmaxf(fabsf(o1[0]), fabsf(o2[0]));
#pragma unroll
                for (int i = 1; i < 8; ++i) am = fmaxf(am, fmaxf(fabsf(o1[i]), fabsf(o2[i])));
                kmx = fmaxf(kmx, (ten == 1) ? am : 0.f); }
            store8_bf16(base, o1); store8_bf16(base + 32, o2); }
        ISEC(5);
    }
    kmx = wave_max(kmx);
    __syncthreads(); if (lane == 0) RED[wave] = kmx; __syncthreads();
    if (tid == 0) { float m = RED[0];
#pragma unroll
        for (int w = 1; w < 8; ++w) m = fmaxf(m, RED[w]);
        atomicMax((unsigned*)(p.ws + WS_CTL) + CW_KMAX, __float_as_uint(m * 1.01f)); }
}

__device__ __forceinline__ unsigned fkey(float f) { unsigned u = __float_as_uint(f); if (u == 0x80000000u) u = 0u; return (u & 0x80000000u) ? ~u : (u | 0x80000000u); }
__device__ __forceinline__ void phase_idx_naive(const Params& p, unsigned char* lds) {
    const int tid = opaque_tid(), lane = tid & 63, wave = tid >> 6;
    const bf16* PROJ = (const bf16*)(p.ws + WS_PROJ); const bf16* KI = (const bf16*)(p.ws + WS_KI); const float* WI = (const float*)(p.ws + WS_WI);
    u64* MASK = (u64*)(p.ws + WS_MASK);
    float* scores = (float*)lds;
    float* qif = (float*)(lds + 65536);
    float* wf = (float*)(lds + 65536 + 2048);
    unsigned* hist = (unsigned*)(lds + 65536 + 4096);
    u64* tiebits = (u64*)(lds + 65536 + 8192);
    int* sh = (int*)(lds + 65536 + 12288);
    for (int t = blockIdx.x; t < S; t += gridDim.x) {
        const int tq = t >> 6, nadm = 64 * (tq + 1), ntw = 4 * (t >> 8) + 4;
        __syncthreads();
        if (nadm <= KSEL) {
            if (tid < ntw) MASK[(size_t)tid * S + t] = (tid <= tq) ? ~0ull : 0ull;
            continue;
        }
        qif[tid] = bf2f(PROJ[(size_t)t * NP + C_QI + tid]); if (tid < 8) wf[tid] = WI[t * 8 + tid];
        __syncthreads();
        for (int s = tid; s < nadm; s += NTHREADS) {
            float kf[64];
#pragma unroll
            for (int j = 0; j < 8; ++j) { const u32x4 v = *(const u32x4*)(KI + (size_t)s * 64 + j * 8);
                kf[j * 8 + 0] = blo(v.x); kf[j * 8 + 1] = bhi(v.x); kf[j * 8 + 2] = blo(v.y); kf[j * 8 + 3] = bhi(v.y); kf[j * 8 + 4] = blo(v.z); kf[j * 8 + 5] = bhi(v.z); kf[j * 8 + 6] = blo(v.w); kf[j * 8 + 7] = bhi(v.w); }
            float I = 0.f;
            for (int h = 0; h < 8; ++h) { float d = 0.f;
#pragma unroll
                for (int k = 0; k < 64; k += 4) { const f32x4 q4 = *(const f32x4*)(qif + h * 64 + k); d = fmaf(q4.x, kf[k], d); d = fmaf(q4.y, kf[k + 1], d); d = fmaf(q4.z, kf[k + 2], d); d = fmaf(q4.w, kf[k + 3], d); }
                I = fmaf(wf[h], fmaxf(d, 0.f), I); }
            scores[s] = I;
        }
        __syncthreads();
        unsigned prefix = 0; int kk = KSEL;
        for (int ps = 0; ps < 4; ++ps) {
            const int shift = 24 - 8 * ps;
            if (tid < 256) hist[tid] = 0u;
            __syncthreads();
            for (int s = tid; s < nadm; s += NTHREADS) { const unsigned key = fkey(scores[s]); if (ps == 0 || (key >> (shift + 8)) == prefix) atomicAdd(&hist[(key >> shift) & 255u], 1u); }
            __syncthreads();
            if (wave == 0) {
                unsigned c4[4]; unsigned tot = 0;
#pragma unroll
                for (int j = 0; j < 4; ++j) { c4[j] = hist[255 - (4 * lane + j)]; tot += c4[j]; }
                unsigned incl = tot;
#pragma unroll
                for (int o = 1; o < 64; o <<= 1) { const unsigned v = __shfl_up(incl, o); if (lane >= o) incl += v; }
                const unsigned excl = incl - tot;
                if (excl < (unsigned)kk && (unsigned)kk <= incl) { const unsigned s0 = excl + c4[0], s1 = s0 + c4[1], s2 = s1 + c4[2]; const unsigned ukk = (unsigned)kk;
                    const int j = ukk <= s0 ? 0 : ukk <= s1 ? 1 : ukk <= s2 ? 2 : 3; const unsigned cum = ukk <= s0 ? excl : ukk <= s1 ? s0 : ukk <= s2 ? s1 : s2;
                    sh[0] = 255 - (4 * lane + j); sh[1] = kk - (int)cum; }
            }
            __syncthreads();
            prefix = (prefix << 8) | (unsigned)sh[0]; kk = sh[1];
            __syncthreads();
        }
        const unsigned T = prefix;
        if (wave == 0) { int run = 0;
            for (int tile = 0; tile <= tq; ++tile) { const bool tie = fkey(scores[tile * 64 + lane]) == T; const u64 bal = __ballot(tie);
                const int rank = run + __popcll(bal & ((1ull << lane) - 1ull)); const u64 tb = __ballot(tie && rank < kk); if (lane == 0) tiebits[tile] = tb; run += __popcll(bal); } }
        __syncthreads();
        for (int tile = wave; tile < ntw; tile += NWAVES) { u64 w = 0ull;
            if (tile <= tq) { w = __ballot(fkey(scores[tile * 64 + lane]) > T) | tiebits[tile]; }
            if (lane == 0) MASK[(size_t)tile * S + t] = w; }
    }
}

namespace idxf {
typedef short bf16x8 __attribute__((ext_vector_type(8)));
typedef float f32x16 __attribute__((ext_vector_type(16)));
constexpr int L_B = 0, L_HIST = 36864, L_PK = L_HIST + 32 * 513 * 4, L_TAIL = L_PK + 2048, L_CC = L_TAIL + 2 * 32 * 64 * 4, L_CT = L_CC + 16 * 32 * 4, L_END = L_CT + 16 * 32 * 4;
constexpr int PK_P = 0, PK_KK = 32, PK_TC = 64, PK_A = 96, PK_SC = 128, PK_MN = 160, PK_MX = 192, PK_FLAG = 224, PK_LO = 256, PK_ND = 288, PK_NC = 320;
constexpr int CAND_CAP = 1024;
constexpr int R_HI = 12, R_LO = 56;
static_assert(L_END <= 131072, "idx LDS");
__device__ __forceinline__ unsigned fkey32(float f) { const unsigned u = __float_as_uint(f); return u ^ ((unsigned)((int)u >> 31) | 0x80000000u); }
__device__ __forceinline__ float fkey_inv(unsigned k) { return __uint_as_float((k & 0x80000000u) ? (k ^ 0x80000000u) : ~k); }
__device__ __forceinline__ int lbin(float I, float A, float sc) { const int b = (int)((I - A) * sc); return b < 0 ? 0 : (b > 1023 ? 1023 : b); }

template <int MODE>
__device__ __forceinline__ void sweep(const Params& p, LAS unsigned char* L, int q0, int ntk, int wave, int lane) {
    const int j = lane & 31, hi = lane >> 5;
    const bf16* KI = (const bf16*)(p.ws + WS_KI); u64* MASK = (u64*)(p.ws + WS_MASK);
    LAS unsigned* PK = (LAS unsigned*)(L + L_PK); LAS unsigned* tailk = (LAS unsigned*)(L + L_TAIL); LAS unsigned* taili = tailk + 32 * 64;
    LAS unsigned* hist = (LAS unsigned*)(L + L_HIST) + ((MODE == 5 || MODE >= 7) ? j : j * 257);
    float w[8]; { const f32x4 wa = *(const f32x4*)((const float*)(p.ws + WS_WI) + (size_t)(q0 + j) * 8), wb = *(const f32x4*)((const float*)(p.ws + WS_WI) + (size_t)(q0 + j) * 8 + 4);
        w[0] = wa.x; w[1] = wa.y; w[2] = wa.z; w[3] = wa.w; w[4] = wb.x; w[5] = wb.y; w[6] = wb.z; w[7] = wb.w; }
    const unsigned P = (MODE == 2 || MODE == 3 || MODE == 6 || MODE == 8) ? PK[PK_P + j] : 0u; const unsigned PLO = (MODE == 8) ? PK[PK_LO + j] : 0u; unsigned ndef = 0u, ccnt = 0u;
    u64* CAND = (u64*)(p.ws + WS_XS) + (size_t)(q0 + j) * CAND_CAP + (wave * 2 + hi) * 64;
    const int nloop = (MODE == 4) ? NWAVES : (MODE == 7) ? ((ntk + 7) >> 3) : ntk;
    const float lA = (MODE >= 5) ? __uint_as_float(PK[PK_A + j]) : 0.f, lS = (MODE >= 5) ? __uint_as_float(PK[PK_SC + j]) : 0.f;
    const LAS unsigned char* bfr = L + L_B + lane * 16;
    const bf16* abase = KI + hi * 8;
    unsigned kmn = 0xffffffffu, tk8[8] = {0u, 0u, 0u, 0u, 0u, 0u, 0u, 0u};
    bf16x8 a[2][4];
#define IDX_LOADA(dst, kt_) do { _Pragma("unroll") for (int hf = 0; hf < 2; ++hf) { const int row = (MODE == 4) ? ((((kt_) * 64 + hf * 32 + (lane & 31)) * (ntk * 64)) >> 9) : (MODE == 7) ? min((((kt_) * 64 + hf * 32 + (lane & 31)) << 3) + 5, ntk * 64 - 1) : ((kt_) * 64 + hf * 32 + (lane & 31)); \
            _Pragma("unroll") for (int ks = 0; ks < 4; ++ks) dst[hf][ks] = *(const bf16x8*)(abase + (size_t)row * 64 + ks * 16); } } while (0)
    for (int kt = wave; kt < nloop; kt += NWAVES) {
        IDX_LOADA(a, kt);
        f32x16 L0, L1; float I0[16], I1[16];
        f32x16 cA0, cA1, cB0, cB1; bf16x8 bA[4], bB[4];
#define IDX_LOADB(BD, H) do { _Pragma("unroll") for (int ks = 0; ks < 4; ++ks) BD[ks] = *(const LAS bf16x8*)(bfr + ((H) * 4 + ks) * 1024); } while (0)
#define IDX_CHAIN(D0, D1, BS) do { D0 = f32x16{}; D1 = f32x16{}; _Pragma("unroll") for (int ks = 0; ks < 4; ++ks) { \
            D0 = __builtin_amdgcn_mfma_f32_32x32x16_bf16(a[0][ks], BS[ks], D0, 0, 0, 0); D1 = __builtin_amdgcn_mfma_f32_32x32x16_bf16(a[1][ks], BS[ks], D1, 0, 0, 0); } \
            asm volatile("" : "+v"(D0)); asm volatile("" : "+v"(D1)); } while (0)
#define IDX_ACC(C0_, C1_, H) do { _Pragma("unroll") for (int r = 0; r < 16; ++r) { I0[r] = fmaf(w[H], __builtin_fabsf(C0_[r]), I0[r]); I1[r] = fmaf(w[H], __builtin_fabsf(C1_[r]), I1[r]); asm volatile("" : "+v"(I0[r]), "+v"(I1[r])); } } while (0)
#define IDX_SB __builtin_amdgcn_sched_barrier(0)
        IDX_LOADB(bA, 8); IDX_LOADB(bB, 0); IDX_SB;
        IDX_LOADB(bA, 8); IDX_CHAIN(L0, L1, bA); IDX_SB;
        IDX_LOADB(bA, 1); IDX_CHAIN(cA0, cA1, bB); IDX_SB;
#pragma unroll
        for (int r = 0; r < 16; ++r) { I0[r] = L0[r]; I1[r] = L1[r]; }
        IDX_LOADB(bB, 2); IDX_CHAIN(cB0, cB1, bA); IDX_ACC(cA0, cA1, 0); IDX_SB;
        IDX_LOADB(bA, 3); IDX_CHAIN(cA0, cA1, bB); IDX_ACC(cB0, cB1, 1); IDX_SB;
        IDX_LOADB(bB, 4); IDX_CHAIN(cB0, cB1, bA); IDX_ACC(cA0, cA1, 2); IDX_SB;
        IDX_LOADB(bA, 5); IDX_CHAIN(cA0, cA1, bB); IDX_ACC(cB0, cB1, 3); IDX_SB;
        IDX_LOADB(bB, 6); IDX_CHAIN(cB0, cB1, bA); IDX_ACC(cA0, cA1, 4); IDX_SB;
        IDX_LOADB(bA, 7); IDX_CHAIN(cA0, cA1, bB); IDX_ACC(cB0, cB1, 5); IDX_SB;
        IDX_CHAIN(cB0, cB1, bA); IDX_ACC(cA0, cA1, 6); IDX_SB;
        IDX_ACC(cB0, cB1, 7);
        IDX_SB;
#undef IDX_LOADB
#undef IDX_SB
#undef IDX_CHAIN
#undef IDX_ACC
        if (MODE == 1) {
#pragma unroll
            for (int r = 0; r < 16; ++r) { const unsigned k0 = fkey32(I0[r]), k1 = fkey32(I1[r]);
                __hip_atomic_fetch_add(hist + (k0 >> 24), 1u, __ATOMIC_RELAXED, __HIP_MEMORY_SCOPE_WORKGROUP); __hip_atomic_fetch_add(hist + (k1 >> 24), 1u, __ATOMIC_RELAXED, __HIP_MEMORY_SCOPE_WORKGROUP); }
        } else if (MODE == 2) {
#pragma unroll
            for (int r = 0; r < 16; ++r) { const unsigned k0 = fkey32(I0[r]), k1 = fkey32(I1[r]);
                if ((k0 >> 24) == P) __hip_atomic_fetch_add(hist + ((k0 >> 16) & 255u), 1u, __ATOMIC_RELAXED, __HIP_MEMORY_SCOPE_WORKGROUP);
                if ((k1 >> 24) == P) __hip_atomic_fetch_add(hist + ((k1 >> 16) & 255u), 1u, __ATOMIC_RELAXED, __HIP_MEMORY_SCOPE_WORKGROUP); }
        } else if (MODE == 4) {
#pragma unroll
            for (int r = 0; r < 16; ++r) { unsigned k0 = fkey32(I0[r]), k1 = fkey32(I1[r]); kmn = min(kmn, min(k0, k1));
#pragma unroll
                for (int i = 0; i < 8; ++i) { const unsigned hi0 = max(tk8[i], k0); k0 = min(tk8[i], k0); tk8[i] = hi0; }
#pragma unroll
                for (int i = 0; i < 8; ++i) { const unsigned hi1 = max(tk8[i], k1); k1 = min(tk8[i], k1); tk8[i] = hi1; } }
        } else if (MODE == 5 || MODE == 7) {
#pragma unroll
            for (int r = 0; r < 16; ++r) { const int b0 = lbin(I0[r], lA, lS), b1 = lbin(I1[r], lA, lS); const int kb = (r & 3) + 8 * (r >> 2) + 4 * hi;
                const bool v0 = (MODE == 5) || (((kt * 64 + kb) << 3) + 5 < ntk * 64), v1 = (MODE == 5) || (((kt * 64 + 32 + kb) << 3) + 5 < ntk * 64);
                if (v0) __hip_atomic_fetch_add(hist + (b0 >> 1) * 32, 1u << ((b0 & 1) * 16), __ATOMIC_RELAXED, __HIP_MEMORY_SCOPE_WORKGROUP);
                if (v1) __hip_atomic_fetch_add(hist + (b1 >> 1) * 32, 1u << ((b1 & 1) * 16), __ATOMIC_RELAXED, __HIP_MEMORY_SCOPE_WORKGROUP); }
        } else if (MODE == 8) {
            unsigned wlo = 0u, whi = 0u; const float thi = (P >= 1023u) ? INFINITY : (float)(P + 1u), tlo = (float)PLO;     const unsigned wbits = __float_as_uint(thi - tlo);
#pragma unroll
            for (int r = 0; r < 16; ++r) { const int kb = (r & 3) + 8 * (r >> 2); const float x0 = (I0[r] - lA) * lS, x1 = (I1[r] - lA) * lS;
                wlo |= (x0 >= thi) ? (1u << kb) : 0u; whi |= (x1 >= thi) ? (1u << kb) : 0u;
                if (__float_as_uint(x0 - tlo) < wbits) { const unsigned c0 = (unsigned)lbin(I0[r], lA, lS); __hip_atomic_fetch_add(hist + (c0 >> 1) * 32, 1u << ((c0 & 1) * 16), __ATOMIC_RELAXED, __HIP_MEMORY_SCOPE_WORKGROUP);
                    if (ccnt < 64u) CAND[ccnt] = ((u64)fkey32(I0[r]) << 32) | (u64)(unsigned)(kt * 64 + kb + 4 * hi); ++ccnt; }
                if (__float_as_uint(x1 - tlo) < wbits) { const unsigned c1 = (unsigned)lbin(I1[r], lA, lS); __hip_atomic_fetch_add(hist + (c1 >> 1) * 32, 1u << ((c1 & 1) * 16), __ATOMIC_RELAXED, __HIP_MEMORY_SCOPE_WORKGROUP);
                    if (ccnt < 64u) CAND[ccnt] = ((u64)fkey32(I1[r]) << 32) | (u64)(unsigned)(kt * 64 + 32 + kb + 4 * hi); ++ccnt; } }
            wlo <<= 4 * hi; whi <<= 4 * hi;
            wlo |= (unsigned)__shfl_xor((int)wlo, 32); whi |= (unsigned)__shfl_xor((int)whi, 32);
            if (hi == 0) { MASK[(size_t)kt * S + q0 + j] = ((u64)whi << 32) | (u64)wlo; ndef += (unsigned)(__popc(wlo) + __popc(whi)); }
        } else {
            unsigned wlo = 0u, whi = 0u;
#pragma unroll
            for (int r = 0; r < 16; ++r) { const int kb = (r & 3) + 8 * (r >> 2); const unsigned k0 = fkey32(I0[r]), k1 = fkey32(I1[r]);
                const unsigned c0 = (MODE == 3) ? (k0 >> 16) : (unsigned)lbin(I0[r], lA, lS), c1 = (MODE == 3) ? (k1 >> 16) : (unsigned)lbin(I1[r], lA, lS);
                wlo |= (c0 > P) ? (1u << kb) : 0u; whi |= (c1 > P) ? (1u << kb) : 0u;
                if (c0 == P) { const unsigned pos = __hip_atomic_fetch_add(PK + PK_TC + j, 1u, __ATOMIC_RELAXED, __HIP_MEMORY_SCOPE_WORKGROUP); if (pos < 64u) { tailk[j * 64 + pos] = k0; taili[j * 64 + pos] = (unsigned)(kt * 64 + kb + 4 * hi); } }
                if (c1 == P) { const unsigned pos = __hip_atomic_fetch_add(PK + PK_TC + j, 1u, __ATOMIC_RELAXED, __HIP_MEMORY_SCOPE_WORKGROUP); if (pos < 64u) { tailk[j * 64 + pos] = k1; taili[j * 64 + pos] = (unsigned)(kt * 64 + 32 + kb + 4 * hi); } } }
            wlo <<= 4 * hi; whi <<= 4 * hi;
            wlo |= (unsigned)__shfl_xor((int)wlo, 32); whi |= (unsigned)__shfl_xor((int)whi, 32);
            if (hi == 0) MASK[(size_t)kt * S + q0 + j] = ((u64)whi << 32) | (u64)wlo;
        }
    }
#undef IDX_LOADA
    if (MODE == 8) { if (hi == 0 && ndef) __hip_atomic_fetch_add(PK + PK_ND + j, ndef, __ATOMIC_RELAXED, __HIP_MEMORY_SCOPE_WORKGROUP); ((LAS unsigned*)(L + L_CC))[(wave * 2 + hi) * 32 + j] = ccnt; }
    if (MODE == 4) {
        const int nadm = ntk * 64; const unsigned cand = nadm >= 8192 ? tk8[3] : nadm >= 4096 ? tk8[7] : nadm >= 2048 ? kmn : nadm >= 1024 ? tk8[7] : kmn;
        __hip_atomic_fetch_min(PK + PK_MN + j, cand, __ATOMIC_RELAXED, __HIP_MEMORY_SCOPE_WORKGROUP); __hip_atomic_fetch_max(PK + PK_MX + j, tk8[0], __ATOMIC_RELAXED, __HIP_MEMORY_SCOPE_WORKGROUP); }
}

__device__ __forceinline__ void scan4(LAS unsigned char* L, int wave, int lane) {
    LAS unsigned* PK = (LAS unsigned*)(L + L_PK);
    for (int qq = 0; qq < 4; ++qq) { const int jq = wave * 4 + qq; const LAS unsigned* hb = (const LAS unsigned*)(L + L_HIST) + jq * 257;
        const unsigned kk = PK[PK_KK + jq];
        const unsigned c0 = hb[255 - 4 * lane], c1 = hb[254 - 4 * lane], c2 = hb[253 - 4 * lane], c3 = hb[252 - 4 * lane]; const unsigned tot = c0 + c1 + c2 + c3;
        unsigned incl = tot;
#pragma unroll
        for (int o = 1; o < 64; o <<= 1) { const unsigned v = __shfl_up(incl, o); if (lane >= o) incl += v; }
        const unsigned excl = incl - tot;
        if (excl < kk && kk <= incl) { const unsigned s0 = excl + c0, s1 = s0 + c1, s2 = s1 + c2;
            const int jb = kk <= s0 ? 0 : kk <= s1 ? 1 : kk <= s2 ? 2 : 3; const unsigned cum = kk <= s0 ? excl : kk <= s1 ? s0 : kk <= s2 ? s1 : s2;
            PK[PK_P + jq] = (PK[PK_P + jq] << 8) | (unsigned)(255 - (4 * lane + jb)); PK[PK_KK + jq] = kk - cum; }
    }
}
__device__ __forceinline__ void scan_lin(LAS unsigned char* L, int tid, int kk_off = PK_KK, int out_off = PK_P, bool write_kk = true) {
    LAS unsigned* PK = (LAS unsigned*)(L + L_PK); LAS unsigned* CT = (LAS unsigned*)(L + L_CT);
    const int jq = tid & 31, ch = tid >> 5; const LAS unsigned* hb = (const LAS unsigned*)(L + L_HIST) + (32 * ch) * 32 + jq;
    unsigned tot = 0u;
#pragma unroll 8
    for (int i = 0; i < 32; ++i) { const unsigned wd = hb[i * 32]; tot += (wd & 0xffffu) + (wd >> 16); }
    CT[ch * 32 + jq] = tot;
    __syncthreads();
    unsigned excl = 0u;
#pragma unroll
    for (int c = 1; c < 16; ++c) excl += (c > ch) ? CT[c * 32 + jq] : 0u;
    const unsigned kk = PK[kk_off + jq];
    if (excl < kk && kk <= excl + tot) { unsigned cum = excl, bsel = 0u, nk = 0u; bool done = false;
        for (int i = 31; i >= 0; --i) { const unsigned wd = hb[i * 32]; const unsigned chi = wd >> 16, clo = wd & 0xffffu;
            bool hit = !done && (cum + chi >= kk); bsel = hit ? (unsigned)(2 * (32 * ch + i) + 1) : bsel; nk = hit ? (kk - cum) : nk; done = done || hit; cum += chi;
            hit = !done && (cum + clo >= kk); bsel = hit ? (unsigned)(2 * (32 * ch + i)) : bsel; nk = hit ? (kk - cum) : nk; done = done || hit; cum += clo; }
        PK[out_off + jq] = bsel; if (write_kk) PK[PK_KK + jq] = nk; }
}
template <bool TOLDS>
__device__ __forceinline__ void tail_resolve(const Params& p, LAS unsigned char* L, int q0, int tid) {
    u64* MASK = (u64*)(p.ws + WS_MASK); LAS unsigned* PK = (LAS unsigned*)(L + L_PK); LAS u64* MW = (LAS u64*)(L + L_HIST);
    const int jq = tid >> 4, e0 = tid & 15; const unsigned n = min(PK[PK_TC + jq], 64u), kk = PK[PK_KK + jq];
    const LAS unsigned* tk = (const LAS unsigned*)(L + L_TAIL) + jq * 64; const LAS unsigned* ti = tk + 32 * 64;
    for (unsigned e = e0; e < n; e += 16) { const unsigned k = tk[e], s = ti[e]; unsigned rank = 0;
        for (unsigned e2 = 0; e2 < n; ++e2) { const unsigned k2 = tk[e2], s2 = ti[e2]; rank += (k2 > k || (k2 == k && s2 < s)) ? 1u : 0u; }
        if (rank < kk) { if (TOLDS) __hip_atomic_fetch_or(MW + (s >> 6) * 32 + jq, 1ull << (s & 63), __ATOMIC_RELAXED, __HIP_MEMORY_SCOPE_WORKGROUP);
            else atomicOr((unsigned long long*)&MASK[(size_t)(s >> 6) * S + q0 + jq], 1ull << (s & 63)); } }
}
__device__ __forceinline__ void idx_unit(const Params& p, unsigned char* lds, int u) {
    int tid_ = threadIdx.x; asm volatile("" : "+v"(tid_)); const int tid = tid_, lane = tid & 63; const int wave = __builtin_amdgcn_readfirstlane(tid >> 6);
    LAS unsigned char* L = (LAS unsigned char*)lds;
    const int q0 = u * 32, tq = q0 >> 6, ntk = tq + 1, ntw = 4 * (q0 >> 8) + 4;
    u64* MASK = (u64*)(p.ws + WS_MASK);
    if (ntk * 64 <= KSEL) { for (int i = tid; i < ntw * 32; i += NTHREADS) { const int tile = i >> 5; MASK[(size_t)tile * S + q0 + (i & 31)] = (tile <= tq) ? ~0ull : 0ull; } return; }
    for (int i = tid; i < (ntw - ntk) * 32; i += NTHREADS) MASK[(size_t)(ntk + (i >> 5)) * S + q0 + (i & 31)] = 0ull;
    __syncthreads();
    ISEC(7);
    { const bf16* PROJ = (const bf16*)(p.ws + WS_PROJ); const bf16* QL = (const bf16*)(p.ws + WS_QL); const int j = lane & 31, hi = lane >> 5;
        for (int f = wave; f < 36; f += NWAVES) { const int h = f >> 2, ks = f & 3;
            const bf16* src = (h < 8) ? PROJ + (size_t)(q0 + j) * NP + C_QI + h * 64 + ks * 16 + hi * 8 : QL + (size_t)(q0 + j) * 64 + ks * 16 + hi * 8;
            *(LAS u32x4*)(L + L_B + f * 1024 + lane * 16) = *(const u32x4*)src; } }
    LAS unsigned* PK = (LAS unsigned*)(L + L_PK);
    if (tid < 32) { PK[PK_P + tid] = 0u; PK[PK_KK + tid] = (unsigned)KSEL; PK[PK_TC + tid] = 0u; PK[PK_MN + tid] = 0xffffffffu; PK[PK_MX + tid] = 0u; }
    if (tid == 0) PK[PK_FLAG] = 0u;
    for (int i = tid; i < 32 * 513; i += NTHREADS) ((LAS unsigned*)(L + L_HIST))[i] = 0u;
    __syncthreads();
    ISEC(0);
    sweep<4>(p, L, q0, ntk, wave, lane);
    __syncthreads();
    ISEC(1);
    if (tid < 32) { const float mn = fkey_inv(PK[PK_MN + tid]), mx = fkey_inv(PK[PK_MX + tid]); const float rg = mx - mn; const float A = mn; const float sc = 1024.f / (1.5f * rg);
        PK[PK_A + tid] = __float_as_uint(A); PK[PK_SC + tid] = __float_as_uint(sc); if (!(rg > 0.f) || !(sc < 3.0e38f)) PK[PK_FLAG] = 1u; }
    __syncthreads();
    bool fallback = PK[PK_FLAG] != 0u;
    bool done = false;
    if (!fallback && ntk >= 32) {
        sweep<7>(p, L, q0, ntk, wave, lane);
        __syncthreads();
        ISEC(8);
        if (tid < 32) { PK[PK_ND + tid] = (unsigned)R_HI; PK[PK_NC + tid] = (unsigned)R_LO; }
        __syncthreads();
        scan_lin(L, tid, PK_ND, PK_P, false);
        __syncthreads();
        scan_lin(L, tid, PK_NC, PK_LO, false);
        __syncthreads();
        if (tid < 32) { PK[PK_ND + tid] = 0u; PK[PK_NC + tid] = 0u; }
        for (int i = tid; i < 32 * 513; i += NTHREADS) ((LAS unsigned*)(L + L_HIST))[i] = 0u;
        __syncthreads();
        ISEC(9);
        sweep<8>(p, L, q0, ntk, wave, lane);
        __syncthreads();
        ISEC(10);
        if (tid < 32) { const LAS unsigned* cc = (const LAS unsigned*)(L + L_CC) + tid; unsigned nc = 0u, mxc = 0u;
#pragma unroll
            for (int i = 0; i < 16; ++i) { const unsigned c = cc[i * 32]; nc += c; mxc = max(mxc, c); }
            const unsigned nd = PK[PK_ND + tid]; const bool ok = nd < (unsigned)KSEL && nd + nc >= (unsigned)KSEL && mxc <= 64u;
            if (!ok) PK[PK_FLAG] = 1u; PK[PK_KK + tid] = (unsigned)KSEL - (ok ? nd : 0u); PK[PK_TC + tid] = 0u; }
        __syncthreads();
        if (PK[PK_FLAG] == 0u) {
            scan_lin(L, tid);
            __syncthreads();
            LAS u64* MW = (LAS u64*)(L + L_HIST);
            for (int i = tid; i < ntk * 32; i += NTHREADS) MW[i] = 0ull;
            __syncthreads();
            { const int jq = tid >> 4, e0 = tid & 15; const unsigned nc = ((const LAS unsigned*)(L + L_CC))[e0 * 32 + jq], bt = PK[PK_P + jq]; const float cA = __uint_as_float(PK[PK_A + jq]), cS = __uint_as_float(PK[PK_SC + jq]);
                const u64* cl = (const u64*)(p.ws + WS_XS) + (size_t)(q0 + jq) * CAND_CAP + e0 * 64; LAS unsigned* tk = (LAS unsigned*)(L + L_TAIL) + jq * 64; LAS unsigned* ti = tk + 32 * 64;
                for (unsigned eb = 0; eb < nc; eb += 8) { u64 rec[8];
#pragma unroll
                    for (int i = 0; i < 8; ++i) { const unsigned e = eb + i; rec[i] = (e < nc) ? cl[e] : 0ull; }
#pragma unroll
                    for (int i = 0; i < 8; ++i) { const unsigned e = eb + i; if (e < nc) { const unsigned key = (unsigned)(rec[i] >> 32), s = (unsigned)rec[i]; const unsigned b = (unsigned)lbin(fkey_inv(key), cA, cS);
                            if (b > bt) __hip_atomic_fetch_or(MW + (s >> 6) * 32 + jq, 1ull << (s & 63), __ATOMIC_RELAXED, __HIP_MEMORY_SCOPE_WORKGROUP);
                            else if (b == bt) { const unsigned pos = __hip_atomic_fetch_add(PK + PK_TC + jq, 1u, __ATOMIC_RELAXED, __HIP_MEMORY_SCOPE_WORKGROUP); if (pos < 64u) { tk[pos] = key; ti[pos] = s; } } } } } }
            __syncthreads();
            if (tid < 32 && PK[PK_TC + tid] > 64u) PK[PK_FLAG] = 1u;
            __syncthreads();
            if (PK[PK_FLAG] == 0u) { tail_resolve<true>(p, L, q0, tid); __syncthreads();
                for (int i = tid; i < ntk * 32; i += NTHREADS) { const u64 wv = MW[i]; if (wv) { u64* gp = &MASK[(size_t)(i >> 5) * S + q0 + (i & 31)]; *gp = *gp | wv; } }
                done = true; }
        }
        ISEC(11);
        if (!done) {
            __syncthreads();
#if PROBE_PHASE == 101
            if (tid == 0) atomicAdd((unsigned*)(p.ws + WS_CTL) + 2048, 1u);
#endif
            if (tid < 32) { PK[PK_P + tid] = 0u; PK[PK_KK + tid] = (unsigned)KSEL; PK[PK_TC + tid] = 0u; }
            if (tid == 0) PK[PK_FLAG] = 0u;
            for (int i = tid; i < 32 * 513; i += NTHREADS) ((LAS unsigned*)(L + L_HIST))[i] = 0u;
            __syncthreads();
        }
    }
    if (!fallback && !done) {
        sweep<5>(p, L, q0, ntk, wave, lane);
        __syncthreads();
        ISEC(2);
        scan_lin(L, tid);
        __syncthreads();
        ISEC(3);
        sweep<6>(p, L, q0, ntk, wave, lane);
        ISEC(4);
        __syncthreads();
        if (tid < 32 && PK[PK_TC + tid] > 64u) PK[PK_FLAG] = 1u;
        __syncthreads();
        fallback = PK[PK_FLAG] != 0u;
        if (!fallback) tail_resolve<false>(p, L, q0, tid);
        ISEC(5);
    }
    if (fallback && !done) {
        __syncthreads();
#if PROBE_PHASE == 100
        if (tid == 0) atomicAdd((unsigned*)(p.ws + WS_CTL) + 2048, 1u);
#endif
        if (tid < 32) { PK[PK_P + tid] = 0u; PK[PK_KK + tid] = (unsigned)KSEL; PK[PK_TC + tid] = 0u; }
        for (int i = tid; i < 32 * 257; i += NTHREADS) ((LAS unsigned*)(L + L_HIST))[i] = 0u;
        __syncthreads();
        sweep<1>(p, L, q0, ntk, wave, lane);
        __syncthreads();
        scan4(L, wave, lane);
        __syncthreads();
        for (int i = tid; i < 32 * 257; i += NTHREADS) ((LAS unsigned*)(L + L_HIST))[i] = 0u;
        __syncthreads();
        sweep<2>(p, L, q0, ntk, wave, lane);
        __syncthreads();
        scan4(L, wave, lane);
        __syncthreads();
        sweep<3>(p, L, q0, ntk, wave, lane);
        __syncthreads();
        tail_resolve<false>(p, L, q0, tid);
    }
}
__device__ __forceinline__ void idx_phase(const Params& p, unsigned char* lds) {
    for (int w = blockIdx.x; w < 256; w += gridDim.x)
#pragma unroll 1
        for (int k = 0; k < 2; ++k) idx_unit(p, lds, k ? 511 - w : w);
}
}

__device__ __forceinline__ void phase_att_naive(const Params& p, unsigned char* lds) {
    const int tid = opaque_tid(), lane = tid & 63, wave = tid >> 6;
    const bf16* PROJ = (const bf16*)(p.ws + WS_PROJ); bf16* MIX = (bf16*)(p.ws + WS_MIX); const u64* MASK = (const u64*)(p.ws + WS_MASK);
    int* sidx = (int*)(lds + wave * 2048); float* slog = (float*)(lds + wave * 2048 + 1024);
    const int h = wave;
    for (int t = blockIdx.x; t < S; t += gridDim.x) {
        const int tq = t >> 6;
        float qf[64];
#pragma unroll
        for (int j = 0; j < 8; ++j) { const u32x4 v = *(const u32x4*)(PROJ + (size_t)t * NP + C_Q + h * 64 + j * 8);
            qf[j * 8 + 0] = blo(v.x); qf[j * 8 + 1] = bhi(v.x); qf[j * 8 + 2] = blo(v.y); qf[j * 8 + 3] = bhi(v.y); qf[j * 8 + 4] = blo(v.z); qf[j * 8 + 5] = bhi(v.z); qf[j * 8 + 6] = blo(v.w); qf[j * 8 + 7] = bhi(v.w); }
        int n = 0;
        for (int tile = 0; tile <= tq; ++tile) {
            const u64 w = MASK[(size_t)tile * S + t]; const bool sel = (w >> lane) & 1ull;
            if (w == 0ull) continue;
            float lg = 0.f; const int s = tile * 64 + lane;
            if (sel) {
#pragma unroll
                for (int j = 0; j < 8; ++j) { const u32x4 v = *(const u32x4*)(PROJ + (size_t)s * NP + C_K + h * 64 + j * 8);
                    lg = fmaf(qf[j * 8 + 0], blo(v.x), lg); lg = fmaf(qf[j * 8 + 1], bhi(v.x), lg); lg = fmaf(qf[j * 8 + 2], blo(v.y), lg); lg = fmaf(qf[j * 8 + 3], bhi(v.y), lg);
                    lg = fmaf(qf[j * 8 + 4], blo(v.z), lg); lg = fmaf(qf[j * 8 + 5], bhi(v.z), lg); lg = fmaf(qf[j * 8 + 6], blo(v.w), lg); lg = fmaf(qf[j * 8 + 7], bhi(v.w), lg); }
                const int pos = n + __popcll(w & ((1ull << lane) - 1ull));
                if (pos < 256) { sidx[pos] = s; slog[pos] = lg; }
            }
            n += __popcll(w);
        }
        if (n > 256) n = 256;
        __builtin_amdgcn_s_waitcnt(0); asm volatile("" ::: "memory");
        float m = -INFINITY; for (int j = lane; j < n; j += 64) m = fmaxf(m, slog[j]);
        m = wave_max(m);
        float l = 0.f; for (int j = lane; j < n; j += 64) { const float pj = exp2f(slog[j] - m); slog[j] = pj; l += pj; }
        l = wave_sum(l);
        __builtin_amdgcn_s_waitcnt(0); asm volatile("" ::: "memory");
        float o = 0.f;
        for (int j = 0; j < n; ++j) o = fmaf(slog[j], bf2f(PROJ[(size_t)sidx[j] * NP + C_V + h * 64 + lane]), o);
        MIX[(size_t)t * D + 512 + h * 64 + lane] = (bf16)f2bf(o / l);
        __builtin_amdgcn_s_waitcnt(0); asm volatile("" ::: "memory");
    }
}

namespace attn_body {
using bf16=__hip_bfloat16;
using bf16x8=__attribute__((ext_vector_type(8)))short;
using s16x4=__attribute__((ext_vector_type(4)))short;
using f32x16=__attribute__((ext_vector_type(16)))float;
using u32x4=__attribute__((ext_vector_type(4)))unsigned;
constexpr int NHEAD=8,SEQ=16384,D=64,DMI=3328,DMO=1024;
typedef unsigned long long u64;
constexpr int NW=8,QBLK=32,QB=QBLK*NW,KVBLK=64,NQB=SEQ/QB;
__device__ __forceinline__ int crow(int r,int hi){return (r&3)+8*(r>>2)+4*hi;}
#define SBAR() __builtin_amdgcn_sched_barrier(0)
__device__ __forceinline__ void cmask(f32x16&p0,f32x16&p1,int jb,int qrel,int hi){
  const float NEG=-INFINITY; int kb=64*jb+4*hi;
  #pragma unroll
  for(int r=0;r<16;++r){int kv=kb+(r&3)+8*(r>>2); if(kv>qrel)p0[r]=NEG; if(kv+32>qrel)p1[r]=NEG;}
}

constexpr int NSLOT=3, SLOTB=8192;
constexpr int LDS_K=0, LDS_V=NSLOT*SLOTB, LDS_WS=2*NSLOT*SLOTB, LDS_OST=LDS_WS+NW*64*4, LDS_M=LDS_OST+NW*4096, LDS_BYTES=LDS_M+NW*2048;
constexpr float C2=0.125f*1.4426950408889634f;
__device__ __forceinline__ void glds16s(const void*sbase,unsigned voff,unsigned lds_dst){unsigned keep;
  asm volatile("s_mov_b32 %0, m0\n\ts_mov_b32 m0, %3\n\ts_nop 0\n\tglobal_load_lds_dwordx4 %1, %2\n\ts_mov_b32 m0, %0":"=&s"(keep):"v"(voff),"s"(sbase),"s"(lds_dst):"memory");}
__device__ __forceinline__ void glds16(const void*gsrc,unsigned lds_dst){unsigned keep;
  asm volatile("s_mov_b32 %0, m0\n\ts_mov_b32 m0, %2\n\ts_nop 0\n\tglobal_load_lds_dwordx4 %1, off\n\ts_mov_b32 m0, %0":"=&s"(keep):"v"(gsrc),"s"(lds_dst):"memory");}
__device__ __forceinline__ float max3f(float a,float b,float c){float r;asm("v_max3_f32 %0, %1, %2, %3":"=v"(r):"v"(a),"v"(b),"v"(c));return r;}
__device__ __forceinline__ float max2f(float a,float b){float r;asm("v_max_f32_e32 %0, %1, %2":"=v"(r):"v"(a),"v"(b));return r;}
__device__ __forceinline__ float fadd_s(float a,float b){float r;asm("v_add_f32_e32 %0, %1, %2":"=v"(r):"v"(a),"v"(b));return r;}
__device__ __forceinline__ float fsub_s(float a,float b){float r;asm("v_sub_f32_e32 %0, %1, %2":"=v"(r):"v"(a),"v"(b));return r;}
typedef float f32x2_t __attribute__((ext_vector_type(2))); typedef __bf16 bf16x2_t __attribute__((ext_vector_type(2)));
__device__ __forceinline__ unsigned cvtpk_s(float lo,float hi){f32x2_t v={lo,hi};bf16x2_t b=__builtin_convertvector(v,bf16x2_t);return __builtin_bit_cast(unsigned,b);}
#define WAIT_BAR(N) asm volatile("s_waitcnt vmcnt(" #N ") lgkmcnt(0)\n\ts_barrier":::"memory")

__device__ __forceinline__ void qkt(f32x16&p0,f32x16&p1,const char*Kslot,const bf16x8*qr,int r32,int hi){ const f32x16 negm=f32x16{};
  const char*kb=Kslot+hi*1024+r32*16;
  #pragma unroll
  for(int d0=0;d0<4;++d0){
    const bf16x8 b0=*reinterpret_cast<const bf16x8*>(kb+d0*2048);
    const bf16x8 b1=*reinterpret_cast<const bf16x8*>(kb+d0*2048+512);
    if(d0==0){p0=__builtin_amdgcn_mfma_f32_32x32x16_bf16(b0,qr[0],negm,0,0,0);p1=__builtin_amdgcn_mfma_f32_32x32x16_bf16(b1,qr[0],negm,0,0,0);}
    else{p0=__builtin_amdgcn_mfma_f32_32x32x16_bf16(b0,qr[d0],p0,0,0,0);p1=__builtin_amdgcn_mfma_f32_32x32x16_bf16(b1,qr[d0],p1,0,0,0);}}
}
typedef __attribute__((address_space(3))) const char* lds_cptr;
typedef short v4i16_t __attribute__((ext_vector_type(4)));
__device__ __forceinline__ void kload8(bf16x8*kf,lds_cptr kp){
  kf[0]=*(const __attribute__((address_space(3))) bf16x8*)(kp);      kf[1]=*(const __attribute__((address_space(3))) bf16x8*)(kp+512);
  kf[2]=*(const __attribute__((address_space(3))) bf16x8*)(kp+2048); kf[3]=*(const __attribute__((address_space(3))) bf16x8*)(kp+2560);
  kf[4]=*(const __attribute__((address_space(3))) bf16x8*)(kp+4096); kf[5]=*(const __attribute__((address_space(3))) bf16x8*)(kp+4608);
  kf[6]=*(const __attribute__((address_space(3))) bf16x8*)(kp+6144); kf[7]=*(const __attribute__((address_space(3))) bf16x8*)(kp+6656);
}
__device__ __forceinline__ void kload2(bf16x8*kf,lds_cptr kp,int j){ kf[2*j]=*(const __attribute__((address_space(3))) bf16x8*)(kp+j*2048); kf[2*j+1]=*(const __attribute__((address_space(3))) bf16x8*)(kp+j*2048+512); }
__device__ __forceinline__ s16x4 vtr(lds_cptr p){ return __builtin_bit_cast(s16x4,__builtin_amdgcn_ds_read_tr16_b64_v4i16((__attribute__((address_space(3))) v4i16_t*)p)); }
__device__ __forceinline__ float rowmax(const f32x16&p0,const f32x16&p1){
  float a=max3f(p0[0],p0[1],p1[0]),b=max3f(p0[2],p0[3],p1[1]);a=max3f(a,p1[2],p1[3]);
  #pragma unroll
  for(int r=4;r<16;r+=4){a=max3f(a,p0[r],p0[r+1]);b=max3f(b,p0[r+2],p0[r+3]);a=max3f(a,p1[r],p1[r+1]);b=max3f(b,p1[r+2],p1[r+3]);}
  const float m=max2f(a,b);
  auto rr=__builtin_amdgcn_permlane32_swap(__float_as_uint(m),__float_as_uint(m),false,false);
  return max2f(__uint_as_float(rr[0]),__uint_as_float(rr[1]));
}
__device__ __forceinline__ void pv(f32x16*o,int vb,bf16x8 pa0,bf16x8 pa1,bf16x8 pa2,bf16x8 pa3){
  #pragma unroll
  for(int d0=0;d0<2;++d0){s16x4 lo[4],hi[4];
    #pragma unroll
    for(int ks=0;ks<4;++ks){
      asm volatile("ds_read_b64_tr_b16 %0,%1 offset:%c2":"=&v"(lo[ks]):"v"(vb),"i"(d0*4096+ks*1024):"memory");
      asm volatile("ds_read_b64_tr_b16 %0,%1 offset:%c2":"=&v"(hi[ks]):"v"(vb),"i"(d0*4096+ks*1024+512):"memory");}
    asm volatile("s_waitcnt lgkmcnt(0)":::"memory");SBAR();
    #define PK(k) (bf16x8){lo[k][0],lo[k][1],lo[k][2],lo[k][3],hi[k][0],hi[k][1],hi[k][2],hi[k][3]}
    o[d0]=__builtin_amdgcn_mfma_f32_32x32x16_bf16(pa0,PK(0),o[d0],0,0,0);
    o[d0]=__builtin_amdgcn_mfma_f32_32x32x16_bf16(pa1,PK(1),o[d0],0,0,0);
    o[d0]=__builtin_amdgcn_mfma_f32_32x32x16_bf16(pa2,PK(2),o[d0],0,0,0);
    o[d0]=__builtin_amdgcn_mfma_f32_32x32x16_bf16(pa3,PK(3),o[d0],0,0,0);
    #undef PK
  }
}

#ifndef ATTN_STORE16
#define ATTN_STORE16(p,v) (*(u32x4*)(p)=(v))
#endif
template<int THRL,bool NM> __device__ __forceinline__ void attn_unit(int h,int qb,const bf16*Q,const bf16*__restrict__ K,const bf16*__restrict__ V,const u64*__restrict__ MASK,bf16*O,char*shm){
  int tid_=threadIdx.x; asm volatile("":"+v"(tid_)); const int tid=tid_,lane=tid&63,r32=lane&31,hi=lane>>5; const int wid=__builtin_amdgcn_readfirstlane(tid>>6);
  const long rowbase=0; const int q0=qb*QB;
  const bf16*Qw=Q+(rowbase+q0+wid*QBLK)*DMI+h*D;
  const bf16*Kh=K+rowbase*DMI+h*D,*Vh=V+rowbase*DMI+h*D;
  const unsigned lds0=(unsigned)(uintptr_t)shm;
  float*wsf=(float*)(shm+LDS_WS)+wid*64;
  const unsigned koff=(unsigned)(lane*DMI+wid*8)*2u;
  const unsigned voffv=(unsigned)((16*(wid&3)+(lane>>2))*DMI+(wid>>2)*32+(lane&3)*8)*2u;
  const unsigned kdst=lds0+LDS_K+wid*1024, vdst=lds0+LDS_V+wid*1024;
  const u64*mbase=MASK+q0+wid*QBLK; const int jm=lane>>4; const unsigned mdst=lds0+LDS_M+wid*2048; const unsigned moff0=(unsigned)(lane&15)*16u, moff1=moff0+((jm==1)?(unsigned)SEQ*8u:0u);
  #define DMA_M2(tA,tB,slot) glds16s(mbase+(size_t)(tA)*SEQ,((tB)!=(tA))?moff1:moff0,(unsigned)__builtin_amdgcn_readfirstlane(mdst+(slot)))
  const unsigned sh4=4u*(unsigned)hi; const float NEGINF=-INFINITY;
  #define MAPPLY(C0,C1,MW) do{ const unsigned lo_=(unsigned)(MW)>>sh4, hi_=(unsigned)((MW)>>32)>>sh4; \
    _Pragma("unroll") for(int r=0;r<16;++r){ const int sh_=31-((r&3)+8*(r>>2)); const int m0_=((int)(lo_<<sh_))>>31, m1_=((int)(hi_<<sh_))>>31;   \
      C0[r]=__int_as_float((__float_as_int(C0[r])&m0_)|(~m0_&(int)0xff800000)); C1[r]=__int_as_float((__float_as_int(C1[r])&m1_)|(~m1_&(int)0xff800000)); } }while(0)
  #define DMA_K(t,slot) glds16s(Kh+(long)(t)*KVBLK*DMI,koff,(unsigned)__builtin_amdgcn_readfirstlane(kdst+(slot)))
  #define DMA_V(t,slot) glds16s(Vh+(long)(t)*KVBLK*DMI,voffv,(unsigned)__builtin_amdgcn_readfirstlane(vdst+(slot)))
  const int vb0=(int)(lds0+LDS_V)+((lane>>4)&1)*32+(lane&3)*8+(4*hi+((lane&15)>>2))*64;
  const char*Kbase=shm+LDS_K; bf16x8 kf[8];
  const lds_cptr shm3=(lds_cptr)shm; const lds_cptr mp0=shm3+LDS_M+wid*2048+r32*8;
  #define MLD(off) (*(const __attribute__((address_space(3))) u64*)(mp0+(off)))
  const lds_cptr kp0=shm3+LDS_K+hi*1024+r32*16; const lds_cptr vp0=shm3+LDS_V+((lane>>4)&1)*32+(lane&3)*8+(4*hi+((lane&15)>>2))*64;
  const int NT=(q0+QB)/KVBLK;
  glds16s(mbase,moff0+((jm==0)?(unsigned)SEQ*8u:(jm==1)?(unsigned)SEQ*16u:0u),(unsigned)__builtin_amdgcn_readfirstlane(mdst));
  DMA_K(0,0);DMA_V(0,0);DMA_K(1,SLOTB);
  bf16x8 qr[4];
  #pragma unroll
  for(int d0=0;d0<4;++d0)qr[d0]=*reinterpret_cast<const bf16x8*>(&Qw[(long)r32*DMI+d0*16+hi*8]);
  float mhat=0.f,l_reg=0.f;f32x16 o[2];o[0]=f32x16{};o[1]=f32x16{};const f32x16 Z16=f32x16{};
  bool resc=false;
  #define START(P0,P1,MW) do{ const float rm=NM?0.f:rowmax(P0,P1); resc=false; \
    if(!NM&&__builtin_expect(__any(rm>(float)THRL),0)){ const float dl=__builtin_fmaxf(rm,0.f); mhat+=dl; \
      _Pragma("unroll") for(int r=0;r<16;++r){P0[r]-=dl;P1[r]-=dl;} } \
    MAPPLY(P0,P1,MW); \
    _Pragma("unroll") for(int r=0;r<16;++r)P0[r]=__builtin_amdgcn_exp2f(P0[r]); }while(0)
  #define RESC() do{ if(resc){ asm volatile("s_waitcnt lgkmcnt(0)":::"memory"); \
      _Pragma("unroll") for(int d_=0;d_<2;++d_) _Pragma("unroll") for(int r=0;r<16;++r)o[d_][r]*=wsf[crow(r,hi)]; } }while(0)
  f32x16 pA0,pA1,pB0,pB1;
  int sl_prev=0,sl_cur=0,sl_next=SLOTB;
  #define ROT() do{sl_prev=sl_cur;sl_cur=sl_next;sl_next=(sl_next==(NSLOT-1)*SLOTB)?0:sl_next+SLOTB;}while(0)
  DMA_K(2,2*SLOTB);
  WAIT_BAR(3);
  const u64 mw0=MLD(512);
  qkt(pA0,pA1,Kbase,qr,r32,hi);asm volatile("s_nop 15\n\ts_nop 7":"+v"(pA0),"+v"(pA1));
  START(pA0,pA1,mw0);
  _Pragma("unroll") for(int r=0;r<16;++r)pA1[r]=__builtin_amdgcn_exp2f(pA1[r]);
  WAIT_BAR(0);
  DMA_K(3,0);DMA_V(1,SLOTB);
  ROT();
  kload8(kf,kp0+sl_cur);
  WAIT_BAR(2);
  s16x4 vlo[8],vhi[8]; u32x4 pw0,pw1,pw2,pw3;
  #define PKW(P,B) cvtpk_s(P[B],P[B+1])
  #define PAF(k) __builtin_bit_cast(bf16x8,pw##k)
  #define VFR(i) (bf16x8){vlo[i][0],vlo[i][1],vlo[i][2],vlo[i][3],vhi[i][0],vhi[i][1],vhi[i][2],vhi[i][3]}
  #define PIN(x) asm volatile("":"+v"(x))
  #define MX3(a,b,c) __builtin_fmaxf(__builtin_fmaxf((a),(b)),(c))
  #define GAPA(MF,A0,A1,A2,A3,W0,W1,PW) do{ MF; sacc+=A0; sacc+=A1; sacc+=A2; sacc+=A3; PIN(sacc); W0; W1; PIN(PW); SBAR(); }while(0)
  #define EX(v) __builtin_amdgcn_exp2f(v)
  #define GAPB(MF,X,B) do{ MF; X[B]=EX(X[B]); X[B+1]=EX(X[B+1]); X[B+2]=EX(X[B+2]); X[B+3]=EX(X[B+3]); PIN(X); SBAR(); }while(0)
  #define VRD(i) do{ vlo[i]=vtr(vp_+(((i)>>2)*4096+((i)&3)*1024)); vhi[i]=vtr(vp_+(((i)>>2)*4096+((i)&3)*1024+512)); }while(0)
  #define KRD(G,j) do{ if(G){ kload2(kf,kp0+sl_next,j); SBAR(); } }while(0)
  #define STEP(C0,C1,P0,P1,t,GK,GV,GL,GM,MOFF) do{ SBAR(); \
    const lds_cptr vp_=vp0+sl_prev; \
    VRD(0); SBAR(); float sacc=(P0[0]+P0[1]); \
    GAPA(C0=__builtin_amdgcn_mfma_f32_32x32x16_bf16(kf[0],qr[0],Z16,0,0,0), P0[2],P0[3],P0[4],P0[5],     pw0[0]=PKW(P0,0), pw0[1]=PKW(P0,2), pw0); \
    VRD(4); SBAR(); GAPA(C1=__builtin_amdgcn_mfma_f32_32x32x16_bf16(kf[1],qr[0],Z16,0,0,0), P0[6],P0[7],P0[8],P0[9],     pw0[2]=PKW(P0,4), pw0[3]=PKW(P0,6), pw0); \
    VRD(1); SBAR(); GAPA(C0=__builtin_amdgcn_mfma_f32_32x32x16_bf16(kf[2],qr[1],C0,0,0,0),   P0[10],P0[11],P0[12],P0[13], pw1[0]=PKW(P0,8), pw1[1]=PKW(P0,10), pw1); \
    VRD(5); SBAR(); GAPA(C1=__builtin_amdgcn_mfma_f32_32x32x16_bf16(kf[3],qr[1],C1,0,0,0),   P0[14],P0[15],P1[0],P1[1],   pw1[2]=PKW(P0,12),pw1[3]=PKW(P0,14), pw1); \
    VRD(2); SBAR(); GAPA(C0=__builtin_amdgcn_mfma_f32_32x32x16_bf16(kf[4],qr[2],C0,0,0,0),   P1[2],P1[3],P1[4],P1[5],     pw2[0]=PKW(P1,0), pw2[1]=PKW(P1,2), pw2); \
    VRD(6); SBAR(); GAPA(C1=__builtin_amdgcn_mfma_f32_32x32x16_bf16(kf[5],qr[2],C1,0,0,0),   P1[6],P1[7],P1[8],P1[9],     pw2[2]=PKW(P1,4), pw2[3]=PKW(P1,6), pw2); \
    VRD(3); SBAR(); GAPA(C0=__builtin_amdgcn_mfma_f32_32x32x16_bf16(kf[6],qr[3],C0,0,0,0),   P1[10],P1[11],P1[12],P1[13], pw3[0]=PKW(P1,8), pw3[1]=PKW(P1,10), pw3); \
    VRD(7); SBAR(); GAPA(C1=__builtin_amdgcn_mfma_f32_32x32x16_bf16(kf[7],qr[3],C1,0,0,0),   P1[14],P1[15],0.f,0.f,       pw3[2]=PKW(P1,12),pw3[3]=PKW(P1,14), pw3); \
    l_reg+=sacc; \
    if(GK){DMA_K((t)+3,sl_cur);} if(GV){DMA_V((t)+1,sl_next);} if(GM){ const int tb_=((t)+3<NT)?(t)+3:NT-1; DMA_M2((t)+2,tb_,mslot^1024); } \
    const u64 mw_=MLD(MOFF); \
    resc=false; \
    if(!NM){ if(__builtin_expect(__any(mhat!=0.f),0)){ _Pragma("unroll") for(int r=0;r<16;++r){C0[r]-=mhat;C1[r]-=mhat;} } \
      float a=MX3(C0[0],C0[1],C1[0]),b=MX3(C0[2],C0[3],C1[1]); a=MX3(a,C1[2],C1[3]); \
      _Pragma("unroll") for(int r=4;r<16;r+=4){a=MX3(a,C0[r],C0[r+1]);b=MX3(b,C0[r+2],C0[r+3]);a=MX3(a,C1[r],C1[r+1]);b=MX3(b,C1[r+2],C1[r+3]);} \
      float rm=__builtin_fmaxf(a,b); { auto rr=__builtin_amdgcn_permlane32_swap(__float_as_uint(rm),__float_as_uint(rm),false,false); rm=__builtin_fmaxf(__uint_as_float(rr[0]),__uint_as_float(rr[1])); } \
      resc=false; \
      if(__builtin_expect(__any(rm>(float)THRL),0)){ const float dl=__builtin_fmaxf(rm,0.f); mhat+=dl; \
        _Pragma("unroll") for(int r=0;r<16;++r){C0[r]-=dl;C1[r]-=dl;} \
        const float f=__builtin_amdgcn_exp2f(-dl); l_reg*=f; if(hi==0)wsf[r32]=f; resc=true; } } \
    MAPPLY(C0,C1,mw_); \
    SBAR(); \
    GAPB(o[0]=__builtin_amdgcn_mfma_f32_32x32x16_bf16(PAF(0),VFR(0),o[0],0,0,0), C0,0); \
    GAPB(o[1]=__builtin_amdgcn_mfma_f32_32x32x16_bf16(PAF(0),VFR(4),o[1],0,0,0), C0,4); \
    KRD(GL,0); GAPB(o[0]=__builtin_amdgcn_mfma_f32_32x32x16_bf16(PAF(1),VFR(1),o[0],0,0,0), C0,8); \
    KRD(GL,1); GAPB(o[1]=__builtin_amdgcn_mfma_f32_32x32x16_bf16(PAF(1),VFR(5),o[1],0,0,0), C0,12); \
    KRD(GL,2); GAPB(o[0]=__builtin_amdgcn_mfma_f32_32x32x16_bf16(PAF(2),VFR(2),o[0],0,0,0), C1,0); \
    KRD(GL,3); GAPB(o[1]=__builtin_amdgcn_mfma_f32_32x32x16_bf16(PAF(2),VFR(6),o[1],0,0,0), C1,4); \
    GAPB(o[0]=__builtin_amdgcn_mfma_f32_32x32x16_bf16(PAF(3),VFR(3),o[0],0,0,0), C1,8); \
    GAPB(o[1]=__builtin_amdgcn_mfma_f32_32x32x16_bf16(PAF(3),VFR(7),o[1],0,0,0), C1,12); \
    }while(0)
  int t=1; int mslot=0;
  for(;t+5<NT;t+=2){
    STEP(pB0,pB1,pA0,pA1,t,true,true,true,true,mslot);          WAIT_BAR(3); RESC(); ROT();
    STEP(pA0,pA1,pB0,pB1,t+1,true,true,true,false,mslot+256);   WAIT_BAR(2); RESC(); ROT(); mslot^=1024;
  }
  #define ENDW(nf) do{ if((nf)==3){WAIT_BAR(3);} else if((nf)==2){WAIT_BAR(2);} else if((nf)==1){WAIT_BAR(1);} else {WAIT_BAR(0);} }while(0)
  for(;t+1<NT;t+=2){
    { const bool gk=(t+3<NT),gv=(t+1<NT),gm=(t+2<NT); STEP(pB0,pB1,pA0,pA1,t,gk,gv,gv,gm,mslot);   ENDW((int)gk+(int)gv+(int)gm); RESC(); ROT(); }
    { const bool gk=(t+4<NT),gv=(t+2<NT);             STEP(pA0,pA1,pB0,pB1,t+1,gk,gv,gv,false,mslot+256); ENDW((t+3<NT)?((int)gk+(int)gv):0); RESC(); ROT(); mslot^=1024; }
  }
  STEP(pB0,pB1,pA0,pA1,NT-1,false,false,false,false,mslot); RESC();
  { float sacc=pB0[0]+pB0[1]; _Pragma("unroll") for(int r=2;r<16;++r)sacc+=pB0[r]; _Pragma("unroll") for(int r=0;r<16;++r)sacc+=pB1[r]; l_reg+=sacc;
    pw0=(u32x4){PKW(pB0,0),PKW(pB0,2),PKW(pB0,4),PKW(pB0,6)};pw1=(u32x4){PKW(pB0,8),PKW(pB0,10),PKW(pB0,12),PKW(pB0,14)};pw2=(u32x4){PKW(pB1,0),PKW(pB1,2),PKW(pB1,4),PKW(pB1,6)};pw3=(u32x4){PKW(pB1,8),PKW(pB1,10),PKW(pB1,12),PKW(pB1,14)};
    SBAR(); pv(o,vb0+sl_cur,PAF(0),PAF(1),PAF(2),PAF(3)); }
  #undef PKW
  #undef PAF
  #undef VFR
  #undef PIN
  #undef MX3
  #undef GAPA
  #undef GAPB
  #undef EX
  #undef VRD
  #undef KRD
  #undef STEP
  #undef ENDW
  {auto rr=__builtin_amdgcn_permlane32_swap(__float_as_uint(l_reg),__float_as_uint(l_reg),false,false);l_reg=__uint_as_float(rr[0])+__uint_as_float(rr[1]);}
  if(hi==0)wsf[32+r32]=l_reg;asm volatile("s_waitcnt lgkmcnt(0)":::"memory");
  float rli[16];
  #pragma unroll
  for(int r=0;r<16;++r)rli[r]=__builtin_amdgcn_rcpf(wsf[32+crow(r,hi)]);
  bf16*Ow=O+(rowbase+q0+wid*QBLK)*DMO+h*D;
  { bf16*stg=(bf16*)(shm+LDS_OST)+wid*2048;
    #pragma unroll
    for(int r=0;r<16;++r){const int orow=crow(r,hi);
      #pragma unroll
      for(int d0=0;d0<2;++d0)stg[orow*64+d0*32+r32]=__float2bfloat16(o[d0][r]*rli[r]);}
    asm volatile("s_waitcnt lgkmcnt(0)":::"memory");
    #pragma unroll
    for(int i=0;i<4;++i){const int row=i*8+(lane>>3),ch=lane&7; const u32x4 v=*(const u32x4*)(stg+row*64+ch*8); ATTN_STORE16(Ow+(long)row*DMO+ch*8,v);} }
  asm volatile("s_waitcnt lgkmcnt(0)\n\ts_barrier":::"memory");
  #undef DMA_K
  #undef DMA_V
  #undef DMA_M2
  #undef MAPPLY
  #undef MLD
  #undef START
  #undef RESC
  #undef ROT
}
constexpr int ATTN_LDS_BYTES=LDS_BYTES;
template<int THRL,bool NM> __device__ __forceinline__ void attn_phase(char*lds,const bf16*Q,const bf16*K,const bf16*V,const u64*MASK,bf16*O){
  const int G=gridDim.x;
  for(int w=blockIdx.x;w<256;w+=G){ const int h=w&7,s=w>>3; attn_unit<THRL,NM>(h,s,Q,K,V,MASK,O,lds); attn_unit<THRL,NM>(h,63-s,Q,K,V,MASK,O,lds); }
}
#undef SBAR
#undef WAIT_BAR
}

__device__ __forceinline__ void phase_route_naive(const Params& p, unsigned char* lds) {
    const int tid = opaque_tid(), lane = tid & 63, wave = tid >> 6;
    const int gw = blockIdx.x * NWAVES + wave, NGW = gridDim.x * NWAVES;
    const float* H2 = (const float*)(p.ws + WS_H2); const float* WGRT = (const float*)(p.ws + WS_WGRT);
    float* RSTD = (float*)(p.ws + WS_RSTD); int* TOKOF = (int*)(p.ws + WS_TOKOF); float* GATEOF = (float*)(p.ws + WS_GATEOF); int* PAIR = (int*)(p.ws + WS_PAIR);
    unsigned* CNT = (unsigned*)(p.ws + WS_CTL) + CW_CNT;
    for (int t = gw; t < S; t += NGW) {
        const f32x4* hr = (const f32x4*)(H2 + (size_t)t * D) + lane; f32x4 v[4]; float ss = 0.f;
#pragma unroll
        for (int j = 0; j < 4; ++j) { v[j] = hr[64 * j]; ss += v[j].x * v[j].x + v[j].y * v[j].y + v[j].z * v[j].z + v[j].w * v[j].w; }
        const float rstd = rsqrtf(wave_sum(ss) * (1.f / D) + EPS);
        float mine = -INFINITY;
        for (int e = 0; e < NE; ++e) { const f32x4* wr = (const f32x4*)(WGRT + (size_t)e * D) + lane; float a = 0.f;
#pragma unroll
            for (int j = 0; j < 4; ++j) { const f32x4 w = wr[64 * j]; a = fmaf(v[j].x, w.x, a); a = fmaf(v[j].y, w.y, a); a = fmaf(v[j].z, w.z, a); a = fmaf(v[j].w, w.w, a); }
            a = wave_sum(a); if (lane == e) mine = a * rstd + p.b_router[e]; }
        float tv[4]; int te[4];
#pragma unroll
        for (int k = 0; k < 4; ++k) { float bv = mine; int bi = lane;
#pragma unroll
            for (int o = 32; o >= 1; o >>= 1) { const float ov = __shfl_xor(bv, o); const int oi = __shfl_xor(bi, o); if (ov > bv || (ov == bv && oi < bi)) { bv = ov; bi = oi; } }
            tv[k] = bv; te[k] = bi; if (lane == bi) mine = -INFINITY; }
        float g[4], gs = 0.f;
#pragma unroll
        for (int k = 0; k < 4; ++k) { g[k] = __expf(tv[k] - tv[0]); gs += g[k]; }
        if (lane == 0) RSTD[t] = rstd;
        if (lane < 4) { const int e = lane == 0 ? te[0] : lane == 1 ? te[1] : lane == 2 ? te[2] : te[3]; const float gg = (lane == 0 ? g[0] : lane == 1 ? g[1] : lane == 2 ? g[2] : g[3]) / gs;
            const unsigned slot = atomicAdd(&CNT[e], 1u); TOKOF[e * S + slot] = t; GATEOF[e * S + slot] = gg; PAIR[t * 4 + lane] = (e << 16) | (int)slot; }
    }
}

__device__ __forceinline__ void phase_route_fast(const Params& p, unsigned char* lds) {
    typedef float f32x16 __attribute__((ext_vector_type(16)));
    const int tid = opaque_tid(), lane = tid & 63, wave = tid >> 6, j = lane & 31, kk = lane >> 5, tsel = wave >> 2, kq = wave & 3;
    const float* H2 = (const float*)(p.ws + WS_H2); const float* WGR = (const float*)(p.ws + WS_WGRT) + 65536;
    float* RSTD = (float*)(p.ws + WS_RSTD); int* TOKOF = (int*)(p.ws + WS_TOKOF); float* GATEOF = (float*)(p.ws + WS_GATEOF); int* PAIR = (int*)(p.ws + WS_PAIR);
    unsigned* CNT = (unsigned*)(p.ws + WS_CTL) + CW_CNT;
    LAS float* sc = (LAS float*)((LAS unsigned char*)lds + wave * 8192);
    for (int tp = blockIdx.x; tp < S / 64; tp += gridDim.x) {
        const int t0 = (tp * 2 + tsel) * 32;
        const float* arow = H2 + (size_t)(t0 + j) * D + kq * 256 + 4 * kk; const float* bcol = WGR + (kq * 256 + 4 * kk) * NE + j;
        f32x16 acc = f32x16{}; float ss = 0.f;
#pragma unroll 8
        for (int m = 0; m < 32; ++m) { const f32x4 a = *(const f32x4*)(arow + 8 * m);
            const float b0 = bcol[(8 * m + 0) * NE], b1 = bcol[(8 * m + 1) * NE], b2 = bcol[(8 * m + 2) * NE], b3 = bcol[(8 * m + 3) * NE];
            acc = __builtin_amdgcn_mfma_f32_32x32x2f32(a.x, b0, acc, 0, 0, 0); acc = __builtin_amdgcn_mfma_f32_32x32x2f32(a.y, b1, acc, 0, 0, 0);
            acc = __builtin_amdgcn_mfma_f32_32x32x2f32(a.z, b2, acc, 0, 0, 0); acc = __builtin_amdgcn_mfma_f32_32x32x2f32(a.w, b3, acc, 0, 0, 0);
            ss += a.x * a.x + a.y * a.y + a.z * a.z + a.w * a.w; }
        ss += __shfl_xor(ss, 32);
        __syncthreads();
#pragma unroll
        for (int r = 0; r < 16; ++r) sc[((r & 3) + 8 * (r >> 2) + 4 * kk) * 33 + j] = acc[r];
        if (kk == 0) sc[32 * 33 + j] = ss;
        __syncthreads();
        if (kq == 0) {
            const LAS float* s0 = sc, *s1 = sc + 2048, *s2 = sc + 4096, *s3 = sc + 6144;
            const float sst = s0[32 * 33 + j] + s1[32 * 33 + j] + s2[32 * 33 + j] + s3[32 * 33 + j];
            const float rstd = rsqrtf(sst * (1.f / D) + EPS);
            float v[32];
#pragma unroll
            for (int e = 0; e < 32; ++e) v[e] = ((s0[j * 33 + e] + s1[j * 33 + e]) + (s2[j * 33 + e] + s3[j * 33 + e])) * rstd + p.b_router[e];
            float tv[4]; int te[4]; unsigned taken = 0u;
#pragma unroll
            for (int k = 0; k < 4; ++k) { float best = -INFINITY; int bi = 0;
#pragma unroll
                for (int e = 0; e < 32; ++e) { const bool ok = !((taken >> e) & 1u) && (v[e] > best); best = ok ? v[e] : best; bi = ok ? e : bi; }
                tv[k] = best; te[k] = bi; taken |= 1u << bi; }
            float g[4], gs = 0.f;
#pragma unroll
            for (int k = 0; k < 4; ++k) { g[k] = __expf(tv[k] - tv[0]); gs += g[k]; }
            const float gi = 1.f / gs;
            const bool act = lane < 32; int rk[4] = {0, 0, 0, 0}; unsigned mycnt = 0u;
#pragma unroll 4
            for (int e = 0; e < 32; ++e) { const bool pick = act && ((taken >> e) & 1u); const u64 m = __ballot(pick); const int below = __popcll(m & ((1ull << lane) - 1ull));
                if (lane == e) mycnt = (unsigned)__popcll(m);
#pragma unroll
                for (int k = 0; k < 4; ++k) rk[k] = (te[k] == e) ? below : rk[k]; }
            unsigned base = 0u; if (act && mycnt) base = atomicAdd(&CNT[lane], mycnt);
#pragma unroll
            for (int k = 0; k < 4; ++k) { const unsigned be = (unsigned)__shfl((int)base, te[k]); if (act) { const int slot = (int)be + rk[k]; const int t = t0 + lane;
                    TOKOF[te[k] * S + slot] = t; GATEOF[te[k] * S + slot] = g[k] * gi; PAIR[t * 4 + k] = (te[k] << 16) | slot; } }
            if (act) RSTD[t0 + lane] = rstd;
        }
    }
}

__device__ __forceinline__ int build_tiles(const Params& p, unsigned char* lds) {
    int* pst = (int*)(lds + LDS_MISC); int* tile_e = pst + 40;
    const unsigned* CNT = (const unsigned*)(p.ws + WS_CTL) + CW_CNT;
    __syncthreads();
    if (opaque_tid() == 0) { int acc = 0; for (int e = 0; e < NE; ++e) { pst[e] = acc; const int c = (int)__hip_atomic_load(&CNT[e], __ATOMIC_RELAXED, __HIP_MEMORY_SCOPE_AGENT); pst[328 + e] = c; const int nt = (c + 255) >> 8; for (int i = 0; i < nt; ++i) tile_e[acc + i] = e; acc += nt; } pst[NE] = acc; }
    __syncthreads();
    return pst[NE];
}

__device__ __forceinline__ void phase_gather(const Params& p, unsigned char* lds) {
    const int tid = opaque_tid(), lane = tid & 63, wave = tid >> 6;
    const int gw = blockIdx.x * NWAVES + wave, NGW = gridDim.x * NWAVES;
    build_tiles(p, lds); const int* pst = (const int*)(lds + LDS_MISC);
    const bf16* XN2 = (const bf16*)(p.ws + WS_XN); bf16* XS = (bf16*)(p.ws + WS_XS); const int* PAIR = (const int*)(p.ws + WS_PAIR);
    const float* RSTD = (const float*)(p.ws + WS_RSTD); const float* GATEOF = (const float*)(p.ws + WS_GATEOF);
    float* ROWRSTD = (float*)(p.ws + WS_ROWRSTD); float* ROWGATE = (float*)(p.ws + WS_ROWGATE);
#if FUSED_GATHER
    int* ROWTOK = (int*)(p.ws + WS_ROWTOK); const int* tile_e = pst + 40; const unsigned* CNT = (const unsigned*)(p.ws + WS_CTL) + CW_CNT; (void)XN2; (void)XS; (void)lane; (void)gw; (void)NGW;
    for (int row = blockIdx.x * NTHREADS + tid; row < pst[NE] * 256; row += gridDim.x * NTHREADS) { const int e = tile_e[row >> 8]; if (row - pst[e] * 256 >= (int)CNT[e]) ROWTOK[row] = 0; }
    for (int pr = blockIdx.x * NTHREADS + tid; pr < S * 4; pr += gridDim.x * NTHREADS) { const int t = pr >> 2; const int pe = PAIR[pr]; const int e = pe >> 16, slot = pe & 0xffff; const int row = pst[e] * 256 + slot;
        ROWTOK[row] = t; ROWRSTD[row] = RSTD[t]; ROWGATE[row] = GATEOF[e * S + slot]; }
#else
    for (int pr0 = gw * 4; pr0 < S * 4; pr0 += NGW * 4) {
        int row[4]; u32x4 va[4], vb[4];
#pragma unroll
        for (int i = 0; i < 4; ++i) { const int pr = pr0 + i, t = pr >> 2; const int pe = PAIR[pr]; const int e = pe >> 16, slot = pe & 0xffff; row[i] = pst[e] * 256 + slot;
            const u32x4* src = (const u32x4*)(XN2 + (size_t)t * D); va[i] = src[lane]; vb[i] = src[lane + 64];
            if (lane == 0) { ROWRSTD[row[i]] = RSTD[t]; ROWGATE[row[i]] = GATEOF[e * S + slot]; } }
#pragma unroll
        for (int i = 0; i < 4; ++i) { u32x4* dst = (u32x4*)(XS + (size_t)row[i] * D); dst[lane] = va[i]; dst[lane + 64] = vb[i]; }
    }
#endif
}

__device__ __forceinline__ void phase_final(const Params& p, unsigned char* lds) {
    const int tid = opaque_tid(), lane = tid & 63, wave = tid >> 6;
    const int gw = blockIdx.x * NWAVES + wave, NGW = gridDim.x * NWAVES;
    build_tiles(p, lds); const int* pst = (const int*)(lds + LDS_MISC);
    const float* H2 = (const float*)(p.ws + WS_H2); const bf16* YS = (const bf16*)(p.ws + WS_YS); const int* PAIR = (const int*)(p.ws + WS_PAIR);
    for (int t = gw; t < S; t += NGW) {
        const f32x4* hr = (const f32x4*)(H2 + (size_t)t * D) + lane; f32x4 v[4];
#pragma unroll
        for (int j = 0; j < 4; ++j) v[j] = hr[64 * j];
#pragma unroll
        for (int k = 0; k < 4; ++k) { const int pe = PAIR[t * 4 + k]; const int row = pst[pe >> 16] * 256 + (pe & 0xffff); const uint2* yr = (const uint2*)(YS + (size_t)row * D) + lane;
#pragma unroll
            for (int j = 0; j < 4; ++j) { const uint2 y = yr[64 * j]; v[j].x += blo(y.x); v[j].y += bhi(y.x); v[j].z += blo(y.y); v[j].w += bhi(y.y); } }
        float ss = 0.f;
#pragma unroll
        for (int j = 0; j < 4; ++j) ss += v[j].x * v[j].x + v[j].y * v[j].y + v[j].z * v[j].z + v[j].w * v[j].w;
        const float rstd = rsqrtf(wave_sum(ss) * (1.f / D) + EPS);
        f32x4* o = (f32x4*)(p.out + (size_t)t * D) + lane;
#pragma unroll
        for (int j = 0; j < 4; ++j) { const f32x4 g = ((const f32x4*)p.norm_final_g)[lane + 64 * j]; o[64 * j] = (f32x4){v[j].x * rstd * g.x, v[j].y * rstd * g.y, v[j].z * rstd * g.z, v[j].w * rstd * g.w}; }
    }
}

#define GAS __attribute__((address_space(1)))
typedef GAS unsigned gu32;
#define XB_TMO      128
#define XB_XCNT(j)  (256  + 64 * (j))
#define XB_XSUB(j)  (1280 + 64 * (j))
#define XB_XGEN(j)  (2304 + 64 * (j))
#define XB_TOP      3328
#define XB_TOPGEN   3392
#define XCD_BAR_WORDS 3456
#define XB_SPIN_CAP (1u << 18)

__device__ __forceinline__ unsigned xb_ld(unsigned* p)              { return __hip_atomic_load(p, __ATOMIC_RELAXED, __HIP_MEMORY_SCOPE_AGENT); }
__device__ __forceinline__ unsigned xb_add(unsigned* p, unsigned v) { return __hip_atomic_fetch_add(p, v, __ATOMIC_RELAXED, __HIP_MEMORY_SCOPE_AGENT); }
__device__ __forceinline__ unsigned xb_xcc_id() { return (unsigned)__builtin_amdgcn_s_getreg((3 << 11) | 20) & 0xFu; }
#define XB_SPIN(cond, bar) do { unsigned _sp = 0; while (cond) { __builtin_amdgcn_s_sleep(1); \
    if ((++_sp & 255u) == 0u) { if (xb_ld(&(bar)[XB_TMO])) break; if (_sp > XB_SPIN_CAP) { atomicAdd(&(bar)[XB_TMO], 1u); break; } } } } while (0)

struct XcdBarrier {
    unsigned* bar; unsigned x;
    volatile LAS unsigned* st;
};

__device__ __forceinline__ XcdBarrier xcd_barrier_post(unsigned* bar, volatile LAS unsigned* st) {
    XcdBarrier b; b.bar = bar; b.x = xb_xcc_id(); b.st = st;
    if (threadIdx.x == 0) (void)xb_add(&bar[XB_XCNT(b.x)], 1u);
    return b;
}
__device__ __forceinline__ void xcd_barrier_complete(unsigned* bar, unsigned x, unsigned& nloc, unsigned& nx) {
    const unsigned G = gridDim.x * gridDim.y * gridDim.z;
    unsigned sum, cnt, mine, sp = 0u;
    for (;;) {
        sum = 0u; cnt = 0u; mine = 0u;
#pragma unroll
        for (unsigned j = 0; j < 16; ++j) { const unsigned c = xb_ld(&bar[XB_XCNT(j)]); sum += c; cnt += (c > 0u) ? 1u : 0u; mine = (j == x) ? c : mine; }
        if (sum == G) break;
        __builtin_amdgcn_s_sleep(1);
        if ((++sp & 255u) == 0u) { if (xb_ld(&bar[XB_TMO])) break; if (sp > XB_SPIN_CAP) { atomicAdd(&bar[XB_TMO], 1u); break; } }
    }
    nloc = mine > 0u ? mine : 1u; nx = cnt > 0u ? cnt : 1u;
}

__device__ __forceinline__ void xcd_barrier(const XcdBarrier& b) {
    asm volatile("s_waitcnt vmcnt(0)" ::: "memory");
    __syncthreads();
    if (threadIdx.x == 0) {
        unsigned* bar = b.bar;
        __builtin_amdgcn_s_waitcnt(0);
        unsigned nloc = b.st[0], nx = b.st[1];
        if (nloc == 0u) { xcd_barrier_complete(bar, b.x, nloc, nx); b.st[0] = nloc; b.st[1] = nx; }
        const unsigned old = xb_add(&bar[XB_XSUB(b.x)], 1u);
        const unsigned gen = old / nloc;
        if (old + 1u == (gen + 1u) * nloc) {
            __builtin_amdgcn_fence(__ATOMIC_RELEASE, "agent");
            asm volatile("s_waitcnt vmcnt(0)" ::: "memory");
            const unsigned og = xb_add(&bar[XB_TOP], 1u);
            const unsigned tg = og / nx;
            if (og + 1u == (tg + 1u) * nx) xb_add(&bar[XB_TOPGEN], 1u);
            else XB_SPIN(xb_ld(&bar[XB_TOPGEN]) == tg, bar);
            __builtin_amdgcn_fence(__ATOMIC_ACQUIRE, "agent");
            xb_add(&bar[XB_XGEN(b.x)], 1u);
            asm volatile("s_waitcnt vmcnt(0)" ::: "memory");
        } else {
            XB_SPIN(xb_ld(&bar[XB_XGEN(b.x)]) == gen, bar);
            __builtin_amdgcn_fence(__ATOMIC_ACQUIRE, "agent");
            asm volatile("s_waitcnt vmcnt(0)" ::: "memory");
        }
    }
    __syncthreads();
}

#ifndef FAST_GEMM
#define FAST_GEMM 1
#endif
#ifndef FAST_ATT
#define FAST_ATT 1
#endif
#ifndef FAST_IDX
#define FAST_IDX 1
#endif
#ifndef FAST_EW
#define FAST_EW 1
#endif
#ifndef FAST_ROUTE
#define FAST_ROUTE 1
#endif
#ifndef MERGED_MOE
#define MERGED_MOE 0
#endif
template <class F, class Sched>
__device__ __forceinline__ void run_gemm_gather(unsigned char* lds, const bf16* A, const bf16* Bt, int K, const Sched& S, const F& f) {
    pg8::Gemm g{A, Bt, 0, 0, K}; EpiAdapt<F> E{f};
    pg8::gemm_phase<EpiAdapt<F>, Sched, true, true, true>((LAS unsigned char*)lds, g, S, E);
    __syncthreads();
}
template <class F, class Sched>
__device__ __forceinline__ void run_gemm(unsigned char* lds, const bf16* A, const bf16* Bt, int K, const Sched& S, const F& f) {
#if FAST_GEMM
    pg8::Gemm g{A, Bt, 0, 0, K}; EpiAdapt<F> E{f};
    pg8::gemm_phase<EpiAdapt<F>, Sched, true, true>((LAS unsigned char*)lds, g, S, E);
#else
    Unit u;
    for (int i = 0; S.next(i, u); ++i) ngemm_unit(lds, A + (size_t)u.pm * 256 * K, K, Bt + (size_t)S.bidx(u) * 256 * K, K, K, f, u);
#endif
    __syncthreads();
}

#ifndef PROBE_MULT
#define PROBE_MULT 8
#endif
#if PROBE_PHASE >= 0
#define STAMP(i) do { if (blockIdx.x == 0 && opaque_tid() == 0) ((volatile LAS unsigned long long*)((LAS unsigned char*)lds + LDS_PROBE))[i] = __builtin_amdgcn_s_memrealtime(); } while (0)
#else
#define STAMP(i) do { } while (0)
#endif
__global__ void __launch_bounds__(NTHREADS, 2) fwd_kernel(Params p) {
    extern __shared__ __attribute__((aligned(16))) unsigned char lds[];
    cg::grid_group grid = cg::this_grid();
    const int G = gridDim.x, bx = blockIdx.x;
    const LAS int* tile_e = (const LAS int*)((LAS unsigned char*)lds + LDS_MISC) + 40;
    volatile LAS unsigned* bst = (volatile LAS unsigned*)((LAS unsigned char*)lds + LDS_MISC + 4096);
    if (opaque_tid() < 2) bst[opaque_tid()] = 0u;
    __syncthreads();
    const XcdBarrier xbar = xcd_barrier_post((unsigned*)(p.ws + WS_CTL) + CW_BAR, bst);
#if PROBE_PHASE >= 200
    if (opaque_tid() < 16) ((volatile LAS unsigned long long*)((LAS unsigned char*)lds + LDS_PROBE + 256))[opaque_tid()] = 0ull;
#endif
    STAMP(0);
    phase_prologue(p, lds);
    if (gridDim.y == 0xffffu) grid.sync();
    xcd_barrier(xbar);
    STAMP(1);
    { pg8::StaticOrder so; so.init(S, NP, G, bx); EpiProj E{(bf16*)(p.ws + WS_PROJ)};
        run_gemm(lds, (const bf16*)(p.ws + WS_XN), (const bf16*)(p.ws + WS_WINT), D, so, E); }
    xcd_barrier(xbar);
    STAMP(2);
#if FAST_EW
    phase_ew_fast(p, lds);
#else
    phase_ew_naive(p, lds);
#endif
    xcd_barrier(xbar);
    STAMP(3);
#if FAST_IDX
    idxf::idx_phase(p, lds);
    __syncthreads();
#else
    phase_idx_naive(p, lds);
#endif
    xcd_barrier(xbar);
    STAMP(4);
#if FAST_ATT
    {
        const int tid = opaque_tid(); const int hq = bx & 7, sq = (bx >> 3) & 31; const int row = ((tid < 256) ? sq : 63 - sq) * 256 + (tid & 255);
        const bf16* qp = (const bf16*)(p.ws + WS_PROJ) + (size_t)row * NP + C_Q + hq * 64; float q1 = 0.f;
#pragma unroll
        for (int j = 0; j < 8; ++j) { const u32x4 v = *(const u32x4*)(qp + j * 8); q1 += fabsf(blo(v.x)) + fabsf(bhi(v.x)) + fabsf(blo(v.y)) + fabsf(bhi(v.y)) + fabsf(blo(v.z)) + fabsf(bhi(v.z)) + fabsf(blo(v.w)) + fabsf(bhi(v.w)); }
        q1 = wave_max(q1); LAS float* qb = (LAS float*)((LAS unsigned char*)lds + LDS_MISC + 4224); if ((tid & 63) == 0) qb[tid >> 6] = q1;
        __syncthreads();
        float qm = qb[0];
#pragma unroll
        for (int w = 1; w < 8; ++w) qm = fmaxf(qm, qb[w]);
        const float kmaxel = *(const float*)((const unsigned*)(p.ws + WS_CTL) + CW_KMAX); const bool nomax = (G == 256) && (qm * kmaxel <= 96.f);
        const attn_body::bf16* PJ = (const attn_body::bf16*)(p.ws + WS_PROJ); const u64* MK = (const u64*)(p.ws + WS_MASK); attn_body::bf16* MO = (attn_body::bf16*)(p.ws + WS_MIX) + 512;
        if (nomax) attn_body::attn_phase<96, true>((char*)lds, PJ + C_Q, PJ + C_K, PJ + C_V, MK, MO);
        else attn_body::attn_phase<96, false>((char*)lds, PJ + C_Q, PJ + C_K, PJ + C_V, MK, MO); }
    __syncthreads();
#else
    phase_att_naive(p, lds);
#endif
    xcd_barrier(xbar);
    STAMP(5);
    { pg8::StaticOrder so; so.init(S, D, G, bx); EpiOut E{p.x, p.norm_ffn_g, (float*)(p.ws + WS_H2), (bf16*)(p.ws + WS_XN)};
        run_gemm(lds, (const bf16*)(p.ws + WS_MIX), (const bf16*)(p.ws + WS_WOUTT), D, so, E); }
    xcd_barrier(xbar);
    STAMP(6);
#if FAST_ROUTE
    phase_route_fast(p, lds);
#else
    phase_route_naive(p, lds);
#endif
    xcd_barrier(xbar);
    STAMP(7);
#if MERGED_MOE
    { const int ntile = build_tiles(p, lds); const LAS int* pst = (const LAS int*)((LAS unsigned char*)lds + LDS_MISC);
        MoeMerged mm; mm.so1.init(ntile * 256, 2048, G, bx); mm.so2.init(ntile * 256, D, G, bx); mm.tile_e = tile_e; mm.ltok = (const LAS int*)((LAS unsigned char*)lds + LDS_LTOK);
        mm.dep = (unsigned*)(p.ws + WS_CTL) + CW_DEP; mm.G = G; mm.c = bx; mm.n1 = 0;
        LAS int* lt = (LAS int*)((LAS unsigned char*)lds + LDS_LTOK); LAS float* lr0 = (LAS float*)((LAS unsigned char*)lds + LDS_LRS); LAS float* lr1 = (LAS float*)(lt + 10 * 256);
        { const int* TOKOF = (const int*)(p.ws + WS_TOKOF); const float* RSTD = (const float*)(p.ws + WS_RSTD); const float* GATEOF = (const float*)(p.ws + WS_GATEOF); Unit u; const int tid = opaque_tid();
            for (int i = 0; i < 15 && mm.next(i, u); ++i) { if (u.pn < 8) mm.n1 = i + 1;
                if (tid < 256) { const int e = tile_e[u.pm], slot = (u.pm - pst[e]) * 256 + tid; const bool valid = slot < pst[328 + e]; LAS float* lr = (i < 9) ? lr0 + i * 256 : lr1 + (i - 9) * 256;
                    if (u.pn < 8) { const int tok = valid ? TOKOF[e * S + slot] : 0; lt[i * 256 + tid] = tok; lr[tid] = valid ? RSTD[tok] : 0.f; }
                    else { lr[tid] = valid ? GATEOF[e * S + slot] : 0.f; if (tid == 0) lt[9 * 256 + i] = HDN_PSEUDO_TOK + u.pm * 256; } } }
            __syncthreads(); }
        EpiMoe E{p.b_gu, p.b_down, lr0, lr1, (bf16*)(p.ws + WS_HDN), (bf16*)(p.ws + WS_YS), tile_e};
        run_gemm_gather(lds, (const bf16*)(p.ws + WS_XN), (const bf16*)(p.ws + WS_WGUT), D, mm, E);
    }
    xcd_barrier(xbar);
    STAMP(8);
    STAMP(9);
#else
    { const int ntile = build_tiles(p, lds); const LAS int* pst = (const LAS int*)((LAS unsigned char*)lds + LDS_MISC);
        MoeOrder mo; mo.so.init(ntile * 256, 2048, G, bx); mo.tile_e = tile_e; mo.ncol = 8; mo.ltok = (const LAS int*)((LAS unsigned char*)lds + LDS_LTOK);
        EpiGU E{p.b_gu, (const LAS float*)((LAS unsigned char*)lds + LDS_LRS), (bf16*)(p.ws + WS_HDN), tile_e};
        { const int* TOKOF = (const int*)(p.ws + WS_TOKOF); const float* RSTD = (const float*)(p.ws + WS_RSTD); LAS int* lt = (LAS int*)((LAS unsigned char*)lds + LDS_LTOK); LAS float* lr = (LAS float*)((LAS unsigned char*)lds + LDS_LRS);
            Unit u; const int tid = opaque_tid();
            for (int i = 0; i < 9 && mo.next(i, u); ++i) if (tid < 256) { const int e = tile_e[u.pm], slot = (u.pm - pst[e]) * 256 + tid; const bool valid = slot < pst[328 + e];
                    const int tok = valid ? TOKOF[e * S + slot] : 0; lt[i * 256 + tid] = tok; lr[i * 256 + tid] = valid ? RSTD[tok] : 0.f; }
            __syncthreads(); }
        run_gemm_gather(lds, (const bf16*)(p.ws + WS_XN), (const bf16*)(p.ws + WS_WGUT), D, mo, E);
    }
    xcd_barrier(xbar);
    STAMP(8);
    { const int ntile = build_tiles(p, lds);
        MoeOrder mo; mo.so.init(ntile * 256, D, G, bx); mo.tile_e = tile_e; mo.ncol = 4; mo.ltok = nullptr; const LAS int* pst = (const LAS int*)((LAS unsigned char*)lds + LDS_MISC);
        EpiDown E{p.b_down, (const LAS float*)((LAS unsigned char*)lds + LDS_LRS), (bf16*)(p.ws + WS_YS), tile_e};
        { const float* GATEOF = (const float*)(p.ws + WS_GATEOF); LAS float* lg = (LAS float*)((LAS unsigned char*)lds + LDS_LRS); Unit u; const int tid = opaque_tid();
            for (int i = 0; i < 9 && mo.next(i, u); ++i) if (tid < 256) { const int e = tile_e[u.pm], slot = (u.pm - pst[e]) * 256 + tid; lg[i * 256 + tid] = (slot < pst[328 + e]) ? GATEOF[e * S + slot] : 0.f; }
            __syncthreads(); }
        run_gemm(lds, (const bf16*)(p.ws + WS_HDN), (const bf16*)(p.ws + WS_WDT), DE, mo, E); }
    xcd_barrier(xbar);
    STAMP(9);
#endif
    phase_final(p, lds);
#if PROBE_PHASE >= 0
    STAMP(10);
    if (blockIdx.x == 0 && opaque_tid() == 0) { volatile LAS unsigned long long* st = (volatile LAS unsigned long long*)((LAS unsigned char*)lds + LDS_PROBE);
#if PROBE_PHASE >= 200
        const unsigned long long dt = ((volatile LAS unsigned long long*)((LAS unsigned char*)lds + LDS_PROBE + 256))[PROBE_PHASE - 200], t0 = __builtin_amdgcn_s_memrealtime();
#elif PROBE_PHASE == 100 || PROBE_PHASE == 101
        const unsigned long long dt = 125ull * (unsigned long long)__hip_atomic_load((unsigned*)(p.ws + WS_CTL) + 2048, __ATOMIC_RELAXED, __HIP_MEMORY_SCOPE_AGENT), t0 = __builtin_amdgcn_s_memrealtime();
#else
        const unsigned long long dt = st[PROBE_PHASE + 1] - st[PROBE_PHASE], t0 = __builtin_amdgcn_s_memrealtime();
#endif
        while (__builtin_amdgcn_s_memrealtime() - t0 < (unsigned long long)PROBE_MULT * dt) __builtin_amdgcn_s_sleep(8); }
#endif
}

extern "C" void kernel_launch(void* const* d_in, const int* in_sizes, int n_in, void* d_out, int out_size, void* d_ws, size_t ws_size, hipStream_t stream) {
    static int grid = 0;
    if (grid == 0) {
        if (n_in != 19 || out_size != S * D || ws_size < WS_END) { fprintf(stderr, "kernel_launch: unexpected shapes (n_in %d out %d ws %zu)\n", n_in, out_size, ws_size); grid = -1; return; }
        int dev = 0, cus = 0, per_cu = 0;
        (void)hipGetDevice(&dev); (void)hipDeviceGetAttribute(&cus, hipDeviceAttributeMultiprocessorCount, dev);
        if (hipFuncSetAttribute((const void*)fwd_kernel, hipFuncAttributeMaxDynamicSharedMemorySize, LDS_BYTES) != hipSuccess) { fprintf(stderr, "kernel_launch: hipFuncSetAttribute failed\n"); grid = -1; return; }
        if (hipOccupancyMaxActiveBlocksPerMultiprocessor(&per_cu, (const void*)fwd_kernel, NTHREADS, LDS_BYTES) != hipSuccess || per_cu < 1) { fprintf(stderr, "kernel_launch: occupancy query says %d\n", per_cu); per_cu = 1; }
        (void)hipGetLastError();
        grid = cus * 1;
    }
    if (grid < 0) return;
    (void)hipMemsetAsync((char*)d_ws + WS_CTL, 0, CTL_BYTES, stream);
    Params p{};
    p.x = (const float*)d_in[0]; p.pos = (const int*)d_in[1]; p.norm_mix_g = (const float*)d_in[2]; p.w_in = (const float*)d_in[3]; p.idx_g = (const float*)d_in[4]; p.idx_b = (const float*)d_in[5];
    p.conv_w = (const float*)d_in[6]; p.conv_b = (const float*)d_in[7]; p.conv_ng = (const float*)d_in[8]; p.conv_nb = (const float*)d_in[9]; p.w_out = (const float*)d_in[10]; p.norm_ffn_g = (const float*)d_in[11];
    p.w_router = (const float*)d_in[12]; p.b_router = (const float*)d_in[13]; p.w_gu = (const float*)d_in[14]; p.b_gu = (const float*)d_in[15]; p.w_down = (const float*)d_in[16]; p.b_down = (const float*)d_in[17];
    p.norm_final_g = (const float*)d_in[18]; p.out = (float*)d_out; p.ws = (unsigned char*)d_ws;
    void* args[] = {&p};
    hipError_t e = hipLaunchCooperativeKernel((const void*)fwd_kernel, dim3(grid), dim3(NTHREADS), args, LDS_BYTES, stream);
    if (e != hipSuccess) fprintf(stderr, "cooperative launch failed: %s (grid %d)\n", hipGetErrorString(e), grid);
}
```

```cpp
#include <hip/hip_runtime.h>
#include <hip/hip_cooperative_groups.h>
#include <cstdio>
#include <cstdint>
#include <hip/hip_bf16.h>
#include <cmath>
namespace cg = cooperative_groups;
#ifndef FUSED_GATHER
#define FUSED_GATHER 1
#endif
#ifndef PROBE_PHASE
#define PROBE_PHASE (-1)
#endif

constexpr int S = 16384, D = 1024, NIN = 3144, NP = 3328;
constexpr int CC = 512, CW = 31, NH = 8, HD = 64, NE = 32, DE = 1024;
constexpr int C_VAL = 0, C_GATE = 512, C_Q = 1024, C_K = 1536, C_V = 2048, C_QI = 2560, C_KI = 3072, C_WI = 3136;
constexpr int KSEL = 256;
constexpr float EPS = 1e-5f;
constexpr float C2 = 0.125f * 1.4426950408889634f;
constexpr int NTHREADS = 512, NWAVES = 8;
constexpr int MAXROWS = 65536 + NE * 256;
constexpr int MAXTILES = MAXROWS / 256;

constexpr size_t MiB = 1u << 20;
constexpr size_t WS_CTL = 0, CTL_BYTES = 1 * MiB;
constexpr size_t WS_WINT = 2 * MiB;
constexpr size_t WS_WOUTT = 9 * MiB;
constexpr size_t WS_WGRT = 11 * MiB;
constexpr size_t WS_COS = 12 * MiB;
constexpr size_t WS_SIN = 14 * MiB;
constexpr size_t WS_WGUT = 16 * MiB;
constexpr size_t WS_WDT = 144 * MiB;
constexpr size_t WS_XN = 208 * MiB;
constexpr size_t WS_PROJ = 240 * MiB;
constexpr size_t WS_MIX = 344 * MiB;
constexpr size_t WS_KI = 376 * MiB;
constexpr size_t WS_QL = 378 * MiB;
constexpr size_t WS_WI = 380 * MiB;
constexpr size_t WS_RSTD = 381 * MiB;
constexpr size_t WS_TOKOF = 382 * MiB;
constexpr size_t WS_GATEOF = 384 * MiB;
constexpr size_t WS_PAIR = 386 * MiB;
constexpr size_t WS_ROWRSTD = 387 * MiB;
constexpr size_t WS_ROWGATE = 388 * MiB;
constexpr size_t WS_ROWTOK = 389 * MiB;
constexpr size_t WS_MASK = 392 * MiB;
constexpr size_t WS_H2 = 424 * MiB;
constexpr size_t WS_XS = 488 * MiB;
constexpr size_t WS_HDN = 632 * MiB;
constexpr size_t WS_YS = 776 * MiB;
constexpr size_t WS_END = 920 * MiB;
constexpr int CW_CNT = 1024;
constexpr int CW_BAR = 4096;
constexpr int CW_KMAX = 2052;

constexpr int LDS_BYTES = 163840;
constexpr int LDS_LTOK = 147456;
constexpr int LDS_MISC = 131072;
constexpr int LDS_LRS = LDS_MISC + 4608;
constexpr int LDS_PROBE = LDS_MISC + 14336;

#define LAS __attribute__((address_space(3)))
typedef unsigned short bf16;
typedef unsigned long long u64;
typedef float f32x4 __attribute__((ext_vector_type(4)));
typedef unsigned u32x4 __attribute__((ext_vector_type(4)));

__device__ __forceinline__ float bf2f(unsigned v) { return __uint_as_float(v << 16); }
__device__ __forceinline__ unsigned f2bf(float f) { unsigned u = __float_as_uint(f); return (u + 0x7fffu + ((u >> 16) & 1u)) >> 16; }
typedef float f32x2_pk __attribute__((ext_vector_type(2))); typedef __bf16 bf16x2_pk __attribute__((ext_vector_type(2)));
__device__ __forceinline__ unsigned pk2(float lo, float hi) { const f32x2_pk v = {lo, hi}; return __builtin_bit_cast(unsigned, __builtin_convertvector(v, bf16x2_pk)); }
__device__ __forceinline__ float blo(unsigned w) { return __uint_as_float(w << 16); }
__device__ __forceinline__ float bhi(unsigned w) { return __uint_as_float(w & 0xffff0000u); }
__device__ __forceinline__ float wave_sum(float v) {
#pragma unroll
    for (int o = 1; o < 64; o <<= 1) v += __shfl_xor(v, o);
    return v;
}
__device__ __forceinline__ float wave_max(float v) {
#pragma unroll
    for (int o = 1; o < 64; o <<= 1) v = fmaxf(v, __shfl_xor(v, o));
    return v;
}
__device__ __forceinline__ int opaque_tid() { int t = threadIdx.x; asm volatile("" : "+v"(t)); return t; }
#if PROBE_PHASE >= 200
#define ISEC(k) do { __syncthreads(); if (blockIdx.x == 0 && tid == 0) { volatile LAS unsigned long long* st_ = (volatile LAS unsigned long long*)((LAS unsigned char*)lds + LDS_PROBE + 256); const unsigned long long now_ = __builtin_amdgcn_s_memrealtime(); st_[k] += now_ - st_[15]; st_[15] = now_; } } while (0)
#else
#define ISEC(k) do { } while (0)
#endif
__device__ __forceinline__ float sigmoidf_(float x) { return __builtin_amdgcn_rcpf(1.f + __expf(-x)); }

struct Params {
    const float* x; const int* pos; const float* norm_mix_g; const float* w_in; const float* idx_g; const float* idx_b;
    const float* conv_w; const float* conv_b; const float* conv_ng; const float* conv_nb; const float* w_out; const float* norm_ffn_g;
    const float* w_router; const float* b_router; const float* w_gu; const float* b_gu; const float* w_down; const float* b_down;
    const float* norm_final_g; float* out; unsigned char* ws;
};

__device__ __forceinline__ void transpose_item(const float* W, int K, int N, bf16* WT, int dst_row0, int k0, int n0, float* scr, int lane) {
    float v[32]; const int n = n0 + (lane & 31); const float* src = W + (size_t)(k0 + (lane >> 5)) * N + n;
#pragma unroll
    for (int i = 0; i < 32; ++i) v[i] = (n < N) ? src[(size_t)(2 * i) * N] : 0.f;
#pragma unroll
    for (int i = 0; i < 32; ++i) scr[(2 * i + (lane >> 5)) * 33 + (lane & 31)] = v[i];
    asm volatile("s_waitcnt lgkmcnt(0)" ::: "memory");
    const int c = lane & 7;
#pragma unroll
    for (int j = 0; j < 4; ++j) { const int nn = (lane >> 3) + 8 * j; const float* s = scr + (8 * c) * 33 + nn;
        u32x4 o; o.x = pk2(s[0 * 33], s[1 * 33]); o.y = pk2(s[2 * 33], s[3 * 33]); o.z = pk2(s[4 * 33], s[5 * 33]); o.w = pk2(s[6 * 33], s[7 * 33]);
        *(u32x4*)(WT + (size_t)(dst_row0 + nn) * K + k0 + 8 * c) = o; }
    asm volatile("s_waitcnt lgkmcnt(0)" ::: "memory");
}

__device__ __forceinline__ void phase_prologue(const Params& p, unsigned char* lds) {
    const int tid = opaque_tid(), lane = tid & 63, wave = tid >> 6;
    const int gw = blockIdx.x * NWAVES + wave, NGW = gridDim.x * NWAVES;
    float* scr = (float*)(lds + wave * 16384);
    bf16* WinT = (bf16*)(p.ws + WS_WINT); bf16* WoutT = (bf16*)(p.ws + WS_WOUTT); bf16* WguT = (bf16*)(p.ws + WS_WGUT); bf16* WdT = (bf16*)(p.ws + WS_WDT);
    constexpr int I_IN = 16 * (NP / 32), I_OUT = 16 * 32, I_GU = 16 * 64, I_DN = 16 * 32;
    constexpr int NITEMS = I_IN + I_OUT + NE * I_GU + NE * I_DN;
    for (int it = gw; it < NITEMS; it += NGW) {
        int r = it;
        if (r < I_IN) { const int nb = r % (NP / 32), kb = r / (NP / 32); transpose_item(p.w_in, D, NIN, WinT, nb * 32, kb * 64, nb * 32, scr, lane); continue; }
        r -= I_IN;
        if (r < I_OUT) { const int nb = r % 32, kb = r / 32; transpose_item(p.w_out, D, D, WoutT, nb * 32, kb * 64, nb * 32, scr, lane); continue; }
        r -= I_OUT;
        if (r < NE * I_GU) { const int e = r / I_GU, q = r % I_GU, nb = q % 64, kb = q / 64; const int n0 = nb * 32;
            const int c = n0 & 1023, isu = n0 >> 10; const int drow = e * 2048 + (c >> 7) * 256 + isu * 128 + (c & 127);
            transpose_item(p.w_gu + (size_t)e * D * 2048, D, 2048, WguT, drow - 0, kb * 64, n0, scr, lane);
            continue; }
        r -= NE * I_GU;
        { const int e = r / I_DN, q = r % I_DN, nb = q % 32, kb = q / 32;
            transpose_item(p.w_down + (size_t)e * DE * D, DE, D, WdT, e * D + nb * 32, kb * 64, nb * 32, scr, lane); }
    }
    for (int i = blockIdx.x * NTHREADS + tid; i < NE * D; i += gridDim.x * NTHREADS) { const int e = i / D, k = i % D; ((float*)(p.ws + WS_WGRT))[i] = p.norm_ffn_g[k] * p.w_router[k * NE + e]; }
    for (int i = blockIdx.x * NTHREADS + tid; i < NE * D; i += gridDim.x * NTHREADS) { const int k = i / NE; ((float*)(p.ws + WS_WGRT))[65536 + i] = p.norm_ffn_g[k] * p.w_router[i]; }
    for (int i = blockIdx.x * NTHREADS + tid; i < S * 32; i += gridDim.x * NTHREADS) { const int t = i >> 5, j = i & 31;
        const float inv = powf(10000.f, -(float)j / 32.f); const float ang = (float)p.pos[t] * inv;
        double xr = (double)ang * 0.15915494309189535; xr -= floor(xr); const float xf = (float)xr;
        ((float*)(p.ws + WS_COS))[i] = __builtin_amdgcn_cosf(xf); ((float*)(p.ws + WS_SIN))[i] = __builtin_amdgcn_sinf(xf); }
    bf16* XN = (bf16*)(p.ws + WS_XN);
    for (int m = gw; m < S; m += NGW) {
        const f32x4* xr = (const f32x4*)(p.x + (size_t)m * D) + lane; f32x4 v[4]; float ss = 0.f;
#pragma unroll
        for (int j = 0; j < 4; ++j) { v[j] = xr[64 * j]; ss += v[j].x * v[j].x + v[j].y * v[j].y + v[j].z * v[j].z + v[j].w * v[j].w; }
        const float rstd = rsqrtf(wave_sum(ss) * (1.f / D) + EPS);
        u64* o8 = (u64*)(XN + (size_t)m * D) + lane;
#pragma unroll
        for (int j = 0; j < 4; ++j) { const f32x4 g = ((const f32x4*)p.norm_mix_g)[lane + 64 * j];
            o8[64 * j] = (u64)pk2(v[j].x * rstd * g.x, v[j].y * rstd * g.y) | ((u64)pk2(v[j].z * rstd * g.z, v[j].w * rstd * g.w) << 32); }
    }
}

namespace pg8 {
#define PG8_LAS __attribute__((address_space(3)))
typedef unsigned short bf16_t;
typedef short bf16x8 __attribute__((ext_vector_type(8)));
typedef float f32x4 __attribute__((ext_vector_type(4)));
typedef unsigned u32x4 __attribute__((ext_vector_type(4)));
constexpr int BM = 256, BK = 64, HALF = 128, HTB = HALF * BK * 2  , STAGE_BYTES = 8 * HTB, NXCD = 8, WGM = 8;

__host__ __device__ __forceinline__ int lds_byte(int r, int c) { const int st = (r >> 4) * 2 + (c >> 5), rr = r & 15, cc = c & 31, ob = rr * 64 + cc * 2; return st * 1024 + (ob ^ (((ob >> 9) & 1) << 5)); }
__host__ __device__ __forceinline__ void stage_rc(int b, int& R, int& C) { const int st = b / 1024, sb = b % 1024, swz = sb ^ (((sb >> 9) & 1) << 5); R = (st >> 1) * 16 + swz / 64; C = (st & 1) * 32 + (swz % 64) / 2; }
__host__ __device__ __forceinline__ int perm32(int rho) { const int n = rho >> 4, i = rho & 15; return 8 * (i >> 2) + 4 * n + (i & 3); }

struct Unit { int pm, pn, ui; };
struct Gemm { const bf16_t* A; const bf16_t* Bt; int M, N, K; };

struct StaticOrder {
    int nM, nN, nwg, G, c;
    __host__ __device__ void init(int M, int N, int G_, int c_) { nM = M / BM; nN = N / BM; nwg = nM * nN; G = G_; c = c_; }
    __host__ __device__ bool next(int i, Unit& u) const { const long L = (long)i * G + c; if (!map(L, u)) return false; u.ui = i; return true; }
    __host__ __device__ bool map(long L, Unit& u) const {
        if (L >= nwg) return false;
        int wgid = (int)L; { const int q = nwg / NXCD, r = nwg % NXCD, xcd = wgid % NXCD, off = wgid / NXCD; wgid = (xcd < r ? xcd * (q + 1) : r * (q + 1) + (xcd - r) * q) + off; }
        const int nig = WGM * nN, gid = wgid / nig, fm = gid * WGM, gsz = (nM - fm) < WGM ? (nM - fm) : WGM;
        u.pm = fm + ((wgid % nig) % gsz); u.pn = (wgid % nig) / gsz; u.ui = 0; return true;
    }
    __device__ __forceinline__ int bidx(const Unit& u) const { return u.pn; }
    __device__ __forceinline__ void a_ready(const Unit&) const {}
    __device__ __forceinline__ void done(const Unit&) const {}
};
template <class Epi, class Sched, bool ALIGN_EPI = false, bool SP2 = false, bool GATHER = false>
__device__ __forceinline__ void gemm_phase(PG8_LAS unsigned char* lds, const Gemm g, const Sched& S, const Epi& E) {
    static_assert(!GATHER || SP2, "GATHER is written for the SP2 loop");
    int tid_ = threadIdx.x; asm volatile("" : "+v"(tid_));
    const int tid = tid_, wid = __builtin_amdgcn_readfirstlane(tid >> 6), lane = tid & 63, wr = wid >> 2, wc = wid & 3, fr = lane & 15, fq = lane >> 4;
    const int K = g.K, nt = K / BK;
    unsigned voffA[2], voffB[2], gC[2]; int gR[2];
#pragma unroll
    for (int i = 0; i < 2; ++i) { int R, C; stage_rc(tid * 16 + i * 8192, R, C); const int Rb = Epi::PERM ? ((R & ~31) + perm32(R & 31)) : R;
        voffA[i] = (unsigned)(R * K + C) * 2u; voffB[i] = (unsigned)(Rb * K + C) * 2u; gR[i] = R; gC[i] = (unsigned)C * 2u; }
    unsigned vc[2][2] = {{0u, 0u}, {0u, 0u}}, vn[2][2] = {{0u, 0u}, {0u, 0u}};
#define PG8_GOFF(dst, uidx) do { _Pragma("unroll") for (int h_ = 0; h_ < 2; ++h_) _Pragma("unroll") for (int i_ = 0; i_ < 2; ++i_) dst[h_][i_] = (unsigned)S.rowtok((uidx), h_ * 128 + gR[i_]) * (unsigned)(K * 2) + gC[i_]; } while (0)
    const size_t kstep = (size_t)(BK * 2);
    const size_t hstep = (size_t)HALF * K * 2;
    const size_t tstep = 2 * hstep;
    const unsigned ldsw = (unsigned)wid * 1024u;
    const int aoff = lds_byte(wr * 64 + fr, fq * 8), boff = lds_byte(wc * 32 + fr, fq * 8);
#define PG8_SA(b, h) (((b) * 2 + (h)) * HTB)
#define PG8_SB(b, h) ((4 + (b) * 2 + (h)) * HTB)
#define PG8_STAGE(bufoff, gbase, voff) do { _Pragma("unroll") for (int _i = 0; _i < 2; ++_i) \
        __builtin_amdgcn_global_load_lds((const unsigned*)((const char*)(gbase) + (voff)[_i]), (PG8_LAS unsigned*)(lds + (bufoff) + ldsw + _i * 8192), 16, 0, 0); } while (0)
#define PG8_STAGE_AG(bufoff, kb, v0, v1) do { \
        __builtin_amdgcn_global_load_lds((const unsigned*)((const char*)g.A + (kb) + (v0)), (PG8_LAS unsigned*)(lds + (bufoff) + ldsw), 16, 0, 0); \
        __builtin_amdgcn_global_load_lds((const unsigned*)((const char*)g.A + (kb) + (v1)), (PG8_LAS unsigned*)(lds + (bufoff) + ldsw + 8192), 16, 0, 0); } while (0)
#define PG8_LDA(dst, b, h) do { _Pragma("unroll") for (int m = 0; m < 4; ++m) _Pragma("unroll") for (int k = 0; k < 2; ++k) dst[m][k] = *(const PG8_LAS bf16x8*)(lds + PG8_SA(b, h) + aoff + m * 2048 + k * 1024); } while (0)
#define PG8_LDB(dst, b, h) do { _Pragma("unroll") for (int n = 0; n < 2; ++n) _Pragma("unroll") for (int k = 0; k < 2; ++k) dst[n][k] = *(const PG8_LAS bf16x8*)(lds + PG8_SB(b, h) + boff + n * 2048 + k * 1024); } while (0)
#define PG8_MMA(ai, bj, At, Bt) do { __builtin_amdgcn_s_setprio(1); _Pragma("unroll") for (int m = 0; m < 4; ++m) _Pragma("unroll") for (int n = 0; n < 2; ++n) _Pragma("unroll") for (int k = 0; k < 2; ++k) \
        acc[ai][bj][m][n] = __builtin_amdgcn_mfma_f32_16x16x32_bf16(Bt[n][k], At[m][k], acc[ai][bj][m][n], 0, 0, 0); __builtin_amdgcn_s_setprio(0); } while (0)
#define PG8_WAIT_V(n) asm volatile("s_waitcnt vmcnt(" #n ")" ::: "memory")
#define PG8_WAIT_L(n) asm volatile("s_waitcnt lgkmcnt(" #n ")" ::: "memory")
#define PG8_BAR __builtin_amdgcn_s_barrier()
#define PG8_SCHED __builtin_amdgcn_sched_barrier(0)
    Unit cur, nxt; int ui = 0;
    if (!S.next(0, cur)) return;
    f32x4 acc[2][2][4][2];
#pragma unroll
    for (int a = 0; a < 2; ++a)
#pragma unroll
        for (int b = 0; b < 2; ++b)
#pragma unroll
            for (int m = 0; m < 4; ++m)
#pragma unroll
                for (int n = 0; n < 2; ++n) acc[a][b][m][n] = (f32x4){0.f, 0.f, 0.f, 0.f};
    bf16x8 At[4][2], B0[2][2], B1[2][2];
    const char* cA = (const char*)g.A + (size_t)cur.pm * tstep; const char* cB = (const char*)g.Bt + (size_t)S.bidx(cur) * tstep;
    S.a_ready(cur);
    if constexpr (SP2) {
        if constexpr (GATHER) { PG8_GOFF(vc, 0); }
        PG8_STAGE(PG8_SB(0, 0), cB, voffB); PG8_STAGE(PG8_SB(0, 1), cB + hstep, voffB);
        if constexpr (GATHER) { PG8_STAGE_AG(PG8_SA(0, 0), (size_t)0, vc[0][0], vc[0][1]); PG8_STAGE_AG(PG8_SA(0, 1), (size_t)0, vc[1][0], vc[1][1]); } else { PG8_STAGE(PG8_SA(0, 0), cA, voffA); PG8_STAGE(PG8_SA(0, 1), cA + hstep, voffA); }
        if (wr == 1) PG8_BAR;
        PG8_WAIT_V(2); PG8_BAR;
        PG8_STAGE(PG8_SB(1, 0), cB + kstep, voffB); if constexpr (GATHER) { PG8_STAGE_AG(PG8_SA(1, 0), kstep, vc[0][0], vc[0][1]); } else { PG8_STAGE(PG8_SA(1, 0), cA + kstep, voffA); } PG8_STAGE(PG8_SB(1, 1), cB + hstep + kstep, voffB);
        PG8_WAIT_V(6); PG8_BAR;
    } else {
        PG8_STAGE(PG8_SB(0, 0), cB, voffB); PG8_STAGE(PG8_SA(0, 0), cA, voffA); PG8_STAGE(PG8_SB(0, 1), cB + hstep, voffB); PG8_STAGE(PG8_SA(0, 1), cA + hstep, voffA);
        if (wr == 1) PG8_BAR;
        PG8_WAIT_V(4); PG8_BAR;
        PG8_STAGE(PG8_SB(1, 0), cB + kstep, voffB); PG8_STAGE(PG8_SA(1, 0), cA + kstep, voffA); PG8_STAGE(PG8_SB(1, 1), cB + hstep + kstep, voffB);
        PG8_WAIT_V(6); PG8_BAR;
    }
    for (;;) {
        const bool has_next = S.next(ui + 1, nxt);
        if constexpr (GATHER) { if (has_next) { PG8_GOFF(vn, ui + 1); } }
        const char* nA = has_next ? (const char*)g.A + (size_t)nxt.pm * tstep : cA; const char* nB = has_next ? (const char*)g.Bt + (size_t)S.bidx(nxt) * tstep : cB;
        for (int t = 0; t < nt; t += 2) {
            const bool last = (t == nt - 2);
            const char* a1 = cA + (size_t)(t + 1) * kstep;
            const char* a2 = last ? nA : cA + (size_t)(t + 2) * kstep; const char* b2 = last ? nB : cB + (size_t)(t + 2) * kstep;
            const char* a3 = a2 + kstep; const char* b3 = b2 + kstep;
            if (last && has_next) S.a_ready(nxt);
            const bool un_ = last && has_next; const size_t k1_ = (size_t)(t + 1) * kstep, k2_ = last ? (size_t)0 : (size_t)(t + 2) * kstep, k3_ = k2_ + kstep;
            const unsigned w00 = un_ ? vn[0][0] : vc[0][0], w01 = un_ ? vn[0][1] : vc[0][1], w10 = un_ ? vn[1][0] : vc[1][0], w11 = un_ ? vn[1][1] : vc[1][1];
            if constexpr (SP2) {
            PG8_LDB(B0, 0, 0); PG8_LDB(B1, 0, 1); PG8_SCHED; PG8_LDA(At, 0, 0); if constexpr (GATHER) { PG8_STAGE_AG(PG8_SA(1, 1), k1_, vc[1][0], vc[1][1]); } else { PG8_STAGE(PG8_SA(1, 1), a1 + hstep, voffA); }
            PG8_WAIT_V(8); PG8_WAIT_L(0); PG8_BAR; PG8_MMA(0, 0, At, B0); PG8_MMA(0, 1, At, B1); PG8_BAR; PG8_SCHED;
            PG8_LDA(At, 0, 1); PG8_STAGE(PG8_SB(0, 0), b2, voffB); PG8_STAGE(PG8_SB(0, 1), b2 + hstep, voffB); if constexpr (GATHER) { PG8_STAGE_AG(PG8_SA(0, 0), k2_, w00, w01); } else { PG8_STAGE(PG8_SA(0, 0), a2, voffA); }
            PG8_WAIT_V(8); PG8_WAIT_L(0); PG8_BAR; PG8_MMA(1, 0, At, B0); PG8_MMA(1, 1, At, B1); PG8_BAR; PG8_SCHED;
            PG8_LDB(B0, 1, 0); PG8_LDB(B1, 1, 1); PG8_SCHED; PG8_LDA(At, 1, 0); if constexpr (GATHER) { PG8_STAGE_AG(PG8_SA(0, 1), k2_, w10, w11); } else { PG8_STAGE(PG8_SA(0, 1), a2 + hstep, voffA); }
            PG8_WAIT_V(8); PG8_WAIT_L(0); PG8_BAR; PG8_MMA(0, 0, At, B0); PG8_MMA(0, 1, At, B1); PG8_BAR; PG8_SCHED;
            PG8_LDA(At, 1, 1); PG8_STAGE(PG8_SB(1, 0), b3, voffB); PG8_STAGE(PG8_SB(1, 1), b3 + hstep, voffB); if constexpr (GATHER) { PG8_STAGE_AG(PG8_SA(1, 0), k3_, w00, w01); } else { PG8_STAGE(PG8_SA(1, 0), a3, voffA); }
            PG8_WAIT_V(8); PG8_WAIT_L(0); PG8_BAR; PG8_MMA(1, 0, At, B0); PG8_MMA(1, 1, At, B1); PG8_BAR; PG8_SCHED;
            } else {
            PG8_LDB(B0, 0, 0); PG8_SCHED; PG8_LDA(At, 0, 0); PG8_STAGE(PG8_SA(1, 1), a1 + hstep, voffA);
            PG8_WAIT_L(8); PG8_BAR; PG8_WAIT_L(0); PG8_MMA(0, 0, At, B0); PG8_BAR; PG8_SCHED;
            PG8_LDB(B1, 0, 1); PG8_STAGE(PG8_SB(0, 0), b2, voffB);
            PG8_BAR; PG8_WAIT_L(0); PG8_MMA(0, 1, At, B1); PG8_BAR;
            PG8_LDA(At, 0, 1); PG8_STAGE(PG8_SA(0, 0), a2, voffA);
            PG8_BAR; PG8_WAIT_L(0); PG8_MMA(1, 0, At, B0); PG8_BAR; PG8_SCHED;
            PG8_STAGE(PG8_SB(0, 1), b2 + hstep, voffB);
            PG8_WAIT_V(6); PG8_BAR; PG8_MMA(1, 1, At, B1); PG8_BAR;
            PG8_LDB(B0, 1, 0); PG8_SCHED; PG8_LDA(At, 1, 0); PG8_STAGE(PG8_SA(0, 1), a2 + hstep, voffA);
            PG8_WAIT_L(8); PG8_BAR; PG8_WAIT_L(0); PG8_MMA(0, 0, At, B0); PG8_BAR; PG8_SCHED;
            PG8_LDB(B1, 1, 1); PG8_STAGE(PG8_SB(1, 0), b3, voffB);
            PG8_BAR; PG8_WAIT_L(0); PG8_MMA(0, 1, At, B1); PG8_BAR;
            PG8_LDA(At, 1, 1); PG8_STAGE(PG8_SA(1, 0), a3, voffA);
            PG8_BAR; PG8_WAIT_L(0); PG8_MMA(1, 0, At, B0); PG8_BAR; PG8_SCHED;
            PG8_STAGE(PG8_SB(1, 1), b3 + hstep, voffB);
            PG8_WAIT_V(6); PG8_BAR; PG8_MMA(1, 1, At, B1); PG8_BAR;
            }
        }
        if constexpr (ALIGN_EPI) { if (wr == 0) PG8_BAR; }
        if constexpr (!Epi::AFTER_DRAIN) { E(acc, cur, wr, wc, fr, fq); S.done(cur); }
        if (!has_next) break;
#pragma unroll
        for (int a = 0; a < 2; ++a)
#pragma unroll
            for (int b = 0; b < 2; ++b)
#pragma unroll
                for (int m = 0; m < 4; ++m)
#pragma unroll
                    for (int n = 0; n < 2; ++n) acc[a][b][m][n] = (f32x4){0.f, 0.f, 0.f, 0.f};
        cur = nxt; cA = nA; cB = nB; ++ui;
        if constexpr (GATHER) { vc[0][0] = vn[0][0]; vc[0][1] = vn[0][1]; vc[1][0] = vn[1][0]; vc[1][1] = vn[1][1]; }
        if constexpr (ALIGN_EPI) { if (wr == 1) PG8_BAR; }
    }
    PG8_WAIT_V(0);
    if constexpr (!ALIGN_EPI) { if (wr == 0) PG8_BAR; }
    PG8_BAR;
    if constexpr (Epi::AFTER_DRAIN) { E.fused(acc, cur, wr, wc, fr, fq, lds, wid, lane); S.done(cur); }
#undef PG8_SA
#undef PG8_SB
#undef PG8_STAGE
#undef PG8_LDA
#undef PG8_STAGE_AG
#undef PG8_GOFF
#undef PG8_LDB
#undef PG8_MMA
#undef PG8_WAIT_V
#undef PG8_WAIT_L
#undef PG8_BAR
#undef PG8_SCHED
}
}

template <class Epi>
__device__ __forceinline__ void ngemm_unit(unsigned char* lds, const bf16* A, int lda, const bf16* Bt, int ldb, int K, const Epi& epi, const pg8::Unit& u) {
    float* As = (float*)lds; float* Bs = As + 32 * 256;
    const int tid = opaque_tid(), tr = tid >> 4, tc = tid & 15;
    float acc0[8][8], acc1[8][8];
#pragma unroll
    for (int i = 0; i < 8; ++i)
#pragma unroll
        for (int j = 0; j < 8; ++j) { acc0[i][j] = 0.f; acc1[i][j] = 0.f; }
    for (int k0 = 0; k0 < K; k0 += 32) {
        __syncthreads();
#pragma unroll
        for (int j = 0; j < 2; ++j) { const int pidx = tid + 512 * j, r = pidx & 255, kq = pidx >> 8;
            const u32x4 va = *(const u32x4*)(A + (size_t)r * lda + k0 + kq * 8);
            const u32x4 vb = *(const u32x4*)(Bt + (size_t)r * ldb + k0 + kq * 8);
            float* ap = As + (kq * 8) * 256 + r; float* bp = Bs + (kq * 8) * 256 + r;
            ap[0 * 256] = blo(va.x); ap[1 * 256] = bhi(va.x); ap[2 * 256] = blo(va.y); ap[3 * 256] = bhi(va.y); ap[4 * 256] = blo(va.z); ap[5 * 256] = bhi(va.z); ap[6 * 256] = blo(va.w); ap[7 * 256] = bhi(va.w);
            bp[0 * 256] = blo(vb.x); bp[1 * 256] = bhi(vb.x); bp[2 * 256] = blo(vb.y); bp[3 * 256] = bhi(vb.y); bp[4 * 256] = blo(vb.z); bp[5 * 256] = bhi(vb.z); bp[6 * 256] = blo(vb.w); bp[7 * 256] = bhi(vb.w); }
        __syncthreads();
#pragma unroll 2
        for (int kk = 0; kk < 32; ++kk) {
            const f32x4 a0 = *(const f32x4*)(As + kk * 256 + tr * 8), a1 = *(const f32x4*)(As + kk * 256 + tr * 8 + 4);
            const f32x4 b00 = *(const f32x4*)(Bs + kk * 256 + tc * 8), b01 = *(const f32x4*)(Bs + kk * 256 + tc * 8 + 4);
            const f32x4 b10 = *(const f32x4*)(Bs + kk * 256 + 128 + tc * 8), b11 = *(const f32x4*)(Bs + kk * 256 + 128 + tc * 8 + 4);
            const float a[8] = {a0.x, a0.y, a0.z, a0.w, a1.x, a1.y, a1.z, a1.w};
            const float b0[8] = {b00.x, b00.y, b00.z, b00.w, b01.x, b01.y, b01.z, b01.w};
            const float b1[8] = {b10.x, b10.y, b10.z, b10.w, b11.x, b11.y, b11.z, b11.w};
#pragma unroll
            for (int i = 0; i < 8; ++i)
#pragma unroll
                for (int j = 0; j < 8; ++j) { acc0[i][j] = fmaf(a[i], b0[j], acc0[i][j]); acc1[i][j] = fmaf(a[i], b1[j], acc1[i][j]); }
        }
    }
    { const typename Epi::Ctx ctx = epi.prep(u, tc * 8);
#pragma unroll
    for (int i = 0; i < 8; ++i) epi(ctx, u, tr * 8 + i, tc * 8, acc0[i], acc1[i]); }
}

__device__ __forceinline__ void store8_bf16(bf16* dst, const float (&v)[8]) {
    u32x4 o; o.x = pk2(v[0], v[1]); o.y = pk2(v[2], v[3]); o.z = pk2(v[4], v[5]); o.w = pk2(v[6], v[7]); *(u32x4*)dst = o;
}

typedef pg8::Unit Unit;
struct EpiProj { bf16* O; struct Ctx {};
    __device__ __forceinline__ Ctx prep(const Unit&, int) const { return Ctx{}; }
    __device__ __forceinline__ void operator()(const Ctx&, const Unit& u, int r, int c8, const float (&v0)[8], const float (&v1)[8]) const {
        bf16* row = O + (size_t)(u.pm * 256 + r) * NP + u.pn * 256 + c8; store8_bf16(row, v0); store8_bf16(row + 128, v1); } };
struct Col16 { float a[8], b[8]; };
__device__ __forceinline__ Col16 load_col16(const float* p0, const float* p1) { const f32x4 a0 = *(const f32x4*)p0, a1 = *(const f32x4*)(p0 + 4), b0 = *(const f32x4*)p1, b1 = *(const f32x4*)(p1 + 4);
    return Col16{{a0.x, a0.y, a0.z, a0.w, a1.x, a1.y, a1.z, a1.w}, {b0.x, b0.y, b0.z, b0.w, b1.x, b1.y, b1.z, b1.w}}; }
struct EpiOut { const float* x; const float* gffn; float* H2; bf16* XN2; typedef Col16 Ctx;
    __device__ __forceinline__ Ctx prep(const Unit& u, int c8) const { const int col = u.pn * 256 + c8; return load_col16(gffn + col, gffn + col + 128); }
    __device__ __forceinline__ void operator()(const Ctx& g, const Unit& u, int r, int c8, const float (&v0)[8], const float (&v1)[8]) const {
        const int col = u.pn * 256 + c8; const size_t off = (size_t)(u.pm * 256 + r) * D + col; float h0[8], h1[8], n0[8], n1[8];
        const Col16 xs = load_col16(x + off, x + off + 128);
#pragma unroll
        for (int i = 0; i < 8; ++i) { h0[i] = xs.a[i] + v0[i]; h1[i] = xs.b[i] + v1[i]; n0[i] = h0[i] * g.a[i]; n1[i] = h1[i] * g.b[i]; }
        *(f32x4*)(H2 + off) = (f32x4){h0[0], h0[1], h0[2], h0[3]}; *(f32x4*)(H2 + off + 4) = (f32x4){h0[4], h0[5], h0[6], h0[7]};
        *(f32x4*)(H2 + off + 128) = (f32x4){h1[0], h1[1], h1[2], h1[3]}; *(f32x4*)(H2 + off + 132) = (f32x4){h1[4], h1[5], h1[6], h1[7]};
        store8_bf16(XN2 + off, n0); store8_bf16(XN2 + off + 128, n1); } };
struct EpiGU { const float* bgu; const LAS float* rowrstd; bf16* HDN; const LAS int* tile_e; typedef Col16 Ctx;
    __device__ __forceinline__ Ctx prep(const Unit& u, int c8) const { const float* bg = bgu + tile_e[u.pm] * 2048 + u.pn * 128 + c8; return load_col16(bg, bg + 1024); }
    __device__ __forceinline__ void operator()(const Ctx& b, const Unit& u, int r, int c8, const float (&v0)[8], const float (&v1)[8]) const {
        const int row = u.pm * 256 + r; const float rs = rowrstd[u.ui * 256 + r]; const int cb = u.pn * 128 + c8; float h[8];
#pragma unroll
        for (int i = 0; i < 8; ++i) { float g = v0[i] * rs + b.a[i]; float uu = v1[i] * rs + b.b[i];
            g = fminf(g, 7.f); uu = fminf(fmaxf(uu, -7.f), 7.f); h[i] = g * sigmoidf_(1.702f * g) * (uu + 1.f); }
        store8_bf16(HDN + (size_t)row * DE + cb, h); } };
struct EpiDown { const float* bd; const LAS float* rowgate; bf16* YS; const LAS int* tile_e; typedef Col16 Ctx;
    __device__ __forceinline__ Ctx prep(const Unit& u, int c8) const { const float* bp = bd + tile_e[u.pm] * D + u.pn * 256 + c8; return load_col16(bp, bp + 128); }
    __device__ __forceinline__ void operator()(const Ctx& b, const Unit& u, int r, int c8, const float (&v0)[8], const float (&v1)[8]) const {
        const int row = u.pm * 256 + r; const float gt = rowgate[u.ui * 256 + r]; const int cb = u.pn * 256 + c8; float y0[8], y1[8];
#pragma unroll
        for (int i = 0; i < 8; ++i) { y0[i] = (v0[i] + b.a[i]) * gt; y1[i] = (v1[i] + b.b[i]) * gt; }
        store8_bf16(YS + (size_t)row * D + cb, y0); store8_bf16(YS + (size_t)row * D + cb + 128, y1); } };

template <class F> struct EpiAdapt {
    static constexpr bool PERM = true, AFTER_DRAIN = false; F f;
    __device__ __forceinline__ void operator()(const f32x4 (&acc)[2][2][4][2], const Unit& u, int wr, int wc, int fr, int fq) const {
        const typename F::Ctx ctx = f.prep(u, wc * 32 + fq * 8);
#pragma unroll
        for (int ai = 0; ai < 2; ++ai)
#pragma unroll
            for (int m = 0; m < 4; ++m) { const int r = ai * 128 + wr * 64 + m * 16 + fr, c8 = wc * 32 + fq * 8;
                const f32x4 a = acc[ai][0][m][0], b = acc[ai][0][m][1], c = acc[ai][1][m][0], d = acc[ai][1][m][1];
                const float v0[8] = {a.x, a.y, a.z, a.w, b.x, b.y, b.z, b.w}, v1[8] = {c.x, c.y, c.z, c.w, d.x, d.y, d.z, d.w};
                f(ctx, u, r, c8, v0, v1); }
    }
};
struct MoeOrder { pg8::StaticOrder so; const LAS int* tile_e; int ncol; const LAS int* ltok;
    __device__ __forceinline__ bool next(int i, Unit& u) const { return so.next(i, u); }
    __device__ __forceinline__ int bidx(const Unit& u) const { return tile_e[u.pm] * ncol + u.pn; }
    __device__ __forceinline__ int rowtok(int ui, int r) const { return ltok[ui * 256 + r]; }
    __device__ __forceinline__ void a_ready(const Unit&) const {}
    __device__ __forceinline__ void done(const Unit&) const {} };
__device__ __forceinline__ void phase_ew_naive(const Params& p, unsigned char* lds) {
    const int tid = opaque_tid(), lane = tid & 63, wave = tid >> 6;
    bf16* PROJ = (bf16*)(p.ws + WS_PROJ); bf16* MIX = (bf16*)(p.ws + WS_MIX); bf16* KI = (bf16*)(p.ws + WS_KI); bf16* QL = (bf16*)(p.ws + WS_QL); float* WI = (float*)(p.ws + WS_WI);
    const float* COS = (const float*)(p.ws + WS_COS); const float* SIN = (const float*)(p.ws + WS_SIN);
    float* red = (float*)(lds);
    for (int t = blockIdx.x; t < S; t += gridDim.x) {
        const int c = tid; float acc = p.conv_b[c];
        for (int j = 0; j < CW; ++j) { const int tt = t - (CW - 1) + j; if (tt >= 0) { const float val = bf2f(PROJ[(size_t)tt * NP + C_VAL + c]), gate = bf2f(PROJ[(size_t)tt * NP + C_GATE + c]);
                acc = fmaf(p.conv_w[j * CC + c], val * sigmoidf_(gate), acc); } }
        const int hh = (tid & 255) >> 5, ii = tid & 31; const int qkbase = (tid < 256) ? C_Q : C_K;
        const float cs = COS[t * 32 + ii], sn = SIN[t * 32 + ii];
        const float x1 = bf2f(PROJ[(size_t)t * NP + qkbase + hh * 64 + ii]), x2 = bf2f(PROJ[(size_t)t * NP + qkbase + hh * 64 + 32 + ii]);
        float qi1 = 0.f, qi2 = 0.f; if (tid < 256) { qi1 = bf2f(PROJ[(size_t)t * NP + C_QI + hh * 64 + ii]); qi2 = bf2f(PROJ[(size_t)t * NP + C_QI + hh * 64 + 32 + ii]); }
        float kiv = 0.f, qlv = 0.f;
        if (wave == 4) kiv = bf2f(PROJ[(size_t)t * NP + C_KI + lane]);
        if (wave == 5) { for (int h = 0; h < 8; ++h) qlv = fmaf(bf2f(PROJ[(size_t)t * NP + C_WI + h]), bf2f(PROJ[(size_t)t * NP + C_QI + h * 64 + lane]), qlv); }
        float wiv = 0.f; if (wave == 6 && lane < 8) wiv = bf2f(PROJ[(size_t)t * NP + C_WI + lane]);
        float s1 = wave_sum(acc); if (lane == 0) red[wave] = s1; __syncthreads();
        float mean = 0.f;
#pragma unroll
        for (int w = 0; w < 8; ++w) mean += red[w];
        mean *= (1.f / CC); const float dv = acc - mean; float s2 = wave_sum(dv * dv); if (lane == 0) red[8 + wave] = s2; __syncthreads();
        float var = 0.f;
#pragma unroll
        for (int w = 0; w < 8; ++w) var += red[8 + w];
        var *= (1.f / CC);
        const float y = dv * rsqrtf(var + EPS) * p.conv_ng[c] + p.conv_nb[c];
        MIX[(size_t)t * D + c] = (bf16)f2bf(y * sigmoidf_(y));
        { const float sc = (tid < 256) ? C2 : 1.f; PROJ[(size_t)t * NP + qkbase + hh * 64 + ii] = (bf16)f2bf((x1 * cs - x2 * sn) * sc); PROJ[(size_t)t * NP + qkbase + hh * 64 + 32 + ii] = (bf16)f2bf((x2 * cs + x1 * sn) * sc); }
        if (tid < 256) { PROJ[(size_t)t * NP + C_QI + hh * 64 + ii] = (bf16)f2bf(qi1 * cs - qi2 * sn); PROJ[(size_t)t * NP + C_QI + hh * 64 + 32 + ii] = (bf16)f2bf(qi2 * cs + qi1 * sn); }
        if (wave == 4) { const float m = wave_sum(kiv) * (1.f / 64.f); const float d = kiv - m; const float vr = wave_sum(d * d) * (1.f / 64.f);
            const float yk = d * rsqrtf(vr + EPS) * p.idx_g[lane] + p.idx_b[lane]; const float other = __shfl_xor(yk, 32);
            const float c_ = COS[t * 32 + (lane & 31)], s_ = SIN[t * 32 + (lane & 31)];
            KI[(size_t)t * 64 + lane] = (bf16)f2bf(lane < 32 ? (yk * c_ - other * s_) : (yk * c_ + other * s_)); }
        if (wave == 5) { const float other = __shfl_xor(qlv, 32); const float c_ = COS[t * 32 + (lane & 31)], s_ = SIN[t * 32 + (lane & 31)];
            QL[(size_t)t * 64 + lane] = (bf16)f2bf(lane < 32 ? (qlv * c_ - other * s_) : (qlv * c_ + other * s_)); }
        if (wave == 6 && lane < 8) WI[t * 8 + lane] = wiv;
        __syncthreads();
    }
}

__device__ __forceinline__ void phase_ew_fast(const Params& p, unsigned char* lds) {
    const int tid = opaque_tid(), lane = tid & 63, wave = tid >> 6;
    bf16* PROJ = (bf16*)(p.ws + WS_PROJ); bf16* MIX = (bf16*)(p.ws + WS_MIX); bf16* KI = (bf16*)(p.ws + WS_KI); bf16* QL = (bf16*)(p.ws + WS_QL); float* WI = (float*)(p.ws + WS_WI);
    const float* COS = (const float*)(p.ws + WS_COS); const float* SIN = (const float*)(p.ws + WS_SIN);
    LAS unsigned char* L = (LAS unsigned char*)lds;
    LAS unsigned* U = (LAS unsigned*)L;
    LAS float* RED = (LAS float*)(L + 65536);
    const int cp = tid & 255, g = tid >> 8, wv_ = wave & 3;
    typedef float f32x2 __attribute__((ext_vector_type(2))); f32x2 wv[CW];
#pragma unroll
    for (int j = 0; j < CW; ++j) { const float2 ww = *(const float2*)(p.conv_w + j * CC + 2 * cp); wv[j] = (f32x2){ww.x, ww.y}; }
    const float2 cb = *(const float2*)(p.conv_b + 2 * cp), ng = *(const float2*)(p.conv_ng + 2 * cp), nb = *(const float2*)(p.conv_nb + 2 * cp);
    float kmx = 0.f;
    for (int unit = blockIdx.x; unit < S / 32; unit += gridDim.x) {
        const int t0 = unit * 32;
        __syncthreads();
        ISEC(6);
#pragma unroll 2
        for (int it = tid; it < 62 * 64; it += NTHREADS) { const int row = it >> 6, c8 = (it & 63) * 8, tt = t0 - 30 + row; u32x4 o = (u32x4){0u, 0u, 0u, 0u};
            if (tt >= 0) { const u32x4 va = *(const u32x4*)(PROJ + (size_t)tt * NP + C_VAL + c8), ga = *(const u32x4*)(PROJ + (size_t)tt * NP + C_GATE + c8);
                o.x = pk2(blo(va.x) * sigmoidf_(blo(ga.x)), bhi(va.x) * sigmoidf_(bhi(ga.x))); o.y = pk2(blo(va.y) * sigmoidf_(blo(ga.y)), bhi(va.y) * sigmoidf_(bhi(ga.y)));
                o.z = pk2(blo(va.z) * sigmoidf_(blo(ga.z)), bhi(va.z) * sigmoidf_(bhi(ga.z))); o.w = pk2(blo(va.w) * sigmoidf_(blo(ga.w)), bhi(va.w) * sigmoidf_(bhi(ga.w))); }
            *(LAS u32x4*)(L + (size_t)row * 1024 + c8 * 2) = o; }
        __syncthreads();
        ISEC(12);
        f32x2 acc[16];
#pragma unroll
        for (int tt = 0; tt < 16; ++tt) acc[tt] = (f32x2){cb.x, cb.y};
#pragma unroll
        for (int r = 0; r < 46; ++r) { const unsigned x = U[(g * 16 + r) * 256 + cp]; const f32x2 xv = (f32x2){blo(x), bhi(x)};
#pragma unroll
            for (int tt = 0; tt < 16; ++tt) { const int j = r - tt; if (j >= 0 && j < CW) acc[tt] = __builtin_elementwise_fma(wv[j], xv, acc[tt]); } }
#pragma unroll
        for (int tt = 0; tt < 16; ++tt) { const f32x2 a = acc[tt]; const float s1 = wave_sum(a.x + a.y), s2 = wave_sum(a.x * a.x + a.y * a.y);
            if (lane == 0) { RED[((g * 16 + tt) * 4 + wv_) * 2] = s1; RED[((g * 16 + tt) * 4 + wv_) * 2 + 1] = s2; } }
        __syncthreads();
#pragma unroll
        for (int tt = 0; tt < 16; ++tt) { const LAS f32x4* rp = (const LAS f32x4*)(RED + (g * 16 + tt) * 8); const f32x4 ra = rp[0], rb = rp[1];
            const float mean = (ra.x + ra.z + rb.x + rb.z) * (1.f / CC), var = (ra.y + ra.w + rb.y + rb.w) * (1.f / CC) - mean * mean, rstd = rsqrtf(fmaxf(var, 0.f) + EPS);
            const float y0 = (acc[tt].x - mean) * rstd * ng.x + nb.x, y1 = (acc[tt].y - mean) * rstd * ng.y + nb.y;
            *(unsigned*)(MIX + (size_t)(t0 + g * 16 + tt) * D + 2 * cp) = pk2(y0 * sigmoidf_(y0), y1 * sigmoidf_(y1)); }
        ISEC(13);
        { const int tl = (lane >> 3) & 3, dc = lane & 7, t = t0 + wave * 4 + tl; const bf16* prow = PROJ + (size_t)t * NP;
            const u32x4 kraw = *(const u32x4*)(prow + C_KI + dc * 8); const u32x4 wraw = *(const u32x4*)(prow + C_WI);
            const float wf[8] = {blo(wraw.x), bhi(wraw.x), blo(wraw.y), bhi(wraw.y), blo(wraw.z), bhi(wraw.z), blo(wraw.w), bhi(wraw.w)};
            float kv[8] = {blo(kraw.x), bhi(kraw.x), blo(kraw.y), bhi(kraw.y), blo(kraw.z), bhi(kraw.z), blo(kraw.w), bhi(kraw.w)}, qv[8] = {0.f, 0.f, 0.f, 0.f, 0.f, 0.f, 0.f, 0.f};
#pragma unroll
            for (int h = 0; h < 8; ++h) { const u32x4 q = *(const u32x4*)(prow + C_QI + h * 64 + dc * 8);
                qv[0] = fmaf(wf[h], blo(q.x), qv[0]); qv[1] = fmaf(wf[h], bhi(q.x), qv[1]); qv[2] = fmaf(wf[h], blo(q.y), qv[2]); qv[3] = fmaf(wf[h], bhi(q.y), qv[3]);
                qv[4] = fmaf(wf[h], blo(q.z), qv[4]); qv[5] = fmaf(wf[h], bhi(q.z), qv[5]); qv[6] = fmaf(wf[h], blo(q.w), qv[6]); qv[7] = fmaf(wf[h], bhi(q.w), qv[7]); }
            float s = 0.f;
#pragma unroll
            for (int i = 0; i < 8; ++i) s += kv[i];
            s += __shfl_xor(s, 1); s += __shfl_xor(s, 2); s += __shfl_xor(s, 4); const float m = s * (1.f / 64.f);
            float s2 = 0.f;
#pragma unroll
            for (int i = 0; i < 8; ++i) { kv[i] -= m; s2 += kv[i] * kv[i]; }
            s2 += __shfl_xor(s2, 1); s2 += __shfl_xor(s2, 2); s2 += __shfl_xor(s2, 4); const float rstd = rsqrtf(s2 * (1.f / 64.f) + EPS);
            const f32x4 ga = *(const f32x4*)(p.idx_g + dc * 8), gb = *(const f32x4*)(p.idx_g + dc * 8 + 4), ba = *(const f32x4*)(p.idx_b + dc * 8), bb = *(const f32x4*)(p.idx_b + dc * 8 + 4);
            const float gg[8] = {ga.x, ga.y, ga.z, ga.w, gb.x, gb.y, gb.z, gb.w}, bbv[8] = {ba.x, ba.y, ba.z, ba.w, bb.x, bb.y, bb.z, bb.w};
            const int cd = (dc & 3) * 8;
            const f32x4 c0 = *(const f32x4*)(COS + t * 32 + cd), c1 = *(const f32x4*)(COS + t * 32 + cd + 4), s0 = *(const f32x4*)(SIN + t * 32 + cd), s1 = *(const f32x4*)(SIN + t * 32 + cd + 4);
            const float cc[8] = {c0.x, c0.y, c0.z, c0.w, c1.x, c1.y, c1.z, c1.w}, ss[8] = {s0.x, s0.y, s0.z, s0.w, s1.x, s1.y, s1.z, s1.w};
            float ko[8], qo[8];
#pragma unroll
            for (int i = 0; i < 8; ++i) { const float yk = kv[i] * rstd * gg[i] + bbv[i]; const float ok = __shfl_xor(yk, 4), oq = __shfl_xor(qv[i], 4);
                ko[i] = (dc < 4) ? (yk * cc[i] - ok * ss[i]) : (yk * cc[i] + ok * ss[i]); qo[i] = (dc < 4) ? (qv[i] * cc[i] - oq * ss[i]) : (qv[i] * cc[i] + oq * ss[i]); }
            if (lane < 32) { store8_bf16(KI + (size_t)t * 64 + dc * 8, ko); store8_bf16(QL + (size_t)t * 64 + dc * 8, qo);
                if (dc == 0) { *(f32x4*)(WI + t * 8) = (f32x4){wf[0], wf[1], wf[2], wf[3]}; *(f32x4*)(WI + t * 8 + 4) = (f32x4){wf[4], wf[5], wf[6], wf[7]}; } } }
        __syncthreads();
        ISEC(14);
#pragma unroll 3
        for (int it = tid; it < 32 * 96; it += NTHREADS) { const int tl = it / 96, rem = it % 96, ten = rem >> 5, hh = (rem >> 2) & 7, ch = rem & 3; const int t = t0 + tl;
            bf16* base = PROJ + (size_t)t * NP + (ten == 0 ? C_Q : ten == 1 ? C_K : C_QI) + hh * 64 + ch * 8; const float sc = (ten == 0) ? C2 : 1.f;
            const u32x4 xa = *(const u32x4*)base, xb = *(const u32x4*)(base + 32);
            const f32x4 c0 = *(const f32x4*)(COS + t * 32 + ch * 8), c1 = *(const f32x4*)(COS + t * 32 + ch * 8 + 4), s0 = *(const f32x4*)(SIN + t * 32 + ch * 8), s1 = *(const f32x4*)(SIN + t * 32 + ch * 8 + 4);
            const float x1[8] = {blo(xa.x), bhi(xa.x), blo(xa.y), bhi(xa.y), blo(xa.z), bhi(xa.z), blo(xa.w), bhi(xa.w)}, x2[8] = {blo(xb.x), bhi(xb.x), blo(xb.y), bhi(xb.y), blo(xb.z), bhi(xb.z), blo(xb.w), bhi(xb.w)};
            const float cc[8] = {c0.x, c0.y, c0.z, c0.w, c1.x, c1.y, c1.z, c1.w}, ss[8] = {s0.x, s0.y, s0.z, s0.w, s1.x, s1.y, s1.z, s1.w};
            float o1[8], o2[8];
#pragma unroll
            for (int i = 0; i < 8; ++i) { o1[i] = (x1[i] * cc[i] - x2[i] * ss[i]) * sc; o2[i] = (x2[i] * cc[i] + x1[i] * ss[i]) * sc; }
            { float am = fmaxf(fabsf(o1[0]), fabsf(o2[0]));
#pragma unroll
                for (int i = 1; i < 8; ++i) am = fmaxf(am, fmaxf(fabsf(o1[i]), fabsf(o2[i])));
                kmx = fmaxf(kmx, (ten == 1) ? am : 0.f); }
            store8_bf16(base, o1); store8_bf16(base + 32, o2); }
        ISEC(5);
    }
    kmx = wave_max(kmx);
    __syncthreads(); if (lane == 0) RED[wave] = kmx; __syncthreads();
    if (tid == 0) { float m = RED[0];
#pragma unroll
        for (int w = 1; w < 8; ++w) m = fmaxf(m, RED[w]);
        atomicMax((unsigned*)(p.ws + WS_CTL) + CW_KMAX, __float_as_uint(m * 1.01f)); }
}

__device__ __forceinline__ unsigned fkey(float f) { unsigned u = __float_as_uint(f); if (u == 0x80000000u) u = 0u; return (u & 0x80000000u) ? ~u : (u | 0x80000000u); }
__device__ __forceinline__ void phase_idx_naive(const Params& p, unsigned char* lds) {
    const int tid = opaque_tid(), lane = tid & 63, wave = tid >> 6;
    const bf16* PROJ = (const bf16*)(p.ws + WS_PROJ); const bf16* KI = (const bf16*)(p.ws + WS_KI); const float* WI = (const float*)(p.ws + WS_WI);
    u64* MASK = (u64*)(p.ws + WS_MASK);
    float* scores = (float*)lds;
    float* qif = (float*)(lds + 65536);
    float* wf = (float*)(lds + 65536 + 2048);
    unsigned* hist = (unsigned*)(lds + 65536 + 4096);
    u64* tiebits = (u64*)(lds + 65536 + 8192);
    int* sh = (int*)(lds + 65536 + 12288);
    for (int t = blockIdx.x; t < S; t += gridDim.x) {
        const int tq = t >> 6, nadm = 64 * (tq + 1), ntw = 4 * (t >> 8) + 4;
        __syncthreads();
        if (nadm <= KSEL) {
            if (tid < ntw) MASK[(size_t)tid * S + t] = (tid <= tq) ? ~0ull : 0ull;
            continue;
        }
        qif[tid] = bf2f(PROJ[(size_t)t * NP + C_QI + tid]); if (tid < 8) wf[tid] = WI[t * 8 + tid];
        __syncthreads();
        for (int s = tid; s < nadm; s += NTHREADS) {
            float kf[64];
#pragma unroll
            for (int j = 0; j < 8; ++j) { const u32x4 v = *(const u32x4*)(KI + (size_t)s * 64 + j * 8);
                kf[j * 8 + 0] = blo(v.x); kf[j * 8 + 1] = bhi(v.x); kf[j * 8 + 2] = blo(v.y); kf[j * 8 + 3] = bhi(v.y); kf[j * 8 + 4] = blo(v.z); kf[j * 8 + 5] = bhi(v.z); kf[j * 8 + 6] = blo(v.w); kf[j * 8 + 7] = bhi(v.w); }
            float I = 0.f;
            for (int h = 0; h < 8; ++h) { float d = 0.f;
#pragma unroll
                for (int k = 0; k < 64; k += 4) { const f32x4 q4 = *(const f32x4*)(qif + h * 64 + k); d = fmaf(q4.x, kf[k], d); d = fmaf(q4.y, kf[k + 1], d); d = fmaf(q4.z, kf[k + 2], d); d = fmaf(q4.w, kf[k + 3], d); }
                I = fmaf(wf[h], fmaxf(d, 0.f), I); }
            scores[s] = I;
        }
        __syncthreads();
        unsigned prefix = 0; int kk = KSEL;
        for (int ps = 0; ps < 4; ++ps) {
            const int shift = 24 - 8 * ps;
            if (tid < 256) hist[tid] = 0u;
            __syncthreads();
            for (int s = tid; s < nadm; s += NTHREADS) { const unsigned key = fkey(scores[s]); if (ps == 0 || (key >> (shift + 8)) == prefix) atomicAdd(&hist[(key >> shift) & 255u], 1u); }
            __syncthreads();
            if (wave == 0) {
                unsigned c4[4]; unsigned tot = 0;
#pragma unroll
                for (int j = 0; j < 4; ++j) { c4[j] = hist[255 - (4 * lane + j)]; tot += c4[j]; }
                unsigned incl = tot;
#pragma unroll
                for (int o = 1; o < 64; o <<= 1) { const unsigned v = __shfl_up(incl, o); if (lane >= o) incl += v; }
                const unsigned excl = incl - tot;
                if (excl < (unsigned)kk && (unsigned)kk <= incl) { const unsigned s0 = excl + c4[0], s1 = s0 + c4[1], s2 = s1 + c4[2]; const unsigned ukk = (unsigned)kk;
                    const int j = ukk <= s0 ? 0 : ukk <= s1 ? 1 : ukk <= s2 ? 2 : 3; const unsigned cum = ukk <= s0 ? excl : ukk <= s1 ? s0 : ukk <= s2 ? s1 : s2;
                    sh[0] = 255 - (4 * lane + j); sh[1] = kk - (int)cum; }
            }
            __syncthreads();
            prefix = (prefix << 8) | (unsigned)sh[0]; kk = sh[1];
            __syncthreads();
        }
        const unsigned T = prefix;
        if (wave == 0) { int run = 0;
            for (int tile = 0; tile <= tq; ++tile) { const bool tie = fkey(scores[tile * 64 + lane]) == T; const u64 bal = __ballot(tie);
                const int rank = run + __popcll(bal & ((1ull << lane) - 1ull)); const u64 tb = __ballot(tie && rank < kk); if (lane == 0) tiebits[tile] = tb; run += __popcll(bal); } }
        __syncthreads();
        for (int tile = wave; tile < ntw; tile += NWAVES) { u64 w = 0ull;
            if (tile <= tq) { w = __ballot(fkey(scores[tile * 64 + lane]) > T) | tiebits[tile]; }
            if (lane == 0) MASK[(size_t)tile * S + t] = w; }
    }
}

namespace idxf {
typedef short bf16x8 __attribute__((ext_vector_type(8)));
typedef float f32x16 __attribute__((ext_vector_type(16)));
constexpr int L_B = 0, L_HIST = 36864, L_PK = L_HIST + 32 * 513 * 4, L_TAIL = L_PK + 2048, L_CC = L_TAIL + 2 * 32 * 64 * 4, L_CT = L_CC + 16 * 32 * 4, L_END = L_CT + 16 * 32 * 4;
constexpr int PK_P = 0, PK_KK = 32, PK_TC = 64, PK_A = 96, PK_SC = 128, PK_MN = 160, PK_MX = 192, PK_FLAG = 224, PK_LO = 256, PK_ND = 288, PK_NC = 320;
constexpr int CAND_CAP = 1024;
constexpr int R_HI = 12, R_LO = 56;
static_assert(L_END <= 131072, "idx LDS");
__device__ __forceinline__ unsigned fkey32(float f) { const unsigned u = __float_as_uint(f); return u ^ ((unsigned)((int)u >> 31) | 0x80000000u); }
__device__ __forceinline__ float fkey_inv(unsigned k) { return __uint_as_float((k & 0x80000000u) ? (k ^ 0x80000000u) : ~k); }
__device__ __forceinline__ int lbin(float I, float A, float sc) { const int b = (int)((I - A) * sc); return b < 0 ? 0 : (b > 1023 ? 1023 : b); }

template <int MODE>
__device__ __forceinline__ void sweep(const Params& p, LAS unsigned char* L, int q0, int ntk, int wave, int lane) {
    const int j = lane & 31, hi = lane >> 5;
    const bf16* KI = (const bf16*)(p.ws + WS_KI); u64* MASK = (u64*)(p.ws + WS_MASK);
    LAS unsigned* PK = (LAS unsigned*)(L + L_PK); LAS unsigned* tailk = (LAS unsigned*)(L + L_TAIL); LAS unsigned* taili = tailk + 32 * 64;
    LAS unsigned* hist = (LAS unsigned*)(L + L_HIST) + ((MODE == 5 || MODE >= 7) ? j : j * 257);
    float w[8]; { const f32x4 wa = *(const f32x4*)((const float*)(p.ws + WS_WI) + (size_t)(q0 + j) * 8), wb = *(const f32x4*)((const float*)(p.ws + WS_WI) + (size_t)(q0 + j) * 8 + 4);
        w[0] = wa.x; w[1] = wa.y; w[2] = wa.z; w[3] = wa.w; w[4] = wb.x; w[5] = wb.y; w[6] = wb.z; w[7] = wb.w; }
    const unsigned P = (MODE == 2 || MODE == 3 || MODE == 6 || MODE == 8) ? PK[PK_P + j] : 0u; const unsigned PLO = (MODE == 8) ? PK[PK_LO + j] : 0u; unsigned ndef = 0u, ccnt = 0u;
    u64* CAND = (u64*)(p.ws + WS_XS) + (size_t)(q0 + j) * CAND_CAP + (wave * 2 + hi) * 64;
    const int nloop = (MODE == 4) ? NWAVES : (MODE == 7) ? ((ntk + 7) >> 3) : ntk;
    const float lA = (MODE >= 5) ? __uint_as_float(PK[PK_A + j]) : 0.f, lS = (MODE >= 5) ? __uint_as_float(PK[PK_SC + j]) : 0.f;
    const LAS unsigned char* bfr = L + L_B + lane * 16;
    const bf16* abase = KI + hi * 8;
    unsigned kmn = 0xffffffffu, tk8[8] = {0u, 0u, 0u, 0u, 0u, 0u, 0u, 0u};
    bf16x8 a[2][4];
#define IDX_LOADA(dst, kt_) do { _Pragma("unroll") for (int hf = 0; hf < 2; ++hf) { const int row = (MODE == 4) ? ((((kt_) * 64 + hf * 32 + (lane & 31)) * (ntk * 64)) >> 9) : (MODE == 7) ? min((((kt_) * 64 + hf * 32 + (lane & 31)) << 3) + 5, ntk * 64 - 1) : ((kt_) * 64 + hf * 32 + (lane & 31)); \
            _Pragma("unroll") for (int ks = 0; ks < 4; ++ks) dst[hf][ks] = *(const bf16x8*)(abase + (size_t)row * 64 + ks * 16); } } while (0)
    for (int kt = wave; kt < nloop; kt += NWAVES) {
        IDX_LOADA(a, kt);
        f32x16 L0, L1; float I0[16], I1[16];
        f32x16 cA0, cA1, cB0, cB1; bf16x8 bA[4], bB[4];
#define IDX_LOADB(BD, H) do { _Pragma("unroll") for (int ks = 0; ks < 4; ++ks) BD[ks] = *(const LAS bf16x8*)(bfr + ((H) * 4 + ks) * 1024); } while (0)
#define IDX_CHAIN(D0, D1, BS) do { D0 = f32x16{}; D1 = f32x16{}; _Pragma("unroll") for (int ks = 0; ks < 4; ++ks) { \
            D0 = __builtin_amdgcn_mfma_f32_32x32x16_bf16(a[0][ks], BS[ks], D0, 0, 0, 0); D1 = __builtin_amdgcn_mfma_f32_32x32x16_bf16(a[1][ks], BS[ks], D1, 0, 0, 0); } \
            asm volatile("" : "+v"(D0)); asm volatile("" : "+v"(D1)); } while (0)
#define IDX_ACC(C0_, C1_, H) do { _Pragma("unroll") for (int r = 0; r < 16; ++r) { I0[r] = fmaf(w[H], __builtin_fabsf(C0_[r]), I0[r]); I1[r] = fmaf(w[H], __builtin_fabsf(C1_[r]), I1[r]); asm volatile("" : "+v"(I0[r]), "+v"(I1[r])); } } while (0)
#define IDX_SB __builtin_amdgcn_sched_barrier(0)
        IDX_LOADB(bA, 8); IDX_LOADB(bB, 0); IDX_SB;
        IDX_LOADB(bA, 8); IDX_CHAIN(L0, L1, bA); IDX_SB;
        IDX_LOADB(bA, 1); IDX_CHAIN(cA0, cA1, bB); IDX_SB;
#pragma unroll
        for (int r = 0; r < 16; ++r) { I0[r] = L0[r]; I1[r] = L1[r]; }
        IDX_LOADB(bB, 2); IDX_CHAIN(cB0, cB1, bA); IDX_ACC(cA0, cA1, 0); IDX_SB;
        IDX_LOADB(bA, 3); IDX_CHAIN(cA0, cA1, bB); IDX_ACC(cB0, cB1, 1); IDX_SB;
        IDX_LOADB(bB, 4); IDX_CHAIN(cB0, cB1, bA); IDX_ACC(cA0, cA1, 2); IDX_SB;
        IDX_LOADB(bA, 5); IDX_CHAIN(cA0, cA1, bB); IDX_ACC(cB0, cB1, 3); IDX_SB;
        IDX_LOADB(bB, 6); IDX_CHAIN(cB0, cB1, bA); IDX_ACC(cA0, cA1, 4); IDX_SB;
        IDX_LOADB(bA, 7); IDX_CHAIN(cA0, cA1, bB); IDX_ACC(cB0, cB1, 5); IDX_SB;
        IDX_CHAIN(cB0, cB1, bA); IDX_ACC(cA0, cA1, 6); IDX_SB;
        IDX_ACC(cB0, cB1, 7);
        IDX_SB;
#undef IDX_LOADB
#undef IDX_SB
#undef IDX_CHAIN
#undef IDX_ACC
        if (MODE == 1) {
#pragma unroll
            for (int r = 0; r < 16; ++r) { const unsigned k0 = fkey32(I0[r]), k1 = fkey32(I1[r]);
                __hip_atomic_fetch_add(hist + (k0 >> 24), 1u, __ATOMIC_RELAXED, __HIP_MEMORY_SCOPE_WORKGROUP); __hip_atomic_fetch_add(hist + (k1 >> 24), 1u, __ATOMIC_RELAXED, __HIP_MEMORY_SCOPE_WORKGROUP); }
        } else if (MODE == 2) {
#pragma unroll
            for (int r = 0; r < 16; ++r) { const unsigned k0 = fkey32(I0[r]), k1 = fkey32(I1[r]);
                if ((k0 >> 24) == P) __hip_atomic_fetch_add(hist + ((k0 >> 16) & 255u), 1u, __ATOMIC_RELAXED, __HIP_MEMORY_SCOPE_WORKGROUP);
                if ((k1 >> 24) == P) __hip_atomic_fetch_add(hist + ((k1 >> 16) & 255u), 1u, __ATOMIC_RELAXED, __HIP_MEMORY_SCOPE_WORKGROUP); }
        } else if (MODE == 4) {
#pragma unroll
            for (int r = 0; r < 16; ++r) { unsigned k0 = fkey32(I0[r]), k1 = fkey32(I1[r]); kmn = min(kmn, min(k0, k1));
#pragma unroll
                for (int i = 0; i < 8; ++i) { const unsigned hi0 = max(tk8[i], k0); k0 = min(tk8[i], k0); tk8[i] = hi0; }
#pragma unroll
                for (int i = 0; i < 8; ++i) { const unsigned hi1 = max(tk8[i], k1); k1 = min(tk8[i], k1); tk8[i] = hi1; } }
        } else if (MODE == 5 || MODE == 7) {
#pragma unroll
            for (int r = 0; r < 16; ++r) { const int b0 = lbin(I0[r], lA, lS), b1 = lbin(I1[r], lA, lS); const int kb = (r & 3) + 8 * (r >> 2) + 4 * hi;
                const bool v0 = (MODE == 5) || (((kt * 64 + kb) << 3) + 5 < ntk * 64), v1 = (MODE == 5) || (((kt * 64 + 32 + kb) << 3) + 5 < ntk * 64);
                if (v0) __hip_atomic_fetch_add(hist + (b0 >> 1) * 32, 1u << ((b0 & 1) * 16), __ATOMIC_RELAXED, __HIP_MEMORY_SCOPE_WORKGROUP);
                if (v1) __hip_atomic_fetch_add(hist + (b1 >> 1) * 32, 1u << ((b1 & 1) * 16), __ATOMIC_RELAXED, __HIP_MEMORY_SCOPE_WORKGROUP); }
        } else if (MODE == 8) {
            unsigned wlo = 0u, whi = 0u; const float thi = (P >= 1023u) ? INFINITY : (float)(P + 1u), tlo = (float)PLO;     const unsigned wbits = __float_as_uint(thi - tlo);
#pragma unroll
            for (int r = 0; r < 16; ++r) { const int kb = (r & 3) + 8 * (r >> 2); const float x0 = (I0[r] - lA) * lS, x1 = (I1[r] - lA) * lS;
                wlo |= (x0 >= thi) ? (1u << kb) : 0u; whi |= (x1 >= thi) ? (1u << kb) : 0u;
                if (__float_as_uint(x0 - tlo) < wbits) { const unsigned c0 = (unsigned)lbin(I0[r], lA, lS); __hip_atomic_fetch_add(hist + (c0 >> 1) * 32, 1u << ((c0 & 1) * 16), __ATOMIC_RELAXED, __HIP_MEMORY_SCOPE_WORKGROUP);
                    if (ccnt < 64u) CAND[ccnt] = ((u64)fkey32(I0[r]) << 32) | (u64)(unsigned)(kt * 64 + kb + 4 * hi); ++ccnt; }
                if (__float_as_uint(x1 - tlo) < wbits) { const unsigned c1 = (unsigned)lbin(I1[r], lA, lS); __hip_atomic_fetch_add(hist + (c1 >> 1) * 32, 1u << ((c1 & 1) * 16), __ATOMIC_RELAXED, __HIP_MEMORY_SCOPE_WORKGROUP);
                    if (ccnt < 64u) CAND[ccnt] = ((u64)fkey32(I1[r]) << 32) | (u64)(unsigned)(kt * 64 + 32 + kb + 4 * hi); ++ccnt; } }
            wlo <<= 4 * hi; whi <<= 4 * hi;
            wlo |= (unsigned)__shfl_xor((int)wlo, 32); whi |= (unsigned)__shfl_xor((int)whi, 32);
            if (hi == 0) { MASK[(size_t)kt * S + q0 + j] = ((u64)whi << 32) | (u64)wlo; ndef += (unsigned)(__popc(wlo) + __popc(whi)); }
        } else {
            unsigned wlo = 0u, whi = 0u;
#pragma unroll
            for (int r = 0; r < 16; ++r) { const int kb = (r & 3) + 8 * (r >> 2); const unsigned k0 = fkey32(I0[r]), k1 = fkey32(I1[r]);
                const unsigned c0 = (MODE == 3) ? (k0 >> 16) : (unsigned)lbin(I0[r], lA, lS), c1 = (MODE == 3) ? (k1 >> 16) : (unsigned)lbin(I1[r], lA, lS);
                wlo |= (c0 > P) ? (1u << kb) : 0u; whi |= (c1 > P) ? (1u << kb) : 0u;
                if (c0 == P) { const unsigned pos = __hip_atomic_fetch_add(PK + PK_TC + j, 1u, __ATOMIC_RELAXED, __HIP_MEMORY_SCOPE_WORKGROUP); if (pos < 64u) { tailk[j * 64 + pos] = k0; taili[j * 64 + pos] = (unsigned)(kt * 64 + kb + 4 * hi); } }
                if (c1 == P) { const unsigned pos = __hip_atomic_fetch_add(PK + PK_TC + j, 1u, __ATOMIC_RELAXED, __HIP_MEMORY_SCOPE_WORKGROUP); if (pos < 64u) { tailk[j * 64 + pos] = k1; taili[j * 64 + pos] = (unsigned)(kt * 64 + 32 + kb + 4 * hi); } } }
            wlo <<= 4 * hi; whi <<= 4 * hi;
            wlo |= (unsigned)__shfl_xor((int)wlo, 32); whi |= (unsigned)__shfl_xor((int)whi, 32);
            if (hi == 0) MASK[(size_t)kt * S + q0 + j] = ((u64)whi << 32) | (u64)wlo;
        }
    }
#undef IDX_LOADA
    if (MODE == 8) { if (hi == 0 && ndef) __hip_atomic_fetch_add(PK + PK_ND + j, ndef, __ATOMIC_RELAXED, __HIP_MEMORY_SCOPE_WORKGROUP); ((LAS unsigned*)(L + L_CC))[(wave * 2 + hi) * 32 + j] = ccnt; }
    if (MODE == 4) {
        const int nadm = ntk * 64; const unsigned cand = nadm >= 8192 ? tk8[3] : nadm >= 4096 ? tk8[7] : nadm >= 2048 ? kmn : nadm >= 1024 ? tk8[7] : kmn;
        __hip_atomic_fetch_min(PK + PK_MN + j, cand, __ATOMIC_RELAXED, __HIP_MEMORY_SCOPE_WORKGROUP); __hip_atomic_fetch_max(PK + PK_MX + j, tk8[0], __ATOMIC_RELAXED, __HIP_MEMORY_SCOPE_WORKGROUP); }
}

__device__ __forceinline__ void scan4(LAS unsigned char* L, int wave, int lane) {
    LAS unsigned* PK = (LAS unsigned*)(L + L_PK);
    for (int qq = 0; qq < 4; ++qq) { const int jq = wave * 4 + qq; const LAS unsigned* hb = (const LAS unsigned*)(L + L_HIST) + jq * 257;
        const unsigned kk = PK[PK_KK + jq];
        const unsigned c0 = hb[255 - 4 * lane], c1 = hb[254 - 4 * lane], c2 = hb[253 - 4 * lane], c3 = hb[252 - 4 * lane]; const unsigned tot = c0 + c1 + c2 + c3;
        unsigned incl = tot;
#pragma unroll
        for (int o = 1; o < 64; o <<= 1) { const unsigned v = __shfl_up(incl, o); if (lane >= o) incl += v; }
        const unsigned excl = incl - tot;
        if (excl < kk && kk <= incl) { const unsigned s0 = excl + c0, s1 = s0 + c1, s2 = s1 + c2;
            const int jb = kk <= s0 ? 0 : kk <= s1 ? 1 : kk <= s2 ? 2 : 3; const unsigned cum = kk <= s0 ? excl : kk <= s1 ? s0 : kk <= s2 ? s1 : s2;
            PK[PK_P + jq] = (PK[PK_P + jq] << 8) | (unsigned)(255 - (4 * lane + jb)); PK[PK_KK + jq] = kk - cum; }
    }
}
__device__ __forceinline__ void scan_lin(LAS unsigned char* L, int tid, int kk_off = PK_KK, int out_off = PK_P, bool write_kk = true) {
    LAS unsigned* PK = (LAS unsigned*)(L + L_PK); LAS unsigned* CT = (LAS unsigned*)(L + L_CT);
    const int jq = tid & 31, ch = tid >> 5; const LAS unsigned* hb = (const LAS unsigned*)(L + L_HIST) + (32 * ch) * 32 + jq;
    unsigned tot = 0u;
#pragma unroll 8
    for (int i = 0; i < 32; ++i) { const unsigned wd = hb[i * 32]; tot += (wd & 0xffffu) + (wd >> 16); }
    CT[ch * 32 + jq] = tot;
    __syncthreads();
    unsigned excl = 0u;
#pragma unroll
    for (int c = 1; c < 16; ++c) excl += (c > ch) ? CT[c * 32 + jq] : 0u;
    const unsigned kk = PK[kk_off + jq];
    if (excl < kk && kk <= excl + tot) { unsigned cum = excl, bsel = 0u, nk = 0u; bool done = false;
        for (int i = 31; i >= 0; --i) { const unsigned wd = hb[i * 32]; const unsigned chi = wd >> 16, clo = wd & 0xffffu;
            bool hit = !done && (cum + chi >= kk); bsel = hit ? (unsigned)(2 * (32 * ch + i) + 1) : bsel; nk = hit ? (kk - cum) : nk; done = done || hit; cum += chi;
            hit = !done && (cum + clo >= kk); bsel = hit ? (unsigned)(2 * (32 * ch + i)) : bsel; nk = hit ? (kk - cum) : nk; done = done || hit; cum += clo; }
        PK[out_off + jq] = bsel; if (write_kk) PK[PK_KK + jq] = nk; }
}
template <bool TOLDS>
__device__ __forceinline__ void tail_resolve(const Params& p, LAS unsigned char* L, int q0, int tid) {
    u64* MASK = (u64*)(p.ws + WS_MASK); LAS unsigned* PK = (LAS unsigned*)(L + L_PK); LAS u64* MW = (LAS u64*)(L + L_HIST);
    const int jq = tid >> 4, e0 = tid & 15; const unsigned n = min(PK[PK_TC + jq], 64u), kk = PK[PK_KK + jq];
    const LAS unsigned* tk = (const LAS unsigned*)(L + L_TAIL) + jq * 64; const LAS unsigned* ti = tk + 32 * 64;
    for (unsigned e = e0; e < n; e += 16) { const unsigned k = tk[e], s = ti[e]; unsigned rank = 0;
        for (unsigned e2 = 0; e2 < n; ++e2) { const unsigned k2 = tk[e2], s2 = ti[e2]; rank += (k2 > k || (k2 == k && s2 < s)) ? 1u : 0u; }
        if (rank < kk) { if (TOLDS) __hip_atomic_fetch_or(MW + (s >> 6) * 32 + jq, 1ull << (s & 63), __ATOMIC_RELAXED, __HIP_MEMORY_SCOPE_WORKGROUP);
            else atomicOr((unsigned long long*)&MASK[(size_t)(s >> 6) * S + q0 + jq], 1ull << (s & 63)); } }
}
__device__ __forceinline__ void idx_unit(const Params& p, unsigned char* lds, int u) {
    int tid_ = threadIdx.x; asm volatile("" : "+v"(tid_)); const int tid = tid_, lane = tid & 63; const int wave = __builtin_amdgcn_readfirstlane(tid >> 6);
    LAS unsigned char* L = (LAS unsigned char*)lds;
    const int q0 = u * 32, tq = q0 >> 6, ntk = tq + 1, ntw = 4 * (q0 >> 8) + 4;
    u64* MASK = (u64*)(p.ws + WS_MASK);
    if (ntk * 64 <= KSEL) { for (int i = tid; i < ntw * 32; i += NTHREADS) { const int tile = i >> 5; MASK[(size_t)tile * S + q0 + (i & 31)] = (tile <= tq) ? ~0ull : 0ull; } return; }
    for (int i = tid; i < (ntw - ntk) * 32; i += NTHREADS) MASK[(size_t)(ntk + (i >> 5)) * S + q0 + (i & 31)] = 0ull;
    __syncthreads();
    ISEC(7);
    { const bf16* PROJ = (const bf16*)(p.ws + WS_PROJ); const bf16* QL = (const bf16*)(p.ws + WS_QL); const int j = lane & 31, hi = lane >> 5;
        for (int f = wave; f < 36; f += NWAVES) { const int h = f >> 2, ks = f & 3;
            const bf16* src = (h < 8) ? PROJ + (size_t)(q0 + j) * NP + C_QI + h * 64 + ks * 16 + hi * 8 : QL + (size_t)(q0 + j) * 64 + ks * 16 + hi * 8;
            *(LAS u32x4*)(L + L_B + f * 1024 + lane * 16) = *(const u32x4*)src; } }
    LAS unsigned* PK = (LAS unsigned*)(L + L_PK);
    if (tid < 32) { PK[PK_P + tid] = 0u; PK[PK_KK + tid] = (unsigned)KSEL; PK[PK_TC + tid] = 0u; PK[PK_MN + tid] = 0xffffffffu; PK[PK_MX + tid] = 0u; }
    if (tid == 0) PK[PK_FLAG] = 0u;
    for (int i = tid; i < 32 * 513; i += NTHREADS) ((LAS unsigned*)(L + L_HIST))[i] = 0u;
    __syncthreads();
    ISEC(0);
    sweep<4>(p, L, q0, ntk, wave, lane);
    __syncthreads();
    ISEC(1);
    if (tid < 32) { const float mn = fkey_inv(PK[PK_MN + tid]), mx = fkey_inv(PK[PK_MX + tid]); const float rg = mx - mn; const float A = mn; const float sc = 1024.f / (1.5f * rg);
        PK[PK_A + tid] = __float_as_uint(A); PK[PK_SC + tid] = __float_as_uint(sc); if (!(rg > 0.f) || !(sc < 3.0e38f)) PK[PK_FLAG] = 1u; }
    __syncthreads();
    bool fallback = PK[PK_FLAG] != 0u;
    bool done = false;
    if (!fallback && ntk >= 32) {
        sweep<7>(p, L, q0, ntk, wave, lane);
        __syncthreads();
        ISEC(8);
        if (tid < 32) { PK[PK_ND + tid] = (unsigned)R_HI; PK[PK_NC + tid] = (unsigned)R_LO; }
        __syncthreads();
        scan_lin(L, tid, PK_ND, PK_P, false);
        __syncthreads();
        scan_lin(L, tid, PK_NC, PK_LO, false);
        __syncthreads();
        if (tid < 32) { PK[PK_ND + tid] = 0u; PK[PK_NC + tid] = 0u; }
        for (int i = tid; i < 32 * 513; i += NTHREADS) ((LAS unsigned*)(L + L_HIST))[i] = 0u;
        __syncthreads();
        ISEC(9);
        sweep<8>(p, L, q0, ntk, wave, lane);
        __syncthreads();
        ISEC(10);
        if (tid < 32) { const LAS unsigned* cc = (const LAS unsigned*)(L + L_CC) + tid; unsigned nc = 0u, mxc = 0u;
#pragma unroll
            for (int i = 0; i < 16; ++i) { const unsigned c = cc[i * 32]; nc += c; mxc = max(mxc, c); }
            const unsigned nd = PK[PK_ND + tid]; const bool ok = nd < (unsigned)KSEL && nd + nc >= (unsigned)KSEL && mxc <= 64u;
            if (!ok) PK[PK_FLAG] = 1u; PK[PK_KK + tid] = (unsigned)KSEL - (ok ? nd : 0u); PK[PK_TC + tid] = 0u; }
        __syncthreads();
        if (PK[PK_FLAG] == 0u) {
            scan_lin(L, tid);
            __syncthreads();
            LAS u64* MW = (LAS u64*)(L + L_HIST);
            for (int i = tid; i < ntk * 32; i += NTHREADS) MW[i] = 0ull;
            __syncthreads();
            { const int jq = tid >> 4, e0 = tid & 15; const unsigned nc = ((const LAS unsigned*)(L + L_CC))[e0 * 32 + jq], bt = PK[PK_P + jq]; const float cA = __uint_as_float(PK[PK_A + jq]), cS = __uint_as_float(PK[PK_SC + jq]);
                const u64* cl = (const u64*)(p.ws + WS_XS) + (size_t)(q0 + jq) * CAND_CAP + e0 * 64; LAS unsigned* tk = (LAS unsigned*)(L + L_TAIL) + jq * 64; LAS unsigned* ti = tk + 32 * 64;
                for (unsigned eb = 0; eb < nc; eb += 8) { u64 rec[8];
#pragma unroll
                    for (int i = 0; i < 8; ++i) { const unsigned e = eb + i; rec[i] = (e < nc) ? cl[e] : 0ull; }
#pragma unroll
                    for (int i = 0; i < 8; ++i) { const unsigned e = eb + i; if (e < nc) { const unsigned key = (unsigned)(rec[i] >> 32), s = (unsigned)rec[i]; const unsigned b = (unsigned)lbin(fkey_inv(key), cA, cS);
                            if (b > bt) __hip_atomic_fetch_or(MW + (s >> 6) * 32 + jq, 1ull << (s & 63), __ATOMIC_RELAXED, __HIP_MEMORY_SCOPE_WORKGROUP);
                            else if (b == bt) { const unsigned pos = __hip_atomic_fetch_add(PK + PK_TC + jq, 1u, __ATOMIC_RELAXED, __HIP_MEMORY_SCOPE_WORKGROUP); if (pos < 64u) { tk[pos] = key; ti[pos] = s; } } } } } }
            __syncthreads();
            if (tid < 32 && PK[PK_TC + tid] > 64u) PK[PK_FLAG] = 1u;
            __syncthreads();
            if (PK[PK_FLAG] == 0u) { tail_resolve<true>(p, L, q0, tid); __syncthreads();
                for (int i = tid; i < ntk * 32; i += NTHREADS) { const u64 wv = MW[i]; if (wv) { u64* gp = &MASK[(size_t)(i >> 5) * S + q0 + (i & 31)]; *gp = *gp | wv; } }
                done = true; }
        }
        ISEC(11);
        if (!done) {
            __syncthreads();
#if PROBE_PHASE == 101
            if (tid == 0) atomicAdd((unsigned*)(p.ws + WS_CTL) + 2048, 1u);
#endif
            if (tid < 32) { PK[PK_P + tid] = 0u; PK[PK_KK + tid] = (unsigned)KSEL; PK[PK_TC + tid] = 0u; }
            if (tid == 0) PK[PK_FLAG] = 0u;
            for (int i = tid; i < 32 * 513; i += NTHREADS) ((LAS unsigned*)(L + L_HIST))[i] = 0u;
            __syncthreads();
        }
    }
    if (!fallback && !done) {
        sweep<5>(p, L, q0, ntk, wave, lane);
        __syncthreads();
        ISEC(2);
        scan_lin(L, tid);
        __syncthreads();
        ISEC(3);
        sweep<6>(p, L, q0, ntk, wave, lane);
        ISEC(4);
        __syncthreads();
        if (tid < 32 && PK[PK_TC + tid] > 64u) PK[PK_FLAG] = 1u;
        __syncthreads();
        fallback = PK[PK_FLAG] != 0u;
        if (!fallback) tail_resolve<false>(p, L, q0, tid);
        ISEC(5);
    }
    if (fallback && !done) {
        __syncthreads();
#if PROBE_PHASE == 100
        if (tid == 0) atomicAdd((unsigned*)(p.ws + WS_CTL) + 2048, 1u);
#endif
        if (tid < 32) { PK[PK_P + tid] = 0u; PK[PK_KK + tid] = (unsigned)KSEL; PK[PK_TC + tid] = 0u; }
        for (int i = tid; i < 32 * 257; i += NTHREADS) ((LAS unsigned*)(L + L_HIST))[i] = 0u;
        __syncthreads();
        sweep<1>(p, L, q0, ntk, wave, lane);
        __syncthreads();
        scan4(L, wave, lane);
        __syncthreads();
        for (int i = tid; i < 32 * 257; i += NTHREADS) ((LAS unsigned*)(L + L_HIST))[i] = 0u;
        __syncthreads();
        sweep<2>(p, L, q0, ntk, wave, lane);
        __syncthreads();
        scan4(L, wave, lane);
        __syncthreads();
        sweep<3>(p, L, q0, ntk, wave, lane);
        __syncthreads();
        tail_resolve<false>(p, L, q0, tid);
    }
}
__device__ __forceinline__ void idx_phase(const Params& p, unsigned char* lds) {
    for (int w = blockIdx.x; w < 256; w += gridDim.x)
#pragma unroll 1
        for (int k = 0; k < 2; ++k) idx_unit(p, lds, k ? 511 - w : w);
}
}

__device__ __forceinline__ void phase_att_naive(const Params& p, unsigned char* lds) {
    const int tid = opaque_tid(), lane = tid & 63, wave = tid >> 6;
    const bf16* PROJ = (const bf16*)(p.ws + WS_PROJ); bf16* MIX = (bf16*)(p.ws + WS_MIX); const u64* MASK = (const u64*)(p.ws + WS_MASK);
    int* sidx = (int*)(lds + wave * 2048); float* slog = (float*)(lds + wave * 2048 + 1024);
    const int h = wave;
    for (int t = blockIdx.x; t < S; t += gridDim.x) {
        const int tq = t >> 6;
        float qf[64];
#pragma unroll
        for (int j = 0; j < 8; ++j) { const u32x4 v = *(const u32x4*)(PROJ + (size_t)t * NP + C_Q + h * 64 + j * 8);
            qf[j * 8 + 0] = blo(v.x); qf[j * 8 + 1] = bhi(v.x); qf[j * 8 + 2] = blo(v.y); qf[j * 8 + 3] = bhi(v.y); qf[j * 8 + 4] = blo(v.z); qf[j * 8 + 5] = bhi(v.z); qf[j * 8 + 6] = blo(v.w); qf[j * 8 + 7] = bhi(v.w); }
        int n = 0;
        for (int tile = 0; tile <= tq; ++tile) {
            const u64 w = MASK[(size_t)tile * S + t]; const bool sel = (w >> lane) & 1ull;
            if (w == 0ull) continue;
            float lg = 0.f; const int s = tile * 64 + lane;
            if (sel) {
#pragma unroll
                for (int j = 0; j < 8; ++j) { const u32x4 v = *(const u32x4*)(PROJ + (size_t)s * NP + C_K + h * 64 + j * 8);
                    lg = fmaf(qf[j * 8 + 0], blo(v.x), lg); lg = fmaf(qf[j * 8 + 1], bhi(v.x), lg); lg = fmaf(qf[j * 8 + 2], blo(v.y), lg); lg = fmaf(qf[j * 8 + 3], bhi(v.y), lg);
                    lg = fmaf(qf[j * 8 + 4], blo(v.z), lg); lg = fmaf(qf[j * 8 + 5], bhi(v.z), lg); lg = fmaf(qf[j * 8 + 6], blo(v.w), lg); lg = fmaf(qf[j * 8 + 7], bhi(v.w), lg); }
                const int pos = n + __popcll(w & ((1ull << lane) - 1ull));
                if (pos < 256) { sidx[pos] = s; slog[pos] = lg; }
            }
            n += __popcll(w);
        }
        if (n > 256) n = 256;
        __builtin_amdgcn_s_waitcnt(0); asm volatile("" ::: "memory");
        float m = -INFINITY; for (int j = lane; j < n; j += 64) m = fmaxf(m, slog[j]);
        m = wave_max(m);
        float l = 0.f; for (int j = lane; j < n; j += 64) { const float pj = exp2f(slog[j] - m); slog[j] = pj; l += pj; }
        l = wave_sum(l);
        __builtin_amdgcn_s_waitcnt(0); asm volatile("" ::: "memory");
        float o = 0.f;
        for (int j = 0; j < n; ++j) o = fmaf(slog[j], bf2f(PROJ[(size_t)sidx[j] * NP + C_V + h * 64 + lane]), o);
        MIX[(size_t)t * D + 512 + h * 64 + lane] = (bf16)f2bf(o / l);
        __builtin_amdgcn_s_waitcnt(0); asm volatile("" ::: "memory");
    }
}

namespace attn_body {
using bf16=__hip_bfloat16;
using bf16x8=__attribute__((ext_vector_type(8)))short;
using s16x4=__attribute__((ext_vector_type(4)))short;
using f32x16=__attribute__((ext_vector_type(16)))float;
using u32x4=__attribute__((ext_vector_type(4)))unsigned;
constexpr int NHEAD=8,SEQ=16384,D=64,DMI=3328,DMO=1024;
typedef unsigned long long u64;
constexpr int NW=8,QBLK=32,QB=QBLK*NW,KVBLK=64,NQB=SEQ/QB;
__device__ __forceinline__ int crow(int r,int hi){return (r&3)+8*(r>>2)+4*hi;}
#define SBAR() __builtin_amdgcn_sched_barrier(0)
__device__ __forceinline__ void cmask(f32x16&p0,f32x16&p1,int jb,int qrel,int hi){
  const float NEG=-INFINITY; int kb=64*jb+4*hi;
  #pragma unroll
  for(int r=0;r<16;++r){int kv=kb+(r&3)+8*(r>>2); if(kv>qrel)p0[r]=NEG; if(kv+32>qrel)p1[r]=NEG;}
}

constexpr int NSLOT=3, SLOTB=8192;
constexpr int LDS_K=0, LDS_V=NSLOT*SLOTB, LDS_WS=2*NSLOT*SLOTB, LDS_OST=LDS_WS+NW*64*4, LDS_M=LDS_OST+NW*4096, LDS_BYTES=LDS_M+NW*2048;
constexpr float C2=0.125f*1.4426950408889634f;
__device__ __forceinline__ void glds16s(const void*sbase,unsigned voff,unsigned lds_dst){unsigned keep;
  asm volatile("s_mov_b32 %0, m0\n\ts_mov_b32 m0, %3\n\ts_nop 0\n\tglobal_load_lds_dwordx4 %1, %2\n\ts_mov_b32 m0, %0":"=&s"(keep):"v"(voff),"s"(sbase),"s"(lds_dst):"memory");}
__device__ __forceinline__ void glds16(const void*gsrc,unsigned lds_dst){unsigned keep;
  asm volatile("s_mov_b32 %0, m0\n\ts_mov_b32 m0, %2\n\ts_nop 0\n\tglobal_load_lds_dwordx4 %1, off\n\ts_mov_b32 m0, %0":"=&s"(keep):"v"(gsrc),"s"(lds_dst):"memory");}
__device__ __forceinline__ float max3f(float a,float b,float c){float r;asm("v_max3_f32 %0, %1, %2, %3":"=v"(r):"v"(a),"v"(b),"v"(c));return r;}
__device__ __forceinline__ float max2f(float a,float b){float r;asm("v_max_f32_e32 %0, %1, %2":"=v"(r):"v"(a),"v"(b));return r;}
__device__ __forceinline__ float fadd_s(float a,float b){float r;asm("v_add_f32_e32 %0, %1, %2":"=v"(r):"v"(a),"v"(b));return r;}
__device__ __forceinline__ float fsub_s(float a,float b){float r;asm("v_sub_f32_e32 %0, %1, %2":"=v"(r):"v"(a),"v"(b));return r;}
typedef float f32x2_t __attribute__((ext_vector_type(2))); typedef __bf16 bf16x2_t __attribute__((ext_vector_type(2)));
__device__ __forceinline__ unsigned cvtpk_s(float lo,float hi){f32x2_t v={lo,hi};bf16x2_t b=__builtin_convertvector(v,bf16x2_t);return __builtin_bit_cast(unsigned,b);}
#define WAIT_BAR(N) asm volatile("s_waitcnt vmcnt(" #N ") lgkmcnt(0)\n\ts_barrier":::"memory")

__device__ __forceinline__ void qkt(f32x16&p0,f32x16&p1,const char*Kslot,const bf16x8*qr,int r32,int hi){ const f32x16 negm=f32x16{};
  const char*kb=Kslot+hi*1024+r32*16;
  #pragma unroll
  for(int d0=0;d0<4;++d0){
    const bf16x8 b0=*reinterpret_cast<const bf16x8*>(kb+d0*2048);
    const bf16x8 b1=*reinterpret_cast<const bf16x8*>(kb+d0*2048+512);
    if(d0==0){p0=__builtin_amdgcn_mfma_f32_32x32x16_bf16(b0,qr[0],negm,0,0,0);p1=__builtin_amdgcn_mfma_f32_32x32x16_bf16(b1,qr[0],negm,0,0,0);}
    else{p0=__builtin_amdgcn_mfma_f32_32x32x16_bf16(b0,qr[d0],p0,0,0,0);p1=__builtin_amdgcn_mfma_f32_32x32x16_bf16(b1,qr[d0],p1,0,0,0);}}
}
typedef __attribute__((address_space(3))) const char* lds_cptr;
typedef short v4i16_t __attribute__((ext_vector_type(4)));
__device__ __forceinline__ void kload8(bf16x8*kf,lds_cptr kp){
  kf[0]=*(const __attribute__((address_space(3))) bf16x8*)(kp);      kf[1]=*(const __attribute__((address_space(3))) bf16x8*)(kp+512);
  kf[2]=*(const __attribute__((address_space(3))) bf16x8*)(kp+2048); kf[3]=*(const __attribute__((address_space(3))) bf16x8*)(kp+2560);
  kf[4]=*(const __attribute__((address_space(3))) bf16x8*)(kp+4096); kf[5]=*(const __attribute__((address_space(3))) bf16x8*)(kp+4608);
  kf[6]=*(const __attribute__((address_space(3))) bf16x8*)(kp+6144); kf[7]=*(const __attribute__((address_space(3))) bf16x8*)(kp+6656);
}
__device__ __forceinline__ void kload2(bf16x8*kf,lds_cptr kp,int j){ kf[2*j]=*(const __attribute__((address_space(3))) bf16x8*)(kp+j*2048); kf[2*j+1]=*(const __attribute__((address_space(3))) bf16x8*)(kp+j*2048+512); }
__device__ __forceinline__ s16x4 vtr(lds_cptr p){ return __builtin_bit_cast(s16x4,__builtin_amdgcn_ds_read_tr16_b64_v4i16((__attribute__((address_space(3))) v4i16_t*)p)); }
__device__ __forceinline__ float rowmax(const f32x16&p0,const f32x16&p1){
  float a=max3f(p0[0],p0[1],p1[0]),b=max3f(p0[2],p0[3],p1[1]);a=max3f(a,p1[2],p1[3]);
  #pragma unroll
  for(int r=4;r<16;r+=4){a=max3f(a,p0[r],p0[r+1]);b=max3f(b,p0[r+2],p0[r+3]);a=max3f(a,p1[r],p1[r+1]);b=max3f(b,p1[r+2],p1[r+3]);}
  const float m=max2f(a,b);
  auto rr=__builtin_amdgcn_permlane32_swap(__float_as_uint(m),__float_as_uint(m),false,false);
  return max2f(__uint_as_float(rr[0]),__uint_as_float(rr[1]));
}
__device__ __forceinline__ void pv(f32x16*o,int vb,bf16x8 pa0,bf16x8 pa1,bf16x8 pa2,bf16x8 pa3){
  #pragma unroll
  for(int d0=0;d0<2;++d0){s16x4 lo[4],hi[4];
    #pragma unroll
    for(int ks=0;ks<4;++ks){
      asm volatile("ds_read_b64_tr_b16 %0,%1 offset:%c2":"=&v"(lo[ks]):"v"(vb),"i"(d0*4096+ks*1024):"memory");
      asm volatile("ds_read_b64_tr_b16 %0,%1 offset:%c2":"=&v"(hi[ks]):"v"(vb),"i"(d0*4096+ks*1024+512):"memory");}
    asm volatile("s_waitcnt lgkmcnt(0)":::"memory");SBAR();
    #define PK(k) (bf16x8){lo[k][0],lo[k][1],lo[k][2],lo[k][3],hi[k][0],hi[k][1],hi[k][2],hi[k][3]}
    o[d0]=__builtin_amdgcn_mfma_f32_32x32x16_bf16(pa0,PK(0),o[d0],0,0,0);
    o[d0]=__builtin_amdgcn_mfma_f32_32x32x16_bf16(pa1,PK(1),o[d0],0,0,0);
    o[d0]=__builtin_amdgcn_mfma_f32_32x32x16_bf16(pa2,PK(2),o[d0],0,0,0);
    o[d0]=__builtin_amdgcn_mfma_f32_32x32x16_bf16(pa3,PK(3),o[d0],0,0,0);
    #undef PK
  }
}

#ifndef ATTN_STORE16
#define ATTN_STORE16(p,v) (*(u32x4*)(p)=(v))
#endif
template<int THRL,bool NM> __device__ __forceinline__ void attn_unit(int h,int qb,const bf16*Q,const bf16*__restrict__ K,const bf16*__restrict__ V,const u64*__restrict__ MASK,bf16*O,char*shm){
  int tid_=threadIdx.x; asm volatile("":"+v"(tid_)); const int tid=tid_,lane=tid&63,r32=lane&31,hi=lane>>5; const int wid=__builtin_amdgcn_readfirstlane(tid>>6);
  const long rowbase=0; const int q0=qb*QB;
  const bf16*Qw=Q+(rowbase+q0+wid*QBLK)*DMI+h*D;
  const bf16*Kh=K+rowbase*DMI+h*D,*Vh=V+rowbase*DMI+h*D;
  const unsigned lds0=(unsigned)(uintptr_t)shm;
  float*wsf=(float*)(shm+LDS_WS)+wid*64;
  const unsigned koff=(unsigned)(lane*DMI+wid*8)*2u;
  const unsigned voffv=(unsigned)((16*(wid&3)+(lane>>2))*DMI+(wid>>2)*32+(lane&3)*8)*2u;
  const unsigned kdst=lds0+LDS_K+wid*1024, vdst=lds0+LDS_V+wid*1024;
  const u64*mbase=MASK+q0+wid*QBLK; const int jm=lane>>4; const unsigned mdst=lds0+LDS_M+wid*2048; const unsigned moff0=(unsigned)(lane&15)*16u, moff1=moff0+((jm==1)?(unsigned)SEQ*8u:0u);
  #define DMA_M2(tA,tB,slot) glds16s(mbase+(size_t)(tA)*SEQ,((tB)!=(tA))?moff1:moff0,(unsigned)__builtin_amdgcn_readfirstlane(mdst+(slot)))
  const unsigned sh4=4u*(unsigned)hi; const float NEGINF=-INFINITY;
  #define MAPPLY(C0,C1,MW) do{ const unsigned lo_=(unsigned)(MW)>>sh4, hi_=(unsigned)((MW)>>32)>>sh4; \
    _Pragma("unroll") for(int r=0;r<16;++r){ const int sh_=31-((r&3)+8*(r>>2)); const int m0_=((int)(lo_<<sh_))>>31, m1_=((int)(hi_<<sh_))>>31;   \
      C0[r]=__int_as_float((__float_as_int(C0[r])&m0_)|(~m0_&(int)0xff800000)); C1[r]=__int_as_float((__float_as_int(C1[r])&m1_)|(~m1_&(int)0xff800000)); } }while(0)
  #define DMA_K(t,slot) glds16s(Kh+(long)(t)*KVBLK*DMI,koff,(unsigned)__builtin_amdgcn_readfirstlane(kdst+(slot)))
  #define DMA_V(t,slot) glds16s(Vh+(long)(t)*KVBLK*DMI,voffv,(unsigned)__builtin_amdgcn_readfirstlane(vdst+(slot)))
  const int vb0=(int)(lds0+LDS_V)+((lane>>4)&1)*32+(lane&3)*8+(4*hi+((lane&15)>>2))*64;
  const char*Kbase=shm+LDS_K; bf16x8 kf[8];
  const lds_cptr shm3=(lds_cptr)shm; const lds_cptr mp0=shm3+LDS_M+wid*2048+r32*8;
  #define MLD(off) (*(const __attribute__((address_space(3))) u64*)(mp0+(off)))
  const lds_cptr kp0=shm3+LDS_K+hi*1024+r32*16; const lds_cptr vp0=shm3+LDS_V+((lane>>4)&1)*32+(lane&3)*8+(4*hi+((lane&15)>>2))*64;
  const int NT=(q0+QB)/KVBLK;
  glds16s(mbase,moff0+((jm==0)?(unsigned)SEQ*8u:(jm==1)?(unsigned)SEQ*16u:0u),(unsigned)__builtin_amdgcn_readfirstlane(mdst));
  DMA_K(0,0);DMA_V(0,0);DMA_K(1,SLOTB);
  bf16x8 qr[4];
  #pragma unroll
  for(int d0=0;d0<4;++d0)qr[d0]=*reinterpret_cast<const bf16x8*>(&Qw[(long)r32*DMI+d0*16+hi*8]);
  float mhat=0.f,l_reg=0.f;f32x16 o[2];o[0]=f32x16{};o[1]=f32x16{};const f32x16 Z16=f32x16{};
  bool resc=false;
  #define START(P0,P1,MW) do{ const float rm=NM?0.f:rowmax(P0,P1); resc=false; \
    if(!NM&&__builtin_expect(__any(rm>(float)THRL),0)){ const float dl=__builtin_fmaxf(rm,0.f); mhat+=dl; \
      _Pragma("unroll") for(int r=0;r<16;++r){P0[r]-=dl;P1[r]-=dl;} } \
    MAPPLY(P0,P1,MW); \
    _Pragma("unroll") for(int r=0;r<16;++r)P0[r]=__builtin_amdgcn_exp2f(P0[r]); }while(0)
  #define RESC() do{ if(resc){ asm volatile("s_waitcnt lgkmcnt(0)":::"memory"); \
      _Pragma("unroll") for(int d_=0;d_<2;++d_) _Pragma("unroll") for(int r=0;r<16;++r)o[d_][r]*=wsf[crow(r,hi)]; } }while(0)
  f32x16 pA0,pA1,pB0,pB1;
  int sl_prev=0,sl_cur=0,sl_next=SLOTB;
  #define ROT() do{sl_prev=sl_cur;sl_cur=sl_next;sl_next=(sl_next==(NSLOT-1)*SLOTB)?0:sl_next+SLOTB;}while(0)
  DMA_K(2,2*SLOTB);
  WAIT_BAR(3);
  const u64 mw0=MLD(512);
  qkt(pA0,pA1,Kbase,qr,r32,hi);asm volatile("s_nop 15\n\ts_nop 7":"+v"(pA0),"+v"(pA1));
  START(pA0,pA1,mw0);
  _Pragma("unroll") for(int r=0;r<16;++r)pA1[r]=__builtin_amdgcn_exp2f(pA1[r]);
  WAIT_BAR(0);
  DMA_K(3,0);DMA_V(1,SLOTB);
  ROT();
  kload8(kf,kp0+sl_cur);
  WAIT_BAR(2);
  s16x4 vlo[8],vhi[8]; u32x4 pw0,pw1,pw2,pw3;
  #define PKW(P,B) cvtpk_s(P[B],P[B+1])
  #define PAF(k) __builtin_bit_cast(bf16x8,pw##k)
  #define VFR(i) (bf16x8){vlo[i][0],vlo[i][1],vlo[i][2],vlo[i][3],vhi[i][0],vhi[i][1],vhi[i][2],vhi[i][3]}
  #define PIN(x) asm volatile("":"+v"(x))
  #define MX3(a,b,c) __builtin_fmaxf(__builtin_fmaxf((a),(b)),(c))
  #define GAPA(MF,A0,A1,A2,A3,W0,W1,PW) do{ MF; sacc+=A0; sacc+=A1; sacc+=A2; sacc+=A3; PIN(sacc); W0; W1; PIN(PW); SBAR(); }while(0)
  #define EX(v) __builtin_amdgcn_exp2f(v)
  #define GAPB(MF,X,B) do{ MF; X[B]=EX(X[B]); X[B+1]=EX(X[B+1]); X[B+2]=EX(X[B+2]); X[B+3]=EX(X[B+3]); PIN(X); SBAR(); }while(0)
  #define VRD(i) do{ vlo[i]=vtr(vp_+(((i)>>2)*4096+((i)&3)*1024)); vhi[i]=vtr(vp_+(((i)>>2)*4096+((i)&3)*1024+512)); }while(0)
  #define KRD(G,j) do{ if(G){ kload2(kf,kp0+sl_next,j); SBAR(); } }while(0)
  #define STEP(C0,C1,P0,P1,t,GK,GV,GL,GM,MOFF) do{ SBAR(); \
    const lds_cptr vp_=vp0+sl_prev; \
    VRD(0); SBAR(); float sacc=(P0[0]+P0[1]); \
    GAPA(C0=__builtin_amdgcn_mfma_f32_32x32x16_bf16(kf[0],qr[0],Z16,0,0,0), P0[2],P0[3],P0[4],P0[5],     pw0[0]=PKW(P0,0), pw0[1]=PKW(P0,2), pw0); \
    VRD(4); SBAR(); GAPA(C1=__builtin_amdgcn_mfma_f32_32x32x16_bf16(kf[1],qr[0],Z16,0,0,0), P0[6],P0[7],P0[8],P0[9],     pw0[2]=PKW(P0,4), pw0[3]=PKW(P0,6), pw0); \
    VRD(1); SBAR(); GAPA(C0=__builtin_amdgcn_mfma_f32_32x32x16_bf16(kf[2],qr[1],C0,0,0,0),   P0[10],P0[11],P0[12],P0[13], pw1[0]=PKW(P0,8), pw1[1]=PKW(P0,10), pw1); \
    VRD(5); SBAR(); GAPA(C1=__builtin_amdgcn_mfma_f32_32x32x16_bf16(kf[3],qr[1],C1,0,0,0),   P0[14],P0[15],P1[0],P1[1],   pw1[2]=PKW(P0,12),pw1[3]=PKW(P0,14), pw1); \
    VRD(2); SBAR(); GAPA(C0=__builtin_amdgcn_mfma_f32_32x32x16_bf16(kf[4],qr[2],C0,0,0,0),   P1[2],P1[3],P1[4],P1[5],     pw2[0]=PKW(P1,0), pw2[1]=PKW(P1,2), pw2); \
    VRD(6); SBAR(); GAPA(C1=__builtin_amdgcn_mfma_f32_32x32x16_bf16(kf[5],qr[2],C1,0,0,0),   P1[6],P1[7],P1[8],P1[9],     pw2[2]=PKW(P1,4), pw2[3]=PKW(P1,6), pw2); \
    VRD(3); SBAR(); GAPA(C0=__builtin_amdgcn_mfma_f32_32x32x16_bf16(kf[6],qr[3],C0,0,0,0),   P1[10],P1[11],P1[12],P1[13], pw3[0]=PKW(P1,8), pw3[1]=PKW(P1,10), pw3); \
    VRD(7); SBAR(); GAPA(C1=__builtin_amdgcn_mfma_f32_32x32x16_bf16(kf[7],qr[3],C1,0,0,0),   P1[14],P1[15],0.f,0.f,       pw3[2]=PKW(P1,12),pw3[3]=PKW(P1,14), pw3); \
    l_reg+=sacc; \
    if(GK){DMA_K((t)+3,sl_cur);} if(GV){DMA_V((t)+1,sl_next);} if(GM){ const int tb_=((t)+3<NT)?(t)+3:NT-1; DMA_M2((t)+2,tb_,mslot^1024); } \
    const u64 mw_=MLD(MOFF); \
    resc=false; \
    if(!NM){ if(__builtin_expect(__any(mhat!=0.f),0)){ _Pragma("unroll") for(int r=0;r<16;++r){C0[r]-=mhat;C1[r]-=mhat;} } \
      float a=MX3(C0[0],C0[1],C1[0]),b=MX3(C0[2],C0[3],C1[1]); a=MX3(a,C1[2],C1[3]); \
      _Pragma("unroll") for(int r=4;r<16;r+=4){a=MX3(a,C0[r],C0[r+1]);b=MX3(b,C0[r+2],C0[r+3]);a=MX3(a,C1[r],C1[r+1]);b=MX3(b,C1[r+2],C1[r+3]);} \
      float rm=__builtin_fmaxf(a,b); { auto rr=__builtin_amdgcn_permlane32_swap(__float_as_uint(rm),__float_as_uint(rm),false,false); rm=__builtin_fmaxf(__uint_as_float(rr[0]),__uint_as_float(rr[1])); } \
      resc=false; \
      if(__builtin_expect(__any(rm>(float)THRL),0)){ const float dl=__builtin_fmaxf(rm,0.f); mhat+=dl; \
        _Pragma("unroll") for(int r=0;r<16;++r){C0[r]-=dl;C1[r]-=dl;} \
        const float f=__builtin_amdgcn_exp2f(-dl); l_reg*=f; if(hi==0)wsf[r32]=f; resc=true; } } \
    MAPPLY(C0,C1,mw_); \
    SBAR(); \
    GAPB(o[0]=__builtin_amdgcn_mfma_f32_32x32x16_bf16(PAF(0),VFR(0),o[0],0,0,0), C0,0); \
    GAPB(o[1]=__builtin_amdgcn_mfma_f32_32x32x16_bf16(PAF(0),VFR(4),o[1],0,0,0), C0,4); \
    KRD(GL,0); GAPB(o[0]=__builtin_amdgcn_mfma_f32_32x32x16_bf16(PAF(1),VFR(1),o[0],0,0,0), C0,8); \
    KRD(GL,1); GAPB(o[1]=__builtin_amdgcn_mfma_f32_32x32x16_bf16(PAF(1),VFR(5),o[1],0,0,0), C0,12); \
    KRD(GL,2); GAPB(o[0]=__builtin_amdgcn_mfma_f32_32x32x16_bf16(PAF(2),VFR(2),o[0],0,0,0), C1,0); \
    KRD(GL,3); GAPB(o[1]=__builtin_amdgcn_mfma_f32_32x32x16_bf16(PAF(2),VFR(6),o[1],0,0,0), C1,4); \
    GAPB(o[0]=__builtin_amdgcn_mfma_f32_32x32x16_bf16(PAF(3),VFR(3),o[0],0,0,0), C1,8); \
    GAPB(o[1]=__builtin_amdgcn_mfma_f32_32x32x16_bf16(PAF(3),VFR(7),o[1],0,0,0), C1,12); \
    }while(0)
  int t=1; int mslot=0;
  for(;t+5<NT;t+=2){
    STEP(pB0,pB1,pA0,pA1,t,true,true,true,true,mslot);          WAIT_BAR(3); RESC(); ROT();
    STEP(pA0,pA1,pB0,pB1,t+1,true,true,true,false,mslot+256);   WAIT_BAR(2); RESC(); ROT(); mslot^=1024;
  }
  #define ENDW(nf) do{ if((nf)==3){WAIT_BAR(3);} else if((nf)==2){WAIT_BAR(2);} else if((nf)==1){WAIT_BAR(1);} else {WAIT_BAR(0);} }while(0)
  for(;t+1<NT;t+=2){
    { const bool gk=(t+3<NT),gv=(t+1<NT),gm=(t+2<NT); STEP(pB0,pB1,pA0,pA1,t,gk,gv,gv,gm,mslot);   ENDW((int)gk+(int)gv+(int)gm); RESC(); ROT(); }
    { const bool gk=(t+4<NT),gv=(t+2<NT);             STEP(pA0,pA1,pB0,pB1,t+1,gk,gv,gv,false,mslot+256); ENDW((t+3<NT)?((int)gk+(int)gv):0); RESC(); ROT(); mslot^=1024; }
  }
  STEP(pB0,pB1,pA0,pA1,NT-1,false,false,false,false,mslot); RESC();
  { float sacc=pB0[0]+pB0[1]; _Pragma("unroll") for(int r=2;r<16;++r)sacc+=pB0[r]; _Pragma("unroll") for(int r=0;r<16;++r)sacc+=pB1[r]; l_reg+=sacc;
    pw0=(u32x4){PKW(pB0,0),PKW(pB0,2),PKW(pB0,4),PKW(pB0,6)};pw1=(u32x4){PKW(pB0,8),PKW(pB0,10),PKW(pB0,12),PKW(pB0,14)};pw2=(u32x4){PKW(pB1,0),PKW(pB1,2),PKW(pB1,4),PKW(pB1,6)};pw3=(u32x4){PKW(pB1,8),PKW(pB1,10),PKW(pB1,12),PKW(pB1,14)};
    SBAR(); pv(o,vb0+sl_cur,PAF(0),PAF(1),PAF(2),PAF(3)); }
  #undef PKW
  #undef PAF
  #undef VFR
  #undef PIN
  #undef MX3
  #undef GAPA
  #undef GAPB
  #undef EX
  #undef VRD
  #undef KRD
  #undef STEP
  #undef ENDW
  {auto rr=__builtin_amdgcn_permlane32_swap(__float_as_uint(l_reg),__float_as_uint(l_reg),false,false);l_reg=__uint_as_float(rr[0])+__uint_as_float(rr[1]);}
  if(hi==0)wsf[32+r32]=l_reg;asm volatile("s_waitcnt lgkmcnt(0)":::"memory");
  float rli[16];
  #pragma unroll
  for(int r=0;r<16;++r)rli[r]=__builtin_amdgcn_rcpf(wsf[32+crow(r,hi)]);
  bf16*Ow=O+(rowbase+q0+wid*QBLK)*DMO+h*D;
  { bf16*stg=(bf16*)(shm+LDS_OST)+wid*2048;
    #pragma unroll
    for(int r=0;r<16;++r){const int orow=crow(r,hi);
      #pragma unroll
      for(int d0=0;d0<2;++d0)stg[orow*64+d0*32+r32]=__float2bfloat16(o[d0][r]*rli[r]);}
    asm volatile("s_waitcnt lgkmcnt(0)":::"memory");
    #pragma unroll
    for(int i=0;i<4;++i){const int row=i*8+(lane>>3),ch=lane&7; const u32x4 v=*(const u32x4*)(stg+row*64+ch*8); ATTN_STORE16(Ow+(long)row*DMO+ch*8,v);} }
  asm volatile("s_waitcnt lgkmcnt(0)\n\ts_barrier":::"memory");
  #undef DMA_K
  #undef DMA_V
  #undef DMA_M2
  #undef MAPPLY
  #undef MLD
  #undef START
  #undef RESC
  #undef ROT
}
constexpr int ATTN_LDS_BYTES=LDS_BYTES;
template<int THRL,bool NM> __device__ __forceinline__ void attn_phase(char*lds,const bf16*Q,const bf16*K,const bf16*V,const u64*MASK,bf16*O){
  const int G=gridDim.x;
  for(int w=blockIdx.x;w<256;w+=G){ const int h=w&7,s=w>>3; attn_unit<THRL,NM>(h,s,Q,K,V,MASK,O,lds); attn_unit<THRL,NM>(h,63-s,Q,K,V,MASK,O,lds); }
}
#undef SBAR
#undef WAIT_BAR
}

__device__ __forceinline__ void phase_route_naive(const Params& p, unsigned char* lds) {
    const int tid = opaque_tid(), lane = tid & 63, wave = tid >> 6;
    const int gw = blockIdx.x * NWAVES + wave, NGW = gridDim.x * NWAVES;
    const float* H2 = (const float*)(p.ws + WS_H2); const float* WGRT = (const float*)(p.ws + WS_WGRT);
    float* RSTD = (float*)(p.ws + WS_RSTD); int* TOKOF = (int*)(p.ws + WS_TOKOF); float* GATEOF = (float*)(p.ws + WS_GATEOF); int* PAIR = (int*)(p.ws + WS_PAIR);
    unsigned* CNT = (unsigned*)(p.ws + WS_CTL) + CW_CNT;
    for (int t = gw; t < S; t += NGW) {
        const f32x4* hr = (const f32x4*)(H2 + (size_t)t * D) + lane; f32x4 v[4]; float ss = 0.f;
#pragma unroll
        for (int j = 0; j < 4; ++j) { v[j] = hr[64 * j]; ss += v[j].x * v[j].x + v[j].y * v[j].y + v[j].z * v[j].z + v[j].w * v[j].w; }
        const float rstd = rsqrtf(wave_sum(ss) * (1.f / D) + EPS);
        float mine = -INFINITY;
        for (int e = 0; e < NE; ++e) { const f32x4* wr = (const f32x4*)(WGRT + (size_t)e * D) + lane; float a = 0.f;
#pragma unroll
            for (int j = 0; j < 4; ++j) { const f32x4 w = wr[64 * j]; a = fmaf(v[j].x, w.x, a); a = fmaf(v[j].y, w.y, a); a = fmaf(v[j].z, w.z, a); a = fmaf(v[j].w, w.w, a); }
            a = wave_sum(a); if (lane == e) mine = a * rstd + p.b_router[e]; }
        float tv[4]; int te[4];
#pragma unroll
        for (int k = 0; k < 4; ++k) { float bv = mine; int bi = lane;
#pragma unroll
            for (int o = 32; o >= 1; o >>= 1) { const float ov = __shfl_xor(bv, o); const int oi = __shfl_xor(bi, o); if (ov > bv || (ov == bv && oi < bi)) { bv = ov; bi = oi; } }
            tv[k] = bv; te[k] = bi; if (lane == bi) mine = -INFINITY; }
        float g[4], gs = 0.f;
#pragma unroll
        for (int k = 0; k < 4; ++k) { g[k] = __expf(tv[k] - tv[0]); gs += g[k]; }
        if (lane == 0) RSTD[t] = rstd;
        if (lane < 4) { const int e = lane == 0 ? te[0] : lane == 1 ? te[1] : lane == 2 ? te[2] : te[3]; const float gg = (lane == 0 ? g[0] : lane == 1 ? g[1] : lane == 2 ? g[2] : g[3]) / gs;
            const unsigned slot = atomicAdd(&CNT[e], 1u); TOKOF[e * S + slot] = t; GATEOF[e * S + slot] = gg; PAIR[t * 4 + lane] = (e << 16) | (int)slot; }
    }
}

__device__ __forceinline__ void phase_route_fast(const Params& p, unsigned char* lds) {
    typedef float f32x16 __attribute__((ext_vector_type(16)));
    const int tid = opaque_tid(), lane = tid & 63, wave = tid >> 6, j = lane & 31, kk = lane >> 5, tsel = wave >> 2, kq = wave & 3;
    const float* H2 = (const float*)(p.ws + WS_H2); const float* WGR = (const float*)(p.ws + WS_WGRT) + 65536;
    float* RSTD = (float*)(p.ws + WS_RSTD); int* TOKOF = (int*)(p.ws + WS_TOKOF); float* GATEOF = (float*)(p.ws + WS_GATEOF); int* PAIR = (int*)(p.ws + WS_PAIR);
    unsigned* CNT = (unsigned*)(p.ws + WS_CTL) + CW_CNT;
    LAS float* sc = (LAS float*)((LAS unsigned char*)lds + wave * 8192);
    for (int tp = blockIdx.x; tp < S / 64; tp += gridDim.x) {
        const int t0 = (tp * 2 + tsel) * 32;
        const float* arow = H2 + (size_t)(t0 + j) * D + kq * 256 + 4 * kk; const float* bcol = WGR + (kq * 256 + 4 * kk) * NE + j;
        f32x16 acc = f32x16{}; float ss = 0.f;
#pragma unroll 8
        for (int m = 0; m < 32; ++m) { const f32x4 a = *(const f32x4*)(arow + 8 * m);
            const float b0 = bcol[(8 * m + 0) * NE], b1 = bcol[(8 * m + 1) * NE], b2 = bcol[(8 * m + 2) * NE], b3 = bcol[(8 * m + 3) * NE];
            acc = __builtin_amdgcn_mfma_f32_32x32x2f32(a.x, b0, acc, 0, 0, 0); acc = __builtin_amdgcn_mfma_f32_32x32x2f32(a.y, b1, acc, 0, 0, 0);
            acc = __builtin_amdgcn_mfma_f32_32x32x2f32(a.z, b2, acc, 0, 0, 0); acc = __builtin_amdgcn_mfma_f32_32x32x2f32(a.w, b3, acc, 0, 0, 0);
            ss += a.x * a.x + a.y * a.y + a.z * a.z + a.w * a.w; }
        ss += __shfl_xor(ss, 32);
        __syncthreads();
#pragma unroll
        for (int r = 0; r < 16; ++r) sc[((r & 3) + 8 * (r >> 2) + 4 * kk) * 33 + j] = acc[r];
        if (kk == 0) sc[32 * 33 + j] = ss;
        __syncthreads();
        if (kq == 0) {
            const LAS float* s0 = sc, *s1 = sc + 2048, *s2 = sc + 4096, *s3 = sc + 6144;
            const float sst = s0[32 * 33 + j] + s1[32 * 33 + j] + s2[32 * 33 + j] + s3[32 * 33 + j];
            const float rstd = rsqrtf(sst * (1.f / D) + EPS);
            float v[32];
#pragma unroll
            for (int e = 0; e < 32; ++e) v[e] = ((s0[j * 33 + e] + s1[j * 33 + e]) + (s2[j * 33 + e] + s3[j * 33 + e])) * rstd + p.b_router[e];
            float tv[4]; int te[4]; unsigned taken = 0u;
#pragma unroll
            for (int k = 0; k < 4; ++k) { float best = -INFINITY; int bi = 0;
#pragma unroll
                for (int e = 0; e < 32; ++e) { const bool ok = !((taken >> e) & 1u) && (v[e] > best); best = ok ? v[e] : best; bi = ok ? e : bi; }
                tv[k] = best; te[k] = bi; taken |= 1u << bi; }
            float g[4], gs = 0.f;
#pragma unroll
            for (int k = 0; k < 4; ++k) { g[k] = __expf(tv[k] - tv[0]); gs += g[k]; }
            const float gi = 1.f / gs;
            const bool act = lane < 32; int rk[4] = {0, 0, 0, 0}; unsigned mycnt = 0u;
#pragma unroll 4
            for (int e = 0; e < 32; ++e) { const bool pick = act && ((taken >> e) & 1u); const u64 m = __ballot(pick); const int below = __popcll(m & ((1ull << lane) - 1ull));
                if (lane == e) mycnt = (unsigned)__popcll(m);
#pragma unroll
                for (int k = 0; k < 4; ++k) rk[k] = (te[k] == e) ? below : rk[k]; }
            unsigned base = 0u; if (act && mycnt) base = atomicAdd(&CNT[lane], mycnt);
#pragma unroll
            for (int k = 0; k < 4; ++k) { const unsigned be = (unsigned)__shfl((int)base, te[k]); if (act) { const int slot = (int)be + rk[k]; const int t = t0 + lane;
                    TOKOF[te[k] * S + slot] = t; GATEOF[te[k] * S + slot] = g[k] * gi; PAIR[t * 4 + k] = (te[k] << 16) | slot; } }
            if (act) RSTD[t0 + lane] = rstd;
        }
    }
}

__device__ __forceinline__ int build_tiles(const Params& p, unsigned char* lds) {
    int* pst = (int*)(lds + LDS_MISC); int* tile_e = pst + 40;
    const unsigned* CNT = (const unsigned*)(p.ws + WS_CTL) + CW_CNT;
    __syncthreads();
    if (opaque_tid() == 0) { int acc = 0; for (int e = 0; e < NE; ++e) { pst[e] = acc; const int c = (int)__hip_atomic_load(&CNT[e], __ATOMIC_RELAXED, __HIP_MEMORY_SCOPE_AGENT); pst[328 + e] = c; const int nt = (c + 255) >> 8; for (int i = 0; i < nt; ++i) tile_e[acc + i] = e; acc += nt; } pst[NE] = acc; }
    __syncthreads();
    return pst[NE];
}

__device__ __forceinline__ void phase_gather(const Params& p, unsigned char* lds) {
    const int tid = opaque_tid(), lane = tid & 63, wave = tid >> 6;
    const int gw = blockIdx.x * NWAVES + wave, NGW = gridDim.x * NWAVES;
    build_tiles(p, lds); const int* pst = (const int*)(lds + LDS_MISC);
    const bf16* XN2 = (const bf16*)(p.ws + WS_XN); bf16* XS = (bf16*)(p.ws + WS_XS); const int* PAIR = (const int*)(p.ws + WS_PAIR);
    const float* RSTD = (const float*)(p.ws + WS_RSTD); const float* GATEOF = (const float*)(p.ws + WS_GATEOF);
    float* ROWRSTD = (float*)(p.ws + WS_ROWRSTD); float* ROWGATE = (float*)(p.ws + WS_ROWGATE);
#if FUSED_GATHER
    int* ROWTOK = (int*)(p.ws + WS_ROWTOK); const int* tile_e = pst + 40; const unsigned* CNT = (const unsigned*)(p.ws + WS_CTL) + CW_CNT; (void)XN2; (void)XS; (void)lane; (void)gw; (void)NGW;
    for (int row = blockIdx.x * NTHREADS + tid; row < pst[NE] * 256; row += gridDim.x * NTHREADS) { const int e = tile_e[row >> 8]; if (row - pst[e] * 256 >= (int)CNT[e]) ROWTOK[row] = 0; }
    for (int pr = blockIdx.x * NTHREADS + tid; pr < S * 4; pr += gridDim.x * NTHREADS) { const int t = pr >> 2; const int pe = PAIR[pr]; const int e = pe >> 16, slot = pe & 0xffff; const int row = pst[e] * 256 + slot;
        ROWTOK[row] = t; ROWRSTD[row] = RSTD[t]; ROWGATE[row] = GATEOF[e * S + slot]; }
#else
    for (int pr0 = gw * 4; pr0 < S * 4; pr0 += NGW * 4) {
        int row[4]; u32x4 va[4], vb[4];
#pragma unroll
        for (int i = 0; i < 4; ++i) { const int pr = pr0 + i, t = pr >> 2; const int pe = PAIR[pr]; const int e = pe >> 16, slot = pe & 0xffff; row[i] = pst[e] * 256 + slot;
            const u32x4* src = (const u32x4*)(XN2 + (size_t)t * D); va[i] = src[lane]; vb[i] = src[lane + 64];
            if (lane == 0) { ROWRSTD[row[i]] = RSTD[t]; ROWGATE[row[i]] = GATEOF[e * S + slot]; } }
#pragma unroll
        for (int i = 0; i < 4; ++i) { u32x4* dst = (u32x4*)(XS + (size_t)row[i] * D); dst[lane] = va[i]; dst[lane + 64] = vb[i]; }
    }
#endif
}

__device__ __forceinline__ void phase_final(const Params& p, unsigned char* lds) {
    const int tid = opaque_tid(), lane = tid & 63, wave = tid >> 6;
    const int gw = blockIdx.x * NWAVES + wave, NGW = gridDim.x * NWAVES;
    build_tiles(p, lds); const int* pst = (const int*)(lds + LDS_MISC);
    const float* H2 = (const float*)(p.ws + WS_H2); const bf16* YS = (const bf16*)(p.ws + WS_YS); const int* PAIR = (const int*)(p.ws + WS_PAIR);
    for (int t = gw; t < S; t += NGW) {
        const f32x4* hr = (const f32x4*)(H2 + (size_t)t * D) + lane; f32x4 v[4];
#pragma unroll
        for (int j = 0; j < 4; ++j) v[j] = hr[64 * j];
#pragma unroll
        for (int k = 0; k < 4; ++k) { const int pe = PAIR[t * 4 + k]; const int row = pst[pe >> 16] * 256 + (pe & 0xffff); const uint2* yr = (const uint2*)(YS + (size_t)row * D) + lane;
#pragma unroll
            for (int j = 0; j < 4; ++j) { const uint2 y = yr[64 * j]; v[j].x += blo(y.x); v[j].y += bhi(y.x); v[j].z += blo(y.y); v[j].w += bhi(y.y); } }
        float ss = 0.f;
#pragma unroll
        for (int j = 0; j < 4; ++j) ss += v[j].x * v[j].x + v[j].y * v[j].y + v[j].z * v[j].z + v[j].w * v[j].w;
        const float rstd = rsqrtf(wave_sum(ss) * (1.f / D) + EPS);
        f32x4* o = (f32x4*)(p.out + (size_t)t * D) + lane;
#pragma unroll
        for (int j = 0; j < 4; ++j) { const f32x4 g = ((const f32x4*)p.norm_final_g)[lane + 64 * j]; o[64 * j] = (f32x4){v[j].x * rstd * g.x, v[j].y * rstd * g.y, v[j].z * rstd * g.z, v[j].w * rstd * g.w}; }
    }
}

#define GAS __attribute__((address_space(1)))
typedef GAS unsigned gu32;
#define XB_TMO      128
#define XB_XCNT(j)  (256  + 64 * (j))
#define XB_XSUB(j)  (1280 + 64 * (j))
#define XB_XGEN(j)  (2304 + 64 * (j))
#define XB_TOP      3328
#define XB_TOPGEN   3392
#define XCD_BAR_WORDS 3456
#define XB_SPIN_CAP (1u << 18)

__device__ __forceinline__ unsigned xb_ld(unsigned* p)              { return __hip_atomic_load(p, __ATOMIC_RELAXED, __HIP_MEMORY_SCOPE_AGENT); }
__device__ __forceinline__ unsigned xb_add(unsigned* p, unsigned v) { return __hip_atomic_fetch_add(p, v, __ATOMIC_RELAXED, __HIP_MEMORY_SCOPE_AGENT); }
__device__ __forceinline__ unsigned xb_xcc_id() { return (unsigned)__builtin_amdgcn_s_getreg((3 << 11) | 20) & 0xFu; }
#define XB_SPIN(cond, bar) do { unsigned _sp = 0; while (cond) { __builtin_amdgcn_s_sleep(1); \
    if ((++_sp & 255u) == 0u) { if (xb_ld(&(bar)[XB_TMO])) break; if (_sp > XB_SPIN_CAP) { atomicAdd(&(bar)[XB_TMO], 1u); break; } } } } while (0)

struct XcdBarrier {
    unsigned* bar; unsigned x;
    volatile LAS unsigned* st;
};

__device__ __forceinline__ XcdBarrier xcd_barrier_post(unsigned* bar, volatile LAS unsigned* st) {
    XcdBarrier b; b.bar = bar; b.x = xb_xcc_id(); b.st = st;
    if (threadIdx.x == 0) (void)xb_add(&bar[XB_XCNT(b.x)], 1u);
    return b;
}
__device__ __forceinline__ void xcd_barrier_complete(unsigned* bar, unsigned x, unsigned& nloc, unsigned& nx) {
    const unsigned G = gridDim.x * gridDim.y * gridDim.z;
    unsigned sum, cnt, mine, sp = 0u;
    for (;;) {
        sum = 0u; cnt = 0u; mine = 0u;
#pragma unroll
        for (unsigned j = 0; j < 16; ++j) { const unsigned c = xb_ld(&bar[XB_XCNT(j)]); sum += c; cnt += (c > 0u) ? 1u : 0u; mine = (j == x) ? c : mine; }
        if (sum == G) break;
        __builtin_amdgcn_s_sleep(1);
        if ((++sp & 255u) == 0u) { if (xb_ld(&bar[XB_TMO])) break; if (sp > XB_SPIN_CAP) { atomicAdd(&bar[XB_TMO], 1u); break; } }
    }
    nloc = mine > 0u ? mine : 1u; nx = cnt > 0u ? cnt : 1u;
}

__device__ __forceinline__ void xcd_barrier(const XcdBarrier& b) {
    asm volatile("s_waitcnt vmcnt(0)" ::: "memory");
    __syncthreads();
    if (threadIdx.x == 0) {
        unsigned* bar = b.bar;
        __builtin_amdgcn_s_waitcnt(0);
        unsigned nloc = b.st[0], nx = b.st[1];
        if (nloc == 0u) { xcd_barrier_complete(bar, b.x, nloc, nx); b.st[0] = nloc; b.st[1] = nx; }
        const unsigned old = xb_add(&bar[XB_XSUB(b.x)], 1u);
        const unsigned gen = old / nloc;
        if (old + 1u == (gen + 1u) * nloc) {
            __builtin_amdgcn_fence(__ATOMIC_RELEASE, "agent");
            asm volatile("s_waitcnt vmcnt(0)" ::: "memory");
            const unsigned og = xb_add(&bar[XB_TOP], 1u);
            const unsigned tg = og / nx;
            if (og + 1u == (tg + 1u) * nx) xb_add(&bar[XB_TOPGEN], 1u);
            else XB_SPIN(xb_ld(&bar[XB_TOPGEN]) == tg, bar);
            __builtin_amdgcn_fence(__ATOMIC_ACQUIRE, "agent");
            xb_add(&bar[XB_XGEN(b.x)], 1u);
            asm volatile("s_waitcnt vmcnt(0)" ::: "memory");
        } else {
            XB_SPIN(xb_ld(&bar[XB_XGEN(b.x)]) == gen, bar);
            __builtin_amdgcn_fence(__ATOMIC_ACQUIRE, "agent");
            asm volatile("s_waitcnt vmcnt(0)" ::: "memory");
        }
    }
    __syncthreads();
}

#ifndef FAST_GEMM
#define FAST_GEMM 1
#endif
#ifndef FAST_ATT
#define FAST_ATT 1
#endif
#ifndef FAST_IDX
#define FAST_IDX 1
#endif
#ifndef FAST_EW
#define FAST_EW 1
#endif
#ifndef FAST_ROUTE
#define FAST_ROUTE 1
#endif
template <class F, class Sched>
__device__ __forceinline__ void run_gemm_gather(unsigned char* lds, const bf16* A, const bf16* Bt, int K, const Sched& S, const F& f) {
    pg8::Gemm g{A, Bt, 0, 0, K}; EpiAdapt<F> E{f};
    pg8::gemm_phase<EpiAdapt<F>, Sched, true, true, true>((LAS unsigned char*)lds, g, S, E);
    __syncthreads();
}
template <class F, class Sched>
__device__ __forceinline__ void run_gemm(unsigned char* lds, const bf16* A, const bf16* Bt, int K, const Sched& S, const F& f) {
#if FAST_GEMM
    pg8::Gemm g{A, Bt, 0, 0, K}; EpiAdapt<F> E{f};
    pg8::gemm_phase<EpiAdapt<F>, Sched, true, true>((LAS unsigned char*)lds, g, S, E);
#else
    Unit u;
    for (int i = 0; S.next(i, u); ++i) ngemm_unit(lds, A + (size_t)u.pm * 256 * K, K, Bt + (size_t)S.bidx(u) * 256 * K, K, K, f, u);
#endif
    __syncthreads();
}

#ifndef PROBE_MULT
#define PROBE_MULT 8
#endif
#if PROBE_PHASE >= 0
#define STAMP(i) do { if (blockIdx.x == 0 && opaque_tid() == 0) ((volatile LAS unsigned long long*)((LAS unsigned char*)lds + LDS_PROBE))[i] = __builtin_amdgcn_s_memrealtime(); } while (0)
#else
#define STAMP(i) do { } while (0)
#endif
__global__ void __launch_bounds__(NTHREADS, 2) fwd_kernel(Params p) {
    extern __shared__ __attribute__((aligned(16))) unsigned char lds[];
    cg::grid_group grid = cg::this_grid();
    const int G = gridDim.x, bx = blockIdx.x;
    const LAS int* tile_e = (const LAS int*)((LAS unsigned char*)lds + LDS_MISC) + 40;
    volatile LAS unsigned* bst = (volatile LAS unsigned*)((LAS unsigned char*)lds + LDS_MISC + 4096);
    if (opaque_tid() < 2) bst[opaque_tid()] = 0u;
    __syncthreads();
    const XcdBarrier xbar = xcd_barrier_post((unsigned*)(p.ws + WS_CTL) + CW_BAR, bst);
#if PROBE_PHASE >= 200
    if (opaque_tid() < 16) ((volatile LAS unsigned long long*)((LAS unsigned char*)lds + LDS_PROBE + 256))[opaque_tid()] = 0ull;
#endif
    STAMP(0);
    phase_prologue(p, lds);
    if (gridDim.y == 0xffffu) grid.sync();
    xcd_barrier(xbar);
    STAMP(1);
    { pg8::StaticOrder so; so.init(S, NP, G, bx); EpiProj E{(bf16*)(p.ws + WS_PROJ)};
        run_gemm(lds, (const bf16*)(p.ws + WS_XN), (const bf16*)(p.ws + WS_WINT), D, so, E); }
    xcd_barrier(xbar);
    STAMP(2);
#if FAST_EW
    phase_ew_fast(p, lds);
#else
    phase_ew_naive(p, lds);
#endif
    xcd_barrier(xbar);
    STAMP(3);
#if FAST_IDX
    idxf::idx_phase(p, lds);
    __syncthreads();
#else
    phase_idx_naive(p, lds);
#endif
    xcd_barrier(xbar);
    STAMP(4);
#if FAST_ATT
    {
        const int tid = opaque_tid(); const int hq = bx & 7, sq = (bx >> 3) & 31; const int row = ((tid < 256) ? sq : 63 - sq) * 256 + (tid & 255);
        const bf16* qp = (const bf16*)(p.ws + WS_PROJ) + (size_t)row * NP + C_Q + hq * 64; float q1 = 0.f;
#pragma unroll
        for (int j = 0; j < 8; ++j) { const u32x4 v = *(const u32x4*)(qp + j * 8); q1 += fabsf(blo(v.x)) + fabsf(bhi(v.x)) + fabsf(blo(v.y)) + fabsf(bhi(v.y)) + fabsf(blo(v.z)) + fabsf(bhi(v.z)) + fabsf(blo(v.w)) + fabsf(bhi(v.w)); }
        q1 = wave_max(q1); LAS float* qb = (LAS float*)((LAS unsigned char*)lds + LDS_MISC + 4224); if ((tid & 63) == 0) qb[tid >> 6] = q1;
        __syncthreads();
        float qm = qb[0];
#pragma unroll
        for (int w = 1; w < 8; ++w) qm = fmaxf(qm, qb[w]);
        const float kmaxel = *(const float*)((const unsigned*)(p.ws + WS_CTL) + CW_KMAX); const bool nomax = (G == 256) && (qm * kmaxel <= 96.f);
        const attn_body::bf16* PJ = (const attn_body::bf16*)(p.ws + WS_PROJ); const u64* MK = (const u64*)(p.ws + WS_MASK); attn_body::bf16* MO = (attn_body::bf16*)(p.ws + WS_MIX) + 512;
        if (nomax) attn_body::attn_phase<96, true>((char*)lds, PJ + C_Q, PJ + C_K, PJ + C_V, MK, MO);
        else attn_body::attn_phase<96, false>((char*)lds, PJ + C_Q, PJ + C_K, PJ + C_V, MK, MO); }
    __syncthreads();
#else
    phase_att_naive(p, lds);
#endif
    xcd_barrier(xbar);
    STAMP(5);
    { pg8::StaticOrder so; so.init(S, D, G, bx); EpiOut E{p.x, p.norm_ffn_g, (float*)(p.ws + WS_H2), (bf16*)(p.ws + WS_XN)};
        run_gemm(lds, (const bf16*)(p.ws + WS_MIX), (const bf16*)(p.ws + WS_WOUTT), D, so, E); }
    xcd_barrier(xbar);
    STAMP(6);
#if FAST_ROUTE
    phase_route_fast(p, lds);
#else
    phase_route_naive(p, lds);
#endif
    xcd_barrier(xbar);
    STAMP(7);
    { const int ntile = build_tiles(p, lds); const LAS int* pst = (const LAS int*)((LAS unsigned char*)lds + LDS_MISC);
        MoeOrder mo; mo.so.init(ntile * 256, 2048, G, bx); mo.tile_e = tile_e; mo.ncol = 8; mo.ltok = (const LAS int*)((LAS unsigned char*)lds + LDS_LTOK);
        EpiGU E{p.b_gu, (const LAS float*)((LAS unsigned char*)lds + LDS_LRS), (bf16*)(p.ws + WS_HDN), tile_e};
        { const int* TOKOF = (const int*)(p.ws + WS_TOKOF); const float* RSTD = (const float*)(p.ws + WS_RSTD); LAS int* lt = (LAS int*)((LAS unsigned char*)lds + LDS_LTOK); LAS float* lr = (LAS float*)((LAS unsigned char*)lds + LDS_LRS);
            Unit u; const int tid = opaque_tid();
            for (int i = 0; i < 9 && mo.next(i, u); ++i) if (tid < 256) { const int e = tile_e[u.pm], slot = (u.pm - pst[e]) * 256 + tid; const bool valid = slot < pst[328 + e];
                    const int tok = valid ? TOKOF[e * S + slot] : 0; lt[i * 256 + tid] = tok; lr[i * 256 + tid] = valid ? RSTD[tok] : 0.f; }
            __syncthreads(); }
        run_gemm_gather(lds, (const bf16*)(p.ws + WS_XN), (const bf16*)(p.ws + WS_WGUT), D, mo, E);
    }
    xcd_barrier(xbar);
    STAMP(8);
    { const int ntile = build_tiles(p, lds);
        MoeOrder mo; mo.so.init(ntile * 256, D, G, bx); mo.tile_e = tile_e; mo.ncol = 4; mo.ltok = nullptr; const LAS int* pst = (const LAS int*)((LAS unsigned char*)lds + LDS_MISC);
        EpiDown E{p.b_down, (const LAS float*)((LAS unsigned char*)lds + LDS_LRS), (bf16*)(p.ws + WS_YS), tile_e};
        { const float* GATEOF = (const float*)(p.ws + WS_GATEOF); LAS float* lg = (LAS float*)((LAS unsigned char*)lds + LDS_LRS); Unit u; const int tid = opaque_tid();
            for (int i = 0; i < 9 && mo.next(i, u); ++i) if (tid < 256) { const int e = tile_e[u.pm], slot = (u.pm - pst[e]) * 256 + tid; lg[i * 256 + tid] = (slot < pst[328 + e]) ? GATEOF[e * S + slot] : 0.f; }
            __syncthreads(); }
        run_gemm(lds, (const bf16*)(p.ws + WS_HDN), (const bf16*)(p.ws + WS_WDT), DE, mo, E); }
    xcd_barrier(xbar);
    STAMP(9);
    phase_final(p, lds);
#if PROBE_PHASE >= 0
    STAMP(10);
    if (blockIdx.x == 0 && opaque_tid() == 0) { volatile LAS unsigned long long* st = (volatile LAS unsigned long long*)((LAS unsigned char*)lds + LDS_PROBE);
#if PROBE_PHASE >= 200
        const unsigned long long dt = ((volatile LAS unsigned long long*)((LAS unsigned char*)lds + LDS_PROBE + 256))[PROBE_PHASE - 200], t0 = __builtin_amdgcn_s_memrealtime();
#elif PROBE_PHASE == 100 || PROBE_PHASE == 101
        const unsigned long long dt = 125ull * (unsigned long long)__hip_atomic_load((unsigned*)(p.ws + WS_CTL) + 2048, __ATOMIC_RELAXED, __HIP_MEMORY_SCOPE_AGENT), t0 = __builtin_amdgcn_s_memrealtime();
#else
        const unsigned long long dt = st[PROBE_PHASE + 1] - st[PROBE_PHASE], t0 = __builtin_amdgcn_s_memrealtime();
#endif
        while (__builtin_amdgcn_s_memrealtime() - t0 < (unsigned long long)PROBE_MULT * dt) __builtin_amdgcn_s_sleep(8); }
#endif
}

extern "C" void kernel_launch(void* const* d_in, const int* in_sizes, int n_in, void* d_out, int out_size, void* d_ws, size_t ws_size, hipStream_t stream) {
    static int grid = 0;
    if (grid == 0) {
        if (n_in != 19 || out_size != S * D || ws_size < WS_END) { fprintf(stderr, "kernel_launch: unexpected shapes (n_in %d out %d ws %zu)\n", n_in, out_size, ws_size); grid = -1; return; }
        int dev = 0, cus = 0, per_cu = 0;
        (void)hipGetDevice(&dev); (void)hipDeviceGetAttribute(&cus, hipDeviceAttributeMultiprocessorCount, dev);
        if (hipFuncSetAttribute((const void*)fwd_kernel, hipFuncAttributeMaxDynamicSharedMemorySize, LDS_BYTES) != hipSuccess) { fprintf(stderr, "kernel_launch: hipFuncSetAttribute failed\n"); grid = -1; return; }
        if (hipOccupancyMaxActiveBlocksPerMultiprocessor(&per_cu, (const void*)fwd_kernel, NTHREADS, LDS_BYTES) != hipSuccess || per_cu < 1) { fprintf(stderr, "kernel_launch: occupancy query says %d\n", per_cu); per_cu = 1; }
        (void)hipGetLastError();
        grid = cus * 1;
    }
    if (grid < 0) return;
    (void)hipMemsetAsync((char*)d_ws + WS_CTL, 0, CTL_BYTES, stream);
    Params p{};
    p.x = (const float*)d_in[0]; p.pos = (const int*)d_in[1]; p.norm_mix_g = (const float*)d_in[2]; p.w_in = (const float*)d_in[3]; p.idx_g = (const float*)d_in[4]; p.idx_b = (const float*)d_in[5];
    p.conv_w = (const float*)d_in[6]; p.conv_b = (const float*)d_in[7]; p.conv_ng = (const float*)d_in[8]; p.conv_nb = (const float*)d_in[9]; p.w_out = (const float*)d_in[10]; p.norm_ffn_g = (const float*)d_in[11];
    p.w_router = (const float*)d_in[12]; p.b_router = (const float*)d_in[13]; p.w_gu = (const float*)d_in[14]; p.b_gu = (const float*)d_in[15]; p.w_down = (const float*)d_in[16]; p.b_down = (const float*)d_in[17];
    p.norm_final_g = (const float*)d_in[18]; p.out = (float*)d_out; p.ws = (unsigned char*)d_ws;
    void* args[] = {&p};
    hipError_t e = hipLaunchCooperativeKernel((const void*)fwd_kernel, dim3(grid), dim3(NTHREADS), args, LDS_BYTES, stream);
    if (e != hipSuccess) fprintf(stderr, "cooperative launch failed: %s (grid %d)\n", hipGetErrorString(e), grid);
}
```

```cpp
#include <hip/hip_runtime.h>
#include <hip/hip_cooperative_groups.h>
#include <cstdio>
#include <cstdint>
#include <hip/hip_bf16.h>
#include <cmath>
namespace cg = cooperative_groups;
#ifndef FUSED_GATHER
#define FUSED_GATHER 1
#endif
#ifndef PROBE_PHASE
#define PROBE_PHASE (-1)
#endif

constexpr int S = 16384, D = 1024, NIN = 3144, NP = 3328;
constexpr int CC = 512, CW = 31, NH = 8, HD = 64, NE = 32, DE = 1024;
constexpr int C_VAL = 0, C_GATE = 512, C_Q = 1024, C_K = 1536, C_V = 2048, C_QI = 2560, C_KI = 3072, C_WI = 3136;
constexpr int KSEL = 256;
constexpr float EPS = 1e-5f;
constexpr float C2 = 0.125f * 1.4426950408889634f;
constexpr int NTHREADS = 512, NWAVES = 8;
constexpr int MAXROWS = 65536 + NE * 256;
constexpr int MAXTILES = MAXROWS / 256;

constexpr size_t MiB = 1u << 20;
constexpr size_t WS_CTL = 0, CTL_BYTES = 1 * MiB;
constexpr size_t WS_WINT = 2 * MiB;
constexpr size_t WS_WOUTT = 9 * MiB;
constexpr size_t WS_WGRT = 11 * MiB;
constexpr size_t WS_COS = 12 * MiB;
constexpr size_t WS_SIN = 14 * MiB;
constexpr size_t WS_WGUT = 16 * MiB;
constexpr size_t WS_WDT = 144 * MiB;
constexpr size_t WS_XN = 208 * MiB;
constexpr size_t WS_PROJ = 240 * MiB;
constexpr size_t WS_MIX = 344 * MiB;
constexpr size_t WS_KI = 376 * MiB;
constexpr size_t WS_QL = 378 * MiB;
constexpr size_t WS_WI = 380 * MiB;
constexpr size_t WS_RSTD = 381 * MiB;
constexpr size_t WS_TOKOF = 382 * MiB;
constexpr size_t WS_GATEOF = 384 * MiB;
constexpr size_t WS_PAIR = 386 * MiB;
constexpr size_t WS_ROWRSTD = 387 * MiB;
constexpr size_t WS_ROWGATE = 388 * MiB;
constexpr size_t WS_ROWTOK = 389 * MiB;
constexpr size_t WS_MASK = 392 * MiB;
constexpr size_t WS_H2 = 424 * MiB;
constexpr size_t WS_XS = 488 * MiB;
constexpr size_t WS_HDN = 632 * MiB;
constexpr size_t WS_YS = 776 * MiB;
constexpr size_t WS_END = 920 * MiB;
constexpr int CW_CNT = 1024;
constexpr int CW_BAR = 4096;
constexpr int CW_KMAX = 2052;

constexpr int LDS_BYTES = 163840;
constexpr int LDS_LTOK = 147456;
constexpr int LDS_MISC = 131072;
constexpr int LDS_LRS = LDS_MISC + 4608;
constexpr int LDS_PROBE = LDS_MISC + 14336;

#define LAS __attribute__((address_space(3)))
typedef unsigned short bf16;
typedef unsigned long long u64;
typedef float f32x4 __attribute__((ext_vector_type(4)));
typedef unsigned u32x4 __attribute__((ext_vector_type(4)));

__device__ __forceinline__ float bf2f(unsigned v) { return __uint_as_float(v << 16); }
__device__ __forceinline__ unsigned f2bf(float f) { unsigned u = __float_as_uint(f); return (u + 0x7fffu + ((u >> 16) & 1u)) >> 16; }
typedef float f32x2_pk __attribute__((ext_vector_type(2))); typedef __bf16 bf16x2_pk __attribute__((ext_vector_type(2)));
__device__ __forceinline__ unsigned pk2(float lo, float hi) { const f32x2_pk v = {lo, hi}; return __builtin_bit_cast(unsigned, __builtin_convertvector(v, bf16x2_pk)); }
__device__ __forceinline__ float blo(unsigned w) { return __uint_as_float(w << 16); }
__device__ __forceinline__ float bhi(unsigned w) { return __uint_as_float(w & 0xffff0000u); }
__device__ __forceinline__ float wave_sum(float v) {
#pragma unroll
    for (int o = 1; o < 64; o <<= 1) v += __shfl_xor(v, o);
    return v;
}
__device__ __forceinline__ float wave_max(float v) {
#pragma unroll
    for (int o = 1; o < 64; o <<= 1) v = fmaxf(v, __shfl_xor(v, o));
    return v;
}
__device__ __forceinline__ int opaque_tid() { int t = threadIdx.x; asm volatile("" : "+v"(t)); return t; }
#if PROBE_PHASE >= 200
#define ISEC(k) do { __syncthreads(); if (blockIdx.x == 0 && tid == 0) { volatile LAS unsigned long long* st_ = (volatile LAS unsigned long long*)((LAS unsigned char*)lds + LDS_PROBE + 256); const unsigned long long now_ = __builtin_amdgcn_s_memrealtime(); st_[k] += now_ - st_[15]; st_[15] = now_; } } while (0)
#else
#define ISEC(k) do { } while (0)
#endif
__device__ __forceinline__ float sigmoidf_(float x) { return __builtin_amdgcn_rcpf(1.f + __expf(-x)); }

struct Params {
    const float* x; const int* pos; const float* norm_mix_g; const float* w_in; const float* idx_g; const float* idx_b;
    const float* conv_w; const float* conv_b; const float* conv_ng; const float* conv_nb; const float* w_out; const float* norm_ffn_g;
    const float* w_router; const float* b_router; const float* w_gu; const float* b_gu; const float* w_down; const float* b_down;
    const float* norm_final_g; float* out; unsigned char* ws;
};

__device__ __forceinline__ void transpose_item(const float* W, int K, int N, bf16* WT, int dst_row0, int k0, int n0, float* scr, int lane) {
    float v[32]; const int n = n0 + (lane & 31); const float* src = W + (size_t)(k0 + (lane >> 5)) * N + n;
#pragma unroll
    for (int i = 0; i < 32; ++i) v[i] = (n < N) ? src[(size_t)(2 * i) * N] : 0.f;
#pragma unroll
    for (int i = 0; i < 32; ++i) scr[(2 * i + (lane >> 5)) * 33 + (lane & 31)] = v[i];
    asm volatile("s_waitcnt lgkmcnt(0)" ::: "memory");
    const int c = lane & 7;
#pragma unroll
    for (int j = 0; j < 4; ++j) { const int nn = (lane >> 3) + 8 * j; const float* s = scr + (8 * c) * 33 + nn;
        u32x4 o; o.x = pk2(s[0 * 33], s[1 * 33]); o.y = pk2(s[2 * 33], s[3 * 33]); o.z = pk2(s[4 * 33], s[5 * 33]); o.w = pk2(s[6 * 33], s[7 * 33]);
        *(u32x4*)(WT + (size_t)(dst_row0 + nn) * K + k0 + 8 * c) = o; }
    asm volatile("s_waitcnt lgkmcnt(0)" ::: "memory");
}

__device__ __forceinline__ void phase_prologue(const Params& p, unsigned char* lds) {
    const int tid = opaque_tid(), lane = tid & 63, wave = tid >> 6;
    const int gw = blockIdx.x * NWAVES + wave, NGW = gridDim.x * NWAVES;
    float* scr = (float*)(lds + wave * 16384);
    bf16* WinT = (bf16*)(p.ws + WS_WINT); bf16* WoutT = (bf16*)(p.ws + WS_WOUTT); bf16* WguT = (bf16*)(p.ws + WS_WGUT); bf16* WdT = (bf16*)(p.ws + WS_WDT);
    constexpr int I_IN = 16 * (NP / 32), I_OUT = 16 * 32, I_GU = 16 * 64, I_DN = 16 * 32;
    constexpr int NITEMS = I_IN + I_OUT + NE * I_GU + NE * I_DN;
    for (int it = gw; it < NITEMS; it += NGW) {
        int r = it;
        if (r < I_IN) { const int nb = r % (NP / 32), kb = r / (NP / 32); transpose_item(p.w_in, D, NIN, WinT, nb * 32, kb * 64, nb * 32, scr, lane); continue; }
        r -= I_IN;
        if (r < I_OUT) { const int nb = r % 32, kb = r / 32; transpose_item(p.w_out, D, D, WoutT, nb * 32, kb * 64, nb * 32, scr, lane); continue; }
        r -= I_OUT;
        if (r < NE * I_GU) { const int e = r / I_GU, q = r % I_GU, nb = q % 64, kb = q / 64; const int n0 = nb * 32;
            const int c = n0 & 1023, isu = n0 >> 10; const int drow = e * 2048 + (c >> 7) * 256 + isu * 128 + (c & 127);
            transpose_item(p.w_gu + (size_t)e * D * 2048, D, 2048, WguT, drow - 0, kb * 64, n0, scr, lane);
            continue; }
        r -= NE * I_GU;
        { const int e = r / I_DN, q = r % I_DN, nb = q % 32, kb = q / 32;
            transpose_item(p.w_down + (size_t)e * DE * D, DE, D, WdT, e * D + nb * 32, kb * 64, nb * 32, scr, lane); }
    }
    for (int i = blockIdx.x * NTHREADS + tid; i < NE * D; i += gridDim.x * NTHREADS) { const int e = i / D, k = i % D; ((float*)(p.ws + WS_WGRT))[i] = p.norm_ffn_g[k] * p.w_router[k * NE + e]; }
    for (int i = blockIdx.x * NTHREADS + tid; i < NE * D; i += gridDim.x * NTHREADS) { const int k = i / NE; ((float*)(p.ws + WS_WGRT))[65536 + i] = p.norm_ffn_g[k] * p.w_router[i]; }
    for (int i = blockIdx.x * NTHREADS + tid; i < S * 32; i += gridDim.x * NTHREADS) { const int t = i >> 5, j = i & 31;
        const float inv = powf(10000.f, -(float)j / 32.f); const float ang = (float)p.pos[t] * inv;
        double xr = (double)ang * 0.15915494309189535; xr -= floor(xr); const float xf = (float)xr;
        ((float*)(p.ws + WS_COS))[i] = __builtin_amdgcn_cosf(xf); ((float*)(p.ws + WS_SIN))[i] = __builtin_amdgcn_sinf(xf); }
    bf16* XN = (bf16*)(p.ws + WS_XN);
    for (int m = gw; m < S; m += NGW) {
        const f32x4* xr = (const f32x4*)(p.x + (size_t)m * D) + lane; f32x4 v[4]; float ss = 0.f;
#pragma unroll
        for (int j = 0; j < 4; ++j) { v[j] = xr[64 * j]; ss += v[j].x * v[j].x + v[j].y * v[j].y + v[j].z * v[j].z + v[j].w * v[j].w; }
        const float rstd = rsqrtf(wave_sum(ss) * (1.f / D) + EPS);
        u64* o8 = (u64*)(XN + (size_t)m * D) + lane;
#pragma unroll
        for (int j = 0; j < 4; ++j) { const f32x4 g = ((const f32x4*)p.norm_mix_g)[lane + 64 * j];
            o8[64 * j] = (u64)pk2(v[j].x * rstd * g.x, v[j].y * rstd * g.y) | ((u64)pk2(v[j].z * rstd * g.z, v[j].w * rstd * g.w) << 32); }
    }
}

namespace pg8 {
#define PG8_LAS __attribute__((address_space(3)))
typedef unsigned short bf16_t;
typedef short bf16x8 __attribute__((ext_vector_type(8)));
typedef float f32x4 __attribute__((ext_vector_type(4)));
typedef unsigned u32x4 __attribute__((ext_vector_type(4)));
constexpr int BM = 256, BK = 64, HALF = 128, HTB = HALF * BK * 2  , STAGE_BYTES = 8 * HTB, NXCD = 8, WGM = 8;

__host__ __device__ __forceinline__ int lds_byte(int r, int c) { const int st = (r >> 4) * 2 + (c >> 5), rr = r & 15, cc = c & 31, ob = rr * 64 + cc * 2; return st * 1024 + (ob ^ (((ob >> 9) & 1) << 5)); }
__host__ __device__ __forceinline__ void stage_rc(int b, int& R, int& C) { const int st = b / 1024, sb = b % 1024, swz = sb ^ (((sb >> 9) & 1) << 5); R = (st >> 1) * 16 + swz / 64; C = (st & 1) * 32 + (swz % 64) / 2; }
__host__ __device__ __forceinline__ int perm32(int rho) { const int n = rho >> 4, i = rho & 15; return 8 * (i >> 2) + 4 * n + (i & 3); }

struct Unit { int pm, pn, ui; };
struct Gemm { const bf16_t* A; const bf16_t* Bt; int M, N, K; };

struct StaticOrder {
    int nM, nN, nwg, G, c;
    __host__ __device__ void init(int M, int N, int G_, int c_) { nM = M / BM; nN = N / BM; nwg = nM * nN; G = G_; c = c_; }
    __host__ __device__ bool next(int i, Unit& u) const { const long L = (long)i * G + c; if (!map(L, u)) return false; u.ui = i; return true; }
    __host__ __device__ bool map(long L, Unit& u) const {
        if (L >= nwg) return false;
        int wgid = (int)L; { const int q = nwg / NXCD, r = nwg % NXCD, xcd = wgid % NXCD, off = wgid / NXCD; wgid = (xcd < r ? xcd * (q + 1) : r * (q + 1) + (xcd - r) * q) + off; }
        const int nig = WGM * nN, gid = wgid / nig, fm = gid * WGM, gsz = (nM - fm) < WGM ? (nM - fm) : WGM;
        u.pm = fm + ((wgid % nig) % gsz); u.pn = (wgid % nig) / gsz; u.ui = 0; return true;
    }
    __device__ __forceinline__ int bidx(const Unit& u) const { return u.pn; }
    __device__ __forceinline__ void a_ready(const Unit&) const {}
    __device__ __forceinline__ void done(const Unit&) const {}
};
template <class Epi, class Sched, bool ALIGN_EPI = false, bool SP2 = false, bool GATHER = false>
__device__ __forceinline__ void gemm_phase(PG8_LAS unsigned char* lds, const Gemm g, const Sched& S, const Epi& E) {
    static_assert(!GATHER || SP2, "GATHER is written for the SP2 loop");
    int tid_ = threadIdx.x; asm volatile("" : "+v"(tid_));
    const int tid = tid_, wid = __builtin_amdgcn_readfirstlane(tid >> 6), lane = tid & 63, wr = wid >> 2, wc = wid & 3, fr = lane & 15, fq = lane >> 4;
    const int K = g.K, nt = K / BK;
    unsigned voffA[2], voffB[2], gC[2]; int gR[2];
#pragma unroll
    for (int i = 0; i < 2; ++i) { int R, C; stage_rc(tid * 16 + i * 8192, R, C); const int Rb = Epi::PERM ? ((R & ~31) + perm32(R & 31)) : R;
        voffA[i] = (unsigned)(R * K + C) * 2u; voffB[i] = (unsigned)(Rb * K + C) * 2u; gR[i] = R; gC[i] = (unsigned)C * 2u; }
    unsigned vc[2][2] = {{0u, 0u}, {0u, 0u}}, vn[2][2] = {{0u, 0u}, {0u, 0u}};
#define PG8_GOFF(dst, uidx) do { _Pragma("unroll") for (int h_ = 0; h_ < 2; ++h_) _Pragma("unroll") for (int i_ = 0; i_ < 2; ++i_) dst[h_][i_] = (unsigned)S.rowtok((uidx), h_ * 128 + gR[i_]) * (unsigned)(K * 2) + gC[i_]; } while (0)
    const size_t kstep = (size_t)(BK * 2);
    const size_t hstep = (size_t)HALF * K * 2;
    const size_t tstep = 2 * hstep;
    const unsigned ldsw = (unsigned)wid * 1024u;
    const int aoff = lds_byte(wr * 64 + fr, fq * 8), boff = lds_byte(wc * 32 + fr, fq * 8);
#define PG8_SA(b, h) (((b) * 2 + (h)) * HTB)
#define PG8_SB(b, h) ((4 + (b) * 2 + (h)) * HTB)
#define PG8_STAGE(bufoff, gbase, voff) do { _Pragma("unroll") for (int _i = 0; _i < 2; ++_i) \
        __builtin_amdgcn_global_load_lds((const unsigned*)((const char*)(gbase) + (voff)[_i]), (PG8_LAS unsigned*)(lds + (bufoff) + ldsw + _i * 8192), 16, 0, 0); } while (0)
#define PG8_STAGE_AG(bufoff, kb, v0, v1) do { \
        __builtin_amdgcn_global_load_lds((const unsigned*)((const char*)g.A + (kb) + (v0)), (PG8_LAS unsigned*)(lds + (bufoff) + ldsw), 16, 0, 0); \
        __builtin_amdgcn_global_load_lds((const unsigned*)((const char*)g.A + (kb) + (v1)), (PG8_LAS unsigned*)(lds + (bufoff) + ldsw + 8192), 16, 0, 0); } while (0)
#define PG8_LDA(dst, b, h) do { _Pragma("unroll") for (int m = 0; m < 4; ++m) _Pragma("unroll") for (int k = 0; k < 2; ++k) dst[m][k] = *(const PG8_LAS bf16x8*)(lds + PG8_SA(b, h) + aoff + m * 2048 + k * 1024); } while (0)
#define PG8_LDB(dst, b, h) do { _Pragma("unroll") for (int n = 0; n < 2; ++n) _Pragma("unroll") for (int k = 0; k < 2; ++k) dst[n][k] = *(const PG8_LAS bf16x8*)(lds + PG8_SB(b, h) + boff + n * 2048 + k * 1024); } while (0)
#define PG8_MMA(ai, bj, At, Bt) do { __builtin_amdgcn_s_setprio(1); _Pragma("unroll") for (int m = 0; m < 4; ++m) _Pragma("unroll") for (int n = 0; n < 2; ++n) _Pragma("unroll") for (int k = 0; k < 2; ++k) \
        acc[ai][bj][m][n] = __builtin_amdgcn_mfma_f32_16x16x32_bf16(Bt[n][k], At[m][k], acc[ai][bj][m][n], 0, 0, 0); __builtin_amdgcn_s_setprio(0); } while (0)
#define PG8_WAIT_V(n) asm volatile("s_waitcnt vmcnt(" #n ")" ::: "memory")
#define PG8_WAIT_L(n) asm volatile("s_waitcnt lgkmcnt(" #n ")" ::: "memory")
#define PG8_BAR __builtin_amdgcn_s_barrier()
#define PG8_SCHED __builtin_amdgcn_sched_barrier(0)
    Unit cur, nxt; int ui = 0;
    if (!S.next(0, cur)) return;
    f32x4 acc[2][2][4][2];
#pragma unroll
    for (int a = 0; a < 2; ++a)
#pragma unroll
        for (int b = 0; b < 2; ++b)
#pragma unroll
            for (int m = 0; m < 4; ++m)
#pragma unroll
                for (int n = 0; n < 2; ++n) acc[a][b][m][n] = (f32x4){0.f, 0.f, 0.f, 0.f};
    bf16x8 At[4][2], B0[2][2], B1[2][2];
    const char* cA = (const char*)g.A + (size_t)cur.pm * tstep; const char* cB = (const char*)g.Bt + (size_t)S.bidx(cur) * tstep;
    S.a_ready(cur);
    if constexpr (SP2) {
        if constexpr (GATHER) { PG8_GOFF(vc, 0); }
        PG8_STAGE(PG8_SB(0, 0), cB, voffB); PG8_STAGE(PG8_SB(0, 1), cB + hstep, voffB);
        if constexpr (GATHER) { PG8_STAGE_AG(PG8_SA(0, 0), (size_t)0, vc[0][0], vc[0][1]); PG8_STAGE_AG(PG8_SA(0, 1), (size_t)0, vc[1][0], vc[1][1]); } else { PG8_STAGE(PG8_SA(0, 0), cA, voffA); PG8_STAGE(PG8_SA(0, 1), cA + hstep, voffA); }
        if (wr == 1) PG8_BAR;
        PG8_WAIT_V(2); PG8_BAR;
        PG8_STAGE(PG8_SB(1, 0), cB + kstep, voffB); if constexpr (GATHER) { PG8_STAGE_AG(PG8_SA(1, 0), kstep, vc[0][0], vc[0][1]); } else { PG8_STAGE(PG8_SA(1, 0), cA + kstep, voffA); } PG8_STAGE(PG8_SB(1, 1), cB + hstep + kstep, voffB);
        PG8_WAIT_V(6); PG8_BAR;
    } else {
        PG8_STAGE(PG8_SB(0, 0), cB, voffB); PG8_STAGE(PG8_SA(0, 0), cA, voffA); PG8_STAGE(PG8_SB(0, 1), cB + hstep, voffB); PG8_STAGE(PG8_SA(0, 1), cA + hstep, voffA);
        if (wr == 1) PG8_BAR;
        PG8_WAIT_V(4); PG8_BAR;
        PG8_STAGE(PG8_SB(1, 0), cB + kstep, voffB); PG8_STAGE(PG8_SA(1, 0), cA + kstep, voffA); PG8_STAGE(PG8_SB(1, 1), cB + hstep + kstep, voffB);
        PG8_WAIT_V(6); PG8_BAR;
    }
    for (;;) {
        const bool has_next = S.next(ui + 1, nxt);
        if constexpr (GATHER) { if (has_next) { PG8_GOFF(vn, ui + 1); } }
        const char* nA = has_next ? (const char*)g.A + (size_t)nxt.pm * tstep : cA; const char* nB = has_next ? (const char*)g.Bt + (size_t)S.bidx(nxt) * tstep : cB;
        for (int t = 0; t < nt; t += 2) {
            const bool last = (t == nt - 2);
            const char* a1 = cA + (size_t)(t + 1) * kstep;
            const char* a2 = last ? nA : cA + (size_t)(t + 2) * kstep; const char* b2 = last ? nB : cB + (size_t)(t + 2) * kstep;
            const char* a3 = a2 + kstep; const char* b3 = b2 + kstep;
            if (last && has_next) S.a_ready(nxt);
            const bool un_ = last && has_next; const size_t k1_ = (size_t)(t + 1) * kstep, k2_ = last ? (size_t)0 : (size_t)(t + 2) * kstep, k3_ = k2_ + kstep;
            const unsigned w00 = un_ ? vn[0][0] : vc[0][0], w01 = un_ ? vn[0][1] : vc[0][1], w10 = un_ ? vn[1][0] : vc[1][0], w11 = un_ ? vn[1][1] : vc[1][1];
            if constexpr (SP2) {
            PG8_LDB(B0, 0, 0); PG8_LDB(B1, 0, 1); PG8_SCHED; PG8_LDA(At, 0, 0); if constexpr (GATHER) { PG8_STAGE_AG(PG8_SA(1, 1), k1_, vc[1][0], vc[1][1]); } else { PG8_STAGE(PG8_SA(1, 1), a1 + hstep, voffA); }
            PG8_WAIT_V(8); PG8_WAIT_L(0); PG8_BAR; PG8_MMA(0, 0, At, B0); PG8_MMA(0, 1, At, B1); PG8_BAR; PG8_SCHED;
            PG8_LDA(At, 0, 1); PG8_STAGE(PG8_SB(0, 0), b2, voffB); PG8_STAGE(PG8_SB(0, 1), b2 + hstep, voffB); if constexpr (GATHER) { PG8_STAGE_AG(PG8_SA(0, 0), k2_, w00, w01); } else { PG8_STAGE(PG8_SA(0, 0), a2, voffA); }
            PG8_WAIT_V(8); PG8_WAIT_L(0); PG8_BAR; PG8_MMA(1, 0, At, B0); PG8_MMA(1, 1, At, B1); PG8_BAR; PG8_SCHED;
            PG8_LDB(B0, 1, 0); PG8_LDB(B1, 1, 1); PG8_SCHED; PG8_LDA(At, 1, 0); if constexpr (GATHER) { PG8_STAGE_AG(PG8_SA(0, 1), k2_, w10, w11); } else { PG8_STAGE(PG8_SA(0, 1), a2 + hstep, voffA); }
            PG8_WAIT_V(8); PG8_WAIT_L(0); PG8_BAR; PG8_MMA(0, 0, At, B0); PG8_MMA(0, 1, At, B1); PG8_BAR; PG8_SCHED;
            PG8_LDA(At, 1, 1); PG8_STAGE(PG8_SB(1, 0), b3, voffB); PG8_STAGE(PG8_SB(1, 1), b3 + hstep, voffB); if constexpr (GATHER) { PG8_STAGE_AG(PG8_SA(1, 0), k3_, w00, w01); } else { PG8_STAGE(PG8_SA(1, 0), a3, voffA); }
            PG8_WAIT_V(8); PG8_WAIT_L(0); PG8_BAR; PG8_MMA(1, 0, At, B0); PG8_MMA(1, 1, At, B1); PG8_BAR; PG8_SCHED;
            } else {
            PG8_LDB(B0, 0, 0); PG8_SCHED; PG8_LDA(At, 0, 0); PG8_STAGE(PG8_SA(1, 1), a1 + hstep, voffA);
            PG8_WAIT_L(8); PG8_BAR; PG8_WAIT_L(0); PG8_MMA(0, 0, At, B0); PG8_BAR; PG8_SCHED;
            PG8_LDB(B1, 0, 1); PG8_STAGE(PG8_SB(0, 0), b2, voffB);
            PG8_BAR; PG8_WAIT_L(0); PG8_MMA(0, 1, At, B1); PG8_BAR;
            PG8_LDA(At, 0, 1); PG8_STAGE(PG8_SA(0, 0), a2, voffA);
            PG8_BAR; PG8_WAIT_L(0); PG8_MMA(1, 0, At, B0); PG8_BAR; PG8_SCHED;
            PG8_STAGE(PG8_SB(0, 1), b2 + hstep, voffB);
            PG8_WAIT_V(6); PG8_BAR; PG8_MMA(1, 1, At, B1); PG8_BAR;
            PG8_LDB(B0, 1, 0); PG8_SCHED; PG8_LDA(At, 1, 0); PG8_STAGE(PG8_SA(0, 1), a2 + hstep, voffA);
            PG8_WAIT_L(8); PG8_BAR; PG8_WAIT_L(0); PG8_MMA(0, 0, At, B0); PG8_BAR; PG8_SCHED;
            PG8_LDB(B1, 1, 1); PG8_STAGE(PG8_SB(1, 0), b3, voffB);
            PG8_BAR; PG8_WAIT_L(0); PG8_MMA(0, 1, At, B1); PG8_BAR;
            PG8_LDA(At, 1, 1); PG8_STAGE(PG8_SA(1, 0), a3, voffA);
            PG8_BAR; PG8_WAIT_L(0); PG8_MMA(1, 0, At, B0); PG8_BAR; PG8_SCHED;
            PG8_STAGE(PG8_SB(1, 1), b3 + hstep, voffB);
            PG8_WAIT_V(6); PG8_BAR; PG8_MMA(1, 1, At, B1); PG8_BAR;
            }
        }
        if constexpr (ALIGN_EPI) { if (wr == 0) PG8_BAR; }
        if constexpr (!Epi::AFTER_DRAIN) { E(acc, cur, wr, wc, fr, fq); S.done(cur); }
        if (!has_next) break;
#pragma unroll
        for (int a = 0; a < 2; ++a)
#pragma unroll
            for (int b = 0; b < 2; ++b)
#pragma unroll
                for (int m = 0; m < 4; ++m)
#pragma unroll
                    for (int n = 0; n < 2; ++n) acc[a][b][m][n] = (f32x4){0.f, 0.f, 0.f, 0.f};
        cur = nxt; cA = nA; cB = nB; ++ui;
        if constexpr (GATHER) { vc[0][0] = vn[0][0]; vc[0][1] = vn[0][1]; vc[1][0] = vn[1][0]; vc[1][1] = vn[1][1]; }
        if constexpr (ALIGN_EPI) { if (wr == 1) PG8_BAR; }
    }
    PG8_WAIT_V(0);
    if constexpr (!ALIGN_EPI) { if (wr == 0) PG8_BAR; }
    PG8_BAR;
    if constexpr (Epi::AFTER_DRAIN) { E.fused(acc, cur, wr, wc, fr, fq, lds, wid, lane); S.done(cur); }
#undef PG8_SA
#undef PG8_SB
#undef PG8_STAGE
#undef PG8_LDA
#undef PG8_STAGE_AG
#undef PG8_GOFF
#undef PG8_LDB
#undef PG8_MMA
#undef PG8_WAIT_V
#undef PG8_WAIT_L
#undef PG8_BAR
#undef PG8_SCHED
}
}

template <class Epi>
__device__ __forceinline__ void ngemm_unit(unsigned char* lds, const bf16* A, int lda, const bf16* Bt, int ldb, int K, const Epi& epi, const pg8::Unit& u) {
    float* As = (float*)lds; float* Bs = As + 32 * 256;
    const int tid = opaque_tid(), tr = tid >> 4, tc = tid & 15;
    float acc0[8][8], acc1[8][8];
#pragma unroll
    for (int i = 0; i < 8; ++i)
#pragma unroll
        for (int j = 0; j < 8; ++j) { acc0[i][j] = 0.f; acc1[i][j] = 0.f; }
    for (int k0 = 0; k0 < K; k0 += 32) {
        __syncthreads();
#pragma unroll
        for (int j = 0; j < 2; ++j) { const int pidx = tid + 512 * j, r = pidx & 255, kq = pidx >> 8;
            const u32x4 va = *(const u32x4*)(A + (size_t)r * lda + k0 + kq * 8);
            const u32x4 vb = *(const u32x4*)(Bt + (size_t)r * ldb + k0 + kq * 8);
            float* ap = As + (kq * 8) * 256 + r; float* bp = Bs + (kq * 8) * 256 + r;
            ap[0 * 256] = blo(va.x); ap[1 * 256] = bhi(va.x); ap[2 * 256] = blo(va.y); ap[3 * 256] = bhi(va.y); ap[4 * 256] = blo(va.z); ap[5 * 256] = bhi(va.z); ap[6 * 256] = blo(va.w); ap[7 * 256] = bhi(va.w);
            bp[0 * 256] = blo(vb.x); bp[1 * 256] = bhi(vb.x); bp[2 * 256] = blo(vb.y); bp[3 * 256] = bhi(vb.y); bp[4 * 256] = blo(vb.z); bp[5 * 256] = bhi(vb.z); bp[6 * 256] = blo(vb.w); bp[7 * 256] = bhi(vb.w); }
        __syncthreads();
#pragma unroll 2
        for (int kk = 0; kk < 32; ++kk) {
            const f32x4 a0 = *(const f32x4*)(As + kk * 256 + tr * 8), a1 = *(const f32x4*)(As + kk * 256 + tr * 8 + 4);
            const f32x4 b00 = *(const f32x4*)(Bs + kk * 256 + tc * 8), b01 = *(const f32x4*)(Bs + kk * 256 + tc * 8 + 4);
            const f32x4 b10 = *(const f32x4*)(Bs + kk * 256 + 128 + tc * 8), b11 = *(const f32x4*)(Bs + kk * 256 + 128 + tc * 8 + 4);
            const float a[8] = {a0.x, a0.y, a0.z, a0.w, a1.x, a1.y, a1.z, a1.w};
            const float b0[8] = {b00.x, b00.y, b00.z, b00.w, b01.x, b01.y, b01.z, b01.w};
            const float b1[8] = {b10.x, b10.y, b10.z, b10.w, b11.x, b11.y, b11.z, b11.w};
#pragma unroll
            for (int i = 0; i < 8; ++i)
#pragma unroll
                for (int j = 0; j < 8; ++j) { acc0[i][j] = fmaf(a[i], b0[j], acc0[i][j]); acc1[i][j] = fmaf(a[i], b1[j], acc1[i][j]); }
        }
    }
    { const typename Epi::Ctx ctx = epi.prep(u, tc * 8);
#pragma unroll
    for (int i = 0; i < 8; ++i) epi(ctx, u, tr * 8 + i, tc * 8, acc0[i], acc1[i]); }
}

__device__ __forceinline__ void store8_bf16(bf16* dst, const float (&v)[8]) {
    u32x4 o; o.x = pk2(v[0], v[1]); o.y = pk2(v[2], v[3]); o.z = pk2(v[4], v[5]); o.w = pk2(v[6], v[7]); *(u32x4*)dst = o;
}

typedef pg8::Unit Unit;
struct EpiProj { bf16* O; struct Ctx {};
    __device__ __forceinline__ Ctx prep(const Unit&, int) const { return Ctx{}; }
    __device__ __forceinline__ void operator()(const Ctx&, const Unit& u, int r, int c8, const float (&v0)[8], const float (&v1)[8]) const {
        bf16* row = O + (size_t)(u.pm * 256 + r) * NP + u.pn * 256 + c8; store8_bf16(row, v0); store8_bf16(row + 128, v1); } };
struct Col16 { float a[8], b[8]; };
__device__ __forceinline__ Col16 load_col16(const float* p0, const float* p1) { const f32x4 a0 = *(const f32x4*)p0, a1 = *(const f32x4*)(p0 + 4), b0 = *(const f32x4*)p1, b1 = *(const f32x4*)(p1 + 4);
    return Col16{{a0.x, a0.y, a0.z, a0.w, a1.x, a1.y, a1.z, a1.w}, {b0.x, b0.y, b0.z, b0.w, b1.x, b1.y, b1.z, b1.w}}; }
struct EpiOut { const float* x; const float* gffn; float* H2; bf16* XN2; typedef Col16 Ctx;
    __device__ __forceinline__ Ctx prep(const Unit& u, int c8) const { const int col = u.pn * 256 + c8; return load_col16(gffn + col, gffn + col + 128); }
    __device__ __forceinline__ void operator()(const Ctx& g, const Unit& u, int r, int c8, const float (&v0)[8], const float (&v1)[8]) const {
        const int col = u.pn * 256 + c8; const size_t off = (size_t)(u.pm * 256 + r) * D + col; float h0[8], h1[8], n0[8], n1[8];
        const Col16 xs = load_col16(x + off, x + off + 128);
#pragma unroll
        for (int i = 0; i < 8; ++i) { h0[i] = xs.a[i] + v0[i]; h1[i] = xs.b[i] + v1[i]; n0[i] = h0[i] * g.a[i]; n1[i] = h1[i] * g.b[i]; }
        *(f32x4*)(H2 + off) = (f32x4){h0[0], h0[1], h0[2], h0[3]}; *(f32x4*)(H2 + off + 4) = (f32x4){h0[4], h0[5], h0[6], h0[7]};
        *(f32x4*)(H2 + off + 128) = (f32x4){h1[0], h1[1], h1[2], h1[3]}; *(f32x4*)(H2 + off + 132) = (f32x4){h1[4], h1[5], h1[6], h1[7]};
        store8_bf16(XN2 + off, n0); store8_bf16(XN2 + off + 128, n1); } };
struct EpiGU { const float* bgu; const LAS float* rowrstd; bf16* HDN; const LAS int* tile_e; typedef Col16 Ctx;
    __device__ __forceinline__ Ctx prep(const Unit& u, int c8) const { const float* bg = bgu + tile_e[u.pm] * 2048 + u.pn * 128 + c8; return load_col16(bg, bg + 1024); }
    __device__ __forceinline__ void operator()(const Ctx& b, const Unit& u, int r, int c8, const float (&v0)[8], const float (&v1)[8]) const {
        const int row = u.pm * 256 + r; const float rs = rowrstd[u.ui * 256 + r]; const int cb = u.pn * 128 + c8; float h[8];
#pragma unroll
        for (int i = 0; i < 8; ++i) { float g = v0[i] * rs + b.a[i]; float uu = v1[i] * rs + b.b[i];
            g = fminf(g, 7.f); uu = fminf(fmaxf(uu, -7.f), 7.f); h[i] = g * sigmoidf_(1.702f * g) * (uu + 1.f); }
        store8_bf16(HDN + (size_t)row * DE + cb, h); } };
struct EpiDown { const float* bd; const LAS float* rowgate; bf16* YS; const LAS int* tile_e; typedef Col16 Ctx;
    __device__ __forceinline__ Ctx prep(const Unit& u, int c8) const { const float* bp = bd + tile_e[u.pm] * D + u.pn * 256 + c8; return load_col16(bp, bp + 128); }
    __device__ __forceinline__ void operator()(const Ctx& b, const Unit& u, int r, int c8, const float (&v0)[8], const float (&v1)[8]) const {
        const int row = u.pm * 256 + r; const float gt = rowgate[u.ui * 256 + r]; const int cb = u.pn * 256 + c8; float y0[8], y1[8];
#pragma unroll
        for (int i = 0; i < 8; ++i) { y0[i] = (v0[i] + b.a[i]) * gt; y1[i] = (v1[i] + b.b[i]) * gt; }
        store8_bf16(YS + (size_t)row * D + cb, y0); store8_bf16(YS + (size_t)row * D + cb + 128, y1); } };

template <class F> struct EpiAdapt {
    static constexpr bool PERM = true, AFTER_DRAIN = false; F f;
    __device__ __forceinline__ void operator()(const f32x4 (&acc)[2][2][4][2], const Unit& u, int wr, int wc, int fr, int fq) const {
        const typename F::Ctx ctx = f.prep(u, wc * 32 + fq * 8);
#pragma unroll
        for (int ai = 0; ai < 2; ++ai)
#pragma unroll
            for (int m = 0; m < 4; ++m) { const int r = ai * 128 + wr * 64 + m * 16 + fr, c8 = wc * 32 + fq * 8;
                const f32x4 a = acc[ai][0][m][0], b = acc[ai][0][m][1], c = acc[ai][1][m][0], d = acc[ai][1][m][1];
                const float v0[8] = {a.x, a.y, a.z, a.w, b.x, b.y, b.z, b.w}, v1[8] = {c.x, c.y, c.z, c.w, d.x, d.y, d.z, d.w};
                f(ctx, u, r, c8, v0, v1); }
    }
};
struct MoeOrder { pg8::StaticOrder so; const LAS int* tile_e; int ncol; const LAS int* ltok;
    __device__ __forceinline__ bool next(int i, Unit& u) const { return so.next(i, u); }
    __device__ __forceinline__ int bidx(const Unit& u) const { return tile_e[u.pm] * ncol + u.pn; }
    __device__ __forceinline__ int rowtok(int ui, int r) const { return ltok[ui * 256 + r]; }
    __device__ __forceinline__ void a_ready(const Unit&) const {}
    __device__ __forceinline__ void done(const Unit&) const {} };
__device__ __forceinline__ void phase_ew_naive(const Params& p, unsigned char* lds) {
    const int tid = opaque_tid(), lane = tid & 63, wave = tid >> 6;
    bf16* PROJ = (bf16*)(p.ws + WS_PROJ); bf16* MIX = (bf16*)(p.ws + WS_MIX); bf16* KI = (bf16*)(p.ws + WS_KI); bf16* QL = (bf16*)(p.ws + WS_QL); float* WI = (float*)(p.ws + WS_WI);
    const float* COS = (const float*)(p.ws + WS_COS); const float* SIN = (const float*)(p.ws + WS_SIN);
    float* red = (float*)(lds);
    for (int t = blockIdx.x; t < S; t += gridDim.x) {
        const int c = tid; float acc = p.conv_b[c];
        for (int j = 0; j < CW; ++j) { const int tt = t - (CW - 1) + j; if (tt >= 0) { const float val = bf2f(PROJ[(size_t)tt * NP + C_VAL + c]), gate = bf2f(PROJ[(size_t)tt * NP + C_GATE + c]);
                acc = fmaf(p.conv_w[j * CC + c], val * sigmoidf_(gate), acc); } }
        const int hh = (tid & 255) >> 5, ii = tid & 31; const int qkbase = (tid < 256) ? C_Q : C_K;
        const float cs = COS[t * 32 + ii], sn = SIN[t * 32 + ii];
        const float x1 = bf2f(PROJ[(size_t)t * NP + qkbase + hh * 64 + ii]), x2 = bf2f(PROJ[(size_t)t * NP + qkbase + hh * 64 + 32 + ii]);
        float qi1 = 0.f, qi2 = 0.f; if (tid < 256) { qi1 = bf2f(PROJ[(size_t)t * NP + C_QI + hh * 64 + ii]); qi2 = bf2f(PROJ[(size_t)t * NP + C_QI + hh * 64 + 32 + ii]); }
        float kiv = 0.f, qlv = 0.f;
        if (wave == 4) kiv = bf2f(PROJ[(size_t)t * NP + C_KI + lane]);
        if (wave == 5) { for (int h = 0; h < 8; ++h) qlv = fmaf(bf2f(PROJ[(size_t)t * NP + C_WI + h]), bf2f(PROJ[(size_t)t * NP + C_QI + h * 64 + lane]), qlv); }
        float wiv = 0.f; if (wave == 6 && lane < 8) wiv = bf2f(PROJ[(size_t)t * NP + C_WI + lane]);
        float s1 = wave_sum(acc); if (lane == 0) red[wave] = s1; __syncthreads();
        float mean = 0.f;
#pragma unroll
        for (int w = 0; w < 8; ++w) mean += red[w];
        mean *= (1.f / CC); const float dv = acc - mean; float s2 = wave_sum(dv * dv); if (lane == 0) red[8 + wave] = s2; __syncthreads();
        float var = 0.f;
#pragma unroll
        for (int w = 0; w < 8; ++w) var += red[8 + w];
        var *= (1.f / CC);
        const float y = dv * rsqrtf(var + EPS) * p.conv_ng[c] + p.conv_nb[c];
        MIX[(size_t)t * D + c] = (bf16)f2bf(y * sigmoidf_(y));
        { const float sc = (tid < 256) ? C2 : 1.f; PROJ[(size_t)t * NP + qkbase + hh * 64 + ii] = (bf16)f2bf((x1 * cs - x2 * sn) * sc); PROJ[(size_t)t * NP + qkbase + hh * 64 + 32 + ii] = (bf16)f2bf((x2 * cs + x1 * sn) * sc); }
        if (tid < 256) { PROJ[(size_t)t * NP + C_QI + hh * 64 + ii] = (bf16)f2bf(qi1 * cs - qi2 * sn); PROJ[(size_t)t * NP + C_QI + hh * 64 + 32 + ii] = (bf16)f2bf(qi2 * cs + qi1 * sn); }
        if (wave == 4) { const float m = wave_sum(kiv) * (1.f / 64.f); const float d = kiv - m; const float vr = wave_sum(d * d) * (1.f / 64.f);
            const float yk = d * rsqrtf(vr + EPS) * p.idx_g[lane] + p.idx_b[lane]; const float other = __shfl_xor(yk, 32);
            const float c_ = COS[t * 32 + (lane & 31)], s_ = SIN[t * 32 + (lane & 31)];
            KI[(size_t)t * 64 + lane] = (bf16)f2bf(lane < 32 ? (yk * c_ - other * s_) : (yk * c_ + other * s_)); }
        if (wave == 5) { const float other = __shfl_xor(qlv, 32); const float c_ = COS[t * 32 + (lane & 31)], s_ = SIN[t * 32 + (lane & 31)];
            QL[(size_t)t * 64 + lane] = (bf16)f2bf(lane < 32 ? (qlv * c_ - other * s_) : (qlv * c_ + other * s_)); }
        if (wave == 6 && lane < 8) WI[t * 8 + lane] = wiv;
        __syncthreads();
    }
}

__device__ __forceinline__ void phase_ew_fast(const Params& p, unsigned char* lds) {
    const int tid = opaque_tid(), lane = tid & 63, wave = tid >> 6;
    bf16* PROJ = (bf16*)(p.ws + WS_PROJ); bf16* MIX = (bf16*)(p.ws + WS_MIX); bf16* KI = (bf16*)(p.ws + WS_KI); bf16* QL = (bf16*)(p.ws + WS_QL); float* WI = (float*)(p.ws + WS_WI);
    const float* COS = (const float*)(p.ws + WS_COS); const float* SIN = (const float*)(p.ws + WS_SIN);
    LAS unsigned char* L = (LAS unsigned char*)lds;
    LAS unsigned* U = (LAS unsigned*)L;
    LAS float* RED = (LAS float*)(L + 65536);
    const int cp = tid & 255, g = tid >> 8, wv_ = wave & 3;
    typedef float f32x2 __attribute__((ext_vector_type(2))); f32x2 wv[CW];
#pragma unroll
    for (int j = 0; j < CW; ++j) { const float2 ww = *(const float2*)(p.conv_w + j * CC + 2 * cp); wv[j] = (f32x2){ww.x, ww.y}; }
    const float2 cb = *(const float2*)(p.conv_b + 2 * cp), ng = *(const float2*)(p.conv_ng + 2 * cp), nb = *(const float2*)(p.conv_nb + 2 * cp);
    float kmx = 0.f;
    for (int unit = blockIdx.x; unit < S / 32; unit += gridDim.x) {
        const int t0 = unit * 32;
        __syncthreads();
        ISEC(6);
#pragma unroll 2
        for (int it = tid; it < 62 * 64; it += NTHREADS) { const int row = it >> 6, c8 = (it & 63) * 8, tt = t0 - 30 + row; u32x4 o = (u32x4){0u, 0u, 0u, 0u};
            if (tt >= 0) { const u32x4 va = *(const u32x4*)(PROJ + (size_t)tt * NP + C_VAL + c8), ga = *(const u32x4*)(PROJ + (size_t)tt * NP + C_GATE + c8);
                o.x = pk2(blo(va.x) * sigmoidf_(blo(ga.x)), bhi(va.x) * sigmoidf_(bhi(ga.x))); o.y = pk2(blo(va.y) * sigmoidf_(blo(ga.y)), bhi(va.y) * sigmoidf_(bhi(ga.y)));
                o.z = pk2(blo(va.z) * sigmoidf_(blo(ga.z)), bhi(va.z) * sigmoidf_(bhi(ga.z))); o.w = pk2(blo(va.w) * sigmoidf_(blo(ga.w)), bhi(va.w) * sigmoidf_(bhi(ga.w))); }
            *(LAS u32x4*)(L + (size_t)row * 1024 + c8 * 2) = o; }
        __syncthreads();
        ISEC(12);
        f32x2 acc[16];
#pragma unroll
        for (int tt = 0; tt < 16; ++tt) acc[tt] = (f32x2){cb.x, cb.y};
#pragma unroll
        for (int r = 0; r < 46; ++r) { const unsigned x = U[(g * 16 + r) * 256 + cp]; const f32x2 xv = (f32x2){blo(x), bhi(x)};
#pragma unroll
            for (int tt = 0; tt < 16; ++tt) { const int j = r - tt; if (j >= 0 && j < CW) acc[tt] = __builtin_elementwise_fma(wv[j], xv, acc[tt]); } }
#pragma unroll
        for (int tt = 0; tt < 16; ++tt) { const f32x2 a = acc[tt]; const float s1 = wave_sum(a.x + a.y), s2 = wave_sum(a.x * a.x + a.y * a.y);
            if (lane == 0) { RED[((g * 16 + tt) * 4 + wv_) * 2] = s1; RED[((g * 16 + tt) * 4 + wv_) * 2 + 1] = s2; } }
        __syncthreads();
#pragma unroll
        for (int tt = 0; tt < 16; ++tt) { const LAS f32x4* rp = (const LAS f32x4*)(RED + (g * 16 + tt) * 8); const f32x4 ra = rp[0], rb = rp[1];
            const float mean = (ra.x + ra.z + rb.x + rb.z) * (1.f / CC), var = (ra.y + ra.w + rb.y + rb.w) * (1.f / CC) - mean * mean, rstd = rsqrtf(fmaxf(var, 0.f) + EPS);
            const float y0 = (acc[tt].x - mean) * rstd * ng.x + nb.x, y1 = (acc[tt].y - mean) * rstd * ng.y + nb.y;
            *(unsigned*)(MIX + (size_t)(t0 + g * 16 + tt) * D + 2 * cp) = pk2(y0 * sigmoidf_(y0), y1 * sigmoidf_(y1)); }
        ISEC(13);
        { const int tl = (lane >> 3) & 3, dc = lane & 7, t = t0 + wave * 4 + tl; const bf16* prow = PROJ + (size_t)t * NP;
            const u32x4 kraw = *(const u32x4*)(prow + C_KI + dc * 8); const u32x4 wraw = *(const u32x4*)(prow + C_WI);
            const float wf[8] = {blo(wraw.x), bhi(wraw.x), blo(wraw.y), bhi(wraw.y), blo(wraw.z), bhi(wraw.z), blo(wraw.w), bhi(wraw.w)};
            float kv[8] = {blo(kraw.x), bhi(kraw.x), blo(kraw.y), bhi(kraw.y), blo(kraw.z), bhi(kraw.z), blo(kraw.w), bhi(kraw.w)}, qv[8] = {0.f, 0.f, 0.f, 0.f, 0.f, 0.f, 0.f, 0.f};
#pragma unroll
            for (int h = 0; h < 8; ++h) { const u32x4 q = *(const u32x4*)(prow + C_QI + h * 64 + dc * 8);
                qv[0] = fmaf(wf[h], blo(q.x), qv[0]); qv[1] = fmaf(wf[h], bhi(q.x), qv[1]); qv[2] = fmaf(wf[h], blo(q.y), qv[2]); qv[3] = fmaf(wf[h], bhi(q.y), qv[3]);
                qv[4] = fmaf(wf[h], blo(q.z), qv[4]); qv[5] = fmaf(wf[h], bhi(q.z), qv[5]); qv[6] = fmaf(wf[h], blo(q.w), qv[6]); qv[7] = fmaf(wf[h], bhi(q.w), qv[7]); }
            float s = 0.f;
#pragma unroll
            for (int i = 0; i < 8; ++i) s += kv[i];
            s += __shfl_xor(s, 1); s += __shfl_xor(s, 2); s += __shfl_xor(s, 4); const float m = s * (1.f / 64.f);
            float s2 = 0.f;
#pragma unroll
            for (int i = 0; i < 8; ++i) { kv[i] -= m; s2 += kv[i] * kv[i]; }
            s2 += __shfl_xor(s2, 1); s2 += __shfl_xor(s2, 2); s2 += __shfl_xor(s2, 4); const float rstd = rsqrtf(s2 * (1.f / 64.f) + EPS);
            const f32x4 ga = *(const f32x4*)(p.idx_g + dc * 8), gb = *(const f32x4*)(p.idx_g + dc * 8 + 4), ba = *(const f32x4*)(p.idx_b + dc * 8), bb = *(const f32x4*)(p.idx_b + dc * 8 + 4);
            const float gg[8] = {ga.x, ga.y, ga.z, ga.w, gb.x, gb.y, gb.z, gb.w}, bbv[8] = {ba.x, ba.y, ba.z, ba.w, bb.x, bb.y, bb.z, bb.w};
            const int cd = (dc & 3) * 8;
            const f32x4 c0 = *(const f32x4*)(COS + t * 32 + cd), c1 = *(const f32x4*)(COS + t * 32 + cd + 4), s0 = *(const f32x4*)(SIN + t * 32 + cd), s1 = *(const f32x4*)(SIN + t * 32 + cd + 4);
            const float cc[8] = {c0.x, c0.y, c0.z, c0.w, c1.x, c1.y, c1.z, c1.w}, ss[8] = {s0.x, s0.y, s0.z, s0.w, s1.x, s1.y, s1.z, s1.w};
            float ko[8], qo[8];
#pragma unroll
            for (int i = 0; i < 8; ++i) { const float yk = kv[i] * rstd * gg[i] + bbv[i]; const float ok = __shfl_xor(yk, 4), oq = __shfl_xor(qv[i], 4);
                ko[i] = (dc < 4) ? (yk * cc[i] - ok * ss[i]) : (yk * cc[i] + ok * ss[i]); qo[i] = (dc < 4) ? (qv[i] * cc[i] - oq * ss[i]) : (qv[i] * cc[i] + oq * ss[i]); }
            if (lane < 32) { store8_bf16(KI + (size_t)t * 64 + dc * 8, ko); store8_bf16(QL + (size_t)t * 64 + dc * 8, qo);
                if (dc == 0) { *(f32x4*)(WI + t * 8) = (f32x4){wf[0], wf[1], wf[2], wf[3]}; *(f32x4*)(WI + t * 8 + 4) = (f32x4){wf[4], wf[5], wf[6], wf[7]}; } } }
        __syncthreads();
        ISEC(14);
#pragma unroll 3
        for (int it = tid; it < 32 * 96; it += NTHREADS) { const int tl = it / 96, rem = it % 96, ten = rem >> 5, hh = (rem >> 2) & 7, ch = rem & 3; const int t = t0 + tl;
            bf16* base = PROJ + (size_t)t * NP + (ten == 0 ? C_Q : ten == 1 ? C_K : C_QI) + hh * 64 + ch * 8; const float sc = (ten == 0) ? C2 : 1.f;
            const u32x4 xa = *(const u32x4*)base, xb = *(const u32x4*)(base + 32);
            const f32x4 c0 = *(const f32x4*)(COS + t * 32 + ch * 8), c1 = *(const f32x4*)(COS + t * 32 + ch * 8 + 4), s0 = *(const f32x4*)(SIN + t * 32 + ch * 8), s1 = *(const f32x4*)(SIN + t * 32 + ch * 8 + 4);
            const float x1[8] = {blo(xa.x), bhi(xa.x), blo(xa.y), bhi(xa.y), blo(xa.z), bhi(xa.z), blo(xa.w), bhi(xa.w)}, x2[8] = {blo(xb.x), bhi(xb.x), blo(xb.y), bhi(xb.y), blo(xb.z), bhi(xb.z), blo(xb.w), bhi(xb.w)};
            const float cc[8] = {c0.x, c0.y, c0.z, c0.w, c1.x, c1.y, c1.z, c1.w}, ss[8] = {s0.x, s0.y, s0.z, s0.w, s1.x, s1.y, s1.z, s1.w};
            float o1[8], o2[8];
#pragma unroll
            for (int i = 0; i < 8; ++i) { o1[i] = (x1[i] * cc[i] - x2[i] * ss[i]) * sc; o2[i] = (x2[i] * cc[i] + x1[i] * ss[i]) * sc; }
            { float am = fmaxf(fabsf(o1[0]), fabsf(o2[0]));
#pragma unroll
                for (int i = 1; i < 8; ++i) am = fmaxf(am, fmaxf(fabsf(o1[i]), fabsf(o2[i])));
                kmx = fmaxf(kmx, (ten == 1) ? am : 0.f); }
            store8_bf16(base, o1); store8_bf16(base + 32, o2); }
        ISEC(5);
    }
    kmx = wave_max(kmx);
    __syncthreads(); if (lane == 0) RED[wave] = kmx; __syncthreads();
    if (tid == 0) { float m = RED[0];
#pragma unroll
        for (int w = 1; w < 8; ++w) m = fmaxf(m, RED[w]);
        atomicMax((unsigned*)(p.ws + WS_CTL) + CW_KMAX, __float_as_uint(m * 1.01f)); }
}

__device__ __forceinline__ unsigned fkey(float f) { unsigned u = __float_as_uint(f); if (u == 0x80000000u) u = 0u; return (u & 0x80000000u) ? ~u : (u | 0x80000000u); }
__device__ __forceinline__ void phase_idx_naive(const Params& p, unsigned char* lds) {
    const int tid = opaque_tid(), lane = tid & 63, wave = tid >> 6;
    const bf16* PROJ = (const bf16*)(p.ws + WS_PROJ); const bf16* KI = (const bf16*)(p.ws + WS_KI); const float* WI = (const float*)(p.ws + WS_WI);
    u64* MASK = (u64*)(p.ws + WS_MASK);
    float* scores = (float*)lds;
    float* qif = (float*)(lds + 65536);
    float* wf = (float*)(lds + 65536 + 2048);
    unsigned* hist = (unsigned*)(lds + 65536 + 4096);
    u64* tiebits = (u64*)(lds + 65536 + 8192);
    int* sh = (int*)(lds + 65536 + 12288);
    for (int t = blockIdx.x; t < S; t += gridDim.x) {
        const int tq = t >> 6, nadm = 64 * (tq + 1), ntw = 4 * (t >> 8) + 4;
        __syncthreads();
        if (nadm <= KSEL) {
            if (tid < ntw) MASK[(size_t)tid * S + t] = (tid <= tq) ? ~0ull : 0ull;
            continue;
        }
        qif[tid] = bf2f(PROJ[(size_t)t * NP + C_QI + tid]); if (tid < 8) wf[tid] = WI[t * 8 + tid];
        __syncthreads();
        for (int s = tid; s < nadm; s += NTHREADS) {
            float kf[64];
#pragma unroll
            for (int j = 0; j < 8; ++j) { const u32x4 v = *(const u32x4*)(KI + (size_t)s * 64 + j * 8);
                kf[j * 8 + 0] = blo(v.x); kf[j * 8 + 1] = bhi(v.x); kf[j * 8 + 2] = blo(v.y); kf[j * 8 + 3] = bhi(v.y); kf[j * 8 + 4] = blo(v.z); kf[j * 8 + 5] = bhi(v.z); kf[j * 8 + 6] = blo(v.w); kf[j * 8 + 7] = bhi(v.w); }
            float I = 0.f;
            for (int h = 0; h < 8; ++h) { float d = 0.f;
#pragma unroll
                for (int k = 0; k < 64; k += 4) { const f32x4 q4 = *(const f32x4*)(qif + h * 64 + k); d = fmaf(q4.x, kf[k], d); d = fmaf(q4.y, kf[k + 1], d); d = fmaf(q4.z, kf[k + 2], d); d = fmaf(q4.w, kf[k + 3], d); }
                I = fmaf(wf[h], fmaxf(d, 0.f), I); }
            scores[s] = I;
        }
        __syncthreads();
        unsigned prefix = 0; int kk = KSEL;
        for (int ps = 0; ps < 4; ++ps) {
            const int shift = 24 - 8 * ps;
            if (tid < 256) hist[tid] = 0u;
            __syncthreads();
            for (int s = tid; s < nadm; s += NTHREADS) { const unsigned key = fkey(scores[s]); if (ps == 0 || (key >> (shift + 8)) == prefix) atomicAdd(&hist[(key >> shift) & 255u], 1u); }
            __syncthreads();
            if (wave == 0) {
                unsigned c4[4]; unsigned tot = 0;
#pragma unroll
                for (int j = 0; j < 4; ++j) { c4[j] = hist[255 - (4 * lane + j)]; tot += c4[j]; }
                unsigned incl = tot;
#pragma unroll
                for (int o = 1; o < 64; o <<= 1) { const unsigned v = __shfl_up(incl, o); if (lane >= o) incl += v; }
                const unsigned excl = incl - tot;
                if (excl < (unsigned)kk && (unsigned)kk <= incl) { const unsigned s0 = excl + c4[0], s1 = s0 + c4[1], s2 = s1 + c4[2]; const unsigned ukk = (unsigned)kk;
                    const int j = ukk <= s0 ? 0 : ukk <= s1 ? 1 : ukk <= s2 ? 2 : 3; const unsigned cum = ukk <= s0 ? excl : ukk <= s1 ? s0 : ukk <= s2 ? s1 : s2;
                    sh[0] = 255 - (4 * lane + j); sh[1] = kk - (int)cum; }
            }
            __syncthreads();
            prefix = (prefix << 8) | (unsigned)sh[0]; kk = sh[1];
            __syncthreads();
        }
        const unsigned T = prefix;
        if (wave == 0) { int run = 0;
            for (int tile = 0; tile <= tq; ++tile) { const bool tie = fkey(scores[tile * 64 + lane]) == T; const u64 bal = __ballot(tie);
                const int rank = run + __popcll(bal & ((1ull << lane) - 1ull)); const u64 tb = __ballot(tie && rank < kk); if (lane == 0) tiebits[tile] = tb; run += __popcll(bal); } }
        __syncthreads();
        for (int tile = wave; tile < ntw; tile += NWAVES) { u64 w = 0ull;
            if (tile <= tq) { w = __ballot(fkey(scores[tile * 64 + lane]) > T) | tiebits[tile]; }
            if (lane == 0) MASK[(size_t)tile * S + t] = w; }
    }
}

namespace idxf {
typedef short bf16x8 __attribute__((ext_vector_type(8)));
typedef float f32x16 __attribute__((ext_vector_type(16)));
constexpr int L_B = 0, L_HIST = 36864, L_PK = L_HIST + 32 * 513 * 4, L_TAIL = L_PK + 2048, L_CC = L_TAIL + 2 * 32 * 64 * 4, L_CT = L_CC + 16 * 32 * 4, L_END = L_CT + 16 * 32 * 4;
constexpr int PK_P = 0, PK_KK = 32, PK_TC = 64, PK_A = 96, PK_SC = 128, PK_MN = 160, PK_MX = 192, PK_FLAG = 224, PK_LO = 256, PK_ND = 288, PK_NC = 320;
constexpr int CAND_CAP = 1024;
constexpr int R_HI = 12, R_LO = 56;
static_assert(L_END <= 131072, "idx LDS");
__device__ __forceinline__ unsigned fkey32(float f) { const unsigned u = __float_as_uint(f); return u ^ ((unsigned)((int)u >> 31) | 0x80000000u); }
__device__ __forceinline__ float fkey_inv(unsigned k) { return __uint_as_float((k & 0x80000000u) ? (k ^ 0x80000000u) : ~k); }
__device__ __forceinline__ int lbin(float I, float A, float sc) { const int b = (int)((I - A) * sc); return b < 0 ? 0 : (b > 1023 ? 1023 : b); }

template <int MODE>
__device__ __forceinline__ void sweep(const Params& p, LAS unsigned char* L, int q0, int ntk, int wave, int lane) {
    const int j = lane & 31, hi = lane >> 5;
    const bf16* KI = (const bf16*)(p.ws + WS_KI); u64* MASK = (u64*)(p.ws + WS_MASK);
    LAS unsigned* PK = (LAS unsigned*)(L + L_PK); LAS unsigned* tailk = (LAS unsigned*)(L + L_TAIL); LAS unsigned* taili = tailk + 32 * 64;
    LAS unsigned* hist = (LAS unsigned*)(L + L_HIST) + ((MODE == 5 || MODE >= 7) ? j : j * 257);
    float w[8]; { const f32x4 wa = *(const f32x4*)((const float*)(p.ws + WS_WI) + (size_t)(q0 + j) * 8), wb = *(const f32x4*)((const float*)(p.ws + WS_WI) + (size_t)(q0 + j) * 8 + 4);
        w[0] = wa.x; w[1] = wa.y; w[2] = wa.z; w[3] = wa.w; w[4] = wb.x; w[5] = wb.y; w[6] = wb.z; w[7] = wb.w; }
    const unsigned P = (MODE == 2 || MODE == 3 || MODE == 6 || MODE == 8) ? PK[PK_P + j] : 0u; const unsigned PLO = (MODE == 8) ? PK[PK_LO + j] : 0u; unsigned ndef = 0u, ccnt = 0u;
    u64* CAND = (u64*)(p.ws + WS_XS) + (size_t)(q0 + j) * CAND_CAP + (wave * 2 + hi) * 64;
    const int nloop = (MODE == 4) ? NWAVES : (MODE == 7) ? ((ntk + 7) >> 3) : ntk;
    const float lA = (MODE >= 5) ? __uint_as_float(PK[PK_A + j]) : 0.f, lS = (MODE >= 5) ? __uint_as_float(PK[PK_SC + j]) : 0.f;
    const LAS unsigned char* bfr = L + L_B + lane * 16;
    const bf16* abase = KI + hi * 8;
    unsigned kmn = 0xffffffffu, tk8[8] = {0u, 0u, 0u, 0u, 0u, 0u, 0u, 0u};
    bf16x8 a[2][4];
#define IDX_LOADA(dst, kt_) do { _Pragma("unroll") for (int hf = 0; hf < 2; ++hf) { const int row = (MODE == 4) ? ((((kt_) * 64 + hf * 32 + (lane & 31)) * (ntk * 64)) >> 9) : (MODE == 7) ? min((((kt_) * 64 + hf * 32 + (lane & 31)) << 3) + 5, ntk * 64 - 1) : ((kt_) * 64 + hf * 32 + (lane & 31)); \
            _Pragma("unroll") for (int ks = 0; ks < 4; ++ks) dst[hf][ks] = *(const bf16x8*)(abase + (size_t)row * 64 + ks * 16); } } while (0)
    for (int kt = wave; kt < nloop; kt += NWAVES) {
        IDX_LOADA(a, kt);
        f32x16 L0, L1; float I0[16], I1[16];
        f32x16 cA0, cA1, cB0, cB1; bf16x8 bA[4], bB[4];
#define IDX_LOADB(BD, H) do { _Pragma("unroll") for (int ks = 0; ks < 4; ++ks) BD[ks] = *(const LAS bf16x8*)(bfr + ((H) * 4 + ks) * 1024); } while (0)
#define IDX_CHAIN(D0, D1, BS) do { D0 = f32x16{}; D1 = f32x16{}; _Pragma("unroll") for (int ks = 0; ks < 4; ++ks) { \
            D0 = __builtin_amdgcn_mfma_f32_32x32x16_bf16(a[0][ks], BS[ks], D0, 0, 0, 0); D1 = __builtin_amdgcn_mfma_f32_32x32x16_bf16(a[1][ks], BS[ks], D1, 0, 0, 0); } \
            asm volatile("" : "+v"(D0)); asm volatile("" : "+v"(D1)); } while (0)
#define IDX_ACC(C0_, C1_, H) do { _Pragma("unroll") for (int r = 0; r < 16; ++r) { I0[r] = fmaf(w[H], __builtin_fabsf(C0_[r]), I0[r]); I1[r] = fmaf(w[H], __builtin_fabsf(C1_[r]), I1[r]); asm volatile("" : "+v"(I0[r]), "+v"(I1[r])); } } while (0)
#define IDX_SB __builtin_amdgcn_sched_barrier(0)
        IDX_LOADB(bA, 8); IDX_LOADB(bB, 0); IDX_SB;
        IDX_LOADB(bA, 8); IDX_CHAIN(L0, L1, bA); IDX_SB;
        IDX_LOADB(bA, 1); IDX_CHAIN(cA0, cA1, bB); IDX_SB;
#pragma unroll
        for (int r = 0; r < 16; ++r) { I0[r] = L0[r]; I1[r] = L1[r]; }
        IDX_LOADB(bB, 2); IDX_CHAIN(cB0, cB1, bA); IDX_ACC(cA0, cA1, 0); IDX_SB;
        IDX_LOADB(bA, 3); IDX_CHAIN(cA0, cA1, bB); IDX_ACC(cB0, cB1, 1); IDX_SB;
        IDX_LOADB(bB, 4); IDX_CHAIN(cB0, cB1, bA); IDX_ACC(cA0, cA1, 2); IDX_SB;
        IDX_LOADB(bA, 5); IDX_CHAIN(cA0, cA1, bB); IDX_ACC(cB0, cB1, 3); IDX_SB;
        IDX_LOADB(bB, 6); IDX_CHAIN(cB0, cB1, bA); IDX_ACC(cA0, cA1, 4); IDX_SB;
        IDX_LOADB(bA, 7); IDX_CHAIN(cA0, cA1, bB); IDX_ACC(cB0, cB1, 5); IDX_SB;
        IDX_CHAIN(cB0, cB1, bA); IDX_ACC(cA0, cA1, 6); IDX_SB;
        IDX_ACC(cB0, cB1, 7);
        IDX_SB;
#undef IDX_LOADB
#undef IDX_SB
#undef IDX_CHAIN
#undef IDX_ACC
        if (MODE == 1) {
#pragma unroll
            for (int r = 0; r < 16; ++r) { const unsigned k0 = fkey32(I0[r]), k1 = fkey32(I1[r]);
                __hip_atomic_fetch_add(hist + (k0 >> 24), 1u, __ATOMIC_RELAXED, __HIP_MEMORY_SCOPE_WORKGROUP); __hip_atomic_fetch_add(hist + (k1 >> 24), 1u, __ATOMIC_RELAXED, __HIP_MEMORY_SCOPE_WORKGROUP); }
        } else if (MODE == 2) {
#pragma unroll
            for (int r = 0; r < 16; ++r) { const unsigned k0 = fkey32(I0[r]), k1 = fkey32(I1[r]);
                if ((k0 >> 24) == P) __hip_atomic_fetch_add(hist + ((k0 >> 16) & 255u), 1u, __ATOMIC_RELAXED, __HIP_MEMORY_SCOPE_WORKGROUP);
                if ((k1 >> 24) == P) __hip_atomic_fetch_add(hist + ((k1 >> 16) & 255u), 1u, __ATOMIC_RELAXED, __HIP_MEMORY_SCOPE_WORKGROUP); }
        } else if (MODE == 4) {
#pragma unroll
            for (int r = 0; r < 16; ++r) { unsigned k0 = fkey32(I0[r]), k1 = fkey32(I1[r]); kmn = min(kmn, min(k0, k1));
#pragma unroll
                for (int i = 0; i < 8; ++i) { const unsigned hi0 = max(tk8[i], k0); k0 = min(tk8[i], k0); tk8[i] = hi0; }
#pragma unroll
                for (int i = 0; i < 8; ++i) { const unsigned hi1 = max(tk8[i], k1); k1 = min(tk8[i], k1); tk8[i] = hi1; } }
        } else if (MODE == 5 || MODE == 7) {
#pragma unroll
            for (int r = 0; r < 16; ++r) { const int b0 = lbin(I0[r], lA, lS), b1 = lbin(I1[r], lA, lS); const int kb = (r & 3) + 8 * (r >> 2) + 4 * hi;
                const bool v0 = (MODE == 5) || (((kt * 64 + kb) << 3) + 5 < ntk * 64), v1 = (MODE == 5) || (((kt * 64 + 32 + kb) << 3) + 5 < ntk * 64);
                if (v0) __hip_atomic_fetch_add(hist + (b0 >> 1) * 32, 1u << ((b0 & 1) * 16), __ATOMIC_RELAXED, __HIP_MEMORY_SCOPE_WORKGROUP);
                if (v1) __hip_atomic_fetch_add(hist + (b1 >> 1) * 32, 1u << ((b1 & 1) * 16), __ATOMIC_RELAXED, __HIP_MEMORY_SCOPE_WORKGROUP); }
        } else if (MODE == 8) {
            unsigned wlo = 0u, whi = 0u; const float thi = (P >= 1023u) ? INFINITY : (float)(P + 1u), tlo = (float)PLO;     const unsigned wbits = __float_as_uint(thi - tlo);
#pragma unroll
            for (int r = 0; r < 16; ++r) { const int kb = (r & 3) + 8 * (r >> 2); const float x0 = (I0[r] - lA) * lS, x1 = (I1[r] - lA) * lS;
                wlo |= (x0 >= thi) ? (1u << kb) : 0u; whi |= (x1 >= thi) ? (1u << kb) : 0u;
                if (__float_as_uint(x0 - tlo) < wbits) { const unsigned c0 = (unsigned)lbin(I0[r], lA, lS); __hip_atomic_fetch_add(hist + (c0 >> 1) * 32, 1u << ((c0 & 1) * 16), __ATOMIC_RELAXED, __HIP_MEMORY_SCOPE_WORKGROUP);
                    if (ccnt < 64u) CAND[ccnt] = ((u64)fkey32(I0[r]) << 32) | (u64)(unsigned)(kt * 64 + kb + 4 * hi); ++ccnt; }
                if (__float_as_uint(x1 - tlo) < wbits) { const unsigned c1 = (unsigned)lbin(I1[r], lA, lS); __hip_atomic_fetch_add(hist + (c1 >> 1) * 32, 1u << ((c1 & 1) * 16), __ATOMIC_RELAXED, __HIP_MEMORY_SCOPE_WORKGROUP);
                    if (ccnt < 64u) CAND[ccnt] = ((u64)fkey32(I1[r]) << 32) | (u64)(unsigned)(kt * 64 + 32 + kb + 4 * hi); ++ccnt; } }
            wlo <<= 4 * hi; whi <<= 4 * hi;
            wlo |= (unsigned)__shfl_xor((int)wlo, 32); whi |= (unsigned)__shfl_xor((int)whi, 32);
            if (hi == 0) { MASK[(size_t)kt * S + q0 + j] = ((u64)whi << 32) | (u64)wlo; ndef += (unsigned)(__popc(wlo) + __popc(whi)); }
        } else {
            unsigned wlo = 0u, whi = 0u;
#pragma unroll
            for (int r = 0; r < 16; ++r) { const int kb = (r & 3) + 8 * (r >> 2); const unsigned k0 = fkey32(I0[r]), k1 = fkey32(I1[r]);
                const unsigned c0 = (MODE == 3) ? (k0 >> 16) : (unsigned)lbin(I0[r], lA, lS), c1 = (MODE == 3) ? (k1 >> 16) : (unsigned)lbin(I1[r], lA, lS);
                wlo |= (c0 > P) ? (1u << kb) : 0u; whi |= (c1 > P) ? (1u << kb) : 0u;
                if (c0 == P) { const unsigned pos = __hip_atomic_fetch_add(PK + PK_TC + j, 1u, __ATOMIC_RELAXED, __HIP_MEMORY_SCOPE_WORKGROUP); if (pos < 64u) { tailk[j * 64 + pos] = k0; taili[j * 64 + pos] = (unsigned)(kt * 64 + kb + 4 * hi); } }
                if (c1 == P) { const unsigned pos = __hip_atomic_fetch_add(PK + PK_TC + j, 1u, __ATOMIC_RELAXED, __HIP_MEMORY_SCOPE_WORKGROUP); if (pos < 64u) { tailk[j * 64 + pos] = k1; taili[j * 64 + pos] = (unsigned)(kt * 64 + 32 + kb + 4 * hi); } } }
            wlo <<= 4 * hi; whi <<= 4 * hi;
            wlo |= (unsigned)__shfl_xor((int)wlo, 32); whi |= (unsigned)__shfl_xor((int)whi, 32);
            if (hi == 0) MASK[(size_t)kt * S + q0 + j] = ((u64)whi << 32) | (u64)wlo;
        }
    }
#undef IDX_LOADA
    if (MODE == 8) { if (hi == 0 && ndef) __hip_atomic_fetch_add(PK + PK_ND + j, ndef, __ATOMIC_RELAXED, __HIP_MEMORY_SCOPE_WORKGROUP); ((LAS unsigned*)(L + L_CC))[(wave * 2 + hi) * 32 + j] = ccnt; }
    if (MODE == 4) {
        const int nadm = ntk * 64; const unsigned cand = nadm >= 8192 ? tk8[3] : nadm >= 4096 ? tk8[7] : nadm >= 2048 ? kmn : nadm >= 1024 ? tk8[7] : kmn;
        __hip_atomic_fetch_min(PK + PK_MN + j, cand, __ATOMIC_RELAXED, __HIP_MEMORY_SCOPE_WORKGROUP); __hip_atomic_fetch_max(PK + PK_MX + j, tk8[0], __ATOMIC_RELAXED, __HIP_MEMORY_SCOPE_WORKGROUP); }
}

__device__ __forceinline__ void scan4(LAS unsigned char* L, int wave, int lane) {
    LAS unsigned* PK = (LAS unsigned*)(L + L_PK);
    for (int qq = 0; qq < 4; ++qq) { const int jq = wave * 4 + qq; const LAS unsigned* hb = (const LAS unsigned*)(L + L_HIST) + jq * 257;
        const unsigned kk = PK[PK_KK + jq];
        const unsigned c0 = hb[255 - 4 * lane], c1 = hb[254 - 4 * lane], c2 = hb[253 - 4 * lane], c3 = hb[252 - 4 * lane]; const unsigned tot = c0 + c1 + c2 + c3;
        unsigned incl = tot;
#pragma unroll
        for (int o = 1; o < 64; o <<= 1) { const unsigned v = __shfl_up(incl, o); if (lane >= o) incl += v; }
        const unsigned excl = incl - tot;
        if (excl < kk && kk <= incl) { const unsigned s0 = excl + c0, s1 = s0 + c1, s2 = s1 + c2;
            const int jb = kk <= s0 ? 0 : kk <= s1 ? 1 : kk <= s2 ? 2 : 3; const unsigned cum = kk <= s0 ? excl : kk <= s1 ? s0 : kk <= s2 ? s1 : s2;
            PK[PK_P + jq] = (PK[PK_P + jq] << 8) | (unsigned)(255 - (4 * lane + jb)); PK[PK_KK + jq] = kk - cum; }
    }
}
__device__ __forceinline__ void scan_lin(LAS unsigned char* L, int tid, int kk_off = PK_KK, int out_off = PK_P, bool write_kk = true) {
    LAS unsigned* PK = (LAS unsigned*)(L + L_PK); LAS unsigned* CT = (LAS unsigned*)(L + L_CT);
    const int jq = tid & 31, ch = tid >> 5; const LAS unsigned* hb = (const LAS unsigned*)(L + L_HIST) + (32 * ch) * 32 + jq;
    unsigned tot = 0u;
#pragma unroll 8
    for (int i = 0; i < 32; ++i) { const unsigned wd = hb[i * 32]; tot += (wd & 0xffffu) + (wd >> 16); }
    CT[ch * 32 + jq] = tot;
    __syncthreads();
    unsigned excl = 0u;
#pragma unroll
    for (int c = 1; c < 16; ++c) excl += (c > ch) ? CT[c * 32 + jq] : 0u;
    const unsigned kk = PK[kk_off + jq];
    if (excl < kk && kk <= excl + tot) { unsigned cum = excl, bsel = 0u, nk = 0u; bool done = false;
        for (int i = 31; i >= 0; --i) { const unsigned wd = hb[i * 32]; const unsigned chi = wd >> 16, clo = wd & 0xffffu;
            bool hit = !done && (cum + chi >= kk); bsel = hit ? (unsigned)(2 * (32 * ch + i) + 1) : bsel; nk = hit ? (kk - cum) : nk; done = done || hit; cum += chi;
            hit = !done && (cum + clo >= kk); bsel = hit ? (unsigned)(2 * (32 * ch + i)) : bsel; nk = hit ? (kk - cum) : nk; done = done || hit; cum += clo; }
        PK[out_off + jq] = bsel; if (write_kk) PK[PK_KK + jq] = nk; }
}
template <bool TOLDS>
__device__ __forceinline__ void tail_resolve(const Params& p, LAS unsigned char* L, int q0, int tid) {
    u64* MASK = (u64*)(p.ws + WS_MASK); LAS unsigned* PK = (LAS unsigned*)(L + L_PK); LAS u64* MW = (LAS u64*)(L + L_HIST);
    const int jq = tid >> 4, e0 = tid & 15; const unsigned n = min(PK[PK_TC + jq], 64u), kk = PK[PK_KK + jq];
    const LAS unsigned* tk = (const LAS unsigned*)(L + L_TAIL) + jq * 64; const LAS unsigned* ti = tk + 32 * 64;
    for (unsigned e = e0; e < n; e += 16) { const unsigned k = tk[e], s = ti[e]; unsigned rank = 0;
        for (unsigned e2 = 0; e2 < n; ++e2) { const unsigned k2 = tk[e2], s2 = ti[e2]; rank += (k2 > k || (k2 == k && s2 < s)) ? 1u : 0u; }
        if (rank < kk) { if (TOLDS) __hip_atomic_fetch_or(MW + (s >> 6) * 32 + jq, 1ull << (s & 63), __ATOMIC_RELAXED, __HIP_MEMORY_SCOPE_WORKGROUP);
            else atomicOr((unsigned long long*)&MASK[(size_t)(s >> 6) * S + q0 + jq], 1ull << (s & 63)); } }
}
__device__ __forceinline__ void idx_unit(const Params& p, unsigned char* lds, int u) {
    int tid_ = threadIdx.x; asm volatile("" : "+v"(tid_)); const int tid = tid_, lane = tid & 63; const int wave = __builtin_amdgcn_readfirstlane(tid >> 6);
    LAS unsigned char* L = (LAS unsigned char*)lds;
    const int q0 = u * 32, tq = q0 >> 6, ntk = tq + 1, ntw = 4 * (q0 >> 8) + 4;
    u64* MASK = (u64*)(p.ws + WS_MASK);
    if (ntk * 64 <= KSEL) { for (int i = tid; i < ntw * 32; i += NTHREADS) { const int tile = i >> 5; MASK[(size_t)tile * S + q0 + (i & 31)] = (tile <= tq) ? ~0ull : 0ull; } return; }
    for (int i = tid; i < (ntw - ntk) * 32; i += NTHREADS) MASK[(size_t)(ntk + (i >> 5)) * S + q0 + (i & 31)] = 0ull;
    __syncthreads();
    ISEC(7);
    { const bf16* PROJ = (const bf16*)(p.ws + WS_PROJ); const bf16* QL = (const bf16*)(p.ws + WS_QL); const int j = lane & 31, hi = lane >> 5;
        u32x4 bv[5];
#pragma unroll
        for (int i = 0; i < 5; ++i) { const int f = wave + NWAVES * i; if (f < 36) { const int h = f >> 2, ks = f & 3;
                const bf16* src = (h < 8) ? PROJ + (size_t)(q0 + j) * NP + C_QI + h * 64 + ks * 16 + hi * 8 : QL + (size_t)(q0 + j) * 64 + ks * 16 + hi * 8; bv[i] = *(const u32x4*)src; } }
#pragma unroll
        for (int i = 0; i < 5; ++i) { const int f = wave + NWAVES * i; if (f < 36) *(LAS u32x4*)(L + L_B + f * 1024 + lane * 16) = bv[i]; } }
    LAS unsigned* PK = (LAS unsigned*)(L + L_PK);
    if (tid < 32) { PK[PK_P + tid] = 0u; PK[PK_KK + tid] = (unsigned)KSEL; PK[PK_TC + tid] = 0u; PK[PK_MN + tid] = 0xffffffffu; PK[PK_MX + tid] = 0u; }
    if (tid == 0) PK[PK_FLAG] = 0u;
    for (int i = tid; i < 32 * 513; i += NTHREADS) ((LAS unsigned*)(L + L_HIST))[i] = 0u;
    __syncthreads();
    ISEC(0);
    sweep<4>(p, L, q0, ntk, wave, lane);
    __syncthreads();
    ISEC(1);
    if (tid < 32) { const float mn = fkey_inv(PK[PK_MN + tid]), mx = fkey_inv(PK[PK_MX + tid]); const float rg = mx - mn; const float A = mn; const float sc = 1024.f / (1.5f * rg);
        PK[PK_A + tid] = __float_as_uint(A); PK[PK_SC + tid] = __float_as_uint(sc); if (!(rg > 0.f) || !(sc < 3.0e38f)) PK[PK_FLAG] = 1u; }
    __syncthreads();
    bool fallback = PK[PK_FLAG] != 0u;
    bool done = false;
    if (!fallback && ntk >= 32) {
        sweep<7>(p, L, q0, ntk, wave, lane);
        __syncthreads();
        ISEC(8);
        if (tid < 32) { PK[PK_ND + tid] = (unsigned)R_HI; PK[PK_NC + tid] = (unsigned)R_LO; }
        __syncthreads();
        scan_lin(L, tid, PK_ND, PK_P, false);
        __syncthreads();
        scan_lin(L, tid, PK_NC, PK_LO, false);
        __syncthreads();
        if (tid < 32) { PK[PK_ND + tid] = 0u; PK[PK_NC + tid] = 0u; }
        for (int i = tid; i < 32 * 513; i += NTHREADS) ((LAS unsigned*)(L + L_HIST))[i] = 0u;
        __syncthreads();
        ISEC(9);
        sweep<8>(p, L, q0, ntk, wave, lane);
        __syncthreads();
        ISEC(10);
        if (tid < 32) { const LAS unsigned* cc = (const LAS unsigned*)(L + L_CC) + tid; unsigned nc = 0u, mxc = 0u;
#pragma unroll
            for (int i = 0; i < 16; ++i) { const unsigned c = cc[i * 32]; nc += c; mxc = max(mxc, c); }
            const unsigned nd = PK[PK_ND + tid]; const bool ok = nd < (unsigned)KSEL && nd + nc >= (unsigned)KSEL && mxc <= 64u;
            if (!ok) PK[PK_FLAG] = 1u; PK[PK_KK + tid] = (unsigned)KSEL - (ok ? nd : 0u); PK[PK_TC + tid] = 0u; }
        __syncthreads();
        if (PK[PK_FLAG] == 0u) {
            scan_lin(L, tid);
            __syncthreads();
            LAS u64* MW = (LAS u64*)(L + L_HIST);
            for (int i = tid; i < ntk * 32; i += NTHREADS) MW[i] = 0ull;
            __syncthreads();
            { const int jq = tid >> 4, e0 = tid & 15; const unsigned nc = ((const LAS unsigned*)(L + L_CC))[e0 * 32 + jq], bt = PK[PK_P + jq]; const float cA = __uint_as_float(PK[PK_A + jq]), cS = __uint_as_float(PK[PK_SC + jq]);
                const u64* cl = (const u64*)(p.ws + WS_XS) + (size_t)(q0 + jq) * CAND_CAP + e0 * 64; LAS unsigned* tk = (LAS unsigned*)(L + L_TAIL) + jq * 64; LAS unsigned* ti = tk + 32 * 64;
                for (unsigned eb = 0; eb < nc; eb += 8) { u64 rec[8];
#pragma unroll
                    for (int i = 0; i < 8; ++i) { const unsigned e = eb + i; rec[i] = (e < nc) ? cl[e] : 0ull; }
#pragma unroll
                    for (int i = 0; i < 8; ++i) { const unsigned e = eb + i; if (e < nc) { const unsigned key = (unsigned)(rec[i] >> 32), s = (unsigned)rec[i]; const unsigned b = (unsigned)lbin(fkey_inv(key), cA, cS);
                            if (b > bt) __hip_atomic_fetch_or(MW + (s >> 6) * 32 + jq, 1ull << (s & 63), __ATOMIC_RELAXED, __HIP_MEMORY_SCOPE_WORKGROUP);
                            else if (b == bt) { const unsigned pos = __hip_atomic_fetch_add(PK + PK_TC + jq, 1u, __ATOMIC_RELAXED, __HIP_MEMORY_SCOPE_WORKGROUP); if (pos < 64u) { tk[pos] = key; ti[pos] = s; } } } } } }
            __syncthreads();
            if (tid < 32 && PK[PK_TC + tid] > 64u) PK[PK_FLAG] = 1u;
            __syncthreads();
            if (PK[PK_FLAG] == 0u) { tail_resolve<true>(p, L, q0, tid); __syncthreads();
                for (int i = tid; i < ntk * 32; i += NTHREADS) { const u64 wv = MW[i]; if (wv) { u64* gp = &MASK[(size_t)(i >> 5) * S + q0 + (i & 31)]; *gp = *gp | wv; } }
                done = true; }
        }
        ISEC(11);
        if (!done) {
            __syncthreads();
#if PROBE_PHASE == 101
            if (tid == 0) atomicAdd((unsigned*)(p.ws + WS_CTL) + 2048, 1u);
#endif
            if (tid < 32) { PK[PK_P + tid] = 0u; PK[PK_KK + tid] = (unsigned)KSEL; PK[PK_TC + tid] = 0u; }
            if (tid == 0) PK[PK_FLAG] = 0u;
            for (int i = tid; i < 32 * 513; i += NTHREADS) ((LAS unsigned*)(L + L_HIST))[i] = 0u;
            __syncthreads();
        }
    }
    if (!fallback && !done) {
        sweep<5>(p, L, q0, ntk, wave, lane);
        __syncthreads();
        ISEC(2);
        scan_lin(L, tid);
        __syncthreads();
        ISEC(3);
        sweep<6>(p, L, q0, ntk, wave, lane);
        ISEC(4);
        __syncthreads();
        if (tid < 32 && PK[PK_TC + tid] > 64u) PK[PK_FLAG] = 1u;
        __syncthreads();
        fallback = PK[PK_FLAG] != 0u;
        if (!fallback) tail_resolve<false>(p, L, q0, tid);
        ISEC(5);
    }
    if (fallback && !done) {
        __syncthreads();
#if PROBE_PHASE == 100
        if (tid == 0) atomicAdd((unsigned*)(p.ws + WS_CTL) + 2048, 1u);
#endif
        if (tid < 32) { PK[PK_P + tid] = 0u; PK[PK_KK + tid] = (unsigned)KSEL; PK[PK_TC + tid] = 0u; }
        for (int i = tid; i < 32 * 257; i += NTHREADS) ((LAS unsigned*)(L + L_HIST))[i] = 0u;
        __syncthreads();
        sweep<1>(p, L, q0, ntk, wave, lane);
        __syncthreads();
        scan4(L, wave, lane);
        __syncthreads();
        for (int i = tid; i < 32 * 257; i += NTHREADS) ((LAS unsigned*)(L + L_HIST))[i] = 0u;
        __syncthreads();
        sweep<2>(p, L, q0, ntk, wave, lane);
        __syncthreads();
        scan4(L, wave, lane);
        __syncthreads();
        sweep<3>(p, L, q0, ntk, wave, lane);
        __syncthreads();
        tail_resolve<false>(p, L, q0, tid);
    }
}
__device__ __forceinline__ void idx_phase(const Params& p, unsigned char* lds) {
    for (int w = blockIdx.x; w < 256; w += gridDim.x)
#pragma unroll 1
        for (int k = 0; k < 2; ++k) idx_unit(p, lds, k ? 511 - w : w);
}
}

__device__ __forceinline__ void phase_att_naive(const Params& p, unsigned char* lds) {
    const int tid = opaque_tid(), lane = tid & 63, wave = tid >> 6;
    const bf16* PROJ = (const bf16*)(p.ws + WS_PROJ); bf16* MIX = (bf16*)(p.ws + WS_MIX); const u64* MASK = (const u64*)(p.ws + WS_MASK);
    int* sidx = (int*)(lds + wave * 2048); float* slog = (float*)(lds + wave * 2048 + 1024);
    const int h = wave;
    for (int t = blockIdx.x; t < S; t += gridDim.x) {
        const int tq = t >> 6;
        float qf[64];
#pragma unroll
        for (int j = 0; j < 8; ++j) { const u32x4 v = *(const u32x4*)(PROJ + (size_t)t * NP + C_Q + h * 64 + j * 8);
            qf[j * 8 + 0] = blo(v.x); qf[j * 8 + 1] = bhi(v.x); qf[j * 8 + 2] = blo(v.y); qf[j * 8 + 3] = bhi(v.y); qf[j * 8 + 4] = blo(v.z); qf[j * 8 + 5] = bhi(v.z); qf[j * 8 + 6] = blo(v.w); qf[j * 8 + 7] = bhi(v.w); }
        int n = 0;
        for (int tile = 0; tile <= tq; ++tile) {
            const u64 w = MASK[(size_t)tile * S + t]; const bool sel = (w >> lane) & 1ull;
            if (w == 0ull) continue;
            float lg = 0.f; const int s = tile * 64 + lane;
            if (sel) {
#pragma unroll
                for (int j = 0; j < 8; ++j) { const u32x4 v = *(const u32x4*)(PROJ + (size_t)s * NP + C_K + h * 64 + j * 8);
                    lg = fmaf(qf[j * 8 + 0], blo(v.x), lg); lg = fmaf(qf[j * 8 + 1], bhi(v.x), lg); lg = fmaf(qf[j * 8 + 2], blo(v.y), lg); lg = fmaf(qf[j * 8 + 3], bhi(v.y), lg);
                    lg = fmaf(qf[j * 8 + 4], blo(v.z), lg); lg = fmaf(qf[j * 8 + 5], bhi(v.z), lg); lg = fmaf(qf[j * 8 + 6], blo(v.w), lg); lg = fmaf(qf[j * 8 + 7], bhi(v.w), lg); }
                const int pos = n + __popcll(w & ((1ull << lane) - 1ull));
                if (pos < 256) { sidx[pos] = s; slog[pos] = lg; }
            }
            n += __popcll(w);
        }
        if (n > 256) n = 256;
        __builtin_amdgcn_s_waitcnt(0); asm volatile("" ::: "memory");
        float m = -INFINITY; for (int j = lane; j < n; j += 64) m = fmaxf(m, slog[j]);
        m = wave_max(m);
        float l = 0.f; for (int j = lane; j < n; j += 64) { const float pj = exp2f(slog[j] - m); slog[j] = pj; l += pj; }
        l = wave_sum(l);
        __builtin_amdgcn_s_waitcnt(0); asm volatile("" ::: "memory");
        float o = 0.f;
        for (int j = 0; j < n; ++j) o = fmaf(slog[j], bf2f(PROJ[(size_t)sidx[j] * NP + C_V + h * 64 + lane]), o);
        MIX[(size_t)t * D + 512 + h * 64 + lane] = (bf16)f2bf(o / l);
        __builtin_amdgcn_s_waitcnt(0); asm volatile("" ::: "memory");
    }
}

namespace attn_body {
using bf16=__hip_bfloat16;
using bf16x8=__attribute__((ext_vector_type(8)))short;
using s16x4=__attribute__((ext_vector_type(4)))short;
using f32x16=__attribute__((ext_vector_type(16)))float;
using u32x4=__attribute__((ext_vector_type(4)))unsigned;
constexpr int NHEAD=8,SEQ=16384,D=64,DMI=3328,DMO=1024;
typedef unsigned long long u64;
constexpr int NW=8,QBLK=32,QB=QBLK*NW,KVBLK=64,NQB=SEQ/QB;
__device__ __forceinline__ int crow(int r,int hi){return (r&3)+8*(r>>2)+4*hi;}
#define SBAR() __builtin_amdgcn_sched_barrier(0)
__device__ __forceinline__ void cmask(f32x16&p0,f32x16&p1,int jb,int qrel,int hi){
  const float NEG=-INFINITY; int kb=64*jb+4*hi;
  #pragma unroll
  for(int r=0;r<16;++r){int kv=kb+(r&3)+8*(r>>2); if(kv>qrel)p0[r]=NEG; if(kv+32>qrel)p1[r]=NEG;}
}

constexpr int NSLOT=3, SLOTB=8192;
constexpr int LDS_K=0, LDS_V=NSLOT*SLOTB, LDS_WS=2*NSLOT*SLOTB, LDS_OST=LDS_WS+NW*64*4, LDS_M=LDS_OST+NW*4096, LDS_BYTES=LDS_M+NW*2048;
constexpr float C2=0.125f*1.4426950408889634f;
__device__ __forceinline__ void glds16s(const void*sbase,unsigned voff,unsigned lds_dst){unsigned keep;
  asm volatile("s_mov_b32 %0, m0\n\ts_mov_b32 m0, %3\n\ts_nop 0\n\tglobal_load_lds_dwordx4 %1, %2\n\ts_mov_b32 m0, %0":"=&s"(keep):"v"(voff),"s"(sbase),"s"(lds_dst):"memory");}
__device__ __forceinline__ void glds16(const void*gsrc,unsigned lds_dst){unsigned keep;
  asm volatile("s_mov_b32 %0, m0\n\ts_mov_b32 m0, %2\n\ts_nop 0\n\tglobal_load_lds_dwordx4 %1, off\n\ts_mov_b32 m0, %0":"=&s"(keep):"v"(gsrc),"s"(lds_dst):"memory");}
__device__ __forceinline__ float max3f(float a,float b,float c){float r;asm("v_max3_f32 %0, %1, %2, %3":"=v"(r):"v"(a),"v"(b),"v"(c));return r;}
__device__ __forceinline__ float max2f(float a,float b){float r;asm("v_max_f32_e32 %0, %1, %2":"=v"(r):"v"(a),"v"(b));return r;}
__device__ __forceinline__ float fadd_s(float a,float b){float r;asm("v_add_f32_e32 %0, %1, %2":"=v"(r):"v"(a),"v"(b));return r;}
__device__ __forceinline__ float fsub_s(float a,float b){float r;asm("v_sub_f32_e32 %0, %1, %2":"=v"(r):"v"(a),"v"(b));return r;}
typedef float f32x2_t __attribute__((ext_vector_type(2))); typedef __bf16 bf16x2_t __attribute__((ext_vector_type(2)));
__device__ __forceinline__ unsigned cvtpk_s(float lo,float hi){f32x2_t v={lo,hi};bf16x2_t b=__builtin_convertvector(v,bf16x2_t);return __builtin_bit_cast(unsigned,b);}
#define WAIT_BAR(N) asm volatile("s_waitcnt vmcnt(" #N ") lgkmcnt(0)\n\ts_barrier":::"memory")

__device__ __forceinline__ void qkt(f32x16&p0,f32x16&p1,const char*Kslot,const bf16x8*qr,int r32,int hi){ const f32x16 negm=f32x16{};
  const char*kb=Kslot+hi*1024+r32*16;
  #pragma unroll
  for(int d0=0;d0<4;++d0){
    const bf16x8 b0=*reinterpret_cast<const bf16x8*>(kb+d0*2048);
    const bf16x8 b1=*reinterpret_cast<const bf16x8*>(kb+d0*2048+512);
    if(d0==0){p0=__builtin_amdgcn_mfma_f32_32x32x16_bf16(b0,qr[0],negm,0,0,0);p1=__builtin_amdgcn_mfma_f32_32x32x16_bf16(b1,qr[0],negm,0,0,0);}
    else{p0=__builtin_amdgcn_mfma_f32_32x32x16_bf16(b0,qr[d0],p0,0,0,0);p1=__builtin_amdgcn_mfma_f32_32x32x16_bf16(b1,qr[d0],p1,0,0,0);}}
}
typedef __attribute__((address_space(3))) const char* lds_cptr;
typedef short v4i16_t __attribute__((ext_vector_type(4)));
__device__ __forceinline__ void kload8(bf16x8*kf,lds_cptr kp){
  kf[0]=*(const __attribute__((address_space(3))) bf16x8*)(kp);      kf[1]=*(const __attribute__((address_space(3))) bf16x8*)(kp+512);
  kf[2]=*(const __attribute__((address_space(3))) bf16x8*)(kp+2048); kf[3]=*(const __attribute__((address_space(3))) bf16x8*)(kp+2560);
  kf[4]=*(const __attribute__((address_space(3))) bf16x8*)(kp+4096); kf[5]=*(const __attribute__((address_space(3))) bf16x8*)(kp+4608);
  kf[6]=*(const __attribute__((address_space(3))) bf16x8*)(kp+6144); kf[7]=*(const __attribute__((address_space(3))) bf16x8*)(kp+6656);
}
__device__ __forceinline__ void kload2(bf16x8*kf,lds_cptr kp,int j){ kf[2*j]=*(const __attribute__((address_space(3))) bf16x8*)(kp+j*2048); kf[2*j+1]=*(const __attribute__((address_space(3))) bf16x8*)(kp+j*2048+512); }
__device__ __forceinline__ s16x4 vtr(lds_cptr p){ return __builtin_bit_cast(s16x4,__builtin_amdgcn_ds_read_tr16_b64_v4i16((__attribute__((address_space(3))) v4i16_t*)p)); }
__device__ __forceinline__ float rowmax(const f32x16&p0,const f32x16&p1){
  float a=max3f(p0[0],p0[1],p1[0]),b=max3f(p0[2],p0[3],p1[1]);a=max3f(a,p1[2],p1[3]);
  #pragma unroll
  for(int r=4;r<16;r+=4){a=max3f(a,p0[r],p0[r+1]);b=max3f(b,p0[r+2],p0[r+3]);a=max3f(a,p1[r],p1[r+1]);b=max3f(b,p1[r+2],p1[r+3]);}
  const float m=max2f(a,b);
  auto rr=__builtin_amdgcn_permlane32_swap(__float_as_uint(m),__float_as_uint(m),false,false);
  return max2f(__uint_as_float(rr[0]),__uint_as_float(rr[1]));
}
__device__ __forceinline__ void pv(f32x16*o,int vb,bf16x8 pa0,bf16x8 pa1,bf16x8 pa2,bf16x8 pa3){
  #pragma unroll
  for(int d0=0;d0<2;++d0){s16x4 lo[4],hi[4];
    #pragma unroll
    for(int ks=0;ks<4;++ks){
      asm volatile("ds_read_b64_tr_b16 %0,%1 offset:%c2":"=&v"(lo[ks]):"v"(vb),"i"(d0*4096+ks*1024):"memory");
      asm volatile("ds_read_b64_tr_b16 %0,%1 offset:%c2":"=&v"(hi[ks]):"v"(vb),"i"(d0*4096+ks*1024+512):"memory");}
    asm volatile("s_waitcnt lgkmcnt(0)":::"memory");SBAR();
    #define PK(k) (bf16x8){lo[k][0],lo[k][1],lo[k][2],lo[k][3],hi[k][0],hi[k][1],hi[k][2],hi[k][3]}
    o[d0]=__builtin_amdgcn_mfma_f32_32x32x16_bf16(pa0,PK(0),o[d0],0,0,0);
    o[d0]=__builtin_amdgcn_mfma_f32_32x32x16_bf16(pa1,PK(1),o[d0],0,0,0);
    o[d0]=__builtin_amdgcn_mfma_f32_32x32x16_bf16(pa2,PK(2),o[d0],0,0,0);
    o[d0]=__builtin_amdgcn_mfma_f32_32x32x16_bf16(pa3,PK(3),o[d0],0,0,0);
    #undef PK
  }
}

#ifndef ATTN_STORE16
#define ATTN_STORE16(p,v) (*(u32x4*)(p)=(v))
#endif
template<int THRL,bool NM> __device__ __forceinline__ void attn_unit(int h,int qb,const bf16*Q,const bf16*__restrict__ K,const bf16*__restrict__ V,const u64*__restrict__ MASK,bf16*O,char*shm){
  int tid_=threadIdx.x; asm volatile("":"+v"(tid_)); const int tid=tid_,lane=tid&63,r32=lane&31,hi=lane>>5; const int wid=__builtin_amdgcn_readfirstlane(tid>>6);
  const long rowbase=0; const int q0=qb*QB;
  const bf16*Qw=Q+(rowbase+q0+wid*QBLK)*DMI+h*D;
  const bf16*Kh=K+rowbase*DMI+h*D,*Vh=V+rowbase*DMI+h*D;
  const unsigned lds0=(unsigned)(uintptr_t)shm;
  float*wsf=(float*)(shm+LDS_WS)+wid*64;
  const unsigned koff=(unsigned)(lane*DMI+wid*8)*2u;
  const unsigned voffv=(unsigned)((16*(wid&3)+(lane>>2))*DMI+(wid>>2)*32+(lane&3)*8)*2u;
  const unsigned kdst=lds0+LDS_K+wid*1024, vdst=lds0+LDS_V+wid*1024;
  const u64*mbase=MASK+q0+wid*QBLK; const int jm=lane>>4; const unsigned mdst=lds0+LDS_M+wid*2048; const unsigned moff0=(unsigned)(lane&15)*16u, moff1=moff0+((jm==1)?(unsigned)SEQ*8u:0u);
  #define DMA_M2(tA,tB,slot) glds16s(mbase+(size_t)(tA)*SEQ,((tB)!=(tA))?moff1:moff0,(unsigned)__builtin_amdgcn_readfirstlane(mdst+(slot)))
  const unsigned sh4=4u*(unsigned)hi; const float NEGINF=-INFINITY;
  #define MAPPLY(C0,C1,MW) do{ const unsigned lo_=(unsigned)(MW)>>sh4, hi_=(unsigned)((MW)>>32)>>sh4; \
    _Pragma("unroll") for(int r=0;r<16;++r){ const int sh_=31-((r&3)+8*(r>>2)); const int m0_=((int)(lo_<<sh_))>>31, m1_=((int)(hi_<<sh_))>>31;   \
      C0[r]=__int_as_float((__float_as_int(C0[r])&m0_)|(~m0_&(int)0xff800000)); C1[r]=__int_as_float((__float_as_int(C1[r])&m1_)|(~m1_&(int)0xff800000)); } }while(0)
  #define DMA_K(t,slot) glds16s(Kh+(long)(t)*KVBLK*DMI,koff,(unsigned)__builtin_amdgcn_readfirstlane(kdst+(slot)))
  #define DMA_V(t,slot) glds16s(Vh+(long)(t)*KVBLK*DMI,voffv,(unsigned)__builtin_amdgcn_readfirstlane(vdst+(slot)))
  const int vb0=(int)(lds0+LDS_V)+((lane>>4)&1)*32+(lane&3)*8+(4*hi+((lane&15)>>2))*64;
  const char*Kbase=shm+LDS_K; bf16x8 kf[8];
  const lds_cptr shm3=(lds_cptr)shm; const lds_cptr mp0=shm3+LDS_M+wid*2048+r32*8;
  #define MLD(off) (*(const __attribute__((address_space(3))) u64*)(mp0+(off)))
  const lds_cptr kp0=shm3+LDS_K+hi*1024+r32*16; const lds_cptr vp0=shm3+LDS_V+((lane>>4)&1)*32+(lane&3)*8+(4*hi+((lane&15)>>2))*64;
  const int NT=(q0+QB)/KVBLK;
  glds16s(mbase,moff0+((jm==0)?(unsigned)SEQ*8u:(jm==1)?(unsigned)SEQ*16u:0u),(unsigned)__builtin_amdgcn_readfirstlane(mdst));
  DMA_K(0,0);DMA_V(0,0);DMA_K(1,SLOTB);
  bf16x8 qr[4];
  #pragma unroll
  for(int d0=0;d0<4;++d0)qr[d0]=*reinterpret_cast<const bf16x8*>(&Qw[(long)r32*DMI+d0*16+hi*8]);
  float mhat=0.f,l_reg=0.f;f32x16 o[2];o[0]=f32x16{};o[1]=f32x16{};const f32x16 Z16=f32x16{};
  bool resc=false;
  #define START(P0,P1,MW) do{ const float rm=NM?0.f:rowmax(P0,P1); resc=false; \
    if(!NM&&__builtin_expect(__any(rm>(float)THRL),0)){ const float dl=__builtin_fmaxf(rm,0.f); mhat+=dl; \
      _Pragma("unroll") for(int r=0;r<16;++r){P0[r]-=dl;P1[r]-=dl;} } \
    MAPPLY(P0,P1,MW); \
    _Pragma("unroll") for(int r=0;r<16;++r)P0[r]=__builtin_amdgcn_exp2f(P0[r]); }while(0)
  #define RESC() do{ if(resc){ asm volatile("s_waitcnt lgkmcnt(0)":::"memory"); \
      _Pragma("unroll") for(int d_=0;d_<2;++d_) _Pragma("unroll") for(int r=0;r<16;++r)o[d_][r]*=wsf[crow(r,hi)]; } }while(0)
  f32x16 pA0,pA1,pB0,pB1;
  int sl_prev=0,sl_cur=0,sl_next=SLOTB;
  #define ROT() do{sl_prev=sl_cur;sl_cur=sl_next;sl_next=(sl_next==(NSLOT-1)*SLOTB)?0:sl_next+SLOTB;}while(0)
  DMA_K(2,2*SLOTB);
  WAIT_BAR(3);
  const u64 mw0=MLD(512);
  qkt(pA0,pA1,Kbase,qr,r32,hi);asm volatile("s_nop 15\n\ts_nop 7":"+v"(pA0),"+v"(pA1));
  START(pA0,pA1,mw0);
  _Pragma("unroll") for(int r=0;r<16;++r)pA1[r]=__builtin_amdgcn_exp2f(pA1[r]);
  WAIT_BAR(0);
  DMA_K(3,0);DMA_V(1,SLOTB);
  ROT();
  kload8(kf,kp0+sl_cur);
  WAIT_BAR(2);
  s16x4 vlo[8],vhi[8]; u32x4 pw0,pw1,pw2,pw3;
  #define PKW(P,B) cvtpk_s(P[B],P[B+1])
  #define PAF(k) __builtin_bit_cast(bf16x8,pw##k)
  #define VFR(i) (bf16x8){vlo[i][0],vlo[i][1],vlo[i][2],vlo[i][3],vhi[i][0],vhi[i][1],vhi[i][2],vhi[i][3]}
  #define PIN(x) asm volatile("":"+v"(x))
  #define MX3(a,b,c) __builtin_fmaxf(__builtin_fmaxf((a),(b)),(c))
  #define GAPA(MF,A0,A1,A2,A3,W0,W1,PW) do{ MF; sacc+=A0; sacc+=A1; sacc+=A2; sacc+=A3; PIN(sacc); W0; W1; PIN(PW); SBAR(); }while(0)
  #define EX(v) __builtin_amdgcn_exp2f(v)
  #define GAPB(MF,X,B) do{ MF; X[B]=EX(X[B]); X[B+1]=EX(X[B+1]); X[B+2]=EX(X[B+2]); X[B+3]=EX(X[B+3]); PIN(X); SBAR(); }while(0)
  #define VRD(i) do{ vlo[i]=vtr(vp_+(((i)>>2)*4096+((i)&3)*1024)); vhi[i]=vtr(vp_+(((i)>>2)*4096+((i)&3)*1024+512)); }while(0)
  #define KRD(G,j) do{ if(G){ kload2(kf,kp0+sl_next,j); SBAR(); } }while(0)
  #define STEP(C0,C1,P0,P1,t,GK,GV,GL,GM,MOFF) do{ SBAR(); \
    const lds_cptr vp_=vp0+sl_prev; \
    VRD(0); SBAR(); float sacc=(P0[0]+P0[1]); \
    GAPA(C0=__builtin_amdgcn_mfma_f32_32x32x16_bf16(kf[0],qr[0],Z16,0,0,0), P0[2],P0[3],P0[4],P0[5],     pw0[0]=PKW(P0,0), pw0[1]=PKW(P0,2), pw0); \
    VRD(4); SBAR(); GAPA(C1=__builtin_amdgcn_mfma_f32_32x32x16_bf16(kf[1],qr[0],Z16,0,0,0), P0[6],P0[7],P0[8],P0[9],     pw0[2]=PKW(P0,4), pw0[3]=PKW(P0,6), pw0); \
    VRD(1); SBAR(); GAPA(C0=__builtin_amdgcn_mfma_f32_32x32x16_bf16(kf[2],qr[1],C0,0,0,0),   P0[10],P0[11],P0[12],P0[13], pw1[0]=PKW(P0,8), pw1[1]=PKW(P0,10), pw1); \
    VRD(5); SBAR(); GAPA(C1=__builtin_amdgcn_mfma_f32_32x32x16_bf16(kf[3],qr[1],C1,0,0,0),   P0[14],P0[15],P1[0],P1[1],   pw1[2]=PKW(P0,12),pw1[3]=PKW(P0,14), pw1); \
    VRD(2); SBAR(); GAPA(C0=__builtin_amdgcn_mfma_f32_32x32x16_bf16(kf[4],qr[2],C0,0,0,0),   P1[2],P1[3],P1[4],P1[5],     pw2[0]=PKW(P1,0), pw2[1]=PKW(P1,2), pw2); \
    VRD(6); SBAR(); GAPA(C1=__builtin_amdgcn_mfma_f32_32x32x16_bf16(kf[5],qr[2],C1,0,0,0),   P1[6],P1[7],P1[8],P1[9],     pw2[2]=PKW(P1,4), pw2[3]=PKW(P1,6), pw2); \
    VRD(3); SBAR(); GAPA(C0=__builtin_amdgcn_mfma_f32_32x32x16_bf16(kf[6],qr[3],C0,0,0,0),   P1[10],P1[11],P1[12],P1[13], pw3[0]=PKW(P1,8), pw3[1]=PKW(P1,10), pw3); \
    VRD(7); SBAR(); GAPA(C1=__builtin_amdgcn_mfma_f32_32x32x16_bf16(kf[7],qr[3],C1,0,0,0),   P1[14],P1[15],0.f,0.f,       pw3[2]=PKW(P1,12),pw3[3]=PKW(P1,14), pw3); \
    l_reg+=sacc; \
    if(GK){DMA_K((t)+3,sl_cur);} if(GV){DMA_V((t)+1,sl_next);} if(GM){ const int tb_=((t)+3<NT)?(t)+3:NT-1; DMA_M2((t)+2,tb_,mslot^1024); } \
    const u64 mw_=MLD(MOFF); \
    resc=false; \
    if(!NM){ if(__builtin_expect(__any(mhat!=0.f),0)){ _Pragma("unroll") for(int r=0;r<16;++r){C0[r]-=mhat;C1[r]-=mhat;} } \
      float a=MX3(C0[0],C0[1],C1[0]),b=MX3(C0[2],C0[3],C1[1]); a=MX3(a,C1[2],C1[3]); \
      _Pragma("unroll") for(int r=4;r<16;r+=4){a=MX3(a,C0[r],C0[r+1]);b=MX3(b,C0[r+2],C0[r+3]);a=MX3(a,C1[r],C1[r+1]);b=MX3(b,C1[r+2],C1[r+3]);} \
      float rm=__builtin_fmaxf(a,b); { auto rr=__builtin_amdgcn_permlane32_swap(__float_as_uint(rm),__float_as_uint(rm),false,false); rm=__builtin_fmaxf(__uint_as_float(rr[0]),__uint_as_float(rr[1])); } \
      resc=false; \
      if(__builtin_expect(__any(rm>(float)THRL),0)){ const float dl=__builtin_fmaxf(rm,0.f); mhat+=dl; \
        _Pragma("unroll") for(int r=0;r<16;++r){C0[r]-=dl;C1[r]-=dl;} \
        const float f=__builtin_amdgcn_exp2f(-dl); l_reg*=f; if(hi==0)wsf[r32]=f; resc=true; } } \
    MAPPLY(C0,C1,mw_); \
    SBAR(); \
    GAPB(o[0]=__builtin_amdgcn_mfma_f32_32x32x16_bf16(PAF(0),VFR(0),o[0],0,0,0), C0,0); \
    GAPB(o[1]=__builtin_amdgcn_mfma_f32_32x32x16_bf16(PAF(0),VFR(4),o[1],0,0,0), C0,4); \
    KRD(GL,0); GAPB(o[0]=__builtin_amdgcn_mfma_f32_32x32x16_bf16(PAF(1),VFR(1),o[0],0,0,0), C0,8); \
    KRD(GL,1); GAPB(o[1]=__builtin_amdgcn_mfma_f32_32x32x16_bf16(PAF(1),VFR(5),o[1],0,0,0), C0,12); \
    KRD(GL,2); GAPB(o[0]=__builtin_amdgcn_mfma_f32_32x32x16_bf16(PAF(2),VFR(2),o[0],0,0,0), C1,0); \
    KRD(GL,3); GAPB(o[1]=__builtin_amdgcn_mfma_f32_32x32x16_bf16(PAF(2),VFR(6),o[1],0,0,0), C1,4); \
    GAPB(o[0]=__builtin_amdgcn_mfma_f32_32x32x16_bf16(PAF(3),VFR(3),o[0],0,0,0), C1,8); \
    GAPB(o[1]=__builtin_amdgcn_mfma_f32_32x32x16_bf16(PAF(3),VFR(7),o[1],0,0,0), C1,12); \
    }while(0)
  int t=1; int mslot=0;
  for(;t+5<NT;t+=2){
    STEP(pB0,pB1,pA0,pA1,t,true,true,true,true,mslot);          WAIT_BAR(3); RESC(); ROT();
    STEP(pA0,pA1,pB0,pB1,t+1,true,true,true,false,mslot+256);   WAIT_BAR(2); RESC(); ROT(); mslot^=1024;
  }
  #define ENDW(nf) do{ if((nf)==3){WAIT_BAR(3);} else if((nf)==2){WAIT_BAR(2);} else if((nf)==1){WAIT_BAR(1);} else {WAIT_BAR(0);} }while(0)
  for(;t+1<NT;t+=2){
    { const bool gk=(t+3<NT),gv=(t+1<NT),gm=(t+2<NT); STEP(pB0,pB1,pA0,pA1,t,gk,gv,gv,gm,mslot);   ENDW((int)gk+(int)gv+(int)gm); RESC(); ROT(); }
    { const bool gk=(t+4<NT),gv=(t+2<NT);             STEP(pA0,pA1,pB0,pB1,t+1,gk,gv,gv,false,mslot+256); ENDW((t+3<NT)?((int)gk+(int)gv):0); RESC(); ROT(); mslot^=1024; }
  }
  STEP(pB0,pB1,pA0,pA1,NT-1,false,false,false,false,mslot); RESC();
  { float sacc=pB0[0]+pB0[1]; _Pragma("unroll") for(int r=2;r<16;++r)sacc+=pB0[r]; _Pragma("unroll") for(int r=0;r<16;++r)sacc+=pB1[r]; l_reg+=sacc;
    pw0=(u32x4){PKW(pB0,0),PKW(pB0,2),PKW(pB0,4),PKW(pB0,6)};pw1=(u32x4){PKW(pB0,8),PKW(pB0,10),PKW(pB0,12),PKW(pB0,14)};pw2=(u32x4){PKW(pB1,0),PKW(pB1,2),PKW(pB1,4),PKW(pB1,6)};pw3=(u32x4){PKW(pB1,8),PKW(pB1,10),PKW(pB1,12),PKW(pB1,14)};
    SBAR(); pv(o,vb0+sl_cur,PAF(0),PAF(1),PAF(2),PAF(3)); }
  #undef PKW
  #undef PAF
  #undef VFR
  #undef PIN
  #undef MX3
  #undef GAPA
  #undef GAPB
  #undef EX
  #undef VRD
  #undef KRD
  #undef STEP
  #undef ENDW
  {auto rr=__builtin_amdgcn_permlane32_swap(__float_as_uint(l_reg),__float_as_uint(l_reg),false,false);l_reg=__uint_as_float(rr[0])+__uint_as_float(rr[1]);}
  if(hi==0)wsf[32+r32]=l_reg;asm volatile("s_waitcnt lgkmcnt(0)":::"memory");
  float rli[16];
  #pragma unroll
  for(int r=0;r<16;++r)rli[r]=__builtin_amdgcn_rcpf(wsf[32+crow(r,hi)]);
  bf16*Ow=O+(rowbase+q0+wid*QBLK)*DMO+h*D;
  { bf16*stg=(bf16*)(shm+LDS_OST)+wid*2048;
    #pragma unroll
    for(int r=0;r<16;++r){const int orow=crow(r,hi);
      #pragma unroll
      for(int d0=0;d0<2;++d0)stg[orow*64+d0*32+r32]=__float2bfloat16(o[d0][r]*rli[r]);}
    asm volatile("s_waitcnt lgkmcnt(0)":::"memory");
    #pragma unroll
    for(int i=0;i<4;++i){const int row=i*8+(lane>>3),ch=lane&7; const u32x4 v=*(const u32x4*)(stg+row*64+ch*8); ATTN_STORE16(Ow+(long)row*DMO+ch*8,v);} }
  asm volatile("s_waitcnt lgkmcnt(0)\n\ts_barrier":::"memory");
  #undef DMA_K
  #undef DMA_V
  #undef DMA_M2
  #undef MAPPLY
  #undef MLD
  #undef START
  #undef RESC
  #undef ROT
}
constexpr int ATTN_LDS_BYTES=LDS_BYTES;
template<int THRL,bool NM> __device__ __forceinline__ void attn_phase(char*lds,const bf16*Q,const bf16*K,const bf16*V,const u64*MASK,bf16*O){
  const int G=gridDim.x;
  for(int w=blockIdx.x;w<256;w+=G){ const int h=w&7,s=w>>3; attn_unit<THRL,NM>(h,s,Q,K,V,MASK,O,lds); attn_unit<THRL,NM>(h,63-s,Q,K,V,MASK,O,lds); }
}
#undef SBAR
#undef WAIT_BAR
}

__device__ __forceinline__ void phase_route_naive(const Params& p, unsigned char* lds) {
    const int tid = opaque_tid(), lane = tid & 63, wave = tid >> 6;
    const int gw = blockIdx.x * NWAVES + wave, NGW = gridDim.x * NWAVES;
    const float* H2 = (const float*)(p.ws + WS_H2); const float* WGRT = (const float*)(p.ws + WS_WGRT);
    float* RSTD = (float*)(p.ws + WS_RSTD); int* TOKOF = (int*)(p.ws + WS_TOKOF); float* GATEOF = (float*)(p.ws + WS_GATEOF); int* PAIR = (int*)(p.ws + WS_PAIR);
    unsigned* CNT = (unsigned*)(p.ws + WS_CTL) + CW_CNT;
    for (int t = gw; t < S; t += NGW) {
        const f32x4* hr = (const f32x4*)(H2 + (size_t)t * D) + lane; f32x4 v[4]; float ss = 0.f;
#pragma unroll
        for (int j = 0; j < 4; ++j) { v[j] = hr[64 * j]; ss += v[j].x * v[j].x + v[j].y * v[j].y + v[j].z * v[j].z + v[j].w * v[j].w; }
        const float rstd = rsqrtf(wave_sum(ss) * (1.f / D) + EPS);
        float mine = -INFINITY;
        for (int e = 0; e < NE; ++e) { const f32x4* wr = (const f32x4*)(WGRT + (size_t)e * D) + lane; float a = 0.f;
#pragma unroll
            for (int j = 0; j < 4; ++j) { const f32x4 w = wr[64 * j]; a = fmaf(v[j].x, w.x, a); a = fmaf(v[j].y, w.y, a); a = fmaf(v[j].z, w.z, a); a = fmaf(v[j].w, w.w, a); }
            a = wave_sum(a); if (lane == e) mine = a * rstd + p.b_router[e]; }
        float tv[4]; int te[4];
#pragma unroll
        for (int k = 0; k < 4; ++k) { float bv = mine; int bi = lane;
#pragma unroll
            for (int o = 32; o >= 1; o >>= 1) { const float ov = __shfl_xor(bv, o); const int oi = __shfl_xor(bi, o); if (ov > bv || (ov == bv && oi < bi)) { bv = ov; bi = oi; } }
            tv[k] = bv; te[k] = bi; if (lane == bi) mine = -INFINITY; }
        float g[4], gs = 0.f;
#pragma unroll
        for (int k = 0; k < 4; ++k) { g[k] = __expf(tv[k] - tv[0]); gs += g[k]; }
        if (lane == 0) RSTD[t] = rstd;
        if (lane < 4) { const int e = lane == 0 ? te[0] : lane == 1 ? te[1] : lane == 2 ? te[2] : te[3]; const float gg = (lane == 0 ? g[0] : lane == 1 ? g[1] : lane == 2 ? g[2] : g[3]) / gs;
            const unsigned slot = atomicAdd(&CNT[e], 1u); TOKOF[e * S + slot] = t; GATEOF[e * S + slot] = gg; PAIR[t * 4 + lane] = (e << 16) | (int)slot; }
    }
}

__device__ __forceinline__ void phase_route_fast(const Params& p, unsigned char* lds) {
    typedef float f32x16 __attribute__((ext_vector_type(16)));
    const int tid = opaque_tid(), lane = tid & 63, wave = tid >> 6, j = lane & 31, kk = lane >> 5, tsel = wave >> 2, kq = wave & 3;
    const float* H2 = (const float*)(p.ws + WS_H2); const float* WGR = (const float*)(p.ws + WS_WGRT) + 65536;
    float* RSTD = (float*)(p.ws + WS_RSTD); int* TOKOF = (int*)(p.ws + WS_TOKOF); float* GATEOF = (float*)(p.ws + WS_GATEOF); int* PAIR = (int*)(p.ws + WS_PAIR);
    unsigned* CNT = (unsigned*)(p.ws + WS_CTL) + CW_CNT;
    LAS float* sc = (LAS float*)((LAS unsigned char*)lds + wave * 8192);
    for (int tp = blockIdx.x; tp < S / 64; tp += gridDim.x) {
        const int t0 = (tp * 2 + tsel) * 32;
        const float* arow = H2 + (size_t)(t0 + j) * D + kq * 256 + 4 * kk; const float* bcol = WGR + (kq * 256 + 4 * kk) * NE + j;
        f32x16 acc = f32x16{}; float ss = 0.f;
#pragma unroll 8
        for (int m = 0; m < 32; ++m) { const f32x4 a = *(const f32x4*)(arow + 8 * m);
            const float b0 = bcol[(8 * m + 0) * NE], b1 = bcol[(8 * m + 1) * NE], b2 = bcol[(8 * m + 2) * NE], b3 = bcol[(8 * m + 3) * NE];
            acc = __builtin_amdgcn_mfma_f32_32x32x2f32(a.x, b0, acc, 0, 0, 0); acc = __builtin_amdgcn_mfma_f32_32x32x2f32(a.y, b1, acc, 0, 0, 0);
            acc = __builtin_amdgcn_mfma_f32_32x32x2f32(a.z, b2, acc, 0, 0, 0); acc = __builtin_amdgcn_mfma_f32_32x32x2f32(a.w, b3, acc, 0, 0, 0);
            ss += a.x * a.x + a.y * a.y + a.z * a.z + a.w * a.w; }
        ss += __shfl_xor(ss, 32);
        __syncthreads();
#pragma unroll
        for (int r = 0; r < 16; ++r) sc[((r & 3) + 8 * (r >> 2) + 4 * kk) * 33 + j] = acc[r];
        if (kk == 0) sc[32 * 33 + j] = ss;
        __syncthreads();
        if (kq == 0) {
            const LAS float* s0 = sc, *s1 = sc + 2048, *s2 = sc + 4096, *s3 = sc + 6144;
            const float sst = s0[32 * 33 + j] + s1[32 * 33 + j] + s2[32 * 33 + j] + s3[32 * 33 + j];
            const float rstd = rsqrtf(sst * (1.f / D) + EPS);
            float v[32];
#pragma unroll
            for (int e = 0; e < 32; ++e) v[e] = ((s0[j * 33 + e] + s1[j * 33 + e]) + (s2[j * 33 + e] + s3[j * 33 + e])) * rstd + p.b_router[e];
            float tv[4]; int te[4]; unsigned taken = 0u;
#pragma unroll
            for (int k = 0; k < 4; ++k) { float best = -INFINITY; int bi = 0;
#pragma unroll
                for (int e = 0; e < 32; ++e) { const bool ok = !((taken >> e) & 1u) && (v[e] > best); best = ok ? v[e] : best; bi = ok ? e : bi; }
                tv[k] = best; te[k] = bi; taken |= 1u << bi; }
            float g[4], gs = 0.f;
#pragma unroll
            for (int k = 0; k < 4; ++k) { g[k] = __expf(tv[k] - tv[0]); gs += g[k]; }
            const float gi = 1.f / gs;
            const bool act = lane < 32; int rk[4] = {0, 0, 0, 0}; unsigned mycnt = 0u;
#pragma unroll 4
            for (int e = 0; e < 32; ++e) { const bool pick = act && ((taken >> e) & 1u); const u64 m = __ballot(pick); const int below = __popcll(m & ((1ull << lane) - 1ull));
                if (lane == e) mycnt = (unsigned)__popcll(m);
#pragma unroll
                for (int k = 0; k < 4; ++k) rk[k] = (te[k] == e) ? below : rk[k]; }
            unsigned base = 0u; if (act && mycnt) base = atomicAdd(&CNT[lane], mycnt);
#pragma unroll
            for (int k = 0; k < 4; ++k) { const unsigned be = (unsigned)__shfl((int)base, te[k]); if (act) { const int slot = (int)be + rk[k]; const int t = t0 + lane;
                    TOKOF[te[k] * S + slot] = t; GATEOF[te[k] * S + slot] = g[k] * gi; PAIR[t * 4 + k] = (te[k] << 16) | slot; } }
            if (act) RSTD[t0 + lane] = rstd;
        }
    }
}

__device__ __forceinline__ int build_tiles(const Params& p, unsigned char* lds) {
    int* pst = (int*)(lds + LDS_MISC); int* tile_e = pst + 40;
    unsigned* CNT = (unsigned*)(p.ws + WS_CTL) + CW_CNT;
    __syncthreads();
    const int tid = opaque_tid();
    if (tid < 64) {
        const int e = tid & 31; const int c = (int)__hip_atomic_load(&CNT[e], __ATOMIC_RELAXED, __HIP_MEMORY_SCOPE_AGENT); const int nt = (c + 255) >> 8;
        int incl = nt;
#pragma unroll
        for (int o = 1; o < 32; o <<= 1) { const int v = __shfl_up(incl, o, 32); if (e >= o) incl += v; }
        const int excl = incl - nt;
        if (tid < 32) { pst[e] = excl; pst[328 + e] = c; if (e == 31) pst[NE] = incl; for (int i = 0; i < nt; ++i) tile_e[excl + i] = e; }
    }
    __syncthreads();
    return pst[NE];
}

__device__ __forceinline__ void phase_gather(const Params& p, unsigned char* lds) {
    const int tid = opaque_tid(), lane = tid & 63, wave = tid >> 6;
    const int gw = blockIdx.x * NWAVES + wave, NGW = gridDim.x * NWAVES;
    build_tiles(p, lds); const int* pst = (const int*)(lds + LDS_MISC);
    const bf16* XN2 = (const bf16*)(p.ws + WS_XN); bf16* XS = (bf16*)(p.ws + WS_XS); const int* PAIR = (const int*)(p.ws + WS_PAIR);
    const float* RSTD = (const float*)(p.ws + WS_RSTD); const float* GATEOF = (const float*)(p.ws + WS_GATEOF);
    float* ROWRSTD = (float*)(p.ws + WS_ROWRSTD); float* ROWGATE = (float*)(p.ws + WS_ROWGATE);
#if FUSED_GATHER
    int* ROWTOK = (int*)(p.ws + WS_ROWTOK); const int* tile_e = pst + 40; const unsigned* CNT = (const unsigned*)(p.ws + WS_CTL) + CW_CNT; (void)XN2; (void)XS; (void)lane; (void)gw; (void)NGW;
    for (int row = blockIdx.x * NTHREADS + tid; row < pst[NE] * 256; row += gridDim.x * NTHREADS) { const int e = tile_e[row >> 8]; if (row - pst[e] * 256 >= (int)CNT[e]) ROWTOK[row] = 0; }
    for (int pr = blockIdx.x * NTHREADS + tid; pr < S * 4; pr += gridDim.x * NTHREADS) { const int t = pr >> 2; const int pe = PAIR[pr]; const int e = pe >> 16, slot = pe & 0xffff; const int row = pst[e] * 256 + slot;
        ROWTOK[row] = t; ROWRSTD[row] = RSTD[t]; ROWGATE[row] = GATEOF[e * S + slot]; }
#else
    for (int pr0 = gw * 4; pr0 < S * 4; pr0 += NGW * 4) {
        int row[4]; u32x4 va[4], vb[4];
#pragma unroll
        for (int i = 0; i < 4; ++i) { const int pr = pr0 + i, t = pr >> 2; const int pe = PAIR[pr]; const int e = pe >> 16, slot = pe & 0xffff; row[i] = pst[e] * 256 + slot;
            const u32x4* src = (const u32x4*)(XN2 + (size_t)t * D); va[i] = src[lane]; vb[i] = src[lane + 64];
            if (lane == 0) { ROWRSTD[row[i]] = RSTD[t]; ROWGATE[row[i]] = GATEOF[e * S + slot]; } }
#pragma unroll
        for (int i = 0; i < 4; ++i) { u32x4* dst = (u32x4*)(XS + (size_t)row[i] * D); dst[lane] = va[i]; dst[lane + 64] = vb[i]; }
    }
#endif
}

__device__ __forceinline__ void phase_final(const Params& p, unsigned char* lds) {
    const int tid = opaque_tid(), lane = tid & 63, wave = tid >> 6;
    const int gw = blockIdx.x * NWAVES + wave, NGW = gridDim.x * NWAVES;
    build_tiles(p, lds); const int* pst = (const int*)(lds + LDS_MISC);
    const float* H2 = (const float*)(p.ws + WS_H2); const bf16* YS = (const bf16*)(p.ws + WS_YS); const int* PAIR = (const int*)(p.ws + WS_PAIR);
    for (int t = gw; t < S; t += NGW) {
        const f32x4* hr = (const f32x4*)(H2 + (size_t)t * D) + lane; f32x4 v[4];
#pragma unroll
        for (int j = 0; j < 4; ++j) v[j] = hr[64 * j];
#pragma unroll
        for (int k = 0; k < 4; ++k) { const int pe = PAIR[t * 4 + k]; const int row = pst[pe >> 16] * 256 + (pe & 0xffff); const uint2* yr = (const uint2*)(YS + (size_t)row * D) + lane;
#pragma unroll
            for (int j = 0; j < 4; ++j) { const uint2 y = yr[64 * j]; v[j].x += blo(y.x); v[j].y += bhi(y.x); v[j].z += blo(y.y); v[j].w += bhi(y.y); } }
        float ss = 0.f;
#pragma unroll
        for (int j = 0; j < 4; ++j) ss += v[j].x * v[j].x + v[j].y * v[j].y + v[j].z * v[j].z + v[j].w * v[j].w;
        const float rstd = rsqrtf(wave_sum(ss) * (1.f / D) + EPS);
        f32x4* o = (f32x4*)(p.out + (size_t)t * D) + lane;
#pragma unroll
        for (int j = 0; j < 4; ++j) { const f32x4 g = ((const f32x4*)p.norm_final_g)[lane + 64 * j]; o[64 * j] = (f32x4){v[j].x * rstd * g.x, v[j].y * rstd * g.y, v[j].z * rstd * g.z, v[j].w * rstd * g.w}; }
    }
}

#define GAS __attribute__((address_space(1)))
typedef GAS unsigned gu32;
#define XB_TMO      128
#define XB_XCNT(j)  (256  + 64 * (j))
#define XB_XSUB(j)  (1280 + 64 * (j))
#define XB_XGEN(j)  (2304 + 64 * (j))
#define XB_TOP      3328
#define XB_TOPGEN   3392
#define XCD_BAR_WORDS 3456
#define XB_SPIN_CAP (1u << 18)

__device__ __forceinline__ unsigned xb_ld(unsigned* p)              { return __hip_atomic_load(p, __ATOMIC_RELAXED, __HIP_MEMORY_SCOPE_AGENT); }
__device__ __forceinline__ unsigned xb_add(unsigned* p, unsigned v) { return __hip_atomic_fetch_add(p, v, __ATOMIC_RELAXED, __HIP_MEMORY_SCOPE_AGENT); }
__device__ __forceinline__ unsigned xb_xcc_id() { return (unsigned)__builtin_amdgcn_s_getreg((3 << 11) | 20) & 0xFu; }
#define XB_SPIN(cond, bar) do { unsigned _sp = 0; while (cond) { __builtin_amdgcn_s_sleep(1); \
    if ((++_sp & 255u) == 0u) { if (xb_ld(&(bar)[XB_TMO])) break; if (_sp > XB_SPIN_CAP) { atomicAdd(&(bar)[XB_TMO], 1u); break; } } } } while (0)

struct XcdBarrier {
    unsigned* bar; unsigned x;
    volatile LAS unsigned* st;
};

__device__ __forceinline__ XcdBarrier xcd_barrier_post(unsigned* bar, volatile LAS unsigned* st) {
    XcdBarrier b; b.bar = bar; b.x = xb_xcc_id(); b.st = st;
    if (threadIdx.x == 0) (void)xb_add(&bar[XB_XCNT(b.x)], 1u);
    return b;
}
__device__ __forceinline__ void xcd_barrier_complete(unsigned* bar, unsigned x, unsigned& nloc, unsigned& nx) {
    const unsigned G = gridDim.x * gridDim.y * gridDim.z;
    unsigned sum, cnt, mine, sp = 0u;
    for (;;) {
        sum = 0u; cnt = 0u; mine = 0u;
#pragma unroll
        for (unsigned j = 0; j < 16; ++j) { const unsigned c = xb_ld(&bar[XB_XCNT(j)]); sum += c; cnt += (c > 0u) ? 1u : 0u; mine = (j == x) ? c : mine; }
        if (sum == G) break;
        __builtin_amdgcn_s_sleep(1);
        if ((++sp & 255u) == 0u) { if (xb_ld(&bar[XB_TMO])) break; if (sp > XB_SPIN_CAP) { atomicAdd(&bar[XB_TMO], 1u); break; } }
    }
    nloc = mine > 0u ? mine : 1u; nx = cnt > 0u ? cnt : 1u;
}

__device__ __forceinline__ void xcd_barrier(const XcdBarrier& b) {
    asm volatile("s_waitcnt vmcnt(0)" ::: "memory");
    __syncthreads();
    if (threadIdx.x == 0) {
        unsigned* bar = b.bar;
        __builtin_amdgcn_s_waitcnt(0);
        unsigned nloc = b.st[0], nx = b.st[1];
        if (nloc == 0u) { xcd_barrier_complete(bar, b.x, nloc, nx); b.st[0] = nloc; b.st[1] = nx; }
        const unsigned old = xb_add(&bar[XB_XSUB(b.x)], 1u);
        const unsigned gen = old / nloc;
        if (old + 1u == (gen + 1u) * nloc) {
            __builtin_amdgcn_fence(__ATOMIC_RELEASE, "agent");
            asm volatile("s_waitcnt vmcnt(0)" ::: "memory");
            const unsigned og = xb_add(&bar[XB_TOP], 1u);
            const unsigned tg = og / nx;
            if (og + 1u == (tg + 1u) * nx) xb_add(&bar[XB_TOPGEN], 1u);
            else XB_SPIN(xb_ld(&bar[XB_TOPGEN]) == tg, bar);
            __builtin_amdgcn_fence(__ATOMIC_ACQUIRE, "agent");
            xb_add(&bar[XB_XGEN(b.x)], 1u);
            asm volatile("s_waitcnt vmcnt(0)" ::: "memory");
        } else {
            XB_SPIN(xb_ld(&bar[XB_XGEN(b.x)]) == gen, bar);
            __builtin_amdgcn_fence(__ATOMIC_ACQUIRE, "agent");
            asm volatile("s_waitcnt vmcnt(0)" ::: "memory");
        }
    }
    __syncthreads();
}

#ifndef FAST_GEMM
#define FAST_GEMM 1
#endif
#ifndef FAST_ATT
#define FAST_ATT 1
#endif
#ifndef FAST_IDX
#define FAST_IDX 1
#endif
#ifndef FAST_EW
#define FAST_EW 1
#endif
#ifndef FAST_ROUTE
#define FAST_ROUTE 1
#endif
template <class F, class Sched>
__device__ __forceinline__ void run_gemm_gather(unsigned char* lds, const bf16* A, const bf16* Bt, int K, const Sched& S, const F& f) {
    pg8::Gemm g{A, Bt, 0, 0, K}; EpiAdapt<F> E{f};
    pg8::gemm_phase<EpiAdapt<F>, Sched, true, true, true>((LAS unsigned char*)lds, g, S, E);
    __syncthreads();
}
template <class F, class Sched>
__device__ __forceinline__ void run_gemm(unsigned char* lds, const bf16* A, const bf16* Bt, int K, const Sched& S, const F& f) {
#if FAST_GEMM
    pg8::Gemm g{A, Bt, 0, 0, K}; EpiAdapt<F> E{f};
    pg8::gemm_phase<EpiAdapt<F>, Sched, true, true>((LAS unsigned char*)lds, g, S, E);
#else
    Unit u;
    for (int i = 0; S.next(i, u); ++i) ngemm_unit(lds, A + (size_t)u.pm * 256 * K, K, Bt + (size_t)S.bidx(u) * 256 * K, K, K, f, u);
#endif
    __syncthreads();
}

#ifndef PROBE_MULT
#define PROBE_MULT 8
#endif
#if PROBE_PHASE >= 0
#define STAMP(i) do { if (blockIdx.x == 0 && opaque_tid() == 0) ((volatile LAS unsigned long long*)((LAS unsigned char*)lds + LDS_PROBE))[i] = __builtin_amdgcn_s_memrealtime(); } while (0)
#else
#define STAMP(i) do { } while (0)
#endif
__global__ void __launch_bounds__(NTHREADS, 2) fwd_kernel(Params p) {
    extern __shared__ __attribute__((aligned(16))) unsigned char lds[];
    cg::grid_group grid = cg::this_grid();
    const int G = gridDim.x, bx = blockIdx.x;
    const LAS int* tile_e = (const LAS int*)((LAS unsigned char*)lds + LDS_MISC) + 40;
    volatile LAS unsigned* bst = (volatile LAS unsigned*)((LAS unsigned char*)lds + LDS_MISC + 4096);
    if (opaque_tid() < 2) bst[opaque_tid()] = 0u;
    __syncthreads();
    const XcdBarrier xbar = xcd_barrier_post((unsigned*)(p.ws + WS_CTL) + CW_BAR, bst);
#if PROBE_PHASE >= 200
    if (opaque_tid() < 16) ((volatile LAS unsigned long long*)((LAS unsigned char*)lds + LDS_PROBE + 256))[opaque_tid()] = 0ull;
#endif
    STAMP(0);
    phase_prologue(p, lds);
    if (gridDim.y == 0xffffu) grid.sync();
    xcd_barrier(xbar);
    STAMP(1);
    { pg8::StaticOrder so; so.init(S, NP, G, bx); EpiProj E{(bf16*)(p.ws + WS_PROJ)};
        run_gemm(lds, (const bf16*)(p.ws + WS_XN), (const bf16*)(p.ws + WS_WINT), D, so, E); }
    xcd_barrier(xbar);
    STAMP(2);
#if FAST_EW
    phase_ew_fast(p, lds);
#else
    phase_ew_naive(p, lds);
#endif
    xcd_barrier(xbar);
    STAMP(3);
#if FAST_IDX
    idxf::idx_phase(p, lds);
    __syncthreads();
#else
    phase_idx_naive(p, lds);
#endif
    xcd_barrier(xbar);
    STAMP(4);
#if FAST_ATT
    {
        const int tid = opaque_tid(); const int hq = bx & 7, sq = (bx >> 3) & 31; const int row = ((tid < 256) ? sq : 63 - sq) * 256 + (tid & 255);
        const bf16* qp = (const bf16*)(p.ws + WS_PROJ) + (size_t)row * NP + C_Q + hq * 64; float q1 = 0.f;
#pragma unroll
        for (int j = 0; j < 8; ++j) { const u32x4 v = *(const u32x4*)(qp + j * 8); q1 += fabsf(blo(v.x)) + fabsf(bhi(v.x)) + fabsf(blo(v.y)) + fabsf(bhi(v.y)) + fabsf(blo(v.z)) + fabsf(bhi(v.z)) + fabsf(blo(v.w)) + fabsf(bhi(v.w)); }
        q1 = wave_max(q1); LAS float* qb = (LAS float*)((LAS unsigned char*)lds + LDS_MISC + 4224); if ((tid & 63) == 0) qb[tid >> 6] = q1;
        __syncthreads();
        float qm = qb[0];
#pragma unroll
        for (int w = 1; w < 8; ++w) qm = fmaxf(qm, qb[w]);
        const float kmaxel = *(const float*)((const unsigned*)(p.ws + WS_CTL) + CW_KMAX); const bool nomax = (G == 256) && (qm * kmaxel <= 96.f);
        const attn_body::bf16* PJ = (const attn_body::bf16*)(p.ws + WS_PROJ); const u64* MK = (const u64*)(p.ws + WS_MASK); attn_body::bf16* MO = (attn_body::bf16*)(p.ws + WS_MIX) + 512;
        if (nomax) attn_body::attn_phase<96, true>((char*)lds, PJ + C_Q, PJ + C_K, PJ + C_V, MK, MO);
        else attn_body::attn_phase<96, false>((char*)lds, PJ + C_Q, PJ + C_K, PJ + C_V, MK, MO); }
    __syncthreads();
#else
    phase_att_naive(p, lds);
#endif
    xcd_barrier(xbar);
    STAMP(5);
    { pg8::StaticOrder so; so.init(S, D, G, bx); EpiOut E{p.x, p.norm_ffn_g, (float*)(p.ws + WS_H2), (bf16*)(p.ws + WS_XN)};
        run_gemm(lds, (const bf16*)(p.ws + WS_MIX), (const bf16*)(p.ws + WS_WOUTT), D, so, E); }
    xcd_barrier(xbar);
    STAMP(6);
#if FAST_ROUTE
    phase_route_fast(p, lds);
#else
    phase_route_naive(p, lds);
#endif
    xcd_barrier(xbar);
    STAMP(7);
    { const int ntile = build_tiles(p, lds); const LAS int* pst = (const LAS int*)((LAS unsigned char*)lds + LDS_MISC);
        MoeOrder mo; mo.so.init(ntile * 256, 2048, G, bx); mo.tile_e = tile_e; mo.ncol = 8; mo.ltok = (const LAS int*)((LAS unsigned char*)lds + LDS_LTOK);
        EpiGU E{p.b_gu, (const LAS float*)((LAS unsigned char*)lds + LDS_LRS), (bf16*)(p.ws + WS_HDN), tile_e};
        { const int* TOKOF = (const int*)(p.ws + WS_TOKOF); const float* RSTD = (const float*)(p.ws + WS_RSTD); LAS int* lt = (LAS int*)((LAS unsigned char*)lds + LDS_LTOK); LAS float* lr = (LAS float*)((LAS unsigned char*)lds + LDS_LRS);
            const int tid = opaque_tid(); Unit uu[9]; bool uv[9]; int tok[9]; float rs[9]; bool val[9];
#pragma unroll
            for (int i = 0; i < 9; ++i) { uv[i] = mo.next(i, uu[i]); val[i] = false; tok[i] = 0;
                if (uv[i] && tid < 256) { const int e = tile_e[uu[i].pm], slot = (uu[i].pm - pst[e]) * 256 + tid; val[i] = slot < pst[328 + e]; if (val[i]) tok[i] = TOKOF[e * S + slot]; } }
#pragma unroll
            for (int i = 0; i < 9; ++i) rs[i] = val[i] ? RSTD[tok[i]] : 0.f;
#pragma unroll
            for (int i = 0; i < 9; ++i) if (uv[i] && tid < 256) { lt[i * 256 + tid] = tok[i]; lr[i * 256 + tid] = rs[i]; }
            __syncthreads(); }
        run_gemm_gather(lds, (const bf16*)(p.ws + WS_XN), (const bf16*)(p.ws + WS_WGUT), D, mo, E);
    }
    xcd_barrier(xbar);
    STAMP(8);
    { const int ntile = build_tiles(p, lds);
        MoeOrder mo; mo.so.init(ntile * 256, D, G, bx); mo.tile_e = tile_e; mo.ncol = 4; mo.ltok = nullptr; const LAS int* pst = (const LAS int*)((LAS unsigned char*)lds + LDS_MISC);
        EpiDown E{p.b_down, (const LAS float*)((LAS unsigned char*)lds + LDS_LRS), (bf16*)(p.ws + WS_YS), tile_e};
        { const float* GATEOF = (const float*)(p.ws + WS_GATEOF); LAS float* lg = (LAS float*)((LAS unsigned char*)lds + LDS_LRS); const int tid = opaque_tid(); Unit uu[9]; bool uv[9]; float gv[9];
#pragma unroll
            for (int i = 0; i < 9; ++i) { uv[i] = mo.next(i, uu[i]); gv[i] = 0.f;
                if (uv[i] && tid < 256) { const int e = tile_e[uu[i].pm], slot = (uu[i].pm - pst[e]) * 256 + tid; if (slot < pst[328 + e]) gv[i] = GATEOF[e * S + slot]; } }
#pragma unroll
            for (int i = 0; i < 9; ++i) if (uv[i] && tid < 256) lg[i * 256 + tid] = gv[i];
            __syncthreads(); }
        run_gemm(lds, (const bf16*)(p.ws + WS_HDN), (const bf16*)(p.ws + WS_WDT), DE, mo, E); }
    xcd_barrier(xbar);
    STAMP(9);
    phase_final(p, lds);
#if PROBE_PHASE >= 0
    STAMP(10);
    if (blockIdx.x == 0 && opaque_tid() == 0) { volatile LAS unsigned long long* st = (volatile LAS unsigned long long*)((LAS unsigned char*)lds + LDS_PROBE);
#if PROBE_PHASE >= 200
        const unsigned long long dt = ((volatile LAS unsigned long long*)((LAS unsigned char*)lds + LDS_PROBE + 256))[PROBE_PHASE - 200], t0 = __builtin_amdgcn_s_memrealtime();
#elif PROBE_PHASE == 100 || PROBE_PHASE == 101
        const unsigned long long dt = 125ull * (unsigned long long)__hip_atomic_load((unsigned*)(p.ws + WS_CTL) + 2048, __ATOMIC_RELAXED, __HIP_MEMORY_SCOPE_AGENT), t0 = __builtin_amdgcn_s_memrealtime();
#else
        const unsigned long long dt = st[PROBE_PHASE + 1] - st[PROBE_PHASE], t0 = __builtin_amdgcn_s_memrealtime();
#endif
        while (__builtin_amdgcn_s_memrealtime() - t0 < (unsigned long long)PROBE_MULT * dt) __builtin_amdgcn_s_sleep(8); }
#endif
}

extern "C" void kernel_launch(void* const* d_in, const int* in_sizes, int n_in, void* d_out, int out_size, void* d_ws, size_t ws_size, hipStream_t stream) {
    static int grid = 0;
    if (grid == 0) {
        if (n_in != 19 || out_size != S * D || ws_size < WS_END) { fprintf(stderr, "kernel_launch: unexpected shapes (n_in %d out %d ws %zu)\n", n_in, out_size, ws_size); grid = -1; return; }
        int dev = 0, cus = 0, per_cu = 0;
        (void)hipGetDevice(&dev); (void)hipDeviceGetAttribute(&cus, hipDeviceAttributeMultiprocessorCount, dev);
        if (hipFuncSetAttribute((const void*)fwd_kernel, hipFuncAttributeMaxDynamicSharedMemorySize, LDS_BYTES) != hipSuccess) { fprintf(stderr, "kernel_launch: hipFuncSetAttribute failed\n"); grid = -1; return; }
        if (hipOccupancyMaxActiveBlocksPerMultiprocessor(&per_cu, (const void*)fwd_kernel, NTHREADS, LDS_BYTES) != hipSuccess || per_cu < 1) { fprintf(stderr, "kernel_launch: occupancy query says %d\n", per_cu); per_cu = 1; }
        (void)hipGetLastError();
        grid = cus * 1;
    }
    if (grid < 0) return;
    (void)hipMemsetAsync((char*)d_ws + WS_CTL, 0, CTL_BYTES, stream);
    Params p{};
    p.x = (const float*)d_in[0]; p.pos = (const int*)d_in[1]; p.norm_mix_g = (const float*)d_in[2]; p.w_in = (const float*)d_in[3]; p.idx_g = (const float*)d_in[4]; p.idx_b = (const float*)d_in[5];
    p.conv_w = (const float*)d_in[6]; p.conv_b = (const float*)d_in[7]; p.conv_ng = (const float*)d_in[8]; p.conv_nb = (const float*)d_in[9]; p.w_out = (const float*)d_in[10]; p.norm_ffn_g = (const float*)d_in[11];
    p.w_router = (const float*)d_in[12]; p.b_router = (const float*)d_in[13]; p.w_gu = (const float*)d_in[14]; p.b_gu = (const float*)d_in[15]; p.w_down = (const float*)d_in[16]; p.b_down = (const float*)d_in[17];
    p.norm_final_g = (const float*)d_in[18]; p.out = (float*)d_out; p.ws = (unsigned char*)d_ws;
    void* args[] = {&p};
    hipError_t e = hipLaunchCooperativeKernel((const void*)fwd_kernel, dim3(grid), dim3(NTHREADS), args, LDS_BYTES, stream);
    if (e != hipSuccess) fprintf(stderr, "cooperative launch failed: %s (grid %d)\n", hipGetErrorString(e), grid);
}
```

```cpp
#include <hip/hip_runtime.h>
#include <hip/hip_cooperative_groups.h>
#include <cstdio>
#include <cstdint>
#include <hip/hip_bf16.h>
#include <cmath>
namespace cg = cooperative_groups;
#ifndef FUSED_GATHER
#define FUSED_GATHER 1
#endif
#ifndef PROBE_PHASE
#define PROBE_PHASE (-1)
#endif

constexpr int S = 16384, D = 1024, NIN = 3144, NP = 3328;
constexpr int CC = 512, CW = 31, NH = 8, HD = 64, NE = 32, DE = 1024;
constexpr int C_VAL = 0, C_GATE = 512, C_Q = 1024, C_K = 1536, C_V = 2048, C_QI = 2560, C_KI = 3072, C_WI = 3136;
constexpr int KSEL = 256;
constexpr float EPS = 1e-5f;
constexpr float C2 = 0.125f * 1.4426950408889634f;
constexpr int NTHREADS = 512, NWAVES = 8;
constexpr int MAXROWS = 65536 + NE * 256;
constexpr int MAXTILES = MAXROWS / 256;

constexpr size_t MiB = 1u << 20;
constexpr size_t WS_CTL = 0, CTL_BYTES = 1 * MiB;
constexpr size_t WS_WINT = 2 * MiB;
constexpr size_t WS_WOUTT = 9 * MiB;
constexpr size_t WS_WGRT = 11 * MiB;
constexpr size_t WS_COS = 12 * MiB;
constexpr size_t WS_SIN = 14 * MiB;
constexpr size_t WS_WGUT = 16 * MiB;
constexpr size_t WS_WDT = 144 * MiB;
constexpr size_t WS_XN = 208 * MiB;
constexpr size_t WS_PROJ = 240 * MiB;
constexpr size_t WS_MIX = 344 * MiB;
constexpr size_t WS_KI = 376 * MiB;
constexpr size_t WS_QL = 378 * MiB;
constexpr size_t WS_WI = 380 * MiB;
constexpr size_t WS_RSTD = 381 * MiB;
constexpr size_t WS_TOKOF = 382 * MiB;
constexpr size_t WS_GATEOF = 384 * MiB;
constexpr size_t WS_PAIR = 386 * MiB;
constexpr size_t WS_ROWRSTD = 387 * MiB;
constexpr size_t WS_ROWGATE = 388 * MiB;
constexpr size_t WS_ROWTOK = 389 * MiB;
constexpr size_t WS_MASK = 392 * MiB;
constexpr size_t WS_H2 = 424 * MiB;
constexpr size_t WS_XS = 488 * MiB;
constexpr size_t WS_HDN = 632 * MiB;
constexpr size_t WS_YS = 776 * MiB;
constexpr size_t WS_END = 920 * MiB;
constexpr int CW_CNT = 1024;
constexpr int CW_BAR = 4096;
constexpr int CW_KMAX = 2052;

constexpr int LDS_BYTES = 163840;
constexpr int LDS_LTOK = 147456;
constexpr int LDS_MISC = 131072;
constexpr int LDS_LRS = LDS_MISC + 4608;
constexpr int LDS_PROBE = LDS_MISC + 14336;

#define LAS __attribute__((address_space(3)))
typedef unsigned short bf16;
typedef unsigned long long u64;
typedef float f32x4 __attribute__((ext_vector_type(4)));
typedef unsigned u32x4 __attribute__((ext_vector_type(4)));

__device__ __forceinline__ float bf2f(unsigned v) { return __uint_as_float(v << 16); }
__device__ __forceinline__ unsigned f2bf(float f) { unsigned u = __float_as_uint(f); return (u + 0x7fffu + ((u >> 16) & 1u)) >> 16; }
typedef float f32x2_pk __attribute__((ext_vector_type(2))); typedef __bf16 bf16x2_pk __attribute__((ext_vector_type(2)));
__device__ __forceinline__ unsigned pk2(float lo, float hi) { const f32x2_pk v = {lo, hi}; return __builtin_bit_cast(unsigned, __builtin_convertvector(v, bf16x2_pk)); }
__device__ __forceinline__ float blo(unsigned w) { return __uint_as_float(w << 16); }
__device__ __forceinline__ float bhi(unsigned w) { return __uint_as_float(w & 0xffff0000u); }
__device__ __forceinline__ float wave_sum(float v) {
#pragma unroll
    for (int o = 1; o < 64; o <<= 1) v += __shfl_xor(v, o);
    return v;
}
__device__ __forceinline__ float wave_max(float v) {
#pragma unroll
    for (int o = 1; o < 64; o <<= 1) v = fmaxf(v, __shfl_xor(v, o));
    return v;
}
__device__ __forceinline__ int opaque_tid() { int t = threadIdx.x; asm volatile("" : "+v"(t)); return t; }
#if PROBE_PHASE >= 200
#define ISEC(k) do { __syncthreads(); if (blockIdx.x == 0 && tid == 0) { volatile LAS unsigned long long* st_ = (volatile LAS unsigned long long*)((LAS unsigned char*)lds + LDS_PROBE + 256); const unsigned long long now_ = __builtin_amdgcn_s_memrealtime(); st_[k] += now_ - st_[15]; st_[15] = now_; } } while (0)
#else
#define ISEC(k) do { } while (0)
#endif
__device__ __forceinline__ float sigmoidf_(float x) { return __builtin_amdgcn_rcpf(1.f + __expf(-x)); }

struct Params {
    const float* x; const int* pos; const float* norm_mix_g; const float* w_in; const float* idx_g; const float* idx_b;
    const float* conv_w; const float* conv_b; const float* conv_ng; const float* conv_nb; const float* w_out; const float* norm_ffn_g;
    const float* w_router; const float* b_router; const float* w_gu; const float* b_gu; const float* w_down; const float* b_down;
    const float* norm_final_g; float* out; unsigned char* ws;
};

template <bool KS = false> __device__ __forceinline__ void transpose_item(const float* W, int K, int N, bf16* WT, int dst_row0, int k0, int n0, float* scr, int lane, const float* ks = nullptr) {
    float v[32]; const int n = n0 + (lane & 31); const float* src = W + (size_t)(k0 + (lane >> 5)) * N + n;
#pragma unroll
    for (int i = 0; i < 32; ++i) v[i] = (n < N) ? src[(size_t)(2 * i) * N] : 0.f;
#pragma unroll
    for (int i = 0; i < 32; ++i) scr[(2 * i + (lane >> 5)) * 33 + (lane & 31)] = v[i];
    asm volatile("s_waitcnt lgkmcnt(0)" ::: "memory");
    const int c = lane & 7;
    f32x4 g0 = {1.f, 1.f, 1.f, 1.f}, g1 = g0; if (KS) { g0 = *(const f32x4*)(ks + k0 + 8 * c); g1 = *(const f32x4*)(ks + k0 + 8 * c + 4); }
#pragma unroll
    for (int j = 0; j < 4; ++j) { const int nn = (lane >> 3) + 8 * j; const float* s = scr + (8 * c) * 33 + nn;
        u32x4 o; o.x = pk2(s[0 * 33] * g0.x, s[1 * 33] * g0.y); o.y = pk2(s[2 * 33] * g0.z, s[3 * 33] * g0.w); o.z = pk2(s[4 * 33] * g1.x, s[5 * 33] * g1.y); o.w = pk2(s[6 * 33] * g1.z, s[7 * 33] * g1.w);
        *(u32x4*)(WT + (size_t)(dst_row0 + nn) * K + k0 + 8 * c) = o; }
    asm volatile("s_waitcnt lgkmcnt(0)" ::: "memory");
}

__device__ __forceinline__ void phase_prologue(const Params& p, unsigned char* lds) {
    const int tid = opaque_tid(), lane = tid & 63, wave = tid >> 6;
    const int gw = blockIdx.x * NWAVES + wave, NGW = gridDim.x * NWAVES;
    float* scr = (float*)(lds + wave * 16384);
    bf16* WinT = (bf16*)(p.ws + WS_WINT); bf16* WoutT = (bf16*)(p.ws + WS_WOUTT); bf16* WguT = (bf16*)(p.ws + WS_WGUT); bf16* WdT = (bf16*)(p.ws + WS_WDT);
    constexpr int I_IN = 16 * (NP / 32), I_OUT = 16 * 32, I_GU = 16 * 64, I_DN = 16 * 32;
    constexpr int NITEMS = I_IN + I_OUT + NE * I_GU + NE * I_DN;
    for (int it = gw; it < NITEMS; it += NGW) {
        int r = it;
        if (r < I_IN) { const int nb = r % (NP / 32), kb = r / (NP / 32); transpose_item(p.w_in, D, NIN, WinT, nb * 32, kb * 64, nb * 32, scr, lane); continue; }
        r -= I_IN;
        if (r < I_OUT) { const int nb = r % 32, kb = r / 32; transpose_item(p.w_out, D, D, WoutT, nb * 32, kb * 64, nb * 32, scr, lane); continue; }
        r -= I_OUT;
        if (r < NE * I_GU) { const int e = r / I_GU, q = r % I_GU, nb = q % 64, kb = q / 64; const int n0 = nb * 32;
            const int c = n0 & 1023, isu = n0 >> 10; const int drow = e * 2048 + (c >> 7) * 256 + isu * 128 + (c & 127);
            transpose_item<true>(p.w_gu + (size_t)e * D * 2048, D, 2048, WguT, drow - 0, kb * 64, n0, scr, lane, p.norm_ffn_g);
            continue; }
        r -= NE * I_GU;
        { const int e = r / I_DN, q = r % I_DN, nb = q % 32, kb = q / 32;
            transpose_item(p.w_down + (size_t)e * DE * D, DE, D, WdT, e * D + nb * 32, kb * 64, nb * 32, scr, lane); }
    }
    for (int i = blockIdx.x * NTHREADS + tid; i < NE * D; i += gridDim.x * NTHREADS) { const int e = i / D, k = i % D; ((float*)(p.ws + WS_WGRT))[i] = p.norm_ffn_g[k] * p.w_router[k * NE + e]; }
    for (int i = blockIdx.x * NTHREADS + tid; i < NE * D; i += gridDim.x * NTHREADS) { const int k = i / NE; ((float*)(p.ws + WS_WGRT))[65536 + i] = p.norm_ffn_g[k] * p.w_router[i]; }
    for (int i = blockIdx.x * NTHREADS + tid; i < S * 32; i += gridDim.x * NTHREADS) { const int t = i >> 5, j = i & 31;
        const float inv = powf(10000.f, -(float)j / 32.f); const float ang = (float)p.pos[t] * inv;
        double xr = (double)ang * 0.15915494309189535; xr -= floor(xr); const float xf = (float)xr;
        ((float*)(p.ws + WS_COS))[i] = __builtin_amdgcn_cosf(xf); ((float*)(p.ws + WS_SIN))[i] = __builtin_amdgcn_sinf(xf); }
    bf16* XN = (bf16*)(p.ws + WS_XN);
    for (int m = gw; m < S; m += NGW) {
        const f32x4* xr = (const f32x4*)(p.x + (size_t)m * D) + lane; f32x4 v[4]; float ss = 0.f;
#pragma unroll
        for (int j = 0; j < 4; ++j) { v[j] = xr[64 * j]; ss += v[j].x * v[j].x + v[j].y * v[j].y + v[j].z * v[j].z + v[j].w * v[j].w; }
        const float rstd = rsqrtf(wave_sum(ss) * (1.f / D) + EPS);
        u64* o8 = (u64*)(XN + (size_t)m * D) + lane;
#pragma unroll
        for (int j = 0; j < 4; ++j) { const f32x4 g = ((const f32x4*)p.norm_mix_g)[lane + 64 * j];
            o8[64 * j] = (u64)pk2(v[j].x * rstd * g.x, v[j].y * rstd * g.y) | ((u64)pk2(v[j].z * rstd * g.z, v[j].w * rstd * g.w) << 32); }
    }
}

namespace pg8 {
#define PG8_LAS __attribute__((address_space(3)))
typedef unsigned short bf16_t;
typedef short bf16x8 __attribute__((ext_vector_type(8)));
typedef float f32x4 __attribute__((ext_vector_type(4)));
typedef unsigned u32x4 __attribute__((ext_vector_type(4)));
constexpr int BM = 256, BK = 64, HALF = 128, HTB = HALF * BK * 2  , STAGE_BYTES = 8 * HTB, NXCD = 8, WGM = 8;

__host__ __device__ __forceinline__ int lds_byte(int r, int c) { const int st = (r >> 4) * 2 + (c >> 5), rr = r & 15, cc = c & 31, ob = rr * 64 + cc * 2; return st * 1024 + (ob ^ (((ob >> 9) & 1) << 5)); }
__host__ __device__ __forceinline__ void stage_rc(int b, int& R, int& C) { const int st = b / 1024, sb = b % 1024, swz = sb ^ (((sb >> 9) & 1) << 5); R = (st >> 1) * 16 + swz / 64; C = (st & 1) * 32 + (swz % 64) / 2; }
__host__ __device__ __forceinline__ int perm32(int rho) { const int n = rho >> 4, i = rho & 15; return 8 * (i >> 2) + 4 * n + (i & 3); }

struct Unit { int pm, pn, ui; };
struct Gemm { const bf16_t* A; const bf16_t* Bt; int M, N, K; };

struct StaticOrder {
    int nM, nN, nwg, G, c;
    __host__ __device__ void init(int M, int N, int G_, int c_) { nM = M / BM; nN = N / BM; nwg = nM * nN; G = G_; c = c_; }
    __host__ __device__ bool next(int i, Unit& u) const { const long L = (long)i * G + c; if (!map(L, u)) return false; u.ui = i; return true; }
    __host__ __device__ bool map(long L, Unit& u) const {
        if (L >= nwg) return false;
        int wgid = (int)L; { const int q = nwg / NXCD, r = nwg % NXCD, xcd = wgid % NXCD, off = wgid / NXCD; wgid = (xcd < r ? xcd * (q + 1) : r * (q + 1) + (xcd - r) * q) + off; }
        const int nig = WGM * nN, gid = wgid / nig, fm = gid * WGM, gsz = (nM - fm) < WGM ? (nM - fm) : WGM;
        u.pm = fm + ((wgid % nig) % gsz); u.pn = (wgid % nig) / gsz; u.ui = 0; return true;
    }
    __device__ __forceinline__ int bidx(const Unit& u) const { return u.pn; }
    __device__ __forceinline__ void a_ready(const Unit&) const {}
    __device__ __forceinline__ void done(const Unit&) const {}
};
template <class Epi, class Sched, bool ALIGN_EPI = false, bool SP2 = false, bool GATHER = false>
__device__ __forceinline__ void gemm_phase(PG8_LAS unsigned char* lds, const Gemm g, const Sched& S, const Epi& E) {
    static_assert(!GATHER || SP2, "GATHER is written for the SP2 loop");
    int tid_ = threadIdx.x; asm volatile("" : "+v"(tid_));
    const int tid = tid_, wid = __builtin_amdgcn_readfirstlane(tid >> 6), lane = tid & 63, wr = wid >> 2, wc = wid & 3, fr = lane & 15, fq = lane >> 4;
    const int K = g.K, nt = K / BK;
    unsigned voffA[2], voffB[2], gC[2]; int gR[2];
#pragma unroll
    for (int i = 0; i < 2; ++i) { int R, C; stage_rc(tid * 16 + i * 8192, R, C); const int Rb = Epi::PERM ? ((R & ~31) + perm32(R & 31)) : R;
        voffA[i] = (unsigned)(R * K + C) * 2u; voffB[i] = (unsigned)(Rb * K + C) * 2u; gR[i] = R; gC[i] = (unsigned)C * 2u; }
    unsigned vc[2][2] = {{0u, 0u}, {0u, 0u}}, vn[2][2] = {{0u, 0u}, {0u, 0u}};
#define PG8_GOFF(dst, uidx) do { _Pragma("unroll") for (int h_ = 0; h_ < 2; ++h_) _Pragma("unroll") for (int i_ = 0; i_ < 2; ++i_) dst[h_][i_] = (unsigned)S.rowtok((uidx), h_ * 128 + gR[i_]) * (unsigned)(K * 2) + gC[i_]; } while (0)
    const size_t kstep = (size_t)(BK * 2);
    const size_t hstep = (size_t)HALF * K * 2;
    const size_t tstep = 2 * hstep;
    const unsigned ldsw = (unsigned)wid * 1024u;
    const int aoff = lds_byte(wr * 64 + fr, fq * 8), boff = lds_byte(wc * 32 + fr, fq * 8);
#define PG8_SA(b, h) (((b) * 2 + (h)) * HTB)
#define PG8_SB(b, h) ((4 + (b) * 2 + (h)) * HTB)
#define PG8_STAGE(bufoff, gbase, voff) do { _Pragma("unroll") for (int _i = 0; _i < 2; ++_i) \
        __builtin_amdgcn_global_load_lds((const unsigned*)((const char*)(gbase) + (voff)[_i]), (PG8_LAS unsigned*)(lds + (bufoff) + ldsw + _i * 8192), 16, 0, 0); } while (0)
#define PG8_STAGE_AG(bufoff, kb, v0, v1) do { \
        __builtin_amdgcn_global_load_lds((const unsigned*)((const char*)g.A + (kb) + (v0)), (PG8_LAS unsigned*)(lds + (bufoff) + ldsw), 16, 0, 0); \
        __builtin_amdgcn_global_load_lds((const unsigned*)((const char*)g.A + (kb) + (v1)), (PG8_LAS unsigned*)(lds + (bufoff) + ldsw + 8192), 16, 0, 0); } while (0)
#define PG8_LDA(dst, b, h) do { _Pragma("unroll") for (int m = 0; m < 4; ++m) _Pragma("unroll") for (int k = 0; k < 2; ++k) dst[m][k] = *(const PG8_LAS bf16x8*)(lds + PG8_SA(b, h) + aoff + m * 2048 + k * 1024); } while (0)
#define PG8_LDB(dst, b, h) do { _Pragma("unroll") for (int n = 0; n < 2; ++n) _Pragma("unroll") for (int k = 0; k < 2; ++k) dst[n][k] = *(const PG8_LAS bf16x8*)(lds + PG8_SB(b, h) + boff + n * 2048 + k * 1024); } while (0)
#define PG8_MMA(ai, bj, At, Bt) do { __builtin_amdgcn_s_setprio(1); _Pragma("unroll") for (int m = 0; m < 4; ++m) _Pragma("unroll") for (int n = 0; n < 2; ++n) _Pragma("unroll") for (int k = 0; k < 2; ++k) \
        acc[ai][bj][m][n] = __builtin_amdgcn_mfma_f32_16x16x32_bf16(Bt[n][k], At[m][k], acc[ai][bj][m][n], 0, 0, 0); __builtin_amdgcn_s_setprio(0); } while (0)
#define PG8_WAIT_V(n) asm volatile("s_waitcnt vmcnt(" #n ")" ::: "memory")
#define PG8_WAIT_L(n) asm volatile("s_waitcnt lgkmcnt(" #n ")" ::: "memory")
#define PG8_BAR __builtin_amdgcn_s_barrier()
#define PG8_SCHED __builtin_amdgcn_sched_barrier(0)
    Unit cur, nxt; int ui = 0;
    if (!S.next(0, cur)) return;
    f32x4 acc[2][2][4][2];
#pragma unroll
    for (int a = 0; a < 2; ++a)
#pragma unroll
        for (int b = 0; b < 2; ++b)
#pragma unroll
            for (int m = 0; m < 4; ++m)
#pragma unroll
                for (int n = 0; n < 2; ++n) acc[a][b][m][n] = (f32x4){0.f, 0.f, 0.f, 0.f};
    bf16x8 At[4][2], B0[2][2], B1[2][2];
    const char* cA = (const char*)g.A + (size_t)cur.pm * tstep; const char* cB = (const char*)g.Bt + (size_t)S.bidx(cur) * tstep;
    S.a_ready(cur);
    if constexpr (SP2) {
        if constexpr (GATHER) { PG8_GOFF(vc, 0); }
        PG8_STAGE(PG8_SB(0, 0), cB, voffB); PG8_STAGE(PG8_SB(0, 1), cB + hstep, voffB);
        if constexpr (GATHER) { PG8_STAGE_AG(PG8_SA(0, 0), (size_t)0, vc[0][0], vc[0][1]); PG8_STAGE_AG(PG8_SA(0, 1), (size_t)0, vc[1][0], vc[1][1]); } else { PG8_STAGE(PG8_SA(0, 0), cA, voffA); PG8_STAGE(PG8_SA(0, 1), cA + hstep, voffA); }
        if (wr == 1) PG8_BAR;
        PG8_WAIT_V(2); PG8_BAR;
        PG8_STAGE(PG8_SB(1, 0), cB + kstep, voffB); if constexpr (GATHER) { PG8_STAGE_AG(PG8_SA(1, 0), kstep, vc[0][0], vc[0][1]); } else { PG8_STAGE(PG8_SA(1, 0), cA + kstep, voffA); } PG8_STAGE(PG8_SB(1, 1), cB + hstep + kstep, voffB);
        PG8_WAIT_V(6); PG8_BAR;
    } else {
        PG8_STAGE(PG8_SB(0, 0), cB, voffB); PG8_STAGE(PG8_SA(0, 0), cA, voffA); PG8_STAGE(PG8_SB(0, 1), cB + hstep, voffB); PG8_STAGE(PG8_SA(0, 1), cA + hstep, voffA);
        if (wr == 1) PG8_BAR;
        PG8_WAIT_V(4); PG8_BAR;
        PG8_STAGE(PG8_SB(1, 0), cB + kstep, voffB); PG8_STAGE(PG8_SA(1, 0), cA + kstep, voffA); PG8_STAGE(PG8_SB(1, 1), cB + hstep + kstep, voffB);
        PG8_WAIT_V(6); PG8_BAR;
    }
    for (;;) {
        const bool has_next = S.next(ui + 1, nxt);
        if constexpr (GATHER) { if (has_next) { PG8_GOFF(vn, ui + 1); } }
        const char* nA = has_next ? (const char*)g.A + (size_t)nxt.pm * tstep : cA; const char* nB = has_next ? (const char*)g.Bt + (size_t)S.bidx(nxt) * tstep : cB;
        for (int t = 0; t < nt; t += 2) {
            const bool last = (t == nt - 2);
            const char* a1 = cA + (size_t)(t + 1) * kstep;
            const char* a2 = last ? nA : cA + (size_t)(t + 2) * kstep; const char* b2 = last ? nB : cB + (size_t)(t + 2) * kstep;
            const char* a3 = a2 + kstep; const char* b3 = b2 + kstep;
            if (last && has_next) S.a_ready(nxt);
            const bool un_ = last && has_next; const size_t k1_ = (size_t)(t + 1) * kstep, k2_ = last ? (size_t)0 : (size_t)(t + 2) * kstep, k3_ = k2_ + kstep;
            const unsigned w00 = un_ ? vn[0][0] : vc[0][0], w01 = un_ ? vn[0][1] : vc[0][1], w10 = un_ ? vn[1][0] : vc[1][0], w11 = un_ ? vn[1][1] : vc[1][1];
            if constexpr (SP2) {
            PG8_LDB(B0, 0, 0); PG8_LDB(B1, 0, 1); PG8_SCHED; PG8_LDA(At, 0, 0); if constexpr (GATHER) { PG8_STAGE_AG(PG8_SA(1, 1), k1_, vc[1][0], vc[1][1]); } else { PG8_STAGE(PG8_SA(1, 1), a1 + hstep, voffA); }
            PG8_WAIT_V(8); PG8_WAIT_L(0); PG8_BAR; PG8_MMA(0, 0, At, B0); PG8_MMA(0, 1, At, B1); PG8_BAR; PG8_SCHED;
            PG8_LDA(At, 0, 1); PG8_STAGE(PG8_SB(0, 0), b2, voffB); PG8_STAGE(PG8_SB(0, 1), b2 + hstep, voffB); if constexpr (GATHER) { PG8_STAGE_AG(PG8_SA(0, 0), k2_, w00, w01); } else { PG8_STAGE(PG8_SA(0, 0), a2, voffA); }
            PG8_WAIT_V(8); PG8_WAIT_L(0); PG8_BAR; PG8_MMA(1, 0, At, B0); PG8_MMA(1, 1, At, B1); PG8_BAR; PG8_SCHED;
            PG8_LDB(B0, 1, 0); PG8_LDB(B1, 1, 1); PG8_SCHED; PG8_LDA(At, 1, 0); if constexpr (GATHER) { PG8_STAGE_AG(PG8_SA(0, 1), k2_, w10, w11); } else { PG8_STAGE(PG8_SA(0, 1), a2 + hstep, voffA); }
            PG8_WAIT_V(8); PG8_WAIT_L(0); PG8_BAR; PG8_MMA(0, 0, At, B0); PG8_MMA(0, 1, At, B1); PG8_BAR; PG8_SCHED;
            PG8_LDA(At, 1, 1); PG8_STAGE(PG8_SB(1, 0), b3, voffB); PG8_STAGE(PG8_SB(1, 1), b3 + hstep, voffB); if constexpr (GATHER) { PG8_STAGE_AG(PG8_SA(1, 0), k3_, w00, w01); } else { PG8_STAGE(PG8_SA(1, 0), a3, voffA); }
            PG8_WAIT_V(8); PG8_WAIT_L(0); PG8_BAR; PG8_MMA(1, 0, At, B0); PG8_MMA(1, 1, At, B1); PG8_BAR; PG8_SCHED;
            } else {
            PG8_LDB(B0, 0, 0); PG8_SCHED; PG8_LDA(At, 0, 0); PG8_STAGE(PG8_SA(1, 1), a1 + hstep, voffA);
            PG8_WAIT_L(8); PG8_BAR; PG8_WAIT_L(0); PG8_MMA(0, 0, At, B0); PG8_BAR; PG8_SCHED;
            PG8_LDB(B1, 0, 1); PG8_STAGE(PG8_SB(0, 0), b2, voffB);
            PG8_BAR; PG8_WAIT_L(0); PG8_MMA(0, 1, At, B1); PG8_BAR;
            PG8_LDA(At, 0, 1); PG8_STAGE(PG8_SA(0, 0), a2, voffA);
            PG8_BAR; PG8_WAIT_L(0); PG8_MMA(1, 0, At, B0); PG8_BAR; PG8_SCHED;
            PG8_STAGE(PG8_SB(0, 1), b2 + hstep, voffB);
            PG8_WAIT_V(6); PG8_BAR; PG8_MMA(1, 1, At, B1); PG8_BAR;
            PG8_LDB(B0, 1, 0); PG8_SCHED; PG8_LDA(At, 1, 0); PG8_STAGE(PG8_SA(0, 1), a2 + hstep, voffA);
            PG8_WAIT_L(8); PG8_BAR; PG8_WAIT_L(0); PG8_MMA(0, 0, At, B0); PG8_BAR; PG8_SCHED;
            PG8_LDB(B1, 1, 1); PG8_STAGE(PG8_SB(1, 0), b3, voffB);
            PG8_BAR; PG8_WAIT_L(0); PG8_MMA(0, 1, At, B1); PG8_BAR;
            PG8_LDA(At, 1, 1); PG8_STAGE(PG8_SA(1, 0), a3, voffA);
            PG8_BAR; PG8_WAIT_L(0); PG8_MMA(1, 0, At, B0); PG8_BAR; PG8_SCHED;
            PG8_STAGE(PG8_SB(1, 1), b3 + hstep, voffB);
            PG8_WAIT_V(6); PG8_BAR; PG8_MMA(1, 1, At, B1); PG8_BAR;
            }
        }
        if constexpr (ALIGN_EPI) { if (wr == 0) PG8_BAR; }
        if constexpr (!Epi::AFTER_DRAIN) { E(acc, cur, wr, wc, fr, fq); S.done(cur); }
        if (!has_next) break;
#pragma unroll
        for (int a = 0; a < 2; ++a)
#pragma unroll
            for (int b = 0; b < 2; ++b)
#pragma unroll
                for (int m = 0; m < 4; ++m)
#pragma unroll
                    for (int n = 0; n < 2; ++n) acc[a][b][m][n] = (f32x4){0.f, 0.f, 0.f, 0.f};
        cur = nxt; cA = nA; cB = nB; ++ui;
        if constexpr (GATHER) { vc[0][0] = vn[0][0]; vc[0][1] = vn[0][1]; vc[1][0] = vn[1][0]; vc[1][1] = vn[1][1]; }
        if constexpr (ALIGN_EPI) { if (wr == 1) PG8_BAR; }
    }
    PG8_WAIT_V(0);
    if constexpr (!ALIGN_EPI) { if (wr == 0) PG8_BAR; }
    PG8_BAR;
    if constexpr (Epi::AFTER_DRAIN) { E.fused(acc, cur, wr, wc, fr, fq, lds, wid, lane); S.done(cur); }
#undef PG8_SA
#undef PG8_SB
#undef PG8_STAGE
#undef PG8_LDA
#undef PG8_STAGE_AG
#undef PG8_GOFF
#undef PG8_LDB
#undef PG8_MMA
#undef PG8_WAIT_V
#undef PG8_WAIT_L
#undef PG8_BAR
#undef PG8_SCHED
}
}

template <class Epi>
__device__ __forceinline__ void ngemm_unit(unsigned char* lds, const bf16* A, int lda, const bf16* Bt, int ldb, int K, const Epi& epi, const pg8::Unit& u) {
    float* As = (float*)lds; float* Bs = As + 32 * 256;
    const int tid = opaque_tid(), tr = tid >> 4, tc = tid & 15;
    float acc0[8][8], acc1[8][8];
#pragma unroll
    for (int i = 0; i < 8; ++i)
#pragma unroll
        for (int j = 0; j < 8; ++j) { acc0[i][j] = 0.f; acc1[i][j] = 0.f; }
    for (int k0 = 0; k0 < K; k0 += 32) {
        __syncthreads();
#pragma unroll
        for (int j = 0; j < 2; ++j) { const int pidx = tid + 512 * j, r = pidx & 255, kq = pidx >> 8;
            const u32x4 va = *(const u32x4*)(A + (size_t)r * lda + k0 + kq * 8);
            const u32x4 vb = *(const u32x4*)(Bt + (size_t)r * ldb + k0 + kq * 8);
            float* ap = As + (kq * 8) * 256 + r; float* bp = Bs + (kq * 8) * 256 + r;
            ap[0 * 256] = blo(va.x); ap[1 * 256] = bhi(va.x); ap[2 * 256] = blo(va.y); ap[3 * 256] = bhi(va.y); ap[4 * 256] = blo(va.z); ap[5 * 256] = bhi(va.z); ap[6 * 256] = blo(va.w); ap[7 * 256] = bhi(va.w);
            bp[0 * 256] = blo(vb.x); bp[1 * 256] = bhi(vb.x); bp[2 * 256] = blo(vb.y); bp[3 * 256] = bhi(vb.y); bp[4 * 256] = blo(vb.z); bp[5 * 256] = bhi(vb.z); bp[6 * 256] = blo(vb.w); bp[7 * 256] = bhi(vb.w); }
        __syncthreads();
#pragma unroll 2
        for (int kk = 0; kk < 32; ++kk) {
            const f32x4 a0 = *(const f32x4*)(As + kk * 256 + tr * 8), a1 = *(const f32x4*)(As + kk * 256 + tr * 8 + 4);
            const f32x4 b00 = *(const f32x4*)(Bs + kk * 256 + tc * 8), b01 = *(const f32x4*)(Bs + kk * 256 + tc * 8 + 4);
            const f32x4 b10 = *(const f32x4*)(Bs + kk * 256 + 128 + tc * 8), b11 = *(const f32x4*)(Bs + kk * 256 + 128 + tc * 8 + 4);
            const float a[8] = {a0.x, a0.y, a0.z, a0.w, a1.x, a1.y, a1.z, a1.w};
            const float b0[8] = {b00.x, b00.y, b00.z, b00.w, b01.x, b01.y, b01.z, b01.w};
            const float b1[8] = {b10.x, b10.y, b10.z, b10.w, b11.x, b11.y, b11.z, b11.w};
#pragma unroll
            for (int i = 0; i < 8; ++i)
#pragma unroll
                for (int j = 0; j < 8; ++j) { acc0[i][j] = fmaf(a[i], b0[j], acc0[i][j]); acc1[i][j] = fmaf(a[i], b1[j], acc1[i][j]); }
        }
    }
    { const typename Epi::Ctx ctx = epi.prep(u, tc * 8);
#pragma unroll
    for (int i = 0; i < 8; ++i) epi(ctx, u, tr * 8 + i, tc * 8, acc0[i], acc1[i]); }
}

__device__ __forceinline__ void store8_bf16(bf16* dst, const float (&v)[8]) {
    u32x4 o; o.x = pk2(v[0], v[1]); o.y = pk2(v[2], v[3]); o.z = pk2(v[4], v[5]); o.w = pk2(v[6], v[7]); *(u32x4*)dst = o;
}

typedef pg8::Unit Unit;
struct EpiProj { bf16* O; struct Ctx {};
    __device__ __forceinline__ Ctx prep(const Unit&, int) const { return Ctx{}; }
    __device__ __forceinline__ void operator()(const Ctx&, const Unit& u, int r, int c8, const float (&v0)[8], const float (&v1)[8]) const {
        bf16* row = O + (size_t)(u.pm * 256 + r) * NP + u.pn * 256 + c8; store8_bf16(row, v0); store8_bf16(row + 128, v1); } };
struct Col16 { float a[8], b[8]; };
__device__ __forceinline__ Col16 load_col16(const float* p0, const float* p1) { const f32x4 a0 = *(const f32x4*)p0, a1 = *(const f32x4*)(p0 + 4), b0 = *(const f32x4*)p1, b1 = *(const f32x4*)(p1 + 4);
    return Col16{{a0.x, a0.y, a0.z, a0.w, a1.x, a1.y, a1.z, a1.w}, {b0.x, b0.y, b0.z, b0.w, b1.x, b1.y, b1.z, b1.w}}; }
struct EpiOut { const float* x; bf16* H2B; struct Ctx {};
    __device__ __forceinline__ Ctx prep(const Unit&, int) const { return Ctx{}; }
    __device__ __forceinline__ void operator()(const Ctx&, const Unit& u, int r, int c8, const float (&v0)[8], const float (&v1)[8]) const {
        const int col = u.pn * 256 + c8; const size_t off = (size_t)(u.pm * 256 + r) * D + col; float h0[8], h1[8];
        const Col16 xs = load_col16(x + off, x + off + 128);
#pragma unroll
        for (int i = 0; i < 8; ++i) { h0[i] = xs.a[i] + v0[i]; h1[i] = xs.b[i] + v1[i]; }
        store8_bf16(H2B + off, h0); store8_bf16(H2B + off + 128, h1); } };
struct EpiGU { const float* bgu; const LAS float* rowrstd; bf16* HDN; const LAS int* tile_e; typedef Col16 Ctx;
    __device__ __forceinline__ Ctx prep(const Unit& u, int c8) const { const float* bg = bgu + tile_e[u.pm] * 2048 + u.pn * 128 + c8; return load_col16(bg, bg + 1024); }
    __device__ __forceinline__ void operator()(const Ctx& b, const Unit& u, int r, int c8, const float (&v0)[8], const float (&v1)[8]) const {
        const int row = u.pm * 256 + r; const float rs = rowrstd[u.ui * 256 + r]; const int cb = u.pn * 128 + c8; float h[8];
#pragma unroll
        for (int i = 0; i < 8; ++i) { float g = v0[i] * rs + b.a[i]; float uu = v1[i] * rs + b.b[i];
            g = fminf(g, 7.f); uu = fminf(fmaxf(uu, -7.f), 7.f); h[i] = g * sigmoidf_(1.702f * g) * (uu + 1.f); }
        store8_bf16(HDN + (size_t)row * DE + cb, h); } };
struct EpiDown { const float* bd; const LAS float* rowgate; bf16* YS; const LAS int* tile_e; typedef Col16 Ctx;
    __device__ __forceinline__ Ctx prep(const Unit& u, int c8) const { const float* bp = bd + tile_e[u.pm] * D + u.pn * 256 + c8; return load_col16(bp, bp + 128); }
    __device__ __forceinline__ void operator()(const Ctx& b, const Unit& u, int r, int c8, const float (&v0)[8], const float (&v1)[8]) const {
        const int row = u.pm * 256 + r; const float gt = rowgate[u.ui * 256 + r]; const int cb = u.pn * 256 + c8; float y0[8], y1[8];
#pragma unroll
        for (int i = 0; i < 8; ++i) { y0[i] = (v0[i] + b.a[i]) * gt; y1[i] = (v1[i] + b.b[i]) * gt; }
        store8_bf16(YS + (size_t)row * D + cb, y0); store8_bf16(YS + (size_t)row * D + cb + 128, y1); } };

template <class F> struct EpiAdapt {
    static constexpr bool PERM = true, AFTER_DRAIN = false; F f;
    __device__ __forceinline__ void operator()(const f32x4 (&acc)[2][2][4][2], const Unit& u, int wr, int wc, int fr, int fq) const {
        const typename F::Ctx ctx = f.prep(u, wc * 32 + fq * 8);
#pragma unroll
        for (int ai = 0; ai < 2; ++ai)
#pragma unroll
            for (int m = 0; m < 4; ++m) { const int r = ai * 128 + wr * 64 + m * 16 + fr, c8 = wc * 32 + fq * 8;
                const f32x4 a = acc[ai][0][m][0], b = acc[ai][0][m][1], c = acc[ai][1][m][0], d = acc[ai][1][m][1];
                const float v0[8] = {a.x, a.y, a.z, a.w, b.x, b.y, b.z, b.w}, v1[8] = {c.x, c.y, c.z, c.w, d.x, d.y, d.z, d.w};
                f(ctx, u, r, c8, v0, v1); }
    }
};
struct MoeOrder { pg8::StaticOrder so; const LAS int* tile_e; int ncol; const LAS int* ltok;
    __device__ __forceinline__ bool next(int i, Unit& u) const { return so.next(i, u); }
    __device__ __forceinline__ int bidx(const Unit& u) const { return tile_e[u.pm] * ncol + u.pn; }
    __device__ __forceinline__ int rowtok(int ui, int r) const { return ltok[ui * 256 + r]; }
    __device__ __forceinline__ void a_ready(const Unit&) const {}
    __device__ __forceinline__ void done(const Unit&) const {} };
__device__ __forceinline__ void phase_ew_naive(const Params& p, unsigned char* lds) {
    const int tid = opaque_tid(), lane = tid & 63, wave = tid >> 6;
    bf16* PROJ = (bf16*)(p.ws + WS_PROJ); bf16* MIX = (bf16*)(p.ws + WS_MIX); bf16* KI = (bf16*)(p.ws + WS_KI); bf16* QL = (bf16*)(p.ws + WS_QL); float* WI = (float*)(p.ws + WS_WI);
    const float* COS = (const float*)(p.ws + WS_COS); const float* SIN = (const float*)(p.ws + WS_SIN);
    float* red = (float*)(lds);
    for (int t = blockIdx.x; t < S; t += gridDim.x) {
        const int c = tid; float acc = p.conv_b[c];
        for (int j = 0; j < CW; ++j) { const int tt = t - (CW - 1) + j; if (tt >= 0) { const float val = bf2f(PROJ[(size_t)tt * NP + C_VAL + c]), gate = bf2f(PROJ[(size_t)tt * NP + C_GATE + c]);
                acc = fmaf(p.conv_w[j * CC + c], val * sigmoidf_(gate), acc); } }
        const int hh = (tid & 255) >> 5, ii = tid & 31; const int qkbase = (tid < 256) ? C_Q : C_K;
        const float cs = COS[t * 32 + ii], sn = SIN[t * 32 + ii];
        const float x1 = bf2f(PROJ[(size_t)t * NP + qkbase + hh * 64 + ii]), x2 = bf2f(PROJ[(size_t)t * NP + qkbase + hh * 64 + 32 + ii]);
        float qi1 = 0.f, qi2 = 0.f; if (tid < 256) { qi1 = bf2f(PROJ[(size_t)t * NP + C_QI + hh * 64 + ii]); qi2 = bf2f(PROJ[(size_t)t * NP + C_QI + hh * 64 + 32 + ii]); }
        float kiv = 0.f, qlv = 0.f;
        if (wave == 4) kiv = bf2f(PROJ[(size_t)t * NP + C_KI + lane]);
        if (wave == 5) { for (int h = 0; h < 8; ++h) qlv = fmaf(bf2f(PROJ[(size_t)t * NP + C_WI + h]), bf2f(PROJ[(size_t)t * NP + C_QI + h * 64 + lane]), qlv); }
        float wiv = 0.f; if (wave == 6 && lane < 8) wiv = bf2f(PROJ[(size_t)t * NP + C_WI + lane]);
        float s1 = wave_sum(acc); if (lane == 0) red[wave] = s1; __syncthreads();
        float mean = 0.f;
#pragma unroll
        for (int w = 0; w < 8; ++w) mean += red[w];
        mean *= (1.f / CC); const float dv = acc - mean; float s2 = wave_sum(dv * dv); if (lane == 0) red[8 + wave] = s2; __syncthreads();
        float var = 0.f;
#pragma unroll
        for (int w = 0; w < 8; ++w) var += red[8 + w];
        var *= (1.f / CC);
        const float y = dv * rsqrtf(var + EPS) * p.conv_ng[c] + p.conv_nb[c];
        MIX[(size_t)t * D + c] = (bf16)f2bf(y * sigmoidf_(y));
        { const float sc = (tid < 256) ? C2 : 1.f; PROJ[(size_t)t * NP + qkbase + hh * 64 + ii] = (bf16)f2bf((x1 * cs - x2 * sn) * sc); PROJ[(size_t)t * NP + qkbase + hh * 64 + 32 + ii] = (bf16)f2bf((x2 * cs + x1 * sn) * sc); }
        if (tid < 256) { PROJ[(size_t)t * NP + C_QI + hh * 64 + ii] = (bf16)f2bf(qi1 * cs - qi2 * sn); PROJ[(size_t)t * NP + C_QI + hh * 64 + 32 + ii] = (bf16)f2bf(qi2 * cs + qi1 * sn); }
        if (wave == 4) { const float m = wave_sum(kiv) * (1.f / 64.f); const float d = kiv - m; const float vr = wave_sum(d * d) * (1.f / 64.f);
            const float yk = d * rsqrtf(vr + EPS) * p.idx_g[lane] + p.idx_b[lane]; const float other = __shfl_xor(yk, 32);
            const float c_ = COS[t * 32 + (lane & 31)], s_ = SIN[t * 32 + (lane & 31)];
            KI[(size_t)t * 64 + lane] = (bf16)f2bf(lane < 32 ? (yk * c_ - other * s_) : (yk * c_ + other * s_)); }
        if (wave == 5) { const float other = __shfl_xor(qlv, 32); const float c_ = COS[t * 32 + (lane & 31)], s_ = SIN[t * 32 + (lane & 31)];
            QL[(size_t)t * 64 + lane] = (bf16)f2bf(lane < 32 ? (qlv * c_ - other * s_) : (qlv * c_ + other * s_)); }
        if (wave == 6 && lane < 8) WI[t * 8 + lane] = wiv;
        __syncthreads();
    }
}

__device__ __forceinline__ void phase_ew_fast(const Params& p, unsigned char* lds) {
    const int tid = opaque_tid(), lane = tid & 63, wave = tid >> 6;
    bf16* PROJ = (bf16*)(p.ws + WS_PROJ); bf16* MIX = (bf16*)(p.ws + WS_MIX); bf16* KI = (bf16*)(p.ws + WS_KI); bf16* QL = (bf16*)(p.ws + WS_QL); float* WI = (float*)(p.ws + WS_WI);
    const float* COS = (const float*)(p.ws + WS_COS); const float* SIN = (const float*)(p.ws + WS_SIN);
    LAS unsigned char* L = (LAS unsigned char*)lds;
    LAS unsigned* U = (LAS unsigned*)L;
    LAS float* RED = (LAS float*)(L + 65536);
    const int cp = tid & 255, g = tid >> 8, wv_ = wave & 3;
    typedef float f32x2 __attribute__((ext_vector_type(2))); f32x2 wv[CW];
#pragma unroll
    for (int j = 0; j < CW; ++j) { const float2 ww = *(const float2*)(p.conv_w + j * CC + 2 * cp); wv[j] = (f32x2){ww.x, ww.y}; }
    const float2 cb = *(const float2*)(p.conv_b + 2 * cp), ng = *(const float2*)(p.conv_ng + 2 * cp), nb = *(const float2*)(p.conv_nb + 2 * cp);
    float kmx = 0.f;
    for (int unit = blockIdx.x; unit < S / 32; unit += gridDim.x) {
        const int t0 = unit * 32;
        __syncthreads();
        ISEC(6);
#pragma unroll 2
        for (int it = tid; it < 62 * 64; it += NTHREADS) { const int row = it >> 6, c8 = (it & 63) * 8, tt = t0 - 30 + row; u32x4 o = (u32x4){0u, 0u, 0u, 0u};
            if (tt >= 0) { const u32x4 va = *(const u32x4*)(PROJ + (size_t)tt * NP + C_VAL + c8), ga = *(const u32x4*)(PROJ + (size_t)tt * NP + C_GATE + c8);
                o.x = pk2(blo(va.x) * sigmoidf_(blo(ga.x)), bhi(va.x) * sigmoidf_(bhi(ga.x))); o.y = pk2(blo(va.y) * sigmoidf_(blo(ga.y)), bhi(va.y) * sigmoidf_(bhi(ga.y)));
                o.z = pk2(blo(va.z) * sigmoidf_(blo(ga.z)), bhi(va.z) * sigmoidf_(bhi(ga.z))); o.w = pk2(blo(va.w) * sigmoidf_(blo(ga.w)), bhi(va.w) * sigmoidf_(bhi(ga.w))); }
            *(LAS u32x4*)(L + (size_t)row * 1024 + c8 * 2) = o; }
        __syncthreads();
        ISEC(12);
        f32x2 acc[16];
#pragma unroll
        for (int tt = 0; tt < 16; ++tt) acc[tt] = (f32x2){cb.x, cb.y};
#pragma unroll
        for (int r = 0; r < 46; ++r) { const unsigned x = U[(g * 16 + r) * 256 + cp]; const f32x2 xv = (f32x2){blo(x), bhi(x)};
#pragma unroll
            for (int tt = 0; tt < 16; ++tt) { const int j = r - tt; if (j >= 0 && j < CW) acc[tt] = __builtin_elementwise_fma(wv[j], xv, acc[tt]); } }
#pragma unroll
        for (int tt = 0; tt < 16; ++tt) { const f32x2 a = acc[tt]; const float s1 = wave_sum(a.x + a.y), s2 = wave_sum(a.x * a.x + a.y * a.y);
            if (lane == 0) { RED[((g * 16 + tt) * 4 + wv_) * 2] = s1; RED[((g * 16 + tt) * 4 + wv_) * 2 + 1] = s2; } }
        __syncthreads();
#pragma unroll
        for (int tt = 0; tt < 16; ++tt) { const LAS f32x4* rp = (const LAS f32x4*)(RED + (g * 16 + tt) * 8); const f32x4 ra = rp[0], rb = rp[1];
            const float mean = (ra.x + ra.z + rb.x + rb.z) * (1.f / CC), var = (ra.y + ra.w + rb.y + rb.w) * (1.f / CC) - mean * mean, rstd = rsqrtf(fmaxf(var, 0.f) + EPS);
            const float y0 = (acc[tt].x - mean) * rstd * ng.x + nb.x, y1 = (acc[tt].y - mean) * rstd * ng.y + nb.y;
            *(unsigned*)(MIX + (size_t)(t0 + g * 16 + tt) * D + 2 * cp) = pk2(y0 * sigmoidf_(y0), y1 * sigmoidf_(y1)); }
        ISEC(13);
        { const int tl = (lane >> 3) & 3, dc = lane & 7, t = t0 + wave * 4 + tl; const bf16* prow = PROJ + (size_t)t * NP;
            const u32x4 kraw = *(const u32x4*)(prow + C_KI + dc * 8); const u32x4 wraw = *(const u32x4*)(prow + C_WI);
            const float wf[8] = {blo(wraw.x), bhi(wraw.x), blo(wraw.y), bhi(wraw.y), blo(wraw.z), bhi(wraw.z), blo(wraw.w), bhi(wraw.w)};
            float kv[8] = {blo(kraw.x), bhi(kraw.x), blo(kraw.y), bhi(kraw.y), blo(kraw.z), bhi(kraw.z), blo(kraw.w), bhi(kraw.w)}, qv[8] = {0.f, 0.f, 0.f, 0.f, 0.f, 0.f, 0.f, 0.f};
#pragma unroll
            for (int h = 0; h < 8; ++h) { const u32x4 q = *(const u32x4*)(prow + C_QI + h * 64 + dc * 8);
                qv[0] = fmaf(wf[h], blo(q.x), qv[0]); qv[1] = fmaf(wf[h], bhi(q.x), qv[1]); qv[2] = fmaf(wf[h], blo(q.y), qv[2]); qv[3] = fmaf(wf[h], bhi(q.y), qv[3]);
                qv[4] = fmaf(wf[h], blo(q.z), qv[4]); qv[5] = fmaf(wf[h], bhi(q.z), qv[5]); qv[6] = fmaf(wf[h], blo(q.w), qv[6]); qv[7] = fmaf(wf[h], bhi(q.w), qv[7]); }
            float s = 0.f;
#pragma unroll
            for (int i = 0; i < 8; ++i) s += kv[i];
            s += __shfl_xor(s, 1); s += __shfl_xor(s, 2); s += __shfl_xor(s, 4); const float m = s * (1.f / 64.f);
            float s2 = 0.f;
#pragma unroll
            for (int i = 0; i < 8; ++i) { kv[i] -= m; s2 += kv[i] * kv[i]; }
            s2 += __shfl_xor(s2, 1); s2 += __shfl_xor(s2, 2); s2 += __shfl_xor(s2, 4); const float rstd = rsqrtf(s2 * (1.f / 64.f) + EPS);
            const f32x4 ga = *(const f32x4*)(p.idx_g + dc * 8), gb = *(const f32x4*)(p.idx_g + dc * 8 + 4), ba = *(const f32x4*)(p.idx_b + dc * 8), bb = *(const f32x4*)(p.idx_b + dc * 8 + 4);
            const float gg[8] = {ga.x, ga.y, ga.z, ga.w, gb.x, gb.y, gb.z, gb.w}, bbv[8] = {ba.x, ba.y, ba.z, ba.w, bb.x, bb.y, bb.z, bb.w};
            const int cd = (dc & 3) * 8;
            const f32x4 c0 = *(const f32x4*)(COS + t * 32 + cd), c1 = *(const f32x4*)(COS + t * 32 + cd + 4), s0 = *(const f32x4*)(SIN + t * 32 + cd), s1 = *(const f32x4*)(SIN + t * 32 + cd + 4);
            const float cc[8] = {c0.x, c0.y, c0.z, c0.w, c1.x, c1.y, c1.z, c1.w}, ss[8] = {s0.x, s0.y, s0.z, s0.w, s1.x, s1.y, s1.z, s1.w};
            float ko[8], qo[8];
#pragma unroll
            for (int i = 0; i < 8; ++i) { const float yk = kv[i] * rstd * gg[i] + bbv[i]; const float ok = __shfl_xor(yk, 4), oq = __shfl_xor(qv[i], 4);
                ko[i] = (dc < 4) ? (yk * cc[i] - ok * ss[i]) : (yk * cc[i] + ok * ss[i]); qo[i] = (dc < 4) ? (qv[i] * cc[i] - oq * ss[i]) : (qv[i] * cc[i] + oq * ss[i]); }
            if (lane < 32) { store8_bf16(KI + (size_t)t * 64 + dc * 8, ko); store8_bf16(QL + (size_t)t * 64 + dc * 8, qo);
                if (dc == 0) { *(f32x4*)(WI + t * 8) = (f32x4){wf[0], wf[1], wf[2], wf[3]}; *(f32x4*)(WI + t * 8 + 4) = (f32x4){wf[4], wf[5], wf[6], wf[7]}; } } }
        __syncthreads();
        ISEC(14);
#pragma unroll 3
        for (int it = tid; it < 32 * 96; it += NTHREADS) { const int tl = it / 96, rem = it % 96, ten = rem >> 5, hh = (rem >> 2) & 7, ch = rem & 3; const int t = t0 + tl;
            bf16* base = PROJ + (size_t)t * NP + (ten == 0 ? C_Q : ten == 1 ? C_K : C_QI) + hh * 64 + ch * 8; const float sc = (ten == 0) ? C2 : 1.f;
            const u32x4 xa = *(const u32x4*)base, xb = *(const u32x4*)(base + 32);
            const f32x4 c0 = *(const f32x4*)(COS + t * 32 + ch * 8), c1 = *(const f32x4*)(COS + t * 32 + ch * 8 + 4), s0 = *(const f32x4*)(SIN + t * 32 + ch * 8), s1 = *(const f32x4*)(SIN + t * 32 + ch * 8 + 4);
            const float x1[8] = {blo(xa.x), bhi(xa.x), blo(xa.y), bhi(xa.y), blo(xa.z), bhi(xa.z), blo(xa.w), bhi(xa.w)}, x2[8] = {blo(xb.x), bhi(xb.x), blo(xb.y), bhi(xb.y), blo(xb.z), bhi(xb.z), blo(xb.w), bhi(xb.w)};
            const float cc[8] = {c0.x, c0.y, c0.z, c0.w, c1.x, c1.y, c1.z, c1.w}, ss[8] = {s0.x, s0.y, s0.z, s0.w, s1.x, s1.y, s1.z, s1.w};
            float o1[8], o2[8];
#pragma unroll
            for (int i = 0; i < 8; ++i) { o1[i] = (x1[i] * cc[i] - x2[i] * ss[i]) * sc; o2[i] = (x2[i] * cc[i] + x1[i] * ss[i]) * sc; }
            { float am = fmaxf(fabsf(o1[0]), fabsf(o2[0]));
#pragma unroll
                for (int i = 1; i < 8; ++i) am = fmaxf(am, fmaxf(fabsf(o1[i]), fabsf(o2[i])));
                kmx = fmaxf(kmx, (ten == 1) ? am : 0.f); }
            store8_bf16(base, o1); store8_bf16(base + 32, o2); }
        ISEC(5);
    }
    kmx = wave_max(kmx);
    __syncthreads(); if (lane == 0) RED[wave] = kmx; __syncthreads();
    if (tid == 0) { float m = RED[0];
#pragma unroll
        for (int w = 1; w < 8; ++w) m = fmaxf(m, RED[w]);
        atomicMax((unsigned*)(p.ws + WS_CTL) + CW_KMAX, __float_as_uint(m * 1.01f)); }
}

__device__ __forceinline__ unsigned fkey(float f) { unsigned u = __float_as_uint(f); if (u == 0x80000000u) u = 0u; return (u & 0x80000000u) ? ~u : (u | 0x80000000u); }
__device__ __forceinline__ void phase_idx_naive(const Params& p, unsigned char* lds) {
    const int tid = opaque_tid(), lane = tid & 63, wave = tid >> 6;
    const bf16* PROJ = (const bf16*)(p.ws + WS_PROJ); const bf16* KI = (const bf16*)(p.ws + WS_KI); const float* WI = (const float*)(p.ws + WS_WI);
    u64* MASK = (u64*)(p.ws + WS_MASK);
    float* scores = (float*)lds;
    float* qif = (float*)(lds + 65536);
    float* wf = (float*)(lds + 65536 + 2048);
    unsigned* hist = (unsigned*)(lds + 65536 + 4096);
    u64* tiebits = (u64*)(lds + 65536 + 8192);
    int* sh = (int*)(lds + 65536 + 12288);
    for (int t = blockIdx.x; t < S; t += gridDim.x) {
        const int tq = t >> 6, nadm = 64 * (tq + 1), ntw = 4 * (t >> 8) + 4;
        __syncthreads();
        if (nadm <= KSEL) {
            if (tid < ntw) MASK[(size_t)tid * S + t] = (tid <= tq) ? ~0ull : 0ull;
            continue;
        }
        qif[tid] = bf2f(PROJ[(size_t)t * NP + C_QI + tid]); if (tid < 8) wf[tid] = WI[t * 8 + tid];
        __syncthreads();
        for (int s = tid; s < nadm; s += NTHREADS) {
            float kf[64];
#pragma unroll
            for (int j = 0; j < 8; ++j) { const u32x4 v = *(const u32x4*)(KI + (size_t)s * 64 + j * 8);
                kf[j * 8 + 0] = blo(v.x); kf[j * 8 + 1] = bhi(v.x); kf[j * 8 + 2] = blo(v.y); kf[j * 8 + 3] = bhi(v.y); kf[j * 8 + 4] = blo(v.z); kf[j * 8 + 5] = bhi(v.z); kf[j * 8 + 6] = blo(v.w); kf[j * 8 + 7] = bhi(v.w); }
            float I = 0.f;
            for (int h = 0; h < 8; ++h) { float d = 0.f;
#pragma unroll
                for (int k = 0; k < 64; k += 4) { const f32x4 q4 = *(const f32x4*)(qif + h * 64 + k); d = fmaf(q4.x, kf[k], d); d = fmaf(q4.y, kf[k + 1], d); d = fmaf(q4.z, kf[k + 2], d); d = fmaf(q4.w, kf[k + 3], d); }
                I = fmaf(wf[h], fmaxf(d, 0.f), I); }
            scores[s] = I;
        }
        __syncthreads();
        unsigned prefix = 0; int kk = KSEL;
        for (int ps = 0; ps < 4; ++ps) {
            const int shift = 24 - 8 * ps;
            if (tid < 256) hist[tid] = 0u;
            __syncthreads();
            for (int s = tid; s < nadm; s += NTHREADS) { const unsigned key = fkey(scores[s]); if (ps == 0 || (key >> (shift + 8)) == prefix) atomicAdd(&hist[(key >> shift) & 255u], 1u); }
            __syncthreads();
            if (wave == 0) {
                unsigned c4[4]; unsigned tot = 0;
#pragma unroll
                for (int j = 0; j < 4; ++j) { c4[j] = hist[255 - (4 * lane + j)]; tot += c4[j]; }
                unsigned incl = tot;
#pragma unroll
                for (int o = 1; o < 64; o <<= 1) { const unsigned v = __shfl_up(incl, o); if (lane >= o) incl += v; }
                const unsigned excl = incl - tot;
                if (excl < (unsigned)kk && (unsigned)kk <= incl) { const unsigned s0 = excl + c4[0], s1 = s0 + c4[1], s2 = s1 + c4[2]; const unsigned ukk = (unsigned)kk;
                    const int j = ukk <= s0 ? 0 : ukk <= s1 ? 1 : ukk <= s2 ? 2 : 3; const unsigned cum = ukk <= s0 ? excl : ukk <= s1 ? s0 : ukk <= s2 ? s1 : s2;
                    sh[0] = 255 - (4 * lane + j); sh[1] = kk - (int)cum; }
            }
            __syncthreads();
            prefix = (prefix << 8) | (unsigned)sh[0]; kk = sh[1];
            __syncthreads();
        }
        const unsigned T = prefix;
        if (wave == 0) { int run = 0;
            for (int tile = 0; tile <= tq; ++tile) { const bool tie = fkey(scores[tile * 64 + lane]) == T; const u64 bal = __ballot(tie);
                const int rank = run + __popcll(bal & ((1ull << lane) - 1ull)); const u64 tb = __ballot(tie && rank < kk); if (lane == 0) tiebits[tile] = tb; run += __popcll(bal); } }
        __syncthreads();
        for (int tile = wave; tile < ntw; tile += NWAVES) { u64 w = 0ull;
            if (tile <= tq) { w = __ballot(fkey(scores[tile * 64 + lane]) > T) | tiebits[tile]; }
            if (lane == 0) MASK[(size_t)tile * S + t] = w; }
    }
}

namespace idxf {
typedef short bf16x8 __attribute__((ext_vector_type(8)));
typedef float f32x16 __attribute__((ext_vector_type(16)));
constexpr int L_B = 0, L_HIST = 36864, L_PK = L_HIST + 32 * 513 * 4, L_TAIL = L_PK + 2048, L_CC = L_TAIL + 2 * 32 * 64 * 4, L_CT = L_CC + 16 * 32 * 4, L_END = L_CT + 16 * 32 * 4;
constexpr int PK_P = 0, PK_KK = 32, PK_TC = 64, PK_A = 96, PK_SC = 128, PK_MN = 160, PK_MX = 192, PK_FLAG = 224, PK_LO = 256, PK_ND = 288, PK_NC = 320;
constexpr int CAND_CAP = 1024;
constexpr int R_HI = 12, R_LO = 56;
static_assert(L_END <= 131072, "idx LDS");
__device__ __forceinline__ unsigned fkey32(float f) { const unsigned u = __float_as_uint(f); return u ^ ((unsigned)((int)u >> 31) | 0x80000000u); }
__device__ __forceinline__ float fkey_inv(unsigned k) { return __uint_as_float((k & 0x80000000u) ? (k ^ 0x80000000u) : ~k); }
__device__ __forceinline__ int lbin(float I, float A, float sc) { const int b = (int)((I - A) * sc); return b < 0 ? 0 : (b > 1023 ? 1023 : b); }

template <int MODE>
__device__ __forceinline__ void sweep(const Params& p, LAS unsigned char* L, int q0, int ntk, int wave, int lane) {
    const int j = lane & 31, hi = lane >> 5;
    const bf16* KI = (const bf16*)(p.ws + WS_KI); u64* MASK = (u64*)(p.ws + WS_MASK);
    LAS unsigned* PK = (LAS unsigned*)(L + L_PK); LAS unsigned* tailk = (LAS unsigned*)(L + L_TAIL); LAS unsigned* taili = tailk + 32 * 64;
    LAS unsigned* hist = (LAS unsigned*)(L + L_HIST) + ((MODE == 5 || MODE >= 7) ? j : j * 257);
    float w[8]; { const f32x4 wa = *(const f32x4*)((const float*)(p.ws + WS_WI) + (size_t)(q0 + j) * 8), wb = *(const f32x4*)((const float*)(p.ws + WS_WI) + (size_t)(q0 + j) * 8 + 4);
        w[0] = wa.x; w[1] = wa.y; w[2] = wa.z; w[3] = wa.w; w[4] = wb.x; w[5] = wb.y; w[6] = wb.z; w[7] = wb.w; }
    const unsigned P = (MODE == 2 || MODE == 3 || MODE == 6 || MODE == 8) ? PK[PK_P + j] : 0u; const unsigned PLO = (MODE == 8) ? PK[PK_LO + j] : 0u; unsigned ndef = 0u, ccnt = 0u;
    u64* CAND = (u64*)(p.ws + WS_XS) + (size_t)(q0 + j) * CAND_CAP + (wave * 2 + hi) * 64;
    const int nloop = (MODE == 4) ? NWAVES : (MODE == 7) ? ((ntk + 7) >> 3) : ntk;
    const float lA = (MODE >= 5) ? __uint_as_float(PK[PK_A + j]) : 0.f, lS = (MODE >= 5) ? __uint_as_float(PK[PK_SC + j]) : 0.f;
    const LAS unsigned char* bfr = L + L_B + lane * 16;
    const bf16* abase = KI + hi * 8;
    unsigned kmn = 0xffffffffu, tk8[8] = {0u, 0u, 0u, 0u, 0u, 0u, 0u, 0u};
    bf16x8 a[2][4];
#define IDX_LOADA(dst, kt_) do { _Pragma("unroll") for (int hf = 0; hf < 2; ++hf) { const int row = (MODE == 4) ? ((((kt_) * 64 + hf * 32 + (lane & 31)) * (ntk * 64)) >> 9) : (MODE == 7) ? min((((kt_) * 64 + hf * 32 + (lane & 31)) << 3) + 5, ntk * 64 - 1) : ((kt_) * 64 + hf * 32 + (lane & 31)); \
            _Pragma("unroll") for (int ks = 0; ks < 4; ++ks) dst[hf][ks] = *(const bf16x8*)(abase + (size_t)row * 64 + ks * 16); } } while (0)
    for (int kt = wave; kt < nloop; kt += NWAVES) {
        IDX_LOADA(a, kt);
        f32x16 L0, L1; float I0[16], I1[16];
        f32x16 cA0, cA1, cB0, cB1; bf16x8 bA[4], bB[4];
#define IDX_LOADB(BD, H) do { _Pragma("unroll") for (int ks = 0; ks < 4; ++ks) BD[ks] = *(const LAS bf16x8*)(bfr + ((H) * 4 + ks) * 1024); } while (0)
#define IDX_CHAIN(D0, D1, BS) do { D0 = f32x16{}; D1 = f32x16{}; _Pragma("unroll") for (int ks = 0; ks < 4; ++ks) { \
            D0 = __builtin_amdgcn_mfma_f32_32x32x16_bf16(a[0][ks], BS[ks], D0, 0, 0, 0); D1 = __builtin_amdgcn_mfma_f32_32x32x16_bf16(a[1][ks], BS[ks], D1, 0, 0, 0); } \
            asm volatile("" : "+v"(D0)); asm volatile("" : "+v"(D1)); } while (0)
#define IDX_ACC(C0_, C1_, H) do { _Pragma("unroll") for (int r = 0; r < 16; ++r) { I0[r] = fmaf(w[H], __builtin_fabsf(C0_[r]), I0[r]); I1[r] = fmaf(w[H], __builtin_fabsf(C1_[r]), I1[r]); asm volatile("" : "+v"(I0[r]), "+v"(I1[r])); } } while (0)
#define IDX_SB __builtin_amdgcn_sched_barrier(0)
        IDX_LOADB(bA, 8); IDX_LOADB(bB, 0); IDX_SB;
        IDX_LOADB(bA, 8); IDX_CHAIN(L0, L1, bA); IDX_SB;
        IDX_LOADB(bA, 1); IDX_CHAIN(cA0, cA1, bB); IDX_SB;
#pragma unroll
        for (int r = 0; r < 16; ++r) { I0[r] = L0[r]; I1[r] = L1[r]; }
        IDX_LOADB(bB, 2); IDX_CHAIN(cB0, cB1, bA); IDX_ACC(cA0, cA1, 0); IDX_SB;
        IDX_LOADB(bA, 3); IDX_CHAIN(cA0, cA1, bB); IDX_ACC(cB0, cB1, 1); IDX_SB;
        IDX_LOADB(bB, 4); IDX_CHAIN(cB0, cB1, bA); IDX_ACC(cA0, cA1, 2); IDX_SB;
        IDX_LOADB(bA, 5); IDX_CHAIN(cA0, cA1, bB); IDX_ACC(cB0, cB1, 3); IDX_SB;
        IDX_LOADB(bB, 6); IDX_CHAIN(cB0, cB1, bA); IDX_ACC(cA0, cA1, 4); IDX_SB;
        IDX_LOADB(bA, 7); IDX_CHAIN(cA0, cA1, bB); IDX_ACC(cB0, cB1, 5); IDX_SB;
        IDX_CHAIN(cB0, cB1, bA); IDX_ACC(cA0, cA1, 6); IDX_SB;
        IDX_ACC(cB0, cB1, 7);
        IDX_SB;
#undef IDX_LOADB
#undef IDX_SB
#undef IDX_CHAIN
#undef IDX_ACC
        if (MODE == 1) {
#pragma unroll
            for (int r = 0; r < 16; ++r) { const unsigned k0 = fkey32(I0[r]), k1 = fkey32(I1[r]);
                __hip_atomic_fetch_add(hist + (k0 >> 24), 1u, __ATOMIC_RELAXED, __HIP_MEMORY_SCOPE_WORKGROUP); __hip_atomic_fetch_add(hist + (k1 >> 24), 1u, __ATOMIC_RELAXED, __HIP_MEMORY_SCOPE_WORKGROUP); }
        } else if (MODE == 2) {
#pragma unroll
            for (int r = 0; r < 16; ++r) { const unsigned k0 = fkey32(I0[r]), k1 = fkey32(I1[r]);
                if ((k0 >> 24) == P) __hip_atomic_fetch_add(hist + ((k0 >> 16) & 255u), 1u, __ATOMIC_RELAXED, __HIP_MEMORY_SCOPE_WORKGROUP);
                if ((k1 >> 24) == P) __hip_atomic_fetch_add(hist + ((k1 >> 16) & 255u), 1u, __ATOMIC_RELAXED, __HIP_MEMORY_SCOPE_WORKGROUP); }
        } else if (MODE == 4) {
#pragma unroll
            for (int r = 0; r < 16; ++r) { unsigned k0 = fkey32(I0[r]), k1 = fkey32(I1[r]); kmn = min(kmn, min(k0, k1));
#pragma unroll
                for (int i = 0; i < 8; ++i) { const unsigned hi0 = max(tk8[i], k0); k0 = min(tk8[i], k0); tk8[i] = hi0; }
#pragma unroll
                for (int i = 0; i < 8; ++i) { const unsigned hi1 = max(tk8[i], k1); k1 = min(tk8[i], k1); tk8[i] = hi1; } }
        } else if (MODE == 5 || MODE == 7) {
#pragma unroll
            for (int r = 0; r < 16; ++r) { const int b0 = lbin(I0[r], lA, lS), b1 = lbin(I1[r], lA, lS); const int kb = (r & 3) + 8 * (r >> 2) + 4 * hi;
                const bool v0 = (MODE == 5) || (((kt * 64 + kb) << 3) + 5 < ntk * 64), v1 = (MODE == 5) || (((kt * 64 + 32 + kb) << 3) + 5 < ntk * 64);
                if (v0) __hip_atomic_fetch_add(hist + (b0 >> 1) * 32, 1u << ((b0 & 1) * 16), __ATOMIC_RELAXED, __HIP_MEMORY_SCOPE_WORKGROUP);
                if (v1) __hip_atomic_fetch_add(hist + (b1 >> 1) * 32, 1u << ((b1 & 1) * 16), __ATOMIC_RELAXED, __HIP_MEMORY_SCOPE_WORKGROUP); }
        } else if (MODE == 8) {
            unsigned wlo = 0u, whi = 0u; const float thi = (P >= 1023u) ? INFINITY : (float)(P + 1u), tlo = (float)PLO;     const unsigned wbits = __float_as_uint(thi - tlo);
#pragma unroll
            for (int r = 0; r < 16; ++r) { const int kb = (r & 3) + 8 * (r >> 2); const float x0 = (I0[r] - lA) * lS, x1 = (I1[r] - lA) * lS;
                wlo |= (x0 >= thi) ? (1u << kb) : 0u; whi |= (x1 >= thi) ? (1u << kb) : 0u;
                if (__float_as_uint(x0 - tlo) < wbits) { const unsigned c0 = (unsigned)lbin(I0[r], lA, lS); __hip_atomic_fetch_add(hist + (c0 >> 1) * 32, 1u << ((c0 & 1) * 16), __ATOMIC_RELAXED, __HIP_MEMORY_SCOPE_WORKGROUP);
                    if (ccnt < 64u) CAND[ccnt] = ((u64)fkey32(I0[r]) << 32) | (u64)(unsigned)(kt * 64 + kb + 4 * hi); ++ccnt; }
                if (__float_as_uint(x1 - tlo) < wbits) { const unsigned c1 = (unsigned)lbin(I1[r], lA, lS); __hip_atomic_fetch_add(hist + (c1 >> 1) * 32, 1u << ((c1 & 1) * 16), __ATOMIC_RELAXED, __HIP_MEMORY_SCOPE_WORKGROUP);
                    if (ccnt < 64u) CAND[ccnt] = ((u64)fkey32(I1[r]) << 32) | (u64)(unsigned)(kt * 64 + 32 + kb + 4 * hi); ++ccnt; } }
            wlo <<= 4 * hi; whi <<= 4 * hi;
            wlo |= (unsigned)__shfl_xor((int)wlo, 32); whi |= (unsigned)__shfl_xor((int)whi, 32);
            if (hi == 0) { MASK[(size_t)kt * S + q0 + j] = ((u64)whi << 32) | (u64)wlo; ndef += (unsigned)(__popc(wlo) + __popc(whi)); }
        } else {
            unsigned wlo = 0u, whi = 0u;
#pragma unroll
            for (int r = 0; r < 16; ++r) { const int kb = (r & 3) + 8 * (r >> 2); const unsigned k0 = fkey32(I0[r]), k1 = fkey32(I1[r]);
                const unsigned c0 = (MODE == 3) ? (k0 >> 16) : (unsigned)lbin(I0[r], lA, lS), c1 = (MODE == 3) ? (k1 >> 16) : (unsigned)lbin(I1[r], lA, lS);
                wlo |= (c0 > P) ? (1u << kb) : 0u; whi |= (c1 > P) ? (1u << kb) : 0u;
                if (c0 == P) { const unsigned pos = __hip_atomic_fetch_add(PK + PK_TC + j, 1u, __ATOMIC_RELAXED, __HIP_MEMORY_SCOPE_WORKGROUP); if (pos < 64u) { tailk[j * 64 + pos] = k0; taili[j * 64 + pos] = (unsigned)(kt * 64 + kb + 4 * hi); } }
                if (c1 == P) { const unsigned pos = __hip_atomic_fetch_add(PK + PK_TC + j, 1u, __ATOMIC_RELAXED, __HIP_MEMORY_SCOPE_WORKGROUP); if (pos < 64u) { tailk[j * 64 + pos] = k1; taili[j * 64 + pos] = (unsigned)(kt * 64 + 32 + kb + 4 * hi); } } }
            wlo <<= 4 * hi; whi <<= 4 * hi;
            wlo |= (unsigned)__shfl_xor((int)wlo, 32); whi |= (unsigned)__shfl_xor((int)whi, 32);
            if (hi == 0) MASK[(size_t)kt * S + q0 + j] = ((u64)whi << 32) | (u64)wlo;
        }
    }
#undef IDX_LOADA
    if (MODE == 8) { if (hi == 0 && ndef) __hip_atomic_fetch_add(PK + PK_ND + j, ndef, __ATOMIC_RELAXED, __HIP_MEMORY_SCOPE_WORKGROUP); ((LAS unsigned*)(L + L_CC))[(wave * 2 + hi) * 32 + j] = ccnt; }
    if (MODE == 4) {
        const int nadm = ntk * 64; const unsigned cand = nadm >= 8192 ? tk8[3] : nadm >= 4096 ? tk8[7] : nadm >= 2048 ? kmn : nadm >= 1024 ? tk8[7] : kmn;
        __hip_atomic_fetch_min(PK + PK_MN + j, cand, __ATOMIC_RELAXED, __HIP_MEMORY_SCOPE_WORKGROUP); __hip_atomic_fetch_max(PK + PK_MX + j, tk8[0], __ATOMIC_RELAXED, __HIP_MEMORY_SCOPE_WORKGROUP); }
}

__device__ __forceinline__ void scan4(LAS unsigned char* L, int wave, int lane) {
    LAS unsigned* PK = (LAS unsigned*)(L + L_PK);
    for (int qq = 0; qq < 4; ++qq) { const int jq = wave * 4 + qq; const LAS unsigned* hb = (const LAS unsigned*)(L + L_HIST) + jq * 257;
        const unsigned kk = PK[PK_KK + jq];
        const unsigned c0 = hb[255 - 4 * lane], c1 = hb[254 - 4 * lane], c2 = hb[253 - 4 * lane], c3 = hb[252 - 4 * lane]; const unsigned tot = c0 + c1 + c2 + c3;
        unsigned incl = tot;
#pragma unroll
        for (int o = 1; o < 64; o <<= 1) { const unsigned v = __shfl_up(incl, o); if (lane >= o) incl += v; }
        const unsigned excl = incl - tot;
        if (excl < kk && kk <= incl) { const unsigned s0 = excl + c0, s1 = s0 + c1, s2 = s1 + c2;
            const int jb = kk <= s0 ? 0 : kk <= s1 ? 1 : kk <= s2 ? 2 : 3; const unsigned cum = kk <= s0 ? excl : kk <= s1 ? s0 : kk <= s2 ? s1 : s2;
            PK[PK_P + jq] = (PK[PK_P + jq] << 8) | (unsigned)(255 - (4 * lane + jb)); PK[PK_KK + jq] = kk - cum; }
    }
}
__device__ __forceinline__ void scan_lin(LAS unsigned char* L, int tid, int kk_off = PK_KK, int out_off = PK_P, bool write_kk = true) {
    LAS unsigned* PK = (LAS unsigned*)(L + L_PK); LAS unsigned* CT = (LAS unsigned*)(L + L_CT);
    const int jq = tid & 31, ch = tid >> 5; const LAS unsigned* hb = (const LAS unsigned*)(L + L_HIST) + (32 * ch) * 32 + jq;
    unsigned tot = 0u;
#pragma unroll 8
    for (int i = 0; i < 32; ++i) { const unsigned wd = hb[i * 32]; tot += (wd & 0xffffu) + (wd >> 16); }
    CT[ch * 32 + jq] = tot;
    __syncthreads();
    unsigned excl = 0u;
#pragma unroll
    for (int c = 1; c < 16; ++c) excl += (c > ch) ? CT[c * 32 + jq] : 0u;
    const unsigned kk = PK[kk_off + jq];
    if (excl < kk && kk <= excl + tot) { unsigned cum = excl, bsel = 0u, nk = 0u; bool done = false;
        for (int i = 31; i >= 0; --i) { const unsigned wd = hb[i * 32]; const unsigned chi = wd >> 16, clo = wd & 0xffffu;
            bool hit = !done && (cum + chi >= kk); bsel = hit ? (unsigned)(2 * (32 * ch + i) + 1) : bsel; nk = hit ? (kk - cum) : nk; done = done || hit; cum += chi;
            hit = !done && (cum + clo >= kk); bsel = hit ? (unsigned)(2 * (32 * ch + i)) : bsel; nk = hit ? (kk - cum) : nk; done = done || hit; cum += clo; }
        PK[out_off + jq] = bsel; if (write_kk) PK[PK_KK + jq] = nk; }
}
template <bool TOLDS>
__device__ __forceinline__ void tail_resolve(const Params& p, LAS unsigned char* L, int q0, int tid) {
    u64* MASK = (u64*)(p.ws + WS_MASK); LAS unsigned* PK = (LAS unsigned*)(L + L_PK); LAS u64* MW = (LAS u64*)(L + L_HIST);
    const int jq = tid >> 4, e0 = tid & 15; const unsigned n = min(PK[PK_TC + jq], 64u), kk = PK[PK_KK + jq];
    const LAS unsigned* tk = (const LAS unsigned*)(L + L_TAIL) + jq * 64; const LAS unsigned* ti = tk + 32 * 64;
    for (unsigned e = e0; e < n; e += 16) { const unsigned k = tk[e], s = ti[e]; unsigned rank = 0;
        for (unsigned e2 = 0; e2 < n; ++e2) { const unsigned k2 = tk[e2], s2 = ti[e2]; rank += (k2 > k || (k2 == k && s2 < s)) ? 1u : 0u; }
        if (rank < kk) { if (TOLDS) __hip_atomic_fetch_or(MW + (s >> 6) * 32 + jq, 1ull << (s & 63), __ATOMIC_RELAXED, __HIP_MEMORY_SCOPE_WORKGROUP);
            else atomicOr((unsigned long long*)&MASK[(size_t)(s >> 6) * S + q0 + jq], 1ull << (s & 63)); } }
}
__device__ __forceinline__ void idx_unit(const Params& p, unsigned char* lds, int u) {
    int tid_ = threadIdx.x; asm volatile("" : "+v"(tid_)); const int tid = tid_, lane = tid & 63; const int wave = __builtin_amdgcn_readfirstlane(tid >> 6);
    LAS unsigned char* L = (LAS unsigned char*)lds;
    const int q0 = u * 32, tq = q0 >> 6, ntk = tq + 1, ntw = 4 * (q0 >> 8) + 4;
    u64* MASK = (u64*)(p.ws + WS_MASK);
    if (ntk * 64 <= KSEL) { for (int i = tid; i < ntw * 32; i += NTHREADS) { const int tile = i >> 5; MASK[(size_t)tile * S + q0 + (i & 31)] = (tile <= tq) ? ~0ull : 0ull; } return; }
    for (int i = tid; i < (ntw - ntk) * 32; i += NTHREADS) MASK[(size_t)(ntk + (i >> 5)) * S + q0 + (i & 31)] = 0ull;
    __syncthreads();
    ISEC(7);
    { const bf16* PROJ = (const bf16*)(p.ws + WS_PROJ); const bf16* QL = (const bf16*)(p.ws + WS_QL); const int j = lane & 31, hi = lane >> 5;
        u32x4 bv[5];
#pragma unroll
        for (int i = 0; i < 5; ++i) { const int f = wave + NWAVES * i; if (f < 36) { const int h = f >> 2, ks = f & 3;
                const bf16* src = (h < 8) ? PROJ + (size_t)(q0 + j) * NP + C_QI + h * 64 + ks * 16 + hi * 8 : QL + (size_t)(q0 + j) * 64 + ks * 16 + hi * 8; bv[i] = *(const u32x4*)src; } }
#pragma unroll
        for (int i = 0; i < 5; ++i) { const int f = wave + NWAVES * i; if (f < 36) *(LAS u32x4*)(L + L_B + f * 1024 + lane * 16) = bv[i]; } }
    LAS unsigned* PK = (LAS unsigned*)(L + L_PK);
    if (tid < 32) { PK[PK_P + tid] = 0u; PK[PK_KK + tid] = (unsigned)KSEL; PK[PK_TC + tid] = 0u; PK[PK_MN + tid] = 0xffffffffu; PK[PK_MX + tid] = 0u; }
    if (tid == 0) PK[PK_FLAG] = 0u;
    for (int i = tid; i < 32 * 513; i += NTHREADS) ((LAS unsigned*)(L + L_HIST))[i] = 0u;
    __syncthreads();
    ISEC(0);
    sweep<4>(p, L, q0, ntk, wave, lane);
    __syncthreads();
    ISEC(1);
    if (tid < 32) { const float mn = fkey_inv(PK[PK_MN + tid]), mx = fkey_inv(PK[PK_MX + tid]); const float rg = mx - mn; const float A = mn; const float sc = 1024.f / (1.5f * rg);
        PK[PK_A + tid] = __float_as_uint(A); PK[PK_SC + tid] = __float_as_uint(sc); if (!(rg > 0.f) || !(sc < 3.0e38f)) PK[PK_FLAG] = 1u; }
    __syncthreads();
    bool fallback = PK[PK_FLAG] != 0u;
    bool done = false;
    if (!fallback && ntk >= 32) {
        sweep<7>(p, L, q0, ntk, wave, lane);
        __syncthreads();
        ISEC(8);
        if (tid < 32) { PK[PK_ND + tid] = (unsigned)R_HI; PK[PK_NC + tid] = (unsigned)R_LO; }
        __syncthreads();
        scan_lin(L, tid, PK_ND, PK_P, false);
        __syncthreads();
        scan_lin(L, tid, PK_NC, PK_LO, false);
        __syncthreads();
        if (tid < 32) { PK[PK_ND + tid] = 0u; PK[PK_NC + tid] = 0u; }
        for (int i = tid; i < 32 * 513; i += NTHREADS) ((LAS unsigned*)(L + L_HIST))[i] = 0u;
        __syncthreads();
        ISEC(9);
        sweep<8>(p, L, q0, ntk, wave, lane);
        __syncthreads();
        ISEC(10);
        if (tid < 32) { const LAS unsigned* cc = (const LAS unsigned*)(L + L_CC) + tid; unsigned nc = 0u, mxc = 0u;
#pragma unroll
            for (int i = 0; i < 16; ++i) { const unsigned c = cc[i * 32]; nc += c; mxc = max(mxc, c); }
            const unsigned nd = PK[PK_ND + tid]; const bool ok = nd < (unsigned)KSEL && nd + nc >= (unsigned)KSEL && mxc <= 64u;
            if (!ok) PK[PK_FLAG] = 1u; PK[PK_KK + tid] = (unsigned)KSEL - (ok ? nd : 0u); PK[PK_TC + tid] = 0u; }
        __syncthreads();
        if (PK[PK_FLAG] == 0u) {
            scan_lin(L, tid);
            __syncthreads();
            LAS u64* MW = (LAS u64*)(L + L_HIST);
            for (int i = tid; i < ntk * 32; i += NTHREADS) MW[i] = 0ull;
            __syncthreads();
            { const int jq = tid >> 4, e0 = tid & 15; const unsigned nc = ((const LAS unsigned*)(L + L_CC))[e0 * 32 + jq], bt = PK[PK_P + jq]; const float cA = __uint_as_float(PK[PK_A + jq]), cS = __uint_as_float(PK[PK_SC + jq]);
                const u64* cl = (const u64*)(p.ws + WS_XS) + (size_t)(q0 + jq) * CAND_CAP + e0 * 64; LAS unsigned* tk = (LAS unsigned*)(L + L_TAIL) + jq * 64; LAS unsigned* ti = tk + 32 * 64;
                for (unsigned eb = 0; eb < nc; eb += 8) { u64 rec[8];
#pragma unroll
                    for (int i = 0; i < 8; ++i) { const unsigned e = eb + i; rec[i] = (e < nc) ? cl[e] : 0ull; }
#pragma unroll
                    for (int i = 0; i < 8; ++i) { const unsigned e = eb + i; if (e < nc) { const unsigned key = (unsigned)(rec[i] >> 32), s = (unsigned)rec[i]; const unsigned b = (unsigned)lbin(fkey_inv(key), cA, cS);
                            if (b > bt) __hip_atomic_fetch_or(MW + (s >> 6) * 32 + jq, 1ull << (s & 63), __ATOMIC_RELAXED, __HIP_MEMORY_SCOPE_WORKGROUP);
                            else if (b == bt) { const unsigned pos = __hip_atomic_fetch_add(PK + PK_TC + jq, 1u, __ATOMIC_RELAXED, __HIP_MEMORY_SCOPE_WORKGROUP); if (pos < 64u) { tk[pos] = key; ti[pos] = s; } } } } } }
            __syncthreads();
            if (tid < 32 && PK[PK_TC + tid] > 64u) PK[PK_FLAG] = 1u;
            __syncthreads();
            if (PK[PK_FLAG] == 0u) { tail_resolve<true>(p, L, q0, tid); __syncthreads();
                for (int i = tid; i < ntk * 32; i += NTHREADS) { const u64 wv = MW[i]; if (wv) { u64* gp = &MASK[(size_t)(i >> 5) * S + q0 + (i & 31)]; *gp = *gp | wv; } }
                done = true; }
        }
        ISEC(11);
        if (!done) {
            __syncthreads();
#if PROBE_PHASE == 101
            if (tid == 0) atomicAdd((unsigned*)(p.ws + WS_CTL) + 2048, 1u);
#endif
            if (tid < 32) { PK[PK_P + tid] = 0u; PK[PK_KK + tid] = (unsigned)KSEL; PK[PK_TC + tid] = 0u; }
            if (tid == 0) PK[PK_FLAG] = 0u;
            for (int i = tid; i < 32 * 513; i += NTHREADS) ((LAS unsigned*)(L + L_HIST))[i] = 0u;
            __syncthreads();
        }
    }
    if (!fallback && !done) {
        sweep<5>(p, L, q0, ntk, wave, lane);
        __syncthreads();
        ISEC(2);
        scan_lin(L, tid);
        __syncthreads();
        ISEC(3);
        sweep<6>(p, L, q0, ntk, wave, lane);
        ISEC(4);
        __syncthreads();
        if (tid < 32 && PK[PK_TC + tid] > 64u) PK[PK_FLAG] = 1u;
        __syncthreads();
        fallback = PK[PK_FLAG] != 0u;
        if (!fallback) tail_resolve<false>(p, L, q0, tid);
        ISEC(5);
    }
    if (fallback && !done) {
        __syncthreads();
#if PROBE_PHASE == 100
        if (tid == 0) atomicAdd((unsigned*)(p.ws + WS_CTL) + 2048, 1u);
#endif
        if (tid < 32) { PK[PK_P + tid] = 0u; PK[PK_KK + tid] = (unsigned)KSEL; PK[PK_TC + tid] = 0u; }
        for (int i = tid; i < 32 * 257; i += NTHREADS) ((LAS unsigned*)(L + L_HIST))[i] = 0u;
        __syncthreads();
        sweep<1>(p, L, q0, ntk, wave, lane);
        __syncthreads();
        scan4(L, wave, lane);
        __syncthreads();
        for (int i = tid; i < 32 * 257; i += NTHREADS) ((LAS unsigned*)(L + L_HIST))[i] = 0u;
        __syncthreads();
        sweep<2>(p, L, q0, ntk, wave, lane);
        __syncthreads();
        scan4(L, wave, lane);
        __syncthreads();
        sweep<3>(p, L, q0, ntk, wave, lane);
        __syncthreads();
        tail_resolve<false>(p, L, q0, tid);
    }
}
__device__ __forceinline__ void idx_phase(const Params& p, unsigned char* lds) {
    for (int w = blockIdx.x; w < 256; w += gridDim.x)
#pragma unroll 1
        for (int k = 0; k < 2; ++k) idx_unit(p, lds, k ? 511 - w : w);
}
}

__device__ __forceinline__ void phase_att_naive(const Params& p, unsigned char* lds) {
    const int tid = opaque_tid(), lane = tid & 63, wave = tid >> 6;
    const bf16* PROJ = (const bf16*)(p.ws + WS_PROJ); bf16* MIX = (bf16*)(p.ws + WS_MIX); const u64* MASK = (const u64*)(p.ws + WS_MASK);
    int* sidx = (int*)(lds + wave * 2048); float* slog = (float*)(lds + wave * 2048 + 1024);
    const int h = wave;
    for (int t = blockIdx.x; t < S; t += gridDim.x) {
        const int tq = t >> 6;
        float qf[64];
#pragma unroll
        for (int j = 0; j < 8; ++j) { const u32x4 v = *(const u32x4*)(PROJ + (size_t)t * NP + C_Q + h * 64 + j * 8);
            qf[j * 8 + 0] = blo(v.x); qf[j * 8 + 1] = bhi(v.x); qf[j * 8 + 2] = blo(v.y); qf[j * 8 + 3] = bhi(v.y); qf[j * 8 + 4] = blo(v.z); qf[j * 8 + 5] = bhi(v.z); qf[j * 8 + 6] = blo(v.w); qf[j * 8 + 7] = bhi(v.w); }
        int n = 0;
        for (int tile = 0; tile <= tq; ++tile) {
            const u64 w = MASK[(size_t)tile * S + t]; const bool sel = (w >> lane) & 1ull;
            if (w == 0ull) continue;
            float lg = 0.f; const int s = tile * 64 + lane;
            if (sel) {
#pragma unroll
                for (int j = 0; j < 8; ++j) { const u32x4 v = *(const u32x4*)(PROJ + (size_t)s * NP + C_K + h * 64 + j * 8);
                    lg = fmaf(qf[j * 8 + 0], blo(v.x), lg); lg = fmaf(qf[j * 8 + 1], bhi(v.x), lg); lg = fmaf(qf[j * 8 + 2], blo(v.y), lg); lg = fmaf(qf[j * 8 + 3], bhi(v.y), lg);
                    lg = fmaf(qf[j * 8 + 4], blo(v.z), lg); lg = fmaf(qf[j * 8 + 5], bhi(v.z), lg); lg = fmaf(qf[j * 8 + 6], blo(v.w), lg); lg = fmaf(qf[j * 8 + 7], bhi(v.w), lg); }
                const int pos = n + __popcll(w & ((1ull << lane) - 1ull));
                if (pos < 256) { sidx[pos] = s; slog[pos] = lg; }
            }
            n += __popcll(w);
        }
        if (n > 256) n = 256;
        __builtin_amdgcn_s_waitcnt(0); asm volatile("" ::: "memory");
        float m = -INFINITY; for (int j = lane; j < n; j += 64) m = fmaxf(m, slog[j]);
        m = wave_max(m);
        float l = 0.f; for (int j = lane; j < n; j += 64) { const float pj = exp2f(slog[j] - m); slog[j] = pj; l += pj; }
        l = wave_sum(l);
        __builtin_amdgcn_s_waitcnt(0); asm volatile("" ::: "memory");
        float o = 0.f;
        for (int j = 0; j < n; ++j) o = fmaf(slog[j], bf2f(PROJ[(size_t)sidx[j] * NP + C_V + h * 64 + lane]), o);
        MIX[(size_t)t * D + 512 + h * 64 + lane] = (bf16)f2bf(o / l);
        __builtin_amdgcn_s_waitcnt(0); asm volatile("" ::: "memory");
    }
}

namespace attn_body {
using bf16=__hip_bfloat16;
using bf16x8=__attribute__((ext_vector_type(8)))short;
using s16x4=__attribute__((ext_vector_type(4)))short;
using f32x16=__attribute__((ext_vector_type(16)))float;
using u32x4=__attribute__((ext_vector_type(4)))unsigned;
constexpr int NHEAD=8,SEQ=16384,D=64,DMI=3328,DMO=1024;
typedef unsigned long long u64;
constexpr int NW=8,QBLK=32,QB=QBLK*NW,KVBLK=64,NQB=SEQ/QB;
__device__ __forceinline__ int crow(int r,int hi){return (r&3)+8*(r>>2)+4*hi;}
#define SBAR() __builtin_amdgcn_sched_barrier(0)
__device__ __forceinline__ void cmask(f32x16&p0,f32x16&p1,int jb,int qrel,int hi){
  const float NEG=-INFINITY; int kb=64*jb+4*hi;
  #pragma unroll
  for(int r=0;r<16;++r){int kv=kb+(r&3)+8*(r>>2); if(kv>qrel)p0[r]=NEG; if(kv+32>qrel)p1[r]=NEG;}
}

constexpr int NSLOT=3, SLOTB=8192;
constexpr int LDS_K=0, LDS_V=NSLOT*SLOTB, LDS_WS=2*NSLOT*SLOTB, LDS_OST=LDS_WS+NW*64*4, LDS_M=LDS_OST+NW*4096, LDS_BYTES=LDS_M+NW*2048;
constexpr float C2=0.125f*1.4426950408889634f;
__device__ __forceinline__ void glds16s(const void*sbase,unsigned voff,unsigned lds_dst){unsigned keep;
  asm volatile("s_mov_b32 %0, m0\n\ts_mov_b32 m0, %3\n\ts_nop 0\n\tglobal_load_lds_dwordx4 %1, %2\n\ts_mov_b32 m0, %0":"=&s"(keep):"v"(voff),"s"(sbase),"s"(lds_dst):"memory");}
__device__ __forceinline__ void glds16(const void*gsrc,unsigned lds_dst){unsigned keep;
  asm volatile("s_mov_b32 %0, m0\n\ts_mov_b32 m0, %2\n\ts_nop 0\n\tglobal_load_lds_dwordx4 %1, off\n\ts_mov_b32 m0, %0":"=&s"(keep):"v"(gsrc),"s"(lds_dst):"memory");}
__device__ __forceinline__ float max3f(float a,float b,float c){float r;asm("v_max3_f32 %0, %1, %2, %3":"=v"(r):"v"(a),"v"(b),"v"(c));return r;}
__device__ __forceinline__ float max2f(float a,float b){float r;asm("v_max_f32_e32 %0, %1, %2":"=v"(r):"v"(a),"v"(b));return r;}
__device__ __forceinline__ float fadd_s(float a,float b){float r;asm("v_add_f32_e32 %0, %1, %2":"=v"(r):"v"(a),"v"(b));return r;}
__device__ __forceinline__ float fsub_s(float a,float b){float r;asm("v_sub_f32_e32 %0, %1, %2":"=v"(r):"v"(a),"v"(b));return r;}
typedef float f32x2_t __attribute__((ext_vector_type(2))); typedef __bf16 bf16x2_t __attribute__((ext_vector_type(2)));
__device__ __forceinline__ unsigned cvtpk_s(float lo,float hi){f32x2_t v={lo,hi};bf16x2_t b=__builtin_convertvector(v,bf16x2_t);return __builtin_bit_cast(unsigned,b);}
#define WAIT_BAR(N) asm volatile("s_waitcnt vmcnt(" #N ") lgkmcnt(0)\n\ts_barrier":::"memory")

__device__ __forceinline__ void qkt(f32x16&p0,f32x16&p1,const char*Kslot,const bf16x8*qr,int r32,int hi){ const f32x16 negm=f32x16{};
  const char*kb=Kslot+hi*1024+r32*16;
  #pragma unroll
  for(int d0=0;d0<4;++d0){
    const bf16x8 b0=*reinterpret_cast<const bf16x8*>(kb+d0*2048);
    const bf16x8 b1=*reinterpret_cast<const bf16x8*>(kb+d0*2048+512);
    if(d0==0){p0=__builtin_amdgcn_mfma_f32_32x32x16_bf16(b0,qr[0],negm,0,0,0);p1=__builtin_amdgcn_mfma_f32_32x32x16_bf16(b1,qr[0],negm,0,0,0);}
    else{p0=__builtin_amdgcn_mfma_f32_32x32x16_bf16(b0,qr[d0],p0,0,0,0);p1=__builtin_amdgcn_mfma_f32_32x32x16_bf16(b1,qr[d0],p1,0,0,0);}}
}
typedef __attribute__((address_space(3))) const char* lds_cptr;
typedef short v4i16_t __attribute__((ext_vector_type(4)));
__device__ __forceinline__ void kload8(bf16x8*kf,lds_cptr kp){
  kf[0]=*(const __attribute__((address_space(3))) bf16x8*)(kp);      kf[1]=*(const __attribute__((address_space(3))) bf16x8*)(kp+512);
  kf[2]=*(const __attribute__((address_space(3))) bf16x8*)(kp+2048); kf[3]=*(const __attribute__((address_space(3))) bf16x8*)(kp+2560);
  kf[4]=*(const __attribute__((address_space(3))) bf16x8*)(kp+4096); kf[5]=*(const __attribute__((address_space(3))) bf16x8*)(kp+4608);
  kf[6]=*(const __attribute__((address_space(3))) bf16x8*)(kp+6144); kf[7]=*(const __attribute__((address_space(3))) bf16x8*)(kp+6656);
}
__device__ __forceinline__ void kload2(bf16x8*kf,lds_cptr kp,int j){ kf[2*j]=*(const __attribute__((address_space(3))) bf16x8*)(kp+j*2048); kf[2*j+1]=*(const __attribute__((address_space(3))) bf16x8*)(kp+j*2048+512); }
__device__ __forceinline__ s16x4 vtr(lds_cptr p){ return __builtin_bit_cast(s16x4,__builtin_amdgcn_ds_read_tr16_b64_v4i16((__attribute__((address_space(3))) v4i16_t*)p)); }
__device__ __forceinline__ float rowmax(const f32x16&p0,const f32x16&p1){
  float a=max3f(p0[0],p0[1],p1[0]),b=max3f(p0[2],p0[3],p1[1]);a=max3f(a,p1[2],p1[3]);
  #pragma unroll
  for(int r=4;r<16;r+=4){a=max3f(a,p0[r],p0[r+1]);b=max3f(b,p0[r+2],p0[r+3]);a=max3f(a,p1[r],p1[r+1]);b=max3f(b,p1[r+2],p1[r+3]);}
  const float m=max2f(a,b);
  auto rr=__builtin_amdgcn_permlane32_swap(__float_as_uint(m),__float_as_uint(m),false,false);
  return max2f(__uint_as_float(rr[0]),__uint_as_float(rr[1]));
}
__device__ __forceinline__ void pv(f32x16*o,int vb,bf16x8 pa0,bf16x8 pa1,bf16x8 pa2,bf16x8 pa3){
  #pragma unroll
  for(int d0=0;d0<2;++d0){s16x4 lo[4],hi[4];
    #pragma unroll
    for(int ks=0;ks<4;++ks){
      asm volatile("ds_read_b64_tr_b16 %0,%1 offset:%c2":"=&v"(lo[ks]):"v"(vb),"i"(d0*4096+ks*1024):"memory");
      asm volatile("ds_read_b64_tr_b16 %0,%1 offset:%c2":"=&v"(hi[ks]):"v"(vb),"i"(d0*4096+ks*1024+512):"memory");}
    asm volatile("s_waitcnt lgkmcnt(0)":::"memory");SBAR();
    #define PK(k) (bf16x8){lo[k][0],lo[k][1],lo[k][2],lo[k][3],hi[k][0],hi[k][1],hi[k][2],hi[k][3]}
    o[d0]=__builtin_amdgcn_mfma_f32_32x32x16_bf16(pa0,PK(0),o[d0],0,0,0);
    o[d0]=__builtin_amdgcn_mfma_f32_32x32x16_bf16(pa1,PK(1),o[d0],0,0,0);
    o[d0]=__builtin_amdgcn_mfma_f32_32x32x16_bf16(pa2,PK(2),o[d0],0,0,0);
    o[d0]=__builtin_amdgcn_mfma_f32_32x32x16_bf16(pa3,PK(3),o[d0],0,0,0);
    #undef PK
  }
}

#ifndef ATTN_STORE16
#define ATTN_STORE16(p,v) (*(u32x4*)(p)=(v))
#endif
template<int THRL,bool NM> __device__ __forceinline__ void attn_unit(int h,int qb,const bf16*Q,const bf16*__restrict__ K,const bf16*__restrict__ V,const u64*__restrict__ MASK,bf16*O,char*shm){
  int tid_=threadIdx.x; asm volatile("":"+v"(tid_)); const int tid=tid_,lane=tid&63,r32=lane&31,hi=lane>>5; const int wid=__builtin_amdgcn_readfirstlane(tid>>6);
  const long rowbase=0; const int q0=qb*QB;
  const bf16*Qw=Q+(rowbase+q0+wid*QBLK)*DMI+h*D;
  const bf16*Kh=K+rowbase*DMI+h*D,*Vh=V+rowbase*DMI+h*D;
  const unsigned lds0=(unsigned)(uintptr_t)shm;
  float*wsf=(float*)(shm+LDS_WS)+wid*64;
  const unsigned koff=(unsigned)(lane*DMI+wid*8)*2u;
  const unsigned voffv=(unsigned)((16*(wid&3)+(lane>>2))*DMI+(wid>>2)*32+(lane&3)*8)*2u;
  const unsigned kdst=lds0+LDS_K+wid*1024, vdst=lds0+LDS_V+wid*1024;
  const u64*mbase=MASK+q0+wid*QBLK; const int jm=lane>>4; const unsigned mdst=lds0+LDS_M+wid*2048; const unsigned moff0=(unsigned)(lane&15)*16u, moff1=moff0+((jm==1)?(unsigned)SEQ*8u:0u);
  #define DMA_M2(tA,tB,slot) glds16s(mbase+(size_t)(tA)*SEQ,((tB)!=(tA))?moff1:moff0,(unsigned)__builtin_amdgcn_readfirstlane(mdst+(slot)))
  const unsigned sh4=4u*(unsigned)hi; const float NEGINF=-INFINITY;
  #define MAPPLY(C0,C1,MW) do{ const unsigned lo_=(unsigned)(MW)>>sh4, hi_=(unsigned)((MW)>>32)>>sh4; \
    _Pragma("unroll") for(int r=0;r<16;++r){ const int sh_=31-((r&3)+8*(r>>2)); const int m0_=((int)(lo_<<sh_))>>31, m1_=((int)(hi_<<sh_))>>31;   \
      C0[r]=__int_as_float((__float_as_int(C0[r])&m0_)|(~m0_&(int)0xff800000)); C1[r]=__int_as_float((__float_as_int(C1[r])&m1_)|(~m1_&(int)0xff800000)); } }while(0)
  #define DMA_K(t,slot) glds16s(Kh+(long)(t)*KVBLK*DMI,koff,(unsigned)__builtin_amdgcn_readfirstlane(kdst+(slot)))
  #define DMA_V(t,slot) glds16s(Vh+(long)(t)*KVBLK*DMI,voffv,(unsigned)__builtin_amdgcn_readfirstlane(vdst+(slot)))
  const int vb0=(int)(lds0+LDS_V)+((lane>>4)&1)*32+(lane&3)*8+(4*hi+((lane&15)>>2))*64;
  const char*Kbase=shm+LDS_K; bf16x8 kf[8];
  const lds_cptr shm3=(lds_cptr)shm; const lds_cptr mp0=shm3+LDS_M+wid*2048+r32*8;
  #define MLD(off) (*(const __attribute__((address_space(3))) u64*)(mp0+(off)))
  const lds_cptr kp0=shm3+LDS_K+hi*1024+r32*16; const lds_cptr vp0=shm3+LDS_V+((lane>>4)&1)*32+(lane&3)*8+(4*hi+((lane&15)>>2))*64;
  const int NT=(q0+QB)/KVBLK;
  glds16s(mbase,moff0+((jm==0)?(unsigned)SEQ*8u:(jm==1)?(unsigned)SEQ*16u:0u),(unsigned)__builtin_amdgcn_readfirstlane(mdst));
  DMA_K(0,0);DMA_V(0,0);DMA_K(1,SLOTB);
  bf16x8 qr[4];
  #pragma unroll
  for(int d0=0;d0<4;++d0)qr[d0]=*reinterpret_cast<const bf16x8*>(&Qw[(long)r32*DMI+d0*16+hi*8]);
  float mhat=0.f,l_reg=0.f;f32x16 o[2];o[0]=f32x16{};o[1]=f32x16{};const f32x16 Z16=f32x16{};
  bool resc=false;
  #define START(P0,P1,MW) do{ const float rm=NM?0.f:rowmax(P0,P1); resc=false; \
    if(!NM&&__builtin_expect(__any(rm>(float)THRL),0)){ const float dl=__builtin_fmaxf(rm,0.f); mhat+=dl; \
      _Pragma("unroll") for(int r=0;r<16;++r){P0[r]-=dl;P1[r]-=dl;} } \
    MAPPLY(P0,P1,MW); \
    _Pragma("unroll") for(int r=0;r<16;++r)P0[r]=__builtin_amdgcn_exp2f(P0[r]); }while(0)
  #define RESC() do{ if(resc){ asm volatile("s_waitcnt lgkmcnt(0)":::"memory"); \
      _Pragma("unroll") for(int d_=0;d_<2;++d_) _Pragma("unroll") for(int r=0;r<16;++r)o[d_][r]*=wsf[crow(r,hi)]; } }while(0)
  f32x16 pA0,pA1,pB0,pB1;
  int sl_prev=0,sl_cur=0,sl_next=SLOTB;
  #define ROT() do{sl_prev=sl_cur;sl_cur=sl_next;sl_next=(sl_next==(NSLOT-1)*SLOTB)?0:sl_next+SLOTB;}while(0)
  DMA_K(2,2*SLOTB);
  WAIT_BAR(3);
  const u64 mw0=MLD(512);
  qkt(pA0,pA1,Kbase,qr,r32,hi);asm volatile("s_nop 15\n\ts_nop 7":"+v"(pA0),"+v"(pA1));
  START(pA0,pA1,mw0);
  _Pragma("unroll") for(int r=0;r<16;++r)pA1[r]=__builtin_amdgcn_exp2f(pA1[r]);
  WAIT_BAR(0);
  DMA_K(3,0);DMA_V(1,SLOTB);
  ROT();
  kload8(kf,kp0+sl_cur);
  WAIT_BAR(2);
  s16x4 vlo[8],vhi[8]; u32x4 pw0,pw1,pw2,pw3;
  #define PKW(P,B) cvtpk_s(P[B],P[B+1])
  #define PAF(k) __builtin_bit_cast(bf16x8,pw##k)
  #define VFR(i) (bf16x8){vlo[i][0],vlo[i][1],vlo[i][2],vlo[i][3],vhi[i][0],vhi[i][1],vhi[i][2],vhi[i][3]}
  #define PIN(x) asm volatile("":"+v"(x))
  #define MX3(a,b,c) __builtin_fmaxf(__builtin_fmaxf((a),(b)),(c))
  #define GAPA(MF,A0,A1,A2,A3,W0,W1,PW) do{ MF; sacc+=A0; sacc+=A1; sacc+=A2; sacc+=A3; PIN(sacc); W0; W1; PIN(PW); SBAR(); }while(0)
  #define EX(v) __builtin_amdgcn_exp2f(v)
  #define GAPB(MF,X,B) do{ MF; X[B]=EX(X[B]); X[B+1]=EX(X[B+1]); X[B+2]=EX(X[B+2]); X[B+3]=EX(X[B+3]); PIN(X); SBAR(); }while(0)
  #define VRD(i) do{ vlo[i]=vtr(vp_+(((i)>>2)*4096+((i)&3)*1024)); vhi[i]=vtr(vp_+(((i)>>2)*4096+((i)&3)*1024+512)); }while(0)
  #define KRD(G,j) do{ if(G){ kload2(kf,kp0+sl_next,j); SBAR(); } }while(0)
  #define STEP(C0,C1,P0,P1,t,GK,GV,GL,GM,MOFF) do{ SBAR(); \
    const lds_cptr vp_=vp0+sl_prev; \
    VRD(0); SBAR(); float sacc=(P0[0]+P0[1]); \
    GAPA(C0=__builtin_amdgcn_mfma_f32_32x32x16_bf16(kf[0],qr[0],Z16,0,0,0), P0[2],P0[3],P0[4],P0[5],     pw0[0]=PKW(P0,0), pw0[1]=PKW(P0,2), pw0); \
    VRD(4); SBAR(); GAPA(C1=__builtin_amdgcn_mfma_f32_32x32x16_bf16(kf[1],qr[0],Z16,0,0,0), P0[6],P0[7],P0[8],P0[9],     pw0[2]=PKW(P0,4), pw0[3]=PKW(P0,6), pw0); \
    VRD(1); SBAR(); GAPA(C0=__builtin_amdgcn_mfma_f32_32x32x16_bf16(kf[2],qr[1],C0,0,0,0),   P0[10],P0[11],P0[12],P0[13], pw1[0]=PKW(P0,8), pw1[1]=PKW(P0,10), pw1); \
    VRD(5); SBAR(); GAPA(C1=__builtin_amdgcn_mfma_f32_32x32x16_bf16(kf[3],qr[1],C1,0,0,0),   P0[14],P0[15],P1[0],P1[1],   pw1[2]=PKW(P0,12),pw1[3]=PKW(P0,14), pw1); \
    VRD(2); SBAR(); GAPA(C0=__builtin_amdgcn_mfma_f32_32x32x16_bf16(kf[4],qr[2],C0,0,0,0),   P1[2],P1[3],P1[4],P1[5],     pw2[0]=PKW(P1,0), pw2[1]=PKW(P1,2), pw2); \
    VRD(6); SBAR(); GAPA(C1=__builtin_amdgcn_mfma_f32_32x32x16_bf16(kf[5],qr[2],C1,0,0,0),   P1[6],P1[7],P1[8],P1[9],     pw2[2]=PKW(P1,4), pw2[3]=PKW(P1,6), pw2); \
    VRD(3); SBAR(); GAPA(C0=__builtin_amdgcn_mfma_f32_32x32x16_bf16(kf[6],qr[3],C0,0,0,0),   P1[10],P1[11],P1[12],P1[13], pw3[0]=PKW(P1,8), pw3[1]=PKW(P1,10), pw3); \
    VRD(7); SBAR(); GAPA(C1=__builtin_amdgcn_mfma_f32_32x32x16_bf16(kf[7],qr[3],C1,0,0,0),   P1[14],P1[15],0.f,0.f,       pw3[2]=PKW(P1,12),pw3[3]=PKW(P1,14), pw3); \
    l_reg+=sacc; \
    if(GK){DMA_K((t)+3,sl_cur);} if(GV){DMA_V((t)+1,sl_next);} if(GM){ const int tb_=((t)+3<NT)?(t)+3:NT-1; DMA_M2((t)+2,tb_,mslot^1024); } \
    const u64 mw_=MLD(MOFF); \
    resc=false; \
    if(!NM){ if(__builtin_expect(__any(mhat!=0.f),0)){ _Pragma("unroll") for(int r=0;r<16;++r){C0[r]-=mhat;C1[r]-=mhat;} } \
      float a=MX3(C0[0],C0[1],C1[0]),b=MX3(C0[2],C0[3],C1[1]); a=MX3(a,C1[2],C1[3]); \
      _Pragma("unroll") for(int r=4;r<16;r+=4){a=MX3(a,C0[r],C0[r+1]);b=MX3(b,C0[r+2],C0[r+3]);a=MX3(a,C1[r],C1[r+1]);b=MX3(b,C1[r+2],C1[r+3]);} \
      float rm=__builtin_fmaxf(a,b); { auto rr=__builtin_amdgcn_permlane32_swap(__float_as_uint(rm),__float_as_uint(rm),false,false); rm=__builtin_fmaxf(__uint_as_float(rr[0]),__uint_as_float(rr[1])); } \
      resc=false; \
      if(__builtin_expect(__any(rm>(float)THRL),0)){ const float dl=__builtin_fmaxf(rm,0.f); mhat+=dl; \
        _Pragma("unroll") for(int r=0;r<16;++r){C0[r]-=dl;C1[r]-=dl;} \
        const float f=__builtin_amdgcn_exp2f(-dl); l_reg*=f; if(hi==0)wsf[r32]=f; resc=true; } } \
    MAPPLY(C0,C1,mw_); \
    SBAR(); \
    GAPB(o[0]=__builtin_amdgcn_mfma_f32_32x32x16_bf16(PAF(0),VFR(0),o[0],0,0,0), C0,0); \
    GAPB(o[1]=__builtin_amdgcn_mfma_f32_32x32x16_bf16(PAF(0),VFR(4),o[1],0,0,0), C0,4); \
    KRD(GL,0); GAPB(o[0]=__builtin_amdgcn_mfma_f32_32x32x16_bf16(PAF(1),VFR(1),o[0],0,0,0), C0,8); \
    KRD(GL,1); GAPB(o[1]=__builtin_amdgcn_mfma_f32_32x32x16_bf16(PAF(1),VFR(5),o[1],0,0,0), C0,12); \
    KRD(GL,2); GAPB(o[0]=__builtin_amdgcn_mfma_f32_32x32x16_bf16(PAF(2),VFR(2),o[0],0,0,0), C1,0); \
    KRD(GL,3); GAPB(o[1]=__builtin_amdgcn_mfma_f32_32x32x16_bf16(PAF(2),VFR(6),o[1],0,0,0), C1,4); \
    GAPB(o[0]=__builtin_amdgcn_mfma_f32_32x32x16_bf16(PAF(3),VFR(3),o[0],0,0,0), C1,8); \
    GAPB(o[1]=__builtin_amdgcn_mfma_f32_32x32x16_bf16(PAF(3),VFR(7),o[1],0,0,0), C1,12); \
    }while(0)
  int t=1; int mslot=0;
  for(;t+5<NT;t+=2){
    STEP(pB0,pB1,pA0,pA1,t,true,true,true,true,mslot);          WAIT_BAR(3); RESC(); ROT();
    STEP(pA0,pA1,pB0,pB1,t+1,true,true,true,false,mslot+256);   WAIT_BAR(2); RESC(); ROT(); mslot^=1024;
  }
  #define ENDW(nf) do{ if((nf)==3){WAIT_BAR(3);} else if((nf)==2){WAIT_BAR(2);} else if((nf)==1){WAIT_BAR(1);} else {WAIT_BAR(0);} }while(0)
  for(;t+1<NT;t+=2){
    { const bool gk=(t+3<NT),gv=(t+1<NT),gm=(t+2<NT); STEP(pB0,pB1,pA0,pA1,t,gk,gv,gv,gm,mslot);   ENDW((int)gk+(int)gv+(int)gm); RESC(); ROT(); }
    { const bool gk=(t+4<NT),gv=(t+2<NT);             STEP(pA0,pA1,pB0,pB1,t+1,gk,gv,gv,false,mslot+256); ENDW((t+3<NT)?((int)gk+(int)gv):0); RESC(); ROT(); mslot^=1024; }
  }
  STEP(pB0,pB1,pA0,pA1,NT-1,false,false,false,false,mslot); RESC();
  { float sacc=pB0[0]+pB0[1]; _Pragma("unroll") for(int r=2;r<16;++r)sacc+=pB0[r]; _Pragma("unroll") for(int r=0;r<16;++r)sacc+=pB1[r]; l_reg+=sacc;
    pw0=(u32x4){PKW(pB0,0),PKW(pB0,2),PKW(pB0,4),PKW(pB0,6)};pw1=(u32x4){PKW(pB0,8),PKW(pB0,10),PKW(pB0,12),PKW(pB0,14)};pw2=(u32x4){PKW(pB1,0),PKW(pB1,2),PKW(pB1,4),PKW(pB1,6)};pw3=(u32x4){PKW(pB1,8),PKW(pB1,10),PKW(pB1,12),PKW(pB1,14)};
    SBAR(); pv(o,vb0+sl_cur,PAF(0),PAF(1),PAF(2),PAF(3)); }
  #undef PKW
  #undef PAF
  #undef VFR
  #undef PIN
  #undef MX3
  #undef GAPA
  #undef GAPB
  #undef EX
  #undef VRD
  #undef KRD
  #undef STEP
  #undef ENDW
  {auto rr=__builtin_amdgcn_permlane32_swap(__float_as_uint(l_reg),__float_as_uint(l_reg),false,false);l_reg=__uint_as_float(rr[0])+__uint_as_float(rr[1]);}
  if(hi==0)wsf[32+r32]=l_reg;asm volatile("s_waitcnt lgkmcnt(0)":::"memory");
  float rli[16];
  #pragma unroll
  for(int r=0;r<16;++r)rli[r]=__builtin_amdgcn_rcpf(wsf[32+crow(r,hi)]);
  bf16*Ow=O+(rowbase+q0+wid*QBLK)*DMO+h*D;
  { bf16*stg=(bf16*)(shm+LDS_OST)+wid*2048;
    #pragma unroll
    for(int r=0;r<16;++r){const int orow=crow(r,hi);
      #pragma unroll
      for(int d0=0;d0<2;++d0)stg[orow*64+d0*32+r32]=__float2bfloat16(o[d0][r]*rli[r]);}
    asm volatile("s_waitcnt lgkmcnt(0)":::"memory");
    #pragma unroll
    for(int i=0;i<4;++i){const int row=i*8+(lane>>3),ch=lane&7; const u32x4 v=*(const u32x4*)(stg+row*64+ch*8); ATTN_STORE16(Ow+(long)row*DMO+ch*8,v);} }
  asm volatile("s_waitcnt lgkmcnt(0)\n\ts_barrier":::"memory");
  #undef DMA_K
  #undef DMA_V
  #undef DMA_M2
  #undef MAPPLY
  #undef MLD
  #undef START
  #undef RESC
  #undef ROT
}
constexpr int ATTN_LDS_BYTES=LDS_BYTES;
template<int THRL,bool NM> __device__ __forceinline__ void attn_phase(char*lds,const bf16*Q,const bf16*K,const bf16*V,const u64*MASK,bf16*O){
  const int G=gridDim.x;
  for(int w=blockIdx.x;w<256;w+=G){ const int h=w&7,s=w>>3; attn_unit<THRL,NM>(h,s,Q,K,V,MASK,O,lds); attn_unit<THRL,NM>(h,63-s,Q,K,V,MASK,O,lds); }
}
#undef SBAR
#undef WAIT_BAR
}

__device__ __forceinline__ void phase_route_naive(const Params& p, unsigned char* lds) {
    const int tid = opaque_tid(), lane = tid & 63, wave = tid >> 6;
    const int gw = blockIdx.x * NWAVES + wave, NGW = gridDim.x * NWAVES;
    const bf16* H2 = (const bf16*)(p.ws + WS_XN); const float* WGRT = (const float*)(p.ws + WS_WGRT);
    float* RSTD = (float*)(p.ws + WS_RSTD); int* TOKOF = (int*)(p.ws + WS_TOKOF); float* GATEOF = (float*)(p.ws + WS_GATEOF); int* PAIR = (int*)(p.ws + WS_PAIR);
    unsigned* CNT = (unsigned*)(p.ws + WS_CTL) + CW_CNT;
    for (int t = gw; t < S; t += NGW) {
        const uint2* hr = (const uint2*)(H2 + (size_t)t * D) + lane; f32x4 v[4]; float ss = 0.f;
#pragma unroll
        for (int j = 0; j < 4; ++j) { const uint2 hb = hr[64 * j]; v[j] = (f32x4){blo(hb.x), bhi(hb.x), blo(hb.y), bhi(hb.y)}; ss += v[j].x * v[j].x + v[j].y * v[j].y + v[j].z * v[j].z + v[j].w * v[j].w; }
        const float rstd = rsqrtf(wave_sum(ss) * (1.f / D) + EPS);
        float mine = -INFINITY;
        for (int e = 0; e < NE; ++e) { const f32x4* wr = (const f32x4*)(WGRT + (size_t)e * D) + lane; float a = 0.f;
#pragma unroll
            for (int j = 0; j < 4; ++j) { const f32x4 w = wr[64 * j]; a = fmaf(v[j].x, w.x, a); a = fmaf(v[j].y, w.y, a); a = fmaf(v[j].z, w.z, a); a = fmaf(v[j].w, w.w, a); }
            a = wave_sum(a); if (lane == e) mine = a * rstd + p.b_router[e]; }
        float tv[4]; int te[4];
#pragma unroll
        for (int k = 0; k < 4; ++k) { float bv = mine; int bi = lane;
#pragma unroll
            for (int o = 32; o >= 1; o >>= 1) { const float ov = __shfl_xor(bv, o); const int oi = __shfl_xor(bi, o); if (ov > bv || (ov == bv && oi < bi)) { bv = ov; bi = oi; } }
            tv[k] = bv; te[k] = bi; if (lane == bi) mine = -INFINITY; }
        float g[4], gs = 0.f;
#pragma unroll
        for (int k = 0; k < 4; ++k) { g[k] = __expf(tv[k] - tv[0]); gs += g[k]; }
        if (lane == 0) RSTD[t] = rstd;
        if (lane < 4) { const int e = lane == 0 ? te[0] : lane == 1 ? te[1] : lane == 2 ? te[2] : te[3]; const float gg = (lane == 0 ? g[0] : lane == 1 ? g[1] : lane == 2 ? g[2] : g[3]) / gs;
            const unsigned slot = atomicAdd(&CNT[e], 1u); TOKOF[e * S + slot] = t; GATEOF[e * S + slot] = gg; PAIR[t * 4 + lane] = (e << 16) | (int)slot; }
    }
}

__device__ __forceinline__ void phase_route_fast(const Params& p, unsigned char* lds) {
    typedef float f32x16 __attribute__((ext_vector_type(16)));
    const int tid = opaque_tid(), lane = tid & 63, wave = tid >> 6, j = lane & 31, kk = lane >> 5, tsel = wave >> 2, kq = wave & 3;
    const bf16* H2 = (const bf16*)(p.ws + WS_XN); const float* WGR = (const float*)(p.ws + WS_WGRT) + 65536;
    float* RSTD = (float*)(p.ws + WS_RSTD); int* TOKOF = (int*)(p.ws + WS_TOKOF); float* GATEOF = (float*)(p.ws + WS_GATEOF); int* PAIR = (int*)(p.ws + WS_PAIR);
    unsigned* CNT = (unsigned*)(p.ws + WS_CTL) + CW_CNT;
    LAS float* sc = (LAS float*)((LAS unsigned char*)lds + wave * 8192);
    for (int tp = blockIdx.x; tp < S / 64; tp += gridDim.x) {
        const int t0 = (tp * 2 + tsel) * 32;
        const bf16* arow = H2 + (size_t)(t0 + j) * D + kq * 256 + 4 * kk; const float* bcol = WGR + (kq * 256 + 4 * kk) * NE + j;
        f32x16 acc = f32x16{}; float ss = 0.f;
#pragma unroll 8
        for (int m = 0; m < 32; ++m) { const uint2 ar = *(const uint2*)(arow + 8 * m); const f32x4 a = {blo(ar.x), bhi(ar.x), blo(ar.y), bhi(ar.y)};
            const float b0 = bcol[(8 * m + 0) * NE], b1 = bcol[(8 * m + 1) * NE], b2 = bcol[(8 * m + 2) * NE], b3 = bcol[(8 * m + 3) * NE];
            acc = __builtin_amdgcn_mfma_f32_32x32x2f32(a.x, b0, acc, 0, 0, 0); acc = __builtin_amdgcn_mfma_f32_32x32x2f32(a.y, b1, acc, 0, 0, 0);
            acc = __builtin_amdgcn_mfma_f32_32x32x2f32(a.z, b2, acc, 0, 0, 0); acc = __builtin_amdgcn_mfma_f32_32x32x2f32(a.w, b3, acc, 0, 0, 0);
            ss += a.x * a.x + a.y * a.y + a.z * a.z + a.w * a.w; }
        ss += __shfl_xor(ss, 32);
        __syncthreads();
#pragma unroll
        for (int r = 0; r < 16; ++r) sc[((r & 3) + 8 * (r >> 2) + 4 * kk) * 33 + j] = acc[r];
        if (kk == 0) sc[32 * 33 + j] = ss;
        __syncthreads();
        if (kq == 0) {
            const LAS float* s0 = sc, *s1 = sc + 2048, *s2 = sc + 4096, *s3 = sc + 6144;
            const float sst = s0[32 * 33 + j] + s1[32 * 33 + j] + s2[32 * 33 + j] + s3[32 * 33 + j];
            const float rstd = rsqrtf(sst * (1.f / D) + EPS);
            float v[32];
#pragma unroll
            for (int e = 0; e < 32; ++e) v[e] = ((s0[j * 33 + e] + s1[j * 33 + e]) + (s2[j * 33 + e] + s3[j * 33 + e])) * rstd + p.b_router[e];
            float tv[4]; int te[4]; unsigned taken = 0u;
#pragma unroll
            for (int k = 0; k < 4; ++k) { float best = -INFINITY; int bi = 0;
#pragma unroll
                for (int e = 0; e < 32; ++e) { const bool ok = !((taken >> e) & 1u) && (v[e] > best); best = ok ? v[e] : best; bi = ok ? e : bi; }
                tv[k] = best; te[k] = bi; taken |= 1u << bi; }
            float g[4], gs = 0.f;
#pragma unroll
            for (int k = 0; k < 4; ++k) { g[k] = __expf(tv[k] - tv[0]); gs += g[k]; }
            const float gi = 1.f / gs;
            const bool act = lane < 32; int rk[4] = {0, 0, 0, 0}; unsigned mycnt = 0u;
#pragma unroll 4
            for (int e = 0; e < 32; ++e) { const bool pick = act && ((taken >> e) & 1u); const u64 m = __ballot(pick); const int below = __popcll(m & ((1ull << lane) - 1ull));
                if (lane == e) mycnt = (unsigned)__popcll(m);
#pragma unroll
                for (int k = 0; k < 4; ++k) rk[k] = (te[k] == e) ? below : rk[k]; }
            unsigned base = 0u; if (act && mycnt) base = atomicAdd(&CNT[lane], mycnt);
#pragma unroll
            for (int k = 0; k < 4; ++k) { const unsigned be = (unsigned)__shfl((int)base, te[k]); if (act) { const int slot = (int)be + rk[k]; const int t = t0 + lane;
                    TOKOF[te[k] * S + slot] = t; GATEOF[te[k] * S + slot] = g[k] * gi; PAIR[t * 4 + k] = (te[k] << 16) | slot; } }
            if (act) RSTD[t0 + lane] = rstd;
        }
    }
}

__device__ __forceinline__ int build_tiles(const Params& p, unsigned char* lds) {
    int* pst = (int*)(lds + LDS_MISC); int* tile_e = pst + 40;
    unsigned* CNT = (unsigned*)(p.ws + WS_CTL) + CW_CNT;
    __syncthreads();
    const int tid = opaque_tid();
    if (tid < 64) {
        const int e = tid & 31; const int c = (int)__hip_atomic_load(&CNT[e], __ATOMIC_RELAXED, __HIP_MEMORY_SCOPE_AGENT); const int nt = (c + 255) >> 8;
        int incl = nt;
#pragma unroll
        for (int o = 1; o < 32; o <<= 1) { const int v = __shfl_up(incl, o, 32); if (e >= o) incl += v; }
        const int excl = incl - nt;
        if (tid < 32) { pst[e] = excl; pst[328 + e] = c; if (e == 31) pst[NE] = incl; for (int i = 0; i < nt; ++i) tile_e[excl + i] = e; }
    }
    __syncthreads();
    return pst[NE];
}

__device__ __forceinline__ void phase_gather(const Params& p, unsigned char* lds) {
    const int tid = opaque_tid(), lane = tid & 63, wave = tid >> 6;
    const int gw = blockIdx.x * NWAVES + wave, NGW = gridDim.x * NWAVES;
    build_tiles(p, lds); const int* pst = (const int*)(lds + LDS_MISC);
    const bf16* XN2 = (const bf16*)(p.ws + WS_XN); bf16* XS = (bf16*)(p.ws + WS_XS); const int* PAIR = (const int*)(p.ws + WS_PAIR);
    const float* RSTD = (const float*)(p.ws + WS_RSTD); const float* GATEOF = (const float*)(p.ws + WS_GATEOF);
    float* ROWRSTD = (float*)(p.ws + WS_ROWRSTD); float* ROWGATE = (float*)(p.ws + WS_ROWGATE);
#if FUSED_GATHER
    int* ROWTOK = (int*)(p.ws + WS_ROWTOK); const int* tile_e = pst + 40; const unsigned* CNT = (const unsigned*)(p.ws + WS_CTL) + CW_CNT; (void)XN2; (void)XS; (void)lane; (void)gw; (void)NGW;
    for (int row = blockIdx.x * NTHREADS + tid; row < pst[NE] * 256; row += gridDim.x * NTHREADS) { const int e = tile_e[row >> 8]; if (row - pst[e] * 256 >= (int)CNT[e]) ROWTOK[row] = 0; }
    for (int pr = blockIdx.x * NTHREADS + tid; pr < S * 4; pr += gridDim.x * NTHREADS) { const int t = pr >> 2; const int pe = PAIR[pr]; const int e = pe >> 16, slot = pe & 0xffff; const int row = pst[e] * 256 + slot;
        ROWTOK[row] = t; ROWRSTD[row] = RSTD[t]; ROWGATE[row] = GATEOF[e * S + slot]; }
#else
    for (int pr0 = gw * 4; pr0 < S * 4; pr0 += NGW * 4) {
        int row[4]; u32x4 va[4], vb[4];
#pragma unroll
        for (int i = 0; i < 4; ++i) { const int pr = pr0 + i, t = pr >> 2; const int pe = PAIR[pr]; const int e = pe >> 16, slot = pe & 0xffff; row[i] = pst[e] * 256 + slot;
            const u32x4* src = (const u32x4*)(XN2 + (size_t)t * D); va[i] = src[lane]; vb[i] = src[lane + 64];
            if (lane == 0) { ROWRSTD[row[i]] = RSTD[t]; ROWGATE[row[i]] = GATEOF[e * S + slot]; } }
#pragma unroll
        for (int i = 0; i < 4; ++i) { u32x4* dst = (u32x4*)(XS + (size_t)row[i] * D); dst[lane] = va[i]; dst[lane + 64] = vb[i]; }
    }
#endif
}

__device__ __forceinline__ void phase_final(const Params& p, unsigned char* lds) {
    const int tid = opaque_tid(), lane = tid & 63, wave = tid >> 6;
    const int gw = blockIdx.x * NWAVES + wave, NGW = gridDim.x * NWAVES;
    build_tiles(p, lds); const int* pst = (const int*)(lds + LDS_MISC);
    const bf16* H2 = (const bf16*)(p.ws + WS_XN); const bf16* YS = (const bf16*)(p.ws + WS_YS); const int* PAIR = (const int*)(p.ws + WS_PAIR);
    for (int t = gw; t < S; t += NGW) {
        const uint2* hr = (const uint2*)(H2 + (size_t)t * D) + lane; f32x4 v[4];
#pragma unroll
        for (int j = 0; j < 4; ++j) { const uint2 hb = hr[64 * j]; v[j] = (f32x4){blo(hb.x), bhi(hb.x), blo(hb.y), bhi(hb.y)}; }
#pragma unroll
        for (int k = 0; k < 4; ++k) { const int pe = PAIR[t * 4 + k]; const int row = pst[pe >> 16] * 256 + (pe & 0xffff); const uint2* yr = (const uint2*)(YS + (size_t)row * D) + lane;
#pragma unroll
            for (int j = 0; j < 4; ++j) { const uint2 y = yr[64 * j]; v[j].x += blo(y.x); v[j].y += bhi(y.x); v[j].z += blo(y.y); v[j].w += bhi(y.y); } }
        float ss = 0.f;
#pragma unroll
        for (int j = 0; j < 4; ++j) ss += v[j].x * v[j].x + v[j].y * v[j].y + v[j].z * v[j].z + v[j].w * v[j].w;
        const float rstd = rsqrtf(wave_sum(ss) * (1.f / D) + EPS);
        f32x4* o = (f32x4*)(p.out + (size_t)t * D) + lane;
#pragma unroll
        for (int j = 0; j < 4; ++j) { const f32x4 g = ((const f32x4*)p.norm_final_g)[lane + 64 * j]; o[64 * j] = (f32x4){v[j].x * rstd * g.x, v[j].y * rstd * g.y, v[j].z * rstd * g.z, v[j].w * rstd * g.w}; }
    }
}

#define GAS __attribute__((address_space(1)))
typedef GAS unsigned gu32;
#define XB_TMO      128
#define XB_XCNT(j)  (256  + 64 * (j))
#define XB_XSUB(j)  (1280 + 64 * (j))
#define XB_XGEN(j)  (2304 + 64 * (j))
#define XB_TOP      3328
#define XB_TOPGEN   3392
#define XCD_BAR_WORDS 3456
#define XB_SPIN_CAP (1u << 18)

__device__ __forceinline__ unsigned xb_ld(unsigned* p)              { return __hip_atomic_load(p, __ATOMIC_RELAXED, __HIP_MEMORY_SCOPE_AGENT); }
__device__ __forceinline__ unsigned xb_add(unsigned* p, unsigned v) { return __hip_atomic_fetch_add(p, v, __ATOMIC_RELAXED, __HIP_MEMORY_SCOPE_AGENT); }
__device__ __forceinline__ unsigned xb_xcc_id() { return (unsigned)__builtin_amdgcn_s_getreg((3 << 11) | 20) & 0xFu; }
#define XB_SPIN(cond, bar) do { unsigned _sp = 0; while (cond) { __builtin_amdgcn_s_sleep(1); \
    if ((++_sp & 255u) == 0u) { if (xb_ld(&(bar)[XB_TMO])) break; if (_sp > XB_SPIN_CAP) { atomicAdd(&(bar)[XB_TMO], 1u); break; } } } } while (0)

struct XcdBarrier {
    unsigned* bar; unsigned x;
    volatile LAS unsigned* st;
};

__device__ __forceinline__ XcdBarrier xcd_barrier_post(unsigned* bar, volatile LAS unsigned* st) {
    XcdBarrier b; b.bar = bar; b.x = xb_xcc_id(); b.st = st;
    if (threadIdx.x == 0) (void)xb_add(&bar[XB_XCNT(b.x)], 1u);
    return b;
}
__device__ __forceinline__ void xcd_barrier_complete(unsigned* bar, unsigned x, unsigned& nloc, unsigned& nx) {
    const unsigned G = gridDim.x * gridDim.y * gridDim.z;
    unsigned sum, cnt, mine, sp = 0u;
    for (;;) {
        sum = 0u; cnt = 0u; mine = 0u;
#pragma unroll
        for (unsigned j = 0; j < 16; ++j) { const unsigned c = xb_ld(&bar[XB_XCNT(j)]); sum += c; cnt += (c > 0u) ? 1u : 0u; mine = (j == x) ? c : mine; }
        if (sum == G) break;
        __builtin_amdgcn_s_sleep(1);
        if ((++sp & 255u) == 0u) { if (xb_ld(&bar[XB_TMO])) break; if (sp > XB_SPIN_CAP) { atomicAdd(&bar[XB_TMO], 1u); break; } }
    }
    nloc = mine > 0u ? mine : 1u; nx = cnt > 0u ? cnt : 1u;
}

__device__ __forceinline__ void xcd_barrier(const XcdBarrier& b) {
    asm volatile("s_waitcnt vmcnt(0)" ::: "memory");
    __syncthreads();
    if (threadIdx.x == 0) {
        unsigned* bar = b.bar;
        __builtin_amdgcn_s_waitcnt(0);
        unsigned nloc = b.st[0], nx = b.st[1];
        if (nloc == 0u) { xcd_barrier_complete(bar, b.x, nloc, nx); b.st[0] = nloc; b.st[1] = nx; }
        const unsigned old = xb_add(&bar[XB_XSUB(b.x)], 1u);
        const unsigned gen = old / nloc;
        if (old + 1u == (gen + 1u) * nloc) {
            __builtin_amdgcn_fence(__ATOMIC_RELEASE, "agent");
            asm volatile("s_waitcnt vmcnt(0)" ::: "memory");
            const unsigned og = xb_add(&bar[XB_TOP], 1u);
            const unsigned tg = og / nx;
            if (og + 1u == (tg + 1u) * nx) xb_add(&bar[XB_TOPGEN], 1u);
            else XB_SPIN(xb_ld(&bar[XB_TOPGEN]) == tg, bar);
            __builtin_amdgcn_fence(__ATOMIC_ACQUIRE, "agent");
            xb_add(&bar[XB_XGEN(b.x)], 1u);
            asm volatile("s_waitcnt vmcnt(0)" ::: "memory");
        } else {
            XB_SPIN(xb_ld(&bar[XB_XGEN(b.x)]) == gen, bar);
            __builtin_amdgcn_fence(__ATOMIC_ACQUIRE, "agent");
            asm volatile("s_waitcnt vmcnt(0)" ::: "memory");
        }
    }
    __syncthreads();
}

#ifndef FAST_GEMM
#define FAST_GEMM 1
#endif
#ifndef FAST_ATT
#define FAST_ATT 1
#endif
#ifndef FAST_IDX
#define FAST_IDX 1
#endif
#ifndef FAST_EW
#define FAST_EW 1
#endif
#ifndef FAST_ROUTE
#define FAST_ROUTE 1
#endif
template <class F, class Sched>
__device__ __forceinline__ void run_gemm_gather(unsigned char* lds, const bf16* A, const bf16* Bt, int K, const Sched& S, const F& f) {
    pg8::Gemm g{A, Bt, 0, 0, K}; EpiAdapt<F> E{f};
    pg8::gemm_phase<EpiAdapt<F>, Sched, true, true, true>((LAS unsigned char*)lds, g, S, E);
    __syncthreads();
}
template <class F, class Sched>
__device__ __forceinline__ void run_gemm(unsigned char* lds, const bf16* A, const bf16* Bt, int K, const Sched& S, const F& f) {
#if FAST_GEMM
    pg8::Gemm g{A, Bt, 0, 0, K}; EpiAdapt<F> E{f};
    pg8::gemm_phase<EpiAdapt<F>, Sched, true, true>((LAS unsigned char*)lds, g, S, E);
#else
    Unit u;
    for (int i = 0; S.next(i, u); ++i) ngemm_unit(lds, A + (size_t)u.pm * 256 * K, K, Bt + (size_t)S.bidx(u) * 256 * K, K, K, f, u);
#endif
    __syncthreads();
}

#ifndef PROBE_MULT
#define PROBE_MULT 8
#endif
#if PROBE_PHASE >= 0
#define STAMP(i) do { if (blockIdx.x == 0 && opaque_tid() == 0) ((volatile LAS unsigned long long*)((LAS unsigned char*)lds + LDS_PROBE))[i] = __builtin_amdgcn_s_memrealtime(); } while (0)
#else
#define STAMP(i) do { } while (0)
#endif
__global__ void __launch_bounds__(NTHREADS, 2) fwd_kernel(Params p) {
    extern __shared__ __attribute__((aligned(16))) unsigned char lds[];
    cg::grid_group grid = cg::this_grid();
    const int G = gridDim.x, bx = blockIdx.x;
    const LAS int* tile_e = (const LAS int*)((LAS unsigned char*)lds + LDS_MISC) + 40;
    volatile LAS unsigned* bst = (volatile LAS unsigned*)((LAS unsigned char*)lds + LDS_MISC + 4096);
    if (opaque_tid() < 2) bst[opaque_tid()] = 0u;
    __syncthreads();
    const XcdBarrier xbar = xcd_barrier_post((unsigned*)(p.ws + WS_CTL) + CW_BAR, bst);
#if PROBE_PHASE >= 200
    if (opaque_tid() < 16) ((volatile LAS unsigned long long*)((LAS unsigned char*)lds + LDS_PROBE + 256))[opaque_tid()] = 0ull;
#endif
    STAMP(0);
    phase_prologue(p, lds);
    if (gridDim.y == 0xffffu) grid.sync();
    xcd_barrier(xbar);
    STAMP(1);
    { pg8::StaticOrder so; so.init(S, NP, G, bx); EpiProj E{(bf16*)(p.ws + WS_PROJ)};
        run_gemm(lds, (const bf16*)(p.ws + WS_XN), (const bf16*)(p.ws + WS_WINT), D, so, E); }
    xcd_barrier(xbar);
    STAMP(2);
#if FAST_EW
    phase_ew_fast(p, lds);
#else
    phase_ew_naive(p, lds);
#endif
    xcd_barrier(xbar);
    STAMP(3);
#if FAST_IDX
    idxf::idx_phase(p, lds);
    __syncthreads();
#else
    phase_idx_naive(p, lds);
#endif
    xcd_barrier(xbar);
    STAMP(4);
#if FAST_ATT
    {
        const int tid = opaque_tid(); const int hq = bx & 7, sq = (bx >> 3) & 31; const int row = ((tid < 256) ? sq : 63 - sq) * 256 + (tid & 255);
        const bf16* qp = (const bf16*)(p.ws + WS_PROJ) + (size_t)row * NP + C_Q + hq * 64; float q1 = 0.f;
#pragma unroll
        for (int j = 0; j < 8; ++j) { const u32x4 v = *(const u32x4*)(qp + j * 8); q1 += fabsf(blo(v.x)) + fabsf(bhi(v.x)) + fabsf(blo(v.y)) + fabsf(bhi(v.y)) + fabsf(blo(v.z)) + fabsf(bhi(v.z)) + fabsf(blo(v.w)) + fabsf(bhi(v.w)); }
        q1 = wave_max(q1); LAS float* qb = (LAS float*)((LAS unsigned char*)lds + LDS_MISC + 4224); if ((tid & 63) == 0) qb[tid >> 6] = q1;
        __syncthreads();
        float qm = qb[0];
#pragma unroll
        for (int w = 1; w < 8; ++w) qm = fmaxf(qm, qb[w]);
        const float kmaxel = *(const float*)((const unsigned*)(p.ws + WS_CTL) + CW_KMAX); const bool nomax = (G == 256) && (qm * kmaxel <= 96.f);
        const attn_body::bf16* PJ = (const attn_body::bf16*)(p.ws + WS_PROJ); const u64* MK = (const u64*)(p.ws + WS_MASK); attn_body::bf16* MO = (attn_body::bf16*)(p.ws + WS_MIX) + 512;
        if (nomax) attn_body::attn_phase<96, true>((char*)lds, PJ + C_Q, PJ + C_K, PJ + C_V, MK, MO);
        else attn_body::attn_phase<96, false>((char*)lds, PJ + C_Q, PJ + C_K, PJ + C_V, MK, MO); }
    __syncthreads();
#else
    phase_att_naive(p, lds);
#endif
    xcd_barrier(xbar);
    STAMP(5);
    { pg8::StaticOrder so; so.init(S, D, G, bx); EpiOut E{p.x, (bf16*)(p.ws + WS_XN)};
        run_gemm(lds, (const bf16*)(p.ws + WS_MIX), (const bf16*)(p.ws + WS_WOUTT), D, so, E); }
    xcd_barrier(xbar);
    STAMP(6);
#if FAST_ROUTE
    phase_route_fast(p, lds);
#else
    phase_route_naive(p, lds);
#endif
    xcd_barrier(xbar);
    STAMP(7);
    { const int ntile = build_tiles(p, lds); const LAS int* pst = (const LAS int*)((LAS unsigned char*)lds + LDS_MISC);
        MoeOrder mo; mo.so.init(ntile * 256, 2048, G, bx); mo.tile_e = tile_e; mo.ncol = 8; mo.ltok = (const LAS int*)((LAS unsigned char*)lds + LDS_LTOK);
        EpiGU E{p.b_gu, (const LAS float*)((LAS unsigned char*)lds + LDS_LRS), (bf16*)(p.ws + WS_HDN), tile_e};
        { const int* TOKOF = (const int*)(p.ws + WS_TOKOF); const float* RSTD = (const float*)(p.ws + WS_RSTD); LAS int* lt = (LAS int*)((LAS unsigned char*)lds + LDS_LTOK); LAS float* lr = (LAS float*)((LAS unsigned char*)lds + LDS_LRS);
            const int tid = opaque_tid(); Unit uu[9]; bool uv[9]; int tok[9]; float rs[9]; bool val[9];
#pragma unroll
            for (int i = 0; i < 9; ++i) { uv[i] = mo.next(i, uu[i]); val[i] = false; tok[i] = 0;
                if (uv[i] && tid < 256) { const int e = tile_e[uu[i].pm], slot = (uu[i].pm - pst[e]) * 256 + tid; val[i] = slot < pst[328 + e]; if (val[i]) tok[i] = TOKOF[e * S + slot]; } }
#pragma unroll
            for (int i = 0; i < 9; ++i) rs[i] = val[i] ? RSTD[tok[i]] : 0.f;
#pragma unroll
            for (int i = 0; i < 9; ++i) if (uv[i] && tid < 256) { lt[i * 256 + tid] = tok[i]; lr[i * 256 + tid] = rs[i]; }
            __syncthreads(); }
        run_gemm_gather(lds, (const bf16*)(p.ws + WS_XN), (const bf16*)(p.ws + WS_WGUT), D, mo, E);
    }
    xcd_barrier(xbar);
    STAMP(8);
    { const int ntile = build_tiles(p, lds);
        MoeOrder mo; mo.so.init(ntile * 256, D, G, bx); mo.tile_e = tile_e; mo.ncol = 4; mo.ltok = nullptr; const LAS int* pst = (const LAS int*)((LAS unsigned char*)lds + LDS_MISC);
        EpiDown E{p.b_down, (const LAS float*)((LAS unsigned char*)lds + LDS_LRS), (bf16*)(p.ws + WS_YS), tile_e};
        { const float* GATEOF = (const float*)(p.ws + WS_GATEOF); LAS float* lg = (LAS float*)((LAS unsigned char*)lds + LDS_LRS); const int tid = opaque_tid(); Unit uu[9]; bool uv[9]; float gv[9];
#pragma unroll
            for (int i = 0; i < 9; ++i) { uv[i] = mo.next(i, uu[i]); gv[i] = 0.f;
                if (uv[i] && tid < 256) { const int e = tile_e[uu[i].pm], slot = (uu[i].pm - pst[e]) * 256 + tid; if (slot < pst[328 + e]) gv[i] = GATEOF[e * S + slot]; } }
#pragma unroll
            for (int i = 0; i < 9; ++i) if (uv[i] && tid < 256) lg[i * 256 + tid] = gv[i];
            __syncthreads(); }
        run_gemm(lds, (const bf16*)(p.ws + WS_HDN), (const bf16*)(p.ws + WS_WDT), DE, mo, E); }
    xcd_barrier(xbar);
    STAMP(9);
    phase_final(p, lds);
#if PROBE_PHASE >= 0
    STAMP(10);
    if (blockIdx.x == 0 && opaque_tid() == 0) { volatile LAS unsigned long long* st = (volatile LAS unsigned long long*)((LAS unsigned char*)lds + LDS_PROBE);
#if PROBE_PHASE >= 200
        const unsigned long long dt = ((volatile LAS unsigned long long*)((LAS unsigned char*)lds + LDS_PROBE + 256))[PROBE_PHASE - 200], t0 = __builtin_amdgcn_s_memrealtime();
#elif PROBE_PHASE == 100 || PROBE_PHASE == 101
        const unsigned long long dt = 125ull * (unsigned long long)__hip_atomic_load((unsigned*)(p.ws + WS_CTL) + 2048, __ATOMIC_RELAXED, __HIP_MEMORY_SCOPE_AGENT), t0 = __builtin_amdgcn_s_memrealtime();
#else
        const unsigned long long dt = st[PROBE_PHASE + 1] - st[PROBE_PHASE], t0 = __builtin_amdgcn_s_memrealtime();
#endif
        while (__builtin_amdgcn_s_memrealtime() - t0 < (unsigned long long)PROBE_MULT * dt) __builtin_amdgcn_s_sleep(8); }
#endif
}

extern "C" void kernel_launch(void* const* d_in, const int* in_sizes, int n_in, void* d_out, int out_size, void* d_ws, size_t ws_size, hipStream_t stream) {
    static int grid = 0;
    if (grid == 0) {
        if (n_in != 19 || out_size != S * D || ws_size < WS_END) { fprintf(stderr, "kernel_launch: unexpected shapes (n_in %d out %d ws %zu)\n", n_in, out_size, ws_size); grid = -1; return; }
        int dev = 0, cus = 0, per_cu = 0;
        (void)hipGetDevice(&dev); (void)hipDeviceGetAttribute(&cus, hipDeviceAttributeMultiprocessorCount, dev);
        if (hipFuncSetAttribute((const void*)fwd_kernel, hipFuncAttributeMaxDynamicSharedMemorySize, LDS_BYTES) != hipSuccess) { fprintf(stderr, "kernel_launch: hipFuncSetAttribute failed\n"); grid = -1; return; }
        if (hipOccupancyMaxActiveBlocksPerMultiprocessor(&per_cu, (const void*)fwd_kernel, NTHREADS, LDS_BYTES) != hipSuccess || per_cu < 1) { fprintf(stderr, "kernel_launch: occupancy query says %d\n", per_cu); per_cu = 1; }
        (void)hipGetLastError();
        grid = cus * 1;
    }
    if (grid < 0) return;
    (void)hipMemsetAsync((char*)d_ws + WS_CTL, 0, CTL_BYTES, stream);
    Params p{};
    p.x = (const float*)d_in[0]; p.pos = (const int*)d_in[1]; p.norm_mix_g = (const float*)d_in[2]; p.w_in = (const float*)d_in[3]; p.idx_g = (const float*)d_in[4]; p.idx_b = (const float*)d_in[5];
    p.conv_w = (const float*)d_in[6]; p.conv_b = (const float*)d_in[7]; p.conv_ng = (const float*)d_in[8]; p.conv_nb = (const float*)d_in[9]; p.w_out = (const float*)d_in[10]; p.norm_ffn_g = (const float*)d_in[11];
    p.w_router = (const float*)d_in[12]; p.b_router = (const float*)d_in[13]; p.w_gu = (const float*)d_in[14]; p.b_gu = (const float*)d_in[15]; p.w_down = (const float*)d_in[16]; p.b_down = (const float*)d_in[17];
    p.norm_final_g = (const float*)d_in[18]; p.out = (float*)d_out; p.ws = (unsigned char*)d_ws;
    void* args[] = {&p};
    hipError_t e = hipLaunchCooperativeKernel((const void*)fwd_kernel, dim3(grid), dim3(NTHREADS), args, LDS_BYTES, stream);
    if (e != hipSuccess) fprintf(stderr, "cooperative launch failed: %s (grid %d)\n", hipGetErrorString(e), grid);
}
```

```cpp
#include <hip/hip_runtime.h>
#include <hip/hip_cooperative_groups.h>
#include <cstdio>
#include <cstdint>
#include <hip/hip_bf16.h>
#include <cmath>
namespace cg = cooperative_groups;
#ifndef FUSED_GATHER
#define FUSED_GATHER 1
#endif
#ifndef PROBE_PHASE
#define PROBE_PHASE (-1)
#endif

constexpr int S = 16384, D = 1024, NIN = 3144, NP = 3328;
constexpr int CC = 512, CW = 31, NH = 8, HD = 64, NE = 32, DE = 1024;
constexpr int C_VAL = 0, C_GATE = 512, C_Q = 1024, C_K = 1536, C_V = 2048, C_QI = 2560, C_KI = 3072, C_WI = 3136;
constexpr int KSEL = 256;
constexpr float EPS = 1e-5f;
constexpr float C2 = 0.125f * 1.4426950408889634f;
constexpr int NTHREADS = 512, NWAVES = 8;
constexpr int MAXROWS = 65536 + NE * 256;
constexpr int MAXTILES = MAXROWS / 256;

constexpr size_t MiB = 1u << 20;
constexpr size_t WS_CTL = 0, CTL_BYTES = 1 * MiB;
constexpr size_t WS_WINT = 2 * MiB;
constexpr size_t WS_WOUTT = 9 * MiB;
constexpr size_t WS_WGRT = 11 * MiB;
constexpr size_t WS_COS = 12 * MiB;
constexpr size_t WS_SIN = 14 * MiB;
constexpr size_t WS_WGUT = 16 * MiB;
constexpr size_t WS_WDT = 144 * MiB;
constexpr size_t WS_XN = 208 * MiB;
constexpr size_t WS_PROJ = 240 * MiB;
constexpr size_t WS_MIX = 344 * MiB;
constexpr size_t WS_KI = 376 * MiB;
constexpr size_t WS_QL = 378 * MiB;
constexpr size_t WS_WI = 380 * MiB;
constexpr size_t WS_RSTD = 381 * MiB;
constexpr size_t WS_TOKOF = 382 * MiB;
constexpr size_t WS_GATEOF = 384 * MiB;
constexpr size_t WS_PAIR = 386 * MiB;
constexpr size_t WS_ROWRSTD = 387 * MiB;
constexpr size_t WS_ROWGATE = 388 * MiB;
constexpr size_t WS_ROWTOK = 389 * MiB;
constexpr size_t WS_MASK = 392 * MiB;
constexpr size_t WS_H2 = 424 * MiB;
constexpr size_t WS_XS = 488 * MiB;
constexpr size_t WS_HDN = 632 * MiB;
constexpr size_t WS_YS = 776 * MiB;
constexpr size_t WS_END = 920 * MiB;
constexpr int CW_CNT = 1024;
constexpr int CW_BAR = 4096;
constexpr int CW_KMAX = 2052;

constexpr int LDS_BYTES = 163840;
constexpr int LDS_LTOK = 147456;
constexpr int LDS_MISC = 131072;
constexpr int LDS_LRS = LDS_MISC + 4608;
constexpr int LDS_PROBE = LDS_MISC + 14336;

#define LAS __attribute__((address_space(3)))
typedef unsigned short bf16;
typedef unsigned long long u64;
typedef float f32x4 __attribute__((ext_vector_type(4)));
typedef unsigned u32x4 __attribute__((ext_vector_type(4)));

__device__ __forceinline__ float bf2f(unsigned v) { return __uint_as_float(v << 16); }
__device__ __forceinline__ unsigned f2bf(float f) { unsigned u = __float_as_uint(f); return (u + 0x7fffu + ((u >> 16) & 1u)) >> 16; }
typedef float f32x2_pk __attribute__((ext_vector_type(2))); typedef __bf16 bf16x2_pk __attribute__((ext_vector_type(2)));
__device__ __forceinline__ unsigned pk2(float lo, float hi) { const f32x2_pk v = {lo, hi}; return __builtin_bit_cast(unsigned, __builtin_convertvector(v, bf16x2_pk)); }
__device__ __forceinline__ float blo(unsigned w) { return __uint_as_float(w << 16); }
__device__ __forceinline__ float bhi(unsigned w) { return __uint_as_float(w & 0xffff0000u); }
__device__ __forceinline__ float wave_sum(float v) {
#pragma unroll
    for (int o = 1; o < 64; o <<= 1) v += __shfl_xor(v, o);
    return v;
}
__device__ __forceinline__ float wave_max(float v) {
#pragma unroll
    for (int o = 1; o < 64; o <<= 1) v = fmaxf(v, __shfl_xor(v, o));
    return v;
}
__device__ __forceinline__ int opaque_tid() { int t = threadIdx.x; asm volatile("" : "+v"(t)); return t; }
#if PROBE_PHASE >= 200
#define ISEC(k) do { __syncthreads(); if (blockIdx.x == 0 && tid == 0) { volatile LAS unsigned long long* st_ = (volatile LAS unsigned long long*)((LAS unsigned char*)lds + LDS_PROBE + 256); const unsigned long long now_ = __builtin_amdgcn_s_memrealtime(); st_[k] += now_ - st_[15]; st_[15] = now_; } } while (0)
#else
#define ISEC(k) do { } while (0)
#endif
__device__ __forceinline__ float sigmoidf_(float x) { return __builtin_amdgcn_rcpf(1.f + __expf(-x)); }

struct Params {
    const float* x; const int* pos; const float* norm_mix_g; const float* w_in; const float* idx_g; const float* idx_b;
    const float* conv_w; const float* conv_b; const float* conv_ng; const float* conv_nb; const float* w_out; const float* norm_ffn_g;
    const float* w_router; const float* b_router; const float* w_gu; const float* b_gu; const float* w_down; const float* b_down;
    const float* norm_final_g; float* out; unsigned char* ws;
};

template <bool KS = false> __device__ __forceinline__ void transpose_item(const float* W, int K, int N, bf16* WT, int dst_row0, int k0, int n0, float* scr, int lane, const float* ks = nullptr) {
    float v[32]; const int n = n0 + (lane & 31); const float* src = W + (size_t)(k0 + (lane >> 5)) * N + n;
#pragma unroll
    for (int i = 0; i < 32; ++i) v[i] = (n < N) ? src[(size_t)(2 * i) * N] : 0.f;
#pragma unroll
    for (int i = 0; i < 32; ++i) scr[(2 * i + (lane >> 5)) * 33 + (lane & 31)] = v[i];
    asm volatile("s_waitcnt lgkmcnt(0)" ::: "memory");
    const int c = lane & 7;
    f32x4 g0 = {1.f, 1.f, 1.f, 1.f}, g1 = g0; if (KS) { g0 = *(const f32x4*)(ks + k0 + 8 * c); g1 = *(const f32x4*)(ks + k0 + 8 * c + 4); }
#pragma unroll
    for (int j = 0; j < 4; ++j) { const int nn = (lane >> 3) + 8 * j; const float* s = scr + (8 * c) * 33 + nn;
        u32x4 o; o.x = pk2(s[0 * 33] * g0.x, s[1 * 33] * g0.y); o.y = pk2(s[2 * 33] * g0.z, s[3 * 33] * g0.w); o.z = pk2(s[4 * 33] * g1.x, s[5 * 33] * g1.y); o.w = pk2(s[6 * 33] * g1.z, s[7 * 33] * g1.w);
        *(u32x4*)(WT + (size_t)(dst_row0 + nn) * K + k0 + 8 * c) = o; }
    asm volatile("s_waitcnt lgkmcnt(0)" ::: "memory");
}

constexpr int PRO_I_DN = 16 * 32, PRO_DEFER_PER_WAVE = 4;
__device__ __forceinline__ int inproj_idle_c0(int G) { const int nwg = (S / 256) * (NP / 256), nr = (nwg + G - 1) / G; return nwg - (nr - 1) * G; }
__device__ __forceinline__ int deferred_items(int G) { const int idle = G - inproj_idle_c0(G); int q = idle * NWAVES * PRO_DEFER_PER_WAVE; return q < NE * PRO_I_DN ? q : NE * PRO_I_DN; }
__device__ __forceinline__ void down_item(const Params& p, int r, float* scr, int lane);
__device__ __forceinline__ void phase_prologue(const Params& p, unsigned char* lds) {
    const int tid = opaque_tid(), lane = tid & 63, wave = tid >> 6;
    const int gw = blockIdx.x * NWAVES + wave, NGW = gridDim.x * NWAVES;
    float* scr = (float*)(lds + wave * 16384);
    bf16* WinT = (bf16*)(p.ws + WS_WINT); bf16* WoutT = (bf16*)(p.ws + WS_WOUTT); bf16* WguT = (bf16*)(p.ws + WS_WGUT); bf16* WdT = (bf16*)(p.ws + WS_WDT);
    constexpr int I_IN = 16 * (NP / 32), I_OUT = 16 * 32, I_GU = 16 * 64, I_DN = PRO_I_DN;
    const int NITEMS = I_IN + I_OUT + NE * I_GU + NE * I_DN - deferred_items(gridDim.x);
    for (int it = gw; it < NITEMS; it += NGW) {
        int r = it;
        if (r < I_IN) { const int nb = r % (NP / 32), kb = r / (NP / 32); transpose_item(p.w_in, D, NIN, WinT, nb * 32, kb * 64, nb * 32, scr, lane); continue; }
        r -= I_IN;
        if (r < I_OUT) { const int nb = r % 32, kb = r / 32; transpose_item(p.w_out, D, D, WoutT, nb * 32, kb * 64, nb * 32, scr, lane); continue; }
        r -= I_OUT;
        if (r < NE * I_GU) { const int e = r / I_GU, q = r % I_GU, nb = q % 64, kb = q / 64; const int n0 = nb * 32;
            const int c = n0 & 1023, isu = n0 >> 10; const int drow = e * 2048 + (c >> 7) * 256 + isu * 128 + (c & 127);
            transpose_item<true>(p.w_gu + (size_t)e * D * 2048, D, 2048, WguT, drow - 0, kb * 64, n0, scr, lane, p.norm_ffn_g);
            continue; }
        r -= NE * I_GU;
        down_item(p, r, scr, lane);
    }
    for (int i = blockIdx.x * NTHREADS + tid; i < NE * D; i += gridDim.x * NTHREADS) { const int e = i / D, k = i % D; ((float*)(p.ws + WS_WGRT))[i] = p.norm_ffn_g[k] * p.w_router[k * NE + e]; }
    for (int i = blockIdx.x * NTHREADS + tid; i < NE * D; i += gridDim.x * NTHREADS) { const int k = i / NE; ((float*)(p.ws + WS_WGRT))[65536 + i] = p.norm_ffn_g[k] * p.w_router[i]; }
    for (int i = blockIdx.x * NTHREADS + tid; i < S * 32; i += gridDim.x * NTHREADS) { const int t = i >> 5, j = i & 31;
        const float inv = powf(10000.f, -(float)j / 32.f); const float ang = (float)p.pos[t] * inv;
        double xr = (double)ang * 0.15915494309189535; xr -= floor(xr); const float xf = (float)xr;
        ((float*)(p.ws + WS_COS))[i] = __builtin_amdgcn_cosf(xf); ((float*)(p.ws + WS_SIN))[i] = __builtin_amdgcn_sinf(xf); }
    bf16* XN = (bf16*)(p.ws + WS_XN);
    for (int m = gw; m < S; m += NGW) {
        const f32x4* xr = (const f32x4*)(p.x + (size_t)m * D) + lane; f32x4 v[4]; float ss = 0.f;
#pragma unroll
        for (int j = 0; j < 4; ++j) { v[j] = xr[64 * j]; ss += v[j].x * v[j].x + v[j].y * v[j].y + v[j].z * v[j].z + v[j].w * v[j].w; }
        const float rstd = rsqrtf(wave_sum(ss) * (1.f / D) + EPS);
        u64* o8 = (u64*)(XN + (size_t)m * D) + lane;
#pragma unroll
        for (int j = 0; j < 4; ++j) { const f32x4 g = ((const f32x4*)p.norm_mix_g)[lane + 64 * j];
            o8[64 * j] = (u64)pk2(v[j].x * rstd * g.x, v[j].y * rstd * g.y) | ((u64)pk2(v[j].z * rstd * g.z, v[j].w * rstd * g.w) << 32); }
    }
}

__device__ __forceinline__ void down_item(const Params& p, int r, float* scr, int lane) {
    const int e = r / PRO_I_DN, q = r % PRO_I_DN, nb = q % 32, kb = q / 32;
    transpose_item(p.w_down + (size_t)e * DE * D, DE, D, (bf16*)(p.ws + WS_WDT), e * D + nb * 32, kb * 64, nb * 32, scr, lane); }
__device__ __forceinline__ void phase_deferred_convert(const Params& p, unsigned char* lds) {
    const int G = gridDim.x, c0 = inproj_idle_c0(G), Q = deferred_items(G);
    if ((int)blockIdx.x < c0 || Q == 0) return;
    __syncthreads();
    const int tid = opaque_tid(), lane = tid & 63, wave = tid >> 6; float* scr = (float*)(lds + wave * 16384);
    const int nw = (G - c0) * NWAVES, first = NE * PRO_I_DN - Q;
    for (int i = ((int)blockIdx.x - c0) * NWAVES + wave; i < Q; i += nw) down_item(p, first + i, scr, lane);
}

namespace pg8 {
#define PG8_LAS __attribute__((address_space(3)))
typedef unsigned short bf16_t;
typedef short bf16x8 __attribute__((ext_vector_type(8)));
typedef float f32x4 __attribute__((ext_vector_type(4)));
typedef unsigned u32x4 __attribute__((ext_vector_type(4)));
constexpr int BM = 256, BK = 64, HALF = 128, HTB = HALF * BK * 2  , STAGE_BYTES = 8 * HTB, NXCD = 8, WGM = 8;

__host__ __device__ __forceinline__ int lds_byte(int r, int c) { const int st = (r >> 4) * 2 + (c >> 5), rr = r & 15, cc = c & 31, ob = rr * 64 + cc * 2; return st * 1024 + (ob ^ (((ob >> 9) & 1) << 5)); }
__host__ __device__ __forceinline__ void stage_rc(int b, int& R, int& C) { const int st = b / 1024, sb = b % 1024, swz = sb ^ (((sb >> 9) & 1) << 5); R = (st >> 1) * 16 + swz / 64; C = (st & 1) * 32 + (swz % 64) / 2; }
__host__ __device__ __forceinline__ int perm32(int rho) { const int n = rho >> 4, i = rho & 15; return 8 * (i >> 2) + 4 * n + (i & 3); }

struct Unit { int pm, pn, ui; };
struct Gemm { const bf16_t* A; const bf16_t* Bt; int M, N, K; };

struct StaticOrder {
    int nM, nN, nwg, G, c;
    __host__ __device__ void init(int M, int N, int G_, int c_) { nM = M / BM; nN = N / BM; nwg = nM * nN; G = G_; c = c_; }
    __host__ __device__ bool next(int i, Unit& u) const { const long L = (long)i * G + c; if (!map(L, u)) return false; u.ui = i; return true; }
    __host__ __device__ bool map(long L, Unit& u) const {
        if (L >= nwg) return false;
        int wgid = (int)L; { const int q = nwg / NXCD, r = nwg % NXCD, xcd = wgid % NXCD, off = wgid / NXCD; wgid = (xcd < r ? xcd * (q + 1) : r * (q + 1) + (xcd - r) * q) + off; }
        const int nig = WGM * nN, gid = wgid / nig, fm = gid * WGM, gsz = (nM - fm) < WGM ? (nM - fm) : WGM;
        u.pm = fm + ((wgid % nig) % gsz); u.pn = (wgid % nig) / gsz; u.ui = 0; return true;
    }
    __device__ __forceinline__ int bidx(const Unit& u) const { return u.pn; }
    __device__ __forceinline__ void a_ready(const Unit&) const {}
    __device__ __forceinline__ void done(const Unit&) const {}
};
template <class Epi, class Sched, bool ALIGN_EPI = false, bool SP2 = false, bool GATHER = false>
__device__ __forceinline__ void gemm_phase(PG8_LAS unsigned char* lds, const Gemm g, const Sched& S, const Epi& E) {
    static_assert(!GATHER || SP2, "GATHER is written for the SP2 loop");
    int tid_ = threadIdx.x; asm volatile("" : "+v"(tid_));
    const int tid = tid_, wid = __builtin_amdgcn_readfirstlane(tid >> 6), lane = tid & 63, wr = wid >> 2, wc = wid & 3, fr = lane & 15, fq = lane >> 4;
    const int K = g.K, nt = K / BK;
    unsigned voffA[2], voffB[2], gC[2]; int gR[2];
#pragma unroll
    for (int i = 0; i < 2; ++i) { int R, C; stage_rc(tid * 16 + i * 8192, R, C); const int Rb = Epi::PERM ? ((R & ~31) + perm32(R & 31)) : R;
        voffA[i] = (unsigned)(R * K + C) * 2u; voffB[i] = (unsigned)(Rb * K + C) * 2u; gR[i] = R; gC[i] = (unsigned)C * 2u; }
    unsigned vc[2][2] = {{0u, 0u}, {0u, 0u}}, vn[2][2] = {{0u, 0u}, {0u, 0u}};
#define PG8_GOFF(dst, uidx) do { _Pragma("unroll") for (int h_ = 0; h_ < 2; ++h_) _Pragma("unroll") for (int i_ = 0; i_ < 2; ++i_) dst[h_][i_] = (unsigned)S.rowtok((uidx), h_ * 128 + gR[i_]) * (unsigned)(K * 2) + gC[i_]; } while (0)
    const size_t kstep = (size_t)(BK * 2);
    const size_t hstep = (size_t)HALF * K * 2;
    const size_t tstep = 2 * hstep;
    const unsigned ldsw = (unsigned)wid * 1024u;
    const int aoff = lds_byte(wr * 64 + fr, fq * 8), boff = lds_byte(wc * 32 + fr, fq * 8);
#define PG8_SA(b, h) (((b) * 2 + (h)) * HTB)
#define PG8_SB(b, h) ((4 + (b) * 2 + (h)) * HTB)
#define PG8_STAGE(bufoff, gbase, voff) do { _Pragma("unroll") for (int _i = 0; _i < 2; ++_i) \
        __builtin_amdgcn_global_load_lds((const unsigned*)((const char*)(gbase) + (voff)[_i]), (PG8_LAS unsigned*)(lds + (bufoff) + ldsw + _i * 8192), 16, 0, 0); } while (0)
#define PG8_STAGE_AG(bufoff, kb, v0, v1) do { \
        __builtin_amdgcn_global_load_lds((const unsigned*)((const char*)g.A + (kb) + (v0)), (PG8_LAS unsigned*)(lds + (bufoff) + ldsw), 16, 0, 0); \
        __builtin_amdgcn_global_load_lds((const unsigned*)((const char*)g.A + (kb) + (v1)), (PG8_LAS unsigned*)(lds + (bufoff) + ldsw + 8192), 16, 0, 0); } while (0)
#define PG8_LDA(dst, b, h) do { _Pragma("unroll") for (int m = 0; m < 4; ++m) _Pragma("unroll") for (int k = 0; k < 2; ++k) dst[m][k] = *(const PG8_LAS bf16x8*)(lds + PG8_SA(b, h) + aoff + m * 2048 + k * 1024); } while (0)
#define PG8_LDB(dst, b, h) do { _Pragma("unroll") for (int n = 0; n < 2; ++n) _Pragma("unroll") for (int k = 0; k < 2; ++k) dst[n][k] = *(const PG8_LAS bf16x8*)(lds + PG8_SB(b, h) + boff + n * 2048 + k * 1024); } while (0)
#define PG8_MMA(ai, bj, At, Bt) do { __builtin_amdgcn_s_setprio(1); _Pragma("unroll") for (int m = 0; m < 4; ++m) _Pragma("unroll") for (int n = 0; n < 2; ++n) _Pragma("unroll") for (int k = 0; k < 2; ++k) \
        acc[ai][bj][m][n] = __builtin_amdgcn_mfma_f32_16x16x32_bf16(Bt[n][k], At[m][k], acc[ai][bj][m][n], 0, 0, 0); __builtin_amdgcn_s_setprio(0); } while (0)
#define PG8_WAIT_V(n) asm volatile("s_waitcnt vmcnt(" #n ")" ::: "memory")
#define PG8_WAIT_L(n) asm volatile("s_waitcnt lgkmcnt(" #n ")" ::: "memory")
#define PG8_BAR __builtin_amdgcn_s_barrier()
#define PG8_SCHED __builtin_amdgcn_sched_barrier(0)
    Unit cur, nxt; int ui = 0;
    if (!S.next(0, cur)) return;
    f32x4 acc[2][2][4][2];
#pragma unroll
    for (int a = 0; a < 2; ++a)
#pragma unroll
        for (int b = 0; b < 2; ++b)
#pragma unroll
            for (int m = 0; m < 4; ++m)
#pragma unroll
                for (int n = 0; n < 2; ++n) acc[a][b][m][n] = (f32x4){0.f, 0.f, 0.f, 0.f};
    bf16x8 At[4][2], B0[2][2], B1[2][2];
    const char* cA = (const char*)g.A + (size_t)cur.pm * tstep; const char* cB = (const char*)g.Bt + (size_t)S.bidx(cur) * tstep;
    S.a_ready(cur);
    if constexpr (SP2) {
        if constexpr (GATHER) { PG8_GOFF(vc, 0); }
        PG8_STAGE(PG8_SB(0, 0), cB, voffB); PG8_STAGE(PG8_SB(0, 1), cB + hstep, voffB);
        if constexpr (GATHER) { PG8_STAGE_AG(PG8_SA(0, 0), (size_t)0, vc[0][0], vc[0][1]); PG8_STAGE_AG(PG8_SA(0, 1), (size_t)0, vc[1][0], vc[1][1]); } else { PG8_STAGE(PG8_SA(0, 0), cA, voffA); PG8_STAGE(PG8_SA(0, 1), cA + hstep, voffA); }
        if (wr == 1) PG8_BAR;
        PG8_WAIT_V(2); PG8_BAR;
        PG8_STAGE(PG8_SB(1, 0), cB + kstep, voffB); if constexpr (GATHER) { PG8_STAGE_AG(PG8_SA(1, 0), kstep, vc[0][0], vc[0][1]); } else { PG8_STAGE(PG8_SA(1, 0), cA + kstep, voffA); } PG8_STAGE(PG8_SB(1, 1), cB + hstep + kstep, voffB);
        PG8_WAIT_V(6); PG8_BAR;
    } else {
        PG8_STAGE(PG8_SB(0, 0), cB, voffB); PG8_STAGE(PG8_SA(0, 0), cA, voffA); PG8_STAGE(PG8_SB(0, 1), cB + hstep, voffB); PG8_STAGE(PG8_SA(0, 1), cA + hstep, voffA);
        if (wr == 1) PG8_BAR;
        PG8_WAIT_V(4); PG8_BAR;
        PG8_STAGE(PG8_SB(1, 0), cB + kstep, voffB); PG8_STAGE(PG8_SA(1, 0), cA + kstep, voffA); PG8_STAGE(PG8_SB(1, 1), cB + hstep + kstep, voffB);
        PG8_WAIT_V(6); PG8_BAR;
    }
    for (;;) {
        const bool has_next = S.next(ui + 1, nxt);
        if constexpr (GATHER) { if (has_next) { PG8_GOFF(vn, ui + 1); } }
        const char* nA = has_next ? (const char*)g.A + (size_t)nxt.pm * tstep : cA; const char* nB = has_next ? (const char*)g.Bt + (size_t)S.bidx(nxt) * tstep : cB;
        for (int t = 0; t < nt; t += 2) {
            const bool last = (t == nt - 2);
            const char* a1 = cA + (size_t)(t + 1) * kstep;
            const char* a2 = last ? nA : cA + (size_t)(t + 2) * kstep; const char* b2 = last ? nB : cB + (size_t)(t + 2) * kstep;
            const char* a3 = a2 + kstep; const char* b3 = b2 + kstep;
            if (last && has_next) S.a_ready(nxt);
            const bool un_ = last && has_next; const size_t k1_ = (size_t)(t + 1) * kstep, k2_ = last ? (size_t)0 : (size_t)(t + 2) * kstep, k3_ = k2_ + kstep;
            const unsigned w00 = un_ ? vn[0][0] : vc[0][0], w01 = un_ ? vn[0][1] : vc[0][1], w10 = un_ ? vn[1][0] : vc[1][0], w11 = un_ ? vn[1][1] : vc[1][1];
            if constexpr (SP2) {
            PG8_LDB(B0, 0, 0); PG8_LDB(B1, 0, 1); PG8_SCHED; PG8_LDA(At, 0, 0); if constexpr (GATHER) { PG8_STAGE_AG(PG8_SA(1, 1), k1_, vc[1][0], vc[1][1]); } else { PG8_STAGE(PG8_SA(1, 1), a1 + hstep, voffA); }
            PG8_WAIT_V(8); PG8_WAIT_L(0); PG8_BAR; PG8_MMA(0, 0, At, B0); PG8_MMA(0, 1, At, B1); PG8_BAR; PG8_SCHED;
            PG8_LDA(At, 0, 1); PG8_STAGE(PG8_SB(0, 0), b2, voffB); PG8_STAGE(PG8_SB(0, 1), b2 + hstep, voffB); if constexpr (GATHER) { PG8_STAGE_AG(PG8_SA(0, 0), k2_, w00, w01); } else { PG8_STAGE(PG8_SA(0, 0), a2, voffA); }
            PG8_WAIT_V(8); PG8_WAIT_L(0); PG8_BAR; PG8_MMA(1, 0, At, B0); PG8_MMA(1, 1, At, B1); PG8_BAR; PG8_SCHED;
            PG8_LDB(B0, 1, 0); PG8_LDB(B1, 1, 1); PG8_SCHED; PG8_LDA(At, 1, 0); if constexpr (GATHER) { PG8_STAGE_AG(PG8_SA(0, 1), k2_, w10, w11); } else { PG8_STAGE(PG8_SA(0, 1), a2 + hstep, voffA); }
            PG8_WAIT_V(8); PG8_WAIT_L(0); PG8_BAR; PG8_MMA(0, 0, At, B0); PG8_MMA(0, 1, At, B1); PG8_BAR; PG8_SCHED;
            PG8_LDA(At, 1, 1); PG8_STAGE(PG8_SB(1, 0), b3, voffB); PG8_STAGE(PG8_SB(1, 1), b3 + hstep, voffB); if constexpr (GATHER) { PG8_STAGE_AG(PG8_SA(1, 0), k3_, w00, w01); } else { PG8_STAGE(PG8_SA(1, 0), a3, voffA); }
            PG8_WAIT_V(8); PG8_WAIT_L(0); PG8_BAR; PG8_MMA(1, 0, At, B0); PG8_MMA(1, 1, At, B1); PG8_BAR; PG8_SCHED;
            } else {
            PG8_LDB(B0, 0, 0); PG8_SCHED; PG8_LDA(At, 0, 0); PG8_STAGE(PG8_SA(1, 1), a1 + hstep, voffA);
            PG8_WAIT_L(8); PG8_BAR; PG8_WAIT_L(0); PG8_MMA(0, 0, At, B0); PG8_BAR; PG8_SCHED;
            PG8_LDB(B1, 0, 1); PG8_STAGE(PG8_SB(0, 0), b2, voffB);
            PG8_BAR; PG8_WAIT_L(0); PG8_MMA(0, 1, At, B1); PG8_BAR;
            PG8_LDA(At, 0, 1); PG8_STAGE(PG8_SA(0, 0), a2, voffA);
            PG8_BAR; PG8_WAIT_L(0); PG8_MMA(1, 0, At, B0); PG8_BAR; PG8_SCHED;
            PG8_STAGE(PG8_SB(0, 1), b2 + hstep, voffB);
            PG8_WAIT_V(6); PG8_BAR; PG8_MMA(1, 1, At, B1); PG8_BAR;
            PG8_LDB(B0, 1, 0); PG8_SCHED; PG8_LDA(At, 1, 0); PG8_STAGE(PG8_SA(0, 1), a2 + hstep, voffA);
            PG8_WAIT_L(8); PG8_BAR; PG8_WAIT_L(0); PG8_MMA(0, 0, At, B0); PG8_BAR; PG8_SCHED;
            PG8_LDB(B1, 1, 1); PG8_STAGE(PG8_SB(1, 0), b3, voffB);
            PG8_BAR; PG8_WAIT_L(0); PG8_MMA(0, 1, At, B1); PG8_BAR;
            PG8_LDA(At, 1, 1); PG8_STAGE(PG8_SA(1, 0), a3, voffA);
            PG8_BAR; PG8_WAIT_L(0); PG8_MMA(1, 0, At, B0); PG8_BAR; PG8_SCHED;
            PG8_STAGE(PG8_SB(1, 1), b3 + hstep, voffB);
            PG8_WAIT_V(6); PG8_BAR; PG8_MMA(1, 1, At, B1); PG8_BAR;
            }
        }
        if constexpr (ALIGN_EPI) { if (wr == 0) PG8_BAR; }
        if constexpr (!Epi::AFTER_DRAIN) { E(acc, cur, wr, wc, fr, fq); S.done(cur); }
        if (!has_next) break;
#pragma unroll
        for (int a = 0; a < 2; ++a)
#pragma unroll
            for (int b = 0; b < 2; ++b)
#pragma unroll
                for (int m = 0; m < 4; ++m)
#pragma unroll
                    for (int n = 0; n < 2; ++n) acc[a][b][m][n] = (f32x4){0.f, 0.f, 0.f, 0.f};
        cur = nxt; cA = nA; cB = nB; ++ui;
        if constexpr (GATHER) { vc[0][0] = vn[0][0]; vc[0][1] = vn[0][1]; vc[1][0] = vn[1][0]; vc[1][1] = vn[1][1]; }
        if constexpr (ALIGN_EPI) { if (wr == 1) PG8_BAR; }
    }
    PG8_WAIT_V(0);
    if constexpr (!ALIGN_EPI) { if (wr == 0) PG8_BAR; }
    PG8_BAR;
    if constexpr (Epi::AFTER_DRAIN) { E.fused(acc, cur, wr, wc, fr, fq, lds, wid, lane); S.done(cur); }
#undef PG8_SA
#undef PG8_SB
#undef PG8_STAGE
#undef PG8_LDA
#undef PG8_STAGE_AG
#undef PG8_GOFF
#undef PG8_LDB
#undef PG8_MMA
#undef PG8_WAIT_V
#undef PG8_WAIT_L
#undef PG8_BAR
#undef PG8_SCHED
}
}

template <class Epi>
__device__ __forceinline__ void ngemm_unit(unsigned char* lds, const bf16* A, int lda, const bf16* Bt, int ldb, int K, const Epi& epi, const pg8::Unit& u) {
    float* As = (float*)lds; float* Bs = As + 32 * 256;
    const int tid = opaque_tid(), tr = tid >> 4, tc = tid & 15;
    float acc0[8][8], acc1[8][8];
#pragma unroll
    for (int i = 0; i < 8; ++i)
#pragma unroll
        for (int j = 0; j < 8; ++j) { acc0[i][j] = 0.f; acc1[i][j] = 0.f; }
    for (int k0 = 0; k0 < K; k0 += 32) {
        __syncthreads();
#pragma unroll
        for (int j = 0; j < 2; ++j) { const int pidx = tid + 512 * j, r = pidx & 255, kq = pidx >> 8;
            const u32x4 va = *(const u32x4*)(A + (size_t)r * lda + k0 + kq * 8);
            const u32x4 vb = *(const u32x4*)(Bt + (size_t)r * ldb + k0 + kq * 8);
            float* ap = As + (kq * 8) * 256 + r; float* bp = Bs + (kq * 8) * 256 + r;
            ap[0 * 256] = blo(va.x); ap[1 * 256] = bhi(va.x); ap[2 * 256] = blo(va.y); ap[3 * 256] = bhi(va.y); ap[4 * 256] = blo(va.z); ap[5 * 256] = bhi(va.z); ap[6 * 256] = blo(va.w); ap[7 * 256] = bhi(va.w);
            bp[0 * 256] = blo(vb.x); bp[1 * 256] = bhi(vb.x); bp[2 * 256] = blo(vb.y); bp[3 * 256] = bhi(vb.y); bp[4 * 256] = blo(vb.z); bp[5 * 256] = bhi(vb.z); bp[6 * 256] = blo(vb.w); bp[7 * 256] = bhi(vb.w); }
        __syncthreads();
#pragma unroll 2
        for (int kk = 0; kk < 32; ++kk) {
            const f32x4 a0 = *(const f32x4*)(As + kk * 256 + tr * 8), a1 = *(const f32x4*)(As + kk * 256 + tr * 8 + 4);
            const f32x4 b00 = *(const f32x4*)(Bs + kk * 256 + tc * 8), b01 = *(const f32x4*)(Bs + kk * 256 + tc * 8 + 4);
            const f32x4 b10 = *(const f32x4*)(Bs + kk * 256 + 128 + tc * 8), b11 = *(const f32x4*)(Bs + kk * 256 + 128 + tc * 8 + 4);
            const float a[8] = {a0.x, a0.y, a0.z, a0.w, a1.x, a1.y, a1.z, a1.w};
            const float b0[8] = {b00.x, b00.y, b00.z, b00.w, b01.x, b01.y, b01.z, b01.w};
            const float b1[8] = {b10.x, b10.y, b10.z, b10.w, b11.x, b11.y, b11.z, b11.w};
#pragma unroll
            for (int i = 0; i < 8; ++i)
#pragma unroll
                for (int j = 0; j < 8; ++j) { acc0[i][j] = fmaf(a[i], b0[j], acc0[i][j]); acc1[i][j] = fmaf(a[i], b1[j], acc1[i][j]); }
        }
    }
    { const typename Epi::Ctx ctx = epi.prep(u, tc * 8);
#pragma unroll
    for (int i = 0; i < 8; ++i) epi(ctx, u, tr * 8 + i, tc * 8, acc0[i], acc1[i]); }
}

__device__ __forceinline__ void store8_bf16(bf16* dst, const float (&v)[8]) {
    u32x4 o; o.x = pk2(v[0], v[1]); o.y = pk2(v[2], v[3]); o.z = pk2(v[4], v[5]); o.w = pk2(v[6], v[7]); *(u32x4*)dst = o;
}

typedef pg8::Unit Unit;
struct EpiProj { bf16* O; struct Ctx {};
    __device__ __forceinline__ Ctx prep(const Unit&, int) const { return Ctx{}; }
    __device__ __forceinline__ void operator()(const Ctx&, const Unit& u, int r, int c8, const float (&v0)[8], const float (&v1)[8]) const {
        bf16* row = O + (size_t)(u.pm * 256 + r) * NP + u.pn * 256 + c8; store8_bf16(row, v0); store8_bf16(row + 128, v1); } };
struct Col16 { float a[8], b[8]; };
__device__ __forceinline__ Col16 load_col16(const float* p0, const float* p1) { const f32x4 a0 = *(const f32x4*)p0, a1 = *(const f32x4*)(p0 + 4), b0 = *(const f32x4*)p1, b1 = *(const f32x4*)(p1 + 4);
    return Col16{{a0.x, a0.y, a0.z, a0.w, a1.x, a1.y, a1.z, a1.w}, {b0.x, b0.y, b0.z, b0.w, b1.x, b1.y, b1.z, b1.w}}; }
struct EpiOut { const float* x; bf16* H2B; struct Ctx {};
    __device__ __forceinline__ Ctx prep(const Unit&, int) const { return Ctx{}; }
    __device__ __forceinline__ void operator()(const Ctx&, const Unit& u, int r, int c8, const float (&v0)[8], const float (&v1)[8]) const {
        const int col = u.pn * 256 + c8; const size_t off = (size_t)(u.pm * 256 + r) * D + col; float h0[8], h1[8];
        const Col16 xs = load_col16(x + off, x + off + 128);
#pragma unroll
        for (int i = 0; i < 8; ++i) { h0[i] = xs.a[i] + v0[i]; h1[i] = xs.b[i] + v1[i]; }
        store8_bf16(H2B + off, h0); store8_bf16(H2B + off + 128, h1); } };
struct EpiGU { const float* bgu; const LAS float* rowrstd; bf16* HDN; const LAS int* tile_e; typedef Col16 Ctx;
    __device__ __forceinline__ Ctx prep(const Unit& u, int c8) const { const float* bg = bgu + tile_e[u.pm] * 2048 + u.pn * 128 + c8; return load_col16(bg, bg + 1024); }
    __device__ __forceinline__ void operator()(const Ctx& b, const Unit& u, int r, int c8, const float (&v0)[8], const float (&v1)[8]) const {
        const int row = u.pm * 256 + r; const float rs = rowrstd[u.ui * 256 + r]; const int cb = u.pn * 128 + c8; float h[8];
#pragma unroll
        for (int i = 0; i < 8; ++i) { float g = v0[i] * rs + b.a[i]; float uu = v1[i] * rs + b.b[i];
            g = fminf(g, 7.f); uu = fminf(fmaxf(uu, -7.f), 7.f); h[i] = g * sigmoidf_(1.702f * g) * (uu + 1.f); }
        store8_bf16(HDN + (size_t)row * DE + cb, h); } };
struct EpiDown { const float* bd; const LAS float* rowgate; bf16* YS; const LAS int* tile_e; typedef Col16 Ctx;
    __device__ __forceinline__ Ctx prep(const Unit& u, int c8) const { const float* bp = bd + tile_e[u.pm] * D + u.pn * 256 + c8; return load_col16(bp, bp + 128); }
    __device__ __forceinline__ void operator()(const Ctx& b, const Unit& u, int r, int c8, const float (&v0)[8], const float (&v1)[8]) const {
        const int row = u.pm * 256 + r; const float gt = rowgate[u.ui * 256 + r]; const int cb = u.pn * 256 + c8; float y0[8], y1[8];
#pragma unroll
        for (int i = 0; i < 8; ++i) { y0[i] = (v0[i] + b.a[i]) * gt; y1[i] = (v1[i] + b.b[i]) * gt; }
        store8_bf16(YS + (size_t)row * D + cb, y0); store8_bf16(YS + (size_t)row * D + cb + 128, y1); } };

template <class F> struct EpiAdapt {
    static constexpr bool PERM = true, AFTER_DRAIN = false; F f;
    __device__ __forceinline__ void operator()(const f32x4 (&acc)[2][2][4][2], const Unit& u, int wr, int wc, int fr, int fq) const {
        const typename F::Ctx ctx = f.prep(u, wc * 32 + fq * 8);
#pragma unroll
        for (int ai = 0; ai < 2; ++ai)
#pragma unroll
            for (int m = 0; m < 4; ++m) { const int r = ai * 128 + wr * 64 + m * 16 + fr, c8 = wc * 32 + fq * 8;
                const f32x4 a = acc[ai][0][m][0], b = acc[ai][0][m][1], c = acc[ai][1][m][0], d = acc[ai][1][m][1];
                const float v0[8] = {a.x, a.y, a.z, a.w, b.x, b.y, b.z, b.w}, v1[8] = {c.x, c.y, c.z, c.w, d.x, d.y, d.z, d.w};
                f(ctx, u, r, c8, v0, v1); }
    }
};
struct MoeOrder { pg8::StaticOrder so; const LAS int* tile_e; int ncol; const LAS int* ltok;
    __device__ __forceinline__ bool next(int i, Unit& u) const { return so.next(i, u); }
    __device__ __forceinline__ int bidx(const Unit& u) const { return tile_e[u.pm] * ncol + u.pn; }
    __device__ __forceinline__ int rowtok(int ui, int r) const { return ltok[ui * 256 + r]; }
    __device__ __forceinline__ void a_ready(const Unit&) const {}
    __device__ __forceinline__ void done(const Unit&) const {} };
__device__ __forceinline__ void phase_ew_naive(const Params& p, unsigned char* lds) {
    const int tid = opaque_tid(), lane = tid & 63, wave = tid >> 6;
    bf16* PROJ = (bf16*)(p.ws + WS_PROJ); bf16* MIX = (bf16*)(p.ws + WS_MIX); bf16* KI = (bf16*)(p.ws + WS_KI); bf16* QL = (bf16*)(p.ws + WS_QL); float* WI = (float*)(p.ws + WS_WI);
    const float* COS = (const float*)(p.ws + WS_COS); const float* SIN = (const float*)(p.ws + WS_SIN);
    float* red = (float*)(lds);
    for (int t = blockIdx.x; t < S; t += gridDim.x) {
        const int c = tid; float acc = p.conv_b[c];
        for (int j = 0; j < CW; ++j) { const int tt = t - (CW - 1) + j; if (tt >= 0) { const float val = bf2f(PROJ[(size_t)tt * NP + C_VAL + c]), gate = bf2f(PROJ[(size_t)tt * NP + C_GATE + c]);
                acc = fmaf(p.conv_w[j * CC + c], val * sigmoidf_(gate), acc); } }
        const int hh = (tid & 255) >> 5, ii = tid & 31; const int qkbase = (tid < 256) ? C_Q : C_K;
        const float cs = COS[t * 32 + ii], sn = SIN[t * 32 + ii];
        const float x1 = bf2f(PROJ[(size_t)t * NP + qkbase + hh * 64 + ii]), x2 = bf2f(PROJ[(size_t)t * NP + qkbase + hh * 64 + 32 + ii]);
        float qi1 = 0.f, qi2 = 0.f; if (tid < 256) { qi1 = bf2f(PROJ[(size_t)t * NP + C_QI + hh * 64 + ii]); qi2 = bf2f(PROJ[(size_t)t * NP + C_QI + hh * 64 + 32 + ii]); }
        float kiv = 0.f, qlv = 0.f;
        if (wave == 4) kiv = bf2f(PROJ[(size_t)t * NP + C_KI + lane]);
        if (wave == 5) { for (int h = 0; h < 8; ++h) qlv = fmaf(bf2f(PROJ[(size_t)t * NP + C_WI + h]), bf2f(PROJ[(size_t)t * NP + C_QI + h * 64 + lane]), qlv); }
        float wiv = 0.f; if (wave == 6 && lane < 8) wiv = bf2f(PROJ[(size_t)t * NP + C_WI + lane]);
        float s1 = wave_sum(acc); if (lane == 0) red[wave] = s1; __syncthreads();
        float mean = 0.f;
#pragma unroll
        for (int w = 0; w < 8; ++w) mean += red[w];
        mean *= (1.f / CC); const float dv = acc - mean; float s2 = wave_sum(dv * dv); if (lane == 0) red[8 + wave] = s2; __syncthreads();
        float var = 0.f;
#pragma unroll
        for (int w = 0; w < 8; ++w) var += red[8 + w];
        var *= (1.f / CC);
        const float y = dv * rsqrtf(var + EPS) * p.conv_ng[c] + p.conv_nb[c];
        MIX[(size_t)t * D + c] = (bf16)f2bf(y * sigmoidf_(y));
        { const float sc = (tid < 256) ? C2 : 1.f; PROJ[(size_t)t * NP + qkbase + hh * 64 + ii] = (bf16)f2bf((x1 * cs - x2 * sn) * sc); PROJ[(size_t)t * NP + qkbase + hh * 64 + 32 + ii] = (bf16)f2bf((x2 * cs + x1 * sn) * sc); }
        if (tid < 256) { PROJ[(size_t)t * NP + C_QI + hh * 64 + ii] = (bf16)f2bf(qi1 * cs - qi2 * sn); PROJ[(size_t)t * NP + C_QI + hh * 64 + 32 + ii] = (bf16)f2bf(qi2 * cs + qi1 * sn); }
        if (wave == 4) { const float m = wave_sum(kiv) * (1.f / 64.f); const float d = kiv - m; const float vr = wave_sum(d * d) * (1.f / 64.f);
            const float yk = d * rsqrtf(vr + EPS) * p.idx_g[lane] + p.idx_b[lane]; const float other = __shfl_xor(yk, 32);
            const float c_ = COS[t * 32 + (lane & 31)], s_ = SIN[t * 32 + (lane & 31)];
            KI[(size_t)t * 64 + lane] = (bf16)f2bf(lane < 32 ? (yk * c_ - other * s_) : (yk * c_ + other * s_)); }
        if (wave == 5) { const float other = __shfl_xor(qlv, 32); const float c_ = COS[t * 32 + (lane & 31)], s_ = SIN[t * 32 + (lane & 31)];
            QL[(size_t)t * 64 + lane] = (bf16)f2bf(lane < 32 ? (qlv * c_ - other * s_) : (qlv * c_ + other * s_)); }
        if (wave == 6 && lane < 8) WI[t * 8 + lane] = wiv;
        __syncthreads();
    }
}

__device__ __forceinline__ void phase_ew_fast(const Params& p, unsigned char* lds) {
    const int tid = opaque_tid(), lane = tid & 63, wave = tid >> 6;
    bf16* PROJ = (bf16*)(p.ws + WS_PROJ); bf16* MIX = (bf16*)(p.ws + WS_MIX); bf16* KI = (bf16*)(p.ws + WS_KI); bf16* QL = (bf16*)(p.ws + WS_QL); float* WI = (float*)(p.ws + WS_WI);
    const float* COS = (const float*)(p.ws + WS_COS); const float* SIN = (const float*)(p.ws + WS_SIN);
    LAS unsigned char* L = (LAS unsigned char*)lds;
    LAS unsigned* U = (LAS unsigned*)L;
    LAS float* RED = (LAS float*)(L + 65536);
    const int cp = tid & 255, g = tid >> 8, wv_ = wave & 3;
    typedef float f32x2 __attribute__((ext_vector_type(2))); f32x2 wv[CW];
#pragma unroll
    for (int j = 0; j < CW; ++j) { const float2 ww = *(const float2*)(p.conv_w + j * CC + 2 * cp); wv[j] = (f32x2){ww.x, ww.y}; }
    const float2 cb = *(const float2*)(p.conv_b + 2 * cp), ng = *(const float2*)(p.conv_ng + 2 * cp), nb = *(const float2*)(p.conv_nb + 2 * cp);
    float kmx = 0.f;
    for (int unit = blockIdx.x; unit < S / 32; unit += gridDim.x) {
        const int t0 = unit * 32;
        __syncthreads();
        ISEC(6);
#pragma unroll 2
        for (int it = tid; it < 62 * 64; it += NTHREADS) { const int row = it >> 6, c8 = (it & 63) * 8, tt = t0 - 30 + row; u32x4 o = (u32x4){0u, 0u, 0u, 0u};
            if (tt >= 0) { const u32x4 va = *(const u32x4*)(PROJ + (size_t)tt * NP + C_VAL + c8), ga = *(const u32x4*)(PROJ + (size_t)tt * NP + C_GATE + c8);
                o.x = pk2(blo(va.x) * sigmoidf_(blo(ga.x)), bhi(va.x) * sigmoidf_(bhi(ga.x))); o.y = pk2(blo(va.y) * sigmoidf_(blo(ga.y)), bhi(va.y) * sigmoidf_(bhi(ga.y)));
                o.z = pk2(blo(va.z) * sigmoidf_(blo(ga.z)), bhi(va.z) * sigmoidf_(bhi(ga.z))); o.w = pk2(blo(va.w) * sigmoidf_(blo(ga.w)), bhi(va.w) * sigmoidf_(bhi(ga.w))); }
            *(LAS u32x4*)(L + (size_t)row * 1024 + c8 * 2) = o; }
        __syncthreads();
        ISEC(12);
        f32x2 acc[16];
#pragma unroll
        for (int tt = 0; tt < 16; ++tt) acc[tt] = (f32x2){cb.x, cb.y};
#pragma unroll
        for (int r = 0; r < 46; ++r) { const unsigned x = U[(g * 16 + r) * 256 + cp]; const f32x2 xv = (f32x2){blo(x), bhi(x)};
#pragma unroll
            for (int tt = 0; tt < 16; ++tt) { const int j = r - tt; if (j >= 0 && j < CW) acc[tt] = __builtin_elementwise_fma(wv[j], xv, acc[tt]); } }
#pragma unroll
        for (int tt = 0; tt < 16; ++tt) { const f32x2 a = acc[tt]; const float s1 = wave_sum(a.x + a.y), s2 = wave_sum(a.x * a.x + a.y * a.y);
            if (lane == 0) { RED[((g * 16 + tt) * 4 + wv_) * 2] = s1; RED[((g * 16 + tt) * 4 + wv_) * 2 + 1] = s2; } }
        __syncthreads();
#pragma unroll
        for (int tt = 0; tt < 16; ++tt) { const LAS f32x4* rp = (const LAS f32x4*)(RED + (g * 16 + tt) * 8); const f32x4 ra = rp[0], rb = rp[1];
            const float mean = (ra.x + ra.z + rb.x + rb.z) * (1.f / CC), var = (ra.y + ra.w + rb.y + rb.w) * (1.f / CC) - mean * mean, rstd = rsqrtf(fmaxf(var, 0.f) + EPS);
            const float y0 = (acc[tt].x - mean) * rstd * ng.x + nb.x, y1 = (acc[tt].y - mean) * rstd * ng.y + nb.y;
            *(unsigned*)(MIX + (size_t)(t0 + g * 16 + tt) * D + 2 * cp) = pk2(y0 * sigmoidf_(y0), y1 * sigmoidf_(y1)); }
        ISEC(13);
        { const int tl = (lane >> 3) & 3, dc = lane & 7, t = t0 + wave * 4 + tl; const bf16* prow = PROJ + (size_t)t * NP;
            const u32x4 kraw = *(const u32x4*)(prow + C_KI + dc * 8); const u32x4 wraw = *(const u32x4*)(prow + C_WI);
            const float wf[8] = {blo(wraw.x), bhi(wraw.x), blo(wraw.y), bhi(wraw.y), blo(wraw.z), bhi(wraw.z), blo(wraw.w), bhi(wraw.w)};
            float kv[8] = {blo(kraw.x), bhi(kraw.x), blo(kraw.y), bhi(kraw.y), blo(kraw.z), bhi(kraw.z), blo(kraw.w), bhi(kraw.w)}, qv[8] = {0.f, 0.f, 0.f, 0.f, 0.f, 0.f, 0.f, 0.f};
#pragma unroll
            for (int h = 0; h < 8; ++h) { const u32x4 q = *(const u32x4*)(prow + C_QI + h * 64 + dc * 8);
                qv[0] = fmaf(wf[h], blo(q.x), qv[0]); qv[1] = fmaf(wf[h], bhi(q.x), qv[1]); qv[2] = fmaf(wf[h], blo(q.y), qv[2]); qv[3] = fmaf(wf[h], bhi(q.y), qv[3]);
                qv[4] = fmaf(wf[h], blo(q.z), qv[4]); qv[5] = fmaf(wf[h], bhi(q.z), qv[5]); qv[6] = fmaf(wf[h], blo(q.w), qv[6]); qv[7] = fmaf(wf[h], bhi(q.w), qv[7]); }
            float s = 0.f;
#pragma unroll
            for (int i = 0; i < 8; ++i) s += kv[i];
            s += __shfl_xor(s, 1); s += __shfl_xor(s, 2); s += __shfl_xor(s, 4); const float m = s * (1.f / 64.f);
            float s2 = 0.f;
#pragma unroll
            for (int i = 0; i < 8; ++i) { kv[i] -= m; s2 += kv[i] * kv[i]; }
            s2 += __shfl_xor(s2, 1); s2 += __shfl_xor(s2, 2); s2 += __shfl_xor(s2, 4); const float rstd = rsqrtf(s2 * (1.f / 64.f) + EPS);
            const f32x4 ga = *(const f32x4*)(p.idx_g + dc * 8), gb = *(const f32x4*)(p.idx_g + dc * 8 + 4), ba = *(const f32x4*)(p.idx_b + dc * 8), bb = *(const f32x4*)(p.idx_b + dc * 8 + 4);
            const float gg[8] = {ga.x, ga.y, ga.z, ga.w, gb.x, gb.y, gb.z, gb.w}, bbv[8] = {ba.x, ba.y, ba.z, ba.w, bb.x, bb.y, bb.z, bb.w};
            const int cd = (dc & 3) * 8;
            const f32x4 c0 = *(const f32x4*)(COS + t * 32 + cd), c1 = *(const f32x4*)(COS + t * 32 + cd + 4), s0 = *(const f32x4*)(SIN + t * 32 + cd), s1 = *(const f32x4*)(SIN + t * 32 + cd + 4);
            const float cc[8] = {c0.x, c0.y, c0.z, c0.w, c1.x, c1.y, c1.z, c1.w}, ss[8] = {s0.x, s0.y, s0.z, s0.w, s1.x, s1.y, s1.z, s1.w};
            float ko[8], qo[8];
#pragma unroll
            for (int i = 0; i < 8; ++i) { const float yk = kv[i] * rstd * gg[i] + bbv[i]; const float ok = __shfl_xor(yk, 4), oq = __shfl_xor(qv[i], 4);
                ko[i] = (dc < 4) ? (yk * cc[i] - ok * ss[i]) : (yk * cc[i] + ok * ss[i]); qo[i] = (dc < 4) ? (qv[i] * cc[i] - oq * ss[i]) : (qv[i] * cc[i] + oq * ss[i]); }
            if (lane < 32) { store8_bf16(KI + (size_t)t * 64 + dc * 8, ko); store8_bf16(QL + (size_t)t * 64 + dc * 8, qo);
                if (dc == 0) { *(f32x4*)(WI + t * 8) = (f32x4){wf[0], wf[1], wf[2], wf[3]}; *(f32x4*)(WI + t * 8 + 4) = (f32x4){wf[4], wf[5], wf[6], wf[7]}; } } }
        __syncthreads();
        ISEC(14);
#pragma unroll 3
        for (int it = tid; it < 32 * 96; it += NTHREADS) { const int tl = it / 96, rem = it % 96, ten = rem >> 5, hh = (rem >> 2) & 7, ch = rem & 3; const int t = t0 + tl;
            bf16* base = PROJ + (size_t)t * NP + (ten == 0 ? C_Q : ten == 1 ? C_K : C_QI) + hh * 64 + ch * 8; const float sc = (ten == 0) ? C2 : 1.f;
            const u32x4 xa = *(const u32x4*)base, xb = *(const u32x4*)(base + 32);
            const f32x4 c0 = *(const f32x4*)(COS + t * 32 + ch * 8), c1 = *(const f32x4*)(COS + t * 32 + ch * 8 + 4), s0 = *(const f32x4*)(SIN + t * 32 + ch * 8), s1 = *(const f32x4*)(SIN + t * 32 + ch * 8 + 4);
            const float x1[8] = {blo(xa.x), bhi(xa.x), blo(xa.y), bhi(xa.y), blo(xa.z), bhi(xa.z), blo(xa.w), bhi(xa.w)}, x2[8] = {blo(xb.x), bhi(xb.x), blo(xb.y), bhi(xb.y), blo(xb.z), bhi(xb.z), blo(xb.w), bhi(xb.w)};
            const float cc[8] = {c0.x, c0.y, c0.z, c0.w, c1.x, c1.y, c1.z, c1.w}, ss[8] = {s0.x, s0.y, s0.z, s0.w, s1.x, s1.y, s1.z, s1.w};
            float o1[8], o2[8];
#pragma unroll
            for (int i = 0; i < 8; ++i) { o1[i] = (x1[i] * cc[i] - x2[i] * ss[i]) * sc; o2[i] = (x2[i] * cc[i] + x1[i] * ss[i]) * sc; }
            { float am = fmaxf(fabsf(o1[0]), fabsf(o2[0]));
#pragma unroll
                for (int i = 1; i < 8; ++i) am = fmaxf(am, fmaxf(fabsf(o1[i]), fabsf(o2[i])));
                kmx = fmaxf(kmx, (ten == 1) ? am : 0.f); }
            store8_bf16(base, o1); store8_bf16(base + 32, o2); }
        ISEC(5);
    }
    kmx = wave_max(kmx);
    __syncthreads(); if (lane == 0) RED[wave] = kmx; __syncthreads();
    if (tid == 0) { float m = RED[0];
#pragma unroll
        for (int w = 1; w < 8; ++w) m = fmaxf(m, RED[w]);
        atomicMax((unsigned*)(p.ws + WS_CTL) + CW_KMAX, __float_as_uint(m * 1.01f)); }
}

__device__ __forceinline__ unsigned fkey(float f) { unsigned u = __float_as_uint(f); if (u == 0x80000000u) u = 0u; return (u & 0x80000000u) ? ~u : (u | 0x80000000u); }
__device__ __forceinline__ void phase_idx_naive(const Params& p, unsigned char* lds) {
    const int tid = opaque_tid(), lane = tid & 63, wave = tid >> 6;
    const bf16* PROJ = (const bf16*)(p.ws + WS_PROJ); const bf16* KI = (const bf16*)(p.ws + WS_KI); const float* WI = (const float*)(p.ws + WS_WI);
    u64* MASK = (u64*)(p.ws + WS_MASK);
    float* scores = (float*)lds;
    float* qif = (float*)(lds + 65536);
    float* wf = (float*)(lds + 65536 + 2048);
    unsigned* hist = (unsigned*)(lds + 65536 + 4096);
    u64* tiebits = (u64*)(lds + 65536 + 8192);
    int* sh = (int*)(lds + 65536 + 12288);
    for (int t = blockIdx.x; t < S; t += gridDim.x) {
        const int tq = t >> 6, nadm = 64 * (tq + 1), ntw = 4 * (t >> 8) + 4;
        __syncthreads();
        if (nadm <= KSEL) {
            if (tid < ntw) MASK[(size_t)tid * S + t] = (tid <= tq) ? ~0ull : 0ull;
            continue;
        }
        qif[tid] = bf2f(PROJ[(size_t)t * NP + C_QI + tid]); if (tid < 8) wf[tid] = WI[t * 8 + tid];
        __syncthreads();
        for (int s = tid; s < nadm; s += NTHREADS) {
            float kf[64];
#pragma unroll
            for (int j = 0; j < 8; ++j) { const u32x4 v = *(const u32x4*)(KI + (size_t)s * 64 + j * 8);
                kf[j * 8 + 0] = blo(v.x); kf[j * 8 + 1] = bhi(v.x); kf[j * 8 + 2] = blo(v.y); kf[j * 8 + 3] = bhi(v.y); kf[j * 8 + 4] = blo(v.z); kf[j * 8 + 5] = bhi(v.z); kf[j * 8 + 6] = blo(v.w); kf[j * 8 + 7] = bhi(v.w); }
            float I = 0.f;
            for (int h = 0; h < 8; ++h) { float d = 0.f;
#pragma unroll
                for (int k = 0; k < 64; k += 4) { const f32x4 q4 = *(const f32x4*)(qif + h * 64 + k); d = fmaf(q4.x, kf[k], d); d = fmaf(q4.y, kf[k + 1], d); d = fmaf(q4.z, kf[k + 2], d); d = fmaf(q4.w, kf[k + 3], d); }
                I = fmaf(wf[h], fmaxf(d, 0.f), I); }
            scores[s] = I;
        }
        __syncthreads();
        unsigned prefix = 0; int kk = KSEL;
        for (int ps = 0; ps < 4; ++ps) {
            const int shift = 24 - 8 * ps;
            if (tid < 256) hist[tid] = 0u;
            __syncthreads();
            for (int s = tid; s < nadm; s += NTHREADS) { const unsigned key = fkey(scores[s]); if (ps == 0 || (key >> (shift + 8)) == prefix) atomicAdd(&hist[(key >> shift) & 255u], 1u); }
            __syncthreads();
            if (wave == 0) {
                unsigned c4[4]; unsigned tot = 0;
#pragma unroll
                for (int j = 0; j < 4; ++j) { c4[j] = hist[255 - (4 * lane + j)]; tot += c4[j]; }
                unsigned incl = tot;
#pragma unroll
                for (int o = 1; o < 64; o <<= 1) { const unsigned v = __shfl_up(incl, o); if (lane >= o) incl += v; }
                const unsigned excl = incl - tot;
                if (excl < (unsigned)kk && (unsigned)kk <= incl) { const unsigned s0 = excl + c4[0], s1 = s0 + c4[1], s2 = s1 + c4[2]; const unsigned ukk = (unsigned)kk;
                    const int j = ukk <= s0 ? 0 : ukk <= s1 ? 1 : ukk <= s2 ? 2 : 3; const unsigned cum = ukk <= s0 ? excl : ukk <= s1 ? s0 : ukk <= s2 ? s1 : s2;
                    sh[0] = 255 - (4 * lane + j); sh[1] = kk - (int)cum; }
            }
            __syncthreads();
            prefix = (prefix << 8) | (unsigned)sh[0]; kk = sh[1];
            __syncthreads();
        }
        const unsigned T = prefix;
        if (wave == 0) { int run = 0;
            for (int tile = 0; tile <= tq; ++tile) { const bool tie = fkey(scores[tile * 64 + lane]) == T; const u64 bal = __ballot(tie);
                const int rank = run + __popcll(bal & ((1ull << lane) - 1ull)); const u64 tb = __ballot(tie && rank < kk); if (lane == 0) tiebits[tile] = tb; run += __popcll(bal); } }
        __syncthreads();
        for (int tile = wave; tile < ntw; tile += NWAVES) { u64 w = 0ull;
            if (tile <= tq) { w = __ballot(fkey(scores[tile * 64 + lane]) > T) | tiebits[tile]; }
            if (lane == 0) MASK[(size_t)tile * S + t] = w; }
    }
}

namespace idxf {
typedef short bf16x8 __attribute__((ext_vector_type(8)));
typedef float f32x16 __attribute__((ext_vector_type(16)));
constexpr int L_B = 0, L_HIST = 36864, L_PK = L_HIST + 32 * 513 * 4, L_TAIL = L_PK + 2048, L_CC = L_TAIL + 2 * 32 * 64 * 4, L_CT = L_CC + 16 * 32 * 4, L_END = L_CT + 16 * 32 * 4;
constexpr int PK_P = 0, PK_KK = 32, PK_TC = 64, PK_A = 96, PK_SC = 128, PK_MN = 160, PK_MX = 192, PK_FLAG = 224, PK_LO = 256, PK_ND = 288, PK_NC = 320;
constexpr int CAND_CAP = 1024;
constexpr int R_HI = 12, R_LO = 56;
static_assert(L_END <= 131072, "idx LDS");
__device__ __forceinline__ unsigned fkey32(float f) { const unsigned u = __float_as_uint(f); return u ^ ((unsigned)((int)u >> 31) | 0x80000000u); }
__device__ __forceinline__ float fkey_inv(unsigned k) { return __uint_as_float((k & 0x80000000u) ? (k ^ 0x80000000u) : ~k); }
__device__ __forceinline__ int lbin(float I, float A, float sc) { const int b = (int)((I - A) * sc); return b < 0 ? 0 : (b > 1023 ? 1023 : b); }

template <int MODE>
__device__ __forceinline__ void sweep(const Params& p, LAS unsigned char* L, int q0, int ntk, int wave, int lane) {
    const int j = lane & 31, hi = lane >> 5;
    const bf16* KI = (const bf16*)(p.ws + WS_KI); u64* MASK = (u64*)(p.ws + WS_MASK);
    LAS unsigned* PK = (LAS unsigned*)(L + L_PK); LAS unsigned* tailk = (LAS unsigned*)(L + L_TAIL); LAS unsigned* taili = tailk + 32 * 64;
    LAS unsigned* hist = (LAS unsigned*)(L + L_HIST) + ((MODE == 5 || MODE >= 7) ? j : j * 257);
    float w[8]; { const f32x4 wa = *(const f32x4*)((const float*)(p.ws + WS_WI) + (size_t)(q0 + j) * 8), wb = *(const f32x4*)((const float*)(p.ws + WS_WI) + (size_t)(q0 + j) * 8 + 4);
        w[0] = wa.x; w[1] = wa.y; w[2] = wa.z; w[3] = wa.w; w[4] = wb.x; w[5] = wb.y; w[6] = wb.z; w[7] = wb.w; }
    const unsigned P = (MODE == 2 || MODE == 3 || MODE == 6 || MODE == 8) ? PK[PK_P + j] : 0u; const unsigned PLO = (MODE == 8) ? PK[PK_LO + j] : 0u; unsigned ndef = 0u, ccnt = 0u;
    u64* CAND = (u64*)(p.ws + WS_XS) + (size_t)(q0 + j) * CAND_CAP + (wave * 2 + hi) * 64;
    const int nloop = (MODE == 4) ? NWAVES : (MODE == 7) ? ((ntk + 7) >> 3) : ntk;
    const float lA = (MODE >= 5) ? __uint_as_float(PK[PK_A + j]) : 0.f, lS = (MODE >= 5) ? __uint_as_float(PK[PK_SC + j]) : 0.f;
    const LAS unsigned char* bfr = L + L_B + lane * 16;
    const bf16* abase = KI + hi * 8;
    unsigned kmn = 0xffffffffu, tk8[8] = {0u, 0u, 0u, 0u, 0u, 0u, 0u, 0u};
    bf16x8 a[2][4];
#define IDX_LOADA(dst, kt_) do { _Pragma("unroll") for (int hf = 0; hf < 2; ++hf) { const int row = (MODE == 4) ? ((((kt_) * 64 + hf * 32 + (lane & 31)) * (ntk * 64)) >> 9) : (MODE == 7) ? min((((kt_) * 64 + hf * 32 + (lane & 31)) << 3) + 5, ntk * 64 - 1) : ((kt_) * 64 + hf * 32 + (lane & 31)); \
            _Pragma("unroll") for (int ks = 0; ks < 4; ++ks) dst[hf][ks] = *(const bf16x8*)(abase + (size_t)row * 64 + ks * 16); } } while (0)
    for (int kt = wave; kt < nloop; kt += NWAVES) {
        IDX_LOADA(a, kt);
        f32x16 L0, L1; float I0[16], I1[16];
        f32x16 cA0, cA1, cB0, cB1; bf16x8 bA[4], bB[4];
#define IDX_LOADB(BD, H) do { _Pragma("unroll") for (int ks = 0; ks < 4; ++ks) BD[ks] = *(const LAS bf16x8*)(bfr + ((H) * 4 + ks) * 1024); } while (0)
#define IDX_CHAIN(D0, D1, BS) do { D0 = f32x16{}; D1 = f32x16{}; _Pragma("unroll") for (int ks = 0; ks < 4; ++ks) { \
            D0 = __builtin_amdgcn_mfma_f32_32x32x16_bf16(a[0][ks], BS[ks], D0, 0, 0, 0); D1 = __builtin_amdgcn_mfma_f32_32x32x16_bf16(a[1][ks], BS[ks], D1, 0, 0, 0); } \
            asm volatile("" : "+v"(D0)); asm volatile("" : "+v"(D1)); } while (0)
#define IDX_ACC(C0_, C1_, H) do { _Pragma("unroll") for (int r = 0; r < 16; ++r) { I0[r] = fmaf(w[H], __builtin_fabsf(C0_[r]), I0[r]); I1[r] = fmaf(w[H], __builtin_fabsf(C1_[r]), I1[r]); asm volatile("" : "+v"(I0[r]), "+v"(I1[r])); } } while (0)
#define IDX_SB __builtin_amdgcn_sched_barrier(0)
        IDX_LOADB(bA, 8); IDX_LOADB(bB, 0); IDX_SB;
        IDX_LOADB(bA, 8); IDX_CHAIN(L0, L1, bA); IDX_SB;
        IDX_LOADB(bA, 1); IDX_CHAIN(cA0, cA1, bB); IDX_SB;
#pragma unroll
        for (int r = 0; r < 16; ++r) { I0[r] = L0[r]; I1[r] = L1[r]; }
        IDX_LOADB(bB, 2); IDX_CHAIN(cB0, cB1, bA); IDX_ACC(cA0, cA1, 0); IDX_SB;
        IDX_LOADB(bA, 3); IDX_CHAIN(cA0, cA1, bB); IDX_ACC(cB0, cB1, 1); IDX_SB;
        IDX_LOADB(bB, 4); IDX_CHAIN(cB0, cB1, bA); IDX_ACC(cA0, cA1, 2); IDX_SB;
        IDX_LOADB(bA, 5); IDX_CHAIN(cA0, cA1, bB); IDX_ACC(cB0, cB1, 3); IDX_SB;
        IDX_LOADB(bB, 6); IDX_CHAIN(cB0, cB1, bA); IDX_ACC(cA0, cA1, 4); IDX_SB;
        IDX_LOADB(bA, 7); IDX_CHAIN(cA0, cA1, bB); IDX_ACC(cB0, cB1, 5); IDX_SB;
        IDX_CHAIN(cB0, cB1, bA); IDX_ACC(cA0, cA1, 6); IDX_SB;
        IDX_ACC(cB0, cB1, 7);
        IDX_SB;
#undef IDX_LOADB
#undef IDX_SB
#undef IDX_CHAIN
#undef IDX_ACC
        if (MODE == 1) {
#pragma unroll
            for (int r = 0; r < 16; ++r) { const unsigned k0 = fkey32(I0[r]), k1 = fkey32(I1[r]);
                __hip_atomic_fetch_add(hist + (k0 >> 24), 1u, __ATOMIC_RELAXED, __HIP_MEMORY_SCOPE_WORKGROUP); __hip_atomic_fetch_add(hist + (k1 >> 24), 1u, __ATOMIC_RELAXED, __HIP_MEMORY_SCOPE_WORKGROUP); }
        } else if (MODE == 2) {
#pragma unroll
            for (int r = 0; r < 16; ++r) { const unsigned k0 = fkey32(I0[r]), k1 = fkey32(I1[r]);
                if ((k0 >> 24) == P) __hip_atomic_fetch_add(hist + ((k0 >> 16) & 255u), 1u, __ATOMIC_RELAXED, __HIP_MEMORY_SCOPE_WORKGROUP);
                if ((k1 >> 24) == P) __hip_atomic_fetch_add(hist + ((k1 >> 16) & 255u), 1u, __ATOMIC_RELAXED, __HIP_MEMORY_SCOPE_WORKGROUP); }
        } else if (MODE == 4) {
#pragma unroll
            for (int r = 0; r < 16; ++r) { unsigned k0 = fkey32(I0[r]), k1 = fkey32(I1[r]); kmn = min(kmn, min(k0, k1));
#pragma unroll
                for (int i = 0; i < 8; ++i) { const unsigned hi0 = max(tk8[i], k0); k0 = min(tk8[i], k0); tk8[i] = hi0; }
#pragma unroll
                for (int i = 0; i < 8; ++i) { const unsigned hi1 = max(tk8[i], k1); k1 = min(tk8[i], k1); tk8[i] = hi1; } }
        } else if (MODE == 5 || MODE == 7) {
#pragma unroll
            for (int r = 0; r < 16; ++r) { const int b0 = lbin(I0[r], lA, lS), b1 = lbin(I1[r], lA, lS); const int kb = (r & 3) + 8 * (r >> 2) + 4 * hi;
                const bool v0 = (MODE == 5) || (((kt * 64 + kb) << 3) + 5 < ntk * 64), v1 = (MODE == 5) || (((kt * 64 + 32 + kb) << 3) + 5 < ntk * 64);
                if (v0) __hip_atomic_fetch_add(hist + (b0 >> 1) * 32, 1u << ((b0 & 1) * 16), __ATOMIC_RELAXED, __HIP_MEMORY_SCOPE_WORKGROUP);
                if (v1) __hip_atomic_fetch_add(hist + (b1 >> 1) * 32, 1u << ((b1 & 1) * 16), __ATOMIC_RELAXED, __HIP_MEMORY_SCOPE_WORKGROUP); }
        } else if (MODE == 8) {
            unsigned wlo = 0u, whi = 0u; const float thi = (P >= 1023u) ? INFINITY : (float)(P + 1u), tlo = (float)PLO;     const unsigned wbits = __float_as_uint(thi - tlo);
#pragma unroll
            for (int r = 0; r < 16; ++r) { const int kb = (r & 3) + 8 * (r >> 2); const float x0 = (I0[r] - lA) * lS, x1 = (I1[r] - lA) * lS;
                wlo |= (x0 >= thi) ? (1u << kb) : 0u; whi |= (x1 >= thi) ? (1u << kb) : 0u;
                if (__float_as_uint(x0 - tlo) < wbits) { const unsigned c0 = (unsigned)lbin(I0[r], lA, lS); __hip_atomic_fetch_add(hist + (c0 >> 1) * 32, 1u << ((c0 & 1) * 16), __ATOMIC_RELAXED, __HIP_MEMORY_SCOPE_WORKGROUP);
                    if (ccnt < 64u) CAND[ccnt] = ((u64)fkey32(I0[r]) << 32) | (u64)(unsigned)(kt * 64 + kb + 4 * hi); ++ccnt; }
                if (__float_as_uint(x1 - tlo) < wbits) { const unsigned c1 = (unsigned)lbin(I1[r], lA, lS); __hip_atomic_fetch_add(hist + (c1 >> 1) * 32, 1u << ((c1 & 1) * 16), __ATOMIC_RELAXED, __HIP_MEMORY_SCOPE_WORKGROUP);
                    if (ccnt < 64u) CAND[ccnt] = ((u64)fkey32(I1[r]) << 32) | (u64)(unsigned)(kt * 64 + 32 + kb + 4 * hi); ++ccnt; } }
            wlo <<= 4 * hi; whi <<= 4 * hi;
            wlo |= (unsigned)__shfl_xor((int)wlo, 32); whi |= (unsigned)__shfl_xor((int)whi, 32);
            if (hi == 0) { MASK[(size_t)kt * S + q0 + j] = ((u64)whi << 32) | (u64)wlo; ndef += (unsigned)(__popc(wlo) + __popc(whi)); }
        } else {
            unsigned wlo = 0u, whi = 0u;
#pragma unroll
            for (int r = 0; r < 16; ++r) { const int kb = (r & 3) + 8 * (r >> 2); const unsigned k0 = fkey32(I0[r]), k1 = fkey32(I1[r]);
                const unsigned c0 = (MODE == 3) ? (k0 >> 16) : (unsigned)lbin(I0[r], lA, lS), c1 = (MODE == 3) ? (k1 >> 16) : (unsigned)lbin(I1[r], lA, lS);
                wlo |= (c0 > P) ? (1u << kb) : 0u; whi |= (c1 > P) ? (1u << kb) : 0u;
                if (c0 == P) { const unsigned pos = __hip_atomic_fetch_add(PK + PK_TC + j, 1u, __ATOMIC_RELAXED, __HIP_MEMORY_SCOPE_WORKGROUP); if (pos < 64u) { tailk[j * 64 + pos] = k0; taili[j * 64 + pos] = (unsigned)(kt * 64 + kb + 4 * hi); } }
                if (c1 == P) { const unsigned pos = __hip_atomic_fetch_add(PK + PK_TC + j, 1u, __ATOMIC_RELAXED, __HIP_MEMORY_SCOPE_WORKGROUP); if (pos < 64u) { tailk[j * 64 + pos] = k1; taili[j * 64 + pos] = (unsigned)(kt * 64 + 32 + kb + 4 * hi); } } }
            wlo <<= 4 * hi; whi <<= 4 * hi;
            wlo |= (unsigned)__shfl_xor((int)wlo, 32); whi |= (unsigned)__shfl_xor((int)whi, 32);
            if (hi == 0) MASK[(size_t)kt * S + q0 + j] = ((u64)whi << 32) | (u64)wlo;
        }
    }
#undef IDX_LOADA
    if (MODE == 8) { if (hi == 0 && ndef) __hip_atomic_fetch_add(PK + PK_ND + j, ndef, __ATOMIC_RELAXED, __HIP_MEMORY_SCOPE_WORKGROUP); ((LAS unsigned*)(L + L_CC))[(wave * 2 + hi) * 32 + j] = ccnt; }
    if (MODE == 4) {
        const int nadm = ntk * 64; const unsigned cand = nadm >= 8192 ? tk8[3] : nadm >= 4096 ? tk8[7] : nadm >= 2048 ? kmn : nadm >= 1024 ? tk8[7] : kmn;
        __hip_atomic_fetch_min(PK + PK_MN + j, cand, __ATOMIC_RELAXED, __HIP_MEMORY_SCOPE_WORKGROUP); __hip_atomic_fetch_max(PK + PK_MX + j, tk8[0], __ATOMIC_RELAXED, __HIP_MEMORY_SCOPE_WORKGROUP); }
}

__device__ __forceinline__ void scan4(LAS unsigned char* L, int wave, int lane) {
    LAS unsigned* PK = (LAS unsigned*)(L + L_PK);
    for (int qq = 0; qq < 4; ++qq) { const int jq = wave * 4 + qq; const LAS unsigned* hb = (const LAS unsigned*)(L + L_HIST) + jq * 257;
        const unsigned kk = PK[PK_KK + jq];
        const unsigned c0 = hb[255 - 4 * lane], c1 = hb[254 - 4 * lane], c2 = hb[253 - 4 * lane], c3 = hb[252 - 4 * lane]; const unsigned tot = c0 + c1 + c2 + c3;
        unsigned incl = tot;
#pragma unroll
        for (int o = 1; o < 64; o <<= 1) { const unsigned v = __shfl_up(incl, o); if (lane >= o) incl += v; }
        const unsigned excl = incl - tot;
        if (excl < kk && kk <= incl) { const unsigned s0 = excl + c0, s1 = s0 + c1, s2 = s1 + c2;
            const int jb = kk <= s0 ? 0 : kk <= s1 ? 1 : kk <= s2 ? 2 : 3; const unsigned cum = kk <= s0 ? excl : kk <= s1 ? s0 : kk <= s2 ? s1 : s2;
            PK[PK_P + jq] = (PK[PK_P + jq] << 8) | (unsigned)(255 - (4 * lane + jb)); PK[PK_KK + jq] = kk - cum; }
    }
}
__device__ __forceinline__ void scan_lin(LAS unsigned char* L, int tid, int kk_off = PK_KK, int out_off = PK_P, bool write_kk = true) {
    LAS unsigned* PK = (LAS unsigned*)(L + L_PK); LAS unsigned* CT = (LAS unsigned*)(L + L_CT);
    const int jq = tid & 31, ch = tid >> 5; const LAS unsigned* hb = (const LAS unsigned*)(L + L_HIST) + (32 * ch) * 32 + jq;
    unsigned tot = 0u;
#pragma unroll 8
    for (int i = 0; i < 32; ++i) { const unsigned wd = hb[i * 32]; tot += (wd & 0xffffu) + (wd >> 16); }
    CT[ch * 32 + jq] = tot;
    __syncthreads();
    unsigned excl = 0u;
#pragma unroll
    for (int c = 1; c < 16; ++c) excl += (c > ch) ? CT[c * 32 + jq] : 0u;
    const unsigned kk = PK[kk_off + jq];
    if (excl < kk && kk <= excl + tot) { unsigned cum = excl, bsel = 0u, nk = 0u; bool done = false;
        for (int i = 31; i >= 0; --i) { const unsigned wd = hb[i * 32]; const unsigned chi = wd >> 16, clo = wd & 0xffffu;
            bool hit = !done && (cum + chi >= kk); bsel = hit ? (unsigned)(2 * (32 * ch + i) + 1) : bsel; nk = hit ? (kk - cum) : nk; done = done || hit; cum += chi;
            hit = !done && (cum + clo >= kk); bsel = hit ? (unsigned)(2 * (32 * ch + i)) : bsel; nk = hit ? (kk - cum) : nk; done = done || hit; cum += clo; }
        PK[out_off + jq] = bsel; if (write_kk) PK[PK_KK + jq] = nk; }
}
template <bool TOLDS>
__device__ __forceinline__ void tail_resolve(const Params& p, LAS unsigned char* L, int q0, int tid) {
    u64* MASK = (u64*)(p.ws + WS_MASK); LAS unsigned* PK = (LAS unsigned*)(L + L_PK); LAS u64* MW = (LAS u64*)(L + L_HIST);
    const int jq = tid >> 4, e0 = tid & 15; const unsigned n = min(PK[PK_TC + jq], 64u), kk = PK[PK_KK + jq];
    const LAS unsigned* tk = (const LAS unsigned*)(L + L_TAIL) + jq * 64; const LAS unsigned* ti = tk + 32 * 64;
    for (unsigned e = e0; e < n; e += 16) { const unsigned k = tk[e], s = ti[e]; unsigned rank = 0;
        for (unsigned e2 = 0; e2 < n; ++e2) { const unsigned k2 = tk[e2], s2 = ti[e2]; rank += (k2 > k || (k2 == k && s2 < s)) ? 1u : 0u; }
        if (rank < kk) { if (TOLDS) __hip_atomic_fetch_or(MW + (s >> 6) * 32 + jq, 1ull << (s & 63), __ATOMIC_RELAXED, __HIP_MEMORY_SCOPE_WORKGROUP);
            else atomicOr((unsigned long long*)&MASK[(size_t)(s >> 6) * S + q0 + jq], 1ull << (s & 63)); } }
}
__device__ __forceinline__ void idx_unit(const Params& p, unsigned char* lds, int u) {
    int tid_ = threadIdx.x; asm volatile("" : "+v"(tid_)); const int tid = tid_, lane = tid & 63; const int wave = __builtin_amdgcn_readfirstlane(tid >> 6);
    LAS unsigned char* L = (LAS unsigned char*)lds;
    const int q0 = u * 32, tq = q0 >> 6, ntk = tq + 1, ntw = 4 * (q0 >> 8) + 4;
    u64* MASK = (u64*)(p.ws + WS_MASK);
    if (ntk * 64 <= KSEL) { for (int i = tid; i < ntw * 32; i += NTHREADS) { const int tile = i >> 5; MASK[(size_t)tile * S + q0 + (i & 31)] = (tile <= tq) ? ~0ull : 0ull; } return; }
    for (int i = tid; i < (ntw - ntk) * 32; i += NTHREADS) MASK[(size_t)(ntk + (i >> 5)) * S + q0 + (i & 31)] = 0ull;
    __syncthreads();
    ISEC(7);
    { const bf16* PROJ = (const bf16*)(p.ws + WS_PROJ); const bf16* QL = (const bf16*)(p.ws + WS_QL); const int j = lane & 31, hi = lane >> 5;
        u32x4 bv[5];
#pragma unroll
        for (int i = 0; i < 5; ++i) { const int f = wave + NWAVES * i; if (f < 36) { const int h = f >> 2, ks = f & 3;
                const bf16* src = (h < 8) ? PROJ + (size_t)(q0 + j) * NP + C_QI + h * 64 + ks * 16 + hi * 8 : QL + (size_t)(q0 + j) * 64 + ks * 16 + hi * 8; bv[i] = *(const u32x4*)src; } }
#pragma unroll
        for (int i = 0; i < 5; ++i) { const int f = wave + NWAVES * i; if (f < 36) *(LAS u32x4*)(L + L_B + f * 1024 + lane * 16) = bv[i]; } }
    LAS unsigned* PK = (LAS unsigned*)(L + L_PK);
    if (tid < 32) { PK[PK_P + tid] = 0u; PK[PK_KK + tid] = (unsigned)KSEL; PK[PK_TC + tid] = 0u; PK[PK_MN + tid] = 0xffffffffu; PK[PK_MX + tid] = 0u; }
    if (tid == 0) PK[PK_FLAG] = 0u;
    for (int i = tid; i < 32 * 513; i += NTHREADS) ((LAS unsigned*)(L + L_HIST))[i] = 0u;
    __syncthreads();
    ISEC(0);
    sweep<4>(p, L, q0, ntk, wave, lane);
    __syncthreads();
    ISEC(1);
    if (tid < 32) { const float mn = fkey_inv(PK[PK_MN + tid]), mx = fkey_inv(PK[PK_MX + tid]); const float rg = mx - mn; const float A = mn; const float sc = 1024.f / (1.5f * rg);
        PK[PK_A + tid] = __float_as_uint(A); PK[PK_SC + tid] = __float_as_uint(sc); if (!(rg > 0.f) || !(sc < 3.0e38f)) PK[PK_FLAG] = 1u; }
    __syncthreads();
    bool fallback = PK[PK_FLAG] != 0u;
    bool done = false;
    if (!fallback && ntk >= 32) {
        sweep<7>(p, L, q0, ntk, wave, lane);
        __syncthreads();
        ISEC(8);
        if (tid < 32) { PK[PK_ND + tid] = (unsigned)R_HI; PK[PK_NC + tid] = (unsigned)R_LO; }
        __syncthreads();
        scan_lin(L, tid, PK_ND, PK_P, false);
        __syncthreads();
        scan_lin(L, tid, PK_NC, PK_LO, false);
        __syncthreads();
        if (tid < 32) { PK[PK_ND + tid] = 0u; PK[PK_NC + tid] = 0u; }
        for (int i = tid; i < 32 * 513; i += NTHREADS) ((LAS unsigned*)(L + L_HIST))[i] = 0u;
        __syncthreads();
        ISEC(9);
        sweep<8>(p, L, q0, ntk, wave, lane);
        __syncthreads();
        ISEC(10);
        if (tid < 32) { const LAS unsigned* cc = (const LAS unsigned*)(L + L_CC) + tid; unsigned nc = 0u, mxc = 0u;
#pragma unroll
            for (int i = 0; i < 16; ++i) { const unsigned c = cc[i * 32]; nc += c; mxc = max(mxc, c); }
            const unsigned nd = PK[PK_ND + tid]; const bool ok = nd < (unsigned)KSEL && nd + nc >= (unsigned)KSEL && mxc <= 64u;
            if (!ok) PK[PK_FLAG] = 1u; PK[PK_KK + tid] = (unsigned)KSEL - (ok ? nd : 0u); PK[PK_TC + tid] = 0u; }
        __syncthreads();
        if (PK[PK_FLAG] == 0u) {
            scan_lin(L, tid);
            __syncthreads();
            LAS u64* MW = (LAS u64*)(L + L_HIST);
            for (int i = tid; i < ntk * 32; i += NTHREADS) MW[i] = 0ull;
            __syncthreads();
            { const int jq = tid >> 4, e0 = tid & 15; const unsigned nc = ((const LAS unsigned*)(L + L_CC))[e0 * 32 + jq], bt = PK[PK_P + jq]; const float cA = __uint_as_float(PK[PK_A + jq]), cS = __uint_as_float(PK[PK_SC + jq]);
                const u64* cl = (const u64*)(p.ws + WS_XS) + (size_t)(q0 + jq) * CAND_CAP + e0 * 64; LAS unsigned* tk = (LAS unsigned*)(L + L_TAIL) + jq * 64; LAS unsigned* ti = tk + 32 * 64;
                for (unsigned eb = 0; eb < nc; eb += 8) { u64 rec[8];
#pragma unroll
                    for (int i = 0; i < 8; ++i) { const unsigned e = eb + i; rec[i] = (e < nc) ? cl[e] : 0ull; }
#pragma unroll
                    for (int i = 0; i < 8; ++i) { const unsigned e = eb + i; if (e < nc) { const unsigned key = (unsigned)(rec[i] >> 32), s = (unsigned)rec[i]; const unsigned b = (unsigned)lbin(fkey_inv(key), cA, cS);
                            if (b > bt) __hip_atomic_fetch_or(MW + (s >> 6) * 32 + jq, 1ull << (s & 63), __ATOMIC_RELAXED, __HIP_MEMORY_SCOPE_WORKGROUP);
                            else if (b == bt) { const unsigned pos = __hip_atomic_fetch_add(PK + PK_TC + jq, 1u, __ATOMIC_RELAXED, __HIP_MEMORY_SCOPE_WORKGROUP); if (pos < 64u) { tk[pos] = key; ti[pos] = s; } } } } } }
            __syncthreads();
            if (tid < 32 && PK[PK_TC + tid] > 64u) PK[PK_FLAG] = 1u;
            __syncthreads();
            if (PK[PK_FLAG] == 0u) { tail_resolve<true>(p, L, q0, tid); __syncthreads();
                for (int i = tid; i < ntk * 32; i += NTHREADS) { const u64 wv = MW[i]; if (wv) { u64* gp = &MASK[(size_t)(i >> 5) * S + q0 + (i & 31)]; *gp = *gp | wv; } }
                done = true; }
        }
        ISEC(11);
        if (!done) {
            __syncthreads();
#if PROBE_PHASE == 101
            if (tid == 0) atomicAdd((unsigned*)(p.ws + WS_CTL) + 2048, 1u);
#endif
            if (tid < 32) { PK[PK_P + tid] = 0u; PK[PK_KK + tid] = (unsigned)KSEL; PK[PK_TC + tid] = 0u; }
            if (tid == 0) PK[PK_FLAG] = 0u;
            for (int i = tid; i < 32 * 513; i += NTHREADS) ((LAS unsigned*)(L + L_HIST))[i] = 0u;
            __syncthreads();
        }
    }
    if (!fallback && !done) {
        sweep<5>(p, L, q0, ntk, wave, lane);
        __syncthreads();
        ISEC(2);
        scan_lin(L, tid);
        __syncthreads();
        ISEC(3);
        sweep<6>(p, L, q0, ntk, wave, lane);
        ISEC(4);
        __syncthreads();
        if (tid < 32 && PK[PK_TC + tid] > 64u) PK[PK_FLAG] = 1u;
        __syncthreads();
        fallback = PK[PK_FLAG] != 0u;
        if (!fallback) tail_resolve<false>(p, L, q0, tid);
        ISEC(5);
    }
    if (fallback && !done) {
        __syncthreads();
#if PROBE_PHASE == 100
        if (tid == 0) atomicAdd((unsigned*)(p.ws + WS_CTL) + 2048, 1u);
#endif
        if (tid < 32) { PK[PK_P + tid] = 0u; PK[PK_KK + tid] = (unsigned)KSEL; PK[PK_TC + tid] = 0u; }
        for (int i = tid; i < 32 * 257; i += NTHREADS) ((LAS unsigned*)(L + L_HIST))[i] = 0u;
        __syncthreads();
        sweep<1>(p, L, q0, ntk, wave, lane);
        __syncthreads();
        scan4(L, wave, lane);
        __syncthreads();
        for (int i = tid; i < 32 * 257; i += NTHREADS) ((LAS unsigned*)(L + L_HIST))[i] = 0u;
        __syncthreads();
        sweep<2>(p, L, q0, ntk, wave, lane);
        __syncthreads();
        scan4(L, wave, lane);
        __syncthreads();
        sweep<3>(p, L, q0, ntk, wave, lane);
        __syncthreads();
        tail_resolve<false>(p, L, q0, tid);
    }
}
__device__ __forceinline__ void idx_phase(const Params& p, unsigned char* lds) {
    for (int w = blockIdx.x; w < 256; w += gridDim.x)
#pragma unroll 1
        for (int k = 0; k < 2; ++k) idx_unit(p, lds, k ? 511 - w : w);
}
}

__device__ __forceinline__ void phase_att_naive(const Params& p, unsigned char* lds) {
    const int tid = opaque_tid(), lane = tid & 63, wave = tid >> 6;
    const bf16* PROJ = (const bf16*)(p.ws + WS_PROJ); bf16* MIX = (bf16*)(p.ws + WS_MIX); const u64* MASK = (const u64*)(p.ws + WS_MASK);
    int* sidx = (int*)(lds + wave * 2048); float* slog = (float*)(lds + wave * 2048 + 1024);
    const int h = wave;
    for (int t = blockIdx.x; t < S; t += gridDim.x) {
        const int tq = t >> 6;
        float qf[64];
#pragma unroll
        for (int j = 0; j < 8; ++j) { const u32x4 v = *(const u32x4*)(PROJ + (size_t)t * NP + C_Q + h * 64 + j * 8);
            qf[j * 8 + 0] = blo(v.x); qf[j * 8 + 1] = bhi(v.x); qf[j * 8 + 2] = blo(v.y); qf[j * 8 + 3] = bhi(v.y); qf[j * 8 + 4] = blo(v.z); qf[j * 8 + 5] = bhi(v.z); qf[j * 8 + 6] = blo(v.w); qf[j * 8 + 7] = bhi(v.w); }
        int n = 0;
        for (int tile = 0; tile <= tq; ++tile) {
            const u64 w = MASK[(size_t)tile * S + t]; const bool sel = (w >> lane) & 1ull;
            if (w == 0ull) continue;
            float lg = 0.f; const int s = tile * 64 + lane;
            if (sel) {
#pragma unroll
                for (int j = 0; j < 8; ++j) { const u32x4 v = *(const u32x4*)(PROJ + (size_t)s * NP + C_K + h * 64 + j * 8);
                    lg = fmaf(qf[j * 8 + 0], blo(v.x), lg); lg = fmaf(qf[j * 8 + 1], bhi(v.x), lg); lg = fmaf(qf[j * 8 + 2], blo(v.y), lg); lg = fmaf(qf[j * 8 + 3], bhi(v.y), lg);
                    lg = fmaf(qf[j * 8 + 4], blo(v.z), lg); lg = fmaf(qf[j * 8 + 5], bhi(v.z), lg); lg = fmaf(qf[j * 8 + 6], blo(v.w), lg); lg = fmaf(qf[j * 8 + 7], bhi(v.w), lg); }
                const int pos = n + __popcll(w & ((1ull << lane) - 1ull));
                if (pos < 256) { sidx[pos] = s; slog[pos] = lg; }
            }
            n += __popcll(w);
        }
        if (n > 256) n = 256;
        __builtin_amdgcn_s_waitcnt(0); asm volatile("" ::: "memory");
        float m = -INFINITY; for (int j = lane; j < n; j += 64) m = fmaxf(m, slog[j]);
        m = wave_max(m);
        float l = 0.f; for (int j = lane; j < n; j += 64) { const float pj = exp2f(slog[j] - m); slog[j] = pj; l += pj; }
        l = wave_sum(l);
        __builtin_amdgcn_s_waitcnt(0); asm volatile("" ::: "memory");
        float o = 0.f;
        for (int j = 0; j < n; ++j) o = fmaf(slog[j], bf2f(PROJ[(size_t)sidx[j] * NP + C_V + h * 64 + lane]), o);
        MIX[(size_t)t * D + 512 + h * 64 + lane] = (bf16)f2bf(o / l);
        __builtin_amdgcn_s_waitcnt(0); asm volatile("" ::: "memory");
    }
}

namespace attn_body {
using bf16=__hip_bfloat16;
using bf16x8=__attribute__((ext_vector_type(8)))short;
using s16x4=__attribute__((ext_vector_type(4)))short;
using f32x16=__attribute__((ext_vector_type(16)))float;
using u32x4=__attribute__((ext_vector_type(4)))unsigned;
constexpr int NHEAD=8,SEQ=16384,D=64,DMI=3328,DMO=1024;
typedef unsigned long long u64;
constexpr int NW=8,QBLK=32,QB=QBLK*NW,KVBLK=64,NQB=SEQ/QB;
__device__ __forceinline__ int crow(int r,int hi){return (r&3)+8*(r>>2)+4*hi;}
#define SBAR() __builtin_amdgcn_sched_barrier(0)
__device__ __forceinline__ void cmask(f32x16&p0,f32x16&p1,int jb,int qrel,int hi){
  const float NEG=-INFINITY; int kb=64*jb+4*hi;
  #pragma unroll
  for(int r=0;r<16;++r){int kv=kb+(r&3)+8*(r>>2); if(kv>qrel)p0[r]=NEG; if(kv+32>qrel)p1[r]=NEG;}
}

constexpr int NSLOT=3, SLOTB=8192;
constexpr int LDS_K=0, LDS_V=NSLOT*SLOTB, LDS_WS=2*NSLOT*SLOTB, LDS_OST=LDS_WS+NW*64*4, LDS_M=LDS_OST+NW*4096, LDS_BYTES=LDS_M+NW*2048;
constexpr float C2=0.125f*1.4426950408889634f;
__device__ __forceinline__ void glds16s(const void*sbase,unsigned voff,unsigned lds_dst){unsigned keep;
  asm volatile("s_mov_b32 %0, m0\n\ts_mov_b32 m0, %3\n\ts_nop 0\n\tglobal_load_lds_dwordx4 %1, %2\n\ts_mov_b32 m0, %0":"=&s"(keep):"v"(voff),"s"(sbase),"s"(lds_dst):"memory");}
__device__ __forceinline__ void glds16(const void*gsrc,unsigned lds_dst){unsigned keep;
  asm volatile("s_mov_b32 %0, m0\n\ts_mov_b32 m0, %2\n\ts_nop 0\n\tglobal_load_lds_dwordx4 %1, off\n\ts_mov_b32 m0, %0":"=&s"(keep):"v"(gsrc),"s"(lds_dst):"memory");}
__device__ __forceinline__ float max3f(float a,float b,float c){float r;asm("v_max3_f32 %0, %1, %2, %3":"=v"(r):"v"(a),"v"(b),"v"(c));return r;}
__device__ __forceinline__ float max2f(float a,float b){float r;asm("v_max_f32_e32 %0, %1, %2":"=v"(r):"v"(a),"v"(b));return r;}
__device__ __forceinline__ float fadd_s(float a,float b){float r;asm("v_add_f32_e32 %0, %1, %2":"=v"(r):"v"(a),"v"(b));return r;}
__device__ __forceinline__ float fsub_s(float a,float b){float r;asm("v_sub_f32_e32 %0, %1, %2":"=v"(r):"v"(a),"v"(b));return r;}
typedef float f32x2_t __attribute__((ext_vector_type(2))); typedef __bf16 bf16x2_t __attribute__((ext_vector_type(2)));
__device__ __forceinline__ unsigned cvtpk_s(float lo,float hi){f32x2_t v={lo,hi};bf16x2_t b=__builtin_convertvector(v,bf16x2_t);return __builtin_bit_cast(unsigned,b);}
#define WAIT_BAR(N) asm volatile("s_waitcnt vmcnt(" #N ") lgkmcnt(0)\n\ts_barrier":::"memory")

__device__ __forceinline__ void qkt(f32x16&p0,f32x16&p1,const char*Kslot,const bf16x8*qr,int r32,int hi){ const f32x16 negm=f32x16{};
  const char*kb=Kslot+hi*1024+r32*16;
  #pragma unroll
  for(int d0=0;d0<4;++d0){
    const bf16x8 b0=*reinterpret_cast<const bf16x8*>(kb+d0*2048);
    const bf16x8 b1=*reinterpret_cast<const bf16x8*>(kb+d0*2048+512);
    if(d0==0){p0=__builtin_amdgcn_mfma_f32_32x32x16_bf16(b0,qr[0],negm,0,0,0);p1=__builtin_amdgcn_mfma_f32_32x32x16_bf16(b1,qr[0],negm,0,0,0);}
    else{p0=__builtin_amdgcn_mfma_f32_32x32x16_bf16(b0,qr[d0],p0,0,0,0);p1=__builtin_amdgcn_mfma_f32_32x32x16_bf16(b1,qr[d0],p1,0,0,0);}}
}
typedef __attribute__((address_space(3))) const char* lds_cptr;
typedef short v4i16_t __attribute__((ext_vector_type(4)));
__device__ __forceinline__ void kload8(bf16x8*kf,lds_cptr kp){
  kf[0]=*(const __attribute__((address_space(3))) bf16x8*)(kp);      kf[1]=*(const __attribute__((address_space(3))) bf16x8*)(kp+512);
  kf[2]=*(const __attribute__((address_space(3))) bf16x8*)(kp+2048); kf[3]=*(const __attribute__((address_space(3))) bf16x8*)(kp+2560);
  kf[4]=*(const __attribute__((address_space(3))) bf16x8*)(kp+4096); kf[5]=*(const __attribute__((address_space(3))) bf16x8*)(kp+4608);
  kf[6]=*(const __attribute__((address_space(3))) bf16x8*)(kp+6144); kf[7]=*(const __attribute__((address_space(3))) bf16x8*)(kp+6656);
}
__device__ __forceinline__ void kload2(bf16x8*kf,lds_cptr kp,int j){ kf[2*j]=*(const __attribute__((address_space(3))) bf16x8*)(kp+j*2048); kf[2*j+1]=*(const __attribute__((address_space(3))) bf16x8*)(kp+j*2048+512); }
__device__ __forceinline__ s16x4 vtr(lds_cptr p){ return __builtin_bit_cast(s16x4,__builtin_amdgcn_ds_read_tr16_b64_v4i16((__attribute__((address_space(3))) v4i16_t*)p)); }
__device__ __forceinline__ float rowmax(const f32x16&p0,const f32x16&p1){
  float a=max3f(p0[0],p0[1],p1[0]),b=max3f(p0[2],p0[3],p1[1]);a=max3f(a,p1[2],p1[3]);
  #pragma unroll
  for(int r=4;r<16;r+=4){a=max3f(a,p0[r],p0[r+1]);b=max3f(b,p0[r+2],p0[r+3]);a=max3f(a,p1[r],p1[r+1]);b=max3f(b,p1[r+2],p1[r+3]);}
  const float m=max2f(a,b);
  auto rr=__builtin_amdgcn_permlane32_swap(__float_as_uint(m),__float_as_uint(m),false,false);
  return max2f(__uint_as_float(rr[0]),__uint_as_float(rr[1]));
}
__device__ __forceinline__ void pv(f32x16*o,int vb,bf16x8 pa0,bf16x8 pa1,bf16x8 pa2,bf16x8 pa3){
  #pragma unroll
  for(int d0=0;d0<2;++d0){s16x4 lo[4],hi[4];
    #pragma unroll
    for(int ks=0;ks<4;++ks){
      asm volatile("ds_read_b64_tr_b16 %0,%1 offset:%c2":"=&v"(lo[ks]):"v"(vb),"i"(d0*4096+ks*1024):"memory");
      asm volatile("ds_read_b64_tr_b16 %0,%1 offset:%c2":"=&v"(hi[ks]):"v"(vb),"i"(d0*4096+ks*1024+512):"memory");}
    asm volatile("s_waitcnt lgkmcnt(0)":::"memory");SBAR();
    #define PK(k) (bf16x8){lo[k][0],lo[k][1],lo[k][2],lo[k][3],hi[k][0],hi[k][1],hi[k][2],hi[k][3]}
    o[d0]=__builtin_amdgcn_mfma_f32_32x32x16_bf16(pa0,PK(0),o[d0],0,0,0);
    o[d0]=__builtin_amdgcn_mfma_f32_32x32x16_bf16(pa1,PK(1),o[d0],0,0,0);
    o[d0]=__builtin_amdgcn_mfma_f32_32x32x16_bf16(pa2,PK(2),o[d0],0,0,0);
    o[d0]=__builtin_amdgcn_mfma_f32_32x32x16_bf16(pa3,PK(3),o[d0],0,0,0);
    #undef PK
  }
}

#ifndef ATTN_STORE16
#define ATTN_STORE16(p,v) (*(u32x4*)(p)=(v))
#endif
template<int THRL,bool NM> __device__ __forceinline__ void attn_unit(int h,int qb,const bf16*Q,const bf16*__restrict__ K,const bf16*__restrict__ V,const u64*__restrict__ MASK,bf16*O,char*shm){
  int tid_=threadIdx.x; asm volatile("":"+v"(tid_)); const int tid=tid_,lane=tid&63,r32=lane&31,hi=lane>>5; const int wid=__builtin_amdgcn_readfirstlane(tid>>6);
  const long rowbase=0; const int q0=qb*QB;
  const bf16*Qw=Q+(rowbase+q0+wid*QBLK)*DMI+h*D;
  const bf16*Kh=K+rowbase*DMI+h*D,*Vh=V+rowbase*DMI+h*D;
  const unsigned lds0=(unsigned)(uintptr_t)shm;
  float*wsf=(float*)(shm+LDS_WS)+wid*64;
  const unsigned koff=(unsigned)(lane*DMI+wid*8)*2u;
  const unsigned voffv=(unsigned)((16*(wid&3)+(lane>>2))*DMI+(wid>>2)*32+(lane&3)*8)*2u;
  const unsigned kdst=lds0+LDS_K+wid*1024, vdst=lds0+LDS_V+wid*1024;
  const u64*mbase=MASK+q0+wid*QBLK; const int jm=lane>>4; const unsigned mdst=lds0+LDS_M+wid*2048; const unsigned moff0=(unsigned)(lane&15)*16u, moff1=moff0+((jm==1)?(unsigned)SEQ*8u:0u);
  #define DMA_M2(tA,tB,slot) glds16s(mbase+(size_t)(tA)*SEQ,((tB)!=(tA))?moff1:moff0,(unsigned)__builtin_amdgcn_readfirstlane(mdst+(slot)))
  const unsigned sh4=4u*(unsigned)hi; const float NEGINF=-INFINITY;
  #define MAPPLY(C0,C1,MW) do{ const unsigned lo_=(unsigned)(MW)>>sh4, hi_=(unsigned)((MW)>>32)>>sh4; \
    _Pragma("unroll") for(int r=0;r<16;++r){ const int sh_=31-((r&3)+8*(r>>2)); const int m0_=((int)(lo_<<sh_))>>31, m1_=((int)(hi_<<sh_))>>31;   \
      C0[r]=__int_as_float((__float_as_int(C0[r])&m0_)|(~m0_&(int)0xff800000)); C1[r]=__int_as_float((__float_as_int(C1[r])&m1_)|(~m1_&(int)0xff800000)); } }while(0)
  #define DMA_K(t,slot) glds16s(Kh+(long)(t)*KVBLK*DMI,koff,(unsigned)__builtin_amdgcn_readfirstlane(kdst+(slot)))
  #define DMA_V(t,slot) glds16s(Vh+(long)(t)*KVBLK*DMI,voffv,(unsigned)__builtin_amdgcn_readfirstlane(vdst+(slot)))
  const int vb0=(int)(lds0+LDS_V)+((lane>>4)&1)*32+(lane&3)*8+(4*hi+((lane&15)>>2))*64;
  const char*Kbase=shm+LDS_K; bf16x8 kf[8];
  const lds_cptr shm3=(lds_cptr)shm; const lds_cptr mp0=shm3+LDS_M+wid*2048+r32*8;
  #define MLD(off) (*(const __attribute__((address_space(3))) u64*)(mp0+(off)))
  const lds_cptr kp0=shm3+LDS_K+hi*1024+r32*16; const lds_cptr vp0=shm3+LDS_V+((lane>>4)&1)*32+(lane&3)*8+(4*hi+((lane&15)>>2))*64;
  const int NT=(q0+QB)/KVBLK;
  glds16s(mbase,moff0+((jm==0)?(unsigned)SEQ*8u:(jm==1)?(unsigned)SEQ*16u:0u),(unsigned)__builtin_amdgcn_readfirstlane(mdst));
  DMA_K(0,0);DMA_V(0,0);DMA_K(1,SLOTB);
  bf16x8 qr[4];
  #pragma unroll
  for(int d0=0;d0<4;++d0)qr[d0]=*reinterpret_cast<const bf16x8*>(&Qw[(long)r32*DMI+d0*16+hi*8]);
  float mhat=0.f,l_reg=0.f;f32x16 o[2];o[0]=f32x16{};o[1]=f32x16{};const f32x16 Z16=f32x16{};
  bool resc=false;
  #define START(P0,P1,MW) do{ const float rm=NM?0.f:rowmax(P0,P1); resc=false; \
    if(!NM&&__builtin_expect(__any(rm>(float)THRL),0)){ const float dl=__builtin_fmaxf(rm,0.f); mhat+=dl; \
      _Pragma("unroll") for(int r=0;r<16;++r){P0[r]-=dl;P1[r]-=dl;} } \
    MAPPLY(P0,P1,MW); \
    _Pragma("unroll") for(int r=0;r<16;++r)P0[r]=__builtin_amdgcn_exp2f(P0[r]); }while(0)
  #define RESC() do{ if(resc){ asm volatile("s_waitcnt lgkmcnt(0)":::"memory"); \
      _Pragma("unroll") for(int d_=0;d_<2;++d_) _Pragma("unroll") for(int r=0;r<16;++r)o[d_][r]*=wsf[crow(r,hi)]; } }while(0)
  f32x16 pA0,pA1,pB0,pB1;
  int sl_prev=0,sl_cur=0,sl_next=SLOTB;
  #define ROT() do{sl_prev=sl_cur;sl_cur=sl_next;sl_next=(sl_next==(NSLOT-1)*SLOTB)?0:sl_next+SLOTB;}while(0)
  DMA_K(2,2*SLOTB);
  WAIT_BAR(3);
  const u64 mw0=MLD(512);
  qkt(pA0,pA1,Kbase,qr,r32,hi);asm volatile("s_nop 15\n\ts_nop 7":"+v"(pA0),"+v"(pA1));
  START(pA0,pA1,mw0);
  _Pragma("unroll") for(int r=0;r<16;++r)pA1[r]=__builtin_amdgcn_exp2f(pA1[r]);
  WAIT_BAR(0);
  DMA_K(3,0);DMA_V(1,SLOTB);
  ROT();
  kload8(kf,kp0+sl_cur);
  WAIT_BAR(2);
  s16x4 vlo[8],vhi[8]; u32x4 pw0,pw1,pw2,pw3;
  #define PKW(P,B) cvtpk_s(P[B],P[B+1])
  #define PAF(k) __builtin_bit_cast(bf16x8,pw##k)
  #define VFR(i) (bf16x8){vlo[i][0],vlo[i][1],vlo[i][2],vlo[i][3],vhi[i][0],vhi[i][1],vhi[i][2],vhi[i][3]}
  #define PIN(x) asm volatile("":"+v"(x))
  #define MX3(a,b,c) __builtin_fmaxf(__builtin_fmaxf((a),(b)),(c))
  #define GAPA(MF,A0,A1,A2,A3,W0,W1,PW) do{ MF; sacc+=A0; sacc+=A1; sacc+=A2; sacc+=A3; PIN(sacc); W0; W1; PIN(PW); SBAR(); }while(0)
  #define EX(v) __builtin_amdgcn_exp2f(v)
  #define GAPB(MF,X,B) do{ MF; X[B]=EX(X[B]); X[B+1]=EX(X[B+1]); X[B+2]=EX(X[B+2]); X[B+3]=EX(X[B+3]); PIN(X); SBAR(); }while(0)
  #define VRD(i) do{ vlo[i]=vtr(vp_+(((i)>>2)*4096+((i)&3)*1024)); vhi[i]=vtr(vp_+(((i)>>2)*4096+((i)&3)*1024+512)); }while(0)
  #define KRD(G,j) do{ if(G){ kload2(kf,kp0+sl_next,j); SBAR(); } }while(0)
  #define STEP(C0,C1,P0,P1,t,GK,GV,GL,GM,MOFF) do{ SBAR(); \
    const lds_cptr vp_=vp0+sl_prev; \
    VRD(0); SBAR(); float sacc=(P0[0]+P0[1]); \
    GAPA(C0=__builtin_amdgcn_mfma_f32_32x32x16_bf16(kf[0],qr[0],Z16,0,0,0), P0[2],P0[3],P0[4],P0[5],     pw0[0]=PKW(P0,0), pw0[1]=PKW(P0,2), pw0); \
    VRD(4); SBAR(); GAPA(C1=__builtin_amdgcn_mfma_f32_32x32x16_bf16(kf[1],qr[0],Z16,0,0,0), P0[6],P0[7],P0[8],P0[9],     pw0[2]=PKW(P0,4), pw0[3]=PKW(P0,6), pw0); \
    VRD(1); SBAR(); GAPA(C0=__builtin_amdgcn_mfma_f32_32x32x16_bf16(kf[2],qr[1],C0,0,0,0),   P0[10],P0[11],P0[12],P0[13], pw1[0]=PKW(P0,8), pw1[1]=PKW(P0,10), pw1); \
    VRD(5); SBAR(); GAPA(C1=__builtin_amdgcn_mfma_f32_32x32x16_bf16(kf[3],qr[1],C1,0,0,0),   P0[14],P0[15],P1[0],P1[1],   pw1[2]=PKW(P0,12),pw1[3]=PKW(P0,14), pw1); \
    VRD(2); SBAR(); GAPA(C0=__builtin_amdgcn_mfma_f32_32x32x16_bf16(kf[4],qr[2],C0,0,0,0),   P1[2],P1[3],P1[4],P1[5],     pw2[0]=PKW(P1,0), pw2[1]=PKW(P1,2), pw2); \
    VRD(6); SBAR(); GAPA(C1=__builtin_amdgcn_mfma_f32_32x32x16_bf16(kf[5],qr[2],C1,0,0,0),   P1[6],P1[7],P1[8],P1[9],     pw2[2]=PKW(P1,4), pw2[3]=PKW(P1,6), pw2); \
    VRD(3); SBAR(); GAPA(C0=__builtin_amdgcn_mfma_f32_32x32x16_bf16(kf[6],qr[3],C0,0,0,0),   P1[10],P1[11],P1[12],P1[13], pw3[0]=PKW(P1,8), pw3[1]=PKW(P1,10), pw3); \
    VRD(7); SBAR(); GAPA(C1=__builtin_amdgcn_mfma_f32_32x32x16_bf16(kf[7],qr[3],C1,0,0,0),   P1[14],P1[15],0.f,0.f,       pw3[2]=PKW(P1,12),pw3[3]=PKW(P1,14), pw3); \
    l_reg+=sacc; \
    if(GK){DMA_K((t)+3,sl_cur);} if(GV){DMA_V((t)+1,sl_next);} if(GM){ const int tb_=((t)+3<NT)?(t)+3:NT-1; DMA_M2((t)+2,tb_,mslot^1024); } \
    const u64 mw_=MLD(MOFF); \
    resc=false; \
    if(!NM){ if(__builtin_expect(__any(mhat!=0.f),0)){ _Pragma("unroll") for(int r=0;r<16;++r){C0[r]-=mhat;C1[r]-=mhat;} } \
      float a=MX3(C0[0],C0[1],C1[0]),b=MX3(C0[2],C0[3],C1[1]); a=MX3(a,C1[2],C1[3]); \
      _Pragma("unroll") for(int r=4;r<16;r+=4){a=MX3(a,C0[r],C0[r+1]);b=MX3(b,C0[r+2],C0[r+3]);a=MX3(a,C1[r],C1[r+1]);b=MX3(b,C1[r+2],C1[r+3]);} \
      float rm=__builtin_fmaxf(a,b); { auto rr=__builtin_amdgcn_permlane32_swap(__float_as_uint(rm),__float_as_uint(rm),false,false); rm=__builtin_fmaxf(__uint_as_float(rr[0]),__uint_as_float(rr[1])); } \
      resc=false; \
      if(__builtin_expect(__any(rm>(float)THRL),0)){ const float dl=__builtin_fmaxf(rm,0.f); mhat+=dl; \
        _Pragma("unroll") for(int r=0;r<16;++r){C0[r]-=dl;C1[r]-=dl;} \
        const float f=__builtin_amdgcn_exp2f(-dl); l_reg*=f; if(hi==0)wsf[r32]=f; resc=true; } } \
    MAPPLY(C0,C1,mw_); \
    SBAR(); \
    GAPB(o[0]=__builtin_amdgcn_mfma_f32_32x32x16_bf16(PAF(0),VFR(0),o[0],0,0,0), C0,0); \
    GAPB(o[1]=__builtin_amdgcn_mfma_f32_32x32x16_bf16(PAF(0),VFR(4),o[1],0,0,0), C0,4); \
    KRD(GL,0); GAPB(o[0]=__builtin_amdgcn_mfma_f32_32x32x16_bf16(PAF(1),VFR(1),o[0],0,0,0), C0,8); \
    KRD(GL,1); GAPB(o[1]=__builtin_amdgcn_mfma_f32_32x32x16_bf16(PAF(1),VFR(5),o[1],0,0,0), C0,12); \
    KRD(GL,2); GAPB(o[0]=__builtin_amdgcn_mfma_f32_32x32x16_bf16(PAF(2),VFR(2),o[0],0,0,0), C1,0); \
    KRD(GL,3); GAPB(o[1]=__builtin_amdgcn_mfma_f32_32x32x16_bf16(PAF(2),VFR(6),o[1],0,0,0), C1,4); \
    GAPB(o[0]=__builtin_amdgcn_mfma_f32_32x32x16_bf16(PAF(3),VFR(3),o[0],0,0,0), C1,8); \
    GAPB(o[1]=__builtin_amdgcn_mfma_f32_32x32x16_bf16(PAF(3),VFR(7),o[1],0,0,0), C1,12); \
    }while(0)
  int t=1; int mslot=0;
  for(;t+5<NT;t+=2){
    STEP(pB0,pB1,pA0,pA1,t,true,true,true,true,mslot);          WAIT_BAR(3); RESC(); ROT();
    STEP(pA0,pA1,pB0,pB1,t+1,true,true,true,false,mslot+256);   WAIT_BAR(2); RESC(); ROT(); mslot^=1024;
  }
  #define ENDW(nf) do{ if((nf)==3){WAIT_BAR(3);} else if((nf)==2){WAIT_BAR(2);} else if((nf)==1){WAIT_BAR(1);} else {WAIT_BAR(0);} }while(0)
  for(;t+1<NT;t+=2){
    { const bool gk=(t+3<NT),gv=(t+1<NT),gm=(t+2<NT); STEP(pB0,pB1,pA0,pA1,t,gk,gv,gv,gm,mslot);   ENDW((int)gk+(int)gv+(int)gm); RESC(); ROT(); }
    { const bool gk=(t+4<NT),gv=(t+2<NT);             STEP(pA0,pA1,pB0,pB1,t+1,gk,gv,gv,false,mslot+256); ENDW((t+3<NT)?((int)gk+(int)gv):0); RESC(); ROT(); mslot^=1024; }
  }
  STEP(pB0,pB1,pA0,pA1,NT-1,false,false,false,false,mslot); RESC();
  { float sacc=pB0[0]+pB0[1]; _Pragma("unroll") for(int r=2;r<16;++r)sacc+=pB0[r]; _Pragma("unroll") for(int r=0;r<16;++r)sacc+=pB1[r]; l_reg+=sacc;
    pw0=(u32x4){PKW(pB0,0),PKW(pB0,2),PKW(pB0,4),PKW(pB0,6)};pw1=(u32x4){PKW(pB0,8),PKW(pB0,10),PKW(pB0,12),PKW(pB0,14)};pw2=(u32x4){PKW(pB1,0),PKW(pB1,2),PKW(pB1,4),PKW(pB1,6)};pw3=(u32x4){PKW(pB1,8),PKW(pB1,10),PKW(pB1,12),PKW(pB1,14)};
    SBAR(); pv(o,vb0+sl_cur,PAF(0),PAF(1),PAF(2),PAF(3)); }
  #undef PKW
  #undef PAF
  #undef VFR
  #undef PIN
  #undef MX3
  #undef GAPA
  #undef GAPB
  #undef EX
  #undef VRD
  #undef KRD
  #undef STEP
  #undef ENDW
  {auto rr=__builtin_amdgcn_permlane32_swap(__float_as_uint(l_reg),__float_as_uint(l_reg),false,false);l_reg=__uint_as_float(rr[0])+__uint_as_float(rr[1]);}
  if(hi==0)wsf[32+r32]=l_reg;asm volatile("s_waitcnt lgkmcnt(0)":::"memory");
  float rli[16];
  #pragma unroll
  for(int r=0;r<16;++r)rli[r]=__builtin_amdgcn_rcpf(wsf[32+crow(r,hi)]);
  bf16*Ow=O+(rowbase+q0+wid*QBLK)*DMO+h*D;
  { bf16*stg=(bf16*)(shm+LDS_OST)+wid*2048;
    #pragma unroll
    for(int r=0;r<16;++r){const int orow=crow(r,hi);
      #pragma unroll
      for(int d0=0;d0<2;++d0)stg[orow*64+d0*32+r32]=__float2bfloat16(o[d0][r]*rli[r]);}
    asm volatile("s_waitcnt lgkmcnt(0)":::"memory");
    #pragma unroll
    for(int i=0;i<4;++i){const int row=i*8+(lane>>3),ch=lane&7; const u32x4 v=*(const u32x4*)(stg+row*64+ch*8); ATTN_STORE16(Ow+(long)row*DMO+ch*8,v);} }
  asm volatile("s_waitcnt lgkmcnt(0)\n\ts_barrier":::"memory");
  #undef DMA_K
  #undef DMA_V
  #undef DMA_M2
  #undef MAPPLY
  #undef MLD
  #undef START
  #undef RESC
  #undef ROT
}
constexpr int ATTN_LDS_BYTES=LDS_BYTES;
template<int THRL,bool NM> __device__ __forceinline__ void attn_phase(char*lds,const bf16*Q,const bf16*K,const bf16*V,const u64*MASK,bf16*O){
  const int G=gridDim.x;
  for(int w=blockIdx.x;w<256;w+=G){ const int h=w&7,s=w>>3; attn_unit<THRL,NM>(h,s,Q,K,V,MASK,O,lds); attn_unit<THRL,NM>(h,63-s,Q,K,V,MASK,O,lds); }
}
#undef SBAR
#undef WAIT_BAR
}

__device__ __forceinline__ void phase_route_naive(const Params& p, unsigned char* lds) {
    const int tid = opaque_tid(), lane = tid & 63, wave = tid >> 6;
    const int gw = blockIdx.x * NWAVES + wave, NGW = gridDim.x * NWAVES;
    const bf16* H2 = (const bf16*)(p.ws + WS_XN); const float* WGRT = (const float*)(p.ws + WS_WGRT);
    float* RSTD = (float*)(p.ws + WS_RSTD); int* TOKOF = (int*)(p.ws + WS_TOKOF); float* GATEOF = (float*)(p.ws + WS_GATEOF); int* PAIR = (int*)(p.ws + WS_PAIR);
    unsigned* CNT = (unsigned*)(p.ws + WS_CTL) + CW_CNT;
    for (int t = gw; t < S; t += NGW) {
        const uint2* hr = (const uint2*)(H2 + (size_t)t * D) + lane; f32x4 v[4]; float ss = 0.f;
#pragma unroll
        for (int j = 0; j < 4; ++j) { const uint2 hb = hr[64 * j]; v[j] = (f32x4){blo(hb.x), bhi(hb.x), blo(hb.y), bhi(hb.y)}; ss += v[j].x * v[j].x + v[j].y * v[j].y + v[j].z * v[j].z + v[j].w * v[j].w; }
        const float rstd = rsqrtf(wave_sum(ss) * (1.f / D) + EPS);
        float mine = -INFINITY;
        for (int e = 0; e < NE; ++e) { const f32x4* wr = (const f32x4*)(WGRT + (size_t)e * D) + lane; float a = 0.f;
#pragma unroll
            for (int j = 0; j < 4; ++j) { const f32x4 w = wr[64 * j]; a = fmaf(v[j].x, w.x, a); a = fmaf(v[j].y, w.y, a); a = fmaf(v[j].z, w.z, a); a = fmaf(v[j].w, w.w, a); }
            a = wave_sum(a); if (lane == e) mine = a * rstd + p.b_router[e]; }
        float tv[4]; int te[4];
#pragma unroll
        for (int k = 0; k < 4; ++k) { float bv = mine; int bi = lane;
#pragma unroll
            for (int o = 32; o >= 1; o >>= 1) { const float ov = __shfl_xor(bv, o); const int oi = __shfl_xor(bi, o); if (ov > bv || (ov == bv && oi < bi)) { bv = ov; bi = oi; } }
            tv[k] = bv; te[k] = bi; if (lane == bi) mine = -INFINITY; }
        float g[4], gs = 0.f;
#pragma unroll
        for (int k = 0; k < 4; ++k) { g[k] = __expf(tv[k] - tv[0]); gs += g[k]; }
        if (lane == 0) RSTD[t] = rstd;
        if (lane < 4) { const int e = lane == 0 ? te[0] : lane == 1 ? te[1] : lane == 2 ? te[2] : te[3]; const float gg = (lane == 0 ? g[0] : lane == 1 ? g[1] : lane == 2 ? g[2] : g[3]) / gs;
            const unsigned slot = atomicAdd(&CNT[e], 1u); TOKOF[e * S + slot] = t; GATEOF[e * S + slot] = gg; PAIR[t * 4 + lane] = (e << 16) | (int)slot; }
    }
}

__device__ __forceinline__ void phase_route_fast(const Params& p, unsigned char* lds) {
    typedef float f32x16 __attribute__((ext_vector_type(16)));
    const int tid = opaque_tid(), lane = tid & 63, wave = tid >> 6, j = lane & 31, kk = lane >> 5, tsel = wave >> 2, kq = wave & 3;
    const bf16* H2 = (const bf16*)(p.ws + WS_XN); const float* WGR = (const float*)(p.ws + WS_WGRT) + 65536;
    float* RSTD = (float*)(p.ws + WS_RSTD); int* TOKOF = (int*)(p.ws + WS_TOKOF); float* GATEOF = (float*)(p.ws + WS_GATEOF); int* PAIR = (int*)(p.ws + WS_PAIR);
    unsigned* CNT = (unsigned*)(p.ws + WS_CTL) + CW_CNT;
    LAS float* sc = (LAS float*)((LAS unsigned char*)lds + wave * 8192);
    for (int tp = blockIdx.x; tp < S / 64; tp += gridDim.x) {
        const int t0 = (tp * 2 + tsel) * 32;
        const bf16* arow = H2 + (size_t)(t0 + j) * D + kq * 256 + 4 * kk; const float* bcol = WGR + (kq * 256 + 4 * kk) * NE + j;
        f32x16 acc = f32x16{}; float ss = 0.f;
#pragma unroll 8
        for (int m = 0; m < 32; ++m) { const uint2 ar = *(const uint2*)(arow + 8 * m); const f32x4 a = {blo(ar.x), bhi(ar.x), blo(ar.y), bhi(ar.y)};
            const float b0 = bcol[(8 * m + 0) * NE], b1 = bcol[(8 * m + 1) * NE], b2 = bcol[(8 * m + 2) * NE], b3 = bcol[(8 * m + 3) * NE];
            acc = __builtin_amdgcn_mfma_f32_32x32x2f32(a.x, b0, acc, 0, 0, 0); acc = __builtin_amdgcn_mfma_f32_32x32x2f32(a.y, b1, acc, 0, 0, 0);
            acc = __builtin_amdgcn_mfma_f32_32x32x2f32(a.z, b2, acc, 0, 0, 0); acc = __builtin_amdgcn_mfma_f32_32x32x2f32(a.w, b3, acc, 0, 0, 0);
            ss += a.x * a.x + a.y * a.y + a.z * a.z + a.w * a.w; }
        ss += __shfl_xor(ss, 32);
        __syncthreads();
#pragma unroll
        for (int r = 0; r < 16; ++r) sc[((r & 3) + 8 * (r >> 2) + 4 * kk) * 33 + j] = acc[r];
        if (kk == 0) sc[32 * 33 + j] = ss;
        __syncthreads();
        if (kq == 0) {
            const LAS float* s0 = sc, *s1 = sc + 2048, *s2 = sc + 4096, *s3 = sc + 6144;
            const float sst = s0[32 * 33 + j] + s1[32 * 33 + j] + s2[32 * 33 + j] + s3[32 * 33 + j];
            const float rstd = rsqrtf(sst * (1.f / D) + EPS);
            float v[32];
#pragma unroll
            for (int e = 0; e < 32; ++e) v[e] = ((s0[j * 33 + e] + s1[j * 33 + e]) + (s2[j * 33 + e] + s3[j * 33 + e])) * rstd + p.b_router[e];
            float tv[4]; int te[4]; unsigned taken = 0u;
#pragma unroll
            for (int k = 0; k < 4; ++k) { float best = -INFINITY; int bi = 0;
#pragma unroll
                for (int e = 0; e < 32; ++e) { const bool ok = !((taken >> e) & 1u) && (v[e] > best); best = ok ? v[e] : best; bi = ok ? e : bi; }
                tv[k] = best; te[k] = bi; taken |= 1u << bi; }
            float g[4], gs = 0.f;
#pragma unroll
            for (int k = 0; k < 4; ++k) { g[k] = __expf(tv[k] - tv[0]); gs += g[k]; }
            const float gi = 1.f / gs;
            const bool act = lane < 32; int rk[4] = {0, 0, 0, 0}; unsigned mycnt = 0u;
#pragma unroll 4
            for (int e = 0; e < 32; ++e) { const bool pick = act && ((taken >> e) & 1u); const u64 m = __ballot(pick); const int below = __popcll(m & ((1ull << lane) - 1ull));
                if (lane == e) mycnt = (unsigned)__popcll(m);
#pragma unroll
                for (int k = 0; k < 4; ++k) rk[k] = (te[k] == e) ? below : rk[k]; }
            unsigned base = 0u; if (act && mycnt) base = atomicAdd(&CNT[lane], mycnt);
#pragma unroll
            for (int k = 0; k < 4; ++k) { const unsigned be = (unsigned)__shfl((int)base, te[k]); if (act) { const int slot = (int)be + rk[k]; const int t = t0 + lane;
                    TOKOF[te[k] * S + slot] = t; GATEOF[te[k] * S + slot] = g[k] * gi; PAIR[t * 4 + k] = (te[k] << 16) | slot; } }
            if (act) RSTD[t0 + lane] = rstd;
        }
    }
}

__device__ __forceinline__ int build_tiles(const Params& p, unsigned char* lds) {
    int* pst = (int*)(lds + LDS_MISC); int* tile_e = pst + 40;
    unsigned* CNT = (unsigned*)(p.ws + WS_CTL) + CW_CNT;
    __syncthreads();
    const int tid = opaque_tid();
    if (tid < 64) {
        const int e = tid & 31; const int c = (int)__hip_atomic_load(&CNT[e], __ATOMIC_RELAXED, __HIP_MEMORY_SCOPE_AGENT); const int nt = (c + 255) >> 8;
        int incl = nt;
#pragma unroll
        for (int o = 1; o < 32; o <<= 1) { const int v = __shfl_up(incl, o, 32); if (e >= o) incl += v; }
        const int excl = incl - nt;
        if (tid < 32) { pst[e] = excl; pst[328 + e] = c; if (e == 31) pst[NE] = incl; for (int i = 0; i < nt; ++i) tile_e[excl + i] = e; }
    }
    __syncthreads();
    return pst[NE];
}

__device__ __forceinline__ void phase_gather(const Params& p, unsigned char* lds) {
    const int tid = opaque_tid(), lane = tid & 63, wave = tid >> 6;
    const int gw = blockIdx.x * NWAVES + wave, NGW = gridDim.x * NWAVES;
    build_tiles(p, lds); const int* pst = (const int*)(lds + LDS_MISC);
    const bf16* XN2 = (const bf16*)(p.ws + WS_XN); bf16* XS = (bf16*)(p.ws + WS_XS); const int* PAIR = (const int*)(p.ws + WS_PAIR);
    const float* RSTD = (const float*)(p.ws + WS_RSTD); const float* GATEOF = (const float*)(p.ws + WS_GATEOF);
    float* ROWRSTD = (float*)(p.ws + WS_ROWRSTD); float* ROWGATE = (float*)(p.ws + WS_ROWGATE);
#if FUSED_GATHER
    int* ROWTOK = (int*)(p.ws + WS_ROWTOK); const int* tile_e = pst + 40; const unsigned* CNT = (const unsigned*)(p.ws + WS_CTL) + CW_CNT; (void)XN2; (void)XS; (void)lane; (void)gw; (void)NGW;
    for (int row = blockIdx.x * NTHREADS + tid; row < pst[NE] * 256; row += gridDim.x * NTHREADS) { const int e = tile_e[row >> 8]; if (row - pst[e] * 256 >= (int)CNT[e]) ROWTOK[row] = 0; }
    for (int pr = blockIdx.x * NTHREADS + tid; pr < S * 4; pr += gridDim.x * NTHREADS) { const int t = pr >> 2; const int pe = PAIR[pr]; const int e = pe >> 16, slot = pe & 0xffff; const int row = pst[e] * 256 + slot;
        ROWTOK[row] = t; ROWRSTD[row] = RSTD[t]; ROWGATE[row] = GATEOF[e * S + slot]; }
#else
    for (int pr0 = gw * 4; pr0 < S * 4; pr0 += NGW * 4) {
        int row[4]; u32x4 va[4], vb[4];
#pragma unroll
        for (int i = 0; i < 4; ++i) { const int pr = pr0 + i, t = pr >> 2; const int pe = PAIR[pr]; const int e = pe >> 16, slot = pe & 0xffff; row[i] = pst[e] * 256 + slot;
            const u32x4* src = (const u32x4*)(XN2 + (size_t)t * D); va[i] = src[lane]; vb[i] = src[lane + 64];
            if (lane == 0) { ROWRSTD[row[i]] = RSTD[t]; ROWGATE[row[i]] = GATEOF[e * S + slot]; } }
#pragma unroll
        for (int i = 0; i < 4; ++i) { u32x4* dst = (u32x4*)(XS + (size_t)row[i] * D); dst[lane] = va[i]; dst[lane + 64] = vb[i]; }
    }
#endif
}

__device__ __forceinline__ void phase_final(const Params& p, unsigned char* lds) {
    const int tid = opaque_tid(), lane = tid & 63, wave = tid >> 6;
    const int gw = blockIdx.x * NWAVES + wave, NGW = gridDim.x * NWAVES;
    build_tiles(p, lds); const int* pst = (const int*)(lds + LDS_MISC);
    const bf16* H2 = (const bf16*)(p.ws + WS_XN); const bf16* YS = (const bf16*)(p.ws + WS_YS); const int* PAIR = (const int*)(p.ws + WS_PAIR);
    for (int t = gw; t < S; t += NGW) {
        const uint2* hr = (const uint2*)(H2 + (size_t)t * D) + lane; f32x4 v[4];
#pragma unroll
        for (int j = 0; j < 4; ++j) { const uint2 hb = hr[64 * j]; v[j] = (f32x4){blo(hb.x), bhi(hb.x), blo(hb.y), bhi(hb.y)}; }
#pragma unroll
        for (int k = 0; k < 4; ++k) { const int pe = PAIR[t * 4 + k]; const int row = pst[pe >> 16] * 256 + (pe & 0xffff); const uint2* yr = (const uint2*)(YS + (size_t)row * D) + lane;
#pragma unroll
            for (int j = 0; j < 4; ++j) { const uint2 y = yr[64 * j]; v[j].x += blo(y.x); v[j].y += bhi(y.x); v[j].z += blo(y.y); v[j].w += bhi(y.y); } }
        float ss = 0.f;
#pragma unroll
        for (int j = 0; j < 4; ++j) ss += v[j].x * v[j].x + v[j].y * v[j].y + v[j].z * v[j].z + v[j].w * v[j].w;
        const float rstd = rsqrtf(wave_sum(ss) * (1.f / D) + EPS);
        f32x4* o = (f32x4*)(p.out + (size_t)t * D) + lane;
#pragma unroll
        for (int j = 0; j < 4; ++j) { const f32x4 g = ((const f32x4*)p.norm_final_g)[lane + 64 * j]; o[64 * j] = (f32x4){v[j].x * rstd * g.x, v[j].y * rstd * g.y, v[j].z * rstd * g.z, v[j].w * rstd * g.w}; }
    }
}

#define GAS __attribute__((address_space(1)))
typedef GAS unsigned gu32;
#define XB_TMO      128
#define XB_XCNT(j)  (256  + 64 * (j))
#define XB_XSUB(j)  (1280 + 64 * (j))
#define XB_XGEN(j)  (2304 + 64 * (j))
#define XB_TOP      3328
#define XB_TOPGEN   3392
#define XCD_BAR_WORDS 3456
#define XB_SPIN_CAP (1u << 18)

__device__ __forceinline__ unsigned xb_ld(unsigned* p)              { return __hip_atomic_load(p, __ATOMIC_RELAXED, __HIP_MEMORY_SCOPE_AGENT); }
__device__ __forceinline__ unsigned xb_add(unsigned* p, unsigned v) { return __hip_atomic_fetch_add(p, v, __ATOMIC_RELAXED, __HIP_MEMORY_SCOPE_AGENT); }
__device__ __forceinline__ unsigned xb_xcc_id() { return (unsigned)__builtin_amdgcn_s_getreg((3 << 11) | 20) & 0xFu; }
#define XB_SPIN(cond, bar) do { unsigned _sp = 0; while (cond) { __builtin_amdgcn_s_sleep(1); \
    if ((++_sp & 255u) == 0u) { if (xb_ld(&(bar)[XB_TMO])) break; if (_sp > XB_SPIN_CAP) { atomicAdd(&(bar)[XB_TMO], 1u); break; } } } } while (0)

struct XcdBarrier {
    unsigned* bar; unsigned x;
    volatile LAS unsigned* st;
};

__device__ __forceinline__ XcdBarrier xcd_barrier_post(unsigned* bar, volatile LAS unsigned* st) {
    XcdBarrier b; b.bar = bar; b.x = xb_xcc_id(); b.st = st;
    if (threadIdx.x == 0) (void)xb_add(&bar[XB_XCNT(b.x)], 1u);
    return b;
}
__device__ __forceinline__ void xcd_barrier_complete(unsigned* bar, unsigned x, unsigned& nloc, unsigned& nx) {
    const unsigned G = gridDim.x * gridDim.y * gridDim.z;
    unsigned sum, cnt, mine, sp = 0u;
    for (;;) {
        sum = 0u; cnt = 0u; mine = 0u;
#pragma unroll
        for (unsigned j = 0; j < 16; ++j) { const unsigned c = xb_ld(&bar[XB_XCNT(j)]); sum += c; cnt += (c > 0u) ? 1u : 0u; mine = (j == x) ? c : mine; }
        if (sum == G) break;
        __builtin_amdgcn_s_sleep(1);
        if ((++sp & 255u) == 0u) { if (xb_ld(&bar[XB_TMO])) break; if (sp > XB_SPIN_CAP) { atomicAdd(&bar[XB_TMO], 1u); break; } }
    }
    nloc = mine > 0u ? mine : 1u; nx = cnt > 0u ? cnt : 1u;
}

__device__ __forceinline__ void xcd_barrier(const XcdBarrier& b) {
    asm volatile("s_waitcnt vmcnt(0)" ::: "memory");
    __syncthreads();
    if (threadIdx.x == 0) {
        unsigned* bar = b.bar;
        __builtin_amdgcn_s_waitcnt(0);
        unsigned nloc = b.st[0], nx = b.st[1];
        if (nloc == 0u) { xcd_barrier_complete(bar, b.x, nloc, nx); b.st[0] = nloc; b.st[1] = nx; }
        const unsigned old = xb_add(&bar[XB_XSUB(b.x)], 1u);
        const unsigned gen = old / nloc;
        if (old + 1u == (gen + 1u) * nloc) {
            __builtin_amdgcn_fence(__ATOMIC_RELEASE, "agent");
            asm volatile("s_waitcnt vmcnt(0)" ::: "memory");
            const unsigned og = xb_add(&bar[XB_TOP], 1u);
            const unsigned tg = og / nx;
            if (og + 1u == (tg + 1u) * nx) xb_add(&bar[XB_TOPGEN], 1u);
            else XB_SPIN(xb_ld(&bar[XB_TOPGEN]) == tg, bar);
            __builtin_amdgcn_fence(__ATOMIC_ACQUIRE, "agent");
            xb_add(&bar[XB_XGEN(b.x)], 1u);
            asm volatile("s_waitcnt vmcnt(0)" ::: "memory");
        } else {
            XB_SPIN(xb_ld(&bar[XB_XGEN(b.x)]) == gen, bar);
            __builtin_amdgcn_fence(__ATOMIC_ACQUIRE, "agent");
            asm volatile("s_waitcnt vmcnt(0)" ::: "memory");
        }
    }
    __syncthreads();
}

#ifndef FAST_GEMM
#define FAST_GEMM 1
#endif
#ifndef FAST_ATT
#define FAST_ATT 1
#endif
#ifndef FAST_IDX
#define FAST_IDX 1
#endif
#ifndef FAST_EW
#define FAST_EW 1
#endif
#ifndef FAST_ROUTE
#define FAST_ROUTE 1
#endif
template <class F, class Sched>
__device__ __forceinline__ void run_gemm_gather(unsigned char* lds, const bf16* A, const bf16* Bt, int K, const Sched& S, const F& f) {
    pg8::Gemm g{A, Bt, 0, 0, K}; EpiAdapt<F> E{f};
    pg8::gemm_phase<EpiAdapt<F>, Sched, true, true, true>((LAS unsigned char*)lds, g, S, E);
    __syncthreads();
}
template <class F, class Sched>
__device__ __forceinline__ void run_gemm(unsigned char* lds, const bf16* A, const bf16* Bt, int K, const Sched& S, const F& f) {
#if FAST_GEMM
    pg8::Gemm g{A, Bt, 0, 0, K}; EpiAdapt<F> E{f};
    pg8::gemm_phase<EpiAdapt<F>, Sched, true, true>((LAS unsigned char*)lds, g, S, E);
#else
    Unit u;
    for (int i = 0; S.next(i, u); ++i) ngemm_unit(lds, A + (size_t)u.pm * 256 * K, K, Bt + (size_t)S.bidx(u) * 256 * K, K, K, f, u);
#endif
    __syncthreads();
}

#ifndef PROBE_MULT
#define PROBE_MULT 8
#endif
#if PROBE_PHASE >= 0
#define STAMP(i) do { if (blockIdx.x == 0 && opaque_tid() == 0) ((volatile LAS unsigned long long*)((LAS unsigned char*)lds + LDS_PROBE))[i] = __builtin_amdgcn_s_memrealtime(); } while (0)
#else
#define STAMP(i) do { } while (0)
#endif
__global__ void __launch_bounds__(NTHREADS, 2) fwd_kernel(Params p) {
    extern __shared__ __attribute__((aligned(16))) unsigned char lds[];
    cg::grid_group grid = cg::this_grid();
    const int G = gridDim.x, bx = blockIdx.x;
    const LAS int* tile_e = (const LAS int*)((LAS unsigned char*)lds + LDS_MISC) + 40;
    volatile LAS unsigned* bst = (volatile LAS unsigned*)((LAS unsigned char*)lds + LDS_MISC + 4096);
    if (opaque_tid() < 2) bst[opaque_tid()] = 0u;
    __syncthreads();
    const XcdBarrier xbar = xcd_barrier_post((unsigned*)(p.ws + WS_CTL) + CW_BAR, bst);
#if PROBE_PHASE >= 200
    if (opaque_tid() < 16) ((volatile LAS unsigned long long*)((LAS unsigned char*)lds + LDS_PROBE + 256))[opaque_tid()] = 0ull;
#endif
    STAMP(0);
    phase_prologue(p, lds);
    if (gridDim.y == 0xffffu) grid.sync();
    xcd_barrier(xbar);
    STAMP(1);
    { pg8::StaticOrder so; so.init(S, NP, G, bx); EpiProj E{(bf16*)(p.ws + WS_PROJ)};
        run_gemm(lds, (const bf16*)(p.ws + WS_XN), (const bf16*)(p.ws + WS_WINT), D, so, E); }
    phase_deferred_convert(p, lds);
    xcd_barrier(xbar);
    STAMP(2);
#if FAST_EW
    phase_ew_fast(p, lds);
#else
    phase_ew_naive(p, lds);
#endif
    xcd_barrier(xbar);
    STAMP(3);
#if FAST_IDX
    idxf::idx_phase(p, lds);
    __syncthreads();
#else
    phase_idx_naive(p, lds);
#endif
    xcd_barrier(xbar);
    STAMP(4);
#if FAST_ATT
    {
        const int tid = opaque_tid(); const int hq = bx & 7, sq = (bx >> 3) & 31; const int row = ((tid < 256) ? sq : 63 - sq) * 256 + (tid & 255);
        const bf16* qp = (const bf16*)(p.ws + WS_PROJ) + (size_t)row * NP + C_Q + hq * 64; float q1 = 0.f;
#pragma unroll
        for (int j = 0; j < 8; ++j) { const u32x4 v = *(const u32x4*)(qp + j * 8); q1 += fabsf(blo(v.x)) + fabsf(bhi(v.x)) + fabsf(blo(v.y)) + fabsf(bhi(v.y)) + fabsf(blo(v.z)) + fabsf(bhi(v.z)) + fabsf(blo(v.w)) + fabsf(bhi(v.w)); }
        q1 = wave_max(q1); LAS float* qb = (LAS float*)((LAS unsigned char*)lds + LDS_MISC + 4224); if ((tid & 63) == 0) qb[tid >> 6] = q1;
        __syncthreads();
        float qm = qb[0];
#pragma unroll
        for (int w = 1; w < 8; ++w) qm = fmaxf(qm, qb[w]);
        const float kmaxel = *(const float*)((const unsigned*)(p.ws + WS_CTL) + CW_KMAX); const bool nomax = (G == 256) && (qm * kmaxel <= 96.f);
        const attn_body::bf16* PJ = (const attn_body::bf16*)(p.ws + WS_PROJ); const u64* MK = (const u64*)(p.ws + WS_MASK); attn_body::bf16* MO = (attn_body::bf16*)(p.ws + WS_MIX) + 512;
        if (nomax) attn_body::attn_phase<96, true>((char*)lds, PJ + C_Q, PJ + C_K, PJ + C_V, MK, MO);
        else attn_body::attn_phase<96, false>((char*)lds, PJ + C_Q, PJ + C_K, PJ + C_V, MK, MO); }
    __syncthreads();
#else
    phase_att_naive(p, lds);
#endif
    xcd_barrier(xbar);
    STAMP(5);
    { pg8::StaticOrder so; so.init(S, D, G, bx); EpiOut E{p.x, (bf16*)(p.ws + WS_XN)};
        run_gemm(lds, (const bf16*)(p.ws + WS_MIX), (const bf16*)(p.ws + WS_WOUTT), D, so, E); }
    xcd_barrier(xbar);
    STAMP(6);
#if FAST_ROUTE
    phase_route_fast(p, lds);
#else
    phase_route_naive(p, lds);
#endif
    xcd_barrier(xbar);
    STAMP(7);
    { const int ntile = build_tiles(p, lds); const LAS int* pst = (const LAS int*)((LAS unsigned char*)lds + LDS_MISC);
        MoeOrder mo; mo.so.init(ntile * 256, 2048, G, bx); mo.tile_e = tile_e; mo.ncol = 8; mo.ltok = (const LAS int*)((LAS unsigned char*)lds + LDS_LTOK);
        EpiGU E{p.b_gu, (const LAS float*)((LAS unsigned char*)lds + LDS_LRS), (bf16*)(p.ws + WS_HDN), tile_e};
        { const int* TOKOF = (const int*)(p.ws + WS_TOKOF); const float* RSTD = (const float*)(p.ws + WS_RSTD); LAS int* lt = (LAS int*)((LAS unsigned char*)lds + LDS_LTOK); LAS float* lr = (LAS float*)((LAS unsigned char*)lds + LDS_LRS);
            const int tid = opaque_tid(); Unit uu[9]; bool uv[9]; int tok[9]; float rs[9]; bool val[9];
#pragma unroll
            for (int i = 0; i < 9; ++i) { uv[i] = mo.next(i, uu[i]); val[i] = false; tok[i] = 0;
                if (uv[i] && tid < 256) { const int e = tile_e[uu[i].pm], slot = (uu[i].pm - pst[e]) * 256 + tid; val[i] = slot < pst[328 + e]; if (val[i]) tok[i] = TOKOF[e * S + slot]; } }
#pragma unroll
            for (int i = 0; i < 9; ++i) rs[i] = val[i] ? RSTD[tok[i]] : 0.f;
#pragma unroll
            for (int i = 0; i < 9; ++i) if (uv[i] && tid < 256) { lt[i * 256 + tid] = tok[i]; lr[i * 256 + tid] = rs[i]; }
            __syncthreads(); }
        run_gemm_gather(lds, (const bf16*)(p.ws + WS_XN), (const bf16*)(p.ws + WS_WGUT), D, mo, E);
    }
    xcd_barrier(xbar);
    STAMP(8);
    { const int ntile = build_tiles(p, lds);
        MoeOrder mo; mo.so.init(ntile * 256, D, G, bx); mo.tile_e = tile_e; mo.ncol = 4; mo.ltok = nullptr; const LAS int* pst = (const LAS int*)((LAS unsigned char*)lds + LDS_MISC);
        EpiDown E{p.b_down, (const LAS float*)((LAS unsigned char*)lds + LDS_LRS), (bf16*)(p.ws + WS_YS), tile_e};
        { const float* GATEOF = (const float*)(p.ws + WS_GATEOF); LAS float* lg = (LAS float*)((LAS unsigned char*)lds + LDS_LRS); const int tid = opaque_tid(); Unit uu[9]; bool uv[9]; float gv[9];
#pragma unroll
            for (int i = 0; i < 9; ++i) { uv[i] = mo.next(i, uu[i]); gv[i] = 0.f;
                if (uv[i] && tid < 256) { const int e = tile_e[uu[i].pm], slot = (uu[i].pm - pst[e]) * 256 + tid; if (slot < pst[328 + e]) gv[i] = GATEOF[e * S + slot]; } }
#pragma unroll
            for (int i = 0; i < 9; ++i) if (uv[i] && tid < 256) lg[i * 256 + tid] = gv[i];
            __syncthreads(); }
        run_gemm(lds, (const bf16*)(p.ws + WS_HDN), (const bf16*)(p.ws + WS_WDT), DE, mo, E); }
    xcd_barrier(xbar);
    STAMP(9);
    phase_final(p, lds);
#if PROBE_PHASE >= 0
    STAMP(10);
    if (blockIdx.x == 0 && opaque_tid() == 0) { volatile LAS unsigned long long* st = (volatile LAS unsigned long long*)((LAS unsigned char*)lds + LDS_PROBE);
#if PROBE_PHASE >= 200
        const unsigned long long dt = ((volatile LAS unsigned long long*)((LAS unsigned char*)lds + LDS_PROBE + 256))[PROBE_PHASE - 200], t0 = __builtin_amdgcn_s_memrealtime();
#elif PROBE_PHASE == 100 || PROBE_PHASE == 101
        const unsigned long long dt = 125ull * (unsigned long long)__hip_atomic_load((unsigned*)(p.ws + WS_CTL) + 2048, __ATOMIC_RELAXED, __HIP_MEMORY_SCOPE_AGENT), t0 = __builtin_amdgcn_s_memrealtime();
#else
        const unsigned long long dt = st[PROBE_PHASE + 1] - st[PROBE_PHASE], t0 = __builtin_amdgcn_s_memrealtime();
#endif
        while (__builtin_amdgcn_s_memrealtime() - t0 < (unsigned long long)PROBE_MULT * dt) __builtin_amdgcn_s_sleep(8); }
#endif
}

extern "C" void kernel_launch(void* const* d_in, const int* in_sizes, int n_in, void* d_out, int out_size, void* d_ws, size_t ws_size, hipStream_t stream) {
    static int grid = 0;
    if (grid == 0) {
        if (n_in != 19 || out_size != S * D || ws_size < WS_END) { fprintf(stderr, "kernel_launch: unexpected shapes (n_in %d out %d ws %zu)\n", n_in, out_size, ws_size); grid = -1; return; }
        int dev = 0, cus = 0, per_cu = 0;
        (void)hipGetDevice(&dev); (void)hipDeviceGetAttribute(&cus, hipDeviceAttributeMultiprocessorCount, dev);
        if (hipFuncSetAttribute((const void*)fwd_kernel, hipFuncAttributeMaxDynamicSharedMemorySize, LDS_BYTES) != hipSuccess) { fprintf(stderr, "kernel_launch: hipFuncSetAttribute failed\n"); grid = -1; return; }
        if (hipOccupancyMaxActiveBlocksPerMultiprocessor(&per_cu, (const void*)fwd_kernel, NTHREADS, LDS_BYTES) != hipSuccess || per_cu < 1) { fprintf(stderr, "kernel_launch: occupancy query says %d\n", per_cu); per_cu = 1; }
        (void)hipGetLastError();
        grid = cus * 1;
    }
    if (grid < 0) return;
    (void)hipMemsetAsync((char*)d_ws + WS_CTL, 0, CTL_BYTES, stream);
    Params p{};
    p.x = (const float*)d_in[0]; p.pos = (const int*)d_in[1]; p.norm_mix_g = (const float*)d_in[2]; p.w_in = (const float*)d_in[3]; p.idx_g = (const float*)d_in[4]; p.idx_b = (const float*)d_in[5];
    p.conv_w = (const float*)d_in[6]; p.conv_b = (const float*)d_in[7]; p.conv_ng = (const float*)d_in[8]; p.conv_nb = (const float*)d_in[9]; p.w_out = (const float*)d_in[10]; p.norm_ffn_g = (const float*)d_in[11];
    p.w_router = (const float*)d_in[12]; p.b_router = (const float*)d_in[13]; p.w_gu = (const float*)d_in[14]; p.b_gu = (const float*)d_in[15]; p.w_down = (const float*)d_in[16]; p.b_down = (const float*)d_in[17];
    p.norm_final_g = (const float*)d_in[18]; p.out = (float*)d_out; p.ws = (unsigned char*)d_ws;
    void* args[] = {&p};
    hipError_t e = hipLaunchCooperativeKernel((const void*)fwd_kernel, dim3(grid), dim3(NTHREADS), args, LDS_BYTES, stream);
    if (e != hipSuccess) fprintf(stderr, "cooperative launch failed: %s (grid %d)\n", hipGetErrorString(e), grid);
}
```
